# Optimizing an MI355X kernel written in HIP

```python
import jax, jax.numpy as jnp
from jax import lax
import numpy as np

D_MODEL = 1024
BATCH = 8
SEQ = 2048
DEPTH = 1

ATTN_HEADS = 8
ATTN_HEAD_DIM = 64
ATTN_WIDTH = ATTN_HEADS * ATTN_HEAD_DIM
KV_LATENT = 128
IDX_HEADS = 8
IDX_HEAD_DIM = 64
TOPK_MAX = 256
Q_BLOCK = 128
POOL_WINDOWS = (2, 4, 8, 16)
POOL_GROUP = 128
POOL_WIDTH = len(POOL_WINDOWS) * POOL_GROUP
N_EXPERTS = 32
TOP_K_EXPERTS = 4
D_FF = 1024
SWIGLU_LIMIT = 7.0
SWIGLU_ALPHA = 1.702
MOE_BLOCK = 128
DEEPNORM_ALPHA = (2.0 * DEPTH) ** 0.25
DEEPNORM_BETA = (8.0 * DEPTH) ** -0.25
LN_EPS = 1e-5
N_MOD = 6
IN_SIZES = (ATTN_WIDTH, KV_LATENT, IDX_HEADS * IDX_HEAD_DIM, IDX_HEAD_DIM, IDX_HEADS, POOL_WIDTH, 2 * D_MODEL)
IN_COLS = sum(IN_SIZES)

kernel_name = 'hybrid_dsa_pool_moe_deepnorm_block'


def layer_norm(x, g, b):
    xf = x.astype(jnp.float32)
    mu = jnp.mean(xf, axis=-1, keepdims=True)
    var = jnp.mean(jnp.square(xf - mu), axis=-1, keepdims=True)
    y = (xf - mu) * lax.rsqrt(var + LN_EPS)
    return (y * g.astype(jnp.float32) + b.astype(jnp.float32)).astype(x.dtype)


def rms_norm(x, g):
    xf = x.astype(jnp.float32)
    y = xf * lax.rsqrt(jnp.mean(jnp.square(xf), axis=-1, keepdims=True) + LN_EPS)
    return (y * g.astype(jnp.float32)).astype(x.dtype)


def split_cols(a):
    offs, acc = [], 0
    for s in IN_SIZES[:-1]:
        acc += s
        offs.append(acc)
    return jnp.split(a, offs, axis=-1)


def dsa_attention(q_lat, c_kv, q_idx, k_idx, w_idx):
    B, S = c_kv.shape[0], c_kv.shape[1]
    topk = min(TOPK_MAX, S // 4)
    nb = S // Q_BLOCK
    slopes = 2.0 ** (-8.0 * jnp.arange(1, ATTN_HEADS + 1, dtype=jnp.float32) / ATTN_HEADS)
    key_pos = jnp.arange(S)

    def to_blocks(a):
        return jnp.moveaxis(a.reshape((B, nb, Q_BLOCK) + a.shape[2:]), 1, 0)

    def one_block(args):
        ql, qi, wi, start = args
        qpos = start + jnp.arange(Q_BLOCK)
        causal = key_pos[None, :] <= qpos[:, None]
        dots = jnp.einsum('bqhd,bsd->bqhs', qi, k_idx).astype(jnp.float32)
        score = jnp.einsum('bqh,bqhs->bqs', wi.astype(jnp.float32), jax.nn.relu(dots))
        score = jnp.where(causal[None], score, -jnp.inf)
        _, sel = lax.top_k(score, topk)
        c_sel = jax.vmap(lambda c, i: c[i])(c_kv, sel)
        logits = jnp.einsum('bqhr,bqkr->bqhk', ql, c_sel).astype(jnp.float32)
        dist = (qpos[None, :, None] - sel).astype(jnp.float32)
        logits = logits - slopes[None, None, :, None] * dist[:, :, None, :]
        valid = sel <= qpos[None, :, None]
        logits = jnp.where(valid[:, :, None, :], logits, -jnp.inf)
        p = jax.nn.softmax(logits, axis=-1).astype(c_sel.dtype)
        return jnp.einsum('bqhk,bqkr->bqhr', p, c_sel)

    starts = jnp.arange(nb) * Q_BLOCK
    out = lax.map(one_block, (to_blocks(q_lat), to_blocks(q_idx), to_blocks(w_idx), starts))
    return jnp.moveaxis(out, 0, 1).reshape(B, S, ATTN_HEADS, KV_LATENT)


def multiscale_pool(u):
    B, S, C = u.shape
    uf = u.astype(jnp.float32)
    cs = jnp.concatenate([jnp.zeros((B, 1, C), jnp.float32), jnp.cumsum(uf, axis=1)], axis=1)
    upper = jnp.arange(1, S + 1)
    outs = []
    for g, w in enumerate(POOL_WINDOWS):
        lo, hi = g * POOL_GROUP, (g + 1) * POOL_GROUP
        lower = jnp.maximum(upper - w, 0)
        csg = cs[..., lo:hi]
        count = (upper - lower).astype(jnp.float32)[None, :, None]
        outs.append((csg[:, upper] - csg[:, lower]) / count - uf[..., lo:hi])
    return jnp.concatenate(outs, axis=-1).astype(u.dtype)


def moe(h, w_router, b_router, w_gate_up, b_gate_up, w_down, b_down):
    B, S, D = h.shape
    T = B * S
    hf = h.reshape(T, D)
    logits = (hf @ w_router).astype(jnp.float32) + b_router.astype(jnp.float32)
    top_logit, top_e = lax.top_k(logits, TOP_K_EXPERTS)
    gate = jax.nn.softmax(top_logit, axis=-1)
    A = T * TOP_K_EXPERTS
    flat_e = top_e.reshape(A)
    order = jnp.argsort(flat_e)
    sorted_e = flat_e[order]
    tok = order // TOP_K_EXPERTS
    sizes = jnp.bincount(flat_e, length=N_EXPERTS)
    starts = jnp.cumsum(sizes) - sizes
    padded = (sizes + MOE_BLOCK - 1) // MOE_BLOCK * MOE_BLOCK
    pad_end = jnp.cumsum(padded)
    pad_start = pad_end - padded
    dest = pad_start[sorted_e] + jnp.arange(A) - starts[sorted_e]
    n_blocks = -(-A // MOE_BLOCK) + N_EXPERTS
    x_pad = jnp.zeros((n_blocks * MOE_BLOCK, D), h.dtype).at[dest].set(hf[tok])
    block_e = jnp.minimum(jnp.searchsorted(pad_end, jnp.arange(n_blocks) * MOE_BLOCK, side='right'), N_EXPERTS - 1)

    def expert_block(args):
        xb, e = args
        gu = xb @ w_gate_up[e] + b_gate_up[e]
        x_glu, x_lin = jnp.split(gu, 2, axis=-1)
        x_glu = jnp.minimum(x_glu, SWIGLU_LIMIT)
        x_lin = jnp.clip(x_lin, -SWIGLU_LIMIT, SWIGLU_LIMIT)
        act = x_glu * jax.nn.sigmoid(SWIGLU_ALPHA * x_glu) * (x_lin + 1.0)
        return act @ w_down[e] + b_down[e]

    y_pad = lax.map(expert_block, (x_pad.reshape(n_blocks, MOE_BLOCK, D), block_e)).reshape(-1, D)
    y = y_pad[dest] * gate.reshape(A)[order][:, None].astype(h.dtype)
    return jax.ops.segment_sum(y, tok, num_segments=T).reshape(B, S, D)


def setup_inputs(seed: int = 0) -> dict:
    key = jax.random.key(seed)
    ks = jax.random.split(key, 24)
    f32 = jnp.float32
    L, D, E, F, R = DEPTH, D_MODEL, N_EXPERTS, D_FF, KV_LATENT
    nrm = lambda k, shape, s: jax.random.normal(k, shape, f32) * s
    return {
        'x': nrm(ks[0], (BATCH, SEQ, D), 1.0),
        'c': nrm(ks[1], (BATCH, D), 1.0),
        'w_ada': nrm(ks[2], (L, D, N_MOD * D), 0.5 * D ** -0.5),
        'b_ada': nrm(ks[3], (L, N_MOD * D), 0.01),
        'w_in': nrm(ks[4], (L, D, IN_COLS), D ** -0.5),
        'kv_norm_g': 1.0 + nrm(ks[5], (L, R), 0.02),
        'w_uk': nrm(ks[6], (L, R, ATTN_HEADS, ATTN_HEAD_DIM), R ** -0.5),
        'w_uv': nrm(ks[7], (L, R, ATTN_HEADS, ATTN_HEAD_DIM), R ** -0.5),
        'w_pool_group': nrm(ks[8], (L, len(POOL_WINDOWS), POOL_GROUP, POOL_GROUP), POOL_GROUP ** -0.5),
        'pool_scale': 1.0 + nrm(ks[9], (L, POOL_WIDTH), 0.02),
        'w_branch_attn': nrm(ks[10], (L, ATTN_WIDTH, D), ATTN_WIDTH ** -0.5),
        'w_branch_pool': nrm(ks[11], (L, POOL_WIDTH, D), POOL_WIDTH ** -0.5),
        'w_out': nrm(ks[12], (L, D, D), D ** -0.5 * DEEPNORM_BETA),
        'ln1_g': 1.0 + nrm(ks[13], (L, D), 0.02),
        'ln1_b': nrm(ks[14], (L, D), 0.02),
        'w_router': nrm(ks[15], (L, D, E), D ** -0.5),
        'b_router': nrm(ks[16], (L, E), 0.01),
        'w_gate_up': nrm(ks[17], (L, E, D, 2 * F), D ** -0.5),
        'b_gate_up': nrm(ks[18], (L, E, 2 * F), 0.01),
        'w_down': nrm(ks[19], (L, E, F, D), F ** -0.5 * DEEPNORM_BETA),
        'b_down': nrm(ks[20], (L, E, D), 0.01),
        'ln2_g': 1.0 + nrm(ks[21], (L, D), 0.02),
        'ln2_b': nrm(ks[22], (L, D), 0.02),
    }


def reference(x, c, w_ada, b_ada, w_in, kv_norm_g, w_uk, w_uv, w_pool_group, pool_scale,
              w_branch_attn, w_branch_pool, w_out, ln1_g, ln1_b, w_router, b_router,
              w_gate_up, b_gate_up, w_down, b_down, ln2_g, ln2_b):
    B, S, D = x.shape
    cond = jax.nn.silu(c)
    for l in range(DEPTH):
        mod = (cond @ w_ada[l] + b_ada[l]).reshape(B, N_MOD, 1, D)
        shift1, scale1, gate1, shift2, scale2, gate2 = (mod[:, 0], mod[:, 1], mod[:, 2], mod[:, 3], mod[:, 4], mod[:, 5])

        h = x * (1.0 + scale1) + shift1
        q, ckv, qi, ki, wi, u, g = split_cols(h @ w_in[l])
        q = q.reshape(B, S, ATTN_HEADS, ATTN_HEAD_DIM)
        q_lat = jnp.einsum('bshd,rhd->bshr', q, w_uk[l]) * (ATTN_HEAD_DIM ** -0.5)
        ckv = rms_norm(ckv, kv_norm_g[l])
        qi = qi.reshape(B, S, IDX_HEADS, IDX_HEAD_DIM) * (IDX_HEAD_DIM ** -0.5)
        wi = wi * (IDX_HEADS ** -0.5)
        o_lat = dsa_attention(q_lat, ckv, qi, ki, wi)
        y_attn = jnp.einsum('bshr,rhd->bshd', o_lat, w_uv[l]).reshape(B, S, ATTN_WIDTH)
        pooled = multiscale_pool(u).reshape(B, S, len(POOL_WINDOWS), POOL_GROUP)
        y_pool = jnp.einsum('bsgc,gcd->bsgd', pooled, w_pool_group[l]).reshape(B, S, POOL_WIDTH) * pool_scale[l]
        g_attn, g_pool = g[..., :D], g[..., D:]
        mix = jax.nn.sigmoid(g_attn) * (y_attn @ w_branch_attn[l]) + jax.nn.sigmoid(g_pool) * (y_pool @ w_branch_pool[l])
        x = layer_norm(DEEPNORM_ALPHA * x + gate1 * (mix @ w_out[l]), ln1_g[l], ln1_b[l])

        h2 = x * (1.0 + scale2) + shift2
        y_moe = moe(h2, w_router[l], b_router[l], w_gate_up[l], b_gate_up[l], w_down[l], b_down[l])
        x = layer_norm(DEEPNORM_ALPHA * x + gate2 * y_moe, ln2_g[l], ln2_b[l])
    return x
```

```cpp
#include <hip/hip_runtime.h>
#include <cstdio>
#include <cstdint>

namespace {
constexpr int D = 1024, B_ = 8, S_ = 2048, T = B_ * S_;
constexpr int NH = 8, HD = 64, RL = 128, IH = 8, IHD = 64, TOPK = 256;
constexpr int PW = 512, NE = 32, TK = 4, FF = 1024;
constexpr int INC = 3784;
constexpr int O_Q = 0, O_CKV = 512, O_QI = 640, O_KI = 1152, O_WI = 1216, O_U = 1224, O_G = 1736;
constexpr float ALPHA = 1.189207115002721f;
constexpr float LN_EPS = 1e-5f;
constexpr int MAXROWS = T * TK + NE * 256;

__global__ void k_mod(const float* c, const float* w_ada, const float* b_ada, float* mod) {
    const int n = blockIdx.x * 256 + threadIdx.x;
    __shared__ float cs[8 * 1024];
    for (int i = threadIdx.x; i < 8 * 1024; i += 256) { const float v = c[i]; cs[i] = v / (1.f + __expf(-v)); }
    __syncthreads();
    float acc[8] = {0, 0, 0, 0, 0, 0, 0, 0};
    for (int k = 0; k < 1024; ++k) { const float w = w_ada[(size_t)k * 6144 + n];
#pragma unroll
        for (int b = 0; b < 8; ++b) acc[b] += cs[b * 1024 + k] * w; }
    for (int b = 0; b < 8; ++b) mod[b * 6144 + n] = acc[b] + b_ada[n];
}
__global__ void k_modulate(const float* x, const float* mod, int i_shift, int i_scale, float* h) {
    const size_t i = (size_t)blockIdx.x * 256 + threadIdx.x;
    const int col = (int)(i % D); const int b = (int)(i / ((size_t)S_ * D));
    h[i] = x[i] * (1.f + mod[b * 6144 + i_scale * 1024 + col]) + mod[b * 6144 + i_shift * 1024 + col];
}
template <class CF, class AF, class BF, class EF>
__global__ void __launch_bounds__(256) k_gemm(int M, int N, int K, int pad_, CF cf, AF af, BF bf, EF ef) {
    const int ctx = cf(blockIdx.y);
    __shared__ float As[16][65], Bs[16][65];
    const int tx = threadIdx.x & 15, ty = threadIdx.x >> 4;
    const int m0 = blockIdx.y * 64, n0 = blockIdx.x * 64;
    float acc[4][4] = {};
    for (int k0 = 0; k0 < K; k0 += 16) {
        for (int i = threadIdx.x; i < 64 * 16; i += 256) { const int mm = i >> 4, kk = i & 15; As[kk][mm] = (m0 + mm < M) ? af(m0 + mm, k0 + kk, ctx) : 0.f; }
        for (int i = threadIdx.x; i < 64 * 16; i += 256) { const int kk = i >> 6, nn = i & 63; Bs[kk][nn] = (n0 + nn < N) ? bf(k0 + kk, n0 + nn, ctx) : 0.f; }
        __syncthreads();
#pragma unroll
        for (int kk = 0; kk < 16; ++kk) { float a[4], b[4];
#pragma unroll
            for (int i = 0; i < 4; ++i) { a[i] = As[kk][ty * 4 + i]; b[i] = Bs[kk][tx * 4 + i]; }
#pragma unroll
            for (int i = 0; i < 4; ++i)
#pragma unroll
                for (int j = 0; j < 4; ++j) acc[i][j] += a[i] * b[j]; }
        __syncthreads();
    }
#pragma unroll
    for (int i = 0; i < 4; ++i) { const int m = m0 + ty * 4 + i; if (m < M) ef(m, n0 + tx * 4, acc[i], ctx); }
}
__global__ void k_qlat(const float* P, const float* w_uk, float* QL) {
    const int t = blockIdx.x; __shared__ float q[512];
    for (int i = threadIdx.x; i < 512; i += 256) q[i] = P[(size_t)t * INC + O_Q + i];
    __syncthreads();
    for (int o = threadIdx.x; o < 1024; o += 256) { const int h = o >> 7, r = o & 127; float a = 0.f;
        for (int d = 0; d < 64; ++d) a += q[h * 64 + d] * w_uk[r * 512 + h * 64 + d];
        QL[(size_t)t * 1024 + o] = a * 0.125f; }
}
__global__ void k_ckv(const float* P, const float* g, float* CKV) {
    const int t = blockIdx.x, r = threadIdx.x; __shared__ float red[128];
    const float v = P[(size_t)t * INC + O_CKV + r]; red[r] = v * v; __syncthreads();
    for (int s = 64; s > 0; s >>= 1) { if (r < s) red[r] += red[r + s]; __syncthreads(); }
    const float rs = 1.0f / sqrtf(red[0] / 128.f + LN_EPS);
    CKV[(size_t)t * 128 + r] = v * rs * g[r];
}
__global__ void k_pool(const float* P, float* POOLED) {
    const int t = blockIdx.x, c = threadIdx.x, s = t % S_; const int g = c >> 7, w = 2 << g;
    const int lo = (s - w + 1) < 0 ? 0 : (s - w + 1); float sum = 0.f;
    for (int sp = lo; sp <= s; ++sp) sum += P[(size_t)(t - s + sp) * INC + O_U + c];
    POOLED[(size_t)t * 512 + c] = sum / (float)(s - lo + 1) - P[(size_t)t * INC + O_U + c];
}
__global__ void k_ypool(const float* POOLED, const float* w_pg, const float* pscale, float* YP) {
    const int t = blockIdx.x, c = threadIdx.x, g = c >> 7, d = c & 127; __shared__ float p[512];
    p[c] = POOLED[(size_t)t * 512 + c]; __syncthreads();
    float a = 0.f; for (int k = 0; k < 128; ++k) a += p[g * 128 + k] * w_pg[(size_t)g * 16384 + k * 128 + d];
    YP[(size_t)t * 512 + c] = a * pscale[c];
}
__device__ __forceinline__ unsigned ord(float f) { unsigned u = __float_as_uint(f); return (u & 0x80000000u) ? ~u : (u | 0x80000000u); }
__global__ void __launch_bounds__(256) k_select(const float* P, int* SEL, int* CNT) {
    const int t = blockIdx.x, b = t / S_, q = t % S_; const int n = q + 1;
    if (n <= TOPK) { for (int i = threadIdx.x; i < n; i += 256) SEL[(size_t)t * TOPK + i] = i; if (threadIdx.x == 0) CNT[t] = n; return; }
    __shared__ float qi[512]; __shared__ float wi[8]; __shared__ unsigned long long keys[2048];
    for (int i = threadIdx.x; i < 512; i += 256) qi[i] = P[(size_t)t * INC + O_QI + i] * 0.125f;
    if (threadIdx.x < 8) wi[threadIdx.x] = P[(size_t)t * INC + O_WI + threadIdx.x] * 0.35355339059327373f;
    __syncthreads();
    for (int j = threadIdx.x; j < 2048; j += 256) {
        unsigned long long kv = 0ull;
        if (j < n) { const float* kp = P + (size_t)(b * S_ + j) * INC + O_KI; float sc = 0.f;
            for (int h = 0; h < 8; ++h) { float dsum = 0.f; for (int d = 0; d < 64; ++d) dsum += qi[h * 64 + d] * kp[d]; sc += wi[h] * fmaxf(dsum, 0.f); }
            kv = ((unsigned long long)ord(sc) << 32) | (unsigned long long)(0xFFFFFFFFu - (unsigned)j); }
        keys[j] = kv; }
    __syncthreads();
    for (int k = 2; k <= 2048; k <<= 1) for (int j = k >> 1; j > 0; j >>= 1) {
        for (int i = threadIdx.x; i < 2048; i += 256) { const int ixj = i ^ j; if (ixj > i) { const unsigned long long a = keys[i], c = keys[ixj]; const bool up = ((i & k) == 0);
                if (up ? (a < c) : (a > c)) { keys[i] = c; keys[ixj] = a; } } }
        __syncthreads(); }
    for (int i = threadIdx.x; i < TOPK; i += 256) SEL[(size_t)t * TOPK + i] = (int)(0xFFFFFFFFu - (unsigned)(keys[i] & 0xFFFFFFFFull));
    if (threadIdx.x == 0) CNT[t] = TOPK;
}
__global__ void __launch_bounds__(256) k_attn(const float* QL, const float* CKV, const int* SEL, const int* CNT, const float* w_uv, float* YA) {
    const int t = blockIdx.x, b = t / S_, q = t % S_, tid = threadIdx.x; const int cnt = CNT[t];
    __shared__ float ql[128], p[256], red[256], ol[128]; __shared__ int sel[256];
    sel[tid] = (tid < cnt) ? SEL[(size_t)t * TOPK + tid] : 0;
    for (int h = 0; h < 8; ++h) {
        __syncthreads();
        if (tid < 128) ql[tid] = QL[(size_t)t * 1024 + h * 128 + tid];
        __syncthreads();
        const float slope = exp2f(-(float)(h + 1));
        float lg = -INFINITY;
        if (tid < cnt) { const float* kp = CKV + (size_t)(b * S_ + sel[tid]) * 128; float a = 0.f; for (int r = 0; r < 128; ++r) a += ql[r] * kp[r]; lg = a - slope * (float)(q - sel[tid]); }
        red[tid] = lg; __syncthreads();
        for (int s = 128; s > 0; s >>= 1) { if (tid < s) red[tid] = fmaxf(red[tid], red[tid + s]); __syncthreads(); }
        const float mx = red[0]; __syncthreads();
        const float e = (tid < cnt) ? __expf(lg - mx) : 0.f; p[tid] = e; red[tid] = e; __syncthreads();
        for (int s = 128; s > 0; s >>= 1) { if (tid < s) red[tid] += red[tid + s]; __syncthreads(); }
        const float inv = 1.f / red[0];
        if (tid < 128) { float a = 0.f; for (int j = 0; j < cnt; ++j) a += p[j] * CKV[(size_t)(b * S_ + sel[j]) * 128 + tid]; ol[tid] = a * inv; }
        __syncthreads();
        if (tid < 64) { float a = 0.f; for (int r = 0; r < 128; ++r) a += ol[r] * w_uv[r * 512 + h * 64 + tid]; YA[(size_t)t * 512 + h * 64 + tid] = a; }
    }
}
__device__ __forceinline__ float blk_sum(float v, float* red) {
    const int tid = threadIdx.x; red[tid] = v; __syncthreads();
    for (int s = 128; s > 0; s >>= 1) { if (tid < s) red[tid] += red[tid + s]; __syncthreads(); }
    const float r = red[0]; __syncthreads(); return r;
}
__global__ void __launch_bounds__(256) k_ln1_route(const float* Z, const float* g1, const float* b1, const float* mod, const float* w_r, const float* b_r,
                                                   float* X1, float* H2, int* gcnt, int* SLOTMAP, int* TOKSLOT, float* GATE) {
    const int t = blockIdx.x, b = t / S_, tid = threadIdx.x; __shared__ float red[256]; __shared__ float h2s[1024]; __shared__ float lg[32];
    float v[4]; float s = 0.f;
    for (int i = 0; i < 4; ++i) { v[i] = Z[(size_t)t * D + tid + 256 * i]; s += v[i]; }
    const float mean = blk_sum(s, red) / D; float s2 = 0.f;
    for (int i = 0; i < 4; ++i) { v[i] -= mean; s2 += v[i] * v[i]; }
    const float rstd = 1.0f / sqrtf(blk_sum(s2, red) / D + LN_EPS);
    for (int i = 0; i < 4; ++i) { const int col = tid + 256 * i; const float x1 = v[i] * rstd * g1[col] + b1[col]; X1[(size_t)t * D + col] = x1;
        const float h2 = x1 * (1.f + mod[b * 6144 + 4 * 1024 + col]) + mod[b * 6144 + 3 * 1024 + col]; H2[(size_t)t * D + col] = h2; h2s[col] = h2; }
    __syncthreads();
    {
        const int e = tid >> 3, part = tid & 7; float a = 0.f;
        for (int k = part; k < 1024; k += 8) a += h2s[k] * w_r[(size_t)k * 32 + e];
        red[tid] = a; __syncthreads();
        if (part == 0) { float sum = 0.f; for (int i = 0; i < 8; ++i) sum += red[tid + i]; lg[e] = sum + b_r[e]; }
        __syncthreads();
    }
    if (tid == 0) {
        int sel[4]; float val[4]; unsigned used = 0u;
        for (int k = 0; k < 4; ++k) { int best = -1; float bv = -INFINITY; for (int e = 0; e < 32; ++e) if (!((used >> e) & 1u) && (best < 0 || lg[e] > bv)) { best = e; bv = lg[e]; } sel[k] = best; val[k] = bv; used |= 1u << best; }
        float den = 0.f, ex[4]; for (int k = 0; k < 4; ++k) { ex[k] = __expf(val[k] - val[0]); den += ex[k]; }
        for (int k = 0; k < 4; ++k) { const int e = sel[k]; const int rank = atomicAdd(&gcnt[e], 1); SLOTMAP[e * T + rank] = t; TOKSLOT[t * 4 + k] = e | (rank << 8); GATE[t * 4 + k] = ex[k] / den; }
    }
}
__global__ void k_prefix(const int* gcnt, int* tstart) {
    if (threadIdx.x == 0) { int a = 0; for (int e = 0; e < 32; ++e) { tstart[e] = a; a += (gcnt[e] + 255) / 256; } tstart[32] = a; }
}
__global__ void __launch_bounds__(256) k_final(const float* X1, const float* Y, const int* TOKSLOT, const float* GATE, const int* tstart, const float* mod,
                                               const float* g2, const float* b2, float* out) {
    const int t = blockIdx.x, b = t / S_, tid = threadIdx.x; __shared__ float red[256];
    float v[4]; float s = 0.f;
    for (int i = 0; i < 4; ++i) { const int col = tid + 256 * i; float m = 0.f;
        for (int k = 0; k < 4; ++k) { const int ts = TOKSLOT[t * 4 + k]; const int e = ts & 255, rank = ts >> 8; m += GATE[t * 4 + k] * Y[((size_t)tstart[e] * 256 + rank) * 1024 + col]; }
        v[i] = ALPHA * X1[(size_t)t * D + col] + mod[b * 6144 + 5 * 1024 + col] * m; s += v[i]; }
    const float mean = blk_sum(s, red) / D; float s2 = 0.f;
    for (int i = 0; i < 4; ++i) { v[i] -= mean; s2 += v[i] * v[i]; }
    const float rstd = 1.0f / sqrtf(blk_sum(s2, red) / D + LN_EPS);
    for (int i = 0; i < 4; ++i) { const int col = tid + 256 * i; out[(size_t)t * D + col] = v[i] * rstd * g2[col] + b2[col]; }
}

struct ARow { const float* A; long long lda; __device__ float operator()(int m, int k, int) const { return A[(size_t)m * lda + k]; } };
struct BMat { const float* Bm; long long ldb; __device__ float operator()(int k, int n, int) const { return Bm[(size_t)k * ldb + n]; } };
struct EStore { float* C; long long ldc; __device__ void operator()(int m, int n, const float (&a)[4], int) const { for (int j = 0; j < 4; ++j) if (n + j < ldc) C[(size_t)m * ldc + n + j] = a[j]; } };
__device__ __forceinline__ float sigm(float x) { return 1.f / (1.f + __expf(-x)); }
struct EGateMul { float* C; const float* P; long long goff; __device__ void operator()(int m, int n, const float (&a)[4], int) const { for (int j = 0; j < 4; ++j) C[(size_t)m * 1024 + n + j] = sigm(P[(size_t)m * INC + goff + n + j]) * a[j]; } };
struct EGateAdd { float* C; const float* P; long long goff; __device__ void operator()(int m, int n, const float (&a)[4], int) const { for (int j = 0; j < 4; ++j) C[(size_t)m * 1024 + n + j] += sigm(P[(size_t)m * INC + goff + n + j]) * a[j]; } };
struct EResid { float* Z; const float* x; const float* mod; __device__ void operator()(int m, int n, const float (&a)[4], int) const { const int b = m / S_; for (int j = 0; j < 4; ++j) Z[(size_t)m * 1024 + n + j] = ALPHA * x[(size_t)m * 1024 + n + j] + mod[b * 6144 + 2 * 1024 + n + j] * a[j]; } };
struct CZero { long long dummy; __device__ int operator()(int) const { return 0; } };
struct CExp { const int* tstart; __device__ int operator()(int by) const { const int tile = by >> 2; if (tile >= tstart[32]) return -1; int e = 0; while (e < 31 && tstart[e + 1] <= tile) ++e; return e; } };
struct AGather { const float* H2; const int* SLOTMAP; const int* gcnt; const int* tstart;
    __device__ float operator()(int m, int k, int e) const { if (e < 0) return 0.f; const int rank = m - tstart[e] * 256; if (rank >= gcnt[e]) return 0.f; return H2[(size_t)SLOTMAP[e * T + rank] * 1024 + k]; } };
struct BGateUp { const float* W;
    __device__ float operator()(int k, int n, int e) const { if (e < 0) return 0.f; const int j = n >> 1; return W[((size_t)e * 1024 + k) * 2048 + ((n & 1) ? 1024 + j : j)]; } };
struct ESwiglu { float* ACT; const float* bgu;
    __device__ void operator()(int m, int n, const float (&a)[4], int e) const { if (e < 0) return;
        for (int p = 0; p < 2; ++p) { const int j = (n >> 1) + p; float gl = a[2 * p] + bgu[e * 2048 + j], li = a[2 * p + 1] + bgu[e * 2048 + 1024 + j];
            gl = fminf(gl, 7.f); li = fminf(fmaxf(li, -7.f), 7.f); ACT[(size_t)m * 1024 + j] = gl * sigm(1.702f * gl) * (li + 1.f); } } };
struct ARowT { const float* A; __device__ float operator()(int m, int k, int e) const { if (e < 0) return 0.f; return A[(size_t)m * 1024 + k]; } };
struct BDown { const float* W; __device__ float operator()(int k, int n, int e) const { if (e < 0) return 0.f; return W[((size_t)e * 1024 + k) * 1024 + n]; } };
struct EDown { float* Y; const float* bd; __device__ void operator()(int m, int n, const float (&a)[4], int e) const { if (e < 0) return; for (int j = 0; j < 4; ++j) Y[(size_t)m * 1024 + n + j] = a[j] + bd[e * 1024 + n + j]; } };
}

extern "C" void kernel_launch(void* const* d_in, const int* in_sizes, int n_in, void* d_out, int out_size, void* d_ws, size_t ws_size, hipStream_t stream) {
    const float* x = (const float*)d_in[0]; const float* c = (const float*)d_in[1]; const float* w_ada = (const float*)d_in[2]; const float* b_ada = (const float*)d_in[3];
    const float* w_in = (const float*)d_in[4]; const float* kvg = (const float*)d_in[5]; const float* w_uk = (const float*)d_in[6]; const float* w_uv = (const float*)d_in[7];
    const float* w_pg = (const float*)d_in[8]; const float* pscale = (const float*)d_in[9]; const float* w_ba = (const float*)d_in[10]; const float* w_bp = (const float*)d_in[11];
    const float* w_out = (const float*)d_in[12]; const float* g1 = (const float*)d_in[13]; const float* b1 = (const float*)d_in[14]; const float* w_r = (const float*)d_in[15];
    const float* b_r = (const float*)d_in[16]; const float* w_gu = (const float*)d_in[17]; const float* b_gu = (const float*)d_in[18]; const float* w_d = (const float*)d_in[19];
    const float* b_d = (const float*)d_in[20]; const float* g2 = (const float*)d_in[21]; const float* b2 = (const float*)d_in[22];
    float* out = (float*)d_out; char* ws = (char*)d_ws;
    const size_t MiB = 1u << 20;
    int* gcnt = (int*)(ws); int* tstart = (int*)(ws + 4096);
    float* MOD = (float*)(ws + 1 * MiB);
    float* P = (float*)(ws + 2 * MiB); float* ACT = P;
    float* Y = (float*)(ws + 290 * MiB);
    float* H = (float*)(ws + 580 * MiB); float* MIX = H;
    float* QL = (float*)(ws + 644 * MiB); float* Z = QL;
    float* CKV = (float*)(ws + 708 * MiB); float* POOLED = (float*)(ws + 716 * MiB); float* YP = (float*)(ws + 748 * MiB);
    int* SEL = (int*)(ws + 780 * MiB); int* CNT = (int*)(ws + 796 * MiB);
    float* YA = (float*)(ws + 797 * MiB); float* X1 = (float*)(ws + 829 * MiB); float* H2 = (float*)(ws + 893 * MiB);
    int* SLOTMAP = (int*)(ws + 957 * MiB); int* TOKSLOT = (int*)(ws + 959 * MiB); float* GATE = (float*)(ws + 959 * MiB + 512 * 1024);
    if (ws_size < 960 * MiB) { fprintf(stderr, "workspace too small: %zu\n", ws_size); return; }
    (void)hipMemsetAsync(ws, 0, 8192, stream);
    k_mod<<<24, 256, 0, stream>>>(c, w_ada, b_ada, MOD);
    k_modulate<<<T * D / 256, 256, 0, stream>>>(x, MOD, 0, 1, H);
    k_gemm<<<dim3((INC + 63) / 64, T / 64), 256, 0, stream>>>(T, INC, D, 0, CZero{0}, ARow{H, D}, BMat{w_in, INC}, EStore{P, INC});
    k_qlat<<<T, 256, 0, stream>>>(P, w_uk, QL);
    k_ckv<<<T, 128, 0, stream>>>(P, kvg, CKV);
    k_pool<<<T, 512, 0, stream>>>(P, POOLED);
    k_ypool<<<T, 512, 0, stream>>>(POOLED, w_pg, pscale, YP);
    k_select<<<T, 256, 0, stream>>>(P, SEL, CNT);
    k_attn<<<T, 256, 0, stream>>>(QL, CKV, SEL, CNT, w_uv, YA);
    k_gemm<<<dim3(D / 64, T / 64), 256, 0, stream>>>(T, D, 512, 0, CZero{0}, ARow{YA, 512}, BMat{w_ba, D}, EGateMul{MIX, P, O_G});
    k_gemm<<<dim3(D / 64, T / 64), 256, 0, stream>>>(T, D, 512, 0, CZero{0}, ARow{YP, 512}, BMat{w_bp, D}, EGateAdd{MIX, P, O_G + 1024});
    k_gemm<<<dim3(D / 64, T / 64), 256, 0, stream>>>(T, D, D, 0, CZero{0}, ARow{MIX, D}, BMat{w_out, D}, EResid{Z, x, MOD});
    k_ln1_route<<<T, 256, 0, stream>>>(Z, g1, b1, MOD, w_r, b_r, X1, H2, gcnt, SLOTMAP, TOKSLOT, GATE);
    k_prefix<<<1, 64, 0, stream>>>(gcnt, tstart);
    k_gemm<<<dim3(2048 / 64, MAXROWS / 64), 256, 0, stream>>>(MAXROWS, 2048, D, 0, CExp{tstart}, AGather{H2, SLOTMAP, gcnt, tstart}, BGateUp{w_gu}, ESwiglu{ACT, b_gu});
    k_gemm<<<dim3(1024 / 64, MAXROWS / 64), 256, 0, stream>>>(MAXROWS, 1024, FF, 0, CExp{tstart}, ARowT{ACT}, BDown{w_d}, EDown{Y, b_d});
    k_final<<<T, 256, 0, stream>>>(X1, Y, TOKSLOT, GATE, tstart, MOD, g2, b2, out);
}
```

```cpp
#include <hip/hip_runtime.h>
#include <cstdio>
#include <cstdint>
namespace pg8 {
#define PG8_LAS __attribute__((address_space(3)))
typedef unsigned short bf16_t;
typedef short bf16x8 __attribute__((ext_vector_type(8)));
typedef float f32x4 __attribute__((ext_vector_type(4)));
typedef unsigned u32x4 __attribute__((ext_vector_type(4)));
constexpr int BM = 256, BK = 64, HALF = 128, HTB = HALF * BK * 2  , STAGE_BYTES = 8 * HTB, NXCD = 8, WGM = 8;

__host__ __device__ __forceinline__ int lds_byte(int r, int c) { const int st = (r >> 4) * 2 + (c >> 5), rr = r & 15, cc = c & 31, ob = rr * 64 + cc * 2; return st * 1024 + (ob ^ (((ob >> 9) & 1) << 5)); }
__host__ __device__ __forceinline__ void stage_rc(int b, int& R, int& C) { const int st = b / 1024, sb = b % 1024, swz = sb ^ (((sb >> 9) & 1) << 5); R = (st >> 1) * 16 + swz / 64; C = (st & 1) * 32 + (swz % 64) / 2; }
__host__ __device__ __forceinline__ int perm32(int rho) { const int n = rho >> 4, i = rho & 15; return 8 * (i >> 2) + 4 * n + (i & 3); }

struct Unit { int pm, pn; };
struct Gemm { const bf16_t* A; const bf16_t* Bt; int M, N, K; };

struct StaticOrder {
    int nM, nN, nwg, G, c;
    __host__ __device__ void init(int M, int N, int G_, int c_) { nM = M / BM; nN = N / BM; nwg = nM * nN; G = G_; c = c_; }
    __host__ __device__ bool next(int i, Unit& u) const {
        const long L = (long)i * G + c; if (L >= nwg) return false;
        int wgid = (int)L; { const int q = nwg / NXCD, r = nwg % NXCD, xcd = wgid % NXCD, off = wgid / NXCD; wgid = (xcd < r ? xcd * (q + 1) : r * (q + 1) + (xcd - r) * q) + off; }
        const int nig = WGM * nN, gid = wgid / nig, fm = gid * WGM, gsz = (nM - fm) < WGM ? (nM - fm) : WGM;
        u.pm = fm + ((wgid % nig) % gsz); u.pn = (wgid % nig) / gsz; return true;
    }
    __device__ __forceinline__ void a_ready(const Unit&) const {}
    __device__ __forceinline__ void done(const Unit&) const {}
};

__device__ __forceinline__ unsigned cvt_pk_bf16(float lo, float hi) { unsigned r; asm volatile("v_cvt_pk_bf16_f32 %0, %1, %2" : "=v"(r) : "v"(lo), "v"(hi)); return r; }
typedef float f32x2 __attribute__((ext_vector_type(2)));
__device__ __forceinline__ f32x2 gelu_pk(f32x2 v) {
    const f32x2 av = __builtin_elementwise_abs(v), d = av * 0.2316418882f + 1.0f;
    f32x2 t; t.x = __builtin_amdgcn_rcpf(d.x); t.y = __builtin_amdgcn_rcpf(d.y);
    f32x2 q = t * 0.5307027145f + (-0.7265760135f); q = q * t + 0.7107068705f; q = q * t + (-0.142248368f); q = q * t + 0.127414796f; q = q * t;
    const f32x2 s = (v * v) * (-0.72134752044f);
    f32x2 e; e.x = __builtin_amdgcn_exp2f(s.x); e.y = __builtin_amdgcn_exp2f(s.y);
    const f32x2 m = v * (q * e), r = v - m;
    f32x2 o; o.x = v.x < 0.f ? m.x : r.x; o.y = v.y < 0.f ? m.y : r.y; return o;
}

template <int ACT  > struct EpiBf16 {
    static constexpr bool PERM = true, AFTER_DRAIN = false; static_assert(ACT == 0 || ACT == 1, "EpiBf16: ACT is 0 (none) or 1 (gelu_pk)");
    bf16_t* O; int ldc; const float* bias; int split_cols; size_t split_stride; float scale0;
    __device__ __forceinline__ void operator()(const f32x4 (&acc)[2][2][4][2], const Unit& u, int wr, int wc, int fr, int fq) const {
        const int row0 = u.pm * BM + wr * 64 + fr; int colt = u.pn * BM; bf16_t* base = O;
        float sc = 1.f; if (split_cols) { const int t = colt / split_cols; base += (size_t)t * split_stride; colt -= t * split_cols; if (t == 0) sc = scale0; }
        const int col0 = colt + wc * 32 + 8 * fq, bcol0 = u.pn * BM + wc * 32 + 8 * fq;
        f32x4 bv[2][2];
#pragma unroll
        for (int bj = 0; bj < 2; ++bj)
#pragma unroll
            for (int n = 0; n < 2; ++n) bv[bj][n] = bias ? *(const f32x4*)(bias + bcol0 + bj * HALF + 4 * n) : (f32x4){0.f, 0.f, 0.f, 0.f};
#pragma unroll
        for (int ai = 0; ai < 2; ++ai)
#pragma unroll
            for (int m = 0; m < 4; ++m) { bf16_t* rowp = base + (size_t)(row0 + ai * HALF + m * 16) * ldc + col0;
#pragma unroll
                for (int bj = 0; bj < 2; ++bj) { f32x4 v0 = acc[ai][bj][m][0] + bv[bj][0], v1 = acc[ai][bj][m][1] + bv[bj][1];
                    if (ACT == 1) { f32x2 a = gelu_pk((f32x2){v0[0], v0[1]}), b = gelu_pk((f32x2){v0[2], v0[3]}), c = gelu_pk((f32x2){v1[0], v1[1]}), d = gelu_pk((f32x2){v1[2], v1[3]});
                        v0 = (f32x4){a.x, a.y, b.x, b.y}; v1 = (f32x4){c.x, c.y, d.x, d.y}; }
                    v0 = v0 * sc; v1 = v1 * sc; u32x4 w; w.x = cvt_pk_bf16(v0[0], v0[1]); w.y = cvt_pk_bf16(v0[2], v0[3]); w.z = cvt_pk_bf16(v1[0], v1[1]); w.w = cvt_pk_bf16(v1[2], v1[3]);
                    *(u32x4*)(rowp + bj * HALF) = w; } }
    }
};

struct PanelStats {
    unsigned* xbuf;
    unsigned* cnt;
    unsigned* tmo;
    int ntn; float eps;
    unsigned code;
    __device__ __forceinline__ bool run(const f32x4 (&v)[2][2][4][2], const Unit& u, int wr, int wc, int fr, int fq, PG8_LAS unsigned char* lds, int wid, int lane) const {
        typedef float f32x2v __attribute__((ext_vector_type(2)));
        PG8_LAS f32x2v* P = (PG8_LAS f32x2v*)lds;
        PG8_LAS f32x2v* S = (PG8_LAS f32x2v*)(lds + 8192);
        PG8_LAS unsigned* flag = (PG8_LAS unsigned*)(lds + 8192 + 2048);
#pragma unroll
        for (int ai = 0; ai < 2; ++ai)
#pragma unroll
            for (int m = 0; m < 4; ++m) {
                float s = 0.f;
#pragma unroll
                for (int bj = 0; bj < 2; ++bj)
#pragma unroll
                    for (int n = 0; n < 2; ++n) { const f32x4 x = v[ai][bj][m][n]; s += (x[0] + x[1]) + (x[2] + x[3]); }
                s += __shfl_xor(s, 16); s += __shfl_xor(s, 32);
                const float mw = s * (1.0f / 64.0f); float q = 0.f;
#pragma unroll
                for (int bj = 0; bj < 2; ++bj)
#pragma unroll
                    for (int n = 0; n < 2; ++n) { const f32x4 d = v[ai][bj][m][n] - mw; q += (d[0] * d[0] + d[1] * d[1]) + (d[2] * d[2] + d[3] * d[3]); }
                q += __shfl_xor(q, 16); q += __shfl_xor(q, 32);
                if (fq == 0) P[(ai * HALF + wr * 64 + m * 16 + fr) * 4 + wc] = (f32x2v){mw, q};
            }
        asm volatile("s_waitcnt lgkmcnt(0)" ::: "memory"); __builtin_amdgcn_s_barrier(); asm volatile("" ::: "memory");
#if defined(BROKEN_EXCHANGE_NO_WAIT)
#warning BROKEN CONTROL BUILD: the row-statistics exchange does not wait; results are wrong by design
        if (blockIdx.x >= 64) { const long long t0_ = clock64(); while (clock64() - t0_ < 60000) __builtin_amdgcn_s_sleep(8); }
#endif
        const int row = wid * 32 + (lane & 31);
        if (lane < 32) {
            const f32x2v a = P[row * 4 + 0], b = P[row * 4 + 1], c = P[row * 4 + 2], d = P[row * 4 + 3];
            const float mt = (a.x + b.x + c.x + d.x) * 0.25f;
            const float da = a.x - mt, db = b.x - mt, dc = c.x - mt, dd = d.x - mt;
            const float m2 = (a.y + b.y) + (c.y + d.y) + 64.0f * ((da * da + db * db) + (dc * dc + dd * dd));
            unsigned long long* slot = (unsigned long long*)xbuf + ((size_t)(u.pm * BM + row) * 4 + u.pn);
            __hip_atomic_store(slot, ((unsigned long long)__float_as_uint(m2) << 32) | __float_as_uint(mt), __ATOMIC_RELAXED, __HIP_MEMORY_SCOPE_AGENT);
        }
        asm volatile("s_waitcnt vmcnt(0)" ::: "memory");
        if (lane == 0) __hip_atomic_fetch_add(cnt + 64 * u.pm, 1u, __ATOMIC_RELAXED, __HIP_MEMORY_SCOPE_AGENT);
        if (wid == 0) {
            bool dead = false; const unsigned long long t0 = __builtin_amdgcn_s_memrealtime(); const unsigned want = 8u * (unsigned)ntn;
            for (;;) {
#if defined(BROKEN_EXCHANGE_NO_WAIT)
                break;
#endif
                if ((unsigned)__builtin_amdgcn_readfirstlane(__hip_atomic_load(cnt + 64 * u.pm, __ATOMIC_RELAXED, __HIP_MEMORY_SCOPE_AGENT)) >= want) break;
                if (__builtin_amdgcn_s_memrealtime() - t0 > 2000000ull) {
                    if (lane == 0) { unsigned expect = 0u; __hip_atomic_compare_exchange_strong(tmo + 1, &expect, code | (unsigned)(u.pm & 0xff), __ATOMIC_RELAXED, __ATOMIC_RELAXED, __HIP_MEMORY_SCOPE_AGENT);
                                     __hip_atomic_store(tmo, 1u, __ATOMIC_RELAXED, __HIP_MEMORY_SCOPE_AGENT); }
                    dead = true; break; }
                __builtin_amdgcn_s_sleep(2);
            }
            __builtin_amdgcn_fence(__ATOMIC_ACQUIRE, "agent");
            if (lane == 0) flag[0] = dead ? 1u : 0u;
        }
        asm volatile("s_waitcnt vmcnt(0) lgkmcnt(0)" ::: "memory"); __builtin_amdgcn_s_barrier(); asm volatile("" ::: "memory");
        const bool bad = flag[0] != 0u;
        if (lane < 32) {
            const unsigned long long* slot = (const unsigned long long*)xbuf + (size_t)(u.pm * BM + row) * 4; float mt[4], m2[4]; float ms = 0.f;
#pragma unroll
            for (int t = 0; t < 4; ++t) { if (t < ntn) { const unsigned long long w = __hip_atomic_load(slot + t, __ATOMIC_RELAXED, __HIP_MEMORY_SCOPE_AGENT); mt[t] = __uint_as_float((unsigned)w); m2[t] = __uint_as_float((unsigned)(w >> 32)); } else { mt[t] = 0.f; m2[t] = 0.f; } ms += mt[t]; }
            const float mean = ms / (float)ntn; float q = 0.f;
#pragma unroll
            for (int t = 0; t < 4; ++t) if (t < ntn) { const float dm = mt[t] - mean; q += m2[t] + 256.0f * dm * dm; }
            S[row] = (f32x2v){mean, 1.0f / sqrtf(q / (256.0f * (float)ntn) + eps)};
        }
        asm volatile("s_waitcnt lgkmcnt(0)" ::: "memory"); __builtin_amdgcn_s_barrier(); asm volatile("" ::: "memory");
        return bad;
    }
};
struct EpiLnRes {
    static constexpr bool PERM = false, AFTER_DRAIN = true;
    const float* base; float* out; int ldc; const float* bias; PanelStats st; unsigned poison;
    __device__ __forceinline__ void fused(f32x4 (&acc)[2][2][4][2], const Unit& u, int wr, int wc, int fr, int fq, PG8_LAS unsigned char* lds, int wid, int lane) const {
        typedef float f32x2v __attribute__((ext_vector_type(2)));
        const PG8_LAS f32x2v* S = (const PG8_LAS f32x2v*)(lds + 8192);
        const int col0 = u.pn * BM + wc * 32 + 4 * fq;
#pragma unroll
        for (int bj = 0; bj < 2; ++bj)
#pragma unroll
            for (int n = 0; n < 2; ++n) { const f32x4 bv = bias ? *(const f32x4*)(bias + col0 + bj * HALF + n * 16) : (f32x4){0.f, 0.f, 0.f, 0.f};
#pragma unroll
                for (int ai = 0; ai < 2; ++ai)
#pragma unroll
                    for (int m = 0; m < 4; ++m) acc[ai][bj][m][n] += bv; }
        f32x4 pre[4][2][2];
#pragma unroll
        for (int m = 0; m < 4; ++m) { const size_t off = (size_t)(u.pm * BM + wr * 64 + m * 16 + fr) * ldc + col0;
#pragma unroll
            for (int bj = 0; bj < 2; ++bj)
#pragma unroll
                for (int n = 0; n < 2; ++n) pre[m][bj][n] = *(const f32x4*)(base + off + bj * HALF + n * 16); }
        const bool bad = st.run(acc, u, wr, wc, fr, fq, lds, wid, lane) || poison != 0u;
        const float qnan = __builtin_nanf("");
#pragma unroll
        for (int ai = 0; ai < 2; ++ai)
#pragma unroll
            for (int m = 0; m < 4; ++m) { const int r = ai * HALF + wr * 64 + m * 16 + fr; const f32x2v sr = S[r]; const size_t off = (size_t)(u.pm * BM + r) * ldc + col0;
#pragma unroll
                for (int bj = 0; bj < 2; ++bj)
#pragma unroll
                    for (int n = 0; n < 2; ++n) { const f32x4 bs = ai == 0 ? pre[m][bj][n] : *(const f32x4*)(base + off + bj * HALF + n * 16); f32x4 o = bs + (acc[ai][bj][m][n] - sr.x) * sr.y;
                        if (bad) o = (f32x4){qnan, qnan, qnan, qnan}; *(f32x4*)(out + off + bj * HALF + n * 16) = o; }
                if (m & 1) asm volatile("" ::: "memory"); }
    }
};
struct EpiLnResLn {
    static constexpr bool PERM = false, AFTER_DRAIN = true;
    const float* base; float* out; bf16_t* xn; int ldc; const float* bias; PanelStats st1, st2; unsigned poison;
    __device__ __forceinline__ void fused(f32x4 (&acc)[2][2][4][2], const Unit& u, int wr, int wc, int fr, int fq, PG8_LAS unsigned char* lds, int wid, int lane) const {
        typedef float f32x2v __attribute__((ext_vector_type(2))); typedef unsigned u32x2v __attribute__((ext_vector_type(2)));
        const PG8_LAS f32x2v* S = (const PG8_LAS f32x2v*)(lds + 8192);
        const int col0 = u.pn * BM + wc * 32 + 4 * fq;
#pragma unroll
        for (int bj = 0; bj < 2; ++bj)
#pragma unroll
            for (int n = 0; n < 2; ++n) { const f32x4 bv = bias ? *(const f32x4*)(bias + col0 + bj * HALF + n * 16) : (f32x4){0.f, 0.f, 0.f, 0.f};
#pragma unroll
                for (int ai = 0; ai < 2; ++ai)
#pragma unroll
                    for (int m = 0; m < 4; ++m) acc[ai][bj][m][n] += bv; }
        bool bad = st1.run(acc, u, wr, wc, fr, fq, lds, wid, lane) || poison != 0u;
        const float qnan = __builtin_nanf("");
#pragma unroll
        for (int ai = 0; ai < 2; ++ai)
#pragma unroll
            for (int m = 0; m < 4; ++m) { const int r = ai * HALF + wr * 64 + m * 16 + fr; const f32x2v sr = S[r]; const size_t off = (size_t)(u.pm * BM + r) * ldc + col0;
#pragma unroll
                for (int bj = 0; bj < 2; ++bj)
#pragma unroll
                    for (int n = 0; n < 2; ++n) { const f32x4 bs = *(const f32x4*)(base + off + bj * HALF + n * 16); acc[ai][bj][m][n] = bs + (acc[ai][bj][m][n] - sr.x) * sr.y; }
                asm volatile("" : "+v"(acc[ai][0][m][0]), "+v"(acc[ai][0][m][1]), "+v"(acc[ai][1][m][0]), "+v"(acc[ai][1][m][1]));
                if (m & 1) asm volatile("" ::: "memory"); }
        const bool bad1 = bad;
        bad = st2.run(acc, u, wr, wc, fr, fq, lds, wid, lane) || bad;
#pragma unroll
        for (int ai = 0; ai < 2; ++ai)
#pragma unroll
            for (int m = 0; m < 4; ++m) { const int r = ai * HALF + wr * 64 + m * 16 + fr; const f32x2v sr = S[r]; const size_t off = (size_t)(u.pm * BM + r) * ldc + col0;
#pragma unroll
                for (int bj = 0; bj < 2; ++bj)
#pragma unroll
                    for (int n = 0; n < 2; ++n) { const f32x4 x1 = acc[ai][bj][m][n]; *(f32x4*)(out + off + bj * HALF + n * 16) = bad1 ? (f32x4){qnan, qnan, qnan, qnan} : x1;
                        const f32x4 o = (x1 - sr.x) * sr.y; u32x2v w; w.x = cvt_pk_bf16(o[0], o[1]); w.y = cvt_pk_bf16(o[2], o[3]);
                        if (bad) { w.x = 0x7fc07fc0u; w.y = 0x7fc07fc0u; } *(u32x2v*)(xn + off + bj * HALF + n * 16) = w; }
                asm volatile("" ::: "memory"); }
    }
};

template <class Epi, class Sched, bool ALIGN_EPI = false, bool SP2 = false>
__device__ __forceinline__ void gemm_phase(PG8_LAS unsigned char* lds, const Gemm g, const Sched& S, const Epi& E) {
    const int tid = threadIdx.x, wid = __builtin_amdgcn_readfirstlane(tid >> 6), lane = tid & 63, wr = wid >> 2, wc = wid & 3, fr = lane & 15, fq = lane >> 4;
    const int K = g.K, nt = K / BK;
    unsigned voffA[2], voffB[2];
#pragma unroll
    for (int i = 0; i < 2; ++i) { int R, C; stage_rc(tid * 16 + i * 8192, R, C); const int Rb = Epi::PERM ? ((R & ~31) + perm32(R & 31)) : R;
        voffA[i] = (unsigned)(R * K + C) * 2u; voffB[i] = (unsigned)(Rb * K + C) * 2u; }
    const size_t kstep = (size_t)(BK * 2);
    const size_t hstep = (size_t)HALF * K * 2;
    const size_t tstep = 2 * hstep;
    const unsigned ldsw = (unsigned)wid * 1024u;
    const int aoff = lds_byte(wr * 64 + fr, fq * 8), boff = lds_byte(wc * 32 + fr, fq * 8);
#define PG8_SA(b, h) (((b) * 2 + (h)) * HTB)
#define PG8_SB(b, h) ((4 + (b) * 2 + (h)) * HTB)
#define PG8_STAGE(bufoff, gbase, voff) do { _Pragma("unroll") for (int _i = 0; _i < 2; ++_i) \
        __builtin_amdgcn_global_load_lds((const unsigned*)((const char*)(gbase) + (voff)[_i]), (PG8_LAS unsigned*)(lds + (bufoff) + ldsw + _i * 8192), 16, 0, 0); } while (0)
#define PG8_LDA(dst, b, h) do { _Pragma("unroll") for (int m = 0; m < 4; ++m) _Pragma("unroll") for (int k = 0; k < 2; ++k) dst[m][k] = *(const PG8_LAS bf16x8*)(lds + PG8_SA(b, h) + aoff + m * 2048 + k * 1024); } while (0)
#define PG8_LDB(dst, b, h) do { _Pragma("unroll") for (int n = 0; n < 2; ++n) _Pragma("unroll") for (int k = 0; k < 2; ++k) dst[n][k] = *(const PG8_LAS bf16x8*)(lds + PG8_SB(b, h) + boff + n * 2048 + k * 1024); } while (0)
#define PG8_MMA(ai, bj, At, Bt) do { __builtin_amdgcn_s_setprio(1); _Pragma("unroll") for (int m = 0; m < 4; ++m) _Pragma("unroll") for (int n = 0; n < 2; ++n) _Pragma("unroll") for (int k = 0; k < 2; ++k) \
        acc[ai][bj][m][n] = __builtin_amdgcn_mfma_f32_16x16x32_bf16(Bt[n][k], At[m][k], acc[ai][bj][m][n], 0, 0, 0); __builtin_amdgcn_s_setprio(0); } while (0)
#define PG8_WAIT_V(n) asm volatile("s_waitcnt vmcnt(" #n ")" ::: "memory")
#define PG8_WAIT_L(n) asm volatile("s_waitcnt lgkmcnt(" #n ")" ::: "memory")
#define PG8_BAR __builtin_amdgcn_s_barrier()
#define PG8_SCHED __builtin_amdgcn_sched_barrier(0)
    Unit cur, nxt; int ui = 0;
    if (!S.next(0, cur)) return;
    f32x4 acc[2][2][4][2];
#pragma unroll
    for (int a = 0; a < 2; ++a)
#pragma unroll
        for (int b = 0; b < 2; ++b)
#pragma unroll
            for (int m = 0; m < 4; ++m)
#pragma unroll
                for (int n = 0; n < 2; ++n) acc[a][b][m][n] = (f32x4){0.f, 0.f, 0.f, 0.f};
    bf16x8 At[4][2], B0[2][2], B1[2][2];
    const char* cA = (const char*)g.A + (size_t)cur.pm * tstep; const char* cB = (const char*)g.Bt + (size_t)cur.pn * tstep;
    S.a_ready(cur);
    if constexpr (SP2) {
        PG8_STAGE(PG8_SB(0, 0), cB, voffB); PG8_STAGE(PG8_SB(0, 1), cB + hstep, voffB); PG8_STAGE(PG8_SA(0, 0), cA, voffA); PG8_STAGE(PG8_SA(0, 1), cA + hstep, voffA);
        if (wr == 1) PG8_BAR;
        PG8_WAIT_V(2); PG8_BAR;
        PG8_STAGE(PG8_SB(1, 0), cB + kstep, voffB); PG8_STAGE(PG8_SA(1, 0), cA + kstep, voffA); PG8_STAGE(PG8_SB(1, 1), cB + hstep + kstep, voffB);
        PG8_WAIT_V(6); PG8_BAR;
    } else {
        PG8_STAGE(PG8_SB(0, 0), cB, voffB); PG8_STAGE(PG8_SA(0, 0), cA, voffA); PG8_STAGE(PG8_SB(0, 1), cB + hstep, voffB); PG8_STAGE(PG8_SA(0, 1), cA + hstep, voffA);
        if (wr == 1) PG8_BAR;
        PG8_WAIT_V(4); PG8_BAR;
        PG8_STAGE(PG8_SB(1, 0), cB + kstep, voffB); PG8_STAGE(PG8_SA(1, 0), cA + kstep, voffA); PG8_STAGE(PG8_SB(1, 1), cB + hstep + kstep, voffB);
        PG8_WAIT_V(6); PG8_BAR;
    }
    for (;;) {
        const bool has_next = S.next(ui + 1, nxt);
        const char* nA = has_next ? (const char*)g.A + (size_t)nxt.pm * tstep : cA; const char* nB = has_next ? (const char*)g.Bt + (size_t)nxt.pn * tstep : cB;
        for (int t = 0; t < nt; t += 2) {
            const bool last = (t == nt - 2);
            const char* a1 = cA + (size_t)(t + 1) * kstep;
            const char* a2 = last ? nA : cA + (size_t)(t + 2) * kstep; const char* b2 = last ? nB : cB + (size_t)(t + 2) * kstep;
            const char* a3 = a2 + kstep; const char* b3 = b2 + kstep;
            if (last && has_next) S.a_ready(nxt);
            if constexpr (SP2) {
            PG8_LDB(B0, 0, 0); PG8_LDB(B1, 0, 1); PG8_SCHED; PG8_LDA(At, 0, 0); PG8_STAGE(PG8_SA(1, 1), a1 + hstep, voffA);
            PG8_WAIT_V(8); PG8_WAIT_L(0); PG8_BAR; PG8_MMA(0, 0, At, B0); PG8_MMA(0, 1, At, B1); PG8_BAR; PG8_SCHED;
            PG8_LDA(At, 0, 1); PG8_STAGE(PG8_SB(0, 0), b2, voffB); PG8_STAGE(PG8_SB(0, 1), b2 + hstep, voffB); PG8_STAGE(PG8_SA(0, 0), a2, voffA);
            PG8_WAIT_V(8); PG8_WAIT_L(0); PG8_BAR; PG8_MMA(1, 0, At, B0); PG8_MMA(1, 1, At, B1); PG8_BAR; PG8_SCHED;
            PG8_LDB(B0, 1, 0); PG8_LDB(B1, 1, 1); PG8_SCHED; PG8_LDA(At, 1, 0); PG8_STAGE(PG8_SA(0, 1), a2 + hstep, voffA);
            PG8_WAIT_V(8); PG8_WAIT_L(0); PG8_BAR; PG8_MMA(0, 0, At, B0); PG8_MMA(0, 1, At, B1); PG8_BAR; PG8_SCHED;
            PG8_LDA(At, 1, 1); PG8_STAGE(PG8_SB(1, 0), b3, voffB); PG8_STAGE(PG8_SB(1, 1), b3 + hstep, voffB); PG8_STAGE(PG8_SA(1, 0), a3, voffA);
            PG8_WAIT_V(8); PG8_WAIT_L(0); PG8_BAR; PG8_MMA(1, 0, At, B0); PG8_MMA(1, 1, At, B1); PG8_BAR; PG8_SCHED;
            } else {
            PG8_LDB(B0, 0, 0); PG8_SCHED; PG8_LDA(At, 0, 0); PG8_STAGE(PG8_SA(1, 1), a1 + hstep, voffA);
            PG8_WAIT_L(8); PG8_BAR; PG8_WAIT_L(0); PG8_MMA(0, 0, At, B0); PG8_BAR; PG8_SCHED;
            PG8_LDB(B1, 0, 1); PG8_STAGE(PG8_SB(0, 0), b2, voffB);
            PG8_BAR; PG8_WAIT_L(0); PG8_MMA(0, 1, At, B1); PG8_BAR;
            PG8_LDA(At, 0, 1); PG8_STAGE(PG8_SA(0, 0), a2, voffA);
            PG8_BAR; PG8_WAIT_L(0); PG8_MMA(1, 0, At, B0); PG8_BAR; PG8_SCHED;
            PG8_STAGE(PG8_SB(0, 1), b2 + hstep, voffB);
            PG8_WAIT_V(6); PG8_BAR; PG8_MMA(1, 1, At, B1); PG8_BAR;
            PG8_LDB(B0, 1, 0); PG8_SCHED; PG8_LDA(At, 1, 0); PG8_STAGE(PG8_SA(0, 1), a2 + hstep, voffA);
            PG8_WAIT_L(8); PG8_BAR; PG8_WAIT_L(0); PG8_MMA(0, 0, At, B0); PG8_BAR; PG8_SCHED;
            PG8_LDB(B1, 1, 1); PG8_STAGE(PG8_SB(1, 0), b3, voffB);
            PG8_BAR; PG8_WAIT_L(0); PG8_MMA(0, 1, At, B1); PG8_BAR;
            PG8_LDA(At, 1, 1); PG8_STAGE(PG8_SA(1, 0), a3, voffA);
            PG8_BAR; PG8_WAIT_L(0); PG8_MMA(1, 0, At, B0); PG8_BAR; PG8_SCHED;
            PG8_STAGE(PG8_SB(1, 1), b3 + hstep, voffB);
            PG8_WAIT_V(6); PG8_BAR; PG8_MMA(1, 1, At, B1); PG8_BAR;
            }
        }
        if constexpr (ALIGN_EPI) { if (wr == 0) PG8_BAR; }
        if constexpr (!Epi::AFTER_DRAIN) { E(acc, cur, wr, wc, fr, fq); S.done(cur); }
        if (!has_next) break;
#pragma unroll
        for (int a = 0; a < 2; ++a)
#pragma unroll
            for (int b = 0; b < 2; ++b)
#pragma unroll
                for (int m = 0; m < 4; ++m)
#pragma unroll
                    for (int n = 0; n < 2; ++n) acc[a][b][m][n] = (f32x4){0.f, 0.f, 0.f, 0.f};
        cur = nxt; cA = nA; cB = nB; ++ui;
        if constexpr (ALIGN_EPI) { if (wr == 1) PG8_BAR; }
    }
    PG8_WAIT_V(0);
    if constexpr (!ALIGN_EPI) { if (wr == 0) PG8_BAR; }
    PG8_BAR;
    if constexpr (Epi::AFTER_DRAIN) { E.fused(acc, cur, wr, wc, fr, fq, lds, wid, lane); S.done(cur); }
#undef PG8_SA
#undef PG8_SB
#undef PG8_STAGE
#undef PG8_LDA
#undef PG8_LDB
#undef PG8_MMA
#undef PG8_WAIT_V
#undef PG8_WAIT_L
#undef PG8_BAR
#undef PG8_SCHED
}
}

#ifndef PG8_SP2
#define PG8_SP2 true
#endif
#ifndef PG8_ALIGN
#define PG8_ALIGN true
#endif
#define GAS __attribute__((address_space(1)))
#define LAS __attribute__((address_space(3)))
typedef unsigned short bf16;
typedef unsigned v4u __attribute__((ext_vector_type(4)));
typedef float f32x4 __attribute__((ext_vector_type(4)));
typedef short bf16x8 __attribute__((ext_vector_type(8)));
typedef GAS unsigned gu32;
typedef GAS unsigned long long gu64;
#define RLX_AGENT __ATOMIC_RELAXED, __HIP_MEMORY_SCOPE_AGENT
#define LDS_WAIT() asm volatile("s_waitcnt lgkmcnt(0)" ::: "memory")
#define VM_WAIT() asm volatile("s_waitcnt vmcnt(0)" ::: "memory")
__device__ __forceinline__ unsigned long long rt() { return __builtin_amdgcn_s_memrealtime(); }
__device__ __forceinline__ unsigned f2bf(float f) { unsigned u = __builtin_bit_cast(unsigned, f); return (u + 0x7fffu + ((u >> 16) & 1u)) >> 16; }
__device__ __forceinline__ unsigned pk2(float lo, float hi) { return f2bf(lo) | (f2bf(hi) << 16); }

#define XB_TMO      128
#define XB_XCNT(j)  (256  + 64 * (j))
#define XB_XSUB(j)  (1280 + 64 * (j))
#define XB_XGEN(j)  (2304 + 64 * (j))
#define XB_TOP      3328
#define XB_TOPGEN   3392
#define XCD_BAR_WORDS 3456
#define XB_SPIN_CAP (1u << 18)

__device__ __forceinline__ unsigned xb_ld(unsigned* p)              { return __hip_atomic_load(p, __ATOMIC_RELAXED, __HIP_MEMORY_SCOPE_AGENT); }
__device__ __forceinline__ unsigned xb_add(unsigned* p, unsigned v) { return __hip_atomic_fetch_add(p, v, __ATOMIC_RELAXED, __HIP_MEMORY_SCOPE_AGENT); }
__device__ __forceinline__ unsigned xb_xcc_id() { return (unsigned)__builtin_amdgcn_s_getreg((3 << 11) | 20) & 0xFu; }
#define XB_SPIN(cond, bar) do { unsigned _sp = 0; while (cond) { __builtin_amdgcn_s_sleep(1); \
    if ((++_sp & 255u) == 0u) { if (xb_ld(&(bar)[XB_TMO])) break; if (_sp > XB_SPIN_CAP) { atomicAdd(&(bar)[XB_TMO], 1u); break; } } } } while (0)

struct XcdBarrier {
    unsigned* bar; unsigned x;
    volatile LAS unsigned* st;
};

__device__ __forceinline__ XcdBarrier xcd_barrier_post(unsigned* bar, volatile LAS unsigned* st) {
    XcdBarrier b; b.bar = bar; b.x = xb_xcc_id(); b.st = st;
    if (threadIdx.x == 0) (void)xb_add(&bar[XB_XCNT(b.x)], 1u);
    return b;
}
__device__ __forceinline__ void xcd_barrier_complete(unsigned* bar, unsigned x, unsigned& nloc, unsigned& nx) {
    const unsigned G = gridDim.x * gridDim.y * gridDim.z;
    unsigned sum, cnt, mine, sp = 0u;
    for (;;) {
        sum = 0u; cnt = 0u; mine = 0u;
#pragma unroll
        for (unsigned j = 0; j < 16; ++j) { const unsigned c = xb_ld(&bar[XB_XCNT(j)]); sum += c; cnt += (c > 0u) ? 1u : 0u; mine = (j == x) ? c : mine; }
        if (sum == G) break;
        __builtin_amdgcn_s_sleep(1);
        if ((++sp & 255u) == 0u) { if (xb_ld(&bar[XB_TMO])) break; if (sp > XB_SPIN_CAP) { atomicAdd(&bar[XB_TMO], 1u); break; } }
    }
    nloc = mine > 0u ? mine : 1u; nx = cnt > 0u ? cnt : 1u;
}

__device__ __forceinline__ void xcd_barrier(const XcdBarrier& b) {
    asm volatile("s_waitcnt vmcnt(0)" ::: "memory");
    __syncthreads();
    if (threadIdx.x == 0) {
        unsigned* bar = b.bar;
        __builtin_amdgcn_s_waitcnt(0);
        unsigned nloc = b.st[0], nx = b.st[1];
        if (nloc == 0u) { xcd_barrier_complete(bar, b.x, nloc, nx); b.st[0] = nloc; b.st[1] = nx; }
        const unsigned old = xb_add(&bar[XB_XSUB(b.x)], 1u);
        const unsigned gen = old / nloc;
        if (old + 1u == (gen + 1u) * nloc) {
            __builtin_amdgcn_fence(__ATOMIC_RELEASE, "agent");
            asm volatile("s_waitcnt vmcnt(0)" ::: "memory");
            const unsigned og = xb_add(&bar[XB_TOP], 1u);
            const unsigned tg = og / nx;
            if (og + 1u == (tg + 1u) * nx) xb_add(&bar[XB_TOPGEN], 1u);
            else XB_SPIN(xb_ld(&bar[XB_TOPGEN]) == tg, bar);
            __builtin_amdgcn_fence(__ATOMIC_ACQUIRE, "agent");
            xb_add(&bar[XB_XGEN(b.x)], 1u);
            asm volatile("s_waitcnt vmcnt(0)" ::: "memory");
        } else {
            XB_SPIN(xb_ld(&bar[XB_XGEN(b.x)]) == gen, bar);
            __builtin_amdgcn_fence(__ATOMIC_ACQUIRE, "agent");
            asm volatile("s_waitcnt vmcnt(0)" ::: "memory");
        }
    }
    __syncthreads();
}
constexpr int NWAVES = 8;
constexpr int B_ = 8, S_ = 2048, T = B_ * S_, D = 1024;
constexpr int INC = 3784;
constexpr int O_Q = 0, O_CKV = 512, O_QI = 640, O_KI = 1152, O_WI = 1216, O_U = 1224, O_G = 1736;
constexpr int NIN = 4352;
constexpr float ALPHA = 1.189207115002721f, LN_EPS = 1e-5f, LOG2E = 1.4426950408889634f;
constexpr int MAXROWS = T * 4 + 32 * 256;
constexpr int TOPK = 256;

constexpr size_t MiB = 1u << 20;
constexpr size_t WS_CTL = 0, CTL_ZERO_BYTES = 1 * MiB;
constexpr size_t WS_MOD = 1 * MiB, WS_WIN = 2 * MiB, WS_WOA = 11 * MiB, WS_WPB = 13 * MiB, WS_WOUT = 14 * MiB, WS_WGU = 16 * MiB, WS_WD = 144 * MiB;
constexpr size_t WS_H = 208 * MiB, WS_QL = 240 * MiB, WS_QI = 272 * MiB, WS_MISC = 288 * MiB, WS_U = 304 * MiB, WS_SG = 320 * MiB;
constexpr size_t WS_CKV = 384 * MiB, WS_CKVT = 388 * MiB, WS_POOLED = 392 * MiB, WS_MASK = 408 * MiB, WS_OLAT = 412 * MiB, WS_TMP = 444 * MiB, WS_MIX = 476 * MiB;
constexpr size_t WS_Z = 508 * MiB, WS_X1 = 572 * MiB, WS_SLOTMAP = 636 * MiB, WS_TOKSLOT = 638 * MiB, WS_GATE = 638 * MiB + 512 * 1024;
constexpr size_t WS_XPAD = 640 * MiB, WS_ACT = 784 * MiB, WS_Y = WS_XPAD, WS_SEL = 928 * MiB, WS_CNT = 944 * MiB, WS_END = 945 * MiB;
constexpr int CW_GCNT = 0, CW_TSTART = 64, CW_BAR = 4096;

constexpr int RING_OFF = 0, RING_BYTES = 131072;
constexpr int LDSCTL_OFF = RING_BYTES, MISC_OFF = LDSCTL_OFF + 320;
constexpr int LDS_BYTES = 147456;

struct Frame {
    LAS unsigned char* lds;
    volatile LAS unsigned* MISCW;
    gu32* ctl;
    int tid, lane, wave, vcu, G;
    unsigned char* ws;
    float* out;
};
__device__ __forceinline__ const float* frame_in(int i) { const char* ka = (const char*)__builtin_amdgcn_kernarg_segment_ptr(); asm volatile("" : "+s"(ka)); return *(const float* const*)(ka + 8 * i); }
__device__ __forceinline__ float bf2f(unsigned short u) { return __uint_as_float((unsigned)u << 16); }
__device__ __forceinline__ float sigm_fast(float x) { return __builtin_amdgcn_rcpf(1.f + __builtin_amdgcn_exp2f(-x * LOG2E)); }

namespace pg8 {
struct EpiInProj {
    static constexpr bool PERM = true, AFTER_DRAIN = false;
    bf16_t *QL, *QI, *U, *SG; float* MISC;
    __device__ __forceinline__ void operator()(const f32x4 (&acc)[2][2][4][2], const Unit& u, int wr, int wc, int fr, int fq) const {
        const int row0 = u.pm * BM + wr * 64 + fr, c0 = wc * 32 + 8 * fq; const int pn = u.pn;
        if (pn == 6) {
#pragma unroll
            for (int ai = 0; ai < 2; ++ai)
#pragma unroll
                for (int m = 0; m < 4; ++m) { float* rowp = MISC + (size_t)(row0 + ai * HALF + m * 16) * 256 + c0;
#pragma unroll
                    for (int bj = 0; bj < 2; ++bj) { *(f32x4*)(rowp + bj * HALF) = acc[ai][bj][m][0]; *(f32x4*)(rowp + bj * HALF + 4) = acc[ai][bj][m][1]; } }
        } else {
            bf16_t* base; int ld, colt; bool sg = false;
            if (pn < 4) { base = QL; ld = 1024; colt = pn * 256; }
            else if (pn < 6) { base = QI; ld = 512; colt = (pn - 4) * 256; }
            else if (pn < 9) { base = U; ld = 512; colt = (pn - 7) * 256; }
            else { base = SG; ld = 2048; colt = (pn - 9) * 256; sg = true; }
#pragma unroll
            for (int ai = 0; ai < 2; ++ai)
#pragma unroll
                for (int m = 0; m < 4; ++m) { bf16_t* rowp = base + (size_t)(row0 + ai * HALF + m * 16) * ld + colt + c0;
#pragma unroll
                    for (int bj = 0; bj < 2; ++bj) { f32x4 v0 = acc[ai][bj][m][0], v1 = acc[ai][bj][m][1];
                        if (sg) {
#pragma unroll
                            for (int i = 0; i < 4; ++i) { v0[i] = sigm_fast(v0[i]); v1[i] = sigm_fast(v1[i]); } }
                        u32x4 w; w.x = cvt_pk_bf16(v0[0], v0[1]); w.y = cvt_pk_bf16(v0[2], v0[3]); w.z = cvt_pk_bf16(v1[0], v1[1]); w.w = cvt_pk_bf16(v1[2], v1[3]);
                        *(u32x4*)(rowp + bj * HALF) = w; } }
        }
    }
};
}

__device__ __forceinline__ void tr_item(const float* W, int ldw, int k0, int n0, int ncols, float scale, bf16* WT, int ldt, int drow0, LAS float* scr, int lane) {
    const int nn = lane & 31;
#pragma unroll 8
    for (int i = 0; i < 32; ++i) { const int kk = 2 * i + (lane >> 5); scr[kk * 33 + nn] = (nn < ncols) ? W[(size_t)(k0 + kk) * ldw + n0 + nn] * scale : 0.f; }
    LDS_WAIT(); asm volatile("" ::: "memory");
    const int c = lane & 7;
#pragma unroll
    for (int j = 0; j < 4; ++j) { const int n = (lane >> 3) + 8 * j; const LAS float* s = scr + (8 * c) * 33 + n;
        v4u o; o.x = pk2(s[0 * 33], s[1 * 33]); o.y = pk2(s[2 * 33], s[3 * 33]); o.z = pk2(s[4 * 33], s[5 * 33]); o.w = pk2(s[6 * 33], s[7 * 33]);
        if (n < ncols) *(GAS v4u*)(WT + (size_t)(drow0 + n) * ldt + k0 + 8 * c) = o; }
    LDS_WAIT(); asm volatile("" ::: "memory");
}
__device__ __forceinline__ void fold_qlat(const float* w_in, const float* w_uk, bf16* Win_t, int task, int lane) {
    const int h = task >> 5, kb = (task >> 1) & 15, rh = task & 1; const int k = kb * 64 + lane;
    const float* wrow = w_in + (size_t)k * INC + O_Q + h * 64;
    for (int r0 = rh * 64; r0 < rh * 64 + 64; r0 += 8) { float a[8] = {0, 0, 0, 0, 0, 0, 0, 0};
#pragma unroll 2
        for (int d = 0; d < 64; ++d) { const float v = wrow[d];
#pragma unroll
            for (int j = 0; j < 8; ++j) a[j] += v * w_uk[(r0 + j) * 512 + h * 64 + d]; }
#pragma unroll
        for (int j = 0; j < 8; ++j) Win_t[(size_t)(h * 128 + r0 + j) * 1024 + k] = (bf16)f2bf(a[j] * (0.125f * LOG2E)); }
}
__device__ __forceinline__ void fold_oa(const float* w_uv, const float* w_ba, bf16* Woa_t, int task, int lane) {
    const int h = task >> 4, nb = task & 15; const int n = nb * 64 + lane;
    for (int r0 = 0; r0 < 128; r0 += 8) { float a[8] = {0, 0, 0, 0, 0, 0, 0, 0};
#pragma unroll 2
        for (int d = 0; d < 64; ++d) { const float v = w_ba[(size_t)(h * 64 + d) * 1024 + n];
#pragma unroll
            for (int j = 0; j < 8; ++j) a[j] += v * w_uv[(r0 + j) * 512 + h * 64 + d]; }
        v4u o; o.x = pk2(a[0], a[1]); o.y = pk2(a[2], a[3]); o.z = pk2(a[4], a[5]); o.w = pk2(a[6], a[7]);
        *(GAS v4u*)(Woa_t + (size_t)n * 1024 + h * 128 + r0) = o; }
}
__device__ __forceinline__ void fold_pb(const float* w_pg, const float* pscale, const float* w_bp, bf16* Wpb_t, int task, int lane) {
    const int g = task >> 6, nb = (task >> 2) & 15, cq = task & 3; const int n = nb * 64 + lane;
    for (int c0 = cq * 32; c0 < cq * 32 + 32; c0 += 8) { float a[8] = {0, 0, 0, 0, 0, 0, 0, 0};
#pragma unroll 2
        for (int d = 0; d < 128; ++d) { const float v = w_bp[(size_t)(g * 128 + d) * 1024 + n] * pscale[g * 128 + d];
#pragma unroll
            for (int j = 0; j < 8; ++j) a[j] += v * w_pg[(size_t)g * 16384 + (c0 + j) * 128 + d]; }
        v4u o; o.x = pk2(a[0], a[1]); o.y = pk2(a[2], a[3]); o.z = pk2(a[4], a[5]); o.w = pk2(a[6], a[7]);
        *(GAS v4u*)(Wpb_t + (size_t)n * 512 + g * 128 + c0) = o; }
}
__device__ __forceinline__ void p0_prologue(Frame& F) {
    const float* c = frame_in(1); const float* w_ada = frame_in(2); const float* b_ada = frame_in(3); const float* w_in = frame_in(4);
    const float* w_uk = frame_in(6); const float* w_uv = frame_in(7); const float* w_pg = frame_in(8); const float* pscale = frame_in(9);
    const float* w_ba = frame_in(10); const float* w_bp = frame_in(11); const float* w_out = frame_in(12); const float* w_gu = frame_in(17); const float* w_d = frame_in(19);
    bf16* Win_t = (bf16*)(F.ws + WS_WIN); bf16* Woa_t = (bf16*)(F.ws + WS_WOA); bf16* Wpb_t = (bf16*)(F.ws + WS_WPB); bf16* Wout_t = (bf16*)(F.ws + WS_WOUT);
    bf16* Wgu_t = (bf16*)(F.ws + WS_WGU); bf16* Wd_t = (bf16*)(F.ws + WS_WD); float* MOD = (float*)(F.ws + WS_MOD);
    for (int cg = blockIdx.x; cg < 96; cg += F.G) {
        LAS float* cs = (LAS float*)(F.lds + 69632); LAS float* red = (LAS float*)(F.lds + 69632 + 32768);
        for (int i = F.tid; i < 8192; i += 512) { const float v = c[i]; cs[i] = v / (1.f + __expf(-v)); }
        __syncthreads();
        float acc[8] = {0, 0, 0, 0, 0, 0, 0, 0}; const int n = cg * 64 + F.lane;
        for (int k = F.wave * 128; k < F.wave * 128 + 128; ++k) { const float w = w_ada[(size_t)k * 6144 + n];
#pragma unroll
            for (int b = 0; b < 8; ++b) acc[b] += cs[b * 1024 + k] * w; }
#pragma unroll
        for (int b = 0; b < 8; ++b) red[(F.wave * 8 + b) * 64 + F.lane] = acc[b];
        __syncthreads();
        { const int b = F.tid >> 6, l = F.tid & 63; float s = 0.f;
#pragma unroll
          for (int w = 0; w < 8; ++w) s += red[(w * 8 + b) * 64 + l];
          MOD[b * 6144 + cg * 64 + l] = s + b_ada[cg * 64 + l]; }
        __syncthreads();
    }
    LAS float* scr = (LAS float*)(F.lds + F.wave * 8448);
    const int gw = F.vcu * NWAVES + F.wave, NGW = F.G * NWAVES;
    constexpr int I_FQ = 256, I_FO = 128, I_FP = 256, I_Z = 56;
    constexpr int I_QI = 256, I_CKV = 64, I_KI = 32, I_WI = 16, I_U = 256, I_G = 1024, I_OUT = 512, I_GU = 32 * 1024, I_D = 32 * 512;
    constexpr int NITEMS = I_FQ + I_FO + I_FP + I_Z + I_QI + I_CKV + I_KI + I_WI + I_U + I_G + I_OUT + I_GU + I_D;
    for (int it = gw; it < NITEMS; it += NGW) {
        int r = it;
        if (r < I_FQ) { fold_qlat(w_in, w_uk, Win_t, r, F.lane); continue; } r -= I_FQ;
        if (r < I_FO) { fold_oa(w_uv, w_ba, Woa_t, r, F.lane); continue; } r -= I_FO;
        if (r < I_FP) { fold_pb(w_pg, pscale, w_bp, Wpb_t, r, F.lane); continue; } r -= I_FP;
        if (r < I_Z) { GAS v4u* z = (GAS v4u*)(Win_t + (size_t)(1736 + r) * 1024); z[F.lane] = (v4u){0u, 0u, 0u, 0u}; z[F.lane + 64] = (v4u){0u, 0u, 0u, 0u}; continue; } r -= I_Z;
        if (r < I_QI) { tr_item(w_in, INC, (r >> 4) * 64, O_QI + (r & 15) * 32, 32, 0.125f, Win_t, 1024, 1024 + (r & 15) * 32, scr, F.lane); continue; } r -= I_QI;
        if (r < I_CKV) { tr_item(w_in, INC, (r >> 2) * 64, O_CKV + (r & 3) * 32, 32, 1.f, Win_t, 1024, 1536 + (r & 3) * 32, scr, F.lane); continue; } r -= I_CKV;
        if (r < I_KI) { tr_item(w_in, INC, (r >> 1) * 64, O_KI + (r & 1) * 32, 32, 1.f, Win_t, 1024, 1664 + (r & 1) * 32, scr, F.lane); continue; } r -= I_KI;
        if (r < I_WI) { tr_item(w_in, INC, r * 64, O_WI, 8, 0.35355339059327373f, Win_t, 1024, 1728, scr, F.lane); continue; } r -= I_WI;
        if (r < I_U) { tr_item(w_in, INC, (r >> 4) * 64, O_U + (r & 15) * 32, 32, 1.f, Win_t, 1024, 1792 + (r & 15) * 32, scr, F.lane); continue; } r -= I_U;
        if (r < I_G) { tr_item(w_in, INC, (r >> 6) * 64, O_G + (r & 63) * 32, 32, 1.f, Win_t, 1024, 2304 + (r & 63) * 32, scr, F.lane); continue; } r -= I_G;
        if (r < I_OUT) { tr_item(w_out, 1024, (r >> 5) * 64, (r & 31) * 32, 32, 1.f, Wout_t, 1024, (r & 31) * 32, scr, F.lane); continue; } r -= I_OUT;
        if (r < I_GU) { const int e = r >> 10, q = r & 1023, kb = q >> 6, ng = q & 63; const int n0 = ng * 32;
            const int drow = (n0 < 1024) ? ((n0 >> 7) * 256 + (n0 & 127)) : (((n0 - 1024) >> 7) * 256 + 128 + ((n0 - 1024) & 127));
            tr_item(w_gu + (size_t)e * 1024 * 2048, 2048, kb * 64, n0, 32, 1.f, Wgu_t + (size_t)e * 2048 * 1024, 1024, drow, scr, F.lane); continue; } r -= I_GU;
        { const int e = r >> 9, q = r & 511, kb = q >> 5, ng = q & 31;
          tr_item(w_d + (size_t)e * 1024 * 1024, 1024, kb * 64, ng * 32, 32, 1.f, Wd_t + (size_t)e * 1024 * 1024, 1024, ng * 32, scr, F.lane); }
    }
}
__device__ __forceinline__ void p1_modulate(Frame& F) {
    const float* x = frame_in(0); const float* MOD = (const float*)(F.ws + WS_MOD); bf16* H = (bf16*)(F.ws + WS_H);
    const int gw = F.vcu * NWAVES + F.wave, NGW = F.G * NWAVES;
    for (int m = gw; m < T; m += NGW) { const int b = m >> 11;
        const GAS f32x4* xr = (const GAS f32x4*)(x + (size_t)m * D) + F.lane; GAS unsigned long long* o8 = (GAS unsigned long long*)(H + (size_t)m * D) + F.lane;
#pragma unroll
        for (int j = 0; j < 4; ++j) { const f32x4 v = xr[64 * j]; const int col = 4 * F.lane + 256 * j;
            const f32x4 sh = *(const f32x4*)(MOD + b * 6144 + col), sc = *(const f32x4*)(MOD + b * 6144 + 1024 + col);
            const f32x4 h = v * (sc + 1.0f) + sh;
            o8[64 * j] = (unsigned long long)pk2(h.x, h.y) | ((unsigned long long)pk2(h.z, h.w) << 32); }
    }
}
constexpr int LC_LCNT = LDSCTL_OFF + 1024, LC_BASE = LDSCTL_OFF + 1280, LC_TSTART = LDSCTL_OFF + 1536, LC_LIST = LDSCTL_OFF + 4096;
namespace pg8 {
__device__ __forceinline__ float bfl(unsigned w) { return __uint_as_float(w << 16); }
__device__ __forceinline__ float bfh(unsigned w) { return __uint_as_float(w & 0xffff0000u); }
struct EpiGateMul {
    static constexpr bool PERM = true, AFTER_DRAIN = false;
    bf16_t* O; const bf16_t* SG; int goff, pad;
    __device__ __forceinline__ void operator()(const f32x4 (&acc)[2][2][4][2], const Unit& u, int wr, int wc, int fr, int fq) const {
        const int row0 = u.pm * BM + wr * 64 + fr, col0 = u.pn * BM + wc * 32 + 8 * fq;
#pragma unroll
        for (int ai = 0; ai < 2; ++ai)
#pragma unroll
            for (int m = 0; m < 4; ++m) { const size_t row = (size_t)(row0 + ai * HALF + m * 16);
#pragma unroll
                for (int bj = 0; bj < 2; ++bj) { const u32x4 g = *(const u32x4*)(SG + row * 2048 + goff + col0 + bj * HALF); const f32x4 v0 = acc[ai][bj][m][0], v1 = acc[ai][bj][m][1];
                    u32x4 w; w.x = cvt_pk_bf16(v0[0] * bfl(g.x), v0[1] * bfh(g.x)); w.y = cvt_pk_bf16(v0[2] * bfl(g.y), v0[3] * bfh(g.y));
                    w.z = cvt_pk_bf16(v1[0] * bfl(g.z), v1[1] * bfh(g.z)); w.w = cvt_pk_bf16(v1[2] * bfl(g.w), v1[3] * bfh(g.w));
                    *(u32x4*)(O + row * 1024 + col0 + bj * HALF) = w; } }
    }
};
struct EpiGateAdd {
    static constexpr bool PERM = true, AFTER_DRAIN = false;
    bf16_t* O; const bf16_t* TMPB; const bf16_t* SG; int goff, pad;
    __device__ __forceinline__ void operator()(const f32x4 (&acc)[2][2][4][2], const Unit& u, int wr, int wc, int fr, int fq) const {
        const int row0 = u.pm * BM + wr * 64 + fr, col0 = u.pn * BM + wc * 32 + 8 * fq;
#pragma unroll
        for (int ai = 0; ai < 2; ++ai)
#pragma unroll
            for (int m = 0; m < 4; ++m) { const size_t row = (size_t)(row0 + ai * HALF + m * 16);
#pragma unroll
                for (int bj = 0; bj < 2; ++bj) { const u32x4 g = *(const u32x4*)(SG + row * 2048 + goff + col0 + bj * HALF); const u32x4 t = *(const u32x4*)(TMPB + row * 1024 + col0 + bj * HALF);
                    const f32x4 v0 = acc[ai][bj][m][0], v1 = acc[ai][bj][m][1];
                    u32x4 w; w.x = cvt_pk_bf16(bfl(t.x) + v0[0] * bfl(g.x), bfh(t.x) + v0[1] * bfh(g.x)); w.y = cvt_pk_bf16(bfl(t.y) + v0[2] * bfl(g.y), bfh(t.y) + v0[3] * bfh(g.y));
                    w.z = cvt_pk_bf16(bfl(t.z) + v1[0] * bfl(g.z), bfh(t.z) + v1[1] * bfh(g.z)); w.w = cvt_pk_bf16(bfl(t.w) + v1[2] * bfl(g.w), bfh(t.w) + v1[3] * bfh(g.w));
                    *(u32x4*)(O + row * 1024 + col0 + bj * HALF) = w; } }
    }
};
struct EpiResid {
    static constexpr bool PERM = false, AFTER_DRAIN = false;
    float* Z; const float* x; const float* gate;
    __device__ __forceinline__ void operator()(const f32x4 (&acc)[2][2][4][2], const Unit& u, int wr, int wc, int fr, int fq) const {
        const int row0 = u.pm * BM + wr * 64 + fr, col0 = u.pn * BM + wc * 32 + 4 * fq; const int b = (u.pm * BM) >> 11;
        f32x4 gv[2][2];
#pragma unroll
        for (int bj = 0; bj < 2; ++bj)
#pragma unroll
            for (int n = 0; n < 2; ++n) gv[bj][n] = *(const f32x4*)(gate + b * 6144 + col0 + bj * HALF + n * 16);
#pragma unroll
        for (int ai = 0; ai < 2; ++ai)
#pragma unroll
            for (int m = 0; m < 4; ++m) { const size_t off = (size_t)(row0 + ai * HALF + m * 16) * 1024 + col0;
#pragma unroll
                for (int bj = 0; bj < 2; ++bj)
#pragma unroll
                    for (int n = 0; n < 2; ++n) { const f32x4 xv = *(const f32x4*)(x + off + bj * HALF + n * 16); *(f32x4*)(Z + off + bj * HALF + n * 16) = xv * ALPHA + gv[bj][n] * acc[ai][bj][m][n]; } }
    }
};
struct EpiSwiglu {
    static constexpr bool PERM = true, AFTER_DRAIN = false;
    bf16_t* ACT; const float* bgu;
    __device__ __forceinline__ void operator()(const f32x4 (&acc)[2][2][4][2], const Unit& u, int wr, int wc, int fr, int fq) const {
        const int e = u.pn >> 3, j = u.pn & 7; const int row0 = u.pm * BM + wr * 64 + fr, cc = wc * 32 + 8 * fq;
        const float* bg = bgu + e * 2048 + j * 128 + cc; f32x4 bgl[2], bli[2];
#pragma unroll
        for (int n = 0; n < 2; ++n) { bgl[n] = *(const f32x4*)(bg + 4 * n); bli[n] = *(const f32x4*)(bg + 1024 + 4 * n); }
#pragma unroll
        for (int ai = 0; ai < 2; ++ai)
#pragma unroll
            for (int m = 0; m < 4; ++m) { float o[8];
#pragma unroll
                for (int n = 0; n < 2; ++n) { const f32x4 gl4 = acc[ai][0][m][n] + bgl[n], li4 = acc[ai][1][m][n] + bli[n];
#pragma unroll
                    for (int i = 0; i < 4; ++i) { const float gl = fminf(gl4[i], 7.f), li = fminf(fmaxf(li4[i], -7.f), 7.f);
                        o[4 * n + i] = gl * __builtin_amdgcn_rcpf(1.f + __builtin_amdgcn_exp2f(gl * (-1.702f * LOG2E))) * (li + 1.f); } }
                u32x4 w; w.x = cvt_pk_bf16(o[0], o[1]); w.y = cvt_pk_bf16(o[2], o[3]); w.z = cvt_pk_bf16(o[4], o[5]); w.w = cvt_pk_bf16(o[6], o[7]);
                *(u32x4*)(ACT + (size_t)(row0 + ai * HALF + m * 16) * 1024 + j * 128 + cc) = w; }
    }
};
struct EpiDown {
    static constexpr bool PERM = true, AFTER_DRAIN = false;
    bf16_t* Y; const float* bd;
    __device__ __forceinline__ void operator()(const f32x4 (&acc)[2][2][4][2], const Unit& u, int wr, int wc, int fr, int fq) const {
        const int e = u.pn >> 2, j = u.pn & 3; const int row0 = u.pm * BM + wr * 64 + fr, col0 = j * 256 + wc * 32 + 8 * fq;
        f32x4 bv[2][2];
#pragma unroll
        for (int bj = 0; bj < 2; ++bj)
#pragma unroll
            for (int n = 0; n < 2; ++n) bv[bj][n] = *(const f32x4*)(bd + e * 1024 + col0 + bj * HALF + 4 * n);
#pragma unroll
        for (int ai = 0; ai < 2; ++ai)
#pragma unroll
            for (int m = 0; m < 4; ++m) { bf16_t* rowp = Y + (size_t)(row0 + ai * HALF + m * 16) * 1024 + col0;
#pragma unroll
                for (int bj = 0; bj < 2; ++bj) { const f32x4 v0 = acc[ai][bj][m][0] + bv[bj][0], v1 = acc[ai][bj][m][1] + bv[bj][1];
                    u32x4 w; w.x = cvt_pk_bf16(v0[0], v0[1]); w.y = cvt_pk_bf16(v0[2], v0[3]); w.z = cvt_pk_bf16(v1[0], v1[1]); w.w = cvt_pk_bf16(v1[2], v1[3]);
                    *(u32x4*)(rowp + bj * HALF) = w; } }
    }
};
struct MoeOrder {
    const PG8_LAS int* tstart; int NT, G, c;
    __device__ __forceinline__ bool next(int i, Unit& u) const {
        const int L = i * G + c; if (L >= tstart[32] * NT) return false;
        int e = 0; while (e < 31 && tstart[e + 1] * NT <= L) ++e;
        const int loc = L - tstart[e] * NT, nte = tstart[e + 1] - tstart[e];
        u.pm = tstart[e] + loc % nte; u.pn = e * NT + loc / nte; return true;
    }
    __device__ __forceinline__ void a_ready(const Unit&) const {}
    __device__ __forceinline__ void done(const Unit&) const {}
};
}

__device__ __forceinline__ float wave_sum(float v) {
#pragma unroll
    for (int o = 1; o < 64; o <<= 1) v += __shfl_xor(v, o);
    return v;
}
__device__ __forceinline__ void p3_post(Frame& F) {
    const float* MISC = (const float*)(F.ws + WS_MISC); const float* kvg = frame_in(5); bf16* CKV = (bf16*)(F.ws + WS_CKV); bf16* CKVT = (bf16*)(F.ws + WS_CKVT);
    const bf16* U = (const bf16*)(F.ws + WS_U); bf16* POOLED = (bf16*)(F.ws + WS_POOLED);
    LAS bf16* tile = (LAS bf16*)(F.lds);
    for (int task = blockIdx.x; task < 256; task += F.G) {
        const int t0 = task * 64; const int row = F.tid >> 3, seg = F.tid & 7;
        const float* src = MISC + (size_t)(t0 + row) * 256 + seg * 16; f32x4 v[4]; float ss = 0.f;
#pragma unroll
        for (int i = 0; i < 4; ++i) { v[i] = *(const f32x4*)(src + 4 * i); ss += (v[i].x * v[i].x + v[i].y * v[i].y) + (v[i].z * v[i].z + v[i].w * v[i].w); }
        ss += __shfl_xor(ss, 1); ss += __shfl_xor(ss, 2); ss += __shfl_xor(ss, 4);
        const float rs = 1.0f / sqrtf(ss * (1.f / 128.f) + LN_EPS);
        unsigned w[8];
#pragma unroll
        for (int i = 0; i < 4; ++i) { const f32x4 g = *(const f32x4*)(kvg + seg * 16 + 4 * i); w[2 * i] = pk2(v[i].x * rs * g.x, v[i].y * rs * g.y); w[2 * i + 1] = pk2(v[i].z * rs * g.z, v[i].w * rs * g.w); }
        GAS v4u* dst = (GAS v4u*)(CKV + (size_t)(t0 + row) * 128 + seg * 16); dst[0] = (v4u){w[0], w[1], w[2], w[3]}; dst[1] = (v4u){w[4], w[5], w[6], w[7]};
        LAS v4u* lt = (LAS v4u*)(tile + row * 128 + seg * 16); lt[0] = (v4u){w[0], w[1], w[2], w[3]}; lt[1] = (v4u){w[4], w[5], w[6], w[7]};
        __syncthreads();
        { const int d = F.tid >> 2, part = F.tid & 3; unsigned o[8];
#pragma unroll
          for (int q = 0; q < 16; q += 2) { unsigned pr[2];
#pragma unroll
              for (int z = 0; z < 2; ++z) { const int p = part * 16 + q + z; const int j = p & 7, h = (p >> 3) & 1, tt = (p >> 4) & 1, kb = p >> 5; const int key = kb * 32 + 16 * tt + 8 * (j >> 2) + 4 * h + (j & 3); pr[z] = tile[key * 128 + d]; }
              o[q >> 1] = pr[0] | (pr[1] << 16); }
          const int b = task >> 5, kt = task & 31;
          GAS v4u* dt = (GAS v4u*)(CKVT + ((size_t)(b * 128 + d) * 2048) + kt * 64 + part * 16); dt[0] = (v4u){o[0], o[1], o[2], o[3]}; dt[1] = (v4u){o[4], o[5], o[6], o[7]}; }
        __syncthreads();
    }
    for (int task = blockIdx.x; task < 256; task += F.G) {
        const int c = F.tid, g = c >> 7, w = 2 << g; const int t0 = task * 64, s0 = t0 & 2047; const bf16* up = U + (size_t)(t0 - s0) * 512 + c;
        float win = 0.f; { const int lo = (s0 - w) < 0 ? 0 : (s0 - w); for (int sp = lo; sp < s0; ++sp) win += bf2f(up[(size_t)sp * 512]); }
        for (int s = s0; s < s0 + 64; ++s) { const float cur = bf2f(up[(size_t)s * 512]); win += cur; if (s - w >= 0) win -= bf2f(up[(size_t)(s - w) * 512]);
            const int cntw = (s + 1 < w) ? (s + 1) : w; POOLED[(size_t)(t0 - s0 + s) * 512 + c] = (bf16)f2bf(win / (float)cntw - cur); }
    }
}
__device__ __forceinline__ void p7_ln1_route(Frame& F) {
    const float* Z = (const float*)(F.ws + WS_Z); const float* g1 = frame_in(13); const float* b1 = frame_in(14); const float* w_r = frame_in(15); const float* b_r = frame_in(16);
    const float* MOD = (const float*)(F.ws + WS_MOD); float* X1 = (float*)(F.ws + WS_X1); bf16* H2 = (bf16*)(F.ws + WS_H);
    int* gcnt = (int*)(F.ctl + CW_GCNT); int* SLOTMAP = (int*)(F.ws + WS_SLOTMAP); int* TOKSLOT = (int*)(F.ws + WS_TOKSLOT); float* GATE = (float*)(F.ws + WS_GATE);
    LAS float* WrL = (LAS float*)(F.lds);
    LAS int* lcnt = (LAS int*)(F.lds + LC_LCNT); LAS int* lbase = (LAS int*)(F.lds + LC_BASE); LAS int* list = (LAS int*)(F.lds + LC_LIST);
    for (int s = F.tid; s < 32768; s += 512) { const int col = s >> 5, e = s & 31; const int j = col >> 8, l = (col & 255) >> 2, i = col & 3; WrL[((((j * 4 + i) * 8 + (e >> 2)) * 64 + l) << 2) + (e & 3)] = w_r[s]; }
    if (F.tid < 32) lcnt[F.tid] = 0;
    __syncthreads();
    const int gw = F.vcu * NWAVES + F.wave, NGW = F.G * NWAVES;
    int it = 0;
    for (int m = gw; m < T; m += NGW, ++it) { const int b = m >> 11;
        const GAS f32x4* zr = (const GAS f32x4*)(Z + (size_t)m * D) + F.lane; f32x4 v[4]; float s = 0.f;
#pragma unroll
        for (int j = 0; j < 4; ++j) { v[j] = zr[64 * j]; s += (v[j].x + v[j].y) + (v[j].z + v[j].w); }
        const float mean = wave_sum(s) * (1.f / D); float s2 = 0.f;
#pragma unroll
        for (int j = 0; j < 4; ++j) { v[j] = v[j] - mean; s2 += (v[j].x * v[j].x + v[j].y * v[j].y) + (v[j].z * v[j].z + v[j].w * v[j].w); }
        const float rstd = 1.f / sqrtf(wave_sum(s2) * (1.f / D) + LN_EPS);
        float acc[32];
#pragma unroll
        for (int e = 0; e < 32; ++e) acc[e] = 0.f;
#pragma unroll
        for (int j = 0; j < 4; ++j) { const int col = 4 * F.lane + 256 * j;
            const f32x4 gg = *(const f32x4*)(g1 + col), bb = *(const f32x4*)(b1 + col); const f32x4 x1 = v[j] * rstd * gg + bb;
            *((GAS f32x4*)(X1 + (size_t)m * D) + F.lane + 64 * j) = x1;
            const f32x4 sh = *(const f32x4*)(MOD + b * 6144 + 3 * 1024 + col), sc = *(const f32x4*)(MOD + b * 6144 + 4 * 1024 + col); const f32x4 h2 = x1 * (sc + 1.0f) + sh;
            *((GAS unsigned long long*)(H2 + (size_t)m * D) + F.lane + 64 * j) = (unsigned long long)pk2(h2.x, h2.y) | ((unsigned long long)pk2(h2.z, h2.w) << 32);
#pragma unroll
            for (int i = 0; i < 4; ++i) { const float hv = h2[i];
#pragma unroll
                for (int e4 = 0; e4 < 8; ++e4) { const f32x4 w4 = *(const LAS f32x4*)(WrL + ((((j * 4 + i) * 8 + e4) * 64 + F.lane) << 2));
                    acc[4 * e4] += hv * w4.x; acc[4 * e4 + 1] += hv * w4.y; acc[4 * e4 + 2] += hv * w4.z; acc[4 * e4 + 3] += hv * w4.w; } } }
#pragma unroll
        for (int e = 0; e < 32; ++e) acc[e] = wave_sum(acc[e]) + b_r[e];
        int se[4]; float sv[4]; unsigned used = 0u;
#pragma unroll
        for (int k = 0; k < 4; ++k) { int best = 0; float bv = -INFINITY; bool have = false;
#pragma unroll
            for (int e = 0; e < 32; ++e) { const bool ok = !((used >> e) & 1u) && (!have || acc[e] > bv); if (ok) { best = e; bv = acc[e]; have = true; } }
            se[k] = best; sv[k] = bv; used |= 1u << best; }
        float ex[4], den = 0.f;
#pragma unroll
        for (int k = 0; k < 4; ++k) { ex[k] = __expf(sv[k] - sv[0]); den += ex[k]; }
        const float inv = 1.f / den;
        if (F.lane < 4) { int e = se[0]; float gt = ex[0];
            if (F.lane == 1) { e = se[1]; gt = ex[1]; } else if (F.lane == 2) { e = se[2]; gt = ex[2]; } else if (F.lane == 3) { e = se[3]; gt = ex[3]; }
            const int lr = __hip_atomic_fetch_add(&lcnt[e], 1, __ATOMIC_RELAXED, __HIP_MEMORY_SCOPE_WORKGROUP);
            LAS int* ent = list + ((F.wave * 8 + it) * 4 + F.lane) * 4; ent[0] = m; ent[1] = e; ent[2] = lr; ent[3] = __float_as_int(gt * inv); }
    }
    __syncthreads();
    if (F.tid < 32) lbase[F.tid] = atomicAdd(&gcnt[F.tid], lcnt[F.tid]);
    __syncthreads();
    { const int nent = it * 4;
      if (F.lane < nent) { LAS int* ent = list + ((F.wave * 8) * 4 + F.lane) * 4; const int m = ent[0], e = ent[1], rank = lbase[e] + ent[2];
          SLOTMAP[e * T + rank] = m; TOKSLOT[m * 4 + (F.lane & 3)] = e | (rank << 8); GATE[m * 4 + (F.lane & 3)] = __int_as_float(ent[3]); } }
}
__device__ __forceinline__ void load_tstart(Frame& F) {
    LAS int* ts = (LAS int*)(F.lds + LC_TSTART); const int* gcnt = (const int*)(F.ctl + CW_GCNT);
    if (F.tid == 0) { int a = 0; for (int e = 0; e < 32; ++e) { ts[e] = a; a += (__hip_atomic_load(gcnt + e, __ATOMIC_RELAXED, __HIP_MEMORY_SCOPE_AGENT) + 255) >> 8; } ts[32] = a; }
    __syncthreads();
}
__device__ __forceinline__ void p8_gather(Frame& F) {
    load_tstart(F);
    const LAS int* ts = (const LAS int*)(F.lds + LC_TSTART); const int* gcnt = (const int*)(F.ctl + CW_GCNT); const int* SLOTMAP = (const int*)(F.ws + WS_SLOTMAP);
    const bf16* H2 = (const bf16*)(F.ws + WS_H); bf16* XPAD = (bf16*)(F.ws + WS_XPAD);
    const int gw = F.vcu * NWAVES + F.wave, NGW = F.G * NWAVES; const int nrows = ts[32] * 256;
    for (int R = gw; R < nrows; R += NGW) { const int tile = R >> 8; int e = 0; while (e < 31 && ts[e + 1] <= tile) ++e;
        const int rank = R - ts[e] * 256; v4u a = (v4u){0u, 0u, 0u, 0u}, b2 = a;
        if (rank < gcnt[e]) { const int tok = SLOTMAP[e * T + rank]; const GAS v4u* src = (const GAS v4u*)(H2 + (size_t)tok * D); a = src[F.lane]; b2 = src[F.lane + 64]; }
        GAS v4u* dst = (GAS v4u*)(XPAD + (size_t)R * D); dst[F.lane] = a; dst[F.lane + 64] = b2; }
}
__device__ __forceinline__ void p11_final(Frame& F) {
    load_tstart(F);
    const LAS int* ts = (const LAS int*)(F.lds + LC_TSTART);
    const float* X1 = (const float*)(F.ws + WS_X1); const bf16* Y = (const bf16*)(F.ws + WS_Y); const int* TOKSLOT = (const int*)(F.ws + WS_TOKSLOT); const float* GATE = (const float*)(F.ws + WS_GATE);
    const float* MOD = (const float*)(F.ws + WS_MOD); const float* g2 = frame_in(21); const float* b2 = frame_in(22);
    const int gw = F.vcu * NWAVES + F.wave, NGW = F.G * NWAVES;
    for (int m = gw; m < T; m += NGW) { const int b = m >> 11;
        f32x4 mo[4];
#pragma unroll
        for (int j = 0; j < 4; ++j) mo[j] = (f32x4){0.f, 0.f, 0.f, 0.f};
#pragma unroll
        for (int k = 0; k < 4; ++k) { const int tsl = TOKSLOT[m * 4 + k]; const int e = tsl & 255, rank = tsl >> 8; const float gt = GATE[m * 4 + k];
            const GAS unsigned long long* yr = (const GAS unsigned long long*)(Y + ((size_t)ts[e] * 256 + rank) * D) + F.lane;
#pragma unroll
            for (int j = 0; j < 4; ++j) { const unsigned long long w = yr[64 * j]; const unsigned lo = (unsigned)w, hi = (unsigned)(w >> 32);
                mo[j].x += gt * pg8::bfl(lo); mo[j].y += gt * pg8::bfh(lo); mo[j].z += gt * pg8::bfl(hi); mo[j].w += gt * pg8::bfh(hi); } }
        f32x4 v[4]; float s = 0.f;
#pragma unroll
        for (int j = 0; j < 4; ++j) { const int col = 4 * F.lane + 256 * j; const f32x4 x1 = *((const GAS f32x4*)(X1 + (size_t)m * D) + F.lane + 64 * j);
            const f32x4 g2m = *(const f32x4*)(MOD + b * 6144 + 5 * 1024 + col); v[j] = x1 * ALPHA + g2m * mo[j]; s += (v[j].x + v[j].y) + (v[j].z + v[j].w); }
        const float mean = wave_sum(s) * (1.f / D); float s2 = 0.f;
#pragma unroll
        for (int j = 0; j < 4; ++j) { v[j] = v[j] - mean; s2 += (v[j].x * v[j].x + v[j].y * v[j].y) + (v[j].z * v[j].z + v[j].w * v[j].w); }
        const float rstd = 1.f / sqrtf(wave_sum(s2) * (1.f / D) + LN_EPS);
#pragma unroll
        for (int j = 0; j < 4; ++j) { const int col = 4 * F.lane + 256 * j; const f32x4 gg = *(const f32x4*)(g2 + col), bb = *(const f32x4*)(b2 + col);
            *((GAS f32x4*)(F.out + (size_t)m * D) + F.lane + 64 * j) = v[j] * rstd * gg + bb; }
    }
}
typedef float f32x16 __attribute__((ext_vector_type(16)));
typedef __bf16 bf2v __attribute__((ext_vector_type(2)));
typedef float f2v __attribute__((ext_vector_type(2)));
__device__ __forceinline__ unsigned pkbf(float a, float b) { f2v v = {a, b}; bf2v r = __builtin_convertvector(v, bf2v); return __builtin_bit_cast(unsigned, r); }
__device__ __forceinline__ bf16x8 pack8(float a0, float a1, float a2, float a3, float a4, float a5, float a6, float a7) {
    v4u p; p.x = pkbf(a0, a1); p.y = pkbf(a2, a3); p.z = pkbf(a4, a5); p.w = pkbf(a6, a7); return __builtin_bit_cast(bf16x8, p); }
#define MFMA32(a, b, c) __builtin_amdgcn_mfma_f32_32x32x16_bf16((a), (b), (c), 0, 0, 0)
__device__ __forceinline__ int krow16(int r, int hh) { return (r & 3) + 8 * (r >> 2) + 4 * hh; }
__device__ __forceinline__ unsigned ordkey(float f) { const unsigned u = __float_as_uint(f); return (u & 0x80000000u) ? ~u : (u | 0x80000000u); }

constexpr int SEL_QI = 0, SEL_HIST = 32768, SEL_CAND = 98304, SEL_MASK = 114688, SEL_META = 122880, SEL_CAP = 128;
__device__ __forceinline__ f32x16 idx_scores(const float* MISCb, int kt, const LAS unsigned char* qiL, const float (&wi)[8], int lane) {
    const int hh = lane >> 5, q = lane & 31; const float* kp = MISCb + (size_t)(kt * 32 + q) * 256 + 128 + 8 * hh;
    bf16x8 A[4];
#pragma unroll
    for (int s = 0; s < 4; ++s) { const f32x4 a = *(const f32x4*)(kp + 16 * s), b = *(const f32x4*)(kp + 16 * s + 4); A[s] = pack8(a.x, a.y, a.z, a.w, b.x, b.y, b.z, b.w); }
    f32x16 sc;
#pragma unroll
    for (int r = 0; r < 16; ++r) sc[r] = 0.f;
#pragma unroll
    for (int h = 0; h < 8; ++h) { f32x16 acc;
#pragma unroll
        for (int r = 0; r < 16; ++r) acc[r] = 0.f;
#pragma unroll
        for (int s = 0; s < 4; ++s) { const int c16 = h * 8 + 2 * s + hh; const bf16x8 Bq = *(const LAS bf16x8*)(qiL + q * 1024 + ((c16 ^ (q & 15)) << 4)); acc = MFMA32(A[s], Bq, acc); }
#pragma unroll
        for (int r = 0; r < 16; ++r) sc[r] = fmaf(wi[h], fmaxf(acc[r], 0.f), sc[r]);
        asm volatile("" ::: "memory"); }
    return sc;
}
template <int MODE>
__device__ __forceinline__ void sel_pass(Frame& F, int lane, int wave, const float* MISCb, int qb, const float (&wi)[8], unsigned trial) {
    const LAS unsigned char* qiL = F.lds + SEL_QI; LAS unsigned* hist = (LAS unsigned*)(F.lds + SEL_HIST); LAS unsigned* cand = (LAS unsigned*)(F.lds + SEL_CAND);
    LAS unsigned* maskL = (LAS unsigned*)(F.lds + SEL_MASK); LAS int* meta = (LAS int*)(F.lds + SEL_META);
    const int hh = lane >> 5, q = lane & 31, qpos = qb * 32 + q; const int bst = meta[q]; const unsigned pfx = (unsigned)meta[128 + q];
    unsigned cntl = 0u;
#pragma unroll 1
    for (int kt = wave; kt <= qb; kt += NWAVES) {
        int lane_t = lane; asm volatile("" : "+v"(lane_t));
        const f32x16 sc = idx_scores(MISCb, kt, qiL, wi, lane_t);
        unsigned word = 0u;
#pragma unroll
        for (int r = 0; r < 16; ++r) { const int kr = krow16(r, hh), key = kt * 32 + kr; const bool valid = key <= qpos;
            const unsigned bits = __float_as_uint(sc[r]) & 0xFFFFF800u; const float st = __uint_as_float(bits);
            int bin = (int)(st * 64.f) + 256; bin = bin < 0 ? 0 : (bin > 511 ? 511 : bin);
            const unsigned ck = (ordkey(st) & 0xFFFFF800u) | (unsigned)(2047 - key);
            if (MODE == 0) { __hip_atomic_fetch_add(hist + q * 512 + bin, valid ? 1u : 0u, __ATOMIC_RELAXED, __HIP_MEMORY_SCOPE_WORKGROUP); }
            if (MODE == 1) { if (valid && bin > bst) word |= 1u << kr;
                if (valid && bin == bst) { const int slot = __hip_atomic_fetch_add((LAS int*)meta + 64 + q, 1, __ATOMIC_RELAXED, __HIP_MEMORY_SCOPE_WORKGROUP); if (slot < SEL_CAP) cand[q * SEL_CAP + slot] = ck; } }
            if (MODE == 2) { cntl += (valid && ck >= (pfx | trial)) ? 1u : 0u; }
            if (MODE == 3) { if (valid && ck >= pfx) word |= 1u << kr; } }
        if (MODE == 1 || MODE == 3) __hip_atomic_fetch_or(maskL + q * 64 + kt, word, __ATOMIC_RELAXED, __HIP_MEMORY_SCOPE_WORKGROUP);
    }
    if (MODE == 2) __hip_atomic_fetch_add((LAS unsigned*)meta + 160 + q, cntl, __ATOMIC_RELAXED, __HIP_MEMORY_SCOPE_WORKGROUP);
}
__device__ __forceinline__ void p3_select(Frame& F) {
    const bf16* QI = (const bf16*)(F.ws + WS_QI); const float* MISC = (const float*)(F.ws + WS_MISC); unsigned* MASK = (unsigned*)(F.ws + WS_MASK);
    LAS unsigned* hist = (LAS unsigned*)(F.lds + SEL_HIST); LAS unsigned* cand = (LAS unsigned*)(F.lds + SEL_CAND); LAS unsigned* maskL = (LAS unsigned*)(F.lds + SEL_MASK); LAS int* meta = (LAS int*)(F.lds + SEL_META);
    const int b = blockIdx.x >> 5, ii = blockIdx.x & 31;
    for (int ui = 0; ui < 2; ++ui) { const int qb = ui ? 63 - ii : ii; const int t0 = b * S_ + qb * 32;
        int tid = F.tid; asm volatile("" : "+v"(tid)); const int lane = tid & 63; int wave = F.wave; asm volatile("" : "+s"(wave));
        if (qb < 8) {
            for (int wd = tid; wd < 2048; wd += 512) { const int q = wd >> 6, w = wd & 63, qpos = qb * 32 + q; const int rel = qpos - 32 * w;
                MASK[(size_t)(t0 + q) * 64 + w] = rel >= 31 ? 0xFFFFFFFFu : (rel < 0 ? 0u : ((2u << rel) - 1u)); }
            continue; }
        __syncthreads();
        for (int c = tid; c < 2048; c += 512) { const int q = c >> 6, c16 = c & 63; *(LAS v4u*)(F.lds + SEL_QI + q * 1024 + ((c16 ^ (q & 15)) << 4)) = *(const GAS v4u*)(QI + (size_t)(t0 + q) * 512 + c16 * 8); }
        { unsigned z = 0u; asm volatile("" : "+v"(z)); const v4u z4 = (v4u){z, z, z, z};
          for (int i = tid; i < 16384 / 4; i += 512) ((LAS v4u*)hist)[i] = z4;
          for (int i = tid; i < 2048 / 4; i += 512) ((LAS v4u*)maskL)[i] = z4; }
        if (tid < 192) meta[tid] = 0;
        float wi[8];
#pragma unroll
        for (int h = 0; h < 8; ++h) wi[h] = MISC[(size_t)(t0 + (lane & 31)) * 256 + 192 + h];
        const float* MISCb = MISC + (size_t)b * S_ * 256;
        __syncthreads();
        sel_pass<0>(F, lane, wave, MISCb, qb, wi, 0u);
        __syncthreads();
        for (int qq = 0; qq < 4; ++qq) { const int q = wave * 4 + qq; const LAS unsigned* hq = hist + q * 512; unsigned c8[8]; unsigned cs = 0u;
#pragma unroll
            for (int i = 0; i < 8; ++i) { c8[i] = hq[511 - 8 * lane - i]; cs += c8[i]; }
            unsigned incl = cs;
#pragma unroll
            for (int o = 1; o < 64; o <<= 1) { const unsigned v = __shfl_up(incl, o); if (lane >= o) incl += v; }
            const unsigned excl = incl - cs;
            if (excl < 256u && incl >= 256u) { unsigned run = excl;
#pragma unroll
                for (int i = 0; i < 8; ++i) { const unsigned before = run; run += c8[i]; if (before < 256u && run >= 256u) { meta[q] = 511 - 8 * lane - i; meta[32 + q] = (int)(256u - before); } } } }
        __syncthreads();
        sel_pass<1>(F, lane, wave, MISCb, qb, wi, 0u);
        __syncthreads();
        if (tid < 32) { if (meta[64 + tid] > SEL_CAP) meta[96] = 1; }
        __syncthreads();
        if (meta[96] == 0) {
            for (int item = tid; item < 32 * SEL_CAP; item += 512) { const int q = item >> 7, i = item & (SEL_CAP - 1); const int n = meta[64 + q];
                if (i < n) { const unsigned my = cand[q * SEL_CAP + i]; int rank = 0; for (int j = 0; j < n; ++j) rank += (cand[q * SEL_CAP + j] > my) ? 1 : 0;
                    if (rank < meta[32 + q]) { const int idx = 2047 - (int)(my & 0x7FFu); __hip_atomic_fetch_or(maskL + q * 64 + (idx >> 5), 1u << (idx & 31), __ATOMIC_RELAXED, __HIP_MEMORY_SCOPE_WORKGROUP); } } }
        } else {
#pragma unroll 1
            for (int bit = 31; bit >= 0; --bit) {
                sel_pass<2>(F, lane, wave, MISCb, qb, wi, 1u << bit);
                __syncthreads();
                if (tid < 32) { if ((unsigned)meta[160 + tid] >= 256u) meta[128 + tid] |= (int)(1u << bit); meta[160 + tid] = 0; }
                __syncthreads(); }
            sel_pass<3>(F, lane, wave, MISCb, qb, wi, 0u);
        }
        __syncthreads();
        { const int q = tid >> 4, w4 = (tid & 15) * 4; *(GAS v4u*)(MASK + (size_t)(t0 + q) * 64 + w4) = *(const LAS v4u*)(maskL + q * 64 + w4); }
    }
}
constexpr int ATT_K = 0, ATT_VT = 32768;
__device__ __forceinline__ void att_load(const bf16* CKV, const bf16* CKVT, int b, int j, int tid, v4u (&st)[4]) {
#pragma unroll
    for (int i = 0; i < 2; ++i) { const int c = tid + 512 * i; st[i] = *(const GAS v4u*)(CKV + (size_t)(b * S_ + 64 * j) * 128 + c * 8); }
#pragma unroll
    for (int i = 0; i < 2; ++i) { const int c = tid + 512 * i, d = c >> 3, ch = c & 7; st[2 + i] = *(const GAS v4u*)(CKVT + (size_t)(b * 128 + d) * 2048 + 64 * j + ch * 8); }
}
__device__ __forceinline__ void att_store(LAS unsigned char* lds, int buf, int tid, const v4u (&st)[4]) {
#pragma unroll
    for (int i = 0; i < 2; ++i) { const int c = tid + 512 * i, row = c >> 4, ch = c & 15; *(LAS v4u*)(lds + ATT_K + buf * 16384 + row * 256 + ((ch ^ (row & 15)) << 4)) = st[i]; }
#pragma unroll
    for (int i = 0; i < 2; ++i) { const int c = tid + 512 * i, d = c >> 3, ch = c & 7; *(LAS v4u*)(lds + ATT_VT + buf * 16384 + d * 128 + ((ch ^ ((d >> 1) & 7)) << 4)) = st[2 + i]; }
}
__device__ __forceinline__ void p4_attention(Frame& F) {
    const bf16* QL = (const bf16*)(F.ws + WS_QL); const bf16* CKV = (const bf16*)(F.ws + WS_CKV); const bf16* CKVT = (const bf16*)(F.ws + WS_CKVT);
    const unsigned* MASK = (const unsigned*)(F.ws + WS_MASK); bf16* OLAT = (bf16*)(F.ws + WS_OLAT);
    const int b = blockIdx.x >> 5, ii = blockIdx.x & 31;
    for (int ui = 0; ui < 2; ++ui) { const int qb = ui ? 63 - ii : ii;
        int tid = F.tid; asm volatile("" : "+v"(tid)); const int lane = tid & 63; int head = F.wave; asm volatile("" : "+s"(head));
        const int hh = lane >> 5, q = lane & 31; const float slope2 = __builtin_amdgcn_exp2f(-(float)(head + 1)) * LOG2E;
        const int t0 = b * S_ + qb * 32, qpos = qb * 32 + q; const int nt = (qb >> 1) + 1;
        bf16x8 Qf[8];
#pragma unroll
        for (int s = 0; s < 8; ++s) Qf[s] = *(const GAS bf16x8*)(QL + (size_t)(t0 + q) * 1024 + head * 128 + 16 * s + 8 * hh);
        f32x16 O[4];
#pragma unroll
        for (int db = 0; db < 4; ++db)
#pragma unroll
            for (int r = 0; r < 16; ++r) O[db][r] = 0.f;
        float m_run = -INFINITY, l_run = 0.f;
        v4u st[4];
        att_load(CKV, CKVT, b, 0, tid, st);
        __syncthreads();
        att_store(F.lds, 0, tid, st);
        __syncthreads();
        for (int j = 0; j < nt; ++j) { const int buf = j & 1;
            if (j + 1 < nt) att_load(CKV, CKVT, b, j + 1, tid, st);
            const unsigned mlo = MASK[(size_t)(t0 + q) * 64 + 2 * j] >> (4 * hh), mhi = MASK[(size_t)(t0 + q) * 64 + 2 * j + 1] >> (4 * hh);
            f32x16 S0, S1;
#pragma unroll
            for (int r = 0; r < 16; ++r) { S0[r] = 0.f; S1[r] = 0.f; }
            const LAS unsigned char* kb0 = F.lds + ATT_K + buf * 16384 + q * 256, * kb1 = kb0 + 32 * 256;
#pragma unroll
            for (int s = 0; s < 8; ++s) { const int sw = ((2 * s + hh) ^ (q & 15)) << 4;
                const bf16x8 A0 = *(const LAS bf16x8*)(kb0 + sw), A1 = *(const LAS bf16x8*)(kb1 + sw);
                S0 = MFMA32(A0, Qf[s], S0); S1 = MFMA32(A1, Qf[s], S1); }
            asm volatile("" ::: "memory");
            const float base0 = slope2 * (float)(64 * j + 4 * hh - qpos);
            float tmax = -INFINITY;
#pragma unroll
            for (int r = 0; r < 16; ++r) { const int kr = (r & 3) + 8 * (r >> 2);
                float s0 = S0[r] + (base0 + slope2 * (float)kr), s1 = S1[r] + (base0 + slope2 * (float)(kr + 32));
                s0 = ((mlo >> kr) & 1u) ? s0 : -INFINITY; s1 = ((mhi >> kr) & 1u) ? s1 : -INFINITY;
                S0[r] = s0; S1[r] = s1; tmax = fmaxf(tmax, fmaxf(s0, s1)); }
            tmax = fmaxf(tmax, __shfl_xor(tmax, 32));
            const float m_new = fmaxf(m_run, tmax), msafe = (m_new == -INFINITY) ? 0.f : m_new;
            const float alpha = __builtin_amdgcn_exp2f(m_run - msafe);
            float ps = 0.f;
#pragma unroll
            for (int r = 0; r < 16; ++r) { S0[r] = __builtin_amdgcn_exp2f(S0[r] - msafe); S1[r] = __builtin_amdgcn_exp2f(S1[r] - msafe); ps += S0[r] + S1[r]; }
            l_run = l_run * alpha + ps; m_run = m_new;
            if (__any(alpha != 1.f)) {
#pragma unroll
                for (int db = 0; db < 4; ++db)
#pragma unroll
                    for (int r = 0; r < 16; ++r) O[db][r] *= alpha; }
            bf16x8 Pf[4];
            Pf[0] = pack8(S0[0], S0[1], S0[2], S0[3], S0[4], S0[5], S0[6], S0[7]); Pf[1] = pack8(S0[8], S0[9], S0[10], S0[11], S0[12], S0[13], S0[14], S0[15]);
            Pf[2] = pack8(S1[0], S1[1], S1[2], S1[3], S1[4], S1[5], S1[6], S1[7]); Pf[3] = pack8(S1[8], S1[9], S1[10], S1[11], S1[12], S1[13], S1[14], S1[15]);
            asm volatile("" ::: "memory");
            const LAS unsigned char* vb = F.lds + ATT_VT + buf * 16384;
#pragma unroll
            for (int db = 0; db < 4; ++db) { const int d = db * 32 + q; const LAS unsigned char* vr = vb + d * 128; const int sx = (d >> 1) & 7;
#pragma unroll
                for (int c2 = 0; c2 < 4; ++c2) { const bf16x8 Av = *(const LAS bf16x8*)(vr + (((c2 * 2 + hh) ^ sx) << 4)); O[db] = MFMA32(Av, Pf[c2], O[db]); } }
            if (j + 1 < nt) att_store(F.lds, buf ^ 1, tid, st);
            __syncthreads();
        }
        const float lt = l_run + __shfl_xor(l_run, 32); const float inv = 1.f / lt;
        bf16* orow = OLAT + (size_t)(t0 + q) * 1024 + head * 128 + 4 * hh;
#pragma unroll
        for (int db = 0; db < 4; ++db)
#pragma unroll
            for (int g = 0; g < 4; ++g) { const unsigned lo = pkbf(O[db][4 * g] * inv, O[db][4 * g + 1] * inv), hi = pkbf(O[db][4 * g + 2] * inv, O[db][4 * g + 3] * inv);
                *(GAS unsigned long long*)(orow + db * 32 + 8 * g) = (unsigned long long)lo | ((unsigned long long)hi << 32); }
    }
}
struct Args { const float* in[23]; float* out; unsigned char* ws; int ph_lo, ph_hi; };
__global__ void __launch_bounds__(NWAVES * 64, 2) mk_fwd(Args args) {
    extern __shared__ __attribute__((aligned(16))) unsigned char lds[];
    Frame F;
    F.lds = (LAS unsigned char*)lds;
    F.MISCW = (volatile LAS unsigned*)(F.lds + MISC_OFF);
    F.tid = threadIdx.x; F.lane = F.tid & 63; F.wave = __builtin_amdgcn_readfirstlane(F.tid >> 6);
    F.G = gridDim.x; { const int bx = blockIdx.x; F.vcu = (F.G % 8 == 0) ? (bx % 8) * (F.G / 8) + bx / 8 : bx; }
    F.ws = args.ws; F.ctl = (gu32*)(args.ws + WS_CTL); F.out = args.out;
    for (int u = F.tid; u < (LDS_BYTES - LDSCTL_OFF) / 4; u += NWAVES * 64) ((LAS unsigned*)(F.lds + LDSCTL_OFF))[u] = 0u;
    __syncthreads();
    const int lo = args.ph_lo, hi = args.ph_hi;
#define IN(k) (lo <= (k) && (k) < hi)
#define SEAM(k) do { if (IN(k) && IN((k) + 1)) xcd_barrier(bar); } while (0)
    XcdBarrier bar; bar.bar = (unsigned*)(F.ctl + CW_BAR); bar.x = 0; bar.st = nullptr;
    if (hi - lo > 1) bar = xcd_barrier_post((unsigned*)(F.ctl + CW_BAR), F.MISCW + 8);
    if (IN(0)) { p0_prologue(F); } SEAM(0);
    if (IN(1)) { p1_modulate(F); } SEAM(1);
    if (IN(2)) {
        pg8::Gemm g{(const pg8::bf16_t*)(F.ws + WS_H), (const pg8::bf16_t*)(F.ws + WS_WIN), T, NIN, D}; pg8::StaticOrder S; S.init(T, NIN, F.G, (int)blockIdx.x);
        pg8::EpiInProj E{(pg8::bf16_t*)(F.ws + WS_QL), (pg8::bf16_t*)(F.ws + WS_QI), (pg8::bf16_t*)(F.ws + WS_U), (pg8::bf16_t*)(F.ws + WS_SG), (float*)(F.ws + WS_MISC)};
        pg8::gemm_phase<pg8::EpiInProj, pg8::StaticOrder, PG8_ALIGN, PG8_SP2>(F.lds + RING_OFF, g, S, E);
    } SEAM(2);
    if (IN(3)) { p3_post(F); __syncthreads(); p3_select(F); } SEAM(3);
    if (IN(4)) { p4_attention(F); } SEAM(4);
    if (IN(5)) {
        { pg8::Gemm g{(const pg8::bf16_t*)(F.ws + WS_OLAT), (const pg8::bf16_t*)(F.ws + WS_WOA), T, D, 1024}; pg8::StaticOrder S; S.init(T, D, F.G, (int)blockIdx.x);
          pg8::EpiGateMul E{(pg8::bf16_t*)(F.ws + WS_TMP), (const pg8::bf16_t*)(F.ws + WS_SG), 0, 0};
          pg8::gemm_phase<pg8::EpiGateMul, pg8::StaticOrder, PG8_ALIGN, PG8_SP2>(F.lds + RING_OFF, g, S, E); }
        { pg8::Gemm g{(const pg8::bf16_t*)(F.ws + WS_POOLED), (const pg8::bf16_t*)(F.ws + WS_WPB), T, D, 512}; pg8::StaticOrder S; S.init(T, D, F.G, (int)blockIdx.x);
          pg8::EpiGateAdd E{(pg8::bf16_t*)(F.ws + WS_MIX), (const pg8::bf16_t*)(F.ws + WS_TMP), (const pg8::bf16_t*)(F.ws + WS_SG), 1024, 0};
          pg8::gemm_phase<pg8::EpiGateAdd, pg8::StaticOrder, PG8_ALIGN, PG8_SP2>(F.lds + RING_OFF, g, S, E); }
    } SEAM(5);
    if (IN(6)) {
        pg8::Gemm g{(const pg8::bf16_t*)(F.ws + WS_MIX), (const pg8::bf16_t*)(F.ws + WS_WOUT), T, D, 1024}; pg8::StaticOrder S; S.init(T, D, F.G, (int)blockIdx.x);
        pg8::EpiResid E{(float*)(F.ws + WS_Z), frame_in(0), (const float*)(F.ws + WS_MOD) + 2 * 1024};
        pg8::gemm_phase<pg8::EpiResid, pg8::StaticOrder, PG8_ALIGN, PG8_SP2>(F.lds + RING_OFF, g, S, E);
    } SEAM(6);
    if (IN(7)) { p7_ln1_route(F); } SEAM(7);
    if (IN(8)) { p8_gather(F); } SEAM(8);
    if (IN(9)) {
        load_tstart(F);
        pg8::Gemm g{(const pg8::bf16_t*)(F.ws + WS_XPAD), (const pg8::bf16_t*)(F.ws + WS_WGU), MAXROWS, 32 * 2048, 1024};
        pg8::MoeOrder S{(const LAS int*)(F.lds + LC_TSTART), 8, F.G, (int)blockIdx.x};
        pg8::EpiSwiglu E{(pg8::bf16_t*)(F.ws + WS_ACT), frame_in(18)};
        pg8::gemm_phase<pg8::EpiSwiglu, pg8::MoeOrder, PG8_ALIGN, PG8_SP2>(F.lds + RING_OFF, g, S, E);
    } SEAM(9);
    if (IN(10)) {
        load_tstart(F);
        pg8::Gemm g{(const pg8::bf16_t*)(F.ws + WS_ACT), (const pg8::bf16_t*)(F.ws + WS_WD), MAXROWS, 32 * 1024, 1024};
        pg8::MoeOrder S{(const LAS int*)(F.lds + LC_TSTART), 4, F.G, (int)blockIdx.x};
        pg8::EpiDown E{(pg8::bf16_t*)(F.ws + WS_Y), frame_in(20)};
        pg8::gemm_phase<pg8::EpiDown, pg8::MoeOrder, PG8_ALIGN, PG8_SP2>(F.lds + RING_OFF, g, S, E);
    } SEAM(10);
    if (IN(11)) { p11_final(F); }
#undef IN
#undef SEAM
}

namespace tmpk {
__global__ void k_ckv(const float* MISC, const float* g, bf16* CKV) {
    const int t = blockIdx.x, r = threadIdx.x; __shared__ float red[128];
    const float v = MISC[(size_t)t * 256 + r]; red[r] = v * v; __syncthreads();
    for (int s = 64; s > 0; s >>= 1) { if (r < s) red[r] += red[r + s]; __syncthreads(); }
    const float rs = 1.0f / sqrtf(red[0] / 128.f + LN_EPS);
    CKV[(size_t)t * 128 + r] = (bf16)f2bf(v * rs * g[r]);
}
__global__ void k_pool(const bf16* U, bf16* POOLED) {
    const int t = blockIdx.x, c = threadIdx.x, s = t % S_; const int g = c >> 7, w = 2 << g;
    const int lo = (s - w + 1) < 0 ? 0 : (s - w + 1); float sum = 0.f;
    for (int sp = lo; sp <= s; ++sp) sum += bf2f(U[(size_t)(t - s + sp) * 512 + c]);
    POOLED[(size_t)t * 512 + c] = (bf16)f2bf(sum / (float)(s - lo + 1) - bf2f(U[(size_t)t * 512 + c]));
}
__device__ __forceinline__ unsigned ord(float f) { unsigned u = __float_as_uint(f); return (u & 0x80000000u) ? ~u : (u | 0x80000000u); }
__global__ void __launch_bounds__(256) k_select(const bf16* QI, const float* MISC, int* SEL, int* CNT) {
    const int t = blockIdx.x, b = t / S_, q = t % S_; const int n = q + 1;
    if (n <= TOPK) { for (int i = threadIdx.x; i < n; i += 256) SEL[(size_t)t * TOPK + i] = i; if (threadIdx.x == 0) CNT[t] = n; return; }
    __shared__ float qi[512]; __shared__ float wi[8]; __shared__ unsigned long long keys[2048];
    for (int i = threadIdx.x; i < 512; i += 256) qi[i] = bf2f(QI[(size_t)t * 512 + i]);
    if (threadIdx.x < 8) wi[threadIdx.x] = MISC[(size_t)t * 256 + 192 + threadIdx.x];
    __syncthreads();
    for (int j = threadIdx.x; j < 2048; j += 256) {
        unsigned long long kv = 0ull;
        if (j < n) { const float* kp = MISC + (size_t)(b * S_ + j) * 256 + 128; float sc = 0.f;
            for (int h = 0; h < 8; ++h) { float dsum = 0.f; for (int d = 0; d < 64; ++d) dsum += qi[h * 64 + d] * bf2f((bf16)f2bf(kp[d])); sc += wi[h] * fmaxf(dsum, 0.f); }
            kv = ((unsigned long long)ord(sc) << 32) | (unsigned long long)(0xFFFFFFFFu - (unsigned)j); }
        keys[j] = kv; }
    __syncthreads();
    for (int k = 2; k <= 2048; k <<= 1) for (int j = k >> 1; j > 0; j >>= 1) {
        for (int i = threadIdx.x; i < 2048; i += 256) { const int ixj = i ^ j; if (ixj > i) { const unsigned long long a = keys[i], c = keys[ixj]; const bool up = ((i & k) == 0);
                if (up ? (a < c) : (a > c)) { keys[i] = c; keys[ixj] = a; } } }
        __syncthreads(); }
    for (int i = threadIdx.x; i < TOPK; i += 256) SEL[(size_t)t * TOPK + i] = (int)(0xFFFFFFFFu - (unsigned)(keys[i] & 0xFFFFFFFFull));
    if (threadIdx.x == 0) CNT[t] = TOPK;
}
__global__ void __launch_bounds__(256) k_attn(const bf16* QL, const bf16* CKV, const int* SEL, const int* CNT, bf16* OLAT) {
    const int t = blockIdx.x, b = t / S_, q = t % S_, tid = threadIdx.x; const int cnt = CNT[t];
    __shared__ float ql[128], p[256], red[256]; __shared__ int sel[256];
    sel[tid] = (tid < cnt) ? SEL[(size_t)t * TOPK + tid] : 0;
    for (int h = 0; h < 8; ++h) {
        __syncthreads();
        if (tid < 128) ql[tid] = bf2f(QL[(size_t)t * 1024 + h * 128 + tid]);
        __syncthreads();
        const float slope = exp2f(-(float)(h + 1)) * LOG2E;
        float lg = -INFINITY;
        if (tid < cnt) { const bf16* kp = CKV + (size_t)(b * S_ + sel[tid]) * 128; float a = 0.f; for (int r = 0; r < 128; ++r) a += ql[r] * bf2f(kp[r]); lg = a - slope * (float)(q - sel[tid]); }
        red[tid] = lg; __syncthreads();
        for (int s = 128; s > 0; s >>= 1) { if (tid < s) red[tid] = fmaxf(red[tid], red[tid + s]); __syncthreads(); }
        const float mx = red[0]; __syncthreads();
        const float e = (tid < cnt) ? exp2f(lg - mx) : 0.f; p[tid] = e; red[tid] = e; __syncthreads();
        for (int s = 128; s > 0; s >>= 1) { if (tid < s) red[tid] += red[tid + s]; __syncthreads(); }
        const float inv = 1.f / red[0];
        if (tid < 128) { float a = 0.f; for (int j = 0; j < cnt; ++j) a += p[j] * bf2f(CKV[(size_t)(b * S_ + sel[j]) * 128 + tid]); OLAT[(size_t)t * 1024 + h * 128 + tid] = (bf16)f2bf(a * inv); }
    }
}
template <bool BT, class CF, class AF, class BF, class EF>
__global__ void __launch_bounds__(256) k_gemm(int M, int N, int K, int pad_, CF cf, AF af, BF bf, EF ef) {
    const int ctx = cf(blockIdx.y);
    __shared__ float As[16][65], Bs[16][65];
    const int tx = threadIdx.x & 15, ty = threadIdx.x >> 4;
    const int m0 = blockIdx.y * 64, n0 = blockIdx.x * 64;
    float acc[4][4] = {};
    for (int k0 = 0; k0 < K; k0 += 16) {
        for (int i = threadIdx.x; i < 64 * 16; i += 256) { const int mm = i >> 4, kk = i & 15; As[kk][mm] = (m0 + mm < M) ? af(m0 + mm, k0 + kk, ctx) : 0.f; }
        for (int i = threadIdx.x; i < 64 * 16; i += 256) { const int kk = BT ? (i & 15) : (i >> 6), nn = BT ? (i >> 4) : (i & 63); Bs[kk][nn] = (n0 + nn < N) ? bf(k0 + kk, n0 + nn, ctx) : 0.f; }
        __syncthreads();
#pragma unroll
        for (int kk = 0; kk < 16; ++kk) { float a[4], b[4];
#pragma unroll
            for (int i = 0; i < 4; ++i) { a[i] = As[kk][ty * 4 + i]; b[i] = Bs[kk][tx * 4 + i]; }
#pragma unroll
            for (int i = 0; i < 4; ++i)
#pragma unroll
                for (int j = 0; j < 4; ++j) acc[i][j] += a[i] * b[j]; }
        __syncthreads();
    }
#pragma unroll
    for (int i = 0; i < 4; ++i) { const int m = m0 + ty * 4 + i; if (m < M) ef(m, n0 + tx * 4, acc[i], ctx); }
}
__device__ __forceinline__ float blk_sum(float v, float* red) {
    const int tid = threadIdx.x; red[tid] = v; __syncthreads();
    for (int s = 128; s > 0; s >>= 1) { if (tid < s) red[tid] += red[tid + s]; __syncthreads(); }
    const float r = red[0]; __syncthreads(); return r;
}
__global__ void __launch_bounds__(256) k_ln1_route(const float* Z, const float* g1, const float* b1, const float* mod, const float* w_r, const float* b_r,
                                                   float* X1, bf16* H2, int* gcnt, int* SLOTMAP, int* TOKSLOT, float* GATE) {
    const int t = blockIdx.x, b = t / S_, tid = threadIdx.x; __shared__ float red[256]; __shared__ float h2s[1024]; __shared__ float lg[32];
    float v[4]; float s = 0.f;
    for (int i = 0; i < 4; ++i) { v[i] = Z[(size_t)t * D + tid + 256 * i]; s += v[i]; }
    const float mean = blk_sum(s, red) / D; float s2 = 0.f;
    for (int i = 0; i < 4; ++i) { v[i] -= mean; s2 += v[i] * v[i]; }
    const float rstd = 1.0f / sqrtf(blk_sum(s2, red) / D + LN_EPS);
    for (int i = 0; i < 4; ++i) { const int col = tid + 256 * i; const float x1 = v[i] * rstd * g1[col] + b1[col]; X1[(size_t)t * D + col] = x1;
        const float h2 = x1 * (1.f + mod[b * 6144 + 4 * 1024 + col]) + mod[b * 6144 + 3 * 1024 + col]; H2[(size_t)t * D + col] = (bf16)f2bf(h2); h2s[col] = h2; }
    __syncthreads();
    { const int e = tid >> 3, part = tid & 7; float a = 0.f;
      for (int k = part; k < 1024; k += 8) a += h2s[k] * w_r[(size_t)k * 32 + e];
      red[tid] = a; __syncthreads();
      if (part == 0) { float sum = 0.f; for (int i = 0; i < 8; ++i) sum += red[tid + i]; lg[e] = sum + b_r[e]; }
      __syncthreads(); }
    if (tid == 0) {
        int sel[4]; float val[4]; unsigned used = 0u;
        for (int k = 0; k < 4; ++k) { int best = -1; float bv = -INFINITY; for (int e = 0; e < 32; ++e) if (!((used >> e) & 1u) && (best < 0 || lg[e] > bv)) { best = e; bv = lg[e]; } sel[k] = best; val[k] = bv; used |= 1u << best; }
        float den = 0.f, ex[4]; for (int k = 0; k < 4; ++k) { ex[k] = __expf(val[k] - val[0]); den += ex[k]; }
        for (int k = 0; k < 4; ++k) { const int e = sel[k]; const int rank = atomicAdd(&gcnt[e], 1); SLOTMAP[e * T + rank] = t; TOKSLOT[t * 4 + k] = e | (rank << 8); GATE[t * 4 + k] = ex[k] / den; }
    }
}
__global__ void k_prefix(const int* gcnt, int* tstart) {
    if (threadIdx.x == 0) { int a = 0; for (int e = 0; e < 32; ++e) { tstart[e] = a; a += (gcnt[e] + 255) / 256; } tstart[32] = a; }
}
__global__ void __launch_bounds__(256) k_final(const float* X1, const bf16* Y, const int* TOKSLOT, const float* GATE, const int* tstart, const float* mod,
                                               const float* g2, const float* b2, float* out) {
    const int t = blockIdx.x, b = t / S_, tid = threadIdx.x; __shared__ float red[256];
    float v[4]; float s = 0.f;
    for (int i = 0; i < 4; ++i) { const int col = tid + 256 * i; float m = 0.f;
        for (int k = 0; k < 4; ++k) { const int ts = TOKSLOT[t * 4 + k]; const int e = ts & 255, rank = ts >> 8; m += GATE[t * 4 + k] * bf2f(Y[((size_t)tstart[e] * 256 + rank) * 1024 + col]); }
        v[i] = ALPHA * X1[(size_t)t * D + col] + mod[b * 6144 + 5 * 1024 + col] * m; s += v[i]; }
    const float mean = blk_sum(s, red) / D; float s2 = 0.f;
    for (int i = 0; i < 4; ++i) { v[i] -= mean; s2 += v[i] * v[i]; }
    const float rstd = 1.0f / sqrtf(blk_sum(s2, red) / D + LN_EPS);
    for (int i = 0; i < 4; ++i) { const int col = tid + 256 * i; out[(size_t)t * D + col] = v[i] * rstd * g2[col] + b2[col]; }
}
struct CZero { long long dummy; __device__ int operator()(int) const { return 0; } };
struct ABf { const bf16* A; long long lda; __device__ float operator()(int m, int k, int) const { return bf2f(A[(size_t)m * lda + k]); } };
struct BBfT { const bf16* Bt; long long ldk; __device__ float operator()(int k, int n, int) const { return bf2f(Bt[(size_t)n * ldk + k]); } };
struct EGateMul { bf16* C; const bf16* SG; long long goff; __device__ void operator()(int m, int n, const float (&a)[4], int) const { for (int j = 0; j < 4; ++j) C[(size_t)m * 1024 + n + j] = (bf16)f2bf(bf2f(SG[(size_t)m * 2048 + goff + n + j]) * a[j]); } };
struct EGateAdd { bf16* C; const bf16* TMP; const bf16* SG; long long goff; __device__ void operator()(int m, int n, const float (&a)[4], int) const { for (int j = 0; j < 4; ++j) C[(size_t)m * 1024 + n + j] = (bf16)f2bf(bf2f(TMP[(size_t)m * 1024 + n + j]) + bf2f(SG[(size_t)m * 2048 + goff + n + j]) * a[j]); } };
struct EResid { float* Z; const float* x; const float* mod; __device__ void operator()(int m, int n, const float (&a)[4], int) const { const int b = m / S_; for (int j = 0; j < 4; ++j) Z[(size_t)m * 1024 + n + j] = ALPHA * x[(size_t)m * 1024 + n + j] + mod[b * 6144 + 2 * 1024 + n + j] * a[j]; } };
struct CExp { const int* tstart; __device__ int operator()(int by) const { const int tile = by >> 2; if (tile >= tstart[32]) return -1; int e = 0; while (e < 31 && tstart[e + 1] <= tile) ++e; return e; } };
struct AGather { const bf16* H2; const int* SLOTMAP; const int* gcnt; const int* tstart;
    __device__ float operator()(int m, int k, int e) const { if (e < 0) return 0.f; const int rank = m - tstart[e] * 256; if (rank >= gcnt[e]) return 0.f; return bf2f(H2[(size_t)SLOTMAP[e * T + rank] * 1024 + k]); } };
struct BGateUpT { const bf16* Wt;
    __device__ float operator()(int k, int n, int e) const { if (e < 0) return 0.f; const int j = n >> 1; const int row = (j >> 7) * 256 + ((n & 1) ? 128 : 0) + (j & 127); return bf2f(Wt[((size_t)e * 2048 + row) * 1024 + k]); } };
struct ESwiglu { bf16* ACT; const float* bgu;
    __device__ void operator()(int m, int n, const float (&a)[4], int e) const { if (e < 0) return;
        for (int p = 0; p < 2; ++p) { const int j = (n >> 1) + p; float gl = a[2 * p] + bgu[e * 2048 + j], li = a[2 * p + 1] + bgu[e * 2048 + 1024 + j];
            gl = fminf(gl, 7.f); li = fminf(fmaxf(li, -7.f), 7.f); ACT[(size_t)m * 1024 + j] = (bf16)f2bf(gl * (1.f / (1.f + __expf(-1.702f * gl))) * (li + 1.f)); } } };
struct ARowT { const bf16* A; __device__ float operator()(int m, int k, int e) const { if (e < 0) return 0.f; return bf2f(A[(size_t)m * 1024 + k]); } };
struct BDownT { const bf16* Wt; __device__ float operator()(int k, int n, int e) const { if (e < 0) return 0.f; return bf2f(Wt[((size_t)e * 1024 + n) * 1024 + k]); } };
struct EDown { bf16* Y; const float* bd; __device__ void operator()(int m, int n, const float (&a)[4], int e) const { if (e < 0) return; for (int j = 0; j < 4; ++j) Y[(size_t)m * 1024 + n + j] = (bf16)f2bf(a[j] + bd[e * 1024 + n + j]); } };
}

static void launch_mk(const Args& a0, int lo, int hi, int grid, hipStream_t stream) {
    Args a = a0; a.ph_lo = lo; a.ph_hi = hi;
    hipLaunchKernelGGL(mk_fwd, dim3(grid), dim3(NWAVES * 64), LDS_BYTES, stream, a);
}
extern "C" void kernel_launch(void* const* d_in, const int* in_sizes, int n_in, void* d_out, int out_size, void* d_ws, size_t ws_size, hipStream_t stream) {
    static int grid = 0;
    if (grid == 0) {
        if (n_in != 23 || ws_size < WS_END) { fprintf(stderr, "kernel_launch: unexpected n_in %d / ws %zu\n", n_in, ws_size); grid = -1; return; }
        int dev = 0, cus = 0;
        if (hipGetDevice(&dev) != hipSuccess || hipDeviceGetAttribute(&cus, hipDeviceAttributeMultiprocessorCount, dev) != hipSuccess) { grid = -1; return; }
        if (hipFuncSetAttribute((const void*)mk_fwd, hipFuncAttributeMaxDynamicSharedMemorySize, LDS_BYTES) != hipSuccess) { fprintf(stderr, "hipFuncSetAttribute failed\n"); grid = -1; return; }
        grid = cus;
        if (grid != 256) { fprintf(stderr, "kernel_launch: built for 256 CUs, found %d\n", cus); grid = -1; return; }
    }
    if (grid < 0) return;
    unsigned char* ws = (unsigned char*)d_ws;
    (void)hipMemsetAsync(ws + WS_CTL, 0, CTL_ZERO_BYTES, stream);
    Args a{};
    for (int i = 0; i < 23; ++i) a.in[i] = (const float*)d_in[i];
    a.out = (float*)d_out; a.ws = ws;
    const float* x = a.in[0]; const float* kvg = a.in[5]; const float* g1 = a.in[13]; const float* b1 = a.in[14]; const float* w_r = a.in[15]; const float* b_r = a.in[16];
    const float* b_gu = a.in[18]; const float* b_d = a.in[20]; const float* g2 = a.in[21]; const float* b2 = a.in[22];
    float* MOD = (float*)(ws + WS_MOD); bf16* QL = (bf16*)(ws + WS_QL); bf16* QI = (bf16*)(ws + WS_QI); float* MISC = (float*)(ws + WS_MISC); bf16* U = (bf16*)(ws + WS_U); bf16* SG = (bf16*)(ws + WS_SG);
    bf16* CKV = (bf16*)(ws + WS_CKV); bf16* POOLED = (bf16*)(ws + WS_POOLED); bf16* OLAT = (bf16*)(ws + WS_OLAT); bf16* TMP = (bf16*)(ws + WS_TMP); bf16* MIX = (bf16*)(ws + WS_MIX);
    float* Z = (float*)(ws + WS_Z); float* X1 = (float*)(ws + WS_X1); bf16* H2 = (bf16*)(ws + WS_H); int* SLOTMAP = (int*)(ws + WS_SLOTMAP); int* TOKSLOT = (int*)(ws + WS_TOKSLOT); float* GATE = (float*)(ws + WS_GATE);
    bf16* ACT = (bf16*)(ws + WS_ACT); bf16* Y = (bf16*)(ws + WS_Y); int* SEL = (int*)(ws + WS_SEL); int* CNT = (int*)(ws + WS_CNT);
    int* gcnt = (int*)(ws + WS_CTL) + CW_GCNT; int* tstart = (int*)(ws + WS_CTL) + CW_TSTART;
    bf16* Woa_t = (bf16*)(ws + WS_WOA); bf16* Wpb_t = (bf16*)(ws + WS_WPB); bf16* Wout_t = (bf16*)(ws + WS_WOUT); bf16* Wgu_t = (bf16*)(ws + WS_WGU); bf16* Wd_t = (bf16*)(ws + WS_WD);
    using namespace tmpk;
    launch_mk(a, 0, 12, grid, stream);
}
```

```cpp
#include <hip/hip_runtime.h>
#include <cstdio>
#include <cstdint>
namespace pg8 {
#define PG8_LAS __attribute__((address_space(3)))
typedef unsigned short bf16_t;
typedef short bf16x8 __attribute__((ext_vector_type(8)));
typedef float f32x4 __attribute__((ext_vector_type(4)));
typedef unsigned u32x4 __attribute__((ext_vector_type(4)));
constexpr int BM = 256, BK = 64, HALF = 128, HTB = HALF * BK * 2  , STAGE_BYTES = 8 * HTB, NXCD = 8, WGM = 8;

__host__ __device__ __forceinline__ int lds_byte(int r, int c) { const int st = (r >> 4) * 2 + (c >> 5), rr = r & 15, cc = c & 31, ob = rr * 64 + cc * 2; return st * 1024 + (ob ^ (((ob >> 9) & 1) << 5)); }
__host__ __device__ __forceinline__ void stage_rc(int b, int& R, int& C) { const int st = b / 1024, sb = b % 1024, swz = sb ^ (((sb >> 9) & 1) << 5); R = (st >> 1) * 16 + swz / 64; C = (st & 1) * 32 + (swz % 64) / 2; }
__host__ __device__ __forceinline__ int perm32(int rho) { const int n = rho >> 4, i = rho & 15; return 8 * (i >> 2) + 4 * n + (i & 3); }

struct Unit { int pm, pn; };
struct Gemm { const bf16_t* A; const bf16_t* Bt; int M, N, K; };

struct StaticOrder {
    int nM, nN, nwg, G, c;
    __host__ __device__ void init(int M, int N, int G_, int c_) { nM = M / BM; nN = N / BM; nwg = nM * nN; G = G_; c = c_; }
    __host__ __device__ bool next(int i, Unit& u) const {
        const long L = (long)i * G + c; if (L >= nwg) return false;
        int wgid = (int)L; { const int q = nwg / NXCD, r = nwg % NXCD, xcd = wgid % NXCD, off = wgid / NXCD; wgid = (xcd < r ? xcd * (q + 1) : r * (q + 1) + (xcd - r) * q) + off; }
        const int nig = WGM * nN, gid = wgid / nig, fm = gid * WGM, gsz = (nM - fm) < WGM ? (nM - fm) : WGM;
        u.pm = fm + ((wgid % nig) % gsz); u.pn = (wgid % nig) / gsz; return true;
    }
    __device__ __forceinline__ void a_ready(const Unit&) const {}
    __device__ __forceinline__ void done(const Unit&) const {}
};

__device__ __forceinline__ unsigned cvt_pk_bf16(float lo, float hi) { unsigned r; asm volatile("v_cvt_pk_bf16_f32 %0, %1, %2" : "=v"(r) : "v"(lo), "v"(hi)); return r; }
typedef float f32x2 __attribute__((ext_vector_type(2)));
__device__ __forceinline__ f32x2 gelu_pk(f32x2 v) {
    const f32x2 av = __builtin_elementwise_abs(v), d = av * 0.2316418882f + 1.0f;
    f32x2 t; t.x = __builtin_amdgcn_rcpf(d.x); t.y = __builtin_amdgcn_rcpf(d.y);
    f32x2 q = t * 0.5307027145f + (-0.7265760135f); q = q * t + 0.7107068705f; q = q * t + (-0.142248368f); q = q * t + 0.127414796f; q = q * t;
    const f32x2 s = (v * v) * (-0.72134752044f);
    f32x2 e; e.x = __builtin_amdgcn_exp2f(s.x); e.y = __builtin_amdgcn_exp2f(s.y);
    const f32x2 m = v * (q * e), r = v - m;
    f32x2 o; o.x = v.x < 0.f ? m.x : r.x; o.y = v.y < 0.f ? m.y : r.y; return o;
}

template <int ACT  > struct EpiBf16 {
    static constexpr bool PERM = true, AFTER_DRAIN = false; static_assert(ACT == 0 || ACT == 1, "EpiBf16: ACT is 0 (none) or 1 (gelu_pk)");
    bf16_t* O; int ldc; const float* bias; int split_cols; size_t split_stride; float scale0;
    __device__ __forceinline__ void operator()(const f32x4 (&acc)[2][2][4][2], const Unit& u, int wr, int wc, int fr, int fq) const {
        const int row0 = u.pm * BM + wr * 64 + fr; int colt = u.pn * BM; bf16_t* base = O;
        float sc = 1.f; if (split_cols) { const int t = colt / split_cols; base += (size_t)t * split_stride; colt -= t * split_cols; if (t == 0) sc = scale0; }
        const int col0 = colt + wc * 32 + 8 * fq, bcol0 = u.pn * BM + wc * 32 + 8 * fq;
        f32x4 bv[2][2];
#pragma unroll
        for (int bj = 0; bj < 2; ++bj)
#pragma unroll
            for (int n = 0; n < 2; ++n) bv[bj][n] = bias ? *(const f32x4*)(bias + bcol0 + bj * HALF + 4 * n) : (f32x4){0.f, 0.f, 0.f, 0.f};
#pragma unroll
        for (int ai = 0; ai < 2; ++ai)
#pragma unroll
            for (int m = 0; m < 4; ++m) { bf16_t* rowp = base + (size_t)(row0 + ai * HALF + m * 16) * ldc + col0;
#pragma unroll
                for (int bj = 0; bj < 2; ++bj) { f32x4 v0 = acc[ai][bj][m][0] + bv[bj][0], v1 = acc[ai][bj][m][1] + bv[bj][1];
                    if (ACT == 1) { f32x2 a = gelu_pk((f32x2){v0[0], v0[1]}), b = gelu_pk((f32x2){v0[2], v0[3]}), c = gelu_pk((f32x2){v1[0], v1[1]}), d = gelu_pk((f32x2){v1[2], v1[3]});
                        v0 = (f32x4){a.x, a.y, b.x, b.y}; v1 = (f32x4){c.x, c.y, d.x, d.y}; }
                    v0 = v0 * sc; v1 = v1 * sc; u32x4 w; w.x = cvt_pk_bf16(v0[0], v0[1]); w.y = cvt_pk_bf16(v0[2], v0[3]); w.z = cvt_pk_bf16(v1[0], v1[1]); w.w = cvt_pk_bf16(v1[2], v1[3]);
                    *(u32x4*)(rowp + bj * HALF) = w; } }
    }
};

struct PanelStats {
    unsigned* xbuf;
    unsigned* cnt;
    unsigned* tmo;
    int ntn; float eps;
    unsigned code;
    __device__ __forceinline__ bool run(const f32x4 (&v)[2][2][4][2], const Unit& u, int wr, int wc, int fr, int fq, PG8_LAS unsigned char* lds, int wid, int lane) const {
        typedef float f32x2v __attribute__((ext_vector_type(2)));
        PG8_LAS f32x2v* P = (PG8_LAS f32x2v*)lds;
        PG8_LAS f32x2v* S = (PG8_LAS f32x2v*)(lds + 8192);
        PG8_LAS unsigned* flag = (PG8_LAS unsigned*)(lds + 8192 + 2048);
#pragma unroll
        for (int ai = 0; ai < 2; ++ai)
#pragma unroll
            for (int m = 0; m < 4; ++m) {
                float s = 0.f;
#pragma unroll
                for (int bj = 0; bj < 2; ++bj)
#pragma unroll
                    for (int n = 0; n < 2; ++n) { const f32x4 x = v[ai][bj][m][n]; s += (x[0] + x[1]) + (x[2] + x[3]); }
                s += __shfl_xor(s, 16); s += __shfl_xor(s, 32);
                const float mw = s * (1.0f / 64.0f); float q = 0.f;
#pragma unroll
                for (int bj = 0; bj < 2; ++bj)
#pragma unroll
                    for (int n = 0; n < 2; ++n) { const f32x4 d = v[ai][bj][m][n] - mw; q += (d[0] * d[0] + d[1] * d[1]) + (d[2] * d[2] + d[3] * d[3]); }
                q += __shfl_xor(q, 16); q += __shfl_xor(q, 32);
                if (fq == 0) P[(ai * HALF + wr * 64 + m * 16 + fr) * 4 + wc] = (f32x2v){mw, q};
            }
        asm volatile("s_waitcnt lgkmcnt(0)" ::: "memory"); __builtin_amdgcn_s_barrier(); asm volatile("" ::: "memory");
#if defined(BROKEN_EXCHANGE_NO_WAIT)
#warning BROKEN CONTROL BUILD: the row-statistics exchange does not wait; results are wrong by design
        if (blockIdx.x >= 64) { const long long t0_ = clock64(); while (clock64() - t0_ < 60000) __builtin_amdgcn_s_sleep(8); }
#endif
        const int row = wid * 32 + (lane & 31);
        if (lane < 32) {
            const f32x2v a = P[row * 4 + 0], b = P[row * 4 + 1], c = P[row * 4 + 2], d = P[row * 4 + 3];
            const float mt = (a.x + b.x + c.x + d.x) * 0.25f;
            const float da = a.x - mt, db = b.x - mt, dc = c.x - mt, dd = d.x - mt;
            const float m2 = (a.y + b.y) + (c.y + d.y) + 64.0f * ((da * da + db * db) + (dc * dc + dd * dd));
            unsigned long long* slot = (unsigned long long*)xbuf + ((size_t)(u.pm * BM + row) * 4 + u.pn);
            __hip_atomic_store(slot, ((unsigned long long)__float_as_uint(m2) << 32) | __float_as_uint(mt), __ATOMIC_RELAXED, __HIP_MEMORY_SCOPE_AGENT);
        }
        asm volatile("s_waitcnt vmcnt(0)" ::: "memory");
        if (lane == 0) __hip_atomic_fetch_add(cnt + 64 * u.pm, 1u, __ATOMIC_RELAXED, __HIP_MEMORY_SCOPE_AGENT);
        if (wid == 0) {
            bool dead = false; const unsigned long long t0 = __builtin_amdgcn_s_memrealtime(); const unsigned want = 8u * (unsigned)ntn;
            for (;;) {
#if defined(BROKEN_EXCHANGE_NO_WAIT)
                break;
#endif
                if ((unsigned)__builtin_amdgcn_readfirstlane(__hip_atomic_load(cnt + 64 * u.pm, __ATOMIC_RELAXED, __HIP_MEMORY_SCOPE_AGENT)) >= want) break;
                if (__builtin_amdgcn_s_memrealtime() - t0 > 2000000ull) {
                    if (lane == 0) { unsigned expect = 0u; __hip_atomic_compare_exchange_strong(tmo + 1, &expect, code | (unsigned)(u.pm & 0xff), __ATOMIC_RELAXED, __ATOMIC_RELAXED, __HIP_MEMORY_SCOPE_AGENT);
                                     __hip_atomic_store(tmo, 1u, __ATOMIC_RELAXED, __HIP_MEMORY_SCOPE_AGENT); }
                    dead = true; break; }
                __builtin_amdgcn_s_sleep(2);
            }
            __builtin_amdgcn_fence(__ATOMIC_ACQUIRE, "agent");
            if (lane == 0) flag[0] = dead ? 1u : 0u;
        }
        asm volatile("s_waitcnt vmcnt(0) lgkmcnt(0)" ::: "memory"); __builtin_amdgcn_s_barrier(); asm volatile("" ::: "memory");
        const bool bad = flag[0] != 0u;
        if (lane < 32) {
            const unsigned long long* slot = (const unsigned long long*)xbuf + (size_t)(u.pm * BM + row) * 4; float mt[4], m2[4]; float ms = 0.f;
#pragma unroll
            for (int t = 0; t < 4; ++t) { if (t < ntn) { const unsigned long long w = __hip_atomic_load(slot + t, __ATOMIC_RELAXED, __HIP_MEMORY_SCOPE_AGENT); mt[t] = __uint_as_float((unsigned)w); m2[t] = __uint_as_float((unsigned)(w >> 32)); } else { mt[t] = 0.f; m2[t] = 0.f; } ms += mt[t]; }
            const float mean = ms / (float)ntn; float q = 0.f;
#pragma unroll
            for (int t = 0; t < 4; ++t) if (t < ntn) { const float dm = mt[t] - mean; q += m2[t] + 256.0f * dm * dm; }
            S[row] = (f32x2v){mean, 1.0f / sqrtf(q / (256.0f * (float)ntn) + eps)};
        }
        asm volatile("s_waitcnt lgkmcnt(0)" ::: "memory"); __builtin_amdgcn_s_barrier(); asm volatile("" ::: "memory");
        return bad;
    }
};
struct EpiLnRes {
    static constexpr bool PERM = false, AFTER_DRAIN = true;
    const float* base; float* out; int ldc; const float* bias; PanelStats st; unsigned poison;
    __device__ __forceinline__ void fused(f32x4 (&acc)[2][2][4][2], const Unit& u, int wr, int wc, int fr, int fq, PG8_LAS unsigned char* lds, int wid, int lane) const {
        typedef float f32x2v __attribute__((ext_vector_type(2)));
        const PG8_LAS f32x2v* S = (const PG8_LAS f32x2v*)(lds + 8192);
        const int col0 = u.pn * BM + wc * 32 + 4 * fq;
#pragma unroll
        for (int bj = 0; bj < 2; ++bj)
#pragma unroll
            for (int n = 0; n < 2; ++n) { const f32x4 bv = bias ? *(const f32x4*)(bias + col0 + bj * HALF + n * 16) : (f32x4){0.f, 0.f, 0.f, 0.f};
#pragma unroll
                for (int ai = 0; ai < 2; ++ai)
#pragma unroll
                    for (int m = 0; m < 4; ++m) acc[ai][bj][m][n] += bv; }
        f32x4 pre[4][2][2];
#pragma unroll
        for (int m = 0; m < 4; ++m) { const size_t off = (size_t)(u.pm * BM + wr * 64 + m * 16 + fr) * ldc + col0;
#pragma unroll
            for (int bj = 0; bj < 2; ++bj)
#pragma unroll
                for (int n = 0; n < 2; ++n) pre[m][bj][n] = *(const f32x4*)(base + off + bj * HALF + n * 16); }
        const bool bad = st.run(acc, u, wr, wc, fr, fq, lds, wid, lane) || poison != 0u;
        const float qnan = __builtin_nanf("");
#pragma unroll
        for (int ai = 0; ai < 2; ++ai)
#pragma unroll
            for (int m = 0; m < 4; ++m) { const int r = ai * HALF + wr * 64 + m * 16 + fr; const f32x2v sr = S[r]; const size_t off = (size_t)(u.pm * BM + r) * ldc + col0;
#pragma unroll
                for (int bj = 0; bj < 2; ++bj)
#pragma unroll
                    for (int n = 0; n < 2; ++n) { const f32x4 bs = ai == 0 ? pre[m][bj][n] : *(const f32x4*)(base + off + bj * HALF + n * 16); f32x4 o = bs + (acc[ai][bj][m][n] - sr.x) * sr.y;
                        if (bad) o = (f32x4){qnan, qnan, qnan, qnan}; *(f32x4*)(out + off + bj * HALF + n * 16) = o; }
                if (m & 1) asm volatile("" ::: "memory"); }
    }
};
struct EpiLnResLn {
    static constexpr bool PERM = false, AFTER_DRAIN = true;
    const float* base; float* out; bf16_t* xn; int ldc; const float* bias; PanelStats st1, st2; unsigned poison;
    __device__ __forceinline__ void fused(f32x4 (&acc)[2][2][4][2], const Unit& u, int wr, int wc, int fr, int fq, PG8_LAS unsigned char* lds, int wid, int lane) const {
        typedef float f32x2v __attribute__((ext_vector_type(2))); typedef unsigned u32x2v __attribute__((ext_vector_type(2)));
        const PG8_LAS f32x2v* S = (const PG8_LAS f32x2v*)(lds + 8192);
        const int col0 = u.pn * BM + wc * 32 + 4 * fq;
#pragma unroll
        for (int bj = 0; bj < 2; ++bj)
#pragma unroll
            for (int n = 0; n < 2; ++n) { const f32x4 bv = bias ? *(const f32x4*)(bias + col0 + bj * HALF + n * 16) : (f32x4){0.f, 0.f, 0.f, 0.f};
#pragma unroll
                for (int ai = 0; ai < 2; ++ai)
#pragma unroll
                    for (int m = 0; m < 4; ++m) acc[ai][bj][m][n] += bv; }
        bool bad = st1.run(acc, u, wr, wc, fr, fq, lds, wid, lane) || poison != 0u;
        const float qnan = __builtin_nanf("");
#pragma unroll
        for (int ai = 0; ai < 2; ++ai)
#pragma unroll
            for (int m = 0; m < 4; ++m) { const int r = ai * HALF + wr * 64 + m * 16 + fr; const f32x2v sr = S[r]; const size_t off = (size_t)(u.pm * BM + r) * ldc + col0;
#pragma unroll
                for (int bj = 0; bj < 2; ++bj)
#pragma unroll
                    for (int n = 0; n < 2; ++n) { const f32x4 bs = *(const f32x4*)(base + off + bj * HALF + n * 16); acc[ai][bj][m][n] = bs + (acc[ai][bj][m][n] - sr.x) * sr.y; }
                asm volatile("" : "+v"(acc[ai][0][m][0]), "+v"(acc[ai][0][m][1]), "+v"(acc[ai][1][m][0]), "+v"(acc[ai][1][m][1]));
                if (m & 1) asm volatile("" ::: "memory"); }
        const bool bad1 = bad;
        bad = st2.run(acc, u, wr, wc, fr, fq, lds, wid, lane) || bad;
#pragma unroll
        for (int ai = 0; ai < 2; ++ai)
#pragma unroll
            for (int m = 0; m < 4; ++m) { const int r = ai * HALF + wr * 64 + m * 16 + fr; const f32x2v sr = S[r]; const size_t off = (size_t)(u.pm * BM + r) * ldc + col0;
#pragma unroll
                for (int bj = 0; bj < 2; ++bj)
#pragma unroll
                    for (int n = 0; n < 2; ++n) { const f32x4 x1 = acc[ai][bj][m][n]; *(f32x4*)(out + off + bj * HALF + n * 16) = bad1 ? (f32x4){qnan, qnan, qnan, qnan} : x1;
                        const f32x4 o = (x1 - sr.x) * sr.y; u32x2v w; w.x = cvt_pk_bf16(o[0], o[1]); w.y = cvt_pk_bf16(o[2], o[3]);
                        if (bad) { w.x = 0x7fc07fc0u; w.y = 0x7fc07fc0u; } *(u32x2v*)(xn + off + bj * HALF + n * 16) = w; }
                asm volatile("" ::: "memory"); }
    }
};

template <class Epi, class Sched, bool ALIGN_EPI = false, bool SP2 = false>
__device__ __forceinline__ void gemm_phase(PG8_LAS unsigned char* lds, const Gemm g, const Sched& S, const Epi& E) {
    const int tid = threadIdx.x, wid = __builtin_amdgcn_readfirstlane(tid >> 6), lane = tid & 63, wr = wid >> 2, wc = wid & 3, fr = lane & 15, fq = lane >> 4;
    const int K = g.K, nt = K / BK;
    unsigned voffA[2], voffB[2];
#pragma unroll
    for (int i = 0; i < 2; ++i) { int R, C; stage_rc(tid * 16 + i * 8192, R, C); const int Rb = Epi::PERM ? ((R & ~31) + perm32(R & 31)) : R;
        voffA[i] = (unsigned)(R * K + C) * 2u; voffB[i] = (unsigned)(Rb * K + C) * 2u; }
    const size_t kstep = (size_t)(BK * 2);
    const size_t hstep = (size_t)HALF * K * 2;
    const size_t tstep = 2 * hstep;
    const unsigned ldsw = (unsigned)wid * 1024u;
    const int aoff = lds_byte(wr * 64 + fr, fq * 8), boff = lds_byte(wc * 32 + fr, fq * 8);
#define PG8_SA(b, h) (((b) * 2 + (h)) * HTB)
#define PG8_SB(b, h) ((4 + (b) * 2 + (h)) * HTB)
#define PG8_STAGE(bufoff, gbase, voff) do { _Pragma("unroll") for (int _i = 0; _i < 2; ++_i) \
        __builtin_amdgcn_global_load_lds((const unsigned*)((const char*)(gbase) + (voff)[_i]), (PG8_LAS unsigned*)(lds + (bufoff) + ldsw + _i * 8192), 16, 0, 0); } while (0)
#define PG8_LDA(dst, b, h) do { _Pragma("unroll") for (int m = 0; m < 4; ++m) _Pragma("unroll") for (int k = 0; k < 2; ++k) dst[m][k] = *(const PG8_LAS bf16x8*)(lds + PG8_SA(b, h) + aoff + m * 2048 + k * 1024); } while (0)
#define PG8_LDB(dst, b, h) do { _Pragma("unroll") for (int n = 0; n < 2; ++n) _Pragma("unroll") for (int k = 0; k < 2; ++k) dst[n][k] = *(const PG8_LAS bf16x8*)(lds + PG8_SB(b, h) + boff + n * 2048 + k * 1024); } while (0)
#define PG8_MMA(ai, bj, At, Bt) do { __builtin_amdgcn_s_setprio(1); _Pragma("unroll") for (int m = 0; m < 4; ++m) _Pragma("unroll") for (int n = 0; n < 2; ++n) _Pragma("unroll") for (int k = 0; k < 2; ++k) \
        acc[ai][bj][m][n] = __builtin_amdgcn_mfma_f32_16x16x32_bf16(Bt[n][k], At[m][k], acc[ai][bj][m][n], 0, 0, 0); __builtin_amdgcn_s_setprio(0); } while (0)
#define PG8_WAIT_V(n) asm volatile("s_waitcnt vmcnt(" #n ")" ::: "memory")
#define PG8_WAIT_L(n) asm volatile("s_waitcnt lgkmcnt(" #n ")" ::: "memory")
#define PG8_BAR __builtin_amdgcn_s_barrier()
#define PG8_SCHED __builtin_amdgcn_sched_barrier(0)
    Unit cur, nxt; int ui = 0;
    if (!S.next(0, cur)) return;
    f32x4 acc[2][2][4][2];
#pragma unroll
    for (int a = 0; a < 2; ++a)
#pragma unroll
        for (int b = 0; b < 2; ++b)
#pragma unroll
            for (int m = 0; m < 4; ++m)
#pragma unroll
                for (int n = 0; n < 2; ++n) acc[a][b][m][n] = (f32x4){0.f, 0.f, 0.f, 0.f};
    bf16x8 At[4][2], B0[2][2], B1[2][2];
    const char* cA = (const char*)g.A + (size_t)cur.pm * tstep; const char* cB = (const char*)g.Bt + (size_t)cur.pn * tstep;
    S.a_ready(cur);
    if constexpr (SP2) {
        PG8_STAGE(PG8_SB(0, 0), cB, voffB); PG8_STAGE(PG8_SB(0, 1), cB + hstep, voffB); PG8_STAGE(PG8_SA(0, 0), cA, voffA); PG8_STAGE(PG8_SA(0, 1), cA + hstep, voffA);
        if (wr == 1) PG8_BAR;
        PG8_WAIT_V(2); PG8_BAR;
        PG8_STAGE(PG8_SB(1, 0), cB + kstep, voffB); PG8_STAGE(PG8_SA(1, 0), cA + kstep, voffA); PG8_STAGE(PG8_SB(1, 1), cB + hstep + kstep, voffB);
        PG8_WAIT_V(6); PG8_BAR;
    } else {
        PG8_STAGE(PG8_SB(0, 0), cB, voffB); PG8_STAGE(PG8_SA(0, 0), cA, voffA); PG8_STAGE(PG8_SB(0, 1), cB + hstep, voffB); PG8_STAGE(PG8_SA(0, 1), cA + hstep, voffA);
        if (wr == 1) PG8_BAR;
        PG8_WAIT_V(4); PG8_BAR;
        PG8_STAGE(PG8_SB(1, 0), cB + kstep, voffB); PG8_STAGE(PG8_SA(1, 0), cA + kstep, voffA); PG8_STAGE(PG8_SB(1, 1), cB + hstep + kstep, voffB);
        PG8_WAIT_V(6); PG8_BAR;
    }
    for (;;) {
        const bool has_next = S.next(ui + 1, nxt);
        const char* nA = has_next ? (const char*)g.A + (size_t)nxt.pm * tstep : cA; const char* nB = has_next ? (const char*)g.Bt + (size_t)nxt.pn * tstep : cB;
        for (int t = 0; t < nt; t += 2) {
            const bool last = (t == nt - 2);
            const char* a1 = cA + (size_t)(t + 1) * kstep;
            const char* a2 = last ? nA : cA + (size_t)(t + 2) * kstep; const char* b2 = last ? nB : cB + (size_t)(t + 2) * kstep;
            const char* a3 = a2 + kstep; const char* b3 = b2 + kstep;
            if (last && has_next) S.a_ready(nxt);
            if constexpr (SP2) {
            PG8_LDB(B0, 0, 0); PG8_LDB(B1, 0, 1); PG8_SCHED; PG8_LDA(At, 0, 0); PG8_STAGE(PG8_SA(1, 1), a1 + hstep, voffA);
            PG8_WAIT_V(8); PG8_WAIT_L(0); PG8_BAR; PG8_MMA(0, 0, At, B0); PG8_MMA(0, 1, At, B1); PG8_BAR; PG8_SCHED;
            PG8_LDA(At, 0, 1); PG8_STAGE(PG8_SB(0, 0), b2, voffB); PG8_STAGE(PG8_SB(0, 1), b2 + hstep, voffB); PG8_STAGE(PG8_SA(0, 0), a2, voffA);
            PG8_WAIT_V(8); PG8_WAIT_L(0); PG8_BAR; PG8_MMA(1, 0, At, B0); PG8_MMA(1, 1, At, B1); PG8_BAR; PG8_SCHED;
            PG8_LDB(B0, 1, 0); PG8_LDB(B1, 1, 1); PG8_SCHED; PG8_LDA(At, 1, 0); PG8_STAGE(PG8_SA(0, 1), a2 + hstep, voffA);
            PG8_WAIT_V(8); PG8_WAIT_L(0); PG8_BAR; PG8_MMA(0, 0, At, B0); PG8_MMA(0, 1, At, B1); PG8_BAR; PG8_SCHED;
            PG8_LDA(At, 1, 1); PG8_STAGE(PG8_SB(1, 0), b3, voffB); PG8_STAGE(PG8_SB(1, 1), b3 + hstep, voffB); PG8_STAGE(PG8_SA(1, 0), a3, voffA);
            PG8_WAIT_V(8); PG8_WAIT_L(0); PG8_BAR; PG8_MMA(1, 0, At, B0); PG8_MMA(1, 1, At, B1); PG8_BAR; PG8_SCHED;
            } else {
            PG8_LDB(B0, 0, 0); PG8_SCHED; PG8_LDA(At, 0, 0); PG8_STAGE(PG8_SA(1, 1), a1 + hstep, voffA);
            PG8_WAIT_L(8); PG8_BAR; PG8_WAIT_L(0); PG8_MMA(0, 0, At, B0); PG8_BAR; PG8_SCHED;
            PG8_LDB(B1, 0, 1); PG8_STAGE(PG8_SB(0, 0), b2, voffB);
            PG8_BAR; PG8_WAIT_L(0); PG8_MMA(0, 1, At, B1); PG8_BAR;
            PG8_LDA(At, 0, 1); PG8_STAGE(PG8_SA(0, 0), a2, voffA);
            PG8_BAR; PG8_WAIT_L(0); PG8_MMA(1, 0, At, B0); PG8_BAR; PG8_SCHED;
            PG8_STAGE(PG8_SB(0, 1), b2 + hstep, voffB);
            PG8_WAIT_V(6); PG8_BAR; PG8_MMA(1, 1, At, B1); PG8_BAR;
            PG8_LDB(B0, 1, 0); PG8_SCHED; PG8_LDA(At, 1, 0); PG8_STAGE(PG8_SA(0, 1), a2 + hstep, voffA);
            PG8_WAIT_L(8); PG8_BAR; PG8_WAIT_L(0); PG8_MMA(0, 0, At, B0); PG8_BAR; PG8_SCHED;
            PG8_LDB(B1, 1, 1); PG8_STAGE(PG8_SB(1, 0), b3, voffB);
            PG8_BAR; PG8_WAIT_L(0); PG8_MMA(0, 1, At, B1); PG8_BAR;
            PG8_LDA(At, 1, 1); PG8_STAGE(PG8_SA(1, 0), a3, voffA);
            PG8_BAR; PG8_WAIT_L(0); PG8_MMA(1, 0, At, B0); PG8_BAR; PG8_SCHED;
            PG8_STAGE(PG8_SB(1, 1), b3 + hstep, voffB);
            PG8_WAIT_V(6); PG8_BAR; PG8_MMA(1, 1, At, B1); PG8_BAR;
            }
        }
        if constexpr (ALIGN_EPI) { if (wr == 0) PG8_BAR; }
        if constexpr (!Epi::AFTER_DRAIN) { E(acc, cur, wr, wc, fr, fq); S.done(cur); }
        if (!has_next) break;
#pragma unroll
        for (int a = 0; a < 2; ++a)
#pragma unroll
            for (int b = 0; b < 2; ++b)
#pragma unroll
                for (int m = 0; m < 4; ++m)
#pragma unroll
                    for (int n = 0; n < 2; ++n) acc[a][b][m][n] = (f32x4){0.f, 0.f, 0.f, 0.f};
        cur = nxt; cA = nA; cB = nB; ++ui;
        if constexpr (ALIGN_EPI) { if (wr == 1) PG8_BAR; }
    }
    PG8_WAIT_V(0);
    if constexpr (!ALIGN_EPI) { if (wr == 0) PG8_BAR; }
    PG8_BAR;
    if constexpr (Epi::AFTER_DRAIN) { E.fused(acc, cur, wr, wc, fr, fq, lds, wid, lane); S.done(cur); }
#undef PG8_SA
#undef PG8_SB
#undef PG8_STAGE
#undef PG8_LDA
#undef PG8_LDB
#undef PG8_MMA
#undef PG8_WAIT_V
#undef PG8_WAIT_L
#undef PG8_BAR
#undef PG8_SCHED
}
}

#ifndef PG8_SP2
#define PG8_SP2 true
#endif
#ifndef PG8_ALIGN
#define PG8_ALIGN true
#endif
#define GAS __attribute__((address_space(1)))
#define LAS __attribute__((address_space(3)))
typedef unsigned short bf16;
typedef unsigned v4u __attribute__((ext_vector_type(4)));
typedef float f32x4 __attribute__((ext_vector_type(4)));
typedef short bf16x8 __attribute__((ext_vector_type(8)));
typedef GAS unsigned gu32;
typedef GAS unsigned long long gu64;
#define RLX_AGENT __ATOMIC_RELAXED, __HIP_MEMORY_SCOPE_AGENT
#define LDS_WAIT() asm volatile("s_waitcnt lgkmcnt(0)" ::: "memory")
#define VM_WAIT() asm volatile("s_waitcnt vmcnt(0)" ::: "memory")
__device__ __forceinline__ unsigned long long rt() { return __builtin_amdgcn_s_memrealtime(); }
__device__ __forceinline__ unsigned f2bf(float f) { unsigned u = __builtin_bit_cast(unsigned, f); return (u + 0x7fffu + ((u >> 16) & 1u)) >> 16; }
__device__ __forceinline__ unsigned pk2(float lo, float hi) { return f2bf(lo) | (f2bf(hi) << 16); }

#define XB_TMO      128
#define XB_XCNT(j)  (256  + 64 * (j))
#define XB_XSUB(j)  (1280 + 64 * (j))
#define XB_XGEN(j)  (2304 + 64 * (j))
#define XB_TOP      3328
#define XB_TOPGEN   3392
#define XCD_BAR_WORDS 3456
#define XB_SPIN_CAP (1u << 18)

__device__ __forceinline__ unsigned xb_ld(unsigned* p)              { return __hip_atomic_load(p, __ATOMIC_RELAXED, __HIP_MEMORY_SCOPE_AGENT); }
__device__ __forceinline__ unsigned xb_add(unsigned* p, unsigned v) { return __hip_atomic_fetch_add(p, v, __ATOMIC_RELAXED, __HIP_MEMORY_SCOPE_AGENT); }
__device__ __forceinline__ unsigned xb_xcc_id() { return (unsigned)__builtin_amdgcn_s_getreg((3 << 11) | 20) & 0xFu; }
#define XB_SPIN(cond, bar) do { unsigned _sp = 0; while (cond) { __builtin_amdgcn_s_sleep(1); \
    if ((++_sp & 255u) == 0u) { if (xb_ld(&(bar)[XB_TMO])) break; if (_sp > XB_SPIN_CAP) { atomicAdd(&(bar)[XB_TMO], 1u); break; } } } } while (0)

struct XcdBarrier {
    unsigned* bar; unsigned x;
    volatile LAS unsigned* st;
};

__device__ __forceinline__ XcdBarrier xcd_barrier_post(unsigned* bar, volatile LAS unsigned* st) {
    XcdBarrier b; b.bar = bar; b.x = xb_xcc_id(); b.st = st;
    if (threadIdx.x == 0) (void)xb_add(&bar[XB_XCNT(b.x)], 1u);
    return b;
}
__device__ __forceinline__ void xcd_barrier_complete(unsigned* bar, unsigned x, unsigned& nloc, unsigned& nx) {
    const unsigned G = gridDim.x * gridDim.y * gridDim.z;
    unsigned sum, cnt, mine, sp = 0u;
    for (;;) {
        sum = 0u; cnt = 0u; mine = 0u;
#pragma unroll
        for (unsigned j = 0; j < 16; ++j) { const unsigned c = xb_ld(&bar[XB_XCNT(j)]); sum += c; cnt += (c > 0u) ? 1u : 0u; mine = (j == x) ? c : mine; }
        if (sum == G) break;
        __builtin_amdgcn_s_sleep(1);
        if ((++sp & 255u) == 0u) { if (xb_ld(&bar[XB_TMO])) break; if (sp > XB_SPIN_CAP) { atomicAdd(&bar[XB_TMO], 1u); break; } }
    }
    nloc = mine > 0u ? mine : 1u; nx = cnt > 0u ? cnt : 1u;
}

__device__ __forceinline__ void xcd_barrier(const XcdBarrier& b) {
    asm volatile("s_waitcnt vmcnt(0)" ::: "memory");
    __syncthreads();
    if (threadIdx.x == 0) {
        unsigned* bar = b.bar;
        __builtin_amdgcn_s_waitcnt(0);
        unsigned nloc = b.st[0], nx = b.st[1];
        if (nloc == 0u) { xcd_barrier_complete(bar, b.x, nloc, nx); b.st[0] = nloc; b.st[1] = nx; }
        const unsigned old = xb_add(&bar[XB_XSUB(b.x)], 1u);
        const unsigned gen = old / nloc;
        if (old + 1u == (gen + 1u) * nloc) {
            __builtin_amdgcn_fence(__ATOMIC_RELEASE, "agent");
            asm volatile("s_waitcnt vmcnt(0)" ::: "memory");
            const unsigned og = xb_add(&bar[XB_TOP], 1u);
            const unsigned tg = og / nx;
            if (og + 1u == (tg + 1u) * nx) xb_add(&bar[XB_TOPGEN], 1u);
            else XB_SPIN(xb_ld(&bar[XB_TOPGEN]) == tg, bar);
            __builtin_amdgcn_fence(__ATOMIC_ACQUIRE, "agent");
            xb_add(&bar[XB_XGEN(b.x)], 1u);
            asm volatile("s_waitcnt vmcnt(0)" ::: "memory");
        } else {
            XB_SPIN(xb_ld(&bar[XB_XGEN(b.x)]) == gen, bar);
            __builtin_amdgcn_fence(__ATOMIC_ACQUIRE, "agent");
            asm volatile("s_waitcnt vmcnt(0)" ::: "memory");
        }
    }
    __syncthreads();
}
constexpr int NWAVES = 8;
constexpr int B_ = 8, S_ = 2048, T = B_ * S_, D = 1024;
constexpr int INC = 3784;
constexpr int O_Q = 0, O_CKV = 512, O_QI = 640, O_KI = 1152, O_WI = 1216, O_U = 1224, O_G = 1736;
constexpr int NIN = 4352;
constexpr float ALPHA = 1.189207115002721f, LN_EPS = 1e-5f, LOG2E = 1.4426950408889634f;
constexpr int MAXROWS = T * 4 + 32 * 256;
constexpr int TOPK = 256;

constexpr size_t MiB = 1u << 20;
constexpr size_t WS_CTL = 0, CTL_ZERO_BYTES = 1 * MiB;
constexpr size_t WS_MOD = 1 * MiB, WS_WIN = 2 * MiB, WS_WOA = 11 * MiB, WS_WPB = 13 * MiB, WS_WOUT = 14 * MiB, WS_WGU = 16 * MiB, WS_WD = 144 * MiB;
constexpr size_t WS_H = 208 * MiB, WS_QL = 240 * MiB, WS_QI = 272 * MiB, WS_MISC = 288 * MiB, WS_U = 304 * MiB, WS_SG = 320 * MiB;
constexpr size_t WS_CKV = 384 * MiB, WS_CKVT = 388 * MiB, WS_POOLED = 392 * MiB, WS_MASK = 408 * MiB, WS_OLAT = 412 * MiB, WS_TMP = 444 * MiB, WS_MIX = 476 * MiB;
constexpr size_t WS_Z = 508 * MiB, WS_X1 = 572 * MiB, WS_SLOTMAP = 636 * MiB, WS_TOKSLOT = 638 * MiB, WS_GATE = 638 * MiB + 512 * 1024;
constexpr size_t WS_XPAD = 640 * MiB, WS_ACT = 784 * MiB, WS_Y = WS_XPAD, WS_SEL = 928 * MiB, WS_CNT = 944 * MiB, WS_END = 945 * MiB;
constexpr int CW_GCNT = 0, CW_TSTART = 64, CW_BAR = 4096;

constexpr int RING_OFF = 0, RING_BYTES = 131072;
constexpr int LDSCTL_OFF = RING_BYTES, MISC_OFF = LDSCTL_OFF + 320;
constexpr int LDS_BYTES = 147456;

struct Frame {
    LAS unsigned char* lds;
    volatile LAS unsigned* MISCW;
    gu32* ctl;
    int tid, lane, wave, vcu, G;
    unsigned char* ws;
    float* out;
};
__device__ __forceinline__ const float* frame_in(int i) { const char* ka = (const char*)__builtin_amdgcn_kernarg_segment_ptr(); asm volatile("" : "+s"(ka)); return *(const float* const*)(ka + 8 * i); }
typedef __bf16 bf2v __attribute__((ext_vector_type(2)));
typedef float f2v __attribute__((ext_vector_type(2)));
__device__ __forceinline__ unsigned pkbf(float a, float b) { f2v v = {a, b}; bf2v r = __builtin_convertvector(v, bf2v); return __builtin_bit_cast(unsigned, r); }
__device__ __forceinline__ float bf2f(unsigned short u) { return __uint_as_float((unsigned)u << 16); }
__device__ __forceinline__ float sigm_fast(float x) { return __builtin_amdgcn_rcpf(1.f + __builtin_amdgcn_exp2f(-x * LOG2E)); }

namespace pg8 {
struct EpiInProj {
    static constexpr bool PERM = true, AFTER_DRAIN = false;
    bf16_t *QL, *QI, *U, *SG; float* MISC;
    __device__ __forceinline__ void operator()(const f32x4 (&acc)[2][2][4][2], const Unit& u, int wr, int wc, int fr, int fq) const {
        const int row0 = u.pm * BM + wr * 64 + fr, c0 = wc * 32 + 8 * fq; const int pn = u.pn;
        if (pn == 6) {
#pragma unroll
            for (int ai = 0; ai < 2; ++ai)
#pragma unroll
                for (int m = 0; m < 4; ++m) { float* rowp = MISC + (size_t)(row0 + ai * HALF + m * 16) * 256 + c0;
#pragma unroll
                    for (int bj = 0; bj < 2; ++bj) { *(f32x4*)(rowp + bj * HALF) = acc[ai][bj][m][0]; *(f32x4*)(rowp + bj * HALF + 4) = acc[ai][bj][m][1]; } }
        } else {
            bf16_t* base; int ld, colt; bool sg = false;
            if (pn < 4) { base = QL; ld = 1024; colt = pn * 256; }
            else if (pn < 6) { base = QI; ld = 512; colt = (pn - 4) * 256; }
            else if (pn < 9) { base = U; ld = 512; colt = (pn - 7) * 256; }
            else { base = SG; ld = 2048; colt = (pn - 9) * 256; sg = true; }
#pragma unroll
            for (int ai = 0; ai < 2; ++ai)
#pragma unroll
                for (int m = 0; m < 4; ++m) { bf16_t* rowp = base + (size_t)(row0 + ai * HALF + m * 16) * ld + colt + c0;
#pragma unroll
                    for (int bj = 0; bj < 2; ++bj) { f32x4 v0 = acc[ai][bj][m][0], v1 = acc[ai][bj][m][1];
                        if (sg) {
#pragma unroll
                            for (int i = 0; i < 4; ++i) { v0[i] = sigm_fast(v0[i]); v1[i] = sigm_fast(v1[i]); } }
                        u32x4 w; w.x = cvt_pk_bf16(v0[0], v0[1]); w.y = cvt_pk_bf16(v0[2], v0[3]); w.z = cvt_pk_bf16(v1[0], v1[1]); w.w = cvt_pk_bf16(v1[2], v1[3]);
                        *(u32x4*)(rowp + bj * HALF) = w; } }
        }
    }
};
}

__device__ __forceinline__ void tr_item(const float* W, int ldw, int k0, int n0, int ncols, float scale, bf16* WT, int ldt, int drow0, LAS float* scr, int lane) {
    const int nn = lane & 31;
#pragma unroll 8
    for (int i = 0; i < 32; ++i) { const int kk = 2 * i + (lane >> 5); scr[kk * 33 + nn] = (nn < ncols) ? W[(size_t)(k0 + kk) * ldw + n0 + nn] * scale : 0.f; }
    LDS_WAIT(); asm volatile("" ::: "memory");
    const int c = lane & 7;
#pragma unroll
    for (int j = 0; j < 4; ++j) { const int n = (lane >> 3) + 8 * j; const LAS float* s = scr + (8 * c) * 33 + n;
        v4u o; o.x = pk2(s[0 * 33], s[1 * 33]); o.y = pk2(s[2 * 33], s[3 * 33]); o.z = pk2(s[4 * 33], s[5 * 33]); o.w = pk2(s[6 * 33], s[7 * 33]);
        if (n < ncols) *(GAS v4u*)(WT + (size_t)(drow0 + n) * ldt + k0 + 8 * c) = o; }
    LDS_WAIT(); asm volatile("" ::: "memory");
}
__device__ __forceinline__ void tr64_item(const float* W, int ldw, int k0, int n0, float scale, bf16* WT, int ldt, int drow0, LAS unsigned char* scr, int lane) {
    const int kr = lane >> 4, nc = lane & 15;
    const float* src = W + (size_t)(k0 + 16 * kr) * ldw + n0 + 4 * nc;
    f32x4 v[16];
#pragma unroll
    for (int i = 0; i < 16; ++i) v[i] = *(const f32x4*)(src + (size_t)i * ldw);
#pragma unroll
    for (int j = 0; j < 4; ++j) { const int n = 4 * nc + j; const int f = (n >> 2) & 7;
#pragma unroll
        for (int hlf = 0; hlf < 2; ++hlf) { v4u o;
            o.x = pkbf(v[8 * hlf + 0][j] * scale, v[8 * hlf + 1][j] * scale); o.y = pkbf(v[8 * hlf + 2][j] * scale, v[8 * hlf + 3][j] * scale);
            o.z = pkbf(v[8 * hlf + 4][j] * scale, v[8 * hlf + 5][j] * scale); o.w = pkbf(v[8 * hlf + 6][j] * scale, v[8 * hlf + 7][j] * scale);
            *(LAS v4u*)(scr + n * 128 + (((2 * kr + hlf) ^ f) << 4)) = o; } }
    LDS_WAIT(); asm volatile("" ::: "memory");
    const int kc = lane & 7;
#pragma unroll
    for (int j = 0; j < 8; ++j) { const int n = (lane >> 3) + 8 * j; const v4u o = *(const LAS v4u*)(scr + n * 128 + ((kc ^ ((n >> 2) & 7)) << 4));
        *(GAS v4u*)(WT + (size_t)(drow0 + n) * ldt + k0 + 8 * kc) = o; }
    LDS_WAIT(); asm volatile("" ::: "memory");
}
__device__ __forceinline__ void fold_qlat(const float* w_in, const float* w_uk, bf16* Win_t, int task, int lane) {
    const int h = task >> 8, kb = (task >> 4) & 15, r0 = (task & 15) * 8; const int k = kb * 64 + lane;
    const float* wrow = w_in + (size_t)k * INC + O_Q + h * 64; const float* up = w_uk + r0 * 512 + h * 64;
    float a[8] = {0, 0, 0, 0, 0, 0, 0, 0};
#pragma unroll 4
    for (int d4 = 0; d4 < 16; ++d4) { const f32x4 v = *(const f32x4*)(wrow + 4 * d4);
#pragma unroll
        for (int j = 0; j < 8; ++j) { const f32x4 u = *(const f32x4*)(up + j * 512 + 4 * d4); a[j] += (v.x * u.x + v.y * u.y) + (v.z * u.z + v.w * u.w); } }
#pragma unroll
    for (int j = 0; j < 8; ++j) Win_t[(size_t)(h * 128 + r0 + j) * 1024 + k] = (bf16)f2bf(a[j] * (0.125f * LOG2E));
}
__device__ __forceinline__ void fold_oa(const float* w_uv, const float* w_ba, bf16* Woa_t, int task, int lane) {
    const int h = task >> 8, nb = (task >> 4) & 15, r0 = (task & 15) * 8; const int n = nb * 64 + lane;
    const float* up = w_uv + r0 * 512 + h * 64; float a[8] = {0, 0, 0, 0, 0, 0, 0, 0};
#pragma unroll 4
    for (int d4 = 0; d4 < 16; ++d4) { float v[4];
#pragma unroll
        for (int i = 0; i < 4; ++i) v[i] = w_ba[(size_t)(h * 64 + 4 * d4 + i) * 1024 + n];
#pragma unroll
        for (int j = 0; j < 8; ++j) { const f32x4 u = *(const f32x4*)(up + j * 512 + 4 * d4); a[j] += (v[0] * u.x + v[1] * u.y) + (v[2] * u.z + v[3] * u.w); } }
    v4u o; o.x = pk2(a[0], a[1]); o.y = pk2(a[2], a[3]); o.z = pk2(a[4], a[5]); o.w = pk2(a[6], a[7]);
    *(GAS v4u*)(Woa_t + (size_t)n * 1024 + h * 128 + r0) = o;
}
__device__ __forceinline__ void fold_pb(const float* w_pg, const float* pscale, const float* w_bp, bf16* Wpb_t, int task, int lane) {
    const int g = task >> 8, nb = (task >> 4) & 15, c0 = (task & 15) * 8; const int n = nb * 64 + lane;
    const float* pg = w_pg + (size_t)g * 16384 + c0 * 128; float a[8] = {0, 0, 0, 0, 0, 0, 0, 0};
#pragma unroll 4
    for (int d4 = 0; d4 < 32; ++d4) { float v[4]; const f32x4 ps = *(const f32x4*)(pscale + g * 128 + 4 * d4);
#pragma unroll
        for (int i = 0; i < 4; ++i) v[i] = w_bp[(size_t)(g * 128 + 4 * d4 + i) * 1024 + n] * ps[i];
#pragma unroll
        for (int j = 0; j < 8; ++j) { const f32x4 u = *(const f32x4*)(pg + j * 128 + 4 * d4); a[j] += (v[0] * u.x + v[1] * u.y) + (v[2] * u.z + v[3] * u.w); } }
    v4u o; o.x = pk2(a[0], a[1]); o.y = pk2(a[2], a[3]); o.z = pk2(a[4], a[5]); o.w = pk2(a[6], a[7]);
    *(GAS v4u*)(Wpb_t + (size_t)n * 512 + g * 128 + c0) = o;
}
__device__ __forceinline__ void p0_prologue(Frame& F) {
    const float* c = frame_in(1); const float* w_ada = frame_in(2); const float* b_ada = frame_in(3); const float* w_in = frame_in(4);
    const float* w_uk = frame_in(6); const float* w_uv = frame_in(7); const float* w_pg = frame_in(8); const float* pscale = frame_in(9);
    const float* w_ba = frame_in(10); const float* w_bp = frame_in(11); const float* w_out = frame_in(12); const float* w_gu = frame_in(17); const float* w_d = frame_in(19);
    bf16* Win_t = (bf16*)(F.ws + WS_WIN); bf16* Woa_t = (bf16*)(F.ws + WS_WOA); bf16* Wpb_t = (bf16*)(F.ws + WS_WPB); bf16* Wout_t = (bf16*)(F.ws + WS_WOUT);
    bf16* Wgu_t = (bf16*)(F.ws + WS_WGU); bf16* Wd_t = (bf16*)(F.ws + WS_WD); float* MOD = (float*)(F.ws + WS_MOD);
    for (int cg = blockIdx.x; cg < 96; cg += F.G) {
        LAS float* cs = (LAS float*)(F.lds + 69632); LAS float* red = (LAS float*)(F.lds + 69632 + 32768);
        for (int i = F.tid; i < 8192; i += 512) { const float v = c[i]; cs[i] = v / (1.f + __expf(-v)); }
        __syncthreads();
        float acc[8] = {0, 0, 0, 0, 0, 0, 0, 0}; const int n = cg * 64 + F.lane;
        for (int k = F.wave * 128; k < F.wave * 128 + 128; ++k) { const float w = w_ada[(size_t)k * 6144 + n];
#pragma unroll
            for (int b = 0; b < 8; ++b) acc[b] += cs[b * 1024 + k] * w; }
#pragma unroll
        for (int b = 0; b < 8; ++b) red[(F.wave * 8 + b) * 64 + F.lane] = acc[b];
        __syncthreads();
        { const int b = F.tid >> 6, l = F.tid & 63; float s = 0.f;
#pragma unroll
          for (int w = 0; w < 8; ++w) s += red[(w * 8 + b) * 64 + l];
          MOD[b * 6144 + cg * 64 + l] = s + b_ada[cg * 64 + l]; }
        __syncthreads();
    }
    LAS unsigned char* scr8 = F.lds + F.wave * 8448; LAS float* scr = (LAS float*)scr8;
    const int gw = F.vcu * NWAVES + F.wave, NGW = F.G * NWAVES;
    constexpr int I_FQ = 2048, I_FO = 2048, I_FP = 1024, I_Z = 56, I_WI = 16;
    constexpr int I_QI = 128, I_CKV = 32, I_KI = 16, I_U = 128, I_G = 512, I_OUT = 256, I_GU = 32 * 512, I_D = 32 * 256;
    constexpr int NITEMS = I_FQ + I_FO + I_FP + I_Z + I_WI + I_QI + I_CKV + I_KI + I_U + I_G + I_OUT + I_GU + I_D;
    for (int it = gw; it < NITEMS; it += NGW) {
        int r = it;
        if (r < I_FQ) { fold_qlat(w_in, w_uk, Win_t, r, F.lane); continue; } r -= I_FQ;
        if (r < I_FO) { fold_oa(w_uv, w_ba, Woa_t, r, F.lane); continue; } r -= I_FO;
        if (r < I_FP) { fold_pb(w_pg, pscale, w_bp, Wpb_t, r, F.lane); continue; } r -= I_FP;
        if (r < I_Z) { GAS v4u* z = (GAS v4u*)(Win_t + (size_t)(1736 + r) * 1024); z[F.lane] = (v4u){0u, 0u, 0u, 0u}; z[F.lane + 64] = (v4u){0u, 0u, 0u, 0u}; continue; } r -= I_Z;
        if (r < I_WI) { tr_item(w_in, INC, r * 64, O_WI, 8, 0.35355339059327373f, Win_t, 1024, 1728, scr, F.lane); continue; } r -= I_WI;
        if (r < I_QI) { tr64_item(w_in, INC, (r >> 3) * 64, O_QI + (r & 7) * 64, 0.125f, Win_t, 1024, 1024 + (r & 7) * 64, scr8, F.lane); continue; } r -= I_QI;
        if (r < I_CKV) { tr64_item(w_in, INC, (r >> 1) * 64, O_CKV + (r & 1) * 64, 1.f, Win_t, 1024, 1536 + (r & 1) * 64, scr8, F.lane); continue; } r -= I_CKV;
        if (r < I_KI) { tr64_item(w_in, INC, r * 64, O_KI, 1.f, Win_t, 1024, 1664, scr8, F.lane); continue; } r -= I_KI;
        if (r < I_U) { tr64_item(w_in, INC, (r >> 3) * 64, O_U + (r & 7) * 64, 1.f, Win_t, 1024, 1792 + (r & 7) * 64, scr8, F.lane); continue; } r -= I_U;
        if (r < I_G) { tr64_item(w_in, INC, (r >> 5) * 64, O_G + (r & 31) * 64, 1.f, Win_t, 1024, 2304 + (r & 31) * 64, scr8, F.lane); continue; } r -= I_G;
        if (r < I_OUT) { tr64_item(w_out, 1024, (r >> 4) * 64, (r & 15) * 64, 1.f, Wout_t, 1024, (r & 15) * 64, scr8, F.lane); continue; } r -= I_OUT;
        if (r < I_GU) { const int e = r >> 9, q = r & 511, kb = q >> 5, ng = q & 31; const int n0 = ng * 64;
            const int drow = (n0 < 1024) ? ((n0 >> 7) * 256 + (n0 & 127)) : (((n0 - 1024) >> 7) * 256 + 128 + ((n0 - 1024) & 127));
            tr64_item(w_gu + (size_t)e * 1024 * 2048, 2048, kb * 64, n0, 1.f, Wgu_t + (size_t)e * 2048 * 1024, 1024, drow, scr8, F.lane); continue; } r -= I_GU;
        { const int e = r >> 8, q = r & 255, kb = q >> 4, ng = q & 15;
          tr64_item(w_d + (size_t)e * 1024 * 1024, 1024, kb * 64, ng * 64, 1.f, Wd_t + (size_t)e * 1024 * 1024, 1024, ng * 64, scr8, F.lane); }
    }
}
__device__ __forceinline__ void p1_modulate(Frame& F) {
    const float* x = frame_in(0); const float* MOD = (const float*)(F.ws + WS_MOD); bf16* H = (bf16*)(F.ws + WS_H);
    const int gw = F.vcu * NWAVES + F.wave, NGW = F.G * NWAVES;
    for (int m = gw; m < T; m += NGW) { const int b = m >> 11;
        const GAS f32x4* xr = (const GAS f32x4*)(x + (size_t)m * D) + F.lane; GAS unsigned long long* o8 = (GAS unsigned long long*)(H + (size_t)m * D) + F.lane;
#pragma unroll
        for (int j = 0; j < 4; ++j) { const f32x4 v = xr[64 * j]; const int col = 4 * F.lane + 256 * j;
            const f32x4 sh = *(const f32x4*)(MOD + b * 6144 + col), sc = *(const f32x4*)(MOD + b * 6144 + 1024 + col);
            const f32x4 h = v * (sc + 1.0f) + sh;
            o8[64 * j] = (unsigned long long)pk2(h.x, h.y) | ((unsigned long long)pk2(h.z, h.w) << 32); }
    }
}
constexpr int LC_LCNT = LDSCTL_OFF + 1024, LC_BASE = LDSCTL_OFF + 1280, LC_TSTART = LDSCTL_OFF + 1536, LC_LIST = LDSCTL_OFF + 4096;
namespace pg8 {
__device__ __forceinline__ float bfl(unsigned w) { return __uint_as_float(w << 16); }
__device__ __forceinline__ float bfh(unsigned w) { return __uint_as_float(w & 0xffff0000u); }
struct EpiGateMul {
    static constexpr bool PERM = true, AFTER_DRAIN = false;
    bf16_t* O; const bf16_t* SG; int goff, pad;
    __device__ __forceinline__ void operator()(const f32x4 (&acc)[2][2][4][2], const Unit& u, int wr, int wc, int fr, int fq) const {
        const int row0 = u.pm * BM + wr * 64 + fr, col0 = u.pn * BM + wc * 32 + 8 * fq;
#pragma unroll
        for (int ai = 0; ai < 2; ++ai)
#pragma unroll
            for (int m = 0; m < 4; ++m) { const size_t row = (size_t)(row0 + ai * HALF + m * 16);
#pragma unroll
                for (int bj = 0; bj < 2; ++bj) { const u32x4 g = *(const u32x4*)(SG + row * 2048 + goff + col0 + bj * HALF); const f32x4 v0 = acc[ai][bj][m][0], v1 = acc[ai][bj][m][1];
                    u32x4 w; w.x = cvt_pk_bf16(v0[0] * bfl(g.x), v0[1] * bfh(g.x)); w.y = cvt_pk_bf16(v0[2] * bfl(g.y), v0[3] * bfh(g.y));
                    w.z = cvt_pk_bf16(v1[0] * bfl(g.z), v1[1] * bfh(g.z)); w.w = cvt_pk_bf16(v1[2] * bfl(g.w), v1[3] * bfh(g.w));
                    *(u32x4*)(O + row * 1024 + col0 + bj * HALF) = w; } }
    }
};
struct EpiGateAdd {
    static constexpr bool PERM = true, AFTER_DRAIN = false;
    bf16_t* O; const bf16_t* TMPB; const bf16_t* SG; int goff, pad;
    __device__ __forceinline__ void operator()(const f32x4 (&acc)[2][2][4][2], const Unit& u, int wr, int wc, int fr, int fq) const {
        const int row0 = u.pm * BM + wr * 64 + fr, col0 = u.pn * BM + wc * 32 + 8 * fq;
#pragma unroll
        for (int ai = 0; ai < 2; ++ai)
#pragma unroll
            for (int m = 0; m < 4; ++m) { const size_t row = (size_t)(row0 + ai * HALF + m * 16);
#pragma unroll
                for (int bj = 0; bj < 2; ++bj) { const u32x4 g = *(const u32x4*)(SG + row * 2048 + goff + col0 + bj * HALF); const u32x4 t = *(const u32x4*)(TMPB + row * 1024 + col0 + bj * HALF);
                    const f32x4 v0 = acc[ai][bj][m][0], v1 = acc[ai][bj][m][1];
                    u32x4 w; w.x = cvt_pk_bf16(bfl(t.x) + v0[0] * bfl(g.x), bfh(t.x) + v0[1] * bfh(g.x)); w.y = cvt_pk_bf16(bfl(t.y) + v0[2] * bfl(g.y), bfh(t.y) + v0[3] * bfh(g.y));
                    w.z = cvt_pk_bf16(bfl(t.z) + v1[0] * bfl(g.z), bfh(t.z) + v1[1] * bfh(g.z)); w.w = cvt_pk_bf16(bfl(t.w) + v1[2] * bfl(g.w), bfh(t.w) + v1[3] * bfh(g.w));
                    *(u32x4*)(O + row * 1024 + col0 + bj * HALF) = w; } }
    }
};
struct EpiResid {
    static constexpr bool PERM = false, AFTER_DRAIN = false;
    float* Z; const float* x; const float* gate;
    __device__ __forceinline__ void operator()(const f32x4 (&acc)[2][2][4][2], const Unit& u, int wr, int wc, int fr, int fq) const {
        const int row0 = u.pm * BM + wr * 64 + fr, col0 = u.pn * BM + wc * 32 + 4 * fq; const int b = (u.pm * BM) >> 11;
        f32x4 gv[2][2];
#pragma unroll
        for (int bj = 0; bj < 2; ++bj)
#pragma unroll
            for (int n = 0; n < 2; ++n) gv[bj][n] = *(const f32x4*)(gate + b * 6144 + col0 + bj * HALF + n * 16);
#pragma unroll
        for (int ai = 0; ai < 2; ++ai)
#pragma unroll
            for (int m = 0; m < 4; ++m) { const size_t off = (size_t)(row0 + ai * HALF + m * 16) * 1024 + col0;
#pragma unroll
                for (int bj = 0; bj < 2; ++bj)
#pragma unroll
                    for (int n = 0; n < 2; ++n) { const f32x4 xv = *(const f32x4*)(x + off + bj * HALF + n * 16); *(f32x4*)(Z + off + bj * HALF + n * 16) = xv * ALPHA + gv[bj][n] * acc[ai][bj][m][n]; } }
    }
};
struct EpiSwiglu {
    static constexpr bool PERM = true, AFTER_DRAIN = false;
    bf16_t* ACT; const float* bgu;
    __device__ __forceinline__ void operator()(const f32x4 (&acc)[2][2][4][2], const Unit& u, int wr, int wc, int fr, int fq) const {
        const int e = u.pn >> 3, j = u.pn & 7; const int row0 = u.pm * BM + wr * 64 + fr, cc = wc * 32 + 8 * fq;
        const float* bg = bgu + e * 2048 + j * 128 + cc; f32x4 bgl[2], bli[2];
#pragma unroll
        for (int n = 0; n < 2; ++n) { bgl[n] = *(const f32x4*)(bg + 4 * n); bli[n] = *(const f32x4*)(bg + 1024 + 4 * n); }
#pragma unroll
        for (int ai = 0; ai < 2; ++ai)
#pragma unroll
            for (int m = 0; m < 4; ++m) { float o[8];
#pragma unroll
                for (int n = 0; n < 2; ++n) { const f32x4 gl4 = acc[ai][0][m][n] + bgl[n], li4 = acc[ai][1][m][n] + bli[n];
#pragma unroll
                    for (int i = 0; i < 4; ++i) { const float gl = fminf(gl4[i], 7.f), li = fminf(fmaxf(li4[i], -7.f), 7.f);
                        o[4 * n + i] = gl * __builtin_amdgcn_rcpf(1.f + __builtin_amdgcn_exp2f(gl * (-1.702f * LOG2E))) * (li + 1.f); } }
                u32x4 w; w.x = cvt_pk_bf16(o[0], o[1]); w.y = cvt_pk_bf16(o[2], o[3]); w.z = cvt_pk_bf16(o[4], o[5]); w.w = cvt_pk_bf16(o[6], o[7]);
                *(u32x4*)(ACT + (size_t)(row0 + ai * HALF + m * 16) * 1024 + j * 128 + cc) = w; }
    }
};
struct EpiDown {
    static constexpr bool PERM = true, AFTER_DRAIN = false;
    bf16_t* Y; const float* bd;
    __device__ __forceinline__ void operator()(const f32x4 (&acc)[2][2][4][2], const Unit& u, int wr, int wc, int fr, int fq) const {
        const int e = u.pn >> 2, j = u.pn & 3; const int row0 = u.pm * BM + wr * 64 + fr, col0 = j * 256 + wc * 32 + 8 * fq;
        f32x4 bv[2][2];
#pragma unroll
        for (int bj = 0; bj < 2; ++bj)
#pragma unroll
            for (int n = 0; n < 2; ++n) bv[bj][n] = *(const f32x4*)(bd + e * 1024 + col0 + bj * HALF + 4 * n);
#pragma unroll
        for (int ai = 0; ai < 2; ++ai)
#pragma unroll
            for (int m = 0; m < 4; ++m) { bf16_t* rowp = Y + (size_t)(row0 + ai * HALF + m * 16) * 1024 + col0;
#pragma unroll
                for (int bj = 0; bj < 2; ++bj) { const f32x4 v0 = acc[ai][bj][m][0] + bv[bj][0], v1 = acc[ai][bj][m][1] + bv[bj][1];
                    u32x4 w; w.x = cvt_pk_bf16(v0[0], v0[1]); w.y = cvt_pk_bf16(v0[2], v0[3]); w.z = cvt_pk_bf16(v1[0], v1[1]); w.w = cvt_pk_bf16(v1[2], v1[3]);
                    *(u32x4*)(rowp + bj * HALF) = w; } }
    }
};
struct MoeOrder {
    const PG8_LAS int* tstart; int NT, G, c;
    __device__ __forceinline__ bool next(int i, Unit& u) const {
        const int L = i * G + c; if (L >= tstart[32] * NT) return false;
        int e = 0; while (e < 31 && tstart[e + 1] * NT <= L) ++e;
        const int loc = L - tstart[e] * NT, nte = tstart[e + 1] - tstart[e];
        u.pm = tstart[e] + loc % nte; u.pn = e * NT + loc / nte; return true;
    }
    __device__ __forceinline__ void a_ready(const Unit&) const {}
    __device__ __forceinline__ void done(const Unit&) const {}
};
}

__device__ __forceinline__ float wave_sum(float v) {
#pragma unroll
    for (int o = 1; o < 64; o <<= 1) v += __shfl_xor(v, o);
    return v;
}
__device__ __forceinline__ void p3_post(Frame& F) {
    const float* MISC = (const float*)(F.ws + WS_MISC); const float* kvg = frame_in(5); bf16* CKV = (bf16*)(F.ws + WS_CKV); bf16* CKVT = (bf16*)(F.ws + WS_CKVT);
    const bf16* U = (const bf16*)(F.ws + WS_U); bf16* POOLED = (bf16*)(F.ws + WS_POOLED);
    LAS bf16* tile = (LAS bf16*)(F.lds);
    for (int task = blockIdx.x; task < 256; task += F.G) {
        const int t0 = task * 64; const int row = F.tid >> 3, seg = F.tid & 7;
        const float* src = MISC + (size_t)(t0 + row) * 256 + seg * 16; f32x4 v[4]; float ss = 0.f;
#pragma unroll
        for (int i = 0; i < 4; ++i) { v[i] = *(const f32x4*)(src + 4 * i); ss += (v[i].x * v[i].x + v[i].y * v[i].y) + (v[i].z * v[i].z + v[i].w * v[i].w); }
        ss += __shfl_xor(ss, 1); ss += __shfl_xor(ss, 2); ss += __shfl_xor(ss, 4);
        const float rs = 1.0f / sqrtf(ss * (1.f / 128.f) + LN_EPS);
        unsigned w[8];
#pragma unroll
        for (int i = 0; i < 4; ++i) { const f32x4 g = *(const f32x4*)(kvg + seg * 16 + 4 * i); w[2 * i] = pk2(v[i].x * rs * g.x, v[i].y * rs * g.y); w[2 * i + 1] = pk2(v[i].z * rs * g.z, v[i].w * rs * g.w); }
        GAS v4u* dst = (GAS v4u*)(CKV + (size_t)(t0 + row) * 128 + seg * 16); dst[0] = (v4u){w[0], w[1], w[2], w[3]}; dst[1] = (v4u){w[4], w[5], w[6], w[7]};
        LAS v4u* lt = (LAS v4u*)(tile + row * 128 + seg * 16); lt[0] = (v4u){w[0], w[1], w[2], w[3]}; lt[1] = (v4u){w[4], w[5], w[6], w[7]};
        __syncthreads();
        { const int d = F.tid >> 2, part = F.tid & 3; unsigned o[8];
#pragma unroll
          for (int q = 0; q < 16; q += 2) { unsigned pr[2];
#pragma unroll
              for (int z = 0; z < 2; ++z) { const int p = part * 16 + q + z; const int j = p & 7, h = (p >> 3) & 1, tt = (p >> 4) & 1, kb = p >> 5; const int key = kb * 32 + 16 * tt + 8 * (j >> 2) + 4 * h + (j & 3); pr[z] = tile[key * 128 + d]; }
              o[q >> 1] = pr[0] | (pr[1] << 16); }
          const int b = task >> 5, kt = task & 31;
          GAS v4u* dt = (GAS v4u*)(CKVT + ((size_t)(b * 128 + d) * 2048) + kt * 64 + part * 16); dt[0] = (v4u){o[0], o[1], o[2], o[3]}; dt[1] = (v4u){o[4], o[5], o[6], o[7]}; }
        __syncthreads();
    }
    for (int task = blockIdx.x; task < 256; task += F.G) {
        const int c = F.tid, g = c >> 7, w = 2 << g; const int t0 = task * 64, s0 = t0 & 2047; const bf16* up = U + (size_t)(t0 - s0) * 512 + c;
        float win = 0.f; { const int lo = (s0 - w) < 0 ? 0 : (s0 - w); for (int sp = lo; sp < s0; ++sp) win += bf2f(up[(size_t)sp * 512]); }
        for (int s = s0; s < s0 + 64; ++s) { const float cur = bf2f(up[(size_t)s * 512]); win += cur; if (s - w >= 0) win -= bf2f(up[(size_t)(s - w) * 512]);
            const int cntw = (s + 1 < w) ? (s + 1) : w; POOLED[(size_t)(t0 - s0 + s) * 512 + c] = (bf16)f2bf(win / (float)cntw - cur); }
    }
}
__device__ __forceinline__ void p7_ln1_route(Frame& F) {
    const float* Z = (const float*)(F.ws + WS_Z); const float* g1 = frame_in(13); const float* b1 = frame_in(14); const float* w_r = frame_in(15); const float* b_r = frame_in(16);
    const float* MOD = (const float*)(F.ws + WS_MOD); float* X1 = (float*)(F.ws + WS_X1); bf16* H2 = (bf16*)(F.ws + WS_H);
    int* gcnt = (int*)(F.ctl + CW_GCNT); int* SLOTMAP = (int*)(F.ws + WS_SLOTMAP); int* TOKSLOT = (int*)(F.ws + WS_TOKSLOT); float* GATE = (float*)(F.ws + WS_GATE);
    LAS float* WrL = (LAS float*)(F.lds);
    LAS int* lcnt = (LAS int*)(F.lds + LC_LCNT); LAS int* lbase = (LAS int*)(F.lds + LC_BASE); LAS int* list = (LAS int*)(F.lds + LC_LIST);
    for (int s = F.tid; s < 32768; s += 512) { const int col = s >> 5, e = s & 31; const int j = col >> 8, l = (col & 255) >> 2, i = col & 3; WrL[((((j * 4 + i) * 8 + (e >> 2)) * 64 + l) << 2) + (e & 3)] = w_r[s]; }
    if (F.tid < 32) lcnt[F.tid] = 0;
    __syncthreads();
    const int gw = F.vcu * NWAVES + F.wave, NGW = F.G * NWAVES;
    int it = 0;
    for (int m = gw; m < T; m += NGW, ++it) { const int b = m >> 11;
        const GAS f32x4* zr = (const GAS f32x4*)(Z + (size_t)m * D) + F.lane; f32x4 v[4]; float s = 0.f;
#pragma unroll
        for (int j = 0; j < 4; ++j) { v[j] = zr[64 * j]; s += (v[j].x + v[j].y) + (v[j].z + v[j].w); }
        const float mean = wave_sum(s) * (1.f / D); float s2 = 0.f;
#pragma unroll
        for (int j = 0; j < 4; ++j) { v[j] = v[j] - mean; s2 += (v[j].x * v[j].x + v[j].y * v[j].y) + (v[j].z * v[j].z + v[j].w * v[j].w); }
        const float rstd = 1.f / sqrtf(wave_sum(s2) * (1.f / D) + LN_EPS);
        float acc[32];
#pragma unroll
        for (int e = 0; e < 32; ++e) acc[e] = 0.f;
#pragma unroll
        for (int j = 0; j < 4; ++j) { const int col = 4 * F.lane + 256 * j;
            const f32x4 gg = *(const f32x4*)(g1 + col), bb = *(const f32x4*)(b1 + col); const f32x4 x1 = v[j] * rstd * gg + bb;
            *((GAS f32x4*)(X1 + (size_t)m * D) + F.lane + 64 * j) = x1;
            const f32x4 sh = *(const f32x4*)(MOD + b * 6144 + 3 * 1024 + col), sc = *(const f32x4*)(MOD + b * 6144 + 4 * 1024 + col); const f32x4 h2 = x1 * (sc + 1.0f) + sh;
            *((GAS unsigned long long*)(H2 + (size_t)m * D) + F.lane + 64 * j) = (unsigned long long)pk2(h2.x, h2.y) | ((unsigned long long)pk2(h2.z, h2.w) << 32);
#pragma unroll
            for (int i = 0; i < 4; ++i) { const float hv = h2[i];
#pragma unroll
                for (int e4 = 0; e4 < 8; ++e4) { const f32x4 w4 = *(const LAS f32x4*)(WrL + ((((j * 4 + i) * 8 + e4) * 64 + F.lane) << 2));
                    acc[4 * e4] += hv * w4.x; acc[4 * e4 + 1] += hv * w4.y; acc[4 * e4 + 2] += hv * w4.z; acc[4 * e4 + 3] += hv * w4.w; } } }
#pragma unroll
        for (int e = 0; e < 32; ++e) acc[e] = wave_sum(acc[e]) + b_r[e];
        int se[4]; float sv[4]; unsigned used = 0u;
#pragma unroll
        for (int k = 0; k < 4; ++k) { int best = 0; float bv = -INFINITY; bool have = false;
#pragma unroll
            for (int e = 0; e < 32; ++e) { const bool ok = !((used >> e) & 1u) && (!have || acc[e] > bv); if (ok) { best = e; bv = acc[e]; have = true; } }
            se[k] = best; sv[k] = bv; used |= 1u << best; }
        float ex[4], den = 0.f;
#pragma unroll
        for (int k = 0; k < 4; ++k) { ex[k] = __expf(sv[k] - sv[0]); den += ex[k]; }
        const float inv = 1.f / den;
        if (F.lane < 4) { int e = se[0]; float gt = ex[0];
            if (F.lane == 1) { e = se[1]; gt = ex[1]; } else if (F.lane == 2) { e = se[2]; gt = ex[2]; } else if (F.lane == 3) { e = se[3]; gt = ex[3]; }
            const int lr = __hip_atomic_fetch_add(&lcnt[e], 1, __ATOMIC_RELAXED, __HIP_MEMORY_SCOPE_WORKGROUP);
            LAS int* ent = list + ((F.wave * 8 + it) * 4 + F.lane) * 4; ent[0] = m; ent[1] = e; ent[2] = lr; ent[3] = __float_as_int(gt * inv); }
    }
    __syncthreads();
    if (F.tid < 32) lbase[F.tid] = atomicAdd(&gcnt[F.tid], lcnt[F.tid]);
    __syncthreads();
    { const int nent = it * 4;
      if (F.lane < nent) { LAS int* ent = list + ((F.wave * 8) * 4 + F.lane) * 4; const int m = ent[0], e = ent[1], rank = lbase[e] + ent[2];
          SLOTMAP[e * T + rank] = m; TOKSLOT[m * 4 + (F.lane & 3)] = e | (rank << 8); GATE[m * 4 + (F.lane & 3)] = __int_as_float(ent[3]); } }
}
__device__ __forceinline__ void load_tstart(Frame& F) {
    LAS int* ts = (LAS int*)(F.lds + LC_TSTART); const int* gcnt = (const int*)(F.ctl + CW_GCNT);
    if (F.tid == 0) { int a = 0; for (int e = 0; e < 32; ++e) { ts[e] = a; a += (__hip_atomic_load(gcnt + e, __ATOMIC_RELAXED, __HIP_MEMORY_SCOPE_AGENT) + 255) >> 8; } ts[32] = a; }
    __syncthreads();
}
__device__ __forceinline__ void p8_gather(Frame& F) {
    load_tstart(F);
    const LAS int* ts = (const LAS int*)(F.lds + LC_TSTART); const int* gcnt = (const int*)(F.ctl + CW_GCNT); const int* SLOTMAP = (const int*)(F.ws + WS_SLOTMAP);
    const bf16* H2 = (const bf16*)(F.ws + WS_H); bf16* XPAD = (bf16*)(F.ws + WS_XPAD);
    const int gw = F.vcu * NWAVES + F.wave, NGW = F.G * NWAVES; const int nrows = ts[32] * 256;
    for (int R = gw; R < nrows; R += NGW) { const int tile = R >> 8; int e = 0; while (e < 31 && ts[e + 1] <= tile) ++e;
        const int rank = R - ts[e] * 256; v4u a = (v4u){0u, 0u, 0u, 0u}, b2 = a;
        if (rank < gcnt[e]) { const int tok = SLOTMAP[e * T + rank]; const GAS v4u* src = (const GAS v4u*)(H2 + (size_t)tok * D); a = src[F.lane]; b2 = src[F.lane + 64]; }
        GAS v4u* dst = (GAS v4u*)(XPAD + (size_t)R * D); dst[F.lane] = a; dst[F.lane + 64] = b2; }
}
__device__ __forceinline__ void p11_final(Frame& F) {
    load_tstart(F);
    const LAS int* ts = (const LAS int*)(F.lds + LC_TSTART);
    const float* X1 = (const float*)(F.ws + WS_X1); const bf16* Y = (const bf16*)(F.ws + WS_Y); const int* TOKSLOT = (const int*)(F.ws + WS_TOKSLOT); const float* GATE = (const float*)(F.ws + WS_GATE);
    const float* MOD = (const float*)(F.ws + WS_MOD); const float* g2 = frame_in(21); const float* b2 = frame_in(22);
    const int gw = F.vcu * NWAVES + F.wave, NGW = F.G * NWAVES;
    for (int m = gw; m < T; m += NGW) { const int b = m >> 11;
        f32x4 mo[4];
#pragma unroll
        for (int j = 0; j < 4; ++j) mo[j] = (f32x4){0.f, 0.f, 0.f, 0.f};
#pragma unroll
        for (int k = 0; k < 4; ++k) { const int tsl = TOKSLOT[m * 4 + k]; const int e = tsl & 255, rank = tsl >> 8; const float gt = GATE[m * 4 + k];
            const GAS unsigned long long* yr = (const GAS unsigned long long*)(Y + ((size_t)ts[e] * 256 + rank) * D) + F.lane;
#pragma unroll
            for (int j = 0; j < 4; ++j) { const unsigned long long w = yr[64 * j]; const unsigned lo = (unsigned)w, hi = (unsigned)(w >> 32);
                mo[j].x += gt * pg8::bfl(lo); mo[j].y += gt * pg8::bfh(lo); mo[j].z += gt * pg8::bfl(hi); mo[j].w += gt * pg8::bfh(hi); } }
        f32x4 v[4]; float s = 0.f;
#pragma unroll
        for (int j = 0; j < 4; ++j) { const int col = 4 * F.lane + 256 * j; const f32x4 x1 = *((const GAS f32x4*)(X1 + (size_t)m * D) + F.lane + 64 * j);
            const f32x4 g2m = *(const f32x4*)(MOD + b * 6144 + 5 * 1024 + col); v[j] = x1 * ALPHA + g2m * mo[j]; s += (v[j].x + v[j].y) + (v[j].z + v[j].w); }
        const float mean = wave_sum(s) * (1.f / D); float s2 = 0.f;
#pragma unroll
        for (int j = 0; j < 4; ++j) { v[j] = v[j] - mean; s2 += (v[j].x * v[j].x + v[j].y * v[j].y) + (v[j].z * v[j].z + v[j].w * v[j].w); }
        const float rstd = 1.f / sqrtf(wave_sum(s2) * (1.f / D) + LN_EPS);
#pragma unroll
        for (int j = 0; j < 4; ++j) { const int col = 4 * F.lane + 256 * j; const f32x4 gg = *(const f32x4*)(g2 + col), bb = *(const f32x4*)(b2 + col);
            *((GAS f32x4*)(F.out + (size_t)m * D) + F.lane + 64 * j) = v[j] * rstd * gg + bb; }
    }
}
typedef float f32x16 __attribute__((ext_vector_type(16)));
__device__ __forceinline__ bf16x8 pack8(float a0, float a1, float a2, float a3, float a4, float a5, float a6, float a7) {
    v4u p; p.x = pkbf(a0, a1); p.y = pkbf(a2, a3); p.z = pkbf(a4, a5); p.w = pkbf(a6, a7); return __builtin_bit_cast(bf16x8, p); }
#define MFMA32(a, b, c) __builtin_amdgcn_mfma_f32_32x32x16_bf16((a), (b), (c), 0, 0, 0)
__device__ __forceinline__ int krow16(int r, int hh) { return (r & 3) + 8 * (r >> 2) + 4 * hh; }
__device__ __forceinline__ unsigned ordkey(float f) { const unsigned u = __float_as_uint(f); return (u & 0x80000000u) ? ~u : (u | 0x80000000u); }

constexpr int SEL_QI = 0, SEL_HIST = 32768, SEL_CAND = 98304, SEL_MASK = 114688, SEL_META = 122880, SEL_CAP = 128;
__device__ __forceinline__ f32x16 idx_scores(const float* MISCb, int kt, const LAS unsigned char* qiL, const float (&wi)[8], int lane) {
    const int hh = lane >> 5, q = lane & 31; const float* kp = MISCb + (size_t)(kt * 32 + q) * 256 + 128 + 8 * hh;
    bf16x8 A[4];
#pragma unroll
    for (int s = 0; s < 4; ++s) { const f32x4 a = *(const f32x4*)(kp + 16 * s), b = *(const f32x4*)(kp + 16 * s + 4); A[s] = pack8(a.x, a.y, a.z, a.w, b.x, b.y, b.z, b.w); }
    f32x16 sc;
#pragma unroll
    for (int r = 0; r < 16; ++r) sc[r] = 0.f;
#pragma unroll
    for (int h = 0; h < 8; ++h) { f32x16 acc;
#pragma unroll
        for (int r = 0; r < 16; ++r) acc[r] = 0.f;
#pragma unroll
        for (int s = 0; s < 4; ++s) { const int c16 = h * 8 + 2 * s + hh; const bf16x8 Bq = *(const LAS bf16x8*)(qiL + q * 1024 + ((c16 ^ (q & 15)) << 4)); acc = MFMA32(A[s], Bq, acc); }
#pragma unroll
        for (int r = 0; r < 16; ++r) sc[r] = fmaf(wi[h], fmaxf(acc[r], 0.f), sc[r]);
        asm volatile("" ::: "memory"); }
    return sc;
}
template <int MODE>
__device__ __forceinline__ void sel_pass(Frame& F, int lane, int wave, const float* MISCb, int qb, const float (&wi)[8], unsigned trial) {
    const LAS unsigned char* qiL = F.lds + SEL_QI; LAS unsigned* hist = (LAS unsigned*)(F.lds + SEL_HIST); LAS unsigned* cand = (LAS unsigned*)(F.lds + SEL_CAND);
    LAS unsigned* maskL = (LAS unsigned*)(F.lds + SEL_MASK); LAS int* meta = (LAS int*)(F.lds + SEL_META);
    const int hh = lane >> 5, q = lane & 31, qpos = qb * 32 + q; const int bst = meta[q]; const unsigned pfx = (unsigned)meta[128 + q];
    unsigned cntl = 0u;
#pragma unroll 1
    for (int kt = wave; kt <= qb; kt += NWAVES) {
        int lane_t = lane; asm volatile("" : "+v"(lane_t));
        const f32x16 sc = idx_scores(MISCb, kt, qiL, wi, lane_t);
        unsigned word = 0u;
#pragma unroll
        for (int r = 0; r < 16; ++r) { const int kr = krow16(r, hh), key = kt * 32 + kr; const bool valid = key <= qpos;
            const unsigned bits = __float_as_uint(sc[r]) & 0xFFFFF800u; const float st = __uint_as_float(bits);
            int bin = (int)(st * 64.f) + 256; bin = bin < 0 ? 0 : (bin > 511 ? 511 : bin);
            const unsigned ck = (ordkey(st) & 0xFFFFF800u) | (unsigned)(2047 - key);
            if (MODE == 0) { __hip_atomic_fetch_add(hist + q * 512 + bin, valid ? 1u : 0u, __ATOMIC_RELAXED, __HIP_MEMORY_SCOPE_WORKGROUP); }
            if (MODE == 1) { if (valid && bin > bst) word |= 1u << kr;
                if (valid && bin == bst) { const int slot = __hip_atomic_fetch_add((LAS int*)meta + 64 + q, 1, __ATOMIC_RELAXED, __HIP_MEMORY_SCOPE_WORKGROUP); if (slot < SEL_CAP) cand[q * SEL_CAP + slot] = ck; } }
            if (MODE == 2) { cntl += (valid && ck >= (pfx | trial)) ? 1u : 0u; }
            if (MODE == 3) { if (valid && ck >= pfx) word |= 1u << kr; } }
        if (MODE == 1 || MODE == 3) __hip_atomic_fetch_or(maskL + q * 64 + kt, word, __ATOMIC_RELAXED, __HIP_MEMORY_SCOPE_WORKGROUP);
    }
    if (MODE == 2) __hip_atomic_fetch_add((LAS unsigned*)meta + 160 + q, cntl, __ATOMIC_RELAXED, __HIP_MEMORY_SCOPE_WORKGROUP);
}
__device__ __forceinline__ void p3_select(Frame& F) {
    const bf16* QI = (const bf16*)(F.ws + WS_QI); const float* MISC = (const float*)(F.ws + WS_MISC); unsigned* MASK = (unsigned*)(F.ws + WS_MASK);
    LAS unsigned* hist = (LAS unsigned*)(F.lds + SEL_HIST); LAS unsigned* cand = (LAS unsigned*)(F.lds + SEL_CAND); LAS unsigned* maskL = (LAS unsigned*)(F.lds + SEL_MASK); LAS int* meta = (LAS int*)(F.lds + SEL_META);
    const int b = blockIdx.x >> 5, ii = blockIdx.x & 31;
    for (int ui = 0; ui < 2; ++ui) { const int qb = ui ? 63 - ii : ii; const int t0 = b * S_ + qb * 32;
        int tid = F.tid; asm volatile("" : "+v"(tid)); const int lane = tid & 63; int wave = F.wave; asm volatile("" : "+s"(wave));
        if (qb < 8) {
            for (int wd = tid; wd < 2048; wd += 512) { const int q = wd >> 6, w = wd & 63, qpos = qb * 32 + q; const int rel = qpos - 32 * w;
                MASK[(size_t)(t0 + q) * 64 + w] = rel >= 31 ? 0xFFFFFFFFu : (rel < 0 ? 0u : ((2u << rel) - 1u)); }
            continue; }
        __syncthreads();
        for (int c = tid; c < 2048; c += 512) { const int q = c >> 6, c16 = c & 63; *(LAS v4u*)(F.lds + SEL_QI + q * 1024 + ((c16 ^ (q & 15)) << 4)) = *(const GAS v4u*)(QI + (size_t)(t0 + q) * 512 + c16 * 8); }
        { unsigned z = 0u; asm volatile("" : "+v"(z)); const v4u z4 = (v4u){z, z, z, z};
          for (int i = tid; i < 16384 / 4; i += 512) ((LAS v4u*)hist)[i] = z4;
          for (int i = tid; i < 2048 / 4; i += 512) ((LAS v4u*)maskL)[i] = z4; }
        if (tid < 192) meta[tid] = 0;
        float wi[8];
#pragma unroll
        for (int h = 0; h < 8; ++h) wi[h] = MISC[(size_t)(t0 + (lane & 31)) * 256 + 192 + h];
        const float* MISCb = MISC + (size_t)b * S_ * 256;
        __syncthreads();
        sel_pass<0>(F, lane, wave, MISCb, qb, wi, 0u);
        __syncthreads();
        for (int qq = 0; qq < 4; ++qq) { const int q = wave * 4 + qq; const LAS unsigned* hq = hist + q * 512; unsigned c8[8]; unsigned cs = 0u;
#pragma unroll
            for (int i = 0; i < 8; ++i) { c8[i] = hq[511 - 8 * lane - i]; cs += c8[i]; }
            unsigned incl = cs;
#pragma unroll
            for (int o = 1; o < 64; o <<= 1) { const unsigned v = __shfl_up(incl, o); if (lane >= o) incl += v; }
            const unsigned excl = incl - cs;
            if (excl < 256u && incl >= 256u) { unsigned run = excl;
#pragma unroll
                for (int i = 0; i < 8; ++i) { const unsigned before = run; run += c8[i]; if (before < 256u && run >= 256u) { meta[q] = 511 - 8 * lane - i; meta[32 + q] = (int)(256u - before); } } } }
        __syncthreads();
        sel_pass<1>(F, lane, wave, MISCb, qb, wi, 0u);
        __syncthreads();
        if (tid < 32) { if (meta[64 + tid] > SEL_CAP) meta[96] = 1; }
        __syncthreads();
        if (meta[96] == 0) {
            for (int item = tid; item < 32 * SEL_CAP; item += 512) { const int q = item >> 7, i = item & (SEL_CAP - 1); const int n = meta[64 + q];
                if (i < n) { const unsigned my = cand[q * SEL_CAP + i]; int rank = 0; for (int j = 0; j < n; ++j) rank += (cand[q * SEL_CAP + j] > my) ? 1 : 0;
                    if (rank < meta[32 + q]) { const int idx = 2047 - (int)(my & 0x7FFu); __hip_atomic_fetch_or(maskL + q * 64 + (idx >> 5), 1u << (idx & 31), __ATOMIC_RELAXED, __HIP_MEMORY_SCOPE_WORKGROUP); } } }
        } else {
#pragma unroll 1
            for (int bit = 31; bit >= 0; --bit) {
                sel_pass<2>(F, lane, wave, MISCb, qb, wi, 1u << bit);
                __syncthreads();
                if (tid < 32) { if ((unsigned)meta[160 + tid] >= 256u) meta[128 + tid] |= (int)(1u << bit); meta[160 + tid] = 0; }
                __syncthreads(); }
            sel_pass<3>(F, lane, wave, MISCb, qb, wi, 0u);
        }
        __syncthreads();
        { const int q = tid >> 4, w4 = (tid & 15) * 4; *(GAS v4u*)(MASK + (size_t)(t0 + q) * 64 + w4) = *(const LAS v4u*)(maskL + q * 64 + w4); }
    }
}
constexpr int ATT_K = 0, ATT_VT = 32768;
__device__ __forceinline__ void att_load(const bf16* CKV, const bf16* CKVT, int b, int j, int tid, v4u (&st)[4]) {
#pragma unroll
    for (int i = 0; i < 2; ++i) { const int c = tid + 512 * i; st[i] = *(const GAS v4u*)(CKV + (size_t)(b * S_ + 64 * j) * 128 + c * 8); }
#pragma unroll
    for (int i = 0; i < 2; ++i) { const int c = tid + 512 * i, d = c >> 3, ch = c & 7; st[2 + i] = *(const GAS v4u*)(CKVT + (size_t)(b * 128 + d) * 2048 + 64 * j + ch * 8); }
}
__device__ __forceinline__ void att_store(LAS unsigned char* lds, int buf, int tid, const v4u (&st)[4]) {
#pragma unroll
    for (int i = 0; i < 2; ++i) { const int c = tid + 512 * i, row = c >> 4, ch = c & 15; *(LAS v4u*)(lds + ATT_K + buf * 16384 + row * 256 + ((ch ^ (row & 15)) << 4)) = st[i]; }
#pragma unroll
    for (int i = 0; i < 2; ++i) { const int c = tid + 512 * i, d = c >> 3, ch = c & 7; *(LAS v4u*)(lds + ATT_VT + buf * 16384 + d * 128 + ((ch ^ ((d >> 1) & 7)) << 4)) = st[2 + i]; }
}
__device__ __forceinline__ void p4_attention(Frame& F) {
    const bf16* QL = (const bf16*)(F.ws + WS_QL); const bf16* CKV = (const bf16*)(F.ws + WS_CKV); const bf16* CKVT = (const bf16*)(F.ws + WS_CKVT);
    const unsigned* MASK = (const unsigned*)(F.ws + WS_MASK); bf16* OLAT = (bf16*)(F.ws + WS_OLAT);
    const int b = blockIdx.x >> 5, ii = blockIdx.x & 31;
    for (int ui = 0; ui < 2; ++ui) { const int qb = ui ? 63 - ii : ii;
        int tid = F.tid; asm volatile("" : "+v"(tid)); const int lane = tid & 63; int head = F.wave; asm volatile("" : "+s"(head));
        const int hh = lane >> 5, q = lane & 31; const float slope2 = __builtin_amdgcn_exp2f(-(float)(head + 1)) * LOG2E;
        const int t0 = b * S_ + qb * 32, qpos = qb * 32 + q; const int nt = (qb >> 1) + 1;
        bf16x8 Qf[8];
#pragma unroll
        for (int s = 0; s < 8; ++s) Qf[s] = *(const GAS bf16x8*)(QL + (size_t)(t0 + q) * 1024 + head * 128 + 16 * s + 8 * hh);
        f32x16 O[4];
#pragma unroll
        for (int db = 0; db < 4; ++db)
#pragma unroll
            for (int r = 0; r < 16; ++r) O[db][r] = 0.f;
        float m_run = -INFINITY, l_run = 0.f;
        v4u st[4];
        att_load(CKV, CKVT, b, 0, tid, st);
        __syncthreads();
        att_store(F.lds, 0, tid, st);
        __syncthreads();
        for (int j = 0; j < nt; ++j) { const int buf = j & 1;
            if (j + 1 < nt) att_load(CKV, CKVT, b, j + 1, tid, st);
            const unsigned mlo = MASK[(size_t)(t0 + q) * 64 + 2 * j] >> (4 * hh), mhi = MASK[(size_t)(t0 + q) * 64 + 2 * j + 1] >> (4 * hh);
            f32x16 S0, S1;
#pragma unroll
            for (int r = 0; r < 16; ++r) { S0[r] = 0.f; S1[r] = 0.f; }
            const LAS unsigned char* kb0 = F.lds + ATT_K + buf * 16384 + q * 256, * kb1 = kb0 + 32 * 256;
#pragma unroll
            for (int s = 0; s < 8; ++s) { const int sw = ((2 * s + hh) ^ (q & 15)) << 4;
                const bf16x8 A0 = *(const LAS bf16x8*)(kb0 + sw), A1 = *(const LAS bf16x8*)(kb1 + sw);
                S0 = MFMA32(A0, Qf[s], S0); S1 = MFMA32(A1, Qf[s], S1); }
            asm volatile("" ::: "memory");
            const float base0 = slope2 * (float)(64 * j + 4 * hh - qpos);
            float tmax = -INFINITY;
#pragma unroll
            for (int r = 0; r < 16; ++r) { const int kr = (r & 3) + 8 * (r >> 2);
                float s0 = S0[r] + (base0 + slope2 * (float)kr), s1 = S1[r] + (base0 + slope2 * (float)(kr + 32));
                s0 = ((mlo >> kr) & 1u) ? s0 : -INFINITY; s1 = ((mhi >> kr) & 1u) ? s1 : -INFINITY;
                S0[r] = s0; S1[r] = s1; tmax = fmaxf(tmax, fmaxf(s0, s1)); }
            tmax = fmaxf(tmax, __shfl_xor(tmax, 32));
            const float m_new = fmaxf(m_run, tmax), msafe = (m_new == -INFINITY) ? 0.f : m_new;
            const float alpha = __builtin_amdgcn_exp2f(m_run - msafe);
            float ps = 0.f;
#pragma unroll
            for (int r = 0; r < 16; ++r) { S0[r] = __builtin_amdgcn_exp2f(S0[r] - msafe); S1[r] = __builtin_amdgcn_exp2f(S1[r] - msafe); ps += S0[r] + S1[r]; }
            l_run = l_run * alpha + ps; m_run = m_new;
            if (__any(alpha != 1.f)) {
#pragma unroll
                for (int db = 0; db < 4; ++db)
#pragma unroll
                    for (int r = 0; r < 16; ++r) O[db][r] *= alpha; }
            bf16x8 Pf[4];
            Pf[0] = pack8(S0[0], S0[1], S0[2], S0[3], S0[4], S0[5], S0[6], S0[7]); Pf[1] = pack8(S0[8], S0[9], S0[10], S0[11], S0[12], S0[13], S0[14], S0[15]);
            Pf[2] = pack8(S1[0], S1[1], S1[2], S1[3], S1[4], S1[5], S1[6], S1[7]); Pf[3] = pack8(S1[8], S1[9], S1[10], S1[11], S1[12], S1[13], S1[14], S1[15]);
            asm volatile("" ::: "memory");
            const LAS unsigned char* vb = F.lds + ATT_VT + buf * 16384;
#pragma unroll
            for (int db = 0; db < 4; ++db) { const int d = db * 32 + q; const LAS unsigned char* vr = vb + d * 128; const int sx = (d >> 1) & 7;
#pragma unroll
                for (int c2 = 0; c2 < 4; ++c2) { const bf16x8 Av = *(const LAS bf16x8*)(vr + (((c2 * 2 + hh) ^ sx) << 4)); O[db] = MFMA32(Av, Pf[c2], O[db]); } }
            if (j + 1 < nt) att_store(F.lds, buf ^ 1, tid, st);
            __syncthreads();
        }
        const float lt = l_run + __shfl_xor(l_run, 32); const float inv = 1.f / lt;
        bf16* orow = OLAT + (size_t)(t0 + q) * 1024 + head * 128 + 4 * hh;
#pragma unroll
        for (int db = 0; db < 4; ++db)
#pragma unroll
            for (int g = 0; g < 4; ++g) { const unsigned lo = pkbf(O[db][4 * g] * inv, O[db][4 * g + 1] * inv), hi = pkbf(O[db][4 * g + 2] * inv, O[db][4 * g + 3] * inv);
                *(GAS unsigned long long*)(orow + db * 32 + 8 * g) = (unsigned long long)lo | ((unsigned long long)hi << 32); }
    }
}
struct Args { const float* in[23]; float* out; unsigned char* ws; int ph_lo, ph_hi; };
__global__ void __launch_bounds__(NWAVES * 64, 2) mk_fwd(Args args) {
    extern __shared__ __attribute__((aligned(16))) unsigned char lds[];
    Frame F;
    F.lds = (LAS unsigned char*)lds;
    F.MISCW = (volatile LAS unsigned*)(F.lds + MISC_OFF);
    F.tid = threadIdx.x; F.lane = F.tid & 63; F.wave = __builtin_amdgcn_readfirstlane(F.tid >> 6);
    F.G = gridDim.x; { const int bx = blockIdx.x; F.vcu = (F.G % 8 == 0) ? (bx % 8) * (F.G / 8) + bx / 8 : bx; }
    F.ws = args.ws; F.ctl = (gu32*)(args.ws + WS_CTL); F.out = args.out;
    for (int u = F.tid; u < (LDS_BYTES - LDSCTL_OFF) / 4; u += NWAVES * 64) ((LAS unsigned*)(F.lds + LDSCTL_OFF))[u] = 0u;
    __syncthreads();
    const int lo = args.ph_lo, hi = args.ph_hi;
#define IN(k) (lo <= (k) && (k) < hi)
#define SEAM(k) do { if (IN(k) && IN((k) + 1)) xcd_barrier(bar); } while (0)
#ifndef PROBE_MASK
#define PROBE_MASK 0
#endif
#define REPS(k) ((((PROBE_MASK) >> (k)) & 1) ? 2 : 1)
#define REPBAR(k) do { if (r_ + 1 < REPS(k)) xcd_barrier(bar); } while (0)
    XcdBarrier bar; bar.bar = (unsigned*)(F.ctl + CW_BAR); bar.x = 0; bar.st = nullptr;
    if (hi - lo > 1) bar = xcd_barrier_post((unsigned*)(F.ctl + CW_BAR), F.MISCW + 8);
    if (IN(0)) for (int r_ = 0; r_ < REPS(0); ++r_) { p0_prologue(F); REPBAR(0); } SEAM(0);
    if (IN(1)) for (int r_ = 0; r_ < REPS(1); ++r_) { p1_modulate(F); REPBAR(1); } SEAM(1);
    if (IN(2)) for (int r_ = 0; r_ < REPS(2); ++r_) {
        pg8::Gemm g{(const pg8::bf16_t*)(F.ws + WS_H), (const pg8::bf16_t*)(F.ws + WS_WIN), T, NIN, D}; pg8::StaticOrder S; S.init(T, NIN, F.G, (int)blockIdx.x);
        pg8::EpiInProj E{(pg8::bf16_t*)(F.ws + WS_QL), (pg8::bf16_t*)(F.ws + WS_QI), (pg8::bf16_t*)(F.ws + WS_U), (pg8::bf16_t*)(F.ws + WS_SG), (float*)(F.ws + WS_MISC)};
        pg8::gemm_phase<pg8::EpiInProj, pg8::StaticOrder, PG8_ALIGN, PG8_SP2>(F.lds + RING_OFF, g, S, E);
    REPBAR(2); } SEAM(2);
    if (IN(3)) for (int r_ = 0; r_ < REPS(3); ++r_) { p3_post(F); __syncthreads(); p3_select(F); REPBAR(3); } SEAM(3);
    if (IN(4)) for (int r_ = 0; r_ < REPS(4); ++r_) { p4_attention(F); REPBAR(4); } SEAM(4);
    if (IN(5)) for (int r_ = 0; r_ < REPS(5); ++r_) {
        { pg8::Gemm g{(const pg8::bf16_t*)(F.ws + WS_OLAT), (const pg8::bf16_t*)(F.ws + WS_WOA), T, D, 1024}; pg8::StaticOrder S; S.init(T, D, F.G, (int)blockIdx.x);
          pg8::EpiGateMul E{(pg8::bf16_t*)(F.ws + WS_TMP), (const pg8::bf16_t*)(F.ws + WS_SG), 0, 0};
          pg8::gemm_phase<pg8::EpiGateMul, pg8::StaticOrder, PG8_ALIGN, PG8_SP2>(F.lds + RING_OFF, g, S, E); }
        { pg8::Gemm g{(const pg8::bf16_t*)(F.ws + WS_POOLED), (const pg8::bf16_t*)(F.ws + WS_WPB), T, D, 512}; pg8::StaticOrder S; S.init(T, D, F.G, (int)blockIdx.x);
          pg8::EpiGateAdd E{(pg8::bf16_t*)(F.ws + WS_MIX), (const pg8::bf16_t*)(F.ws + WS_TMP), (const pg8::bf16_t*)(F.ws + WS_SG), 1024, 0};
          pg8::gemm_phase<pg8::EpiGateAdd, pg8::StaticOrder, PG8_ALIGN, PG8_SP2>(F.lds + RING_OFF, g, S, E); }
    REPBAR(5); } SEAM(5);
    if (IN(6)) for (int r_ = 0; r_ < REPS(6); ++r_) {
        pg8::Gemm g{(const pg8::bf16_t*)(F.ws + WS_MIX), (const pg8::bf16_t*)(F.ws + WS_WOUT), T, D, 1024}; pg8::StaticOrder S; S.init(T, D, F.G, (int)blockIdx.x);
        pg8::EpiResid E{(float*)(F.ws + WS_Z), frame_in(0), (const float*)(F.ws + WS_MOD) + 2 * 1024};
        pg8::gemm_phase<pg8::EpiResid, pg8::StaticOrder, PG8_ALIGN, PG8_SP2>(F.lds + RING_OFF, g, S, E);
    REPBAR(6); } SEAM(6);
    if (IN(7)) for (int r_ = 0; r_ < REPS(7); ++r_) { p7_ln1_route(F); REPBAR(7); } SEAM(7);
    if (IN(8)) for (int r_ = 0; r_ < REPS(8); ++r_) { p8_gather(F); REPBAR(8); } SEAM(8);
    if (IN(9)) for (int r_ = 0; r_ < REPS(9); ++r_) {
        load_tstart(F);
        pg8::Gemm g{(const pg8::bf16_t*)(F.ws + WS_XPAD), (const pg8::bf16_t*)(F.ws + WS_WGU), MAXROWS, 32 * 2048, 1024};
        pg8::MoeOrder S{(const LAS int*)(F.lds + LC_TSTART), 8, F.G, (int)blockIdx.x};
        pg8::EpiSwiglu E{(pg8::bf16_t*)(F.ws + WS_ACT), frame_in(18)};
        pg8::gemm_phase<pg8::EpiSwiglu, pg8::MoeOrder, PG8_ALIGN, PG8_SP2>(F.lds + RING_OFF, g, S, E);
    REPBAR(9); } SEAM(9);
    if (IN(10)) for (int r_ = 0; r_ < REPS(10); ++r_) {
        load_tstart(F);
        pg8::Gemm g{(const pg8::bf16_t*)(F.ws + WS_ACT), (const pg8::bf16_t*)(F.ws + WS_WD), MAXROWS, 32 * 1024, 1024};
        pg8::MoeOrder S{(const LAS int*)(F.lds + LC_TSTART), 4, F.G, (int)blockIdx.x};
        pg8::EpiDown E{(pg8::bf16_t*)(F.ws + WS_Y), frame_in(20)};
        pg8::gemm_phase<pg8::EpiDown, pg8::MoeOrder, PG8_ALIGN, PG8_SP2>(F.lds + RING_OFF, g, S, E);
    REPBAR(10); } SEAM(10);
    if (IN(11)) for (int r_ = 0; r_ < REPS(11); ++r_) { p11_final(F); REPBAR(11); }
#undef IN
#undef SEAM
}

namespace tmpk {
__global__ void k_ckv(const float* MISC, const float* g, bf16* CKV) {
    const int t = blockIdx.x, r = threadIdx.x; __shared__ float red[128];
    const float v = MISC[(size_t)t * 256 + r]; red[r] = v * v; __syncthreads();
    for (int s = 64; s > 0; s >>= 1) { if (r < s) red[r] += red[r + s]; __syncthreads(); }
    const float rs = 1.0f / sqrtf(red[0] / 128.f + LN_EPS);
    CKV[(size_t)t * 128 + r] = (bf16)f2bf(v * rs * g[r]);
}
__global__ void k_pool(const bf16* U, bf16* POOLED) {
    const int t = blockIdx.x, c = threadIdx.x, s = t % S_; const int g = c >> 7, w = 2 << g;
    const int lo = (s - w + 1) < 0 ? 0 : (s - w + 1); float sum = 0.f;
    for (int sp = lo; sp <= s; ++sp) sum += bf2f(U[(size_t)(t - s + sp) * 512 + c]);
    POOLED[(size_t)t * 512 + c] = (bf16)f2bf(sum / (float)(s - lo + 1) - bf2f(U[(size_t)t * 512 + c]));
}
__device__ __forceinline__ unsigned ord(float f) { unsigned u = __float_as_uint(f); return (u & 0x80000000u) ? ~u : (u | 0x80000000u); }
__global__ void __launch_bounds__(256) k_select(const bf16* QI, const float* MISC, int* SEL, int* CNT) {
    const int t = blockIdx.x, b = t / S_, q = t % S_; const int n = q + 1;
    if (n <= TOPK) { for (int i = threadIdx.x; i < n; i += 256) SEL[(size_t)t * TOPK + i] = i; if (threadIdx.x == 0) CNT[t] = n; return; }
    __shared__ float qi[512]; __shared__ float wi[8]; __shared__ unsigned long long keys[2048];
    for (int i = threadIdx.x; i < 512; i += 256) qi[i] = bf2f(QI[(size_t)t * 512 + i]);
    if (threadIdx.x < 8) wi[threadIdx.x] = MISC[(size_t)t * 256 + 192 + threadIdx.x];
    __syncthreads();
    for (int j = threadIdx.x; j < 2048; j += 256) {
        unsigned long long kv = 0ull;
        if (j < n) { const float* kp = MISC + (size_t)(b * S_ + j) * 256 + 128; float sc = 0.f;
            for (int h = 0; h < 8; ++h) { float dsum = 0.f; for (int d = 0; d < 64; ++d) dsum += qi[h * 64 + d] * bf2f((bf16)f2bf(kp[d])); sc += wi[h] * fmaxf(dsum, 0.f); }
            kv = ((unsigned long long)ord(sc) << 32) | (unsigned long long)(0xFFFFFFFFu - (unsigned)j); }
        keys[j] = kv; }
    __syncthreads();
    for (int k = 2; k <= 2048; k <<= 1) for (int j = k >> 1; j > 0; j >>= 1) {
        for (int i = threadIdx.x; i < 2048; i += 256) { const int ixj = i ^ j; if (ixj > i) { const unsigned long long a = keys[i], c = keys[ixj]; const bool up = ((i & k) == 0);
                if (up ? (a < c) : (a > c)) { keys[i] = c; keys[ixj] = a; } } }
        __syncthreads(); }
    for (int i = threadIdx.x; i < TOPK; i += 256) SEL[(size_t)t * TOPK + i] = (int)(0xFFFFFFFFu - (unsigned)(keys[i] & 0xFFFFFFFFull));
    if (threadIdx.x == 0) CNT[t] = TOPK;
}
__global__ void __launch_bounds__(256) k_attn(const bf16* QL, const bf16* CKV, const int* SEL, const int* CNT, bf16* OLAT) {
    const int t = blockIdx.x, b = t / S_, q = t % S_, tid = threadIdx.x; const int cnt = CNT[t];
    __shared__ float ql[128], p[256], red[256]; __shared__ int sel[256];
    sel[tid] = (tid < cnt) ? SEL[(size_t)t * TOPK + tid] : 0;
    for (int h = 0; h < 8; ++h) {
        __syncthreads();
        if (tid < 128) ql[tid] = bf2f(QL[(size_t)t * 1024 + h * 128 + tid]);
        __syncthreads();
        const float slope = exp2f(-(float)(h + 1)) * LOG2E;
        float lg = -INFINITY;
        if (tid < cnt) { const bf16* kp = CKV + (size_t)(b * S_ + sel[tid]) * 128; float a = 0.f; for (int r = 0; r < 128; ++r) a += ql[r] * bf2f(kp[r]); lg = a - slope * (float)(q - sel[tid]); }
        red[tid] = lg; __syncthreads();
        for (int s = 128; s > 0; s >>= 1) { if (tid < s) red[tid] = fmaxf(red[tid], red[tid + s]); __syncthreads(); }
        const float mx = red[0]; __syncthreads();
        const float e = (tid < cnt) ? exp2f(lg - mx) : 0.f; p[tid] = e; red[tid] = e; __syncthreads();
        for (int s = 128; s > 0; s >>= 1) { if (tid < s) red[tid] += red[tid + s]; __syncthreads(); }
        const float inv = 1.f / red[0];
        if (tid < 128) { float a = 0.f; for (int j = 0; j < cnt; ++j) a += p[j] * bf2f(CKV[(size_t)(b * S_ + sel[j]) * 128 + tid]); OLAT[(size_t)t * 1024 + h * 128 + tid] = (bf16)f2bf(a * inv); }
    }
}
template <bool BT, class CF, class AF, class BF, class EF>
__global__ void __launch_bounds__(256) k_gemm(int M, int N, int K, int pad_, CF cf, AF af, BF bf, EF ef) {
    const int ctx = cf(blockIdx.y);
    __shared__ float As[16][65], Bs[16][65];
    const int tx = threadIdx.x & 15, ty = threadIdx.x >> 4;
    const int m0 = blockIdx.y * 64, n0 = blockIdx.x * 64;
    float acc[4][4] = {};
    for (int k0 = 0; k0 < K; k0 += 16) {
        for (int i = threadIdx.x; i < 64 * 16; i += 256) { const int mm = i >> 4, kk = i & 15; As[kk][mm] = (m0 + mm < M) ? af(m0 + mm, k0 + kk, ctx) : 0.f; }
        for (int i = threadIdx.x; i < 64 * 16; i += 256) { const int kk = BT ? (i & 15) : (i >> 6), nn = BT ? (i >> 4) : (i & 63); Bs[kk][nn] = (n0 + nn < N) ? bf(k0 + kk, n0 + nn, ctx) : 0.f; }
        __syncthreads();
#pragma unroll
        for (int kk = 0; kk < 16; ++kk) { float a[4], b[4];
#pragma unroll
            for (int i = 0; i < 4; ++i) { a[i] = As[kk][ty * 4 + i]; b[i] = Bs[kk][tx * 4 + i]; }
#pragma unroll
            for (int i = 0; i < 4; ++i)
#pragma unroll
                for (int j = 0; j < 4; ++j) acc[i][j] += a[i] * b[j]; }
        __syncthreads();
    }
#pragma unroll
    for (int i = 0; i < 4; ++i) { const int m = m0 + ty * 4 + i; if (m < M) ef(m, n0 + tx * 4, acc[i], ctx); }
}
__device__ __forceinline__ float blk_sum(float v, float* red) {
    const int tid = threadIdx.x; red[tid] = v; __syncthreads();
    for (int s = 128; s > 0; s >>= 1) { if (tid < s) red[tid] += red[tid + s]; __syncthreads(); }
    const float r = red[0]; __syncthreads(); return r;
}
__global__ void __launch_bounds__(256) k_ln1_route(const float* Z, const float* g1, const float* b1, const float* mod, const float* w_r, const float* b_r,
                                                   float* X1, bf16* H2, int* gcnt, int* SLOTMAP, int* TOKSLOT, float* GATE) {
    const int t = blockIdx.x, b = t / S_, tid = threadIdx.x; __shared__ float red[256]; __shared__ float h2s[1024]; __shared__ float lg[32];
    float v[4]; float s = 0.f;
    for (int i = 0; i < 4; ++i) { v[i] = Z[(size_t)t * D + tid + 256 * i]; s += v[i]; }
    const float mean = blk_sum(s, red) / D; float s2 = 0.f;
    for (int i = 0; i < 4; ++i) { v[i] -= mean; s2 += v[i] * v[i]; }
    const float rstd = 1.0f / sqrtf(blk_sum(s2, red) / D + LN_EPS);
    for (int i = 0; i < 4; ++i) { const int col = tid + 256 * i; const float x1 = v[i] * rstd * g1[col] + b1[col]; X1[(size_t)t * D + col] = x1;
        const float h2 = x1 * (1.f + mod[b * 6144 + 4 * 1024 + col]) + mod[b * 6144 + 3 * 1024 + col]; H2[(size_t)t * D + col] = (bf16)f2bf(h2); h2s[col] = h2; }
    __syncthreads();
    { const int e = tid >> 3, part = tid & 7; float a = 0.f;
      for (int k = part; k < 1024; k += 8) a += h2s[k] * w_r[(size_t)k * 32 + e];
      red[tid] = a; __syncthreads();
      if (part == 0) { float sum = 0.f; for (int i = 0; i < 8; ++i) sum += red[tid + i]; lg[e] = sum + b_r[e]; }
      __syncthreads(); }
    if (tid == 0) {
        int sel[4]; float val[4]; unsigned used = 0u;
        for (int k = 0; k < 4; ++k) { int best = -1; float bv = -INFINITY; for (int e = 0; e < 32; ++e) if (!((used >> e) & 1u) && (best < 0 || lg[e] > bv)) { best = e; bv = lg[e]; } sel[k] = best; val[k] = bv; used |= 1u << best; }
        float den = 0.f, ex[4]; for (int k = 0; k < 4; ++k) { ex[k] = __expf(val[k] - val[0]); den += ex[k]; }
        for (int k = 0; k < 4; ++k) { const int e = sel[k]; const int rank = atomicAdd(&gcnt[e], 1); SLOTMAP[e * T + rank] = t; TOKSLOT[t * 4 + k] = e | (rank << 8); GATE[t * 4 + k] = ex[k] / den; }
    }
}
__global__ void k_prefix(const int* gcnt, int* tstart) {
    if (threadIdx.x == 0) { int a = 0; for (int e = 0; e < 32; ++e) { tstart[e] = a; a += (gcnt[e] + 255) / 256; } tstart[32] = a; }
}
__global__ void __launch_bounds__(256) k_final(const float* X1, const bf16* Y, const int* TOKSLOT, const float* GATE, const int* tstart, const float* mod,
                                               const float* g2, const float* b2, float* out) {
    const int t = blockIdx.x, b = t / S_, tid = threadIdx.x; __shared__ float red[256];
    float v[4]; float s = 0.f;
    for (int i = 0; i < 4; ++i) { const int col = tid + 256 * i; float m = 0.f;
        for (int k = 0; k < 4; ++k) { const int ts = TOKSLOT[t * 4 + k]; const int e = ts & 255, rank = ts >> 8; m += GATE[t * 4 + k] * bf2f(Y[((size_t)tstart[e] * 256 + rank) * 1024 + col]); }
        v[i] = ALPHA * X1[(size_t)t * D + col] + mod[b * 6144 + 5 * 1024 + col] * m; s += v[i]; }
    const float mean = blk_sum(s, red) / D; float s2 = 0.f;
    for (int i = 0; i < 4; ++i) { v[i] -= mean; s2 += v[i] * v[i]; }
    const float rstd = 1.0f / sqrtf(blk_sum(s2, red) / D + LN_EPS);
    for (int i = 0; i < 4; ++i) { const int col = tid + 256 * i; out[(size_t)t * D + col] = v[i] * rstd * g2[col] + b2[col]; }
}
struct CZero { long long dummy; __device__ int operator()(int) const { return 0; } };
struct ABf { const bf16* A; long long lda; __device__ float operator()(int m, int k, int) const { return bf2f(A[(size_t)m * lda + k]); } };
struct BBfT { const bf16* Bt; long long ldk; __device__ float operator()(int k, int n, int) const { return bf2f(Bt[(size_t)n * ldk + k]); } };
struct EGateMul { bf16* C; const bf16* SG; long long goff; __device__ void operator()(int m, int n, const float (&a)[4], int) const { for (int j = 0; j < 4; ++j) C[(size_t)m * 1024 + n + j] = (bf16)f2bf(bf2f(SG[(size_t)m * 2048 + goff + n + j]) * a[j]); } };
struct EGateAdd { bf16* C; const bf16* TMP; const bf16* SG; long long goff; __device__ void operator()(int m, int n, const float (&a)[4], int) const { for (int j = 0; j < 4; ++j) C[(size_t)m * 1024 + n + j] = (bf16)f2bf(bf2f(TMP[(size_t)m * 1024 + n + j]) + bf2f(SG[(size_t)m * 2048 + goff + n + j]) * a[j]); } };
struct EResid { float* Z; const float* x; const float* mod; __device__ void operator()(int m, int n, const float (&a)[4], int) const { const int b = m / S_; for (int j = 0; j < 4; ++j) Z[(size_t)m * 1024 + n + j] = ALPHA * x[(size_t)m * 1024 + n + j] + mod[b * 6144 + 2 * 1024 + n + j] * a[j]; } };
struct CExp { const int* tstart; __device__ int operator()(int by) const { const int tile = by >> 2; if (tile >= tstart[32]) return -1; int e = 0; while (e < 31 && tstart[e + 1] <= tile) ++e; return e; } };
struct AGather { const bf16* H2; const int* SLOTMAP; const int* gcnt; const int* tstart;
    __device__ float operator()(int m, int k, int e) const { if (e < 0) return 0.f; const int rank = m - tstart[e] * 256; if (rank >= gcnt[e]) return 0.f; return bf2f(H2[(size_t)SLOTMAP[e * T + rank] * 1024 + k]); } };
struct BGateUpT { const bf16* Wt;
    __device__ float operator()(int k, int n, int e) const { if (e < 0) return 0.f; const int j = n >> 1; const int row = (j >> 7) * 256 + ((n & 1) ? 128 : 0) + (j & 127); return bf2f(Wt[((size_t)e * 2048 + row) * 1024 + k]); } };
struct ESwiglu { bf16* ACT; const float* bgu;
    __device__ void operator()(int m, int n, const float (&a)[4], int e) const { if (e < 0) return;
        for (int p = 0; p < 2; ++p) { const int j = (n >> 1) + p; float gl = a[2 * p] + bgu[e * 2048 + j], li = a[2 * p + 1] + bgu[e * 2048 + 1024 + j];
            gl = fminf(gl, 7.f); li = fminf(fmaxf(li, -7.f), 7.f); ACT[(size_t)m * 1024 + j] = (bf16)f2bf(gl * (1.f / (1.f + __expf(-1.702f * gl))) * (li + 1.f)); } } };
struct ARowT { const bf16* A; __device__ float operator()(int m, int k, int e) const { if (e < 0) return 0.f; return bf2f(A[(size_t)m * 1024 + k]); } };
struct BDownT { const bf16* Wt; __device__ float operator()(int k, int n, int e) const { if (e < 0) return 0.f; return bf2f(Wt[((size_t)e * 1024 + n) * 1024 + k]); } };
struct EDown { bf16* Y; const float* bd; __device__ void operator()(int m, int n, const float (&a)[4], int e) const { if (e < 0) return; for (int j = 0; j < 4; ++j) Y[(size_t)m * 1024 + n + j] = (bf16)f2bf(a[j] + bd[e * 1024 + n + j]); } };
}

static void launch_mk(const Args& a0, int lo, int hi, int grid, hipStream_t stream) {
    Args a = a0; a.ph_lo = lo; a.ph_hi = hi;
    hipLaunchKernelGGL(mk_fwd, dim3(grid), dim3(NWAVES * 64), LDS_BYTES, stream, a);
}
extern "C" void kernel_launch(void* const* d_in, const int* in_sizes, int n_in, void* d_out, int out_size, void* d_ws, size_t ws_size, hipStream_t stream) {
    static int grid = 0;
    if (grid == 0) {
        if (n_in != 23 || ws_size < WS_END) { fprintf(stderr, "kernel_launch: unexpected n_in %d / ws %zu\n", n_in, ws_size); grid = -1; return; }
        int dev = 0, cus = 0;
        if (hipGetDevice(&dev) != hipSuccess || hipDeviceGetAttribute(&cus, hipDeviceAttributeMultiprocessorCount, dev) != hipSuccess) { grid = -1; return; }
        if (hipFuncSetAttribute((const void*)mk_fwd, hipFuncAttributeMaxDynamicSharedMemorySize, LDS_BYTES) != hipSuccess) { fprintf(stderr, "hipFuncSetAttribute failed\n"); grid = -1; return; }
        grid = cus;
        if (grid != 256) { fprintf(stderr, "kernel_launch: built for 256 CUs, found %d\n", cus); grid = -1; return; }
    }
    if (grid < 0) return;
    unsigned char* ws = (unsigned char*)d_ws;
    (void)hipMemsetAsync(ws + WS_CTL, 0, CTL_ZERO_BYTES, stream);
    Args a{};
    for (int i = 0; i < 23; ++i) a.in[i] = (const float*)d_in[i];
    a.out = (float*)d_out; a.ws = ws;
    const float* x = a.in[0]; const float* kvg = a.in[5]; const float* g1 = a.in[13]; const float* b1 = a.in[14]; const float* w_r = a.in[15]; const float* b_r = a.in[16];
    const float* b_gu = a.in[18]; const float* b_d = a.in[20]; const float* g2 = a.in[21]; const float* b2 = a.in[22];
    float* MOD = (float*)(ws + WS_MOD); bf16* QL = (bf16*)(ws + WS_QL); bf16* QI = (bf16*)(ws + WS_QI); float* MISC = (float*)(ws + WS_MISC); bf16* U = (bf16*)(ws + WS_U); bf16* SG = (bf16*)(ws + WS_SG);
    bf16* CKV = (bf16*)(ws + WS_CKV); bf16* POOLED = (bf16*)(ws + WS_POOLED); bf16* OLAT = (bf16*)(ws + WS_OLAT); bf16* TMP = (bf16*)(ws + WS_TMP); bf16* MIX = (bf16*)(ws + WS_MIX);
    float* Z = (float*)(ws + WS_Z); float* X1 = (float*)(ws + WS_X1); bf16* H2 = (bf16*)(ws + WS_H); int* SLOTMAP = (int*)(ws + WS_SLOTMAP); int* TOKSLOT = (int*)(ws + WS_TOKSLOT); float* GATE = (float*)(ws + WS_GATE);
    bf16* ACT = (bf16*)(ws + WS_ACT); bf16* Y = (bf16*)(ws + WS_Y); int* SEL = (int*)(ws + WS_SEL); int* CNT = (int*)(ws + WS_CNT);
    int* gcnt = (int*)(ws + WS_CTL) + CW_GCNT; int* tstart = (int*)(ws + WS_CTL) + CW_TSTART;
    bf16* Woa_t = (bf16*)(ws + WS_WOA); bf16* Wpb_t = (bf16*)(ws + WS_WPB); bf16* Wout_t = (bf16*)(ws + WS_WOUT); bf16* Wgu_t = (bf16*)(ws + WS_WGU); bf16* Wd_t = (bf16*)(ws + WS_WD);
    using namespace tmpk;
    launch_mk(a, 0, 12, grid, stream);
}
```

```cpp
#include <hip/hip_runtime.h>
#include <cstdio>
#include <cstdint>
namespace pg8 {
#define PG8_LAS __attribute__((address_space(3)))
typedef unsigned short bf16_t;
typedef short bf16x8 __attribute__((ext_vector_type(8)));
typedef float f32x4 __attribute__((ext_vector_type(4)));
typedef unsigned u32x4 __attribute__((ext_vector_type(4)));
constexpr int BM = 256, BK = 64, HALF = 128, HTB = HALF * BK * 2  , STAGE_BYTES = 8 * HTB, NXCD = 8, WGM = 8;

__host__ __device__ __forceinline__ int lds_byte(int r, int c) { const int st = (r >> 4) * 2 + (c >> 5), rr = r & 15, cc = c & 31, ob = rr * 64 + cc * 2; return st * 1024 + (ob ^ (((ob >> 9) & 1) << 5)); }
__host__ __device__ __forceinline__ void stage_rc(int b, int& R, int& C) { const int st = b / 1024, sb = b % 1024, swz = sb ^ (((sb >> 9) & 1) << 5); R = (st >> 1) * 16 + swz / 64; C = (st & 1) * 32 + (swz % 64) / 2; }
__host__ __device__ __forceinline__ int perm32(int rho) { const int n = rho >> 4, i = rho & 15; return 8 * (i >> 2) + 4 * n + (i & 3); }

struct Unit { int pm, pn; };
struct Gemm { const bf16_t* A; const bf16_t* Bt; int M, N, K; };

struct StaticOrder {
    int nM, nN, nwg, G, c;
    __host__ __device__ void init(int M, int N, int G_, int c_) { nM = M / BM; nN = N / BM; nwg = nM * nN; G = G_; c = c_; }
    __host__ __device__ bool next(int i, Unit& u) const {
        const long L = (long)i * G + c; if (L >= nwg) return false;
        int wgid = (int)L; { const int q = nwg / NXCD, r = nwg % NXCD, xcd = wgid % NXCD, off = wgid / NXCD; wgid = (xcd < r ? xcd * (q + 1) : r * (q + 1) + (xcd - r) * q) + off; }
        const int nig = WGM * nN, gid = wgid / nig, fm = gid * WGM, gsz = (nM - fm) < WGM ? (nM - fm) : WGM;
        u.pm = fm + ((wgid % nig) % gsz); u.pn = (wgid % nig) / gsz; return true;
    }
    __device__ __forceinline__ void a_ready(const Unit&) const {}
    __device__ __forceinline__ void done(const Unit&) const {}
};

__device__ __forceinline__ unsigned cvt_pk_bf16(float lo, float hi) { unsigned r; asm volatile("v_cvt_pk_bf16_f32 %0, %1, %2" : "=v"(r) : "v"(lo), "v"(hi)); return r; }
typedef float f32x2 __attribute__((ext_vector_type(2)));
__device__ __forceinline__ f32x2 gelu_pk(f32x2 v) {
    const f32x2 av = __builtin_elementwise_abs(v), d = av * 0.2316418882f + 1.0f;
    f32x2 t; t.x = __builtin_amdgcn_rcpf(d.x); t.y = __builtin_amdgcn_rcpf(d.y);
    f32x2 q = t * 0.5307027145f + (-0.7265760135f); q = q * t + 0.7107068705f; q = q * t + (-0.142248368f); q = q * t + 0.127414796f; q = q * t;
    const f32x2 s = (v * v) * (-0.72134752044f);
    f32x2 e; e.x = __builtin_amdgcn_exp2f(s.x); e.y = __builtin_amdgcn_exp2f(s.y);
    const f32x2 m = v * (q * e), r = v - m;
    f32x2 o; o.x = v.x < 0.f ? m.x : r.x; o.y = v.y < 0.f ? m.y : r.y; return o;
}

template <int ACT  > struct EpiBf16 {
    static constexpr bool PERM = true, AFTER_DRAIN = false; static_assert(ACT == 0 || ACT == 1, "EpiBf16: ACT is 0 (none) or 1 (gelu_pk)");
    bf16_t* O; int ldc; const float* bias; int split_cols; size_t split_stride; float scale0;
    __device__ __forceinline__ void operator()(const f32x4 (&acc)[2][2][4][2], const Unit& u, int wr, int wc, int fr, int fq) const {
        const int row0 = u.pm * BM + wr * 64 + fr; int colt = u.pn * BM; bf16_t* base = O;
        float sc = 1.f; if (split_cols) { const int t = colt / split_cols; base += (size_t)t * split_stride; colt -= t * split_cols; if (t == 0) sc = scale0; }
        const int col0 = colt + wc * 32 + 8 * fq, bcol0 = u.pn * BM + wc * 32 + 8 * fq;
        f32x4 bv[2][2];
#pragma unroll
        for (int bj = 0; bj < 2; ++bj)
#pragma unroll
            for (int n = 0; n < 2; ++n) bv[bj][n] = bias ? *(const f32x4*)(bias + bcol0 + bj * HALF + 4 * n) : (f32x4){0.f, 0.f, 0.f, 0.f};
#pragma unroll
        for (int ai = 0; ai < 2; ++ai)
#pragma unroll
            for (int m = 0; m < 4; ++m) { bf16_t* rowp = base + (size_t)(row0 + ai * HALF + m * 16) * ldc + col0;
#pragma unroll
                for (int bj = 0; bj < 2; ++bj) { f32x4 v0 = acc[ai][bj][m][0] + bv[bj][0], v1 = acc[ai][bj][m][1] + bv[bj][1];
                    if (ACT == 1) { f32x2 a = gelu_pk((f32x2){v0[0], v0[1]}), b = gelu_pk((f32x2){v0[2], v0[3]}), c = gelu_pk((f32x2){v1[0], v1[1]}), d = gelu_pk((f32x2){v1[2], v1[3]});
                        v0 = (f32x4){a.x, a.y, b.x, b.y}; v1 = (f32x4){c.x, c.y, d.x, d.y}; }
                    v0 = v0 * sc; v1 = v1 * sc; u32x4 w; w.x = cvt_pk_bf16(v0[0], v0[1]); w.y = cvt_pk_bf16(v0[2], v0[3]); w.z = cvt_pk_bf16(v1[0], v1[1]); w.w = cvt_pk_bf16(v1[2], v1[3]);
                    *(u32x4*)(rowp + bj * HALF) = w; } }
    }
};

struct PanelStats {
    unsigned* xbuf;
    unsigned* cnt;
    unsigned* tmo;
    int ntn; float eps;
    unsigned code;
    __device__ __forceinline__ bool run(const f32x4 (&v)[2][2][4][2], const Unit& u, int wr, int wc, int fr, int fq, PG8_LAS unsigned char* lds, int wid, int lane) const {
        typedef float f32x2v __attribute__((ext_vector_type(2)));
        PG8_LAS f32x2v* P = (PG8_LAS f32x2v*)lds;
        PG8_LAS f32x2v* S = (PG8_LAS f32x2v*)(lds + 8192);
        PG8_LAS unsigned* flag = (PG8_LAS unsigned*)(lds + 8192 + 2048);
#pragma unroll
        for (int ai = 0; ai < 2; ++ai)
#pragma unroll
            for (int m = 0; m < 4; ++m) {
                float s = 0.f;
#pragma unroll
                for (int bj = 0; bj < 2; ++bj)
#pragma unroll
                    for (int n = 0; n < 2; ++n) { const f32x4 x = v[ai][bj][m][n]; s += (x[0] + x[1]) + (x[2] + x[3]); }
                s += __shfl_xor(s, 16); s += __shfl_xor(s, 32);
                const float mw = s * (1.0f / 64.0f); float q = 0.f;
#pragma unroll
                for (int bj = 0; bj < 2; ++bj)
#pragma unroll
                    for (int n = 0; n < 2; ++n) { const f32x4 d = v[ai][bj][m][n] - mw; q += (d[0] * d[0] + d[1] * d[1]) + (d[2] * d[2] + d[3] * d[3]); }
                q += __shfl_xor(q, 16); q += __shfl_xor(q, 32);
                if (fq == 0) P[(ai * HALF + wr * 64 + m * 16 + fr) * 4 + wc] = (f32x2v){mw, q};
            }
        asm volatile("s_waitcnt lgkmcnt(0)" ::: "memory"); __builtin_amdgcn_s_barrier(); asm volatile("" ::: "memory");
#if defined(BROKEN_EXCHANGE_NO_WAIT)
#warning BROKEN CONTROL BUILD: the row-statistics exchange does not wait; results are wrong by design
        if (blockIdx.x >= 64) { const long long t0_ = clock64(); while (clock64() - t0_ < 60000) __builtin_amdgcn_s_sleep(8); }
#endif
        const int row = wid * 32 + (lane & 31);
        if (lane < 32) {
            const f32x2v a = P[row * 4 + 0], b = P[row * 4 + 1], c = P[row * 4 + 2], d = P[row * 4 + 3];
            const float mt = (a.x + b.x + c.x + d.x) * 0.25f;
            const float da = a.x - mt, db = b.x - mt, dc = c.x - mt, dd = d.x - mt;
            const float m2 = (a.y + b.y) + (c.y + d.y) + 64.0f * ((da * da + db * db) + (dc * dc + dd * dd));
            unsigned long long* slot = (unsigned long long*)xbuf + ((size_t)(u.pm * BM + row) * 4 + u.pn);
            __hip_atomic_store(slot, ((unsigned long long)__float_as_uint(m2) << 32) | __float_as_uint(mt), __ATOMIC_RELAXED, __HIP_MEMORY_SCOPE_AGENT);
        }
        asm volatile("s_waitcnt vmcnt(0)" ::: "memory");
        if (lane == 0) __hip_atomic_fetch_add(cnt + 64 * u.pm, 1u, __ATOMIC_RELAXED, __HIP_MEMORY_SCOPE_AGENT);
        if (wid == 0) {
            bool dead = false; const unsigned long long t0 = __builtin_amdgcn_s_memrealtime(); const unsigned want = 8u * (unsigned)ntn;
            for (;;) {
#if defined(BROKEN_EXCHANGE_NO_WAIT)
                break;
#endif
                if ((unsigned)__builtin_amdgcn_readfirstlane(__hip_atomic_load(cnt + 64 * u.pm, __ATOMIC_RELAXED, __HIP_MEMORY_SCOPE_AGENT)) >= want) break;
                if (__builtin_amdgcn_s_memrealtime() - t0 > 2000000ull) {
                    if (lane == 0) { unsigned expect = 0u; __hip_atomic_compare_exchange_strong(tmo + 1, &expect, code | (unsigned)(u.pm & 0xff), __ATOMIC_RELAXED, __ATOMIC_RELAXED, __HIP_MEMORY_SCOPE_AGENT);
                                     __hip_atomic_store(tmo, 1u, __ATOMIC_RELAXED, __HIP_MEMORY_SCOPE_AGENT); }
                    dead = true; break; }
                __builtin_amdgcn_s_sleep(2);
            }
            __builtin_amdgcn_fence(__ATOMIC_ACQUIRE, "agent");
            if (lane == 0) flag[0] = dead ? 1u : 0u;
        }
        asm volatile("s_waitcnt vmcnt(0) lgkmcnt(0)" ::: "memory"); __builtin_amdgcn_s_barrier(); asm volatile("" ::: "memory");
        const bool bad = flag[0] != 0u;
        if (lane < 32) {
            const unsigned long long* slot = (const unsigned long long*)xbuf + (size_t)(u.pm * BM + row) * 4; float mt[4], m2[4]; float ms = 0.f;
#pragma unroll
            for (int t = 0; t < 4; ++t) { if (t < ntn) { const unsigned long long w = __hip_atomic_load(slot + t, __ATOMIC_RELAXED, __HIP_MEMORY_SCOPE_AGENT); mt[t] = __uint_as_float((unsigned)w); m2[t] = __uint_as_float((unsigned)(w >> 32)); } else { mt[t] = 0.f; m2[t] = 0.f; } ms += mt[t]; }
            const float mean = ms / (float)ntn; float q = 0.f;
#pragma unroll
            for (int t = 0; t < 4; ++t) if (t < ntn) { const float dm = mt[t] - mean; q += m2[t] + 256.0f * dm * dm; }
            S[row] = (f32x2v){mean, 1.0f / sqrtf(q / (256.0f * (float)ntn) + eps)};
        }
        asm volatile("s_waitcnt lgkmcnt(0)" ::: "memory"); __builtin_amdgcn_s_barrier(); asm volatile("" ::: "memory");
        return bad;
    }
};
struct EpiLnRes {
    static constexpr bool PERM = false, AFTER_DRAIN = true;
    const float* base; float* out; int ldc; const float* bias; PanelStats st; unsigned poison;
    __device__ __forceinline__ void fused(f32x4 (&acc)[2][2][4][2], const Unit& u, int wr, int wc, int fr, int fq, PG8_LAS unsigned char* lds, int wid, int lane) const {
        typedef float f32x2v __attribute__((ext_vector_type(2)));
        const PG8_LAS f32x2v* S = (const PG8_LAS f32x2v*)(lds + 8192);
        const int col0 = u.pn * BM + wc * 32 + 4 * fq;
#pragma unroll
        for (int bj = 0; bj < 2; ++bj)
#pragma unroll
            for (int n = 0; n < 2; ++n) { const f32x4 bv = bias ? *(const f32x4*)(bias + col0 + bj * HALF + n * 16) : (f32x4){0.f, 0.f, 0.f, 0.f};
#pragma unroll
                for (int ai = 0; ai < 2; ++ai)
#pragma unroll
                    for (int m = 0; m < 4; ++m) acc[ai][bj][m][n] += bv; }
        f32x4 pre[4][2][2];
#pragma unroll
        for (int m = 0; m < 4; ++m) { const size_t off = (size_t)(u.pm * BM + wr * 64 + m * 16 + fr) * ldc + col0;
#pragma unroll
            for (int bj = 0; bj < 2; ++bj)
#pragma unroll
                for (int n = 0; n < 2; ++n) pre[m][bj][n] = *(const f32x4*)(base + off + bj * HALF + n * 16); }
        const bool bad = st.run(acc, u, wr, wc, fr, fq, lds, wid, lane) || poison != 0u;
        const float qnan = __builtin_nanf("");
#pragma unroll
        for (int ai = 0; ai < 2; ++ai)
#pragma unroll
            for (int m = 0; m < 4; ++m) { const int r = ai * HALF + wr * 64 + m * 16 + fr; const f32x2v sr = S[r]; const size_t off = (size_t)(u.pm * BM + r) * ldc + col0;
#pragma unroll
                for (int bj = 0; bj < 2; ++bj)
#pragma unroll
                    for (int n = 0; n < 2; ++n) { const f32x4 bs = ai == 0 ? pre[m][bj][n] : *(const f32x4*)(base + off + bj * HALF + n * 16); f32x4 o = bs + (acc[ai][bj][m][n] - sr.x) * sr.y;
                        if (bad) o = (f32x4){qnan, qnan, qnan, qnan}; *(f32x4*)(out + off + bj * HALF + n * 16) = o; }
                if (m & 1) asm volatile("" ::: "memory"); }
    }
};
struct EpiLnResLn {
    static constexpr bool PERM = false, AFTER_DRAIN = true;
    const float* base; float* out; bf16_t* xn; int ldc; const float* bias; PanelStats st1, st2; unsigned poison;
    __device__ __forceinline__ void fused(f32x4 (&acc)[2][2][4][2], const Unit& u, int wr, int wc, int fr, int fq, PG8_LAS unsigned char* lds, int wid, int lane) const {
        typedef float f32x2v __attribute__((ext_vector_type(2))); typedef unsigned u32x2v __attribute__((ext_vector_type(2)));
        const PG8_LAS f32x2v* S = (const PG8_LAS f32x2v*)(lds + 8192);
        const int col0 = u.pn * BM + wc * 32 + 4 * fq;
#pragma unroll
        for (int bj = 0; bj < 2; ++bj)
#pragma unroll
            for (int n = 0; n < 2; ++n) { const f32x4 bv = bias ? *(const f32x4*)(bias + col0 + bj * HALF + n * 16) : (f32x4){0.f, 0.f, 0.f, 0.f};
#pragma unroll
                for (int ai = 0; ai < 2; ++ai)
#pragma unroll
                    for (int m = 0; m < 4; ++m) acc[ai][bj][m][n] += bv; }
        bool bad = st1.run(acc, u, wr, wc, fr, fq, lds, wid, lane) || poison != 0u;
        const float qnan = __builtin_nanf("");
#pragma unroll
        for (int ai = 0; ai < 2; ++ai)
#pragma unroll
            for (int m = 0; m < 4; ++m) { const int r = ai * HALF + wr * 64 + m * 16 + fr; const f32x2v sr = S[r]; const size_t off = (size_t)(u.pm * BM + r) * ldc + col0;
#pragma unroll
                for (int bj = 0; bj < 2; ++bj)
#pragma unroll
                    for (int n = 0; n < 2; ++n) { const f32x4 bs = *(const f32x4*)(base + off + bj * HALF + n * 16); acc[ai][bj][m][n] = bs + (acc[ai][bj][m][n] - sr.x) * sr.y; }
                asm volatile("" : "+v"(acc[ai][0][m][0]), "+v"(acc[ai][0][m][1]), "+v"(acc[ai][1][m][0]), "+v"(acc[ai][1][m][1]));
                if (m & 1) asm volatile("" ::: "memory"); }
        const bool bad1 = bad;
        bad = st2.run(acc, u, wr, wc, fr, fq, lds, wid, lane) || bad;
#pragma unroll
        for (int ai = 0; ai < 2; ++ai)
#pragma unroll
            for (int m = 0; m < 4; ++m) { const int r = ai * HALF + wr * 64 + m * 16 + fr; const f32x2v sr = S[r]; const size_t off = (size_t)(u.pm * BM + r) * ldc + col0;
#pragma unroll
                for (int bj = 0; bj < 2; ++bj)
#pragma unroll
                    for (int n = 0; n < 2; ++n) { const f32x4 x1 = acc[ai][bj][m][n]; *(f32x4*)(out + off + bj * HALF + n * 16) = bad1 ? (f32x4){qnan, qnan, qnan, qnan} : x1;
                        const f32x4 o = (x1 - sr.x) * sr.y; u32x2v w; w.x = cvt_pk_bf16(o[0], o[1]); w.y = cvt_pk_bf16(o[2], o[3]);
                        if (bad) { w.x = 0x7fc07fc0u; w.y = 0x7fc07fc0u; } *(u32x2v*)(xn + off + bj * HALF + n * 16) = w; }
                asm volatile("" ::: "memory"); }
    }
};

template <class Epi, class Sched, bool ALIGN_EPI = false, bool SP2 = false>
__device__ __forceinline__ void gemm_phase(PG8_LAS unsigned char* lds, const Gemm g, const Sched& S, const Epi& E) {
    const int tid = threadIdx.x, wid = __builtin_amdgcn_readfirstlane(tid >> 6), lane = tid & 63, wr = wid >> 2, wc = wid & 3, fr = lane & 15, fq = lane >> 4;
    const int K = g.K, nt = K / BK;
    unsigned voffA[2], voffB[2];
#pragma unroll
    for (int i = 0; i < 2; ++i) { int R, C; stage_rc(tid * 16 + i * 8192, R, C); const int Rb = Epi::PERM ? ((R & ~31) + perm32(R & 31)) : R;
        voffA[i] = (unsigned)(R * K + C) * 2u; voffB[i] = (unsigned)(Rb * K + C) * 2u; }
    const size_t kstep = (size_t)(BK * 2);
    const size_t hstep = (size_t)HALF * K * 2;
    const size_t tstep = 2 * hstep;
    const unsigned ldsw = (unsigned)wid * 1024u;
    const int aoff = lds_byte(wr * 64 + fr, fq * 8), boff = lds_byte(wc * 32 + fr, fq * 8);
#define PG8_SA(b, h) (((b) * 2 + (h)) * HTB)
#define PG8_SB(b, h) ((4 + (b) * 2 + (h)) * HTB)
#define PG8_STAGE(bufoff, gbase, voff) do { _Pragma("unroll") for (int _i = 0; _i < 2; ++_i) \
        __builtin_amdgcn_global_load_lds((const unsigned*)((const char*)(gbase) + (voff)[_i]), (PG8_LAS unsigned*)(lds + (bufoff) + ldsw + _i * 8192), 16, 0, 0); } while (0)
#define PG8_LDA(dst, b, h) do { _Pragma("unroll") for (int m = 0; m < 4; ++m) _Pragma("unroll") for (int k = 0; k < 2; ++k) dst[m][k] = *(const PG8_LAS bf16x8*)(lds + PG8_SA(b, h) + aoff + m * 2048 + k * 1024); } while (0)
#define PG8_LDB(dst, b, h) do { _Pragma("unroll") for (int n = 0; n < 2; ++n) _Pragma("unroll") for (int k = 0; k < 2; ++k) dst[n][k] = *(const PG8_LAS bf16x8*)(lds + PG8_SB(b, h) + boff + n * 2048 + k * 1024); } while (0)
#define PG8_MMA(ai, bj, At, Bt) do { __builtin_amdgcn_s_setprio(1); _Pragma("unroll") for (int m = 0; m < 4; ++m) _Pragma("unroll") for (int n = 0; n < 2; ++n) _Pragma("unroll") for (int k = 0; k < 2; ++k) \
        acc[ai][bj][m][n] = __builtin_amdgcn_mfma_f32_16x16x32_bf16(Bt[n][k], At[m][k], acc[ai][bj][m][n], 0, 0, 0); __builtin_amdgcn_s_setprio(0); } while (0)
#define PG8_WAIT_V(n) asm volatile("s_waitcnt vmcnt(" #n ")" ::: "memory")
#define PG8_WAIT_L(n) asm volatile("s_waitcnt lgkmcnt(" #n ")" ::: "memory")
#define PG8_BAR __builtin_amdgcn_s_barrier()
#define PG8_SCHED __builtin_amdgcn_sched_barrier(0)
    Unit cur, nxt; int ui = 0;
    if (!S.next(0, cur)) return;
    f32x4 acc[2][2][4][2];
#pragma unroll
    for (int a = 0; a < 2; ++a)
#pragma unroll
        for (int b = 0; b < 2; ++b)
#pragma unroll
            for (int m = 0; m < 4; ++m)
#pragma unroll
                for (int n = 0; n < 2; ++n) acc[a][b][m][n] = (f32x4){0.f, 0.f, 0.f, 0.f};
    bf16x8 At[4][2], B0[2][2], B1[2][2];
    const char* cA = (const char*)g.A + (size_t)cur.pm * tstep; const char* cB = (const char*)g.Bt + (size_t)cur.pn * tstep;
    S.a_ready(cur);
    if constexpr (SP2) {
        PG8_STAGE(PG8_SB(0, 0), cB, voffB); PG8_STAGE(PG8_SB(0, 1), cB + hstep, voffB); PG8_STAGE(PG8_SA(0, 0), cA, voffA); PG8_STAGE(PG8_SA(0, 1), cA + hstep, voffA);
        if (wr == 1) PG8_BAR;
        PG8_WAIT_V(2); PG8_BAR;
        PG8_STAGE(PG8_SB(1, 0), cB + kstep, voffB); PG8_STAGE(PG8_SA(1, 0), cA + kstep, voffA); PG8_STAGE(PG8_SB(1, 1), cB + hstep + kstep, voffB);
        PG8_WAIT_V(6); PG8_BAR;
    } else {
        PG8_STAGE(PG8_SB(0, 0), cB, voffB); PG8_STAGE(PG8_SA(0, 0), cA, voffA); PG8_STAGE(PG8_SB(0, 1), cB + hstep, voffB); PG8_STAGE(PG8_SA(0, 1), cA + hstep, voffA);
        if (wr == 1) PG8_BAR;
        PG8_WAIT_V(4); PG8_BAR;
        PG8_STAGE(PG8_SB(1, 0), cB + kstep, voffB); PG8_STAGE(PG8_SA(1, 0), cA + kstep, voffA); PG8_STAGE(PG8_SB(1, 1), cB + hstep + kstep, voffB);
        PG8_WAIT_V(6); PG8_BAR;
    }
    for (;;) {
        const bool has_next = S.next(ui + 1, nxt);
        const char* nA = has_next ? (const char*)g.A + (size_t)nxt.pm * tstep : cA; const char* nB = has_next ? (const char*)g.Bt + (size_t)nxt.pn * tstep : cB;
        for (int t = 0; t < nt; t += 2) {
            const bool last = (t == nt - 2);
            const char* a1 = cA + (size_t)(t + 1) * kstep;
            const char* a2 = last ? nA : cA + (size_t)(t + 2) * kstep; const char* b2 = last ? nB : cB + (size_t)(t + 2) * kstep;
            const char* a3 = a2 + kstep; const char* b3 = b2 + kstep;
            if (last && has_next) S.a_ready(nxt);
            if constexpr (SP2) {
            PG8_LDB(B0, 0, 0); PG8_LDB(B1, 0, 1); PG8_SCHED; PG8_LDA(At, 0, 0); PG8_STAGE(PG8_SA(1, 1), a1 + hstep, voffA);
            PG8_WAIT_V(8); PG8_WAIT_L(0); PG8_BAR; PG8_MMA(0, 0, At, B0); PG8_MMA(0, 1, At, B1); PG8_BAR; PG8_SCHED;
            PG8_LDA(At, 0, 1); PG8_STAGE(PG8_SB(0, 0), b2, voffB); PG8_STAGE(PG8_SB(0, 1), b2 + hstep, voffB); PG8_STAGE(PG8_SA(0, 0), a2, voffA);
            PG8_WAIT_V(8); PG8_WAIT_L(0); PG8_BAR; PG8_MMA(1, 0, At, B0); PG8_MMA(1, 1, At, B1); PG8_BAR; PG8_SCHED;
            PG8_LDB(B0, 1, 0); PG8_LDB(B1, 1, 1); PG8_SCHED; PG8_LDA(At, 1, 0); PG8_STAGE(PG8_SA(0, 1), a2 + hstep, voffA);
            PG8_WAIT_V(8); PG8_WAIT_L(0); PG8_BAR; PG8_MMA(0, 0, At, B0); PG8_MMA(0, 1, At, B1); PG8_BAR; PG8_SCHED;
            PG8_LDA(At, 1, 1); PG8_STAGE(PG8_SB(1, 0), b3, voffB); PG8_STAGE(PG8_SB(1, 1), b3 + hstep, voffB); PG8_STAGE(PG8_SA(1, 0), a3, voffA);
            PG8_WAIT_V(8); PG8_WAIT_L(0); PG8_BAR; PG8_MMA(1, 0, At, B0); PG8_MMA(1, 1, At, B1); PG8_BAR; PG8_SCHED;
            } else {
            PG8_LDB(B0, 0, 0); PG8_SCHED; PG8_LDA(At, 0, 0); PG8_STAGE(PG8_SA(1, 1), a1 + hstep, voffA);
            PG8_WAIT_L(8); PG8_BAR; PG8_WAIT_L(0); PG8_MMA(0, 0, At, B0); PG8_BAR; PG8_SCHED;
            PG8_LDB(B1, 0, 1); PG8_STAGE(PG8_SB(0, 0), b2, voffB);
            PG8_BAR; PG8_WAIT_L(0); PG8_MMA(0, 1, At, B1); PG8_BAR;
            PG8_LDA(At, 0, 1); PG8_STAGE(PG8_SA(0, 0), a2, voffA);
            PG8_BAR; PG8_WAIT_L(0); PG8_MMA(1, 0, At, B0); PG8_BAR; PG8_SCHED;
            PG8_STAGE(PG8_SB(0, 1), b2 + hstep, voffB);
            PG8_WAIT_V(6); PG8_BAR; PG8_MMA(1, 1, At, B1); PG8_BAR;
            PG8_LDB(B0, 1, 0); PG8_SCHED; PG8_LDA(At, 1, 0); PG8_STAGE(PG8_SA(0, 1), a2 + hstep, voffA);
            PG8_WAIT_L(8); PG8_BAR; PG8_WAIT_L(0); PG8_MMA(0, 0, At, B0); PG8_BAR; PG8_SCHED;
            PG8_LDB(B1, 1, 1); PG8_STAGE(PG8_SB(1, 0), b3, voffB);
            PG8_BAR; PG8_WAIT_L(0); PG8_MMA(0, 1, At, B1); PG8_BAR;
            PG8_LDA(At, 1, 1); PG8_STAGE(PG8_SA(1, 0), a3, voffA);
            PG8_BAR; PG8_WAIT_L(0); PG8_MMA(1, 0, At, B0); PG8_BAR; PG8_SCHED;
            PG8_STAGE(PG8_SB(1, 1), b3 + hstep, voffB);
            PG8_WAIT_V(6); PG8_BAR; PG8_MMA(1, 1, At, B1); PG8_BAR;
            }
        }
        if constexpr (ALIGN_EPI) { if (wr == 0) PG8_BAR; }
        if constexpr (!Epi::AFTER_DRAIN) { E(acc, cur, wr, wc, fr, fq); S.done(cur); }
        if (!has_next) break;
#pragma unroll
        for (int a = 0; a < 2; ++a)
#pragma unroll
            for (int b = 0; b < 2; ++b)
#pragma unroll
                for (int m = 0; m < 4; ++m)
#pragma unroll
                    for (int n = 0; n < 2; ++n) acc[a][b][m][n] = (f32x4){0.f, 0.f, 0.f, 0.f};
        cur = nxt; cA = nA; cB = nB; ++ui;
        if constexpr (ALIGN_EPI) { if (wr == 1) PG8_BAR; }
    }
    PG8_WAIT_V(0);
    if constexpr (!ALIGN_EPI) { if (wr == 0) PG8_BAR; }
    PG8_BAR;
    if constexpr (Epi::AFTER_DRAIN) { E.fused(acc, cur, wr, wc, fr, fq, lds, wid, lane); S.done(cur); }
#undef PG8_SA
#undef PG8_SB
#undef PG8_STAGE
#undef PG8_LDA
#undef PG8_LDB
#undef PG8_MMA
#undef PG8_WAIT_V
#undef PG8_WAIT_L
#undef PG8_BAR
#undef PG8_SCHED
}
}

#ifndef PG8_SP2
#define PG8_SP2 true
#endif
#ifndef PG8_ALIGN
#define PG8_ALIGN true
#endif
#define GAS __attribute__((address_space(1)))
#define LAS __attribute__((address_space(3)))
typedef unsigned short bf16;
typedef unsigned v4u __attribute__((ext_vector_type(4)));
typedef float f32x4 __attribute__((ext_vector_type(4)));
typedef short bf16x8 __attribute__((ext_vector_type(8)));
typedef GAS unsigned gu32;
typedef GAS unsigned long long gu64;
#define RLX_AGENT __ATOMIC_RELAXED, __HIP_MEMORY_SCOPE_AGENT
#define LDS_WAIT() asm volatile("s_waitcnt lgkmcnt(0)" ::: "memory")
#define VM_WAIT() asm volatile("s_waitcnt vmcnt(0)" ::: "memory")
__device__ __forceinline__ unsigned long long rt() { return __builtin_amdgcn_s_memrealtime(); }
__device__ __forceinline__ unsigned f2bf(float f) { unsigned u = __builtin_bit_cast(unsigned, f); return (u + 0x7fffu + ((u >> 16) & 1u)) >> 16; }
__device__ __forceinline__ unsigned pk2(float lo, float hi) { return f2bf(lo) | (f2bf(hi) << 16); }

#define XB_TMO      128
#define XB_XCNT(j)  (256  + 64 * (j))
#define XB_XSUB(j)  (1280 + 64 * (j))
#define XB_XGEN(j)  (2304 + 64 * (j))
#define XB_TOP      3328
#define XB_TOPGEN   3392
#define XCD_BAR_WORDS 3456
#define XB_SPIN_CAP (1u << 18)

__device__ __forceinline__ unsigned xb_ld(unsigned* p)              { return __hip_atomic_load(p, __ATOMIC_RELAXED, __HIP_MEMORY_SCOPE_AGENT); }
__device__ __forceinline__ unsigned xb_add(unsigned* p, unsigned v) { return __hip_atomic_fetch_add(p, v, __ATOMIC_RELAXED, __HIP_MEMORY_SCOPE_AGENT); }
__device__ __forceinline__ unsigned xb_xcc_id() { return (unsigned)__builtin_amdgcn_s_getreg((3 << 11) | 20) & 0xFu; }
#define XB_SPIN(cond, bar) do { unsigned _sp = 0; while (cond) { __builtin_amdgcn_s_sleep(1); \
    if ((++_sp & 255u) == 0u) { if (xb_ld(&(bar)[XB_TMO])) break; if (_sp > XB_SPIN_CAP) { atomicAdd(&(bar)[XB_TMO], 1u); break; } } } } while (0)

struct XcdBarrier {
    unsigned* bar; unsigned x;
    volatile LAS unsigned* st;
};

__device__ __forceinline__ XcdBarrier xcd_barrier_post(unsigned* bar, volatile LAS unsigned* st) {
    XcdBarrier b; b.bar = bar; b.x = xb_xcc_id(); b.st = st;
    if (threadIdx.x == 0) (void)xb_add(&bar[XB_XCNT(b.x)], 1u);
    return b;
}
__device__ __forceinline__ void xcd_barrier_complete(unsigned* bar, unsigned x, unsigned& nloc, unsigned& nx) {
    const unsigned G = gridDim.x * gridDim.y * gridDim.z;
    unsigned sum, cnt, mine, sp = 0u;
    for (;;) {
        sum = 0u; cnt = 0u; mine = 0u;
#pragma unroll
        for (unsigned j = 0; j < 16; ++j) { const unsigned c = xb_ld(&bar[XB_XCNT(j)]); sum += c; cnt += (c > 0u) ? 1u : 0u; mine = (j == x) ? c : mine; }
        if (sum == G) break;
        __builtin_amdgcn_s_sleep(1);
        if ((++sp & 255u) == 0u) { if (xb_ld(&bar[XB_TMO])) break; if (sp > XB_SPIN_CAP) { atomicAdd(&bar[XB_TMO], 1u); break; } }
    }
    nloc = mine > 0u ? mine : 1u; nx = cnt > 0u ? cnt : 1u;
}

__device__ __forceinline__ void xcd_barrier(const XcdBarrier& b) {
    asm volatile("s_waitcnt vmcnt(0)" ::: "memory");
    __syncthreads();
    if (threadIdx.x == 0) {
        unsigned* bar = b.bar;
        __builtin_amdgcn_s_waitcnt(0);
        unsigned nloc = b.st[0], nx = b.st[1];
        if (nloc == 0u) { xcd_barrier_complete(bar, b.x, nloc, nx); b.st[0] = nloc; b.st[1] = nx; }
        const unsigned old = xb_add(&bar[XB_XSUB(b.x)], 1u);
        const unsigned gen = old / nloc;
        if (old + 1u == (gen + 1u) * nloc) {
            __builtin_amdgcn_fence(__ATOMIC_RELEASE, "agent");
            asm volatile("s_waitcnt vmcnt(0)" ::: "memory");
            const unsigned og = xb_add(&bar[XB_TOP], 1u);
            const unsigned tg = og / nx;
            if (og + 1u == (tg + 1u) * nx) xb_add(&bar[XB_TOPGEN], 1u);
            else XB_SPIN(xb_ld(&bar[XB_TOPGEN]) == tg, bar);
            __builtin_amdgcn_fence(__ATOMIC_ACQUIRE, "agent");
            xb_add(&bar[XB_XGEN(b.x)], 1u);
            asm volatile("s_waitcnt vmcnt(0)" ::: "memory");
        } else {
            XB_SPIN(xb_ld(&bar[XB_XGEN(b.x)]) == gen, bar);
            __builtin_amdgcn_fence(__ATOMIC_ACQUIRE, "agent");
            asm volatile("s_waitcnt vmcnt(0)" ::: "memory");
        }
    }
    __syncthreads();
}
constexpr int NWAVES = 8;
constexpr int B_ = 8, S_ = 2048, T = B_ * S_, D = 1024;
constexpr int INC = 3784;
constexpr int O_Q = 0, O_CKV = 512, O_QI = 640, O_KI = 1152, O_WI = 1216, O_U = 1224, O_G = 1736;
constexpr int NIN = 4352;
constexpr float ALPHA = 1.189207115002721f, LN_EPS = 1e-5f, LOG2E = 1.4426950408889634f;
constexpr int MAXROWS = T * 4 + 32 * 256;
constexpr int TOPK = 256;

constexpr size_t MiB = 1u << 20;
constexpr size_t WS_CTL = 0, CTL_ZERO_BYTES = 1 * MiB;
constexpr size_t WS_MOD = 1 * MiB, WS_WIN = 2 * MiB, WS_WOA = 11 * MiB, WS_WPB = 13 * MiB, WS_WOUT = 14 * MiB, WS_WGU = 16 * MiB, WS_WD = 144 * MiB;
constexpr size_t WS_H = 208 * MiB, WS_QL = 240 * MiB, WS_QI = 272 * MiB, WS_MISC = 288 * MiB, WS_U = 304 * MiB, WS_SG = 320 * MiB;
constexpr size_t WS_CKV = 384 * MiB, WS_CKVT = 388 * MiB, WS_POOLED = 392 * MiB, WS_MASK = 408 * MiB, WS_OLAT = 412 * MiB, WS_TMP = 444 * MiB, WS_MIX = 476 * MiB;
constexpr size_t WS_Z = 508 * MiB, WS_X1 = 572 * MiB, WS_SLOTMAP = 636 * MiB, WS_TOKSLOT = 638 * MiB, WS_GATE = 638 * MiB + 512 * 1024;
constexpr size_t WS_XPAD = 640 * MiB, WS_ACT = 784 * MiB, WS_Y = WS_XPAD, WS_KI = 928 * MiB, WS_WRB = 930 * MiB, WS_END = 931 * MiB;
constexpr int CW_GCNT = 0, CW_TSTART = 64, CW_BAR = 4096;

constexpr int RING_OFF = 0, RING_BYTES = 131072;
constexpr int LDSCTL_OFF = RING_BYTES, MISC_OFF = LDSCTL_OFF + 320;
constexpr int LDS_BYTES = 147456;

struct Frame {
    LAS unsigned char* lds;
    volatile LAS unsigned* MISCW;
    gu32* ctl;
    int tid, lane, wave, vcu, G;
    unsigned char* ws;
    float* out;
};
__device__ __forceinline__ const float* frame_in(int i) { const char* ka = (const char*)__builtin_amdgcn_kernarg_segment_ptr(); asm volatile("" : "+s"(ka)); return *(const float* const*)(ka + 8 * i); }
typedef __bf16 bf2v __attribute__((ext_vector_type(2)));
typedef float f2v __attribute__((ext_vector_type(2)));
__device__ __forceinline__ unsigned pkbf(float a, float b) { f2v v = {a, b}; bf2v r = __builtin_convertvector(v, bf2v); return __builtin_bit_cast(unsigned, r); }
__device__ __forceinline__ float bf2f(unsigned short u) { return __uint_as_float((unsigned)u << 16); }
__device__ __forceinline__ float sigm_fast(float x) { return __builtin_amdgcn_rcpf(1.f + __builtin_amdgcn_exp2f(-x * LOG2E)); }

typedef float f32x16 __attribute__((ext_vector_type(16)));
__device__ __forceinline__ bf16x8 pack8(float a0, float a1, float a2, float a3, float a4, float a5, float a6, float a7) {
    v4u p; p.x = pkbf(a0, a1); p.y = pkbf(a2, a3); p.z = pkbf(a4, a5); p.w = pkbf(a6, a7); return __builtin_bit_cast(bf16x8, p); }
#define MFMA32(a, b, c) __builtin_amdgcn_mfma_f32_32x32x16_bf16((a), (b), (c), 0, 0, 0)
__device__ __forceinline__ int krow16(int r, int hh) { return (r & 3) + 8 * (r >> 2) + 4 * hh; }

namespace pg8 {
struct EpiInProj {
    static constexpr bool PERM = true, AFTER_DRAIN = false;
    bf16_t *QL, *QI, *U, *SG; float* MISC; bf16_t* KI;
    __device__ __forceinline__ void operator()(const f32x4 (&acc)[2][2][4][2], const Unit& u, int wr, int wc, int fr, int fq) const {
        const int row0 = u.pm * BM + wr * 64 + fr, c0 = wc * 32 + 8 * fq; const int pn = u.pn;
        if (pn == 6) {
#pragma unroll
            for (int ai = 0; ai < 2; ++ai)
#pragma unroll
                for (int m = 0; m < 4; ++m) { float* rowp = MISC + (size_t)(row0 + ai * HALF + m * 16) * 256 + c0;
#pragma unroll
                    for (int bj = 0; bj < 2; ++bj) { *(f32x4*)(rowp + bj * HALF) = acc[ai][bj][m][0]; *(f32x4*)(rowp + bj * HALF + 4) = acc[ai][bj][m][1]; }
                    if (wc < 2) { const f32x4 v0 = acc[ai][1][m][0], v1 = acc[ai][1][m][1]; u32x4 w; w.x = cvt_pk_bf16(v0[0], v0[1]); w.y = cvt_pk_bf16(v0[2], v0[3]); w.z = cvt_pk_bf16(v1[0], v1[1]); w.w = cvt_pk_bf16(v1[2], v1[3]);
                        *(u32x4*)(KI + (size_t)(row0 + ai * HALF + m * 16) * 64 + c0) = w; } }
        } else {
            bf16_t* base; int ld, colt; bool sg = false;
            if (pn < 4) { base = QL; ld = 1024; colt = pn * 256; }
            else if (pn < 6) { base = QI; ld = 512; colt = (pn - 4) * 256; }
            else if (pn < 9) { base = U; ld = 512; colt = (pn - 7) * 256; }
            else { base = SG; ld = 2048; colt = (pn - 9) * 256; sg = true; }
#pragma unroll
            for (int ai = 0; ai < 2; ++ai)
#pragma unroll
                for (int m = 0; m < 4; ++m) { bf16_t* rowp = base + (size_t)(row0 + ai * HALF + m * 16) * ld + colt + c0;
#pragma unroll
                    for (int bj = 0; bj < 2; ++bj) { f32x4 v0 = acc[ai][bj][m][0], v1 = acc[ai][bj][m][1];
                        if (sg) {
#pragma unroll
                            for (int i = 0; i < 4; ++i) { v0[i] = sigm_fast(v0[i]); v1[i] = sigm_fast(v1[i]); } }
                        u32x4 w; w.x = cvt_pk_bf16(v0[0], v0[1]); w.y = cvt_pk_bf16(v0[2], v0[3]); w.z = cvt_pk_bf16(v1[0], v1[1]); w.w = cvt_pk_bf16(v1[2], v1[3]);
                        *(u32x4*)(rowp + bj * HALF) = w; } }
        }
    }
};
}

__device__ __forceinline__ void tr_item(const float* W, int ldw, int k0, int n0, int ncols, float scale, bf16* WT, int ldt, int drow0, LAS float* scr, int lane) {
    const int nn = lane & 31;
#pragma unroll 8
    for (int i = 0; i < 32; ++i) { const int kk = 2 * i + (lane >> 5); scr[kk * 33 + nn] = (nn < ncols) ? W[(size_t)(k0 + kk) * ldw + n0 + nn] * scale : 0.f; }
    LDS_WAIT(); asm volatile("" ::: "memory");
    const int c = lane & 7;
#pragma unroll
    for (int j = 0; j < 4; ++j) { const int n = (lane >> 3) + 8 * j; const LAS float* s = scr + (8 * c) * 33 + n;
        v4u o; o.x = pk2(s[0 * 33], s[1 * 33]); o.y = pk2(s[2 * 33], s[3 * 33]); o.z = pk2(s[4 * 33], s[5 * 33]); o.w = pk2(s[6 * 33], s[7 * 33]);
        if (n < ncols) *(GAS v4u*)(WT + (size_t)(drow0 + n) * ldt + k0 + 8 * c) = o; }
    LDS_WAIT(); asm volatile("" ::: "memory");
}
struct TrDesc { const float* src; bf16* dst; int ldw; float scale; };
__device__ __forceinline__ void tr_load(const TrDesc& d, int lane, f32x4 (&v)[16]) {
    const int kr = lane >> 4, nc = lane & 15; const float* src = d.src + (size_t)(16 * kr) * d.ldw + 4 * nc;
#pragma unroll
    for (int i = 0; i < 16; ++i) v[i] = __builtin_nontemporal_load((const f32x4*)(src + (size_t)i * d.ldw));
}
__device__ __forceinline__ void tr_finish(const TrDesc& d, LAS unsigned char* scr, int lane, const f32x4 (&v)[16]) {
    const int kr = lane >> 4, nc = lane & 15; const float scale = d.scale;
#pragma unroll
    for (int j = 0; j < 4; ++j) { const int n = 4 * nc + j; const int f = (n >> 2) & 7;
#pragma unroll
        for (int hlf = 0; hlf < 2; ++hlf) { v4u o;
            o.x = pkbf(v[8 * hlf + 0][j] * scale, v[8 * hlf + 1][j] * scale); o.y = pkbf(v[8 * hlf + 2][j] * scale, v[8 * hlf + 3][j] * scale);
            o.z = pkbf(v[8 * hlf + 4][j] * scale, v[8 * hlf + 5][j] * scale); o.w = pkbf(v[8 * hlf + 6][j] * scale, v[8 * hlf + 7][j] * scale);
            *(LAS v4u*)(scr + n * 128 + (((2 * kr + hlf) ^ f) << 4)) = o; } }
    LDS_WAIT(); asm volatile("" ::: "memory");
    const int kc = lane & 7;
#pragma unroll
    for (int j = 0; j < 8; ++j) { const int n = (lane >> 3) + 8 * j; const v4u o = *(const LAS v4u*)(scr + n * 128 + ((kc ^ ((n >> 2) & 7)) << 4));
        *(GAS v4u*)(d.dst + (size_t)n * 1024 + 8 * kc) = o; }
    LDS_WAIT(); asm volatile("" ::: "memory");
}
__device__ __forceinline__ void fold_qlat(const float* w_in, const float* w_uk, bf16* Win_t, int task, int lane) {
    const int h = task >> 8, kb = (task >> 4) & 15, r0 = (task & 15) * 8; const int k = kb * 64 + lane;
    const float* wrow = w_in + (size_t)k * INC + O_Q + h * 64; const float* up = w_uk + r0 * 512 + h * 64;
    float a[8] = {0, 0, 0, 0, 0, 0, 0, 0};
#pragma unroll 4
    for (int d4 = 0; d4 < 16; ++d4) { const f32x4 v = *(const f32x4*)(wrow + 4 * d4);
#pragma unroll
        for (int j = 0; j < 8; ++j) { const f32x4 u = *(const f32x4*)(up + j * 512 + 4 * d4); a[j] += (v.x * u.x + v.y * u.y) + (v.z * u.z + v.w * u.w); } }
#pragma unroll
    for (int j = 0; j < 8; ++j) Win_t[(size_t)(h * 128 + r0 + j) * 1024 + k] = (bf16)f2bf(a[j] * (0.125f * LOG2E));
}
__device__ __forceinline__ void fold_oa(const float* w_uv, const float* w_ba, bf16* Woa_t, int task, int lane) {
    const int h = task >> 8, nb = (task >> 4) & 15, r0 = (task & 15) * 8; const int n = nb * 64 + lane;
    const float* up = w_uv + r0 * 512 + h * 64; float a[8] = {0, 0, 0, 0, 0, 0, 0, 0};
#pragma unroll 4
    for (int d4 = 0; d4 < 16; ++d4) { float v[4];
#pragma unroll
        for (int i = 0; i < 4; ++i) v[i] = w_ba[(size_t)(h * 64 + 4 * d4 + i) * 1024 + n];
#pragma unroll
        for (int j = 0; j < 8; ++j) { const f32x4 u = *(const f32x4*)(up + j * 512 + 4 * d4); a[j] += (v[0] * u.x + v[1] * u.y) + (v[2] * u.z + v[3] * u.w); } }
    v4u o; o.x = pk2(a[0], a[1]); o.y = pk2(a[2], a[3]); o.z = pk2(a[4], a[5]); o.w = pk2(a[6], a[7]);
    *(GAS v4u*)(Woa_t + (size_t)n * 1024 + h * 128 + r0) = o;
}
__device__ __forceinline__ void fold_pb(const float* w_pg, const float* pscale, const float* w_bp, bf16* Wpb_t, int task, int lane) {
    const int g = task >> 8, nb = (task >> 4) & 15, c0 = (task & 15) * 8; const int n = nb * 64 + lane;
    const float* pg = w_pg + (size_t)g * 16384 + c0 * 128; float a[8] = {0, 0, 0, 0, 0, 0, 0, 0};
#pragma unroll 4
    for (int d4 = 0; d4 < 32; ++d4) { float v[4]; const f32x4 ps = *(const f32x4*)(pscale + g * 128 + 4 * d4);
#pragma unroll
        for (int i = 0; i < 4; ++i) v[i] = w_bp[(size_t)(g * 128 + 4 * d4 + i) * 1024 + n] * ps[i];
#pragma unroll
        for (int j = 0; j < 8; ++j) { const f32x4 u = *(const f32x4*)(pg + j * 128 + 4 * d4); a[j] += (v[0] * u.x + v[1] * u.y) + (v[2] * u.z + v[3] * u.w); } }
    v4u o; o.x = pk2(a[0], a[1]); o.y = pk2(a[2], a[3]); o.z = pk2(a[4], a[5]); o.w = pk2(a[6], a[7]);
    *(GAS v4u*)(Wpb_t + (size_t)n * 512 + g * 128 + c0) = o;
}
__device__ __forceinline__ void p0_prologue(Frame& F) {
    const float* c = frame_in(1); const float* w_ada = frame_in(2); const float* b_ada = frame_in(3); const float* w_in = frame_in(4);
    const float* w_uk = frame_in(6); const float* w_uv = frame_in(7); const float* w_pg = frame_in(8); const float* pscale = frame_in(9);
    const float* w_ba = frame_in(10); const float* w_bp = frame_in(11); const float* w_out = frame_in(12); const float* w_gu = frame_in(17); const float* w_d = frame_in(19);
    bf16* Win_t = (bf16*)(F.ws + WS_WIN); bf16* Woa_t = (bf16*)(F.ws + WS_WOA); bf16* Wpb_t = (bf16*)(F.ws + WS_WPB); bf16* Wout_t = (bf16*)(F.ws + WS_WOUT);
    bf16* Wgu_t = (bf16*)(F.ws + WS_WGU); bf16* Wd_t = (bf16*)(F.ws + WS_WD); float* MOD = (float*)(F.ws + WS_MOD);
    for (int cg = blockIdx.x; cg < 96; cg += F.G) {
        LAS float* cs = (LAS float*)(F.lds + 69632); LAS float* red = (LAS float*)(F.lds + 69632 + 32768);
        for (int i = F.tid; i < 8192; i += 512) { const float v = c[i]; cs[i] = v / (1.f + __expf(-v)); }
        __syncthreads();
        float acc[8] = {0, 0, 0, 0, 0, 0, 0, 0}; const int n = cg * 64 + F.lane;
#pragma unroll 16
        for (int k = F.wave * 128; k < F.wave * 128 + 128; ++k) { const float w = __builtin_nontemporal_load(w_ada + (size_t)k * 6144 + n);
#pragma unroll
            for (int b = 0; b < 8; ++b) acc[b] += cs[b * 1024 + k] * w; }
#pragma unroll
        for (int b = 0; b < 8; ++b) red[(F.wave * 8 + b) * 64 + F.lane] = acc[b];
        __syncthreads();
        { const int b = F.tid >> 6, l = F.tid & 63; float s = 0.f;
#pragma unroll
          for (int w = 0; w < 8; ++w) s += red[(w * 8 + b) * 64 + l];
          MOD[b * 6144 + cg * 64 + l] = s + b_ada[cg * 64 + l]; }
        __syncthreads();
    }
    LAS unsigned char* scr8 = F.lds + F.wave * 8448; LAS float* scr = (LAS float*)scr8;
    const int gw = F.vcu * NWAVES + F.wave, NGW = F.G * NWAVES;
    constexpr int I_FQ = 2048, I_FO = 2048, I_FP = 1024, I_Z = 56, I_WI = 16, I_WR = 64, NSMALL = I_FQ + I_FO + I_FP + I_Z + I_WI + I_WR;
    for (int it = gw; it < NSMALL; it += NGW) {
        int r = it;
        if (r < I_FQ) { fold_qlat(w_in, w_uk, Win_t, r, F.lane); continue; } r -= I_FQ;
        if (r < I_FO) { fold_oa(w_uv, w_ba, Woa_t, r, F.lane); continue; } r -= I_FO;
        if (r < I_FP) { fold_pb(w_pg, pscale, w_bp, Wpb_t, r, F.lane); continue; } r -= I_FP;
        if (r < I_Z) { GAS v4u* z = (GAS v4u*)(Win_t + (size_t)(1736 + r) * 1024); z[F.lane] = (v4u){0u, 0u, 0u, 0u}; z[F.lane + 64] = (v4u){0u, 0u, 0u, 0u}; continue; } r -= I_Z;
        if (r < I_WI) { tr_item(w_in, INC, r * 64, O_WI, 8, 0.35355339059327373f, Win_t, 1024, 1728, scr, F.lane); continue; } r -= I_WI;
        {
            const float* w_r = frame_in(15); bf16* WrB = (bf16*)(F.ws + WS_WRB); const int ks = r, e = F.lane & 31, h8 = F.lane >> 5; float v[8]; unsigned hi[4], lo[4];
#pragma unroll
            for (int j = 0; j < 8; ++j) v[j] = w_r[(size_t)(16 * ks + 8 * h8 + j) * 32 + e];
#pragma unroll
            for (int j = 0; j < 4; ++j) { hi[j] = pkbf(v[2 * j], v[2 * j + 1]); lo[j] = pkbf(v[2 * j] - __uint_as_float(hi[j] << 16), v[2 * j + 1] - __uint_as_float(hi[j] & 0xffff0000u)); }
            *(GAS v4u*)(WrB + ((size_t)(ks * 2) * 64 + F.lane) * 8) = (v4u){hi[0], hi[1], hi[2], hi[3]}; *(GAS v4u*)(WrB + ((size_t)(ks * 2 + 1) * 64 + F.lane) * 8) = (v4u){lo[0], lo[1], lo[2], lo[3]}; }
    }
    constexpr int I_QI = 128, I_CKV = 32, I_KI = 16, I_U = 128, I_G = 512, I_OUT = 256, I_GU = 32 * 512, I_D = 32 * 256;
    constexpr int NTR = I_QI + I_CKV + I_KI + I_U + I_G + I_OUT + I_GU + I_D;
    auto decode = [&](int r) -> TrDesc {
        if (r < I_QI) return TrDesc{w_in + (size_t)((r >> 3) * 64) * INC + O_QI + (r & 7) * 64, Win_t + (size_t)(1024 + (r & 7) * 64) * 1024 + (r >> 3) * 64, INC, 0.125f}; r -= I_QI;
        if (r < I_CKV) return TrDesc{w_in + (size_t)((r >> 1) * 64) * INC + O_CKV + (r & 1) * 64, Win_t + (size_t)(1536 + (r & 1) * 64) * 1024 + (r >> 1) * 64, INC, 1.f}; r -= I_CKV;
        if (r < I_KI) return TrDesc{w_in + (size_t)(r * 64) * INC + O_KI, Win_t + (size_t)1664 * 1024 + r * 64, INC, 1.f}; r -= I_KI;
        if (r < I_U) return TrDesc{w_in + (size_t)((r >> 3) * 64) * INC + O_U + (r & 7) * 64, Win_t + (size_t)(1792 + (r & 7) * 64) * 1024 + (r >> 3) * 64, INC, 1.f}; r -= I_U;
        if (r < I_G) return TrDesc{w_in + (size_t)((r >> 5) * 64) * INC + O_G + (r & 31) * 64, Win_t + (size_t)(2304 + (r & 31) * 64) * 1024 + (r >> 5) * 64, INC, 1.f}; r -= I_G;
        if (r < I_OUT) return TrDesc{w_out + (size_t)((r >> 4) * 64) * 1024 + (r & 15) * 64, Wout_t + (size_t)((r & 15) * 64) * 1024 + (r >> 4) * 64, 1024, 1.f}; r -= I_OUT;
        if (r < I_GU) { const int e = r >> 9, q = r & 511, kb = q >> 5, n0 = (q & 31) * 64;
            const int drow = (n0 < 1024) ? ((n0 >> 7) * 256 + (n0 & 127)) : (((n0 - 1024) >> 7) * 256 + 128 + ((n0 - 1024) & 127));
            return TrDesc{w_gu + ((size_t)e * 1024 + kb * 64) * 2048 + n0, Wgu_t + ((size_t)e * 2048 + drow) * 1024 + kb * 64, 2048, 1.f}; } r -= I_GU;
        { const int e = r >> 8, q = r & 255, kb = q >> 4, n0 = (q & 15) * 64;
          return TrDesc{w_d + ((size_t)e * 1024 + kb * 64) * 1024 + n0, Wd_t + ((size_t)e * 1024 + n0) * 1024 + kb * 64, 1024, 1.f}; }
    };
    {   f32x4 vA[16], vB[16]; TrDesc dA, dB; int it = gw;
        if (it < NTR) { dA = decode(it); tr_load(dA, F.lane, vA); }
        while (it < NTR) {
            int itn = it + NGW; if (itn < NTR) { dB = decode(itn); tr_load(dB, F.lane, vB); }
            tr_finish(dA, scr8, F.lane, vA);
            it = itn; if (it >= NTR) break;
            itn = it + NGW; if (itn < NTR) { dA = decode(itn); tr_load(dA, F.lane, vA); }
            tr_finish(dB, scr8, F.lane, vB);
            it = itn;
        }
    }
}
__device__ __forceinline__ void p1_modulate(Frame& F) {
    const float* x = frame_in(0); const float* MOD = (const float*)(F.ws + WS_MOD); bf16* H = (bf16*)(F.ws + WS_H);
    const int gw = F.vcu * NWAVES + F.wave, NGW = F.G * NWAVES;
    for (int m = gw; m < T; m += NGW) { const int b = m >> 11;
        const GAS f32x4* xr = (const GAS f32x4*)(x + (size_t)m * D) + F.lane; GAS unsigned long long* o8 = (GAS unsigned long long*)(H + (size_t)m * D) + F.lane;
#pragma unroll
        for (int j = 0; j < 4; ++j) { const f32x4 v = xr[64 * j]; const int col = 4 * F.lane + 256 * j;
            const f32x4 sh = *(const f32x4*)(MOD + b * 6144 + col), sc = *(const f32x4*)(MOD + b * 6144 + 1024 + col);
            const f32x4 h = v * (sc + 1.0f) + sh;
            o8[64 * j] = (unsigned long long)pk2(h.x, h.y) | ((unsigned long long)pk2(h.z, h.w) << 32); }
    }
}
constexpr int LC_LCNT = LDSCTL_OFF + 1024, LC_BASE = LDSCTL_OFF + 1280, LC_TSTART = LDSCTL_OFF + 1536, LC_LIST = LDSCTL_OFF + 4096;
namespace pg8 {
__device__ __forceinline__ float bfl(unsigned w) { return __uint_as_float(w << 16); }
__device__ __forceinline__ float bfh(unsigned w) { return __uint_as_float(w & 0xffff0000u); }
struct EpiGateMul {
    static constexpr bool PERM = true, AFTER_DRAIN = false;
    bf16_t* O; const bf16_t* SG; int goff, pad;
    __device__ __forceinline__ void operator()(const f32x4 (&acc)[2][2][4][2], const Unit& u, int wr, int wc, int fr, int fq) const {
        const int row0 = u.pm * BM + wr * 64 + fr, col0 = u.pn * BM + wc * 32 + 8 * fq;
#pragma unroll
        for (int ai = 0; ai < 2; ++ai)
#pragma unroll
            for (int m = 0; m < 4; ++m) { const size_t row = (size_t)(row0 + ai * HALF + m * 16);
#pragma unroll
                for (int bj = 0; bj < 2; ++bj) { const u32x4 g = *(const u32x4*)(SG + row * 2048 + goff + col0 + bj * HALF); const f32x4 v0 = acc[ai][bj][m][0], v1 = acc[ai][bj][m][1];
                    u32x4 w; w.x = cvt_pk_bf16(v0[0] * bfl(g.x), v0[1] * bfh(g.x)); w.y = cvt_pk_bf16(v0[2] * bfl(g.y), v0[3] * bfh(g.y));
                    w.z = cvt_pk_bf16(v1[0] * bfl(g.z), v1[1] * bfh(g.z)); w.w = cvt_pk_bf16(v1[2] * bfl(g.w), v1[3] * bfh(g.w));
                    *(u32x4*)(O + row * 1024 + col0 + bj * HALF) = w; } }
    }
};
struct EpiGateAdd {
    static constexpr bool PERM = true, AFTER_DRAIN = false;
    bf16_t* O; const bf16_t* TMPB; const bf16_t* SG; int goff, pad;
    __device__ __forceinline__ void operator()(const f32x4 (&acc)[2][2][4][2], const Unit& u, int wr, int wc, int fr, int fq) const {
        const int row0 = u.pm * BM + wr * 64 + fr, col0 = u.pn * BM + wc * 32 + 8 * fq;
#pragma unroll
        for (int ai = 0; ai < 2; ++ai)
#pragma unroll
            for (int m = 0; m < 4; ++m) { const size_t row = (size_t)(row0 + ai * HALF + m * 16);
#pragma unroll
                for (int bj = 0; bj < 2; ++bj) { const u32x4 g = *(const u32x4*)(SG + row * 2048 + goff + col0 + bj * HALF); const u32x4 t = *(const u32x4*)(TMPB + row * 1024 + col0 + bj * HALF);
                    const f32x4 v0 = acc[ai][bj][m][0], v1 = acc[ai][bj][m][1];
                    u32x4 w; w.x = cvt_pk_bf16(bfl(t.x) + v0[0] * bfl(g.x), bfh(t.x) + v0[1] * bfh(g.x)); w.y = cvt_pk_bf16(bfl(t.y) + v0[2] * bfl(g.y), bfh(t.y) + v0[3] * bfh(g.y));
                    w.z = cvt_pk_bf16(bfl(t.z) + v1[0] * bfl(g.z), bfh(t.z) + v1[1] * bfh(g.z)); w.w = cvt_pk_bf16(bfl(t.w) + v1[2] * bfl(g.w), bfh(t.w) + v1[3] * bfh(g.w));
                    *(u32x4*)(O + row * 1024 + col0 + bj * HALF) = w; } }
    }
};
struct EpiResid {
    static constexpr bool PERM = false, AFTER_DRAIN = false;
    float* Z; const float* x; const float* gate;
    __device__ __forceinline__ void operator()(const f32x4 (&acc)[2][2][4][2], const Unit& u, int wr, int wc, int fr, int fq) const {
        const int row0 = u.pm * BM + wr * 64 + fr, col0 = u.pn * BM + wc * 32 + 4 * fq; const int b = (u.pm * BM) >> 11;
        f32x4 gv[2][2];
#pragma unroll
        for (int bj = 0; bj < 2; ++bj)
#pragma unroll
            for (int n = 0; n < 2; ++n) gv[bj][n] = *(const f32x4*)(gate + b * 6144 + col0 + bj * HALF + n * 16);
#pragma unroll
        for (int ai = 0; ai < 2; ++ai)
#pragma unroll
            for (int m = 0; m < 4; ++m) { const size_t off = (size_t)(row0 + ai * HALF + m * 16) * 1024 + col0;
#pragma unroll
                for (int bj = 0; bj < 2; ++bj)
#pragma unroll
                    for (int n = 0; n < 2; ++n) { const f32x4 xv = *(const f32x4*)(x + off + bj * HALF + n * 16); *(f32x4*)(Z + off + bj * HALF + n * 16) = xv * ALPHA + gv[bj][n] * acc[ai][bj][m][n]; } }
    }
};
struct EpiSwiglu {
    static constexpr bool PERM = true, AFTER_DRAIN = false;
    bf16_t* ACT; const float* bgu;
    __device__ __forceinline__ void operator()(const f32x4 (&acc)[2][2][4][2], const Unit& u, int wr, int wc, int fr, int fq) const {
        const int e = u.pn >> 3, j = u.pn & 7; const int row0 = u.pm * BM + wr * 64 + fr, cc = wc * 32 + 8 * fq;
        const float* bg = bgu + e * 2048 + j * 128 + cc; f32x4 bgl[2], bli[2];
#pragma unroll
        for (int n = 0; n < 2; ++n) { bgl[n] = *(const f32x4*)(bg + 4 * n); bli[n] = *(const f32x4*)(bg + 1024 + 4 * n); }
#pragma unroll
        for (int ai = 0; ai < 2; ++ai)
#pragma unroll
            for (int m = 0; m < 4; ++m) { float o[8];
#pragma unroll
                for (int n = 0; n < 2; ++n) { const f32x4 gl4 = acc[ai][0][m][n] + bgl[n], li4 = acc[ai][1][m][n] + bli[n];
#pragma unroll
                    for (int i = 0; i < 4; ++i) { const float gl = fminf(gl4[i], 7.f), li = fminf(fmaxf(li4[i], -7.f), 7.f);
                        o[4 * n + i] = gl * __builtin_amdgcn_rcpf(1.f + __builtin_amdgcn_exp2f(gl * (-1.702f * LOG2E))) * (li + 1.f); } }
                u32x4 w; w.x = cvt_pk_bf16(o[0], o[1]); w.y = cvt_pk_bf16(o[2], o[3]); w.z = cvt_pk_bf16(o[4], o[5]); w.w = cvt_pk_bf16(o[6], o[7]);
                *(u32x4*)(ACT + (size_t)(row0 + ai * HALF + m * 16) * 1024 + j * 128 + cc) = w; }
    }
};
struct EpiDown {
    static constexpr bool PERM = true, AFTER_DRAIN = false;
    bf16_t* Y; const float* bd;
    __device__ __forceinline__ void operator()(const f32x4 (&acc)[2][2][4][2], const Unit& u, int wr, int wc, int fr, int fq) const {
        const int e = u.pn >> 2, j = u.pn & 3; const int row0 = u.pm * BM + wr * 64 + fr, col0 = j * 256 + wc * 32 + 8 * fq;
        f32x4 bv[2][2];
#pragma unroll
        for (int bj = 0; bj < 2; ++bj)
#pragma unroll
            for (int n = 0; n < 2; ++n) bv[bj][n] = *(const f32x4*)(bd + e * 1024 + col0 + bj * HALF + 4 * n);
#pragma unroll
        for (int ai = 0; ai < 2; ++ai)
#pragma unroll
            for (int m = 0; m < 4; ++m) { bf16_t* rowp = Y + (size_t)(row0 + ai * HALF + m * 16) * 1024 + col0;
#pragma unroll
                for (int bj = 0; bj < 2; ++bj) { const f32x4 v0 = acc[ai][bj][m][0] + bv[bj][0], v1 = acc[ai][bj][m][1] + bv[bj][1];
                    u32x4 w; w.x = cvt_pk_bf16(v0[0], v0[1]); w.y = cvt_pk_bf16(v0[2], v0[3]); w.z = cvt_pk_bf16(v1[0], v1[1]); w.w = cvt_pk_bf16(v1[2], v1[3]);
                    *(u32x4*)(rowp + bj * HALF) = w; } }
    }
};
struct MoeOrder {
    const PG8_LAS int* tstart; int NT, G, c;
    __device__ __forceinline__ bool next(int i, Unit& u) const {
        const int x = c & 7, li = c >> 3, per = G >> 3; int L = i * per + li;
#pragma unroll 1
        for (int j = 0; j < 4; ++j) { const int e = x + 8 * j; const int nte = tstart[e + 1] - tstart[e], nu = nte * NT;
            if (L < nu) { u.pm = tstart[e] + L % nte; u.pn = e * NT + L / nte; return true; }
            L -= nu; }
        return false;
    }
    __device__ __forceinline__ void a_ready(const Unit&) const {}
    __device__ __forceinline__ void done(const Unit&) const {}
};
}

__device__ __forceinline__ float wave_sum(float v) {
#pragma unroll
    for (int o = 1; o < 64; o <<= 1) v += __shfl_xor(v, o);
    return v;
}
__device__ __forceinline__ void p3_post(Frame& F) {
    const float* MISC = (const float*)(F.ws + WS_MISC); const float* kvg = frame_in(5); bf16* CKV = (bf16*)(F.ws + WS_CKV); bf16* CKVT = (bf16*)(F.ws + WS_CKVT);
    const bf16* U = (const bf16*)(F.ws + WS_U); bf16* POOLED = (bf16*)(F.ws + WS_POOLED);
    LAS bf16* tile = (LAS bf16*)(F.lds);
    for (int task = blockIdx.x; task < 256; task += F.G) {
        const int t0 = task * 64; const int row = F.tid >> 3, seg = F.tid & 7;
        const float* src = MISC + (size_t)(t0 + row) * 256 + seg * 16; f32x4 v[4]; float ss = 0.f;
#pragma unroll
        for (int i = 0; i < 4; ++i) { v[i] = *(const f32x4*)(src + 4 * i); ss += (v[i].x * v[i].x + v[i].y * v[i].y) + (v[i].z * v[i].z + v[i].w * v[i].w); }
        ss += __shfl_xor(ss, 1); ss += __shfl_xor(ss, 2); ss += __shfl_xor(ss, 4);
        const float rs = 1.0f / sqrtf(ss * (1.f / 128.f) + LN_EPS);
        unsigned w[8];
#pragma unroll
        for (int i = 0; i < 4; ++i) { const f32x4 g = *(const f32x4*)(kvg + seg * 16 + 4 * i); w[2 * i] = pk2(v[i].x * rs * g.x, v[i].y * rs * g.y); w[2 * i + 1] = pk2(v[i].z * rs * g.z, v[i].w * rs * g.w); }
        GAS v4u* dst = (GAS v4u*)(CKV + (size_t)(t0 + row) * 128 + seg * 16); dst[0] = (v4u){w[0], w[1], w[2], w[3]}; dst[1] = (v4u){w[4], w[5], w[6], w[7]};
        LAS v4u* lt = (LAS v4u*)(tile + row * 128 + seg * 16); lt[0] = (v4u){w[0], w[1], w[2], w[3]}; lt[1] = (v4u){w[4], w[5], w[6], w[7]};
        __syncthreads();
        { const int d = F.tid >> 2, part = F.tid & 3; unsigned o[8];
#pragma unroll
          for (int q = 0; q < 16; q += 2) { unsigned pr[2];
#pragma unroll
              for (int z = 0; z < 2; ++z) { const int p = part * 16 + q + z; const int j = p & 7, h = (p >> 3) & 1, tt = (p >> 4) & 1, kb = p >> 5; const int key = kb * 32 + 16 * tt + 8 * (j >> 2) + 4 * h + (j & 3); pr[z] = tile[key * 128 + d]; }
              o[q >> 1] = pr[0] | (pr[1] << 16); }
          const int b = task >> 5, kt = task & 31;
          GAS v4u* dt = (GAS v4u*)(CKVT + ((size_t)(b * 128 + d) * 2048) + kt * 64 + part * 16); dt[0] = (v4u){o[0], o[1], o[2], o[3]}; dt[1] = (v4u){o[4], o[5], o[6], o[7]}; }
        __syncthreads();
    }
    for (int task = blockIdx.x; task < 1024; task += F.G) {
        const int c = F.tid, g = c >> 7; const int t0 = task * 16, s0 = t0 & 2047; const bf16* up = U + (size_t)(t0 - s0) * 512 + c;
        float v[32];
#pragma unroll
        for (int j = 0; j < 32; ++j) { const int sp = s0 - 16 + j; v[j] = (sp >= 0) ? bf2f(up[(size_t)(sp < 0 ? 0 : sp) * 512]) : 0.f; }
        float pre[33]; pre[0] = 0.f;
#pragma unroll
        for (int j = 0; j < 32; ++j) pre[j + 1] = pre[j] + v[j];
#define POOL_OUT(W) _Pragma("unroll") for (int j = 16; j < 32; ++j) { const int s = s0 + j - 16; const int cntw = (s + 1 < (W)) ? (s + 1) : (W); \
            POOLED[(size_t)(t0 + j - 16) * 512 + c] = (bf16)f2bf((pre[j + 1] - pre[j + 1 - (W)]) / (float)cntw - v[j]); }
        if (g == 0) { POOL_OUT(2) } else if (g == 1) { POOL_OUT(4) } else if (g == 2) { POOL_OUT(8) } else { POOL_OUT(16) }
#undef POOL_OUT
    }
}
constexpr int P7_AL = 0, P7_LOGIT = 131072 - 4096;
__device__ __forceinline__ void p7_ln1_route(Frame& F, int cw_gcnt) {
    const float* Z = (const float*)(F.ws + WS_Z); const float* g1 = frame_in(13); const float* b1 = frame_in(14); const float* b_r = frame_in(16);
    const float* MOD = (const float*)(F.ws + WS_MOD); float* X1 = (float*)(F.ws + WS_X1); bf16* H2 = (bf16*)(F.ws + WS_H); const bf16* WrB = (const bf16*)(F.ws + WS_WRB);
    int* gcnt = (int*)(F.ctl + cw_gcnt); int* SLOTMAP = (int*)(F.ws + WS_SLOTMAP); int* TOKSLOT = (int*)(F.ws + WS_TOKSLOT); float* GATE = (float*)(F.ws + WS_GATE);
    LAS unsigned char* AL = F.lds + P7_AL; LAS float* red = (LAS float*)(F.lds);
    LAS float* logit = (LAS float*)(F.lds + 65536);
    LAS int* lcnt = (LAS int*)(F.lds + LC_LCNT); LAS int* lbase = (LAS int*)(F.lds + LC_BASE); LAS int* list = (LAS int*)(F.lds + LC_LIST);
    if (F.tid < 32) lcnt[F.tid] = 0;
    const int hh = F.lane >> 5, l31 = F.lane & 31;
    bf16x8 Bh[8], Bl[8];
#pragma unroll
    for (int s = 0; s < 8; ++s) { const bf16* p = WrB + ((size_t)((F.wave * 8 + s) * 2) * 64 + F.lane) * 8; Bh[s] = *(const GAS bf16x8*)p; Bl[s] = *(const GAS bf16x8*)(p + 64 * 8); }
    const int rows_per_wg = T / F.G;
    for (int step = 0; step < rows_per_wg / 32; ++step) { const int m0 = blockIdx.x * rows_per_wg + step * 32;
        __syncthreads();
#pragma unroll 1
        for (int rr = 0; rr < 4; ++rr) { const int row = F.wave * 4 + rr, m = m0 + row, b = m >> 11;
            const GAS f32x4* zr = (const GAS f32x4*)(Z + (size_t)m * D) + F.lane; f32x4 v[4]; float s = 0.f;
#pragma unroll
            for (int j = 0; j < 4; ++j) { v[j] = zr[64 * j]; s += (v[j].x + v[j].y) + (v[j].z + v[j].w); }
            const float mean = wave_sum(s) * (1.f / D); float s2 = 0.f;
#pragma unroll
            for (int j = 0; j < 4; ++j) { v[j] = v[j] - mean; s2 += (v[j].x * v[j].x + v[j].y * v[j].y) + (v[j].z * v[j].z + v[j].w * v[j].w); }
            const float rstd = 1.f / sqrtf(wave_sum(s2) * (1.f / D) + LN_EPS);
#pragma unroll
            for (int j = 0; j < 4; ++j) { const int col = 4 * F.lane + 256 * j;
                const f32x4 gg = *(const f32x4*)(g1 + col), bb = *(const f32x4*)(b1 + col); const f32x4 x1 = v[j] * rstd * gg + bb;
                *((GAS f32x4*)(X1 + (size_t)m * D) + F.lane + 64 * j) = x1;
                const f32x4 sh = *(const f32x4*)(MOD + b * 6144 + 3 * 1024 + col), sc = *(const f32x4*)(MOD + b * 6144 + 4 * 1024 + col); const f32x4 h2 = x1 * (sc + 1.0f) + sh;
                const unsigned h01 = pkbf(h2.x, h2.y), h23 = pkbf(h2.z, h2.w);
                *((GAS unsigned long long*)(H2 + (size_t)m * D) + F.lane + 64 * j) = (unsigned long long)h01 | ((unsigned long long)h23 << 32);
                const unsigned l01 = pkbf(h2.x - pg8::bfl(h01), h2.y - pg8::bfh(h01)), l23 = pkbf(h2.z - pg8::bfl(h23), h2.w - pg8::bfh(h23));
                const int chunk = 32 * j + (F.lane >> 1); const int off = row * 2048 + (((chunk & ~15) | ((chunk ^ row) & 15)) << 4) + (F.lane & 1) * 8;
                *(LAS unsigned long long*)(AL + off) = (unsigned long long)h01 | ((unsigned long long)h23 << 32);
                *(LAS unsigned long long*)(AL + 65536 + off) = (unsigned long long)l01 | ((unsigned long long)l23 << 32); } }
        __syncthreads();
        f32x16 acc;
#pragma unroll
        for (int r = 0; r < 16; ++r) acc[r] = 0.f;
#pragma unroll
        for (int s = 0; s < 8; ++s) { const int chunk = 2 * (F.wave * 8 + s) + hh; const int off = l31 * 2048 + (((chunk & ~15) | ((chunk ^ l31) & 15)) << 4);
            const bf16x8 Ah = *(const LAS bf16x8*)(AL + off), Alo = *(const LAS bf16x8*)(AL + 65536 + off);
            acc = MFMA32(Ah, Bh[s], acc); acc = MFMA32(Ah, Bl[s], acc); acc = MFMA32(Alo, Bh[s], acc); }
        __syncthreads();
#pragma unroll
        for (int r = 0; r < 16; ++r) red[(F.wave * 32 + krow16(r, hh)) * 32 + l31] = acc[r];
        __syncthreads();
        { const int row = F.tid >> 4, e0 = (F.tid & 15) * 2; float s0 = 0.f, s1 = 0.f;
#pragma unroll
          for (int w = 0; w < 8; ++w) { s0 += red[(w * 32 + row) * 32 + e0]; s1 += red[(w * 32 + row) * 32 + e0 + 1]; }
          logit[row * 33 + e0] = s0 + b_r[e0]; logit[row * 33 + e0 + 1] = s1 + b_r[e0 + 1]; }
        __syncthreads();
        if (F.tid < 32) { const int row = F.tid, m = m0 + row; float lg[32];
#pragma unroll
            for (int e = 0; e < 32; ++e) lg[e] = logit[row * 33 + e];
            int se[4]; float sv[4]; unsigned used = 0u;
#pragma unroll
            for (int k = 0; k < 4; ++k) { int best = 0; float bv = -INFINITY; bool have = false;
#pragma unroll
                for (int e = 0; e < 32; ++e) { const bool ok = !((used >> e) & 1u) && (!have || lg[e] > bv); if (ok) { best = e; bv = lg[e]; have = true; } }
                se[k] = best; sv[k] = bv; used |= 1u << best; }
            float ex[4], den = 0.f;
#pragma unroll
            for (int k = 0; k < 4; ++k) { ex[k] = __expf(sv[k] - sv[0]); den += ex[k]; }
            const float inv = 1.f / den;
#pragma unroll
            for (int k = 0; k < 4; ++k) { const int lr = __hip_atomic_fetch_add(&lcnt[se[k]], 1, __ATOMIC_RELAXED, __HIP_MEMORY_SCOPE_WORKGROUP);
                LAS int* ent = list + ((step * 32 + row) * 4 + k) * 4; ent[0] = m; ent[1] = se[k]; ent[2] = lr; ent[3] = __float_as_int(ex[k] * inv); } }
    }
    __syncthreads();
    if (F.tid < 32) lbase[F.tid] = atomicAdd(&gcnt[F.tid], lcnt[F.tid]);
    __syncthreads();
    if (F.tid < 256) { LAS int* ent = list + F.tid * 4; const int m = ent[0], e = ent[1], rank = lbase[e] + ent[2];
        SLOTMAP[e * T + rank] = m; TOKSLOT[m * 4 + (F.tid & 3)] = e | (rank << 8); GATE[m * 4 + (F.tid & 3)] = __int_as_float(ent[3]); }
}
__device__ __forceinline__ void load_tstart(Frame& F) {
    LAS int* ts = (LAS int*)(F.lds + LC_TSTART); const int* gcnt = (const int*)(F.ctl + CW_GCNT);
    if (F.tid == 0) { int a = 0; for (int e = 0; e < 32; ++e) { ts[e] = a; a += (__hip_atomic_load(gcnt + e, __ATOMIC_RELAXED, __HIP_MEMORY_SCOPE_AGENT) + 255) >> 8; } ts[32] = a; }
    __syncthreads();
}
__device__ __forceinline__ void p8_gather(Frame& F) {
    load_tstart(F);
    const LAS int* ts = (const LAS int*)(F.lds + LC_TSTART); const int* gcnt = (const int*)(F.ctl + CW_GCNT); const int* SLOTMAP = (const int*)(F.ws + WS_SLOTMAP);
    const bf16* H2 = (const bf16*)(F.ws + WS_H); bf16* XPAD = (bf16*)(F.ws + WS_XPAD);
    const int gw = F.vcu * NWAVES + F.wave, NGW = F.G * NWAVES; const int nrows = ts[32] * 256;
    for (int R = gw; R < nrows; R += NGW) { const int tile = R >> 8; int e = 0; while (e < 31 && ts[e + 1] <= tile) ++e;
        const int rank = R - ts[e] * 256; v4u a = (v4u){0u, 0u, 0u, 0u}, b2 = a;
        if (rank < gcnt[e]) { const int tok = SLOTMAP[e * T + rank]; const GAS v4u* src = (const GAS v4u*)(H2 + (size_t)tok * D); a = src[F.lane]; b2 = src[F.lane + 64]; }
        GAS v4u* dst = (GAS v4u*)(XPAD + (size_t)R * D); dst[F.lane] = a; dst[F.lane + 64] = b2; }
}
__device__ __forceinline__ void p11_final(Frame& F) {
    load_tstart(F);
    const LAS int* ts = (const LAS int*)(F.lds + LC_TSTART);
    const float* X1 = (const float*)(F.ws + WS_X1); const bf16* Y = (const bf16*)(F.ws + WS_Y); const int* TOKSLOT = (const int*)(F.ws + WS_TOKSLOT); const float* GATE = (const float*)(F.ws + WS_GATE);
    const float* MOD = (const float*)(F.ws + WS_MOD); const float* g2 = frame_in(21); const float* b2 = frame_in(22);
    const int gw = F.vcu * NWAVES + F.wave, NGW = F.G * NWAVES;
    for (int m = gw; m < T; m += NGW) { const int b = m >> 11;
        f32x4 mo[4];
#pragma unroll
        for (int j = 0; j < 4; ++j) mo[j] = (f32x4){0.f, 0.f, 0.f, 0.f};
#pragma unroll
        for (int k = 0; k < 4; ++k) { const int tsl = TOKSLOT[m * 4 + k]; const int e = tsl & 255, rank = tsl >> 8; const float gt = GATE[m * 4 + k];
            const GAS unsigned long long* yr = (const GAS unsigned long long*)(Y + ((size_t)ts[e] * 256 + rank) * D) + F.lane;
#pragma unroll
            for (int j = 0; j < 4; ++j) { const unsigned long long w = yr[64 * j]; const unsigned lo = (unsigned)w, hi = (unsigned)(w >> 32);
                mo[j].x += gt * pg8::bfl(lo); mo[j].y += gt * pg8::bfh(lo); mo[j].z += gt * pg8::bfl(hi); mo[j].w += gt * pg8::bfh(hi); } }
        f32x4 v[4]; float s = 0.f;
#pragma unroll
        for (int j = 0; j < 4; ++j) { const int col = 4 * F.lane + 256 * j; const f32x4 x1 = *((const GAS f32x4*)(X1 + (size_t)m * D) + F.lane + 64 * j);
            const f32x4 g2m = *(const f32x4*)(MOD + b * 6144 + 5 * 1024 + col); v[j] = x1 * ALPHA + g2m * mo[j]; s += (v[j].x + v[j].y) + (v[j].z + v[j].w); }
        const float mean = wave_sum(s) * (1.f / D); float s2 = 0.f;
#pragma unroll
        for (int j = 0; j < 4; ++j) { v[j] = v[j] - mean; s2 += (v[j].x * v[j].x + v[j].y * v[j].y) + (v[j].z * v[j].z + v[j].w * v[j].w); }
        const float rstd = 1.f / sqrtf(wave_sum(s2) * (1.f / D) + LN_EPS);
#pragma unroll
        for (int j = 0; j < 4; ++j) { const int col = 4 * F.lane + 256 * j; const f32x4 gg = *(const f32x4*)(g2 + col), bb = *(const f32x4*)(b2 + col);
            *((GAS f32x4*)(F.out + (size_t)m * D) + F.lane + 64 * j) = v[j] * rstd * gg + bb; }
    }
}
__device__ __forceinline__ unsigned ordkey(float f) { const unsigned u = __float_as_uint(f); return (u & 0x80000000u) ? ~u : (u | 0x80000000u); }

constexpr int SEL_QI = 0, SEL_HIST = 32768, SEL_CAND = 98304, SEL_MASK = 114688, SEL_META = 122880, SEL_CAP = 128;
__device__ __forceinline__ float relu_i(float x) { const int i = __float_as_int(x); return __int_as_float(i > 0 ? i : 0); }
__device__ __forceinline__ void idx_load_a(const bf16* KIb, int kt, int lane, bf16x8 (&A)[4]) {
    const bf16* kp = KIb + (size_t)(kt * 32 + (lane & 31)) * 64 + 8 * (lane >> 5);
#pragma unroll
    for (int s = 0; s < 4; ++s) A[s] = *(const GAS bf16x8*)(kp + 16 * s);
}
__device__ __forceinline__ void idx_scores1(const bf16x8 (&AA)[4], const LAS unsigned char* qiL, const float (&wi)[8], int lane, f32x16& scA) {
    const int hh = lane >> 5, q = lane & 31; const LAS unsigned char* qrow = qiL + q * 1024; const int qs = q & 15;
#pragma unroll
    for (int r = 0; r < 16; ++r) scA[r] = 0.f;
    bf16x8 Bc[4], Bn[4];
#pragma unroll
    for (int s = 0; s < 4; ++s) Bc[s] = *(const LAS bf16x8*)(qrow + (((2 * s + hh) ^ qs) << 4));
#pragma unroll
    for (int h = 0; h < 8; ++h) {
        if (h < 7) {
#pragma unroll
            for (int s = 0; s < 4; ++s) Bn[s] = *(const LAS bf16x8*)(qrow + ((((h + 1) * 8 + 2 * s + hh) ^ qs) << 4)); }
        f32x16 accA;
#pragma unroll
        for (int r = 0; r < 16; ++r) accA[r] = 0.f;
#pragma unroll
        for (int s = 0; s < 4; ++s) accA = MFMA32(AA[s], Bc[s], accA);
#pragma unroll
        for (int r = 0; r < 16; ++r) scA[r] = fmaf(wi[h], relu_i(accA[r]), scA[r]);
#pragma unroll
        for (int s = 0; s < 4; ++s) Bc[s] = Bn[s];
    }
}
template <int MODE, int VAR>
__device__ __forceinline__ void sel_tile(Frame& F, const f32x16& sc, int kt, int hh, int q, int qpos, int bst, unsigned pfx, unsigned trial, unsigned& cntl) {
    LAS unsigned* hist = (LAS unsigned*)(F.lds + SEL_HIST); LAS unsigned* cand = (LAS unsigned*)(F.lds + SEL_CAND); LAS unsigned* maskL = (LAS unsigned*)(F.lds + SEL_MASK); LAS int* meta = (LAS int*)(F.lds + SEL_META);
    unsigned word = 0u; const int kbase = kt * 32 + 4 * hh; const int lim = qpos - kbase;
#pragma unroll
    for (int r = 0; r < 16; ++r) { const int kr0 = (r & 3) + 8 * (r >> 2); const bool valid = kr0 <= lim;
        const unsigned bits = __float_as_uint(sc[r]) & 0xFFFFF800u; const float st = __uint_as_float(bits);
        int bin = (int)(st * 64.f) + 256; bin = bin < 0 ? 0 : (bin > 511 ? 511 : bin);
        if (MODE == 0) { if (VAR == 1) { asm volatile("" :: "v"(bin), "v"(valid ? 1u : 0u)); } else __hip_atomic_fetch_add(hist + q * 512 + bin, valid ? 1u : 0u, __ATOMIC_RELAXED, __HIP_MEMORY_SCOPE_WORKGROUP); }
        else { const unsigned ck = (ordkey(st) & 0xFFFFF800u) | (unsigned)(2047 - kbase - kr0);
            if (MODE == 1) { word |= (valid && bin > bst) ? (1u << kr0) : 0u; const bool isc = valid && bin == bst;
                if (isc) { const int slot = __hip_atomic_fetch_add((LAS int*)meta + 64 + q, 1, __ATOMIC_RELAXED, __HIP_MEMORY_SCOPE_WORKGROUP); if (slot < SEL_CAP) cand[q * SEL_CAP + slot] = ck; } }
            if (MODE == 2) { cntl += (valid && ck >= (pfx | trial)) ? 1u : 0u; }
            if (MODE == 3) { word |= (valid && ck >= pfx) ? (1u << kr0) : 0u; } }
        }
    if (MODE == 1 || MODE == 3) __hip_atomic_fetch_or(maskL + q * 64 + kt, word << (4 * hh), __ATOMIC_RELAXED, __HIP_MEMORY_SCOPE_WORKGROUP);
}
template <int MODE, int VAR>
__device__ __forceinline__ void sel_pass(Frame& F, int lane, int wave, const bf16* KIb, int qb, const float (&wi)[8], unsigned trial) {
    const LAS unsigned char* qiL = F.lds + SEL_QI; LAS int* meta = (LAS int*)(F.lds + SEL_META);
    const int bst = meta[lane & 31]; const unsigned pfx = (unsigned)meta[128 + (lane & 31)];
    unsigned cntl = 0u;
    bf16x8 AA[4], NA[4];
    if (wave <= qb) idx_load_a(KIb, wave, lane, AA);
#pragma unroll 1
    for (int kt = wave; kt <= qb; kt += NWAVES) {
        int lane_t = lane; asm volatile("" : "+v"(lane_t));
        const int hh = lane_t >> 5, q = lane_t & 31, qpos = qb * 32 + q;
        if (kt + NWAVES <= qb) idx_load_a(KIb, kt + NWAVES, lane_t, NA);
        f32x16 scA;
        idx_scores1(AA, qiL, wi, lane_t, scA);
        if (VAR == 2) { asm volatile("" :: "v"(scA[0]), "v"(scA[7]), "v"(scA[15])); } else sel_tile<MODE, VAR>(F, scA, kt, hh, q, qpos, bst, pfx, trial, cntl);
#pragma unroll
        for (int s = 0; s < 4; ++s) AA[s] = NA[s];
    }
    if (MODE == 2) __hip_atomic_fetch_add((LAS unsigned*)meta + 160 + (lane & 31), cntl, __ATOMIC_RELAXED, __HIP_MEMORY_SCOPE_WORKGROUP);
}
template <int VAR>
__device__ __forceinline__ void p3_select(Frame& F) {
    const bf16* QI = (const bf16*)(F.ws + WS_QI); const float* MISC = (const float*)(F.ws + WS_MISC); unsigned* MASK = (unsigned*)(F.ws + WS_MASK);
    LAS unsigned* hist = (LAS unsigned*)(F.lds + SEL_HIST); LAS unsigned* cand = (LAS unsigned*)(F.lds + SEL_CAND); LAS unsigned* maskL = (LAS unsigned*)(F.lds + SEL_MASK); LAS int* meta = (LAS int*)(F.lds + SEL_META);
    const int b = blockIdx.x >> 5, ii = blockIdx.x & 31;
    for (int ui = 0; ui < 2; ++ui) { const int qb = ui ? 63 - ii : ii; const int t0 = b * S_ + qb * 32;
        int tid = F.tid; asm volatile("" : "+v"(tid)); const int lane = tid & 63; int wave = F.wave; asm volatile("" : "+s"(wave));
        if (qb < 8) {
            for (int wd = tid; wd < 2048; wd += 512) { const int q = wd >> 6, w = wd & 63, qpos = qb * 32 + q; const int rel = qpos - 32 * w;
                MASK[(size_t)(t0 + q) * 64 + w] = rel >= 31 ? 0xFFFFFFFFu : (rel < 0 ? 0u : ((2u << rel) - 1u)); }
            continue; }
        __syncthreads();
        for (int c = tid; c < 2048; c += 512) { const int q = c >> 6, c16 = c & 63; *(LAS v4u*)(F.lds + SEL_QI + q * 1024 + ((c16 ^ (q & 15)) << 4)) = *(const GAS v4u*)(QI + (size_t)(t0 + q) * 512 + c16 * 8); }
        { unsigned z = 0u; asm volatile("" : "+v"(z)); const v4u z4 = (v4u){z, z, z, z};
          for (int i = tid; i < 16384 / 4; i += 512) ((LAS v4u*)hist)[i] = z4;
          for (int i = tid; i < 2048 / 4; i += 512) ((LAS v4u*)maskL)[i] = z4; }
        if (tid < 192) meta[tid] = 0;
        float wi[8];
#pragma unroll
        for (int h = 0; h < 8; ++h) wi[h] = MISC[(size_t)(t0 + (lane & 31)) * 256 + 192 + h];
        const bf16* KIb = (const bf16*)(F.ws + WS_KI) + (size_t)b * S_ * 64;
        __syncthreads();
        sel_pass<0, VAR>(F, lane, wave, KIb, qb, wi, 0u);
        __syncthreads();
        for (int qq = 0; qq < 4; ++qq) { const int q = wave * 4 + qq; const LAS unsigned* hq = hist + q * 512; unsigned c8[8]; unsigned cs = 0u;
#pragma unroll
            for (int i = 0; i < 8; ++i) { c8[i] = hq[511 - 8 * lane - i]; cs += c8[i]; }
            unsigned incl = cs;
#pragma unroll
            for (int o = 1; o < 64; o <<= 1) { const unsigned v = __shfl_up(incl, o); if (lane >= o) incl += v; }
            const unsigned excl = incl - cs;
            if (excl < 256u && incl >= 256u) { unsigned run = excl;
#pragma unroll
                for (int i = 0; i < 8; ++i) { const unsigned before = run; run += c8[i]; if (before < 256u && run >= 256u) { meta[q] = 511 - 8 * lane - i; meta[32 + q] = (int)(256u - before); } } } }
        __syncthreads();
        sel_pass<1, VAR>(F, lane, wave, KIb, qb, wi, 0u);
        __syncthreads();
        if (tid < 32) { if (meta[64 + tid] > SEL_CAP) meta[96] = 1; }
        __syncthreads();
        if (meta[96] == 0) {
            for (int item = tid; item < 32 * SEL_CAP; item += 512) { const int q = item >> 7, i = item & (SEL_CAP - 1); const int n = meta[64 + q];
                if (i < n) { const unsigned my = cand[q * SEL_CAP + i]; int rank = 0; for (int j = 0; j < n; ++j) rank += (cand[q * SEL_CAP + j] > my) ? 1 : 0;
                    if (rank < meta[32 + q]) { const int idx = 2047 - (int)(my & 0x7FFu); __hip_atomic_fetch_or(maskL + q * 64 + (idx >> 5), 1u << (idx & 31), __ATOMIC_RELAXED, __HIP_MEMORY_SCOPE_WORKGROUP); } } }
        } else {
#pragma unroll 1
            for (int bit = 31; bit >= 0; --bit) {
                sel_pass<2, VAR>(F, lane, wave, KIb, qb, wi, 1u << bit);
                __syncthreads();
                if (tid < 32) { if ((unsigned)meta[160 + tid] >= 256u) meta[128 + tid] |= (int)(1u << bit); meta[160 + tid] = 0; }
                __syncthreads(); }
            sel_pass<3, VAR>(F, lane, wave, KIb, qb, wi, 0u);
        }
        __syncthreads();
        { const int q = tid >> 4, w4 = (tid & 15) * 4; *(GAS v4u*)(MASK + (size_t)(t0 + q) * 64 + w4) = *(const LAS v4u*)(maskL + q * 64 + w4); }
    }
}
constexpr int ATT_K = 0, ATT_VT = 32768;
__device__ __forceinline__ void att_load(const bf16* CKV, const bf16* CKVT, int b, int j, int tid, v4u (&st)[4]) {
#pragma unroll
    for (int i = 0; i < 2; ++i) { const int c = tid + 512 * i; st[i] = *(const GAS v4u*)(CKV + (size_t)(b * S_ + 64 * j) * 128 + c * 8); }
#pragma unroll
    for (int i = 0; i < 2; ++i) { const int c = tid + 512 * i, d = c >> 3, ch = c & 7; st[2 + i] = *(const GAS v4u*)(CKVT + (size_t)(b * 128 + d) * 2048 + 64 * j + ch * 8); }
}
__device__ __forceinline__ void att_store(LAS unsigned char* lds, int buf, int tid, const v4u (&st)[4]) {
#pragma unroll
    for (int i = 0; i < 2; ++i) { const int c = tid + 512 * i, row = c >> 4, ch = c & 15; *(LAS v4u*)(lds + ATT_K + buf * 16384 + row * 256 + ((ch ^ (row & 15)) << 4)) = st[i]; }
#pragma unroll
    for (int i = 0; i < 2; ++i) { const int c = tid + 512 * i, d = c >> 3, ch = c & 7; *(LAS v4u*)(lds + ATT_VT + buf * 16384 + d * 128 + ((ch ^ ((d >> 1) & 7)) << 4)) = st[2 + i]; }
}
__device__ __forceinline__ void p4_attention(Frame& F) {
    const bf16* QL = (const bf16*)(F.ws + WS_QL); const bf16* CKV = (const bf16*)(F.ws + WS_CKV); const bf16* CKVT = (const bf16*)(F.ws + WS_CKVT);
    const unsigned* MASK = (const unsigned*)(F.ws + WS_MASK); bf16* OLAT = (bf16*)(F.ws + WS_OLAT);
    const int b = blockIdx.x >> 5, ii = blockIdx.x & 31;
    for (int ui = 0; ui < 2; ++ui) { const int qb = ui ? 63 - ii : ii;
        int tid = F.tid; asm volatile("" : "+v"(tid)); const int lane = tid & 63; int head = F.wave; asm volatile("" : "+s"(head));
        const int hh = lane >> 5, q = lane & 31; const float slope2 = __builtin_amdgcn_exp2f(-(float)(head + 1)) * LOG2E;
        const int t0 = b * S_ + qb * 32, qpos = qb * 32 + q; const int nt = (qb >> 1) + 1;
        bf16x8 Qf[8];
#pragma unroll
        for (int s = 0; s < 8; ++s) Qf[s] = *(const GAS bf16x8*)(QL + (size_t)(t0 + q) * 1024 + head * 128 + 16 * s + 8 * hh);
        f32x16 O[4];
#pragma unroll
        for (int db = 0; db < 4; ++db)
#pragma unroll
            for (int r = 0; r < 16; ++r) O[db][r] = 0.f;
        float m_run = -INFINITY, l_run = 0.f;
        v4u st[4];
        att_load(CKV, CKVT, b, 0, tid, st);
        __syncthreads();
        att_store(F.lds, 0, tid, st);
        __syncthreads();
        for (int j = 0; j < nt; ++j) { const int buf = j & 1;
            if (j + 1 < nt) att_load(CKV, CKVT, b, j + 1, tid, st);
            const unsigned mlo = MASK[(size_t)(t0 + q) * 64 + 2 * j] >> (4 * hh), mhi = MASK[(size_t)(t0 + q) * 64 + 2 * j + 1] >> (4 * hh);
            f32x16 S0, S1;
#pragma unroll
            for (int r = 0; r < 16; ++r) { S0[r] = 0.f; S1[r] = 0.f; }
            const LAS unsigned char* kb0 = F.lds + ATT_K + buf * 16384 + q * 256, * kb1 = kb0 + 32 * 256;
#pragma unroll
            for (int s = 0; s < 8; ++s) { const int sw = ((2 * s + hh) ^ (q & 15)) << 4;
                const bf16x8 A0 = *(const LAS bf16x8*)(kb0 + sw), A1 = *(const LAS bf16x8*)(kb1 + sw);
                S0 = MFMA32(A0, Qf[s], S0); S1 = MFMA32(A1, Qf[s], S1); }
            asm volatile("" ::: "memory");
            const float base0 = slope2 * (float)(64 * j + 4 * hh - qpos);
            float tmax = -INFINITY;
#pragma unroll
            for (int r = 0; r < 16; ++r) { const int kr = (r & 3) + 8 * (r >> 2);
                float s0 = S0[r] + (base0 + slope2 * (float)kr), s1 = S1[r] + (base0 + slope2 * (float)(kr + 32));
                s0 = ((mlo >> kr) & 1u) ? s0 : -INFINITY; s1 = ((mhi >> kr) & 1u) ? s1 : -INFINITY;
                S0[r] = s0; S1[r] = s1; tmax = fmaxf(tmax, fmaxf(s0, s1)); }
            tmax = fmaxf(tmax, __shfl_xor(tmax, 32));
            const float m_new = fmaxf(m_run, tmax), msafe = (m_new == -INFINITY) ? 0.f : m_new;
            const float alpha = __builtin_amdgcn_exp2f(m_run - msafe);
            float ps = 0.f;
#pragma unroll
            for (int r = 0; r < 16; ++r) { S0[r] = __builtin_amdgcn_exp2f(S0[r] - msafe); S1[r] = __builtin_amdgcn_exp2f(S1[r] - msafe); ps += S0[r] + S1[r]; }
            l_run = l_run * alpha + ps; m_run = m_new;
            if (__any(alpha != 1.f)) {
#pragma unroll
                for (int db = 0; db < 4; ++db)
#pragma unroll
                    for (int r = 0; r < 16; ++r) O[db][r] *= alpha; }
            bf16x8 Pf[4];
            Pf[0] = pack8(S0[0], S0[1], S0[2], S0[3], S0[4], S0[5], S0[6], S0[7]); Pf[1] = pack8(S0[8], S0[9], S0[10], S0[11], S0[12], S0[13], S0[14], S0[15]);
            Pf[2] = pack8(S1[0], S1[1], S1[2], S1[3], S1[4], S1[5], S1[6], S1[7]); Pf[3] = pack8(S1[8], S1[9], S1[10], S1[11], S1[12], S1[13], S1[14], S1[15]);
            asm volatile("" ::: "memory");
            const LAS unsigned char* vb = F.lds + ATT_VT + buf * 16384;
#pragma unroll
            for (int db = 0; db < 4; ++db) { const int d = db * 32 + q; const LAS unsigned char* vr = vb + d * 128; const int sx = (d >> 1) & 7;
#pragma unroll
                for (int c2 = 0; c2 < 4; ++c2) { const bf16x8 Av = *(const LAS bf16x8*)(vr + (((c2 * 2 + hh) ^ sx) << 4)); O[db] = MFMA32(Av, Pf[c2], O[db]); } }
            if (j + 1 < nt) att_store(F.lds, buf ^ 1, tid, st);
            __syncthreads();
        }
        const float lt = l_run + __shfl_xor(l_run, 32); const float inv = 1.f / lt;
        bf16* orow = OLAT + (size_t)(t0 + q) * 1024 + head * 128 + 4 * hh;
#pragma unroll
        for (int db = 0; db < 4; ++db)
#pragma unroll
            for (int g = 0; g < 4; ++g) { const unsigned lo = pkbf(O[db][4 * g] * inv, O[db][4 * g + 1] * inv), hi = pkbf(O[db][4 * g + 2] * inv, O[db][4 * g + 3] * inv);
                *(GAS unsigned long long*)(orow + db * 32 + 8 * g) = (unsigned long long)lo | ((unsigned long long)hi << 32); }
    }
}
struct Args { const float* in[23]; float* out; unsigned char* ws; int ph_lo, ph_hi; };
__global__ void __launch_bounds__(NWAVES * 64, 2) mk_fwd(Args args) {
    extern __shared__ __attribute__((aligned(16))) unsigned char lds[];
    Frame F;
    F.lds = (LAS unsigned char*)lds;
    F.MISCW = (volatile LAS unsigned*)(F.lds + MISC_OFF);
    F.tid = threadIdx.x; F.lane = F.tid & 63; F.wave = __builtin_amdgcn_readfirstlane(F.tid >> 6);
    F.G = gridDim.x; { const int bx = blockIdx.x; F.vcu = (F.G % 8 == 0) ? (bx % 8) * (F.G / 8) + bx / 8 : bx; }
    F.ws = args.ws; F.ctl = (gu32*)(args.ws + WS_CTL); F.out = args.out;
    for (int u = F.tid; u < (LDS_BYTES - LDSCTL_OFF) / 4; u += NWAVES * 64) ((LAS unsigned*)(F.lds + LDSCTL_OFF))[u] = 0u;
    __syncthreads();
    const int lo = args.ph_lo, hi = args.ph_hi;
#define IN(k) (lo <= (k) && (k) < hi)
#define SEAM(k) do { if (IN(k) && IN((k) + 1)) xcd_barrier(bar); } while (0)
#ifndef PROBE_MASK
#define PROBE_MASK 0
#endif
#define PHASE(k, BODY) do { if (IN(k)) { if ((PROBE_MASK >> (k)) & 1) { BODY; xcd_barrier(bar); } BODY; } SEAM(k); } while (0)
#define BODY0 { p0_prologue(F); }
#define BODY1 { p1_modulate(F); }
#define BODY2 { pg8::Gemm g{(const pg8::bf16_t*)(F.ws + WS_H), (const pg8::bf16_t*)(F.ws + WS_WIN), T, NIN, D}; pg8::StaticOrder S; S.init(T, NIN, F.G, (int)blockIdx.x); \
        pg8::EpiInProj E{(pg8::bf16_t*)(F.ws + WS_QL), (pg8::bf16_t*)(F.ws + WS_QI), (pg8::bf16_t*)(F.ws + WS_U), (pg8::bf16_t*)(F.ws + WS_SG), (float*)(F.ws + WS_MISC), (pg8::bf16_t*)(F.ws + WS_KI)}; \
        pg8::gemm_phase<pg8::EpiInProj, pg8::StaticOrder, PG8_ALIGN, PG8_SP2>(F.lds + RING_OFF, g, S, E); }
#define BODY3 { p3_post(F); __syncthreads(); p3_select<0>(F); }
#ifndef SELVAR
#define SELVAR 0
#endif
#ifdef PROBE_POST
#define BODY3V { p3_post(F); }
#else
#define BODY3V { p3_select<SELVAR>(F); }
#endif
#define BODY4 { p4_attention(F); }
#define BODY5 { { pg8::Gemm g{(const pg8::bf16_t*)(F.ws + WS_OLAT), (const pg8::bf16_t*)(F.ws + WS_WOA), T, D, 1024}; pg8::StaticOrder S; S.init(T, D, F.G, (int)blockIdx.x); \
          pg8::EpiGateMul E{(pg8::bf16_t*)(F.ws + WS_TMP), (const pg8::bf16_t*)(F.ws + WS_SG), 0, 0}; \
          pg8::gemm_phase<pg8::EpiGateMul, pg8::StaticOrder, PG8_ALIGN, PG8_SP2>(F.lds + RING_OFF, g, S, E); } \
        { pg8::Gemm g{(const pg8::bf16_t*)(F.ws + WS_POOLED), (const pg8::bf16_t*)(F.ws + WS_WPB), T, D, 512}; pg8::StaticOrder S; S.init(T, D, F.G, (int)blockIdx.x); \
          pg8::EpiGateAdd E{(pg8::bf16_t*)(F.ws + WS_MIX), (const pg8::bf16_t*)(F.ws + WS_TMP), (const pg8::bf16_t*)(F.ws + WS_SG), 1024, 0}; \
          pg8::gemm_phase<pg8::EpiGateAdd, pg8::StaticOrder, PG8_ALIGN, PG8_SP2>(F.lds + RING_OFF, g, S, E); } }
#define BODY6 { pg8::Gemm g{(const pg8::bf16_t*)(F.ws + WS_MIX), (const pg8::bf16_t*)(F.ws + WS_WOUT), T, D, 1024}; pg8::StaticOrder S; S.init(T, D, F.G, (int)blockIdx.x); \
        pg8::EpiResid E{(float*)(F.ws + WS_Z), frame_in(0), (const float*)(F.ws + WS_MOD) + 2 * 1024}; \
        pg8::gemm_phase<pg8::EpiResid, pg8::StaticOrder, PG8_ALIGN, PG8_SP2>(F.lds + RING_OFF, g, S, E); }
#define BODY7 { p7_ln1_route(F, CW_GCNT); }
#define BODY7DRY { p7_ln1_route(F, 128); }
#define BODY8 { p8_gather(F); }
#define BODY9 { load_tstart(F); \
        pg8::Gemm g{(const pg8::bf16_t*)(F.ws + WS_XPAD), (const pg8::bf16_t*)(F.ws + WS_WGU), MAXROWS, 32 * 2048, 1024}; \
        pg8::MoeOrder S{(const LAS int*)(F.lds + LC_TSTART), 8, F.G, (int)blockIdx.x}; \
        pg8::EpiSwiglu E{(pg8::bf16_t*)(F.ws + WS_ACT), frame_in(18)}; \
        pg8::gemm_phase<pg8::EpiSwiglu, pg8::MoeOrder, PG8_ALIGN, PG8_SP2>(F.lds + RING_OFF, g, S, E); }
#define BODY10 { load_tstart(F); \
        pg8::Gemm g{(const pg8::bf16_t*)(F.ws + WS_ACT), (const pg8::bf16_t*)(F.ws + WS_WD), MAXROWS, 32 * 1024, 1024}; \
        pg8::MoeOrder S{(const LAS int*)(F.lds + LC_TSTART), 4, F.G, (int)blockIdx.x}; \
        pg8::EpiDown E{(pg8::bf16_t*)(F.ws + WS_Y), frame_in(20)}; \
        pg8::gemm_phase<pg8::EpiDown, pg8::MoeOrder, PG8_ALIGN, PG8_SP2>(F.lds + RING_OFF, g, S, E); }
#define BODY11 { p11_final(F); }
    XcdBarrier bar; bar.bar = (unsigned*)(F.ctl + CW_BAR); bar.x = 0; bar.st = nullptr;
    if (hi - lo > 1) bar = xcd_barrier_post((unsigned*)(F.ctl + CW_BAR), F.MISCW + 8);
    PHASE(0, BODY0); PHASE(1, BODY1); PHASE(2, BODY2);
    if (IN(3)) { if ((PROBE_MASK >> 3) & 1) { BODY3V; xcd_barrier(bar); } BODY3; } SEAM(3);
    PHASE(4, BODY4); PHASE(5, BODY5);
    PHASE(6, BODY6);
    if (IN(7)) { if ((PROBE_MASK >> 7) & 1) { BODY7DRY; xcd_barrier(bar); } BODY7; } SEAM(7);
    PHASE(8, BODY8); PHASE(9, BODY9); PHASE(10, BODY10);
    if (IN(11)) { if ((PROBE_MASK >> 11) & 1) { BODY11; xcd_barrier(bar); } BODY11; }
#undef IN
#undef SEAM
}

static void launch_mk(const Args& a0, int lo, int hi, int grid, hipStream_t stream) {
    Args a = a0; a.ph_lo = lo; a.ph_hi = hi;
    hipLaunchKernelGGL(mk_fwd, dim3(grid), dim3(NWAVES * 64), LDS_BYTES, stream, a);
}
extern "C" void kernel_launch(void* const* d_in, const int* in_sizes, int n_in, void* d_out, int out_size, void* d_ws, size_t ws_size, hipStream_t stream) {
    static int grid = 0;
    if (grid == 0) {
        if (n_in != 23 || ws_size < WS_END) { fprintf(stderr, "kernel_launch: unexpected n_in %d / ws %zu\n", n_in, ws_size); grid = -1; return; }
        int dev = 0, cus = 0;
        if (hipGetDevice(&dev) != hipSuccess || hipDeviceGetAttribute(&cus, hipDeviceAttributeMultiprocessorCount, dev) != hipSuccess) { grid = -1; return; }
        if (hipFuncSetAttribute((const void*)mk_fwd, hipFuncAttributeMaxDynamicSharedMemorySize, LDS_BYTES) != hipSuccess) { fprintf(stderr, "hipFuncSetAttribute failed\n"); grid = -1; return; }
        grid = cus;
        if (grid != 256) { fprintf(stderr, "kernel_launch: built for 256 CUs, found %d\n", cus); grid = -1; return; }
    }
    if (grid < 0) return;
    unsigned char* ws = (unsigned char*)d_ws;
    (void)hipMemsetAsync(ws + WS_CTL, 0, CTL_ZERO_BYTES, stream);
    Args a{};
    for (int i = 0; i < 23; ++i) a.in[i] = (const float*)d_in[i];
    a.out = (float*)d_out; a.ws = ws;
    launch_mk(a, 0, 12, grid, stream);
}
```

```cpp
#include <hip/hip_runtime.h>
#include <cstdio>
#include <cstdint>
namespace pg8 {
#define PG8_LAS __attribute__((address_space(3)))
typedef unsigned short bf16_t;
typedef short bf16x8 __attribute__((ext_vector_type(8)));
typedef float f32x4 __attribute__((ext_vector_type(4)));
typedef unsigned u32x4 __attribute__((ext_vector_type(4)));
constexpr int BM = 256, BK = 64, HALF = 128, HTB = HALF * BK * 2  , STAGE_BYTES = 8 * HTB, NXCD = 8, WGM = 8;

__host__ __device__ __forceinline__ int lds_byte(int r, int c) { const int st = (r >> 4) * 2 + (c >> 5), rr = r & 15, cc = c & 31, ob = rr * 64 + cc * 2; return st * 1024 + (ob ^ (((ob >> 9) & 1) << 5)); }
__host__ __device__ __forceinline__ void stage_rc(int b, int& R, int& C) { const int st = b / 1024, sb = b % 1024, swz = sb ^ (((sb >> 9) & 1) << 5); R = (st >> 1) * 16 + swz / 64; C = (st & 1) * 32 + (swz % 64) / 2; }
__host__ __device__ __forceinline__ int perm32(int rho) { const int n = rho >> 4, i = rho & 15; return 8 * (i >> 2) + 4 * n + (i & 3); }

struct Unit { int pm, pn; };
struct Gemm { const bf16_t* A; const bf16_t* Bt; int M, N, K; };

struct StaticOrder {
    static constexpr bool GATHER = false;
    int nM, nN, nwg, G, c;
    __host__ __device__ void init(int M, int N, int G_, int c_) { nM = M / BM; nN = N / BM; nwg = nM * nN; G = G_; c = c_; }
    __host__ __device__ bool next(int i, Unit& u) const {
        const long L = (long)i * G + c; if (L >= nwg) return false;
        int wgid = (int)L; { const int q = nwg / NXCD, r = nwg % NXCD, xcd = wgid % NXCD, off = wgid / NXCD; wgid = (xcd < r ? xcd * (q + 1) : r * (q + 1) + (xcd - r) * q) + off; }
        const int nig = WGM * nN, gid = wgid / nig, fm = gid * WGM, gsz = (nM - fm) < WGM ? (nM - fm) : WGM;
        u.pm = fm + ((wgid % nig) % gsz); u.pn = (wgid % nig) / gsz; return true;
    }
    __device__ __forceinline__ void a_ready(const Unit&) const {}
    __device__ __forceinline__ void done(const Unit&) const {}
};

__device__ __forceinline__ unsigned cvt_pk_bf16(float lo, float hi) { unsigned r; asm volatile("v_cvt_pk_bf16_f32 %0, %1, %2" : "=v"(r) : "v"(lo), "v"(hi)); return r; }
typedef float f32x2 __attribute__((ext_vector_type(2)));
__device__ __forceinline__ f32x2 gelu_pk(f32x2 v) {
    const f32x2 av = __builtin_elementwise_abs(v), d = av * 0.2316418882f + 1.0f;
    f32x2 t; t.x = __builtin_amdgcn_rcpf(d.x); t.y = __builtin_amdgcn_rcpf(d.y);
    f32x2 q = t * 0.5307027145f + (-0.7265760135f); q = q * t + 0.7107068705f; q = q * t + (-0.142248368f); q = q * t + 0.127414796f; q = q * t;
    const f32x2 s = (v * v) * (-0.72134752044f);
    f32x2 e; e.x = __builtin_amdgcn_exp2f(s.x); e.y = __builtin_amdgcn_exp2f(s.y);
    const f32x2 m = v * (q * e), r = v - m;
    f32x2 o; o.x = v.x < 0.f ? m.x : r.x; o.y = v.y < 0.f ? m.y : r.y; return o;
}

template <int ACT  > struct EpiBf16 {
    static constexpr bool PERM = true, AFTER_DRAIN = false; static_assert(ACT == 0 || ACT == 1, "EpiBf16: ACT is 0 (none) or 1 (gelu_pk)");
    bf16_t* O; int ldc; const float* bias; int split_cols; size_t split_stride; float scale0;
    __device__ __forceinline__ void operator()(const f32x4 (&acc)[2][2][4][2], const Unit& u, int wr, int wc, int fr, int fq) const {
        const int row0 = u.pm * BM + wr * 64 + fr; int colt = u.pn * BM; bf16_t* base = O;
        float sc = 1.f; if (split_cols) { const int t = colt / split_cols; base += (size_t)t * split_stride; colt -= t * split_cols; if (t == 0) sc = scale0; }
        const int col0 = colt + wc * 32 + 8 * fq, bcol0 = u.pn * BM + wc * 32 + 8 * fq;
        f32x4 bv[2][2];
#pragma unroll
        for (int bj = 0; bj < 2; ++bj)
#pragma unroll
            for (int n = 0; n < 2; ++n) bv[bj][n] = bias ? *(const f32x4*)(bias + bcol0 + bj * HALF + 4 * n) : (f32x4){0.f, 0.f, 0.f, 0.f};
#pragma unroll
        for (int ai = 0; ai < 2; ++ai)
#pragma unroll
            for (int m = 0; m < 4; ++m) { bf16_t* rowp = base + (size_t)(row0 + ai * HALF + m * 16) * ldc + col0;
#pragma unroll
                for (int bj = 0; bj < 2; ++bj) { f32x4 v0 = acc[ai][bj][m][0] + bv[bj][0], v1 = acc[ai][bj][m][1] + bv[bj][1];
                    if (ACT == 1) { f32x2 a = gelu_pk((f32x2){v0[0], v0[1]}), b = gelu_pk((f32x2){v0[2], v0[3]}), c = gelu_pk((f32x2){v1[0], v1[1]}), d = gelu_pk((f32x2){v1[2], v1[3]});
                        v0 = (f32x4){a.x, a.y, b.x, b.y}; v1 = (f32x4){c.x, c.y, d.x, d.y}; }
                    v0 = v0 * sc; v1 = v1 * sc; u32x4 w; w.x = cvt_pk_bf16(v0[0], v0[1]); w.y = cvt_pk_bf16(v0[2], v0[3]); w.z = cvt_pk_bf16(v1[0], v1[1]); w.w = cvt_pk_bf16(v1[2], v1[3]);
                    *(u32x4*)(rowp + bj * HALF) = w; } }
    }
};

struct PanelStats {
    unsigned* xbuf;
    unsigned* cnt;
    unsigned* tmo;
    int ntn; float eps;
    unsigned code;
    __device__ __forceinline__ bool run(const f32x4 (&v)[2][2][4][2], const Unit& u, int wr, int wc, int fr, int fq, PG8_LAS unsigned char* lds, int wid, int lane) const {
        typedef float f32x2v __attribute__((ext_vector_type(2)));
        PG8_LAS f32x2v* P = (PG8_LAS f32x2v*)lds;
        PG8_LAS f32x2v* S = (PG8_LAS f32x2v*)(lds + 8192);
        PG8_LAS unsigned* flag = (PG8_LAS unsigned*)(lds + 8192 + 2048);
#pragma unroll
        for (int ai = 0; ai < 2; ++ai)
#pragma unroll
            for (int m = 0; m < 4; ++m) {
                float s = 0.f;
#pragma unroll
                for (int bj = 0; bj < 2; ++bj)
#pragma unroll
                    for (int n = 0; n < 2; ++n) { const f32x4 x = v[ai][bj][m][n]; s += (x[0] + x[1]) + (x[2] + x[3]); }
                s += __shfl_xor(s, 16); s += __shfl_xor(s, 32);
                const float mw = s * (1.0f / 64.0f); float q = 0.f;
#pragma unroll
                for (int bj = 0; bj < 2; ++bj)
#pragma unroll
                    for (int n = 0; n < 2; ++n) { const f32x4 d = v[ai][bj][m][n] - mw; q += (d[0] * d[0] + d[1] * d[1]) + (d[2] * d[2] + d[3] * d[3]); }
                q += __shfl_xor(q, 16); q += __shfl_xor(q, 32);
                if (fq == 0) P[(ai * HALF + wr * 64 + m * 16 + fr) * 4 + wc] = (f32x2v){mw, q};
            }
        asm volatile("s_waitcnt lgkmcnt(0)" ::: "memory"); __builtin_amdgcn_s_barrier(); asm volatile("" ::: "memory");
#if defined(BROKEN_EXCHANGE_NO_WAIT)
#warning BROKEN CONTROL BUILD: the row-statistics exchange does not wait; results are wrong by design
        if (blockIdx.x >= 64) { const long long t0_ = clock64(); while (clock64() - t0_ < 60000) __builtin_amdgcn_s_sleep(8); }
#endif
        const int row = wid * 32 + (lane & 31);
        if (lane < 32) {
            const f32x2v a = P[row * 4 + 0], b = P[row * 4 + 1], c = P[row * 4 + 2], d = P[row * 4 + 3];
            const float mt = (a.x + b.x + c.x + d.x) * 0.25f;
            const float da = a.x - mt, db = b.x - mt, dc = c.x - mt, dd = d.x - mt;
            const float m2 = (a.y + b.y) + (c.y + d.y) + 64.0f * ((da * da + db * db) + (dc * dc + dd * dd));
            unsigned long long* slot = (unsigned long long*)xbuf + ((size_t)(u.pm * BM + row) * 4 + u.pn);
            __hip_atomic_store(slot, ((unsigned long long)__float_as_uint(m2) << 32) | __float_as_uint(mt), __ATOMIC_RELAXED, __HIP_MEMORY_SCOPE_AGENT);
        }
        asm volatile("s_waitcnt vmcnt(0)" ::: "memory");
        if (lane == 0) __hip_atomic_fetch_add(cnt + 64 * u.pm, 1u, __ATOMIC_RELAXED, __HIP_MEMORY_SCOPE_AGENT);
        if (wid == 0) {
            bool dead = false; const unsigned long long t0 = __builtin_amdgcn_s_memrealtime(); const unsigned want = 8u * (unsigned)ntn;
            for (;;) {
#if defined(BROKEN_EXCHANGE_NO_WAIT)
                break;
#endif
                if ((unsigned)__builtin_amdgcn_readfirstlane(__hip_atomic_load(cnt + 64 * u.pm, __ATOMIC_RELAXED, __HIP_MEMORY_SCOPE_AGENT)) >= want) break;
                if (__builtin_amdgcn_s_memrealtime() - t0 > 2000000ull) {
                    if (lane == 0) { unsigned expect = 0u; __hip_atomic_compare_exchange_strong(tmo + 1, &expect, code | (unsigned)(u.pm & 0xff), __ATOMIC_RELAXED, __ATOMIC_RELAXED, __HIP_MEMORY_SCOPE_AGENT);
                                     __hip_atomic_store(tmo, 1u, __ATOMIC_RELAXED, __HIP_MEMORY_SCOPE_AGENT); }
                    dead = true; break; }
                __builtin_amdgcn_s_sleep(2);
            }
            __builtin_amdgcn_fence(__ATOMIC_ACQUIRE, "agent");
            if (lane == 0) flag[0] = dead ? 1u : 0u;
        }
        asm volatile("s_waitcnt vmcnt(0) lgkmcnt(0)" ::: "memory"); __builtin_amdgcn_s_barrier(); asm volatile("" ::: "memory");
        const bool bad = flag[0] != 0u;
        if (lane < 32) {
            const unsigned long long* slot = (const unsigned long long*)xbuf + (size_t)(u.pm * BM + row) * 4; float mt[4], m2[4]; float ms = 0.f;
#pragma unroll
            for (int t = 0; t < 4; ++t) { if (t < ntn) { const unsigned long long w = __hip_atomic_load(slot + t, __ATOMIC_RELAXED, __HIP_MEMORY_SCOPE_AGENT); mt[t] = __uint_as_float((unsigned)w); m2[t] = __uint_as_float((unsigned)(w >> 32)); } else { mt[t] = 0.f; m2[t] = 0.f; } ms += mt[t]; }
            const float mean = ms / (float)ntn; float q = 0.f;
#pragma unroll
            for (int t = 0; t < 4; ++t) if (t < ntn) { const float dm = mt[t] - mean; q += m2[t] + 256.0f * dm * dm; }
            S[row] = (f32x2v){mean, 1.0f / sqrtf(q / (256.0f * (float)ntn) + eps)};
        }
        asm volatile("s_waitcnt lgkmcnt(0)" ::: "memory"); __builtin_amdgcn_s_barrier(); asm volatile("" ::: "memory");
        return bad;
    }
};
struct EpiLnRes {
    static constexpr bool PERM = false, AFTER_DRAIN = true;
    const float* base; float* out; int ldc; const float* bias; PanelStats st; unsigned poison;
    __device__ __forceinline__ void fused(f32x4 (&acc)[2][2][4][2], const Unit& u, int wr, int wc, int fr, int fq, PG8_LAS unsigned char* lds, int wid, int lane) const {
        typedef float f32x2v __attribute__((ext_vector_type(2)));
        const PG8_LAS f32x2v* S = (const PG8_LAS f32x2v*)(lds + 8192);
        const int col0 = u.pn * BM + wc * 32 + 4 * fq;
#pragma unroll
        for (int bj = 0; bj < 2; ++bj)
#pragma unroll
            for (int n = 0; n < 2; ++n) { const f32x4 bv = bias ? *(const f32x4*)(bias + col0 + bj * HALF + n * 16) : (f32x4){0.f, 0.f, 0.f, 0.f};
#pragma unroll
                for (int ai = 0; ai < 2; ++ai)
#pragma unroll
                    for (int m = 0; m < 4; ++m) acc[ai][bj][m][n] += bv; }
        f32x4 pre[4][2][2];
#pragma unroll
        for (int m = 0; m < 4; ++m) { const size_t off = (size_t)(u.pm * BM + wr * 64 + m * 16 + fr) * ldc + col0;
#pragma unroll
            for (int bj = 0; bj < 2; ++bj)
#pragma unroll
                for (int n = 0; n < 2; ++n) pre[m][bj][n] = *(const f32x4*)(base + off + bj * HALF + n * 16); }
        const bool bad = st.run(acc, u, wr, wc, fr, fq, lds, wid, lane) || poison != 0u;
        const float qnan = __builtin_nanf("");
#pragma unroll
        for (int ai = 0; ai < 2; ++ai)
#pragma unroll
            for (int m = 0; m < 4; ++m) { const int r = ai * HALF + wr * 64 + m * 16 + fr; const f32x2v sr = S[r]; const size_t off = (size_t)(u.pm * BM + r) * ldc + col0;
#pragma unroll
                for (int bj = 0; bj < 2; ++bj)
#pragma unroll
                    for (int n = 0; n < 2; ++n) { const f32x4 bs = ai == 0 ? pre[m][bj][n] : *(const f32x4*)(base + off + bj * HALF + n * 16); f32x4 o = bs + (acc[ai][bj][m][n] - sr.x) * sr.y;
                        if (bad) o = (f32x4){qnan, qnan, qnan, qnan}; *(f32x4*)(out + off + bj * HALF + n * 16) = o; }
                if (m & 1) asm volatile("" ::: "memory"); }
    }
};
struct EpiLnResLn {
    static constexpr bool PERM = false, AFTER_DRAIN = true;
    const float* base; float* out; bf16_t* xn; int ldc; const float* bias; PanelStats st1, st2; unsigned poison;
    __device__ __forceinline__ void fused(f32x4 (&acc)[2][2][4][2], const Unit& u, int wr, int wc, int fr, int fq, PG8_LAS unsigned char* lds, int wid, int lane) const {
        typedef float f32x2v __attribute__((ext_vector_type(2))); typedef unsigned u32x2v __attribute__((ext_vector_type(2)));
        const PG8_LAS f32x2v* S = (const PG8_LAS f32x2v*)(lds + 8192);
        const int col0 = u.pn * BM + wc * 32 + 4 * fq;
#pragma unroll
        for (int bj = 0; bj < 2; ++bj)
#pragma unroll
            for (int n = 0; n < 2; ++n) { const f32x4 bv = bias ? *(const f32x4*)(bias + col0 + bj * HALF + n * 16) : (f32x4){0.f, 0.f, 0.f, 0.f};
#pragma unroll
                for (int ai = 0; ai < 2; ++ai)
#pragma unroll
                    for (int m = 0; m < 4; ++m) acc[ai][bj][m][n] += bv; }
        bool bad = st1.run(acc, u, wr, wc, fr, fq, lds, wid, lane) || poison != 0u;
        const float qnan = __builtin_nanf("");
#pragma unroll
        for (int ai = 0; ai < 2; ++ai)
#pragma unroll
            for (int m = 0; m < 4; ++m) { const int r = ai * HALF + wr * 64 + m * 16 + fr; const f32x2v sr = S[r]; const size_t off = (size_t)(u.pm * BM + r) * ldc + col0;
#pragma unroll
                for (int bj = 0; bj < 2; ++bj)
#pragma unroll
                    for (int n = 0; n < 2; ++n) { const f32x4 bs = *(const f32x4*)(base + off + bj * HALF + n * 16); acc[ai][bj][m][n] = bs + (acc[ai][bj][m][n] - sr.x) * sr.y; }
                asm volatile("" : "+v"(acc[ai][0][m][0]), "+v"(acc[ai][0][m][1]), "+v"(acc[ai][1][m][0]), "+v"(acc[ai][1][m][1]));
                if (m & 1) asm volatile("" ::: "memory"); }
        const bool bad1 = bad;
        bad = st2.run(acc, u, wr, wc, fr, fq, lds, wid, lane) || bad;
#pragma unroll
        for (int ai = 0; ai < 2; ++ai)
#pragma unroll
            for (int m = 0; m < 4; ++m) { const int r = ai * HALF + wr * 64 + m * 16 + fr; const f32x2v sr = S[r]; const size_t off = (size_t)(u.pm * BM + r) * ldc + col0;
#pragma unroll
                for (int bj = 0; bj < 2; ++bj)
#pragma unroll
                    for (int n = 0; n < 2; ++n) { const f32x4 x1 = acc[ai][bj][m][n]; *(f32x4*)(out + off + bj * HALF + n * 16) = bad1 ? (f32x4){qnan, qnan, qnan, qnan} : x1;
                        const f32x4 o = (x1 - sr.x) * sr.y; u32x2v w; w.x = cvt_pk_bf16(o[0], o[1]); w.y = cvt_pk_bf16(o[2], o[3]);
                        if (bad) { w.x = 0x7fc07fc0u; w.y = 0x7fc07fc0u; } *(u32x2v*)(xn + off + bj * HALF + n * 16) = w; }
                asm volatile("" ::: "memory"); }
    }
};

template <class Epi, class Sched, bool ALIGN_EPI = false, bool SP2 = false>
__device__ __forceinline__ void gemm_phase(PG8_LAS unsigned char* lds, const Gemm g, const Sched& S, const Epi& E, const int wave_id  ) {
    int tid; { int l_; asm volatile("v_mbcnt_lo_u32_b32 %0, -1, 0\n\tv_mbcnt_hi_u32_b32 %0, -1, %0" : "=v"(l_)); tid = wave_id * 64 + l_; }
    const int wid = wave_id, lane = tid & 63, wr = wid >> 2, wc = wid & 3, fr = lane & 15, fq = lane >> 4;
    const int K = g.K, nt = K / BK;
    constexpr bool GA = Sched::GATHER;
    static_assert(!GA || SP2, "row gather is wired into the SP2 loop only");
    unsigned voffA[2], voffB[2]; int RA[2], CA[2];
#pragma unroll
    for (int i = 0; i < 2; ++i) { int R, C; stage_rc(tid * 16 + i * 8192, R, C); const int Rb = Epi::PERM ? ((R & ~31) + perm32(R & 31)) : R; RA[i] = R; CA[i] = C;
        voffA[i] = (unsigned)(R * K + C) * 2u; voffB[i] = (unsigned)(Rb * K + C) * 2u; }
    unsigned goc[2][2], gon[2][2]; const char* const gA = (const char*)g.A;
#define PG8_GO(dst, slot, u) do { _Pragma("unroll") for (int _h = 0; _h < 2; ++_h) _Pragma("unroll") for (int _i = 0; _i < 2; ++_i) \
        dst[_h][_i] = (unsigned)S.arow(slot, u, _h * HALF + RA[_i]) * (unsigned)(K * 2) + (unsigned)(CA[_i] * 2); } while (0)
#define PG8_STAGE_A(bufoff, gbase_plain, kb, h, useN) do { if constexpr (GA) { _Pragma("unroll") for (int _i = 0; _i < 2; ++_i) { const unsigned _o = (useN) ? gon[h][_i] : goc[h][_i]; \
        __builtin_amdgcn_global_load_lds((const unsigned*)(gA + (kb) + _o), (PG8_LAS unsigned*)(lds + (bufoff) + ldsw + _i * 8192), 16, 0, 0); } } else { PG8_STAGE(bufoff, gbase_plain, voffA); } } while (0)
    const size_t kstep = (size_t)(BK * 2);
    const size_t hstep = (size_t)HALF * K * 2;
    const size_t tstep = 2 * hstep;
    const unsigned ldsw = (unsigned)wid * 1024u;
    const int aoff = lds_byte(wr * 64 + fr, fq * 8), boff = lds_byte(wc * 32 + fr, fq * 8);
#define PG8_SA(b, h) (((b) * 2 + (h)) * HTB)
#define PG8_SB(b, h) ((4 + (b) * 2 + (h)) * HTB)
#define PG8_STAGE(bufoff, gbase, voff) do { _Pragma("unroll") for (int _i = 0; _i < 2; ++_i) \
        __builtin_amdgcn_global_load_lds((const unsigned*)((const char*)(gbase) + (voff)[_i]), (PG8_LAS unsigned*)(lds + (bufoff) + ldsw + _i * 8192), 16, 0, 0); } while (0)
#define PG8_LDA(dst, b, h) do { _Pragma("unroll") for (int m = 0; m < 4; ++m) _Pragma("unroll") for (int k = 0; k < 2; ++k) dst[m][k] = *(const PG8_LAS bf16x8*)(lds + PG8_SA(b, h) + aoff + m * 2048 + k * 1024); } while (0)
#define PG8_LDB(dst, b, h) do { _Pragma("unroll") for (int n = 0; n < 2; ++n) _Pragma("unroll") for (int k = 0; k < 2; ++k) dst[n][k] = *(const PG8_LAS bf16x8*)(lds + PG8_SB(b, h) + boff + n * 2048 + k * 1024); } while (0)
#define PG8_MMA(ai, bj, At, Bt) do { __builtin_amdgcn_s_setprio(1); _Pragma("unroll") for (int m = 0; m < 4; ++m) _Pragma("unroll") for (int n = 0; n < 2; ++n) _Pragma("unroll") for (int k = 0; k < 2; ++k) \
        acc[ai][bj][m][n] = __builtin_amdgcn_mfma_f32_16x16x32_bf16(Bt[n][k], At[m][k], acc[ai][bj][m][n], 0, 0, 0); __builtin_amdgcn_s_setprio(0); } while (0)
#define PG8_WAIT_V(n) asm volatile("s_waitcnt vmcnt(" #n ")" ::: "memory")
#define PG8_WAIT_L(n) asm volatile("s_waitcnt lgkmcnt(" #n ")" ::: "memory")
#define PG8_BAR __builtin_amdgcn_s_barrier()
#define PG8_SCHED __builtin_amdgcn_sched_barrier(0)
    Unit cur, nxt; int ui = 0;
    if (!S.next(0, cur)) return;
    f32x4 acc[2][2][4][2];
#pragma unroll
    for (int a = 0; a < 2; ++a)
#pragma unroll
        for (int b = 0; b < 2; ++b)
#pragma unroll
            for (int m = 0; m < 4; ++m)
#pragma unroll
                for (int n = 0; n < 2; ++n) acc[a][b][m][n] = (f32x4){0.f, 0.f, 0.f, 0.f};
    bf16x8 At[4][2], B0[2][2], B1[2][2];
    const char* cA = (const char*)g.A + (size_t)cur.pm * tstep; const char* cB = (const char*)g.Bt + (size_t)cur.pn * tstep;
    if constexpr (GA) { PG8_GO(goc, 0, cur); }
    S.a_ready(cur);
    if constexpr (SP2) {
        PG8_STAGE(PG8_SB(0, 0), cB, voffB); PG8_STAGE(PG8_SB(0, 1), cB + hstep, voffB); PG8_STAGE_A(PG8_SA(0, 0), cA, 0, 0, false); PG8_STAGE_A(PG8_SA(0, 1), cA + hstep, 0, 1, false);
        if (wr == 1) PG8_BAR;
        PG8_WAIT_V(2); PG8_BAR;
        PG8_STAGE(PG8_SB(1, 0), cB + kstep, voffB); PG8_STAGE_A(PG8_SA(1, 0), cA + kstep, kstep, 0, false); PG8_STAGE(PG8_SB(1, 1), cB + hstep + kstep, voffB);
        PG8_WAIT_V(6); PG8_BAR;
    } else {
        PG8_STAGE(PG8_SB(0, 0), cB, voffB); PG8_STAGE(PG8_SA(0, 0), cA, voffA); PG8_STAGE(PG8_SB(0, 1), cB + hstep, voffB); PG8_STAGE(PG8_SA(0, 1), cA + hstep, voffA);
        if (wr == 1) PG8_BAR;
        PG8_WAIT_V(4); PG8_BAR;
        PG8_STAGE(PG8_SB(1, 0), cB + kstep, voffB); PG8_STAGE(PG8_SA(1, 0), cA + kstep, voffA); PG8_STAGE(PG8_SB(1, 1), cB + hstep + kstep, voffB);
        PG8_WAIT_V(6); PG8_BAR;
    }
    for (;;) {
        const bool has_next = S.next(ui + 1, nxt);
        if constexpr (GA) { if (has_next) { PG8_GO(gon, ui + 1, nxt); } else { _Pragma("unroll") for (int _h = 0; _h < 2; ++_h) _Pragma("unroll") for (int _i = 0; _i < 2; ++_i) gon[_h][_i] = goc[_h][_i]; } }
        const char* nA = has_next ? (const char*)g.A + (size_t)nxt.pm * tstep : cA; const char* nB = has_next ? (const char*)g.Bt + (size_t)nxt.pn * tstep : cB;
        for (int t = 0; t < nt; t += 2) {
            const bool last = (t == nt - 2);
            const char* a1 = cA + (size_t)(t + 1) * kstep;
            const char* a2 = last ? nA : cA + (size_t)(t + 2) * kstep; const char* b2 = last ? nB : cB + (size_t)(t + 2) * kstep;
            const char* a3 = a2 + kstep; const char* b3 = b2 + kstep;
            const size_t k2 = last ? (size_t)0 : (size_t)(t + 2) * kstep;
            if (last && has_next) S.a_ready(nxt);
            if constexpr (SP2) {
            PG8_LDB(B0, 0, 0); PG8_LDB(B1, 0, 1); PG8_SCHED; PG8_LDA(At, 0, 0); PG8_STAGE_A(PG8_SA(1, 1), a1 + hstep, (size_t)(t + 1) * kstep, 1, false);
            PG8_WAIT_V(8); PG8_WAIT_L(0); PG8_BAR; PG8_MMA(0, 0, At, B0); PG8_MMA(0, 1, At, B1); PG8_BAR; PG8_SCHED;
            PG8_LDA(At, 0, 1); PG8_STAGE(PG8_SB(0, 0), b2, voffB); PG8_STAGE(PG8_SB(0, 1), b2 + hstep, voffB); PG8_STAGE_A(PG8_SA(0, 0), a2, k2, 0, last);
            PG8_WAIT_V(8); PG8_WAIT_L(0); PG8_BAR; PG8_MMA(1, 0, At, B0); PG8_MMA(1, 1, At, B1); PG8_BAR; PG8_SCHED;
            PG8_LDB(B0, 1, 0); PG8_LDB(B1, 1, 1); PG8_SCHED; PG8_LDA(At, 1, 0); PG8_STAGE_A(PG8_SA(0, 1), a2 + hstep, k2, 1, last);
            PG8_WAIT_V(8); PG8_WAIT_L(0); PG8_BAR; PG8_MMA(0, 0, At, B0); PG8_MMA(0, 1, At, B1); PG8_BAR; PG8_SCHED;
            PG8_LDA(At, 1, 1); PG8_STAGE(PG8_SB(1, 0), b3, voffB); PG8_STAGE(PG8_SB(1, 1), b3 + hstep, voffB); PG8_STAGE_A(PG8_SA(1, 0), a3, k2 + kstep, 0, last);
            PG8_WAIT_V(8); PG8_WAIT_L(0); PG8_BAR; PG8_MMA(1, 0, At, B0); PG8_MMA(1, 1, At, B1); PG8_BAR; PG8_SCHED;
            } else {
            PG8_LDB(B0, 0, 0); PG8_SCHED; PG8_LDA(At, 0, 0); PG8_STAGE(PG8_SA(1, 1), a1 + hstep, voffA);
            PG8_WAIT_L(8); PG8_BAR; PG8_WAIT_L(0); PG8_MMA(0, 0, At, B0); PG8_BAR; PG8_SCHED;
            PG8_LDB(B1, 0, 1); PG8_STAGE(PG8_SB(0, 0), b2, voffB);
            PG8_BAR; PG8_WAIT_L(0); PG8_MMA(0, 1, At, B1); PG8_BAR;
            PG8_LDA(At, 0, 1); PG8_STAGE(PG8_SA(0, 0), a2, voffA);
            PG8_BAR; PG8_WAIT_L(0); PG8_MMA(1, 0, At, B0); PG8_BAR; PG8_SCHED;
            PG8_STAGE(PG8_SB(0, 1), b2 + hstep, voffB);
            PG8_WAIT_V(6); PG8_BAR; PG8_MMA(1, 1, At, B1); PG8_BAR;
            PG8_LDB(B0, 1, 0); PG8_SCHED; PG8_LDA(At, 1, 0); PG8_STAGE(PG8_SA(0, 1), a2 + hstep, voffA);
            PG8_WAIT_L(8); PG8_BAR; PG8_WAIT_L(0); PG8_MMA(0, 0, At, B0); PG8_BAR; PG8_SCHED;
            PG8_LDB(B1, 1, 1); PG8_STAGE(PG8_SB(1, 0), b3, voffB);
            PG8_BAR; PG8_WAIT_L(0); PG8_MMA(0, 1, At, B1); PG8_BAR;
            PG8_LDA(At, 1, 1); PG8_STAGE(PG8_SA(1, 0), a3, voffA);
            PG8_BAR; PG8_WAIT_L(0); PG8_MMA(1, 0, At, B0); PG8_BAR; PG8_SCHED;
            PG8_STAGE(PG8_SB(1, 1), b3 + hstep, voffB);
            PG8_WAIT_V(6); PG8_BAR; PG8_MMA(1, 1, At, B1); PG8_BAR;
            }
        }
        if constexpr (ALIGN_EPI) { if (wr == 0) PG8_BAR; }
        if constexpr (!Epi::AFTER_DRAIN) { E(acc, cur, wr, wc, fr, fq); S.done(cur); }
        if (!has_next) break;
#pragma unroll
        for (int a = 0; a < 2; ++a)
#pragma unroll
            for (int b = 0; b < 2; ++b)
#pragma unroll
                for (int m = 0; m < 4; ++m)
#pragma unroll
                    for (int n = 0; n < 2; ++n) acc[a][b][m][n] = (f32x4){0.f, 0.f, 0.f, 0.f};
        cur = nxt; cA = nA; cB = nB; ++ui;
        if constexpr (GA) { _Pragma("unroll") for (int _h = 0; _h < 2; ++_h) _Pragma("unroll") for (int _i = 0; _i < 2; ++_i) goc[_h][_i] = gon[_h][_i]; }
        if constexpr (ALIGN_EPI) { if (wr == 1) PG8_BAR; }
    }
    PG8_WAIT_V(0);
    if constexpr (!ALIGN_EPI) { if (wr == 0) PG8_BAR; }
    PG8_BAR;
    if constexpr (Epi::AFTER_DRAIN) { E.fused(acc, cur, wr, wc, fr, fq, lds, wid, lane); S.done(cur); }
#undef PG8_SA
#undef PG8_SB
#undef PG8_STAGE
#undef PG8_STAGE_A
#undef PG8_GO
#undef PG8_LDA
#undef PG8_LDB
#undef PG8_MMA
#undef PG8_WAIT_V
#undef PG8_WAIT_L
#undef PG8_BAR
#undef PG8_SCHED
}
}

#ifndef PG8_SP2
#define PG8_SP2 true
#endif
#ifndef PG8_ALIGN
#define PG8_ALIGN true
#endif
#define GAS __attribute__((address_space(1)))
#define LAS __attribute__((address_space(3)))
typedef unsigned short bf16;
typedef unsigned v4u __attribute__((ext_vector_type(4)));
typedef float f32x4 __attribute__((ext_vector_type(4)));
typedef short bf16x8 __attribute__((ext_vector_type(8)));
typedef GAS unsigned gu32;
typedef GAS unsigned long long gu64;
#define RLX_AGENT __ATOMIC_RELAXED, __HIP_MEMORY_SCOPE_AGENT
#define LDS_WAIT() asm volatile("s_waitcnt lgkmcnt(0)" ::: "memory")
#define VM_WAIT() asm volatile("s_waitcnt vmcnt(0)" ::: "memory")
__device__ __forceinline__ unsigned long long rt() { return __builtin_amdgcn_s_memrealtime(); }
__device__ __forceinline__ unsigned f2bf(float f) { unsigned u = __builtin_bit_cast(unsigned, f); return (u + 0x7fffu + ((u >> 16) & 1u)) >> 16; }
__device__ __forceinline__ unsigned pk2(float lo, float hi) { return f2bf(lo) | (f2bf(hi) << 16); }

#define XB_TMO      128
#define XB_XCNT(j)  (256  + 64 * (j))
#define XB_XSUB(j)  (1280 + 64 * (j))
#define XB_XGEN(j)  (2304 + 64 * (j))
#define XB_TOP      3328
#define XB_TOPGEN   3392
#define XCD_BAR_WORDS 3456
#define XB_SPIN_CAP (1u << 18)

__device__ __forceinline__ unsigned xb_ld(unsigned* p)              { return __hip_atomic_load(p, __ATOMIC_RELAXED, __HIP_MEMORY_SCOPE_AGENT); }
__device__ __forceinline__ unsigned xb_add(unsigned* p, unsigned v) { return __hip_atomic_fetch_add(p, v, __ATOMIC_RELAXED, __HIP_MEMORY_SCOPE_AGENT); }
__device__ __forceinline__ unsigned xb_xcc_id() { return (unsigned)__builtin_amdgcn_s_getreg((3 << 11) | 20) & 0xFu; }
#define XB_SPIN(cond, bar) do { unsigned _sp = 0; while (cond) { __builtin_amdgcn_s_sleep(1); \
    if ((++_sp & 255u) == 0u) { if (xb_ld(&(bar)[XB_TMO])) break; if (_sp > XB_SPIN_CAP) { atomicAdd(&(bar)[XB_TMO], 1u); break; } } } } while (0)

struct XcdBarrier {
    unsigned* bar; unsigned x;
    volatile LAS unsigned* st;
};

__device__ __forceinline__ XcdBarrier xcd_barrier_post(unsigned* bar, volatile LAS unsigned* st, bool leader) {
    XcdBarrier b; b.bar = bar; b.x = xb_xcc_id(); b.st = st;
    if (leader) (void)xb_add(&bar[XB_XCNT(b.x)], 1u);
    return b;
}
__device__ __forceinline__ void xcd_barrier_complete(unsigned* bar, unsigned x, unsigned& nloc, unsigned& nx) {
    const unsigned G = gridDim.x * gridDim.y * gridDim.z;
    unsigned sum, cnt, mine, sp = 0u;
    for (;;) {
        sum = 0u; cnt = 0u; mine = 0u;
#pragma unroll
        for (unsigned j = 0; j < 16; ++j) { const unsigned c = xb_ld(&bar[XB_XCNT(j)]); sum += c; cnt += (c > 0u) ? 1u : 0u; mine = (j == x) ? c : mine; }
        if (sum == G) break;
        __builtin_amdgcn_s_sleep(1);
        if ((++sp & 255u) == 0u) { if (xb_ld(&bar[XB_TMO])) break; if (sp > XB_SPIN_CAP) { atomicAdd(&bar[XB_TMO], 1u); break; } }
    }
    nloc = mine > 0u ? mine : 1u; nx = cnt > 0u ? cnt : 1u;
}

__device__ __forceinline__ void xcd_barrier(const XcdBarrier& b, bool leader) {
    asm volatile("s_waitcnt vmcnt(0)" ::: "memory");
    __syncthreads();
    if (leader) {
        unsigned* bar = b.bar;
        __builtin_amdgcn_s_waitcnt(0);
        unsigned nloc = b.st[0], nx = b.st[1];
        if (nloc == 0u) { xcd_barrier_complete(bar, b.x, nloc, nx); b.st[0] = nloc; b.st[1] = nx; }
        const unsigned old = xb_add(&bar[XB_XSUB(b.x)], 1u);
        const unsigned gen = old / nloc;
        if (old + 1u == (gen + 1u) * nloc) {
            __builtin_amdgcn_fence(__ATOMIC_RELEASE, "agent");
            asm volatile("s_waitcnt vmcnt(0)" ::: "memory");
            const unsigned og = xb_add(&bar[XB_TOP], 1u);
            const unsigned tg = og / nx;
            if (og + 1u == (tg + 1u) * nx) xb_add(&bar[XB_TOPGEN], 1u);
            else XB_SPIN(xb_ld(&bar[XB_TOPGEN]) == tg, bar);
            __builtin_amdgcn_fence(__ATOMIC_ACQUIRE, "agent");
            xb_add(&bar[XB_XGEN(b.x)], 1u);
            asm volatile("s_waitcnt vmcnt(0)" ::: "memory");
        } else {
            XB_SPIN(xb_ld(&bar[XB_XGEN(b.x)]) == gen, bar);
            __builtin_amdgcn_fence(__ATOMIC_ACQUIRE, "agent");
            asm volatile("s_waitcnt vmcnt(0)" ::: "memory");
        }
    }
    __syncthreads();
}
constexpr int NWAVES = 8;
constexpr int B_ = 8, S_ = 2048, T = B_ * S_, D = 1024;
constexpr int INC = 3784;
constexpr int O_Q = 0, O_CKV = 512, O_QI = 640, O_KI = 1152, O_WI = 1216, O_U = 1224, O_G = 1736;
constexpr int NIN = 4352;
constexpr float ALPHA = 1.189207115002721f, LN_EPS = 1e-5f, LOG2E = 1.4426950408889634f;
constexpr int MAXROWS = T * 4 + 32 * 256;
constexpr int TOPK = 256;

constexpr size_t MiB = 1u << 20;
constexpr size_t WS_CTL = 0, CTL_ZERO_BYTES = 1 * MiB;
constexpr size_t WS_MOD = 1 * MiB, WS_WIN = 2 * MiB, WS_WOA = 11 * MiB, WS_WPB = 13 * MiB, WS_WOUT = 14 * MiB, WS_WGU = 16 * MiB, WS_WD = 144 * MiB;
constexpr size_t WS_H = 208 * MiB, WS_QL = 240 * MiB, WS_QI = 272 * MiB, WS_MISC = 288 * MiB, WS_U = 304 * MiB, WS_SG = 320 * MiB;
constexpr size_t WS_CKV = 384 * MiB, WS_CKVT = 388 * MiB, WS_POOLED = 392 * MiB, WS_MASK = 408 * MiB, WS_OLAT = 412 * MiB, WS_TMP = 444 * MiB, WS_MIX = 476 * MiB;
constexpr size_t WS_Z = 508 * MiB, WS_X1 = 572 * MiB, WS_SLOTMAP = 636 * MiB, WS_TOKSLOT = 638 * MiB, WS_GATE = 638 * MiB + 512 * 1024;
constexpr size_t WS_XPAD = 640 * MiB, WS_ACT = 784 * MiB, WS_Y = WS_XPAD, WS_KI = 928 * MiB, WS_WRB = 930 * MiB, WS_END = 931 * MiB;
constexpr int CW_GCNT = 0, CW_TSTART = 64, CW_BAR = 4096;

constexpr int RING_OFF = 0, RING_BYTES = 131072;
constexpr int LDSCTL_OFF = RING_BYTES, MISC_OFF = LDSCTL_OFF + 320;
constexpr int LDS_BYTES = 163840;

struct Frame {
    LAS unsigned char* lds;
    volatile LAS unsigned* MISCW;
    gu32* ctl;
    int tid, lane, wave, vcu, G;
    unsigned char* ws;
    float* out;
};
__device__ __forceinline__ const float* frame_in(int i) { const char* ka = (const char*)__builtin_amdgcn_kernarg_segment_ptr(); asm volatile("" : "+s"(ka)); return *(const float* const*)(ka + 8 * i); }
typedef __bf16 bf2v __attribute__((ext_vector_type(2)));
typedef float f2v __attribute__((ext_vector_type(2)));
__device__ __forceinline__ unsigned pkbf(float a, float b) { f2v v = {a, b}; bf2v r = __builtin_convertvector(v, bf2v); return __builtin_bit_cast(unsigned, r); }
__device__ __forceinline__ float bf2f(unsigned short u) { return __uint_as_float((unsigned)u << 16); }
__device__ __forceinline__ float sigm_fast(float x) { return __builtin_amdgcn_rcpf(1.f + __builtin_amdgcn_exp2f(-x * LOG2E)); }

typedef float f32x16 __attribute__((ext_vector_type(16)));
__device__ __forceinline__ bf16x8 pack8(float a0, float a1, float a2, float a3, float a4, float a5, float a6, float a7) {
    v4u p; p.x = pkbf(a0, a1); p.y = pkbf(a2, a3); p.z = pkbf(a4, a5); p.w = pkbf(a6, a7); return __builtin_bit_cast(bf16x8, p); }
#define MFMA32(a, b, c) __builtin_amdgcn_mfma_f32_32x32x16_bf16((a), (b), (c), 0, 0, 0)
__device__ __forceinline__ int krow16(int r, int hh) { return (r & 3) + 8 * (r >> 2) + 4 * hh; }

namespace pg8 {
struct EpiInProj {
    static constexpr bool PERM = true, AFTER_DRAIN = false;
    bf16_t *QL, *QI, *U, *SG; float* MISC; bf16_t* KI;
    __device__ __forceinline__ void operator()(const f32x4 (&acc)[2][2][4][2], const Unit& u, int wr, int wc, int fr, int fq) const {
        const int row0 = u.pm * BM + wr * 64 + fr, c0 = wc * 32 + 8 * fq; const int pn = u.pn;
        if (pn == 6) {
#pragma unroll
            for (int ai = 0; ai < 2; ++ai)
#pragma unroll
                for (int m = 0; m < 4; ++m) { float* rowp = MISC + (size_t)(row0 + ai * HALF + m * 16) * 256 + c0;
#pragma unroll
                    for (int bj = 0; bj < 2; ++bj) { *(f32x4*)(rowp + bj * HALF) = acc[ai][bj][m][0]; *(f32x4*)(rowp + bj * HALF + 4) = acc[ai][bj][m][1]; }
                    if (wc < 2) { const f32x4 v0 = acc[ai][1][m][0], v1 = acc[ai][1][m][1]; u32x4 w; w.x = cvt_pk_bf16(v0[0], v0[1]); w.y = cvt_pk_bf16(v0[2], v0[3]); w.z = cvt_pk_bf16(v1[0], v1[1]); w.w = cvt_pk_bf16(v1[2], v1[3]);
                        *(u32x4*)(KI + (size_t)(row0 + ai * HALF + m * 16) * 64 + c0) = w; } }
        } else {
            bf16_t* base; int ld, colt; bool sg = false;
            if (pn < 4) { base = QL; ld = 1024; colt = pn * 256; }
            else if (pn < 6) { base = QI; ld = 512; colt = (pn - 4) * 256; }
            else if (pn < 9) { base = U; ld = 512; colt = (pn - 7) * 256; }
            else { base = SG; ld = 2048; colt = (pn - 9) * 256; sg = true; }
#pragma unroll
            for (int ai = 0; ai < 2; ++ai)
#pragma unroll
                for (int m = 0; m < 4; ++m) { bf16_t* rowp = base + (size_t)(row0 + ai * HALF + m * 16) * ld + colt + c0;
#pragma unroll
                    for (int bj = 0; bj < 2; ++bj) { f32x4 v0 = acc[ai][bj][m][0], v1 = acc[ai][bj][m][1];
                        if (sg) {
#pragma unroll
                            for (int i = 0; i < 4; ++i) { v0[i] = sigm_fast(v0[i]); v1[i] = sigm_fast(v1[i]); } }
                        u32x4 w; w.x = cvt_pk_bf16(v0[0], v0[1]); w.y = cvt_pk_bf16(v0[2], v0[3]); w.z = cvt_pk_bf16(v1[0], v1[1]); w.w = cvt_pk_bf16(v1[2], v1[3]);
                        *(u32x4*)(rowp + bj * HALF) = w; } }
        }
    }
};
}

__device__ __forceinline__ void tr_item(const float* W, int ldw, int k0, int n0, int ncols, float scale, bf16* WT, int ldt, int drow0, LAS float* scr, int lane) {
    const int nn = lane & 31;
#pragma unroll 8
    for (int i = 0; i < 32; ++i) { const int kk = 2 * i + (lane >> 5); scr[kk * 33 + nn] = (nn < ncols) ? W[(size_t)(k0 + kk) * ldw + n0 + nn] * scale : 0.f; }
    LDS_WAIT(); asm volatile("" ::: "memory");
    const int c = lane & 7;
#pragma unroll
    for (int j = 0; j < 4; ++j) { const int n = (lane >> 3) + 8 * j; const LAS float* s = scr + (8 * c) * 33 + n;
        v4u o; o.x = pk2(s[0 * 33], s[1 * 33]); o.y = pk2(s[2 * 33], s[3 * 33]); o.z = pk2(s[4 * 33], s[5 * 33]); o.w = pk2(s[6 * 33], s[7 * 33]);
        if (n < ncols) *(GAS v4u*)(WT + (size_t)(drow0 + n) * ldt + k0 + 8 * c) = o; }
    LDS_WAIT(); asm volatile("" ::: "memory");
}
struct TrDesc { const float* src; bf16* dst; int ldw; float scale; };
__device__ __forceinline__ void tr_load(const TrDesc& d, int lane, f32x4 (&v)[16]) {
    const int kr = lane >> 4, nc = lane & 15; const float* src = d.src + (size_t)(16 * kr) * d.ldw + 4 * nc;
#pragma unroll
    for (int i = 0; i < 16; ++i) v[i] = __builtin_nontemporal_load((const f32x4*)(src + (size_t)i * d.ldw));
}
__device__ __forceinline__ void tr_finish(const TrDesc& d, LAS unsigned char* scr, int lane, const f32x4 (&v)[16]) {
    const int kr = lane >> 4, nc = lane & 15; const float scale = d.scale;
#pragma unroll
    for (int j = 0; j < 4; ++j) { const int n = 4 * nc + j; const int f = (n >> 2) & 7;
#pragma unroll
        for (int hlf = 0; hlf < 2; ++hlf) { v4u o;
            o.x = pkbf(v[8 * hlf + 0][j] * scale, v[8 * hlf + 1][j] * scale); o.y = pkbf(v[8 * hlf + 2][j] * scale, v[8 * hlf + 3][j] * scale);
            o.z = pkbf(v[8 * hlf + 4][j] * scale, v[8 * hlf + 5][j] * scale); o.w = pkbf(v[8 * hlf + 6][j] * scale, v[8 * hlf + 7][j] * scale);
            *(LAS v4u*)(scr + n * 128 + (((2 * kr + hlf) ^ f) << 4)) = o; } }
    LDS_WAIT(); asm volatile("" ::: "memory");
    const int kc = lane & 7;
#pragma unroll
    for (int j = 0; j < 8; ++j) { const int n = (lane >> 3) + 8 * j; const v4u o = *(const LAS v4u*)(scr + n * 128 + ((kc ^ ((n >> 2) & 7)) << 4));
        *(GAS v4u*)(d.dst + (size_t)n * 1024 + 8 * kc) = o; }
    LDS_WAIT(); asm volatile("" ::: "memory");
}
__device__ __forceinline__ void fold_qlat(const float* w_in, const float* w_uk, bf16* Win_t, int task, int lane) {
    const int h = task >> 8, kb = (task >> 4) & 15, r0 = (task & 15) * 8; const int k = kb * 64 + lane;
    const float* wrow = w_in + (size_t)k * INC + O_Q + h * 64; const float* up = w_uk + r0 * 512 + h * 64;
    float a[8] = {0, 0, 0, 0, 0, 0, 0, 0};
#pragma unroll 4
    for (int d4 = 0; d4 < 16; ++d4) { const f32x4 v = *(const f32x4*)(wrow + 4 * d4);
#pragma unroll
        for (int j = 0; j < 8; ++j) { const f32x4 u = *(const f32x4*)(up + j * 512 + 4 * d4); a[j] += (v.x * u.x + v.y * u.y) + (v.z * u.z + v.w * u.w); } }
#pragma unroll
    for (int j = 0; j < 8; ++j) Win_t[(size_t)(h * 128 + r0 + j) * 1024 + k] = (bf16)f2bf(a[j] * (0.125f * LOG2E));
}
__device__ __forceinline__ void fold_oa(const float* w_uv, const float* w_ba, bf16* Woa_t, int task, int lane) {
    const int h = task >> 8, nb = (task >> 4) & 15, r0 = (task & 15) * 8; const int n = nb * 64 + lane;
    const float* up = w_uv + r0 * 512 + h * 64; float a[8] = {0, 0, 0, 0, 0, 0, 0, 0};
#pragma unroll 4
    for (int d4 = 0; d4 < 16; ++d4) { float v[4];
#pragma unroll
        for (int i = 0; i < 4; ++i) v[i] = w_ba[(size_t)(h * 64 + 4 * d4 + i) * 1024 + n];
#pragma unroll
        for (int j = 0; j < 8; ++j) { const f32x4 u = *(const f32x4*)(up + j * 512 + 4 * d4); a[j] += (v[0] * u.x + v[1] * u.y) + (v[2] * u.z + v[3] * u.w); } }
    v4u o; o.x = pk2(a[0], a[1]); o.y = pk2(a[2], a[3]); o.z = pk2(a[4], a[5]); o.w = pk2(a[6], a[7]);
    *(GAS v4u*)(Woa_t + (size_t)n * 1024 + h * 128 + r0) = o;
}
__device__ __forceinline__ void fold_pb(const float* w_pg, const float* pscale, const float* w_bp, bf16* Wpb_t, int task, int lane) {
    const int g = task >> 8, nb = (task >> 4) & 15, c0 = (task & 15) * 8; const int n = nb * 64 + lane;
    const float* pg = w_pg + (size_t)g * 16384 + c0 * 128; float a[8] = {0, 0, 0, 0, 0, 0, 0, 0};
#pragma unroll 4
    for (int d4 = 0; d4 < 32; ++d4) { float v[4]; const f32x4 ps = *(const f32x4*)(pscale + g * 128 + 4 * d4);
#pragma unroll
        for (int i = 0; i < 4; ++i) v[i] = w_bp[(size_t)(g * 128 + 4 * d4 + i) * 1024 + n] * ps[i];
#pragma unroll
        for (int j = 0; j < 8; ++j) { const f32x4 u = *(const f32x4*)(pg + j * 128 + 4 * d4); a[j] += (v[0] * u.x + v[1] * u.y) + (v[2] * u.z + v[3] * u.w); } }
    v4u o; o.x = pk2(a[0], a[1]); o.y = pk2(a[2], a[3]); o.z = pk2(a[4], a[5]); o.w = pk2(a[6], a[7]);
    *(GAS v4u*)(Wpb_t + (size_t)n * 512 + g * 128 + c0) = o;
}
__device__ __forceinline__ void p0_prologue(Frame& F) {
    const float* c = frame_in(1); const float* w_ada = frame_in(2); const float* b_ada = frame_in(3); const float* w_in = frame_in(4);
    const float* w_uk = frame_in(6); const float* w_uv = frame_in(7); const float* w_pg = frame_in(8); const float* pscale = frame_in(9);
    const float* w_ba = frame_in(10); const float* w_bp = frame_in(11); const float* w_out = frame_in(12); const float* w_gu = frame_in(17); const float* w_d = frame_in(19);
    bf16* Win_t = (bf16*)(F.ws + WS_WIN); bf16* Woa_t = (bf16*)(F.ws + WS_WOA); bf16* Wpb_t = (bf16*)(F.ws + WS_WPB); bf16* Wout_t = (bf16*)(F.ws + WS_WOUT);
    bf16* Wgu_t = (bf16*)(F.ws + WS_WGU); bf16* Wd_t = (bf16*)(F.ws + WS_WD); float* MOD = (float*)(F.ws + WS_MOD);
    for (int cg = blockIdx.x; cg < 96; cg += F.G) {
        LAS float* cs = (LAS float*)(F.lds + 69632); LAS float* red = (LAS float*)(F.lds + 69632 + 32768);
        for (int i = F.tid; i < 8192; i += 512) { const float v = c[i]; cs[i] = v / (1.f + __expf(-v)); }
        __syncthreads();
        float acc[8] = {0, 0, 0, 0, 0, 0, 0, 0}; const int n = cg * 64 + F.lane;
#pragma unroll 16
        for (int k = F.wave * 128; k < F.wave * 128 + 128; ++k) { const float w = __builtin_nontemporal_load(w_ada + (size_t)k * 6144 + n);
#pragma unroll
            for (int b = 0; b < 8; ++b) acc[b] += cs[b * 1024 + k] * w; }
#pragma unroll
        for (int b = 0; b < 8; ++b) red[(F.wave * 8 + b) * 64 + F.lane] = acc[b];
        __syncthreads();
        { const int b = F.tid >> 6, l = F.tid & 63; float s = 0.f;
#pragma unroll
          for (int w = 0; w < 8; ++w) s += red[(w * 8 + b) * 64 + l];
          MOD[b * 6144 + cg * 64 + l] = s + b_ada[cg * 64 + l]; }
        __syncthreads();
    }
    LAS unsigned char* scr8 = F.lds + F.wave * 8448; LAS float* scr = (LAS float*)scr8;
    const int gw = F.vcu * NWAVES + F.wave, NGW = F.G * NWAVES;
    constexpr int I_FQ = 2048, I_FO = 2048, I_FP = 1024, I_Z = 56, I_WI = 16, I_WR = 64, NSMALL = I_FQ + I_FO + I_FP + I_Z + I_WI + I_WR;
    for (int it = gw; it < NSMALL; it += NGW) {
        int r = it;
        if (r < I_FQ) { fold_qlat(w_in, w_uk, Win_t, r, F.lane); continue; } r -= I_FQ;
        if (r < I_FO) { fold_oa(w_uv, w_ba, Woa_t, r, F.lane); continue; } r -= I_FO;
        if (r < I_FP) { fold_pb(w_pg, pscale, w_bp, Wpb_t, r, F.lane); continue; } r -= I_FP;
        if (r < I_Z) { GAS v4u* z = (GAS v4u*)(Win_t + (size_t)(1736 + r) * 1024); z[F.lane] = (v4u){0u, 0u, 0u, 0u}; z[F.lane + 64] = (v4u){0u, 0u, 0u, 0u}; continue; } r -= I_Z;
        if (r < I_WI) { tr_item(w_in, INC, r * 64, O_WI, 8, 0.35355339059327373f, Win_t, 1024, 1728, scr, F.lane); continue; } r -= I_WI;
        {
            const float* w_r = frame_in(15); bf16* WrB = (bf16*)(F.ws + WS_WRB); const int ks = r, e = F.lane & 31, h8 = F.lane >> 5; float v[8]; unsigned hi[4], lo[4];
#pragma unroll
            for (int j = 0; j < 8; ++j) v[j] = w_r[(size_t)(16 * ks + 8 * h8 + j) * 32 + e];
#pragma unroll
            for (int j = 0; j < 4; ++j) { hi[j] = pkbf(v[2 * j], v[2 * j + 1]); lo[j] = pkbf(v[2 * j] - __uint_as_float(hi[j] << 16), v[2 * j + 1] - __uint_as_float(hi[j] & 0xffff0000u)); }
            *(GAS v4u*)(WrB + ((size_t)(ks * 2) * 64 + F.lane) * 8) = (v4u){hi[0], hi[1], hi[2], hi[3]}; *(GAS v4u*)(WrB + ((size_t)(ks * 2 + 1) * 64 + F.lane) * 8) = (v4u){lo[0], lo[1], lo[2], lo[3]}; }
    }
    constexpr int I_QI = 128, I_CKV = 32, I_KI = 16, I_U = 128, I_G = 512, I_OUT = 256, I_GU = 32 * 512, I_D = 32 * 256;
    constexpr int NTR = I_QI + I_CKV + I_KI + I_U + I_G + I_OUT + I_GU + I_D;
    auto decode = [&](int r) -> TrDesc {
        if (r < I_QI) return TrDesc{w_in + (size_t)((r >> 3) * 64) * INC + O_QI + (r & 7) * 64, Win_t + (size_t)(1024 + (r & 7) * 64) * 1024 + (r >> 3) * 64, INC, 0.125f}; r -= I_QI;
        if (r < I_CKV) return TrDesc{w_in + (size_t)((r >> 1) * 64) * INC + O_CKV + (r & 1) * 64, Win_t + (size_t)(1536 + (r & 1) * 64) * 1024 + (r >> 1) * 64, INC, 1.f}; r -= I_CKV;
        if (r < I_KI) return TrDesc{w_in + (size_t)(r * 64) * INC + O_KI, Win_t + (size_t)1664 * 1024 + r * 64, INC, 1.f}; r -= I_KI;
        if (r < I_U) return TrDesc{w_in + (size_t)((r >> 3) * 64) * INC + O_U + (r & 7) * 64, Win_t + (size_t)(1792 + (r & 7) * 64) * 1024 + (r >> 3) * 64, INC, 1.f}; r -= I_U;
        if (r < I_G) return TrDesc{w_in + (size_t)((r >> 5) * 64) * INC + O_G + (r & 31) * 64, Win_t + (size_t)(2304 + (r & 31) * 64) * 1024 + (r >> 5) * 64, INC, 1.f}; r -= I_G;
        if (r < I_OUT) return TrDesc{w_out + (size_t)((r >> 4) * 64) * 1024 + (r & 15) * 64, Wout_t + (size_t)((r & 15) * 64) * 1024 + (r >> 4) * 64, 1024, 1.f}; r -= I_OUT;
        if (r < I_GU) { const int e = r >> 9, q = r & 511, kb = q >> 5, n0 = (q & 31) * 64;
            const int drow = (n0 < 1024) ? ((n0 >> 7) * 256 + (n0 & 127)) : (((n0 - 1024) >> 7) * 256 + 128 + ((n0 - 1024) & 127));
            return TrDesc{w_gu + ((size_t)e * 1024 + kb * 64) * 2048 + n0, Wgu_t + ((size_t)e * 2048 + drow) * 1024 + kb * 64, 2048, 1.f}; } r -= I_GU;
        { const int e = r >> 8, q = r & 255, kb = q >> 4, n0 = (q & 15) * 64;
          return TrDesc{w_d + ((size_t)e * 1024 + kb * 64) * 1024 + n0, Wd_t + ((size_t)e * 1024 + n0) * 1024 + kb * 64, 1024, 1.f}; }
    };
    {   f32x4 vA[16], vB[16]; TrDesc dA, dB; int it = gw;
        if (it < NTR) { dA = decode(it); tr_load(dA, F.lane, vA); }
        while (it < NTR) {
            int itn = it + NGW; if (itn < NTR) { dB = decode(itn); tr_load(dB, F.lane, vB); }
            tr_finish(dA, scr8, F.lane, vA);
            it = itn; if (it >= NTR) break;
            itn = it + NGW; if (itn < NTR) { dA = decode(itn); tr_load(dA, F.lane, vA); }
            tr_finish(dB, scr8, F.lane, vB);
            it = itn;
        }
    }
}
__device__ __forceinline__ void p1_modulate(Frame& F) {
    const float* x = frame_in(0); const float* MOD = (const float*)(F.ws + WS_MOD); bf16* H = (bf16*)(F.ws + WS_H);
    const int gw = F.vcu * NWAVES + F.wave, NGW = F.G * NWAVES;
    for (int m = gw; m < T; m += NGW) { const int b = m >> 11;
        const GAS f32x4* xr = (const GAS f32x4*)(x + (size_t)m * D) + F.lane; GAS unsigned long long* o8 = (GAS unsigned long long*)(H + (size_t)m * D) + F.lane;
#pragma unroll
        for (int j = 0; j < 4; ++j) { const f32x4 v = xr[64 * j]; const int col = 4 * F.lane + 256 * j;
            const f32x4 sh = *(const f32x4*)(MOD + b * 6144 + col), sc = *(const f32x4*)(MOD + b * 6144 + 1024 + col);
            const f32x4 h = v * (sc + 1.0f) + sh;
            o8[64 * j] = (unsigned long long)pk2(h.x, h.y) | ((unsigned long long)pk2(h.z, h.w) << 32); }
    }
}
constexpr int MOE_TAB_SLOTS = 10, LC_ROWTAB = LDSCTL_OFF + 8192;
constexpr int LC_LCNT = LDSCTL_OFF + 1024, LC_BASE = LDSCTL_OFF + 1280, LC_TSTART = LDSCTL_OFF + 1536, LC_LIST = LDSCTL_OFF + 4096;
namespace pg8 {
__device__ __forceinline__ float bfl(unsigned w) { return __uint_as_float(w << 16); }
__device__ __forceinline__ float bfh(unsigned w) { return __uint_as_float(w & 0xffff0000u); }
struct EpiGateMul {
    static constexpr bool PERM = true, AFTER_DRAIN = false;
    bf16_t* O; const bf16_t* SG; int goff, pad;
    __device__ __forceinline__ void operator()(const f32x4 (&acc)[2][2][4][2], const Unit& u, int wr, int wc, int fr, int fq) const {
        const int row0 = u.pm * BM + wr * 64 + fr, col0 = u.pn * BM + wc * 32 + 8 * fq;
#pragma unroll
        for (int ai = 0; ai < 2; ++ai)
#pragma unroll
            for (int m = 0; m < 4; ++m) { const size_t row = (size_t)(row0 + ai * HALF + m * 16);
#pragma unroll
                for (int bj = 0; bj < 2; ++bj) { const u32x4 g = *(const u32x4*)(SG + row * 2048 + goff + col0 + bj * HALF); const f32x4 v0 = acc[ai][bj][m][0], v1 = acc[ai][bj][m][1];
                    u32x4 w; w.x = cvt_pk_bf16(v0[0] * bfl(g.x), v0[1] * bfh(g.x)); w.y = cvt_pk_bf16(v0[2] * bfl(g.y), v0[3] * bfh(g.y));
                    w.z = cvt_pk_bf16(v1[0] * bfl(g.z), v1[1] * bfh(g.z)); w.w = cvt_pk_bf16(v1[2] * bfl(g.w), v1[3] * bfh(g.w));
                    *(u32x4*)(O + row * 1024 + col0 + bj * HALF) = w; } }
    }
};
struct EpiGateAdd {
    static constexpr bool PERM = true, AFTER_DRAIN = false;
    bf16_t* O; const bf16_t* TMPB; const bf16_t* SG; int goff, pad;
    __device__ __forceinline__ void operator()(const f32x4 (&acc)[2][2][4][2], const Unit& u, int wr, int wc, int fr, int fq) const {
        const int row0 = u.pm * BM + wr * 64 + fr, col0 = u.pn * BM + wc * 32 + 8 * fq;
#pragma unroll
        for (int ai = 0; ai < 2; ++ai)
#pragma unroll
            for (int m = 0; m < 4; ++m) { const size_t row = (size_t)(row0 + ai * HALF + m * 16);
#pragma unroll
                for (int bj = 0; bj < 2; ++bj) { const u32x4 g = *(const u32x4*)(SG + row * 2048 + goff + col0 + bj * HALF); const u32x4 t = *(const u32x4*)(TMPB + row * 1024 + col0 + bj * HALF);
                    const f32x4 v0 = acc[ai][bj][m][0], v1 = acc[ai][bj][m][1];
                    u32x4 w; w.x = cvt_pk_bf16(bfl(t.x) + v0[0] * bfl(g.x), bfh(t.x) + v0[1] * bfh(g.x)); w.y = cvt_pk_bf16(bfl(t.y) + v0[2] * bfl(g.y), bfh(t.y) + v0[3] * bfh(g.y));
                    w.z = cvt_pk_bf16(bfl(t.z) + v1[0] * bfl(g.z), bfh(t.z) + v1[1] * bfh(g.z)); w.w = cvt_pk_bf16(bfl(t.w) + v1[2] * bfl(g.w), bfh(t.w) + v1[3] * bfh(g.w));
                    *(u32x4*)(O + row * 1024 + col0 + bj * HALF) = w; } }
    }
};
struct EpiResid {
    static constexpr bool PERM = false, AFTER_DRAIN = false;
    float* Z; const float* x; const float* gate;
    __device__ __forceinline__ void operator()(const f32x4 (&acc)[2][2][4][2], const Unit& u, int wr, int wc, int fr, int fq) const {
        const int row0 = u.pm * BM + wr * 64 + fr, col0 = u.pn * BM + wc * 32 + 4 * fq; const int b = (u.pm * BM) >> 11;
        f32x4 gv[2][2];
#pragma unroll
        for (int bj = 0; bj < 2; ++bj)
#pragma unroll
            for (int n = 0; n < 2; ++n) gv[bj][n] = *(const f32x4*)(gate + b * 6144 + col0 + bj * HALF + n * 16);
#pragma unroll
        for (int ai = 0; ai < 2; ++ai)
#pragma unroll
            for (int m = 0; m < 4; ++m) { const size_t off = (size_t)(row0 + ai * HALF + m * 16) * 1024 + col0;
#pragma unroll
                for (int bj = 0; bj < 2; ++bj)
#pragma unroll
                    for (int n = 0; n < 2; ++n) { const f32x4 xv = *(const f32x4*)(x + off + bj * HALF + n * 16); *(f32x4*)(Z + off + bj * HALF + n * 16) = xv * ALPHA + gv[bj][n] * acc[ai][bj][m][n]; } }
    }
};
struct EpiSwiglu {
    static constexpr bool PERM = true, AFTER_DRAIN = false;
    bf16_t* ACT; const float* bgu;
    __device__ __forceinline__ void operator()(const f32x4 (&acc)[2][2][4][2], const Unit& u, int wr, int wc, int fr, int fq) const {
        const int e = u.pn >> 3, j = u.pn & 7; const int row0 = u.pm * BM + wr * 64 + fr, cc = wc * 32 + 8 * fq;
        const float* bg = bgu + e * 2048 + j * 128 + cc; f32x4 bgl[2], bli[2];
#pragma unroll
        for (int n = 0; n < 2; ++n) { bgl[n] = *(const f32x4*)(bg + 4 * n); bli[n] = *(const f32x4*)(bg + 1024 + 4 * n); }
#pragma unroll
        for (int ai = 0; ai < 2; ++ai)
#pragma unroll
            for (int m = 0; m < 4; ++m) { float o[8];
#pragma unroll
                for (int n = 0; n < 2; ++n) { const f32x4 gl4 = acc[ai][0][m][n] + bgl[n], li4 = acc[ai][1][m][n] + bli[n];
#pragma unroll
                    for (int i = 0; i < 4; ++i) { const float gl = fminf(gl4[i], 7.f), li = fminf(fmaxf(li4[i], -7.f), 7.f);
                        o[4 * n + i] = gl * __builtin_amdgcn_rcpf(1.f + __builtin_amdgcn_exp2f(gl * (-1.702f * LOG2E))) * (li + 1.f); } }
                u32x4 w; w.x = cvt_pk_bf16(o[0], o[1]); w.y = cvt_pk_bf16(o[2], o[3]); w.z = cvt_pk_bf16(o[4], o[5]); w.w = cvt_pk_bf16(o[6], o[7]);
                *(u32x4*)(ACT + (size_t)(row0 + ai * HALF + m * 16) * 1024 + j * 128 + cc) = w; }
    }
};
struct EpiDown {
    static constexpr bool PERM = true, AFTER_DRAIN = false;
    bf16_t* Y; const float* bd;
    __device__ __forceinline__ void operator()(const f32x4 (&acc)[2][2][4][2], const Unit& u, int wr, int wc, int fr, int fq) const {
        const int e = u.pn >> 2, j = u.pn & 3; const int row0 = u.pm * BM + wr * 64 + fr, col0 = j * 256 + wc * 32 + 8 * fq;
        f32x4 bv[2][2];
#pragma unroll
        for (int bj = 0; bj < 2; ++bj)
#pragma unroll
            for (int n = 0; n < 2; ++n) bv[bj][n] = *(const f32x4*)(bd + e * 1024 + col0 + bj * HALF + 4 * n);
#pragma unroll
        for (int ai = 0; ai < 2; ++ai)
#pragma unroll
            for (int m = 0; m < 4; ++m) { bf16_t* rowp = Y + (size_t)(row0 + ai * HALF + m * 16) * 1024 + col0;
#pragma unroll
                for (int bj = 0; bj < 2; ++bj) { const f32x4 v0 = acc[ai][bj][m][0] + bv[bj][0], v1 = acc[ai][bj][m][1] + bv[bj][1];
                    u32x4 w; w.x = cvt_pk_bf16(v0[0], v0[1]); w.y = cvt_pk_bf16(v0[2], v0[3]); w.z = cvt_pk_bf16(v1[0], v1[1]); w.w = cvt_pk_bf16(v1[2], v1[3]);
                    *(u32x4*)(rowp + bj * HALF) = w; } }
    }
};
template <bool GATHER_>
struct MoeOrderT {
    static constexpr bool GATHER = GATHER_;
    const PG8_LAS int* tstart; int NT, G, c;
    const PG8_LAS int* rowtab; const int* slotmap; const int* cnt;
    __device__ __forceinline__ int arow(int slot, const Unit& u, int r) const {
        if (slot < MOE_TAB_SLOTS) return rowtab[slot * 256 + r];
        const int e = u.pn / NT, rank = (u.pm - tstart[e]) * 256 + r; return rank < cnt[e] ? slotmap[e * T + rank] : 0;
    }
    __device__ __forceinline__ bool next(int i, Unit& u) const {
        const int x = c & 7, li = c >> 3, per = G >> 3; int L = i * per + li;
#pragma unroll 1
        for (int j = 0; j < 4; ++j) { const int e = x + 8 * j; const int nte = tstart[e + 1] - tstart[e], nu = nte * NT;
            if (L < nu) { u.pm = tstart[e] + L % nte; u.pn = e * NT + L / nte; return true; }
            L -= nu; }
        return false;
    }
    __device__ __forceinline__ void a_ready(const Unit&) const {}
    __device__ __forceinline__ void done(const Unit&) const {}
};
typedef MoeOrderT<true> MoeOrderG; typedef MoeOrderT<false> MoeOrder;
}

__device__ __forceinline__ float wave_sum(float v) {
#pragma unroll
    for (int o = 1; o < 64; o <<= 1) v += __shfl_xor(v, o);
    return v;
}
__device__ __forceinline__ void p3_post(Frame& F) {
    const float* MISC = (const float*)(F.ws + WS_MISC); const float* kvg = frame_in(5); bf16* CKV = (bf16*)(F.ws + WS_CKV); bf16* CKVT = (bf16*)(F.ws + WS_CKVT);
    const bf16* U = (const bf16*)(F.ws + WS_U); bf16* POOLED = (bf16*)(F.ws + WS_POOLED);
    LAS bf16* tile = (LAS bf16*)(F.lds);
    for (int task = blockIdx.x; task < 256; task += F.G) {
        const int t0 = task * 64; const int row = F.tid >> 3, seg = F.tid & 7;
        const float* src = MISC + (size_t)(t0 + row) * 256 + seg * 16; f32x4 v[4]; float ss = 0.f;
#pragma unroll
        for (int i = 0; i < 4; ++i) { v[i] = *(const f32x4*)(src + 4 * i); ss += (v[i].x * v[i].x + v[i].y * v[i].y) + (v[i].z * v[i].z + v[i].w * v[i].w); }
        ss += __shfl_xor(ss, 1); ss += __shfl_xor(ss, 2); ss += __shfl_xor(ss, 4);
        const float rs = 1.0f / sqrtf(ss * (1.f / 128.f) + LN_EPS);
        unsigned w[8];
#pragma unroll
        for (int i = 0; i < 4; ++i) { const f32x4 g = *(const f32x4*)(kvg + seg * 16 + 4 * i); w[2 * i] = pk2(v[i].x * rs * g.x, v[i].y * rs * g.y); w[2 * i + 1] = pk2(v[i].z * rs * g.z, v[i].w * rs * g.w); }
        GAS v4u* dst = (GAS v4u*)(CKV + (size_t)(t0 + row) * 128 + seg * 16); dst[0] = (v4u){w[0], w[1], w[2], w[3]}; dst[1] = (v4u){w[4], w[5], w[6], w[7]};
        LAS v4u* lt = (LAS v4u*)(tile + row * 128 + seg * 16); lt[0] = (v4u){w[0], w[1], w[2], w[3]}; lt[1] = (v4u){w[4], w[5], w[6], w[7]};
        __syncthreads();
        { const int d = F.tid >> 2, part = F.tid & 3; unsigned o[8];
#pragma unroll
          for (int q = 0; q < 16; q += 2) { unsigned pr[2];
#pragma unroll
              for (int z = 0; z < 2; ++z) { const int p = part * 16 + q + z; const int j = p & 7, h = (p >> 3) & 1, tt = (p >> 4) & 1, kb = p >> 5; const int key = kb * 32 + 16 * tt + 8 * (j >> 2) + 4 * h + (j & 3); pr[z] = tile[key * 128 + d]; }
              o[q >> 1] = pr[0] | (pr[1] << 16); }
          const int b = task >> 5, kt = task & 31;
          GAS v4u* dt = (GAS v4u*)(CKVT + ((size_t)(b * 128 + d) * 2048) + kt * 64 + part * 16); dt[0] = (v4u){o[0], o[1], o[2], o[3]}; dt[1] = (v4u){o[4], o[5], o[6], o[7]}; }
        __syncthreads();
    }
    for (int task = blockIdx.x; task < 1024; task += F.G) {
        const int c = F.tid, g = c >> 7; const int t0 = task * 16, s0 = t0 & 2047; const bf16* up = U + (size_t)(t0 - s0) * 512 + c;
        float v[32];
#pragma unroll
        for (int j = 0; j < 32; ++j) { const int sp = s0 - 16 + j; v[j] = (sp >= 0) ? bf2f(up[(size_t)(sp < 0 ? 0 : sp) * 512]) : 0.f; }
        float pre[33]; pre[0] = 0.f;
#pragma unroll
        for (int j = 0; j < 32; ++j) pre[j + 1] = pre[j] + v[j];
#define POOL_OUT(W) _Pragma("unroll") for (int j = 16; j < 32; ++j) { const int s = s0 + j - 16; const int cntw = (s + 1 < (W)) ? (s + 1) : (W); \
            POOLED[(size_t)(t0 + j - 16) * 512 + c] = (bf16)f2bf((pre[j + 1] - pre[j + 1 - (W)]) / (float)cntw - v[j]); }
        if (g == 0) { POOL_OUT(2) } else if (g == 1) { POOL_OUT(4) } else if (g == 2) { POOL_OUT(8) } else { POOL_OUT(16) }
#undef POOL_OUT
    }
}
constexpr int P7_AL = 0, P7_LOGIT = 131072 - 4096;
__device__ __forceinline__ void p7_ln1_route(Frame& F, int cw_gcnt) {
    const float* Z = (const float*)(F.ws + WS_Z); const float* g1 = frame_in(13); const float* b1 = frame_in(14); const float* b_r = frame_in(16);
    const float* MOD = (const float*)(F.ws + WS_MOD); float* X1 = (float*)(F.ws + WS_X1); bf16* H2 = (bf16*)(F.ws + WS_H); const bf16* WrB = (const bf16*)(F.ws + WS_WRB);
    int* gcnt = (int*)(F.ctl + cw_gcnt); int* SLOTMAP = (int*)(F.ws + WS_SLOTMAP); int* TOKSLOT = (int*)(F.ws + WS_TOKSLOT); float* GATE = (float*)(F.ws + WS_GATE);
    LAS unsigned char* AL = F.lds + P7_AL; LAS float* red = (LAS float*)(F.lds);
    LAS float* logit = (LAS float*)(F.lds + 65536);
    LAS int* lcnt = (LAS int*)(F.lds + LC_LCNT); LAS int* lbase = (LAS int*)(F.lds + LC_BASE); LAS int* list = (LAS int*)(F.lds + LC_LIST);
    if (F.tid < 32) lcnt[F.tid] = 0;
    const int hh = F.lane >> 5, l31 = F.lane & 31;
    bf16x8 Bh[8], Bl[8];
#pragma unroll
    for (int s = 0; s < 8; ++s) { const bf16* p = WrB + ((size_t)((F.wave * 8 + s) * 2) * 64 + F.lane) * 8; Bh[s] = *(const GAS bf16x8*)p; Bl[s] = *(const GAS bf16x8*)(p + 64 * 8); }
    const int rows_per_wg = T / F.G;
    for (int step = 0; step < rows_per_wg / 32; ++step) { const int m0 = blockIdx.x * rows_per_wg + step * 32;
        __syncthreads();
#pragma unroll 1
        for (int rr = 0; rr < 4; ++rr) { const int row = F.wave * 4 + rr, m = m0 + row, b = m >> 11;
            const GAS f32x4* zr = (const GAS f32x4*)(Z + (size_t)m * D) + F.lane; f32x4 v[4]; float s = 0.f;
#pragma unroll
            for (int j = 0; j < 4; ++j) { v[j] = zr[64 * j]; s += (v[j].x + v[j].y) + (v[j].z + v[j].w); }
            const float mean = wave_sum(s) * (1.f / D); float s2 = 0.f;
#pragma unroll
            for (int j = 0; j < 4; ++j) { v[j] = v[j] - mean; s2 += (v[j].x * v[j].x + v[j].y * v[j].y) + (v[j].z * v[j].z + v[j].w * v[j].w); }
            const float rstd = 1.f / sqrtf(wave_sum(s2) * (1.f / D) + LN_EPS);
#pragma unroll
            for (int j = 0; j < 4; ++j) { const int col = 4 * F.lane + 256 * j;
                const f32x4 gg = *(const f32x4*)(g1 + col), bb = *(const f32x4*)(b1 + col); const f32x4 x1 = v[j] * rstd * gg + bb;
                *((GAS f32x4*)(X1 + (size_t)m * D) + F.lane + 64 * j) = x1;
                const f32x4 sh = *(const f32x4*)(MOD + b * 6144 + 3 * 1024 + col), sc = *(const f32x4*)(MOD + b * 6144 + 4 * 1024 + col); const f32x4 h2 = x1 * (sc + 1.0f) + sh;
                const unsigned h01 = pkbf(h2.x, h2.y), h23 = pkbf(h2.z, h2.w);
                *((GAS unsigned long long*)(H2 + (size_t)m * D) + F.lane + 64 * j) = (unsigned long long)h01 | ((unsigned long long)h23 << 32);
                const unsigned l01 = pkbf(h2.x - pg8::bfl(h01), h2.y - pg8::bfh(h01)), l23 = pkbf(h2.z - pg8::bfl(h23), h2.w - pg8::bfh(h23));
                const int chunk = 32 * j + (F.lane >> 1); const int off = row * 2048 + (((chunk & ~15) | ((chunk ^ row) & 15)) << 4) + (F.lane & 1) * 8;
                *(LAS unsigned long long*)(AL + off) = (unsigned long long)h01 | ((unsigned long long)h23 << 32);
                *(LAS unsigned long long*)(AL + 65536 + off) = (unsigned long long)l01 | ((unsigned long long)l23 << 32); } }
        __syncthreads();
        f32x16 acc;
#pragma unroll
        for (int r = 0; r < 16; ++r) acc[r] = 0.f;
#pragma unroll
        for (int s = 0; s < 8; ++s) { const int chunk = 2 * (F.wave * 8 + s) + hh; const int off = l31 * 2048 + (((chunk & ~15) | ((chunk ^ l31) & 15)) << 4);
            const bf16x8 Ah = *(const LAS bf16x8*)(AL + off), Alo = *(const LAS bf16x8*)(AL + 65536 + off);
            acc = MFMA32(Ah, Bh[s], acc); acc = MFMA32(Ah, Bl[s], acc); acc = MFMA32(Alo, Bh[s], acc); }
        __syncthreads();
#pragma unroll
        for (int r = 0; r < 16; ++r) red[(F.wave * 32 + krow16(r, hh)) * 32 + l31] = acc[r];
        __syncthreads();
        { const int row = F.tid >> 4, e0 = (F.tid & 15) * 2; float s0 = 0.f, s1 = 0.f;
#pragma unroll
          for (int w = 0; w < 8; ++w) { s0 += red[(w * 32 + row) * 32 + e0]; s1 += red[(w * 32 + row) * 32 + e0 + 1]; }
          logit[row * 33 + e0] = s0 + b_r[e0]; logit[row * 33 + e0 + 1] = s1 + b_r[e0 + 1]; }
        __syncthreads();
        if (F.tid < 32) { const int row = F.tid, m = m0 + row; float lg[32];
#pragma unroll
            for (int e = 0; e < 32; ++e) lg[e] = logit[row * 33 + e];
            int se[4]; float sv[4]; unsigned used = 0u;
#pragma unroll
            for (int k = 0; k < 4; ++k) { int best = 0; float bv = -INFINITY; bool have = false;
#pragma unroll
                for (int e = 0; e < 32; ++e) { const bool ok = !((used >> e) & 1u) && (!have || lg[e] > bv); if (ok) { best = e; bv = lg[e]; have = true; } }
                se[k] = best; sv[k] = bv; used |= 1u << best; }
            float ex[4], den = 0.f;
#pragma unroll
            for (int k = 0; k < 4; ++k) { ex[k] = __expf(sv[k] - sv[0]); den += ex[k]; }
            const float inv = 1.f / den;
#pragma unroll
            for (int k = 0; k < 4; ++k) { const int lr = __hip_atomic_fetch_add(&lcnt[se[k]], 1, __ATOMIC_RELAXED, __HIP_MEMORY_SCOPE_WORKGROUP);
                LAS int* ent = list + ((step * 32 + row) * 4 + k) * 4; ent[0] = m; ent[1] = se[k]; ent[2] = lr; ent[3] = __float_as_int(ex[k] * inv); } }
    }
    __syncthreads();
    if (F.tid < 32) lbase[F.tid] = atomicAdd(&gcnt[F.tid], lcnt[F.tid]);
    __syncthreads();
    if (F.tid < 256) { LAS int* ent = list + F.tid * 4; const int m = ent[0], e = ent[1], rank = lbase[e] + ent[2];
        SLOTMAP[e * T + rank] = m; TOKSLOT[m * 4 + (F.tid & 3)] = e | (rank << 8); GATE[m * 4 + (F.tid & 3)] = __int_as_float(ent[3]); }
}
__device__ __forceinline__ void load_tstart(Frame& F) {
    LAS int* ts = (LAS int*)(F.lds + LC_TSTART); const int* gcnt = (const int*)(F.ctl + CW_GCNT);
    if (F.tid == 0) { int a = 0; for (int e = 0; e < 32; ++e) { ts[e] = a; a += (__hip_atomic_load(gcnt + e, __ATOMIC_RELAXED, __HIP_MEMORY_SCOPE_AGENT) + 255) >> 8; } ts[32] = a; }
    __syncthreads();
}
__device__ __forceinline__ void moe_fill_rowtab(Frame& F, const pg8::MoeOrderG& S) {
    LAS int* tab = (LAS int*)(F.lds + LC_ROWTAB); const LAS int* ts = (const LAS int*)(F.lds + LC_TSTART);
    for (int slot = 0; slot < MOE_TAB_SLOTS; ++slot) { pg8::Unit u; if (!S.next(slot, u)) break;
        if (F.tid < 256) { const int e = u.pn / S.NT, rank = (u.pm - ts[e]) * 256 + F.tid; tab[slot * 256 + F.tid] = rank < S.cnt[e] ? S.slotmap[e * T + rank] : 0; } }
    __syncthreads();
}
__device__ __forceinline__ void p11_final(Frame& F) {
    load_tstart(F);
    const LAS int* ts = (const LAS int*)(F.lds + LC_TSTART);
    const float* X1 = (const float*)(F.ws + WS_X1); const bf16* Y = (const bf16*)(F.ws + WS_Y); const int* TOKSLOT = (const int*)(F.ws + WS_TOKSLOT); const float* GATE = (const float*)(F.ws + WS_GATE);
    const float* MOD = (const float*)(F.ws + WS_MOD); const float* g2 = frame_in(21); const float* b2 = frame_in(22);
    const int gw = F.vcu * NWAVES + F.wave, NGW = F.G * NWAVES;
    for (int m = gw; m < T; m += NGW) { const int b = m >> 11;
        f32x4 mo[4];
#pragma unroll
        for (int j = 0; j < 4; ++j) mo[j] = (f32x4){0.f, 0.f, 0.f, 0.f};
#pragma unroll
        for (int k = 0; k < 4; ++k) { const int tsl = TOKSLOT[m * 4 + k]; const int e = tsl & 255, rank = tsl >> 8; const float gt = GATE[m * 4 + k];
            const GAS unsigned long long* yr = (const GAS unsigned long long*)(Y + ((size_t)ts[e] * 256 + rank) * D) + F.lane;
#pragma unroll
            for (int j = 0; j < 4; ++j) { const unsigned long long w = yr[64 * j]; const unsigned lo = (unsigned)w, hi = (unsigned)(w >> 32);
                mo[j].x += gt * pg8::bfl(lo); mo[j].y += gt * pg8::bfh(lo); mo[j].z += gt * pg8::bfl(hi); mo[j].w += gt * pg8::bfh(hi); } }
        f32x4 v[4]; float s = 0.f;
#pragma unroll
        for (int j = 0; j < 4; ++j) { const int col = 4 * F.lane + 256 * j; const f32x4 x1 = *((const GAS f32x4*)(X1 + (size_t)m * D) + F.lane + 64 * j);
            const f32x4 g2m = *(const f32x4*)(MOD + b * 6144 + 5 * 1024 + col); v[j] = x1 * ALPHA + g2m * mo[j]; s += (v[j].x + v[j].y) + (v[j].z + v[j].w); }
        const float mean = wave_sum(s) * (1.f / D); float s2 = 0.f;
#pragma unroll
        for (int j = 0; j < 4; ++j) { v[j] = v[j] - mean; s2 += (v[j].x * v[j].x + v[j].y * v[j].y) + (v[j].z * v[j].z + v[j].w * v[j].w); }
        const float rstd = 1.f / sqrtf(wave_sum(s2) * (1.f / D) + LN_EPS);
#pragma unroll
        for (int j = 0; j < 4; ++j) { const int col = 4 * F.lane + 256 * j; const f32x4 gg = *(const f32x4*)(g2 + col), bb = *(const f32x4*)(b2 + col);
            *((GAS f32x4*)(F.out + (size_t)m * D) + F.lane + 64 * j) = v[j] * rstd * gg + bb; }
    }
}
__device__ __forceinline__ unsigned ordkey(float f) { const unsigned u = __float_as_uint(f); return (u & 0x80000000u) ? ~u : (u | 0x80000000u); }

constexpr int SEL_QI = 0, SEL_HIST = 32768, SEL_CAND = 98304, SEL_MASK = 114688, SEL_META = 122880, SEL_CAP = 128;
__device__ __forceinline__ float relu_i(float x) { const int i = __float_as_int(x); return __int_as_float(i > 0 ? i : 0); }
__device__ __forceinline__ void idx_load_a(const bf16* KIb, int kt, int lane, bf16x8 (&A)[4]) {
    const bf16* kp = KIb + (size_t)(kt * 32 + (lane & 31)) * 64 + 8 * (lane >> 5);
#pragma unroll
    for (int s = 0; s < 4; ++s) A[s] = *(const GAS bf16x8*)(kp + 16 * s);
}
__device__ __forceinline__ void idx_scores1(const bf16x8 (&AA)[4], const LAS unsigned char* qiL, const float (&wi)[8], int lane, f32x16& scA) {
    const int hh = lane >> 5, q = lane & 31; const LAS unsigned char* qrow = qiL + q * 1024; const int qs = q & 15;
#pragma unroll
    for (int r = 0; r < 16; ++r) scA[r] = 0.f;
    bf16x8 Bc[4], Bn[4];
#pragma unroll
    for (int s = 0; s < 4; ++s) Bc[s] = *(const LAS bf16x8*)(qrow + (((2 * s + hh) ^ qs) << 4));
#pragma unroll
    for (int h = 0; h < 8; ++h) {
        if (h < 7) {
#pragma unroll
            for (int s = 0; s < 4; ++s) Bn[s] = *(const LAS bf16x8*)(qrow + ((((h + 1) * 8 + 2 * s + hh) ^ qs) << 4)); }
        f32x16 accA;
#pragma unroll
        for (int r = 0; r < 16; ++r) accA[r] = 0.f;
#pragma unroll
        for (int s = 0; s < 4; ++s) accA = MFMA32(AA[s], Bc[s], accA);
#pragma unroll
        for (int r = 0; r < 16; ++r) scA[r] = fmaf(wi[h], relu_i(accA[r]), scA[r]);
#pragma unroll
        for (int s = 0; s < 4; ++s) Bc[s] = Bn[s];
    }
}
template <int MODE, int VAR>
__device__ __forceinline__ void sel_tile(Frame& F, const f32x16& sc, int kt, int hh, int q, int qpos, int bst, unsigned pfx, unsigned trial, unsigned& cntl) {
    LAS unsigned* hist = (LAS unsigned*)(F.lds + SEL_HIST); LAS unsigned* cand = (LAS unsigned*)(F.lds + SEL_CAND); LAS unsigned* maskL = (LAS unsigned*)(F.lds + SEL_MASK); LAS int* meta = (LAS int*)(F.lds + SEL_META);
    unsigned word = 0u; const int kbase = kt * 32 + 4 * hh; const int lim = qpos - kbase;
#pragma unroll
    for (int r = 0; r < 16; ++r) { const int kr0 = (r & 3) + 8 * (r >> 2); const bool valid = kr0 <= lim;
        const unsigned bits = __float_as_uint(sc[r]) & 0xFFFFF800u; const float st = __uint_as_float(bits);
        int bin = (int)(st * 64.f) + 256; bin = bin < 0 ? 0 : (bin > 511 ? 511 : bin);
        if (MODE == 0) { if (VAR == 1) { asm volatile("" :: "v"(bin), "v"(valid ? 1u : 0u)); } else __hip_atomic_fetch_add(hist + q * 512 + bin, valid ? 1u : 0u, __ATOMIC_RELAXED, __HIP_MEMORY_SCOPE_WORKGROUP); }
        else { const unsigned ck = (ordkey(st) & 0xFFFFF800u) | (unsigned)(2047 - kbase - kr0);
            if (MODE == 1) { word |= (valid && bin > bst) ? (1u << kr0) : 0u; const bool isc = valid && bin == bst;
                if (isc) { const int slot = __hip_atomic_fetch_add((LAS int*)meta + 64 + q, 1, __ATOMIC_RELAXED, __HIP_MEMORY_SCOPE_WORKGROUP); if (slot < SEL_CAP) cand[q * SEL_CAP + slot] = ck; } }
            if (MODE == 2) { cntl += (valid && ck >= (pfx | trial)) ? 1u : 0u; }
            if (MODE == 3) { word |= (valid && ck >= pfx) ? (1u << kr0) : 0u; } }
        }
    if (MODE == 1 || MODE == 3) __hip_atomic_fetch_or(maskL + q * 64 + kt, word << (4 * hh), __ATOMIC_RELAXED, __HIP_MEMORY_SCOPE_WORKGROUP);
}
template <int MODE, int VAR>
__device__ __forceinline__ void sel_pass(Frame& F, int lane, int wave, const bf16* KIb, int qb, const float (&wi)[8], unsigned trial) {
    const LAS unsigned char* qiL = F.lds + SEL_QI; LAS int* meta = (LAS int*)(F.lds + SEL_META);
    const int bst = meta[lane & 31]; const unsigned pfx = (unsigned)meta[128 + (lane & 31)];
    unsigned cntl = 0u;
    bf16x8 AA[4], NA[4];
    if (wave <= qb) idx_load_a(KIb, wave, lane, AA);
#pragma unroll 1
    for (int kt = wave; kt <= qb; kt += NWAVES) {
        int lane_t = lane; asm volatile("" : "+v"(lane_t));
        const int hh = lane_t >> 5, q = lane_t & 31, qpos = qb * 32 + q;
        if (kt + NWAVES <= qb) idx_load_a(KIb, kt + NWAVES, lane_t, NA);
        f32x16 scA;
        idx_scores1(AA, qiL, wi, lane_t, scA);
        if (VAR == 2) { asm volatile("" :: "v"(scA[0]), "v"(scA[7]), "v"(scA[15])); } else sel_tile<MODE, VAR>(F, scA, kt, hh, q, qpos, bst, pfx, trial, cntl);
#pragma unroll
        for (int s = 0; s < 4; ++s) AA[s] = NA[s];
    }
    if (MODE == 2) __hip_atomic_fetch_add((LAS unsigned*)meta + 160 + (lane & 31), cntl, __ATOMIC_RELAXED, __HIP_MEMORY_SCOPE_WORKGROUP);
}
template <int VAR>
__device__ __forceinline__ void p3_select(Frame& F) {
    const bf16* QI = (const bf16*)(F.ws + WS_QI); const float* MISC = (const float*)(F.ws + WS_MISC); unsigned* MASK = (unsigned*)(F.ws + WS_MASK);
    LAS unsigned* hist = (LAS unsigned*)(F.lds + SEL_HIST); LAS unsigned* cand = (LAS unsigned*)(F.lds + SEL_CAND); LAS unsigned* maskL = (LAS unsigned*)(F.lds + SEL_MASK); LAS int* meta = (LAS int*)(F.lds + SEL_META);
    const int b = blockIdx.x >> 5, ii = blockIdx.x & 31;
    for (int ui = 0; ui < 2; ++ui) { const int qb = ui ? 63 - ii : ii; const int t0 = b * S_ + qb * 32;
        int tid = F.tid; asm volatile("" : "+v"(tid)); const int lane = tid & 63; int wave = F.wave; asm volatile("" : "+s"(wave));
        if (qb < 8) {
            for (int wd = tid; wd < 2048; wd += 512) { const int q = wd >> 6, w = wd & 63, qpos = qb * 32 + q; const int rel = qpos - 32 * w;
                MASK[(size_t)(t0 + q) * 64 + w] = rel >= 31 ? 0xFFFFFFFFu : (rel < 0 ? 0u : ((2u << rel) - 1u)); }
            continue; }
        __syncthreads();
        for (int c = tid; c < 2048; c += 512) { const int q = c >> 6, c16 = c & 63; *(LAS v4u*)(F.lds + SEL_QI + q * 1024 + ((c16 ^ (q & 15)) << 4)) = *(const GAS v4u*)(QI + (size_t)(t0 + q) * 512 + c16 * 8); }
        { unsigned z = 0u; asm volatile("" : "+v"(z)); const v4u z4 = (v4u){z, z, z, z};
          for (int i = tid; i < 16384 / 4; i += 512) ((LAS v4u*)hist)[i] = z4;
          for (int i = tid; i < 2048 / 4; i += 512) ((LAS v4u*)maskL)[i] = z4; }
        if (tid < 192) meta[tid] = 0;
        float wi[8];
#pragma unroll
        for (int h = 0; h < 8; ++h) wi[h] = MISC[(size_t)(t0 + (lane & 31)) * 256 + 192 + h];
        const bf16* KIb = (const bf16*)(F.ws + WS_KI) + (size_t)b * S_ * 64;
        __syncthreads();
        sel_pass<0, VAR>(F, lane, wave, KIb, qb, wi, 0u);
        __syncthreads();
        for (int qq = 0; qq < 4; ++qq) { const int q = wave * 4 + qq; const LAS unsigned* hq = hist + q * 512; unsigned c8[8]; unsigned cs = 0u;
#pragma unroll
            for (int i = 0; i < 8; ++i) { c8[i] = hq[511 - 8 * lane - i]; cs += c8[i]; }
            unsigned incl = cs;
#pragma unroll
            for (int o = 1; o < 64; o <<= 1) { const unsigned v = __shfl_up(incl, o); if (lane >= o) incl += v; }
            const unsigned excl = incl - cs;
            if (excl < 256u && incl >= 256u) { unsigned run = excl;
#pragma unroll
                for (int i = 0; i < 8; ++i) { const unsigned before = run; run += c8[i]; if (before < 256u && run >= 256u) { meta[q] = 511 - 8 * lane - i; meta[32 + q] = (int)(256u - before); } } } }
        __syncthreads();
        sel_pass<1, VAR>(F, lane, wave, KIb, qb, wi, 0u);
        __syncthreads();
        if (tid < 32) { if (meta[64 + tid] > SEL_CAP) meta[96] = 1; }
        __syncthreads();
        if (meta[96] == 0) {
            for (int item = tid; item < 32 * SEL_CAP; item += 512) { const int q = item >> 7, i = item & (SEL_CAP - 1); const int n = meta[64 + q];
                if (i < n) { const unsigned my = cand[q * SEL_CAP + i]; int rank = 0; for (int j = 0; j < n; ++j) rank += (cand[q * SEL_CAP + j] > my) ? 1 : 0;
                    if (rank < meta[32 + q]) { const int idx = 2047 - (int)(my & 0x7FFu); __hip_atomic_fetch_or(maskL + q * 64 + (idx >> 5), 1u << (idx & 31), __ATOMIC_RELAXED, __HIP_MEMORY_SCOPE_WORKGROUP); } } }
        } else {
#pragma unroll 1
            for (int bit = 31; bit >= 0; --bit) {
                sel_pass<2, VAR>(F, lane, wave, KIb, qb, wi, 1u << bit);
                __syncthreads();
                if (tid < 32) { if ((unsigned)meta[160 + tid] >= 256u) meta[128 + tid] |= (int)(1u << bit); meta[160 + tid] = 0; }
                __syncthreads(); }
            sel_pass<3, VAR>(F, lane, wave, KIb, qb, wi, 0u);
        }
        __syncthreads();
        { const int q = tid >> 4, w4 = (tid & 15) * 4; *(GAS v4u*)(MASK + (size_t)(t0 + q) * 64 + w4) = *(const LAS v4u*)(maskL + q * 64 + w4); }
    }
}
typedef unsigned u32x2v __attribute__((ext_vector_type(2)));
constexpr int ATT_K = 0, ATT_VT = 32768;
__device__ __forceinline__ void att_load(const bf16* CKV, const bf16* CKVT, int b, int j, int tid, v4u (&st)[4]) {
#pragma unroll
    for (int i = 0; i < 2; ++i) { const int c = tid + 512 * i; st[i] = *(const GAS v4u*)(CKV + (size_t)(b * S_ + 64 * j) * 128 + c * 8); }
#pragma unroll
    for (int i = 0; i < 2; ++i) { const int c = tid + 512 * i, d = c >> 3, ch = c & 7; st[2 + i] = *(const GAS v4u*)(CKVT + (size_t)(b * 128 + d) * 2048 + 64 * j + ch * 8); }
}
__device__ __forceinline__ void att_store(LAS unsigned char* lds, int buf, int tid, const v4u (&st)[4]) {
#pragma unroll
    for (int i = 0; i < 2; ++i) { const int c = tid + 512 * i, row = c >> 4, ch = c & 15; *(LAS v4u*)(lds + ATT_K + buf * 16384 + row * 256 + ((ch ^ (row & 15)) << 4)) = st[i]; }
#pragma unroll
    for (int i = 0; i < 2; ++i) { const int c = tid + 512 * i, d = c >> 3, ch = c & 7; *(LAS v4u*)(lds + ATT_VT + buf * 16384 + d * 128 + ((ch ^ ((d >> 1) & 7)) << 4)) = st[2 + i]; }
}
__device__ __forceinline__ void p4_attention(Frame& F) {
    const bf16* QL = (const bf16*)(F.ws + WS_QL); const bf16* CKV = (const bf16*)(F.ws + WS_CKV); const bf16* CKVT = (const bf16*)(F.ws + WS_CKVT);
    const unsigned* MASK = (const unsigned*)(F.ws + WS_MASK); bf16* OLAT = (bf16*)(F.ws + WS_OLAT);
    const int b = blockIdx.x >> 5, ii = blockIdx.x & 31;
    for (int ui = 0; ui < 2; ++ui) { const int qb = ui ? 63 - ii : ii;
        int lane; asm volatile("v_mbcnt_lo_u32_b32 %0, -1, 0\n\tv_mbcnt_hi_u32_b32 %0, -1, %0" : "=v"(lane)); int head = F.wave; asm volatile("" : "+s"(head)); const int tid = head * 64 + lane;
        const int hh = lane >> 5, q = lane & 31; const float slope2 = __builtin_amdgcn_exp2f(-(float)(head + 1)) * LOG2E;
        const int t0 = b * S_ + qb * 32, qpos = qb * 32 + q; const int nt = (qb >> 1) + 1;
        bf16x8 Qf[8];
#pragma unroll
        for (int s = 0; s < 8; ++s) Qf[s] = *(const GAS bf16x8*)(QL + (size_t)(t0 + q) * 1024 + head * 128 + 16 * s + 8 * hh);
#pragma unroll
        for (int s = 0; s < 8; ++s) asm volatile("" : "+v"(Qf[s]));
        f32x16 O[4];
#pragma unroll
        for (int db = 0; db < 4; ++db)
#pragma unroll
            for (int r = 0; r < 16; ++r) O[db][r] = 0.f;
        float m_run = -INFINITY, l_run = 0.f;
        v4u st[4];
        att_load(CKV, CKVT, b, 0, tid, st);
        __syncthreads();
        att_store(F.lds, 0, tid, st);
        __syncthreads();
        for (int j = 0; j < nt; ++j) { const int buf = j & 1;
            const u32x2v mw = *(const GAS u32x2v*)(MASK + (size_t)(t0 + q) * 64 + 2 * j);
            __builtin_amdgcn_sched_barrier(0);
            att_load(CKV, CKVT, b, (j + 1 < nt) ? j + 1 : j, tid, st);
            __builtin_amdgcn_sched_barrier(0);
            f32x16 S0, S1;
#pragma unroll
            for (int r = 0; r < 16; ++r) { S0[r] = 0.f; S1[r] = 0.f; }
            const LAS unsigned char* kb0 = F.lds + ATT_K + buf * 16384 + q * 256, * kb1 = kb0 + 32 * 256;
            { bf16x8 Kf[16];
#pragma unroll
              for (int s = 0; s < 8; ++s) { const int sw = ((2 * s + hh) ^ (q & 15)) << 4; Kf[2 * s] = *(const LAS bf16x8*)(kb0 + sw); Kf[2 * s + 1] = *(const LAS bf16x8*)(kb1 + sw); }
#pragma unroll
              for (int s = 0; s < 8; ++s) { S0 = MFMA32(Kf[2 * s], Qf[s], S0); S1 = MFMA32(Kf[2 * s + 1], Qf[s], S1); }
              __builtin_amdgcn_sched_group_barrier(0x100, 6, 0);
#pragma unroll
              for (int i = 0; i < 5; ++i) { __builtin_amdgcn_sched_group_barrier(0x008, 2, 0); __builtin_amdgcn_sched_group_barrier(0x100, 2, 0); }
              __builtin_amdgcn_sched_group_barrier(0x008, 6, 0); }
            const LAS unsigned char* vb = F.lds + ATT_VT + buf * 16384;
            const unsigned mlo = mw.x >> (4 * hh), mhi = mw.y >> (4 * hh);
            const float base0 = slope2 * (float)(64 * j + 4 * hh - qpos);
            float tmax = -INFINITY;
#pragma unroll
            for (int r = 0; r < 16; ++r) { const int kr = (r & 3) + 8 * (r >> 2);
                float s0 = S0[r] + (base0 + slope2 * (float)kr), s1 = S1[r] + (base0 + slope2 * (float)(kr + 32));
                s0 = ((mlo >> kr) & 1u) ? s0 : -INFINITY; s1 = ((mhi >> kr) & 1u) ? s1 : -INFINITY;
                S0[r] = s0; S1[r] = s1; tmax = fmaxf(tmax, fmaxf(s0, s1)); }
            { const auto rr = __builtin_amdgcn_permlane32_swap(__float_as_uint(tmax), __float_as_uint(tmax), false, false); tmax = fmaxf(__uint_as_float(rr[0]), __uint_as_float(rr[1])); }
            const float m_new = fmaxf(m_run, tmax), msafe = (m_new == -INFINITY) ? 0.f : m_new;
            const float alpha = __builtin_amdgcn_exp2f(m_run - msafe);
            float ps = 0.f;
#pragma unroll
            for (int r = 0; r < 16; ++r) { S0[r] = __builtin_amdgcn_exp2f(S0[r] - msafe); S1[r] = __builtin_amdgcn_exp2f(S1[r] - msafe); ps += S0[r] + S1[r]; }
            l_run = l_run * alpha + ps; m_run = m_new;
            if (__any(alpha != 1.f)) {
#pragma unroll
                for (int db = 0; db < 4; ++db)
#pragma unroll
                    for (int r = 0; r < 16; ++r) O[db][r] *= alpha; }
            bf16x8 Pf[4];
            Pf[0] = pack8(S0[0], S0[1], S0[2], S0[3], S0[4], S0[5], S0[6], S0[7]); Pf[1] = pack8(S0[8], S0[9], S0[10], S0[11], S0[12], S0[13], S0[14], S0[15]);
            Pf[2] = pack8(S1[0], S1[1], S1[2], S1[3], S1[4], S1[5], S1[6], S1[7]); Pf[3] = pack8(S1[8], S1[9], S1[10], S1[11], S1[12], S1[13], S1[14], S1[15]);
            { bf16x8 Vf[16];
#pragma unroll
              for (int db = 0; db < 4; ++db) { const int d = db * 32 + q; const LAS unsigned char* vr = vb + d * 128; const int sx = (d >> 1) & 7;
#pragma unroll
                  for (int c2 = 0; c2 < 4; ++c2) Vf[db * 4 + c2] = *(const LAS bf16x8*)(vr + (((c2 * 2 + hh) ^ sx) << 4)); }
#pragma unroll
              for (int db = 0; db < 4; ++db)
#pragma unroll
                  for (int c2 = 0; c2 < 4; ++c2) O[db] = MFMA32(Vf[db * 4 + c2], Pf[c2], O[db]);
              __builtin_amdgcn_sched_group_barrier(0x100, 4, 0);
#pragma unroll
              for (int i = 0; i < 6; ++i) { __builtin_amdgcn_sched_group_barrier(0x008, 2, 0); __builtin_amdgcn_sched_group_barrier(0x100, 2, 0); }
              __builtin_amdgcn_sched_group_barrier(0x008, 4, 0); }
            att_store(F.lds, buf ^ 1, tid, st);
            __syncthreads();
        }
        float lt; { const auto rr = __builtin_amdgcn_permlane32_swap(__float_as_uint(l_run), __float_as_uint(l_run), false, false); lt = __uint_as_float(rr[0]) + __uint_as_float(rr[1]); }
        const float inv = 1.f / lt;
        bf16* orow = OLAT + (size_t)(t0 + q) * 1024 + head * 128 + 4 * hh;
#pragma unroll
        for (int db = 0; db < 4; ++db)
#pragma unroll
            for (int g = 0; g < 4; ++g) { const unsigned lo = pkbf(O[db][4 * g] * inv, O[db][4 * g + 1] * inv), hi = pkbf(O[db][4 * g + 2] * inv, O[db][4 * g + 3] * inv);
                *(GAS unsigned long long*)(orow + db * 32 + 8 * g) = (unsigned long long)lo | ((unsigned long long)hi << 32); }
    }
}
struct Args { const float* in[23]; float* out; unsigned char* ws; int ph_lo, ph_hi; };
__global__ void __launch_bounds__(NWAVES * 64, 2) mk_fwd(Args args) {
    extern __shared__ __attribute__((aligned(16))) unsigned char lds[];
    Frame F;
    F.lds = (LAS unsigned char*)lds;
    F.MISCW = (volatile LAS unsigned*)(F.lds + MISC_OFF);
    F.tid = threadIdx.x; F.lane = F.tid & 63; F.wave = __builtin_amdgcn_readfirstlane(F.tid >> 6);
    F.G = gridDim.x; { const int bx = blockIdx.x; F.vcu = (F.G % 8 == 0) ? (bx % 8) * (F.G / 8) + bx / 8 : bx; }
    F.ws = args.ws; F.ctl = (gu32*)(args.ws + WS_CTL); F.out = args.out;
    for (int u = F.tid; u < (LDS_BYTES - LDSCTL_OFF) / 4; u += NWAVES * 64) ((LAS unsigned*)(F.lds + LDSCTL_OFF))[u] = 0u;
    __syncthreads();
    const int lo = args.ph_lo, hi = args.ph_hi;
#define IN(k) (lo <= (k) && (k) < hi)
#define REID() do { int l_; asm volatile("v_mbcnt_lo_u32_b32 %0, -1, 0\n\tv_mbcnt_hi_u32_b32 %0, -1, %0" : "=v"(l_)); F.lane = l_; F.tid = F.wave * 64 + l_; } while (0)
#define SEAM(k) do { if (IN(k) && IN((k) + 1)) { REID(); xcd_barrier(bar, F.wave == 0 && F.lane == 0); } } while (0)
#ifndef PROBE_MASK
#define PROBE_MASK 0
#endif
#define PHASE(k, BODY) do { if (IN(k)) { if ((PROBE_MASK >> (k)) & 1) { REID(); BODY; REID(); xcd_barrier(bar, F.wave == 0 && F.lane == 0); } REID(); BODY; } SEAM(k); } while (0)
#define BODY0 { p0_prologue(F); }
#define BODY1 { p1_modulate(F); }
#define BODY2 { pg8::Gemm g{(const pg8::bf16_t*)(F.ws + WS_H), (const pg8::bf16_t*)(F.ws + WS_WIN), T, NIN, D}; pg8::StaticOrder S; S.init(T, NIN, F.G, (int)blockIdx.x); \
        pg8::EpiInProj E{(pg8::bf16_t*)(F.ws + WS_QL), (pg8::bf16_t*)(F.ws + WS_QI), (pg8::bf16_t*)(F.ws + WS_U), (pg8::bf16_t*)(F.ws + WS_SG), (float*)(F.ws + WS_MISC), (pg8::bf16_t*)(F.ws + WS_KI)}; \
        pg8::gemm_phase<pg8::EpiInProj, pg8::StaticOrder, PG8_ALIGN, PG8_SP2>(F.lds + RING_OFF, g, S, E, F.wave); }
#define BODY3 { p3_post(F); __syncthreads(); p3_select<0>(F); }
#ifndef SELVAR
#define SELVAR 0
#endif
#ifdef PROBE_POST
#define BODY3V { p3_post(F); }
#else
#define BODY3V { p3_select<SELVAR>(F); }
#endif
#define BODY4 { p4_attention(F); }
#define BODY5 { { pg8::Gemm g{(const pg8::bf16_t*)(F.ws + WS_OLAT), (const pg8::bf16_t*)(F.ws + WS_WOA), T, D, 1024}; pg8::StaticOrder S; S.init(T, D, F.G, (int)blockIdx.x); \
          pg8::EpiGateMul E{(pg8::bf16_t*)(F.ws + WS_TMP), (const pg8::bf16_t*)(F.ws + WS_SG), 0, 0}; \
          pg8::gemm_phase<pg8::EpiGateMul, pg8::StaticOrder, PG8_ALIGN, PG8_SP2>(F.lds + RING_OFF, g, S, E, F.wave); } \
        { pg8::Gemm g{(const pg8::bf16_t*)(F.ws + WS_POOLED), (const pg8::bf16_t*)(F.ws + WS_WPB), T, D, 512}; pg8::StaticOrder S; S.init(T, D, F.G, (int)blockIdx.x); \
          pg8::EpiGateAdd E{(pg8::bf16_t*)(F.ws + WS_MIX), (const pg8::bf16_t*)(F.ws + WS_TMP), (const pg8::bf16_t*)(F.ws + WS_SG), 1024, 0}; \
          pg8::gemm_phase<pg8::EpiGateAdd, pg8::StaticOrder, PG8_ALIGN, PG8_SP2>(F.lds + RING_OFF, g, S, E, F.wave); } }
#define BODY6 { pg8::Gemm g{(const pg8::bf16_t*)(F.ws + WS_MIX), (const pg8::bf16_t*)(F.ws + WS_WOUT), T, D, 1024}; pg8::StaticOrder S; S.init(T, D, F.G, (int)blockIdx.x); \
        pg8::EpiResid E{(float*)(F.ws + WS_Z), frame_in(0), (const float*)(F.ws + WS_MOD) + 2 * 1024}; \
        pg8::gemm_phase<pg8::EpiResid, pg8::StaticOrder, PG8_ALIGN, PG8_SP2>(F.lds + RING_OFF, g, S, E, F.wave); }
#define BODY7 { p7_ln1_route(F, CW_GCNT); }
#define BODY7DRY { p7_ln1_route(F, 128); }
#define BODY9 { load_tstart(F); \
        pg8::MoeOrderG S{(const LAS int*)(F.lds + LC_TSTART), 8, F.G, (int)blockIdx.x, (const LAS int*)(F.lds + LC_ROWTAB), (const int*)(F.ws + WS_SLOTMAP), (const int*)(F.ctl + CW_GCNT)}; \
        moe_fill_rowtab(F, S); \
        pg8::Gemm g{(const pg8::bf16_t*)(F.ws + WS_H), (const pg8::bf16_t*)(F.ws + WS_WGU), T, 32 * 2048, 1024}; \
        pg8::EpiSwiglu E{(pg8::bf16_t*)(F.ws + WS_ACT), frame_in(18)}; \
        pg8::gemm_phase<pg8::EpiSwiglu, pg8::MoeOrderG, PG8_ALIGN, PG8_SP2>(F.lds + RING_OFF, g, S, E, F.wave); }
#define BODY10 { load_tstart(F); \
        pg8::Gemm g{(const pg8::bf16_t*)(F.ws + WS_ACT), (const pg8::bf16_t*)(F.ws + WS_WD), MAXROWS, 32 * 1024, 1024}; \
        pg8::MoeOrder S{(const LAS int*)(F.lds + LC_TSTART), 4, F.G, (int)blockIdx.x, nullptr, nullptr, nullptr}; \
        pg8::EpiDown E{(pg8::bf16_t*)(F.ws + WS_Y), frame_in(20)}; \
        pg8::gemm_phase<pg8::EpiDown, pg8::MoeOrder, PG8_ALIGN, PG8_SP2>(F.lds + RING_OFF, g, S, E, F.wave); }
#define BODY11 { p11_final(F); }
    XcdBarrier bar; bar.bar = (unsigned*)(F.ctl + CW_BAR); bar.x = 0; bar.st = nullptr;
    if (hi - lo > 1) bar = xcd_barrier_post((unsigned*)(F.ctl + CW_BAR), F.MISCW + 8, F.tid == 0);
    PHASE(0, BODY0); PHASE(1, BODY1); PHASE(2, BODY2);
    if (IN(3)) { if ((PROBE_MASK >> 3) & 1) { REID(); BODY3V; REID(); xcd_barrier(bar, F.wave == 0 && F.lane == 0); } REID(); BODY3; } SEAM(3);
    PHASE(4, BODY4); PHASE(5, BODY5);
    PHASE(6, BODY6);
    if (IN(7)) { if ((PROBE_MASK >> 7) & 1) { REID(); BODY7DRY; REID(); xcd_barrier(bar, F.wave == 0 && F.lane == 0); } REID(); BODY7; } SEAM(7);
    PHASE(9, BODY9); PHASE(10, BODY10);
    if (IN(11)) { if ((PROBE_MASK >> 11) & 1) { REID(); BODY11; REID(); xcd_barrier(bar, F.wave == 0 && F.lane == 0); } REID(); BODY11; }
#undef IN
#undef SEAM
}

static void launch_mk(const Args& a0, int lo, int hi, int grid, hipStream_t stream) {
    Args a = a0; a.ph_lo = lo; a.ph_hi = hi;
    hipLaunchKernelGGL(mk_fwd, dim3(grid), dim3(NWAVES * 64), LDS_BYTES, stream, a);
}
extern "C" void kernel_launch(void* const* d_in, const int* in_sizes, int n_in, void* d_out, int out_size, void* d_ws, size_t ws_size, hipStream_t stream) {
    static int grid = 0;
    if (grid == 0) {
        if (n_in != 23 || ws_size < WS_END) { fprintf(stderr, "kernel_launch: unexpected n_in %d / ws %zu\n", n_in, ws_size); grid = -1; return; }
        int dev = 0, cus = 0;
        if (hipGetDevice(&dev) != hipSuccess || hipDeviceGetAttribute(&cus, hipDeviceAttributeMultiprocessorCount, dev) != hipSuccess) { grid = -1; return; }
        if (hipFuncSetAttribute((const void*)mk_fwd, hipFuncAttributeMaxDynamicSharedMemorySize, LDS_BYTES) != hipSuccess) { fprintf(stderr, "hipFuncSetAttribute failed\n"); grid = -1; return; }
        grid = cus;
        if (grid != 256) { fprintf(stderr, "kernel_launch: built for 256 CUs, found %d\n", cus); grid = -1; return; }
    }
    if (grid < 0) return;
    unsigned char* ws = (unsigned char*)d_ws;
    (void)hipMemsetAsync(ws + WS_CTL, 0, CTL_ZERO_BYTES, stream);
    Args a{};
    for (int i = 0; i < 23; ++i) a.in[i] = (const float*)d_in[i];
    a.out = (float*)d_out; a.ws = ws;
    launch_mk(a, 0, 12, grid, stream);
}
```

```cpp
#include <hip/hip_runtime.h>
#include <cstdio>
#include <cstdint>
namespace pg8 {
#define PG8_LAS __attribute__((address_space(3)))
typedef unsigned short bf16_t;
typedef short bf16x8 __attribute__((ext_vector_type(8)));
typedef float f32x4 __attribute__((ext_vector_type(4)));
typedef unsigned u32x4 __attribute__((ext_vector_type(4)));
constexpr int BM = 256, BK = 64, HALF = 128, HTB = HALF * BK * 2  , STAGE_BYTES = 8 * HTB, NXCD = 8, WGM = 8;

__host__ __device__ __forceinline__ int lds_byte(int r, int c) { const int st = (r >> 4) * 2 + (c >> 5), rr = r & 15, cc = c & 31, ob = rr * 64 + cc * 2; return st * 1024 + (ob ^ (((ob >> 9) & 1) << 5)); }
__host__ __device__ __forceinline__ void stage_rc(int b, int& R, int& C) { const int st = b / 1024, sb = b % 1024, swz = sb ^ (((sb >> 9) & 1) << 5); R = (st >> 1) * 16 + swz / 64; C = (st & 1) * 32 + (swz % 64) / 2; }
__host__ __device__ __forceinline__ int perm32(int rho) { const int n = rho >> 4, i = rho & 15; return 8 * (i >> 2) + 4 * n + (i & 3); }

struct Unit { int pm, pn; };
struct Gemm { const bf16_t* A; const bf16_t* Bt; int M, N, K; };

struct StaticOrder {
    static constexpr bool GATHER = false;
    int nM, nN, nwg, G, c;
    __host__ __device__ void init(int M, int N, int G_, int c_) { nM = M / BM; nN = N / BM; nwg = nM * nN; G = G_; c = c_; }
    __host__ __device__ bool next(int i, Unit& u) const {
        const long L = (long)i * G + c; if (L >= nwg) return false;
        int wgid = (int)L; { const int q = nwg / NXCD, r = nwg % NXCD, xcd = wgid % NXCD, off = wgid / NXCD; wgid = (xcd < r ? xcd * (q + 1) : r * (q + 1) + (xcd - r) * q) + off; }
        const int nig = WGM * nN, gid = wgid / nig, fm = gid * WGM, gsz = (nM - fm) < WGM ? (nM - fm) : WGM;
        u.pm = fm + ((wgid % nig) % gsz); u.pn = (wgid % nig) / gsz; return true;
    }
    __device__ __forceinline__ void a_ready(const Unit&) const {}
    __device__ __forceinline__ void done(const Unit&) const {}
};

__device__ __forceinline__ unsigned cvt_pk_bf16(float lo, float hi) { unsigned r; asm volatile("v_cvt_pk_bf16_f32 %0, %1, %2" : "=v"(r) : "v"(lo), "v"(hi)); return r; }
typedef float f32x2 __attribute__((ext_vector_type(2)));
__device__ __forceinline__ f32x2 gelu_pk(f32x2 v) {
    const f32x2 av = __builtin_elementwise_abs(v), d = av * 0.2316418882f + 1.0f;
    f32x2 t; t.x = __builtin_amdgcn_rcpf(d.x); t.y = __builtin_amdgcn_rcpf(d.y);
    f32x2 q = t * 0.5307027145f + (-0.7265760135f); q = q * t + 0.7107068705f; q = q * t + (-0.142248368f); q = q * t + 0.127414796f; q = q * t;
    const f32x2 s = (v * v) * (-0.72134752044f);
    f32x2 e; e.x = __builtin_amdgcn_exp2f(s.x); e.y = __builtin_amdgcn_exp2f(s.y);
    const f32x2 m = v * (q * e), r = v - m;
    f32x2 o; o.x = v.x < 0.f ? m.x : r.x; o.y = v.y < 0.f ? m.y : r.y; return o;
}

template <int ACT  > struct EpiBf16 {
    static constexpr bool PERM = true, AFTER_DRAIN = false; static_assert(ACT == 0 || ACT == 1, "EpiBf16: ACT is 0 (none) or 1 (gelu_pk)");
    bf16_t* O; int ldc; const float* bias; int split_cols; size_t split_stride; float scale0;
    __device__ __forceinline__ void operator()(const f32x4 (&acc)[2][2][4][2], const Unit& u, int wr, int wc, int fr, int fq) const {
        const int row0 = u.pm * BM + wr * 64 + fr; int colt = u.pn * BM; bf16_t* base = O;
        float sc = 1.f; if (split_cols) { const int t = colt / split_cols; base += (size_t)t * split_stride; colt -= t * split_cols; if (t == 0) sc = scale0; }
        const int col0 = colt + wc * 32 + 8 * fq, bcol0 = u.pn * BM + wc * 32 + 8 * fq;
        f32x4 bv[2][2];
#pragma unroll
        for (int bj = 0; bj < 2; ++bj)
#pragma unroll
            for (int n = 0; n < 2; ++n) bv[bj][n] = bias ? *(const f32x4*)(bias + bcol0 + bj * HALF + 4 * n) : (f32x4){0.f, 0.f, 0.f, 0.f};
#pragma unroll
        for (int ai = 0; ai < 2; ++ai)
#pragma unroll
            for (int m = 0; m < 4; ++m) { bf16_t* rowp = base + (size_t)(row0 + ai * HALF + m * 16) * ldc + col0;
#pragma unroll
                for (int bj = 0; bj < 2; ++bj) { f32x4 v0 = acc[ai][bj][m][0] + bv[bj][0], v1 = acc[ai][bj][m][1] + bv[bj][1];
                    if (ACT == 1) { f32x2 a = gelu_pk((f32x2){v0[0], v0[1]}), b = gelu_pk((f32x2){v0[2], v0[3]}), c = gelu_pk((f32x2){v1[0], v1[1]}), d = gelu_pk((f32x2){v1[2], v1[3]});
                        v0 = (f32x4){a.x, a.y, b.x, b.y}; v1 = (f32x4){c.x, c.y, d.x, d.y}; }
                    v0 = v0 * sc; v1 = v1 * sc; u32x4 w; w.x = cvt_pk_bf16(v0[0], v0[1]); w.y = cvt_pk_bf16(v0[2], v0[3]); w.z = cvt_pk_bf16(v1[0], v1[1]); w.w = cvt_pk_bf16(v1[2], v1[3]);
                    *(u32x4*)(rowp + bj * HALF) = w; } }
    }
};

struct PanelStats {
    unsigned* xbuf;
    unsigned* cnt;
    unsigned* tmo;
    int ntn; float eps;
    unsigned code;
    __device__ __forceinline__ bool run(const f32x4 (&v)[2][2][4][2], const Unit& u, int wr, int wc, int fr, int fq, PG8_LAS unsigned char* lds, int wid, int lane) const {
        typedef float f32x2v __attribute__((ext_vector_type(2)));
        PG8_LAS f32x2v* P = (PG8_LAS f32x2v*)lds;
        PG8_LAS f32x2v* S = (PG8_LAS f32x2v*)(lds + 8192);
        PG8_LAS unsigned* flag = (PG8_LAS unsigned*)(lds + 8192 + 2048);
#pragma unroll
        for (int ai = 0; ai < 2; ++ai)
#pragma unroll
            for (int m = 0; m < 4; ++m) {
                float s = 0.f;
#pragma unroll
                for (int bj = 0; bj < 2; ++bj)
#pragma unroll
                    for (int n = 0; n < 2; ++n) { const f32x4 x = v[ai][bj][m][n]; s += (x[0] + x[1]) + (x[2] + x[3]); }
                s += __shfl_xor(s, 16); s += __shfl_xor(s, 32);
                const float mw = s * (1.0f / 64.0f); float q = 0.f;
#pragma unroll
                for (int bj = 0; bj < 2; ++bj)
#pragma unroll
                    for (int n = 0; n < 2; ++n) { const f32x4 d = v[ai][bj][m][n] - mw; q += (d[0] * d[0] + d[1] * d[1]) + (d[2] * d[2] + d[3] * d[3]); }
                q += __shfl_xor(q, 16); q += __shfl_xor(q, 32);
                if (fq == 0) P[(ai * HALF + wr * 64 + m * 16 + fr) * 4 + wc] = (f32x2v){mw, q};
            }
        asm volatile("s_waitcnt lgkmcnt(0)" ::: "memory"); __builtin_amdgcn_s_barrier(); asm volatile("" ::: "memory");
#if defined(BROKEN_EXCHANGE_NO_WAIT)
#warning BROKEN CONTROL BUILD: the row-statistics exchange does not wait; results are wrong by design
        if (blockIdx.x >= 64) { const long long t0_ = clock64(); while (clock64() - t0_ < 60000) __builtin_amdgcn_s_sleep(8); }
#endif
        const int row = wid * 32 + (lane & 31);
        if (lane < 32) {
            const f32x2v a = P[row * 4 + 0], b = P[row * 4 + 1], c = P[row * 4 + 2], d = P[row * 4 + 3];
            const float mt = (a.x + b.x + c.x + d.x) * 0.25f;
            const float da = a.x - mt, db = b.x - mt, dc = c.x - mt, dd = d.x - mt;
            const float m2 = (a.y + b.y) + (c.y + d.y) + 64.0f * ((da * da + db * db) + (dc * dc + dd * dd));
            unsigned long long* slot = (unsigned long long*)xbuf + ((size_t)(u.pm * BM + row) * 4 + u.pn);
            __hip_atomic_store(slot, ((unsigned long long)__float_as_uint(m2) << 32) | __float_as_uint(mt), __ATOMIC_RELAXED, __HIP_MEMORY_SCOPE_AGENT);
        }
        asm volatile("s_waitcnt vmcnt(0)" ::: "memory");
        if (lane == 0) __hip_atomic_fetch_add(cnt + 64 * u.pm, 1u, __ATOMIC_RELAXED, __HIP_MEMORY_SCOPE_AGENT);
        if (wid == 0) {
            bool dead = false; const unsigned long long t0 = __builtin_amdgcn_s_memrealtime(); const unsigned want = 8u * (unsigned)ntn;
            for (;;) {
#if defined(BROKEN_EXCHANGE_NO_WAIT)
                break;
#endif
                if ((unsigned)__builtin_amdgcn_readfirstlane(__hip_atomic_load(cnt + 64 * u.pm, __ATOMIC_RELAXED, __HIP_MEMORY_SCOPE_AGENT)) >= want) break;
                if (__builtin_amdgcn_s_memrealtime() - t0 > 2000000ull) {
                    if (lane == 0) { unsigned expect = 0u; __hip_atomic_compare_exchange_strong(tmo + 1, &expect, code | (unsigned)(u.pm & 0xff), __ATOMIC_RELAXED, __ATOMIC_RELAXED, __HIP_MEMORY_SCOPE_AGENT);
                                     __hip_atomic_store(tmo, 1u, __ATOMIC_RELAXED, __HIP_MEMORY_SCOPE_AGENT); }
                    dead = true; break; }
                __builtin_amdgcn_s_sleep(2);
            }
            __builtin_amdgcn_fence(__ATOMIC_ACQUIRE, "agent");
            if (lane == 0) flag[0] = dead ? 1u : 0u;
        }
        asm volatile("s_waitcnt vmcnt(0) lgkmcnt(0)" ::: "memory"); __builtin_amdgcn_s_barrier(); asm volatile("" ::: "memory");
        const bool bad = flag[0] != 0u;
        if (lane < 32) {
            const unsigned long long* slot = (const unsigned long long*)xbuf + (size_t)(u.pm * BM + row) * 4; float mt[4], m2[4]; float ms = 0.f;
#pragma unroll
            for (int t = 0; t < 4; ++t) { if (t < ntn) { const unsigned long long w = __hip_atomic_load(slot + t, __ATOMIC_RELAXED, __HIP_MEMORY_SCOPE_AGENT); mt[t] = __uint_as_float((unsigned)w); m2[t] = __uint_as_float((unsigned)(w >> 32)); } else { mt[t] = 0.f; m2[t] = 0.f; } ms += mt[t]; }
            const float mean = ms / (float)ntn; float q = 0.f;
#pragma unroll
            for (int t = 0; t < 4; ++t) if (t < ntn) { const float dm = mt[t] - mean; q += m2[t] + 256.0f * dm * dm; }
            S[row] = (f32x2v){mean, 1.0f / sqrtf(q / (256.0f * (float)ntn) + eps)};
        }
        asm volatile("s_waitcnt lgkmcnt(0)" ::: "memory"); __builtin_amdgcn_s_barrier(); asm volatile("" ::: "memory");
        return bad;
    }
};
struct EpiLnRes {
    static constexpr bool PERM = false, AFTER_DRAIN = true;
    const float* base; float* out; int ldc; const float* bias; PanelStats st; unsigned poison;
    __device__ __forceinline__ void fused(f32x4 (&acc)[2][2][4][2], const Unit& u, int wr, int wc, int fr, int fq, PG8_LAS unsigned char* lds, int wid, int lane) const {
        typedef float f32x2v __attribute__((ext_vector_type(2)));
        const PG8_LAS f32x2v* S = (const PG8_LAS f32x2v*)(lds + 8192);
        const int col0 = u.pn * BM + wc * 32 + 4 * fq;
#pragma unroll
        for (int bj = 0; bj < 2; ++bj)
#pragma unroll
            for (int n = 0; n < 2; ++n) { const f32x4 bv = bias ? *(const f32x4*)(bias + col0 + bj * HALF + n * 16) : (f32x4){0.f, 0.f, 0.f, 0.f};
#pragma unroll
                for (int ai = 0; ai < 2; ++ai)
#pragma unroll
                    for (int m = 0; m < 4; ++m) acc[ai][bj][m][n] += bv; }
        f32x4 pre[4][2][2];
#pragma unroll
        for (int m = 0; m < 4; ++m) { const size_t off = (size_t)(u.pm * BM + wr * 64 + m * 16 + fr) * ldc + col0;
#pragma unroll
            for (int bj = 0; bj < 2; ++bj)
#pragma unroll
                for (int n = 0; n < 2; ++n) pre[m][bj][n] = *(const f32x4*)(base + off + bj * HALF + n * 16); }
        const bool bad = st.run(acc, u, wr, wc, fr, fq, lds, wid, lane) || poison != 0u;
        const float qnan = __builtin_nanf("");
#pragma unroll
        for (int ai = 0; ai < 2; ++ai)
#pragma unroll
            for (int m = 0; m < 4; ++m) { const int r = ai * HALF + wr * 64 + m * 16 + fr; const f32x2v sr = S[r]; const size_t off = (size_t)(u.pm * BM + r) * ldc + col0;
#pragma unroll
                for (int bj = 0; bj < 2; ++bj)
#pragma unroll
                    for (int n = 0; n < 2; ++n) { const f32x4 bs = ai == 0 ? pre[m][bj][n] : *(const f32x4*)(base + off + bj * HALF + n * 16); f32x4 o = bs + (acc[ai][bj][m][n] - sr.x) * sr.y;
                        if (bad) o = (f32x4){qnan, qnan, qnan, qnan}; *(f32x4*)(out + off + bj * HALF + n * 16) = o; }
                if (m & 1) asm volatile("" ::: "memory"); }
    }
};
struct EpiLnResLn {
    static constexpr bool PERM = false, AFTER_DRAIN = true;
    const float* base; float* out; bf16_t* xn; int ldc; const float* bias; PanelStats st1, st2; unsigned poison;
    __device__ __forceinline__ void fused(f32x4 (&acc)[2][2][4][2], const Unit& u, int wr, int wc, int fr, int fq, PG8_LAS unsigned char* lds, int wid, int lane) const {
        typedef float f32x2v __attribute__((ext_vector_type(2))); typedef unsigned u32x2v __attribute__((ext_vector_type(2)));
        const PG8_LAS f32x2v* S = (const PG8_LAS f32x2v*)(lds + 8192);
        const int col0 = u.pn * BM + wc * 32 + 4 * fq;
#pragma unroll
        for (int bj = 0; bj < 2; ++bj)
#pragma unroll
            for (int n = 0; n < 2; ++n) { const f32x4 bv = bias ? *(const f32x4*)(bias + col0 + bj * HALF + n * 16) : (f32x4){0.f, 0.f, 0.f, 0.f};
#pragma unroll
                for (int ai = 0; ai < 2; ++ai)
#pragma unroll
                    for (int m = 0; m < 4; ++m) acc[ai][bj][m][n] += bv; }
        bool bad = st1.run(acc, u, wr, wc, fr, fq, lds, wid, lane) || poison != 0u;
        const float qnan = __builtin_nanf("");
#pragma unroll
        for (int ai = 0; ai < 2; ++ai)
#pragma unroll
            for (int m = 0; m < 4; ++m) { const int r = ai * HALF + wr * 64 + m * 16 + fr; const f32x2v sr = S[r]; const size_t off = (size_t)(u.pm * BM + r) * ldc + col0;
#pragma unroll
                for (int bj = 0; bj < 2; ++bj)
#pragma unroll
                    for (int n = 0; n < 2; ++n) { const f32x4 bs = *(const f32x4*)(base + off + bj * HALF + n * 16); acc[ai][bj][m][n] = bs + (acc[ai][bj][m][n] - sr.x) * sr.y; }
                asm volatile("" : "+v"(acc[ai][0][m][0]), "+v"(acc[ai][0][m][1]), "+v"(acc[ai][1][m][0]), "+v"(acc[ai][1][m][1]));
                if (m & 1) asm volatile("" ::: "memory"); }
        const bool bad1 = bad;
        bad = st2.run(acc, u, wr, wc, fr, fq, lds, wid, lane) || bad;
#pragma unroll
        for (int ai = 0; ai < 2; ++ai)
#pragma unroll
            for (int m = 0; m < 4; ++m) { const int r = ai * HALF + wr * 64 + m * 16 + fr; const f32x2v sr = S[r]; const size_t off = (size_t)(u.pm * BM + r) * ldc + col0;
#pragma unroll
                for (int bj = 0; bj < 2; ++bj)
#pragma unroll
                    for (int n = 0; n < 2; ++n) { const f32x4 x1 = acc[ai][bj][m][n]; *(f32x4*)(out + off + bj * HALF + n * 16) = bad1 ? (f32x4){qnan, qnan, qnan, qnan} : x1;
                        const f32x4 o = (x1 - sr.x) * sr.y; u32x2v w; w.x = cvt_pk_bf16(o[0], o[1]); w.y = cvt_pk_bf16(o[2], o[3]);
                        if (bad) { w.x = 0x7fc07fc0u; w.y = 0x7fc07fc0u; } *(u32x2v*)(xn + off + bj * HALF + n * 16) = w; }
                asm volatile("" ::: "memory"); }
    }
};

template <class Epi, class Sched, bool ALIGN_EPI = false, bool SP2 = false>
__device__ __forceinline__ void gemm_phase(PG8_LAS unsigned char* lds, const Gemm g, const Sched& S, const Epi& E, const int wave_id  ) {
    int tid; { int l_; asm volatile("v_mbcnt_lo_u32_b32 %0, -1, 0\n\tv_mbcnt_hi_u32_b32 %0, -1, %0" : "=v"(l_)); tid = wave_id * 64 + l_; }
    const int wid = wave_id, lane = tid & 63, wr = wid >> 2, wc = wid & 3, fr = lane & 15, fq = lane >> 4;
    const int K = g.K, nt = K / BK;
    constexpr bool GA = Sched::GATHER;
    static_assert(!GA || SP2, "row gather is wired into the SP2 loop only");
    unsigned voffA[2], voffB[2]; int RA[2], CA[2];
#pragma unroll
    for (int i = 0; i < 2; ++i) { int R, C; stage_rc(tid * 16 + i * 8192, R, C); const int Rb = Epi::PERM ? ((R & ~31) + perm32(R & 31)) : R; RA[i] = R; CA[i] = C;
        voffA[i] = (unsigned)(R * K + C) * 2u; voffB[i] = (unsigned)(Rb * K + C) * 2u; }
    unsigned goc[2][2], gon[2][2]; const char* const gA = (const char*)g.A;
#define PG8_GO(dst, slot, u) do { _Pragma("unroll") for (int _h = 0; _h < 2; ++_h) _Pragma("unroll") for (int _i = 0; _i < 2; ++_i) \
        dst[_h][_i] = (unsigned)S.arow(slot, u, _h * HALF + RA[_i]) * (unsigned)(K * 2) + (unsigned)(CA[_i] * 2); } while (0)
#define PG8_STAGE_A(bufoff, gbase_plain, kb, h, useN) do { if constexpr (GA) { _Pragma("unroll") for (int _i = 0; _i < 2; ++_i) { const unsigned _o = (useN) ? gon[h][_i] : goc[h][_i]; \
        __builtin_amdgcn_global_load_lds((const unsigned*)(gA + (kb) + _o), (PG8_LAS unsigned*)(lds + (bufoff) + ldsw + _i * 8192), 16, 0, 0); } } else { PG8_STAGE(bufoff, gbase_plain, voffA); } } while (0)
    const size_t kstep = (size_t)(BK * 2);
    const size_t hstep = (size_t)HALF * K * 2;
    const size_t tstep = 2 * hstep;
    const unsigned ldsw = (unsigned)wid * 1024u;
    const int aoff = lds_byte(wr * 64 + fr, fq * 8), boff = lds_byte(wc * 32 + fr, fq * 8);
#define PG8_SA(b, h) (((b) * 2 + (h)) * HTB)
#define PG8_SB(b, h) ((4 + (b) * 2 + (h)) * HTB)
#define PG8_STAGE(bufoff, gbase, voff) do { _Pragma("unroll") for (int _i = 0; _i < 2; ++_i) \
        __builtin_amdgcn_global_load_lds((const unsigned*)((const char*)(gbase) + (voff)[_i]), (PG8_LAS unsigned*)(lds + (bufoff) + ldsw + _i * 8192), 16, 0, 0); } while (0)
#define PG8_LDA(dst, b, h) do { _Pragma("unroll") for (int m = 0; m < 4; ++m) _Pragma("unroll") for (int k = 0; k < 2; ++k) dst[m][k] = *(const PG8_LAS bf16x8*)(lds + PG8_SA(b, h) + aoff + m * 2048 + k * 1024); } while (0)
#define PG8_LDB(dst, b, h) do { _Pragma("unroll") for (int n = 0; n < 2; ++n) _Pragma("unroll") for (int k = 0; k < 2; ++k) dst[n][k] = *(const PG8_LAS bf16x8*)(lds + PG8_SB(b, h) + boff + n * 2048 + k * 1024); } while (0)
#define PG8_MMA(ai, bj, At, Bt) do { __builtin_amdgcn_s_setprio(1); _Pragma("unroll") for (int m = 0; m < 4; ++m) _Pragma("unroll") for (int n = 0; n < 2; ++n) _Pragma("unroll") for (int k = 0; k < 2; ++k) \
        acc[ai][bj][m][n] = __builtin_amdgcn_mfma_f32_16x16x32_bf16(Bt[n][k], At[m][k], acc[ai][bj][m][n], 0, 0, 0); __builtin_amdgcn_s_setprio(0); } while (0)
#define PG8_WAIT_V(n) asm volatile("s_waitcnt vmcnt(" #n ")" ::: "memory")
#define PG8_WAIT_L(n) asm volatile("s_waitcnt lgkmcnt(" #n ")" ::: "memory")
#define PG8_BAR __builtin_amdgcn_s_barrier()
#define PG8_SCHED __builtin_amdgcn_sched_barrier(0)
    Unit cur, nxt; int ui = 0;
    if (!S.next(0, cur)) return;
    f32x4 acc[2][2][4][2];
#pragma unroll
    for (int a = 0; a < 2; ++a)
#pragma unroll
        for (int b = 0; b < 2; ++b)
#pragma unroll
            for (int m = 0; m < 4; ++m)
#pragma unroll
                for (int n = 0; n < 2; ++n) acc[a][b][m][n] = (f32x4){0.f, 0.f, 0.f, 0.f};
    bf16x8 At[4][2], B0[2][2], B1[2][2];
#define PG8_ROT(u) (2 * (((u).pm + 3 * (u).pn) & 3))
#define PG8_KOFF(t, r) ((size_t)(((t) + (r)) & (nt - 1)) * kstep)
    int rc = SP2 ? PG8_ROT(cur) : 0, rn = rc;
    const char* cA = (const char*)g.A + (size_t)cur.pm * tstep; const char* cB = (const char*)g.Bt + (size_t)cur.pn * tstep;
    if constexpr (GA) { PG8_GO(goc, 0, cur); }
    S.a_ready(cur);
    if constexpr (SP2) {
        const size_t k0 = PG8_KOFF(0, rc);
        PG8_STAGE(PG8_SB(0, 0), cB + k0, voffB); PG8_STAGE(PG8_SB(0, 1), cB + k0 + hstep, voffB); PG8_STAGE_A(PG8_SA(0, 0), cA + k0, k0, 0, false); PG8_STAGE_A(PG8_SA(0, 1), cA + k0 + hstep, k0, 1, false);
        if (wr == 1) PG8_BAR;
        PG8_WAIT_V(2); PG8_BAR;
        PG8_STAGE(PG8_SB(1, 0), cB + k0 + kstep, voffB); PG8_STAGE_A(PG8_SA(1, 0), cA + k0 + kstep, k0 + kstep, 0, false); PG8_STAGE(PG8_SB(1, 1), cB + k0 + hstep + kstep, voffB);
        PG8_WAIT_V(6); PG8_BAR;
    } else {
        PG8_STAGE(PG8_SB(0, 0), cB, voffB); PG8_STAGE(PG8_SA(0, 0), cA, voffA); PG8_STAGE(PG8_SB(0, 1), cB + hstep, voffB); PG8_STAGE(PG8_SA(0, 1), cA + hstep, voffA);
        if (wr == 1) PG8_BAR;
        PG8_WAIT_V(4); PG8_BAR;
        PG8_STAGE(PG8_SB(1, 0), cB + kstep, voffB); PG8_STAGE(PG8_SA(1, 0), cA + kstep, voffA); PG8_STAGE(PG8_SB(1, 1), cB + hstep + kstep, voffB);
        PG8_WAIT_V(6); PG8_BAR;
    }
    for (;;) {
        const bool has_next = S.next(ui + 1, nxt);
        rn = (SP2 && has_next) ? PG8_ROT(nxt) : rc;
        unsigned tv = 0u;
        if (has_next) { const char* ta;
            if (tid < 128) ta = (const char*)g.Bt + (size_t)nxt.pn * tstep + (size_t)tid * 4096;
            else if constexpr (GA) ta = gA + (size_t)S.arow(ui + 1, nxt, (tid - 128) & 255) * (size_t)(K * 2);
            else ta = (const char*)g.A + (size_t)nxt.pm * tstep + (size_t)((tid - 128) & 127) * 4096;
            asm volatile("global_load_dword %0, %1, off" : "=v"(tv) : "v"(ta) : "memory"); }
        if constexpr (GA) { if (has_next) { PG8_GO(gon, ui + 1, nxt); } else { _Pragma("unroll") for (int _h = 0; _h < 2; ++_h) _Pragma("unroll") for (int _i = 0; _i < 2; ++_i) gon[_h][_i] = goc[_h][_i]; } }
        const char* nA = has_next ? (const char*)g.A + (size_t)nxt.pm * tstep : cA; const char* nB = has_next ? (const char*)g.Bt + (size_t)nxt.pn * tstep : cB;
        for (int t = 0; t < nt; t += 2) {
            const bool last = (t == nt - 2);
            const size_t kt0 = PG8_KOFF(t, rc), kt2 = last ? PG8_KOFF(0, rn) : PG8_KOFF(t + 2, rc);
            const char* a1 = cA + kt0 + kstep;
            const char* a2 = (last ? nA : cA) + kt2; const char* b2 = (last ? nB : cB) + kt2;
            const char* a3 = a2 + kstep; const char* b3 = b2 + kstep;
            const size_t k2 = kt2;
            if (last && has_next) S.a_ready(nxt);
            if constexpr (SP2) {
            PG8_LDB(B0, 0, 0); PG8_LDB(B1, 0, 1); PG8_SCHED; PG8_LDA(At, 0, 0); PG8_STAGE_A(PG8_SA(1, 1), a1 + hstep, kt0 + kstep, 1, false);
            PG8_WAIT_V(8); PG8_WAIT_L(0); PG8_BAR; PG8_MMA(0, 0, At, B0); PG8_MMA(0, 1, At, B1); PG8_BAR; PG8_SCHED;
            PG8_LDA(At, 0, 1); PG8_STAGE(PG8_SB(0, 0), b2, voffB); PG8_STAGE(PG8_SB(0, 1), b2 + hstep, voffB); PG8_STAGE_A(PG8_SA(0, 0), a2, k2, 0, last);
            PG8_WAIT_V(8); PG8_WAIT_L(0); PG8_BAR; PG8_MMA(1, 0, At, B0); PG8_MMA(1, 1, At, B1); PG8_BAR; PG8_SCHED;
            PG8_LDB(B0, 1, 0); PG8_LDB(B1, 1, 1); PG8_SCHED; PG8_LDA(At, 1, 0); PG8_STAGE_A(PG8_SA(0, 1), a2 + hstep, k2, 1, last);
            PG8_WAIT_V(8); PG8_WAIT_L(0); PG8_BAR; PG8_MMA(0, 0, At, B0); PG8_MMA(0, 1, At, B1); PG8_BAR; PG8_SCHED;
            PG8_LDA(At, 1, 1); PG8_STAGE(PG8_SB(1, 0), b3, voffB); PG8_STAGE(PG8_SB(1, 1), b3 + hstep, voffB); PG8_STAGE_A(PG8_SA(1, 0), a3, k2 + kstep, 0, last);
            PG8_WAIT_V(8); PG8_WAIT_L(0); PG8_BAR; PG8_MMA(1, 0, At, B0); PG8_MMA(1, 1, At, B1); PG8_BAR; PG8_SCHED;
            } else {
            PG8_LDB(B0, 0, 0); PG8_SCHED; PG8_LDA(At, 0, 0); PG8_STAGE(PG8_SA(1, 1), a1 + hstep, voffA);
            PG8_WAIT_L(8); PG8_BAR; PG8_WAIT_L(0); PG8_MMA(0, 0, At, B0); PG8_BAR; PG8_SCHED;
            PG8_LDB(B1, 0, 1); PG8_STAGE(PG8_SB(0, 0), b2, voffB);
            PG8_BAR; PG8_WAIT_L(0); PG8_MMA(0, 1, At, B1); PG8_BAR;
            PG8_LDA(At, 0, 1); PG8_STAGE(PG8_SA(0, 0), a2, voffA);
            PG8_BAR; PG8_WAIT_L(0); PG8_MMA(1, 0, At, B0); PG8_BAR; PG8_SCHED;
            PG8_STAGE(PG8_SB(0, 1), b2 + hstep, voffB);
            PG8_WAIT_V(6); PG8_BAR; PG8_MMA(1, 1, At, B1); PG8_BAR;
            PG8_LDB(B0, 1, 0); PG8_SCHED; PG8_LDA(At, 1, 0); PG8_STAGE(PG8_SA(0, 1), a2 + hstep, voffA);
            PG8_WAIT_L(8); PG8_BAR; PG8_WAIT_L(0); PG8_MMA(0, 0, At, B0); PG8_BAR; PG8_SCHED;
            PG8_LDB(B1, 1, 1); PG8_STAGE(PG8_SB(1, 0), b3, voffB);
            PG8_BAR; PG8_WAIT_L(0); PG8_MMA(0, 1, At, B1); PG8_BAR;
            PG8_LDA(At, 1, 1); PG8_STAGE(PG8_SA(1, 0), a3, voffA);
            PG8_BAR; PG8_WAIT_L(0); PG8_MMA(1, 0, At, B0); PG8_BAR; PG8_SCHED;
            PG8_STAGE(PG8_SB(1, 1), b3 + hstep, voffB);
            PG8_WAIT_V(6); PG8_BAR; PG8_MMA(1, 1, At, B1); PG8_BAR;
            }
        }
        if constexpr (ALIGN_EPI) { if (wr == 0) PG8_BAR; }
        if constexpr (!Epi::AFTER_DRAIN) { E(acc, cur, wr, wc, fr, fq); S.done(cur); }
        asm volatile("" : "+v"(tv));
        if (!has_next) break;
#pragma unroll
        for (int a = 0; a < 2; ++a)
#pragma unroll
            for (int b = 0; b < 2; ++b)
#pragma unroll
                for (int m = 0; m < 4; ++m)
#pragma unroll
                    for (int n = 0; n < 2; ++n) acc[a][b][m][n] = (f32x4){0.f, 0.f, 0.f, 0.f};
        cur = nxt; cA = nA; cB = nB; ++ui; rc = rn;
        if constexpr (GA) { _Pragma("unroll") for (int _h = 0; _h < 2; ++_h) _Pragma("unroll") for (int _i = 0; _i < 2; ++_i) goc[_h][_i] = gon[_h][_i]; }
        if constexpr (ALIGN_EPI) { if (wr == 1) PG8_BAR; }
    }
    PG8_WAIT_V(0);
    if constexpr (!ALIGN_EPI) { if (wr == 0) PG8_BAR; }
    PG8_BAR;
    if constexpr (Epi::AFTER_DRAIN) { E.fused(acc, cur, wr, wc, fr, fq, lds, wid, lane); S.done(cur); }
#undef PG8_SA
#undef PG8_SB
#undef PG8_STAGE
#undef PG8_ROT
#undef PG8_KOFF
#undef PG8_STAGE_A
#undef PG8_GO
#undef PG8_LDA
#undef PG8_LDB
#undef PG8_MMA
#undef PG8_WAIT_V
#undef PG8_WAIT_L
#undef PG8_BAR
#undef PG8_SCHED
}
}

#ifndef PG8_SP2
#define PG8_SP2 true
#endif
#ifndef PG8_ALIGN
#define PG8_ALIGN true
#endif
#define GAS __attribute__((address_space(1)))
#define LAS __attribute__((address_space(3)))
typedef unsigned short bf16;
typedef unsigned v4u __attribute__((ext_vector_type(4)));
typedef float f32x4 __attribute__((ext_vector_type(4)));
typedef short bf16x8 __attribute__((ext_vector_type(8)));
typedef GAS unsigned gu32;
typedef GAS unsigned long long gu64;
#define RLX_AGENT __ATOMIC_RELAXED, __HIP_MEMORY_SCOPE_AGENT
#define LDS_WAIT() asm volatile("s_waitcnt lgkmcnt(0)" ::: "memory")
#define VM_WAIT() asm volatile("s_waitcnt vmcnt(0)" ::: "memory")
__device__ __forceinline__ unsigned long long rt() { return __builtin_amdgcn_s_memrealtime(); }
__device__ __forceinline__ unsigned f2bf(float f) { unsigned u = __builtin_bit_cast(unsigned, f); return (u + 0x7fffu + ((u >> 16) & 1u)) >> 16; }
__device__ __forceinline__ unsigned pk2(float lo, float hi) { return f2bf(lo) | (f2bf(hi) << 16); }

#define XB_TMO      128
#define XB_XCNT(j)  (256  + 64 * (j))
#define XB_XSUB(j)  (1280 + 64 * (j))
#define XB_XGEN(j)  (2304 + 64 * (j))
#define XB_TOP      3328
#define XB_TOPGEN   3392
#define XCD_BAR_WORDS 3456
#define XB_SPIN_CAP (1u << 18)

__device__ __forceinline__ unsigned xb_ld(unsigned* p)              { return __hip_atomic_load(p, __ATOMIC_RELAXED, __HIP_MEMORY_SCOPE_AGENT); }
__device__ __forceinline__ unsigned xb_add(unsigned* p, unsigned v) { return __hip_atomic_fetch_add(p, v, __ATOMIC_RELAXED, __HIP_MEMORY_SCOPE_AGENT); }
__device__ __forceinline__ unsigned xb_xcc_id() { return (unsigned)__builtin_amdgcn_s_getreg((3 << 11) | 20) & 0xFu; }
#define XB_SPIN(cond, bar) do { unsigned _sp = 0; while (cond) { __builtin_amdgcn_s_sleep(1); \
    if ((++_sp & 255u) == 0u) { if (xb_ld(&(bar)[XB_TMO])) break; if (_sp > XB_SPIN_CAP) { atomicAdd(&(bar)[XB_TMO], 1u); break; } } } } while (0)

struct XcdBarrier {
    unsigned* bar; unsigned x;
    volatile LAS unsigned* st;
};

__device__ __forceinline__ XcdBarrier xcd_barrier_post(unsigned* bar, volatile LAS unsigned* st, bool leader) {
    XcdBarrier b; b.bar = bar; b.x = xb_xcc_id(); b.st = st;
    if (leader) (void)xb_add(&bar[XB_XCNT(b.x)], 1u);
    return b;
}
__device__ __forceinline__ void xcd_barrier_complete(unsigned* bar, unsigned x, unsigned& nloc, unsigned& nx) {
    const unsigned G = gridDim.x * gridDim.y * gridDim.z;
    unsigned sum, cnt, mine, sp = 0u;
    for (;;) {
        sum = 0u; cnt = 0u; mine = 0u;
#pragma unroll
        for (unsigned j = 0; j < 16; ++j) { const unsigned c = xb_ld(&bar[XB_XCNT(j)]); sum += c; cnt += (c > 0u) ? 1u : 0u; mine = (j == x) ? c : mine; }
        if (sum == G) break;
        __builtin_amdgcn_s_sleep(1);
        if ((++sp & 255u) == 0u) { if (xb_ld(&bar[XB_TMO])) break; if (sp > XB_SPIN_CAP) { atomicAdd(&bar[XB_TMO], 1u); break; } }
    }
    nloc = mine > 0u ? mine : 1u; nx = cnt > 0u ? cnt : 1u;
}

__device__ __forceinline__ void xcd_barrier(const XcdBarrier& b, bool leader) {
    asm volatile("s_waitcnt vmcnt(0)" ::: "memory");
    __syncthreads();
    if (leader) {
        unsigned* bar = b.bar;
        __builtin_amdgcn_s_waitcnt(0);
        unsigned nloc = b.st[0], nx = b.st[1];
        if (nloc == 0u) { xcd_barrier_complete(bar, b.x, nloc, nx); b.st[0] = nloc; b.st[1] = nx; }
        const unsigned old = xb_add(&bar[XB_XSUB(b.x)], 1u);
        const unsigned gen = old / nloc;
        if (old + 1u == (gen + 1u) * nloc) {
            __builtin_amdgcn_fence(__ATOMIC_RELEASE, "agent");
            asm volatile("s_waitcnt vmcnt(0)" ::: "memory");
            const unsigned og = xb_add(&bar[XB_TOP], 1u);
            const unsigned tg = og / nx;
            if (og + 1u == (tg + 1u) * nx) xb_add(&bar[XB_TOPGEN], 1u);
            else XB_SPIN(xb_ld(&bar[XB_TOPGEN]) == tg, bar);
            __builtin_amdgcn_fence(__ATOMIC_ACQUIRE, "agent");
            xb_add(&bar[XB_XGEN(b.x)], 1u);
            asm volatile("s_waitcnt vmcnt(0)" ::: "memory");
        } else {
            XB_SPIN(xb_ld(&bar[XB_XGEN(b.x)]) == gen, bar);
            __builtin_amdgcn_fence(__ATOMIC_ACQUIRE, "agent");
            asm volatile("s_waitcnt vmcnt(0)" ::: "memory");
        }
    }
    __syncthreads();
}
constexpr int NWAVES = 8;
constexpr int B_ = 8, S_ = 2048, T = B_ * S_, D = 1024;
constexpr int INC = 3784;
constexpr int O_Q = 0, O_CKV = 512, O_QI = 640, O_KI = 1152, O_WI = 1216, O_U = 1224, O_G = 1736;
constexpr int NIN = 4352;
constexpr float ALPHA = 1.189207115002721f, LN_EPS = 1e-5f, LOG2E = 1.4426950408889634f;
constexpr int MAXROWS = T * 4 + 32 * 256;
constexpr int TOPK = 256;

constexpr size_t MiB = 1u << 20;
constexpr size_t WS_CTL = 0, CTL_ZERO_BYTES = 1 * MiB;
constexpr size_t WS_MOD = 1 * MiB, WS_WIN = 2 * MiB, WS_WOA = 11 * MiB, WS_WPB = 13 * MiB, WS_WOUT = 14 * MiB, WS_WGU = 16 * MiB, WS_WD = 144 * MiB;
constexpr size_t WS_H = 208 * MiB, WS_QL = 240 * MiB, WS_QI = 272 * MiB, WS_MISC = 288 * MiB, WS_U = 304 * MiB, WS_SG = 320 * MiB;
constexpr size_t WS_CKV = 384 * MiB, WS_CKVT = 388 * MiB, WS_POOLED = 392 * MiB, WS_MASK = 408 * MiB, WS_OLAT = 412 * MiB, WS_TMP = 444 * MiB, WS_MIX = 476 * MiB;
constexpr size_t WS_Z = 508 * MiB, WS_X1 = 572 * MiB, WS_SLOTMAP = 636 * MiB, WS_TOKSLOT = 638 * MiB, WS_GATE = 638 * MiB + 512 * 1024;
constexpr size_t WS_XPAD = 640 * MiB, WS_ACT = 784 * MiB, WS_Y = WS_XPAD, WS_KI = 928 * MiB, WS_WRB = 930 * MiB, WS_END = 931 * MiB;
constexpr int CW_GCNT = 0, CW_TSTART = 64, CW_BAR = 4096;

constexpr int RING_OFF = 0, RING_BYTES = 131072;
constexpr int LDSCTL_OFF = RING_BYTES, MISC_OFF = LDSCTL_OFF + 320;
constexpr int LDS_BYTES = 163840;

struct Frame {
    LAS unsigned char* lds;
    volatile LAS unsigned* MISCW;
    gu32* ctl;
    int tid, lane, wave, vcu, G;
    unsigned char* ws;
    float* out;
};
__device__ __forceinline__ const float* frame_in(int i) { typedef __attribute__((address_space(4))) const char* kptr_t; kptr_t ka = (kptr_t)__builtin_amdgcn_kernarg_segment_ptr(); asm volatile("" : "+s"(ka));
    const float* p = *(const float* __attribute__((address_space(4))) const*)(ka + 8 * i); return (const float*)(const GAS float*)p; }
typedef __bf16 bf2v __attribute__((ext_vector_type(2)));
typedef float f2v __attribute__((ext_vector_type(2)));
__device__ __forceinline__ unsigned pkbf(float a, float b) { f2v v = {a, b}; bf2v r = __builtin_convertvector(v, bf2v); return __builtin_bit_cast(unsigned, r); }
__device__ __forceinline__ float bf2f(unsigned short u) { return __uint_as_float((unsigned)u << 16); }
__device__ __forceinline__ float sigm_fast(float x) { return __builtin_amdgcn_rcpf(1.f + __builtin_amdgcn_exp2f(-x * LOG2E)); }

typedef float f32x16 __attribute__((ext_vector_type(16)));
__device__ __forceinline__ bf16x8 pack8(float a0, float a1, float a2, float a3, float a4, float a5, float a6, float a7) {
    v4u p; p.x = pkbf(a0, a1); p.y = pkbf(a2, a3); p.z = pkbf(a4, a5); p.w = pkbf(a6, a7); return __builtin_bit_cast(bf16x8, p); }
#define MFMA32(a, b, c) __builtin_amdgcn_mfma_f32_32x32x16_bf16((a), (b), (c), 0, 0, 0)
__device__ __forceinline__ int krow16(int r, int hh) { return (r & 3) + 8 * (r >> 2) + 4 * hh; }

namespace pg8 {
struct EpiInProj {
    static constexpr bool PERM = true, AFTER_DRAIN = false;
    bf16_t *QL, *QI, *U, *SG; float* MISC; bf16_t* KI;
    __device__ __forceinline__ void operator()(const f32x4 (&acc)[2][2][4][2], const Unit& u, int wr, int wc, int fr, int fq) const {
        const int row0 = u.pm * BM + wr * 64 + fr, c0 = wc * 32 + 8 * fq; const int pn = u.pn;
        if (pn == 6) {
#pragma unroll
            for (int ai = 0; ai < 2; ++ai)
#pragma unroll
                for (int m = 0; m < 4; ++m) { float* rowp = MISC + (size_t)(row0 + ai * HALF + m * 16) * 256 + c0;
#pragma unroll
                    for (int bj = 0; bj < 2; ++bj) { *(f32x4*)(rowp + bj * HALF) = acc[ai][bj][m][0]; *(f32x4*)(rowp + bj * HALF + 4) = acc[ai][bj][m][1]; }
                    if (wc < 2) { const f32x4 v0 = acc[ai][1][m][0], v1 = acc[ai][1][m][1]; u32x4 w; w.x = cvt_pk_bf16(v0[0], v0[1]); w.y = cvt_pk_bf16(v0[2], v0[3]); w.z = cvt_pk_bf16(v1[0], v1[1]); w.w = cvt_pk_bf16(v1[2], v1[3]);
                        *(u32x4*)(KI + (size_t)(row0 + ai * HALF + m * 16) * 64 + c0) = w; } }
        } else {
            bf16_t* base; int ld, colt; bool sg = false;
            if (pn < 4) { base = QL; ld = 1024; colt = pn * 256; }
            else if (pn < 6) { base = QI; ld = 512; colt = (pn - 4) * 256; }
            else if (pn < 9) { base = U; ld = 512; colt = (pn - 7) * 256; }
            else { base = SG; ld = 2048; colt = (pn - 9) * 256; sg = true; }
#pragma unroll
            for (int ai = 0; ai < 2; ++ai)
#pragma unroll
                for (int m = 0; m < 4; ++m) { bf16_t* rowp = base + (size_t)(row0 + ai * HALF + m * 16) * ld + colt + c0;
#pragma unroll
                    for (int bj = 0; bj < 2; ++bj) { f32x4 v0 = acc[ai][bj][m][0], v1 = acc[ai][bj][m][1];
                        if (sg) {
#pragma unroll
                            for (int i = 0; i < 4; ++i) { v0[i] = sigm_fast(v0[i]); v1[i] = sigm_fast(v1[i]); } }
                        u32x4 w; w.x = cvt_pk_bf16(v0[0], v0[1]); w.y = cvt_pk_bf16(v0[2], v0[3]); w.z = cvt_pk_bf16(v1[0], v1[1]); w.w = cvt_pk_bf16(v1[2], v1[3]);
                        *(u32x4*)(rowp + bj * HALF) = w; } }
        }
    }
};
}

__device__ __forceinline__ void tr_item(const float* W, int ldw, int k0, int n0, int ncols, float scale, bf16* WT, int ldt, int drow0, LAS float* scr, int lane) {
    const int nn = lane & 31;
#pragma unroll 8
    for (int i = 0; i < 32; ++i) { const int kk = 2 * i + (lane >> 5); scr[kk * 33 + nn] = (nn < ncols) ? W[(size_t)(k0 + kk) * ldw + n0 + nn] * scale : 0.f; }
    LDS_WAIT(); asm volatile("" ::: "memory");
    const int c = lane & 7;
#pragma unroll
    for (int j = 0; j < 4; ++j) { const int n = (lane >> 3) + 8 * j; const LAS float* s = scr + (8 * c) * 33 + n;
        v4u o; o.x = pk2(s[0 * 33], s[1 * 33]); o.y = pk2(s[2 * 33], s[3 * 33]); o.z = pk2(s[4 * 33], s[5 * 33]); o.w = pk2(s[6 * 33], s[7 * 33]);
        if (n < ncols) *(GAS v4u*)(WT + (size_t)(drow0 + n) * ldt + k0 + 8 * c) = o; }
    LDS_WAIT(); asm volatile("" ::: "memory");
}
struct TrDesc { const float* src; bf16* dst; int ldw; float scale; };
__device__ __forceinline__ void tr_load(const TrDesc& d, int lane, f32x4 (&v)[16]) {
    const int kr = lane >> 4, nc = lane & 15; const float* src = d.src + (size_t)(16 * kr) * d.ldw + 4 * nc;
#pragma unroll
    for (int i = 0; i < 16; ++i) v[i] = __builtin_nontemporal_load((const f32x4*)(src + (size_t)i * d.ldw));
}
__device__ __forceinline__ void tr_finish(const TrDesc& d, LAS unsigned char* scr, int lane, const f32x4 (&v)[16]) {
    const int kr = lane >> 4, nc = lane & 15; const float scale = d.scale;
#pragma unroll
    for (int j = 0; j < 4; ++j) { const int n = 4 * nc + j; const int f = (n >> 2) & 7;
#pragma unroll
        for (int hlf = 0; hlf < 2; ++hlf) { v4u o;
            o.x = pkbf(v[8 * hlf + 0][j] * scale, v[8 * hlf + 1][j] * scale); o.y = pkbf(v[8 * hlf + 2][j] * scale, v[8 * hlf + 3][j] * scale);
            o.z = pkbf(v[8 * hlf + 4][j] * scale, v[8 * hlf + 5][j] * scale); o.w = pkbf(v[8 * hlf + 6][j] * scale, v[8 * hlf + 7][j] * scale);
            *(LAS v4u*)(scr + n * 128 + (((2 * kr + hlf) ^ f) << 4)) = o; } }
    LDS_WAIT(); asm volatile("" ::: "memory");
    const int kc = lane & 7;
#pragma unroll
    for (int j = 0; j < 8; ++j) { const int n = (lane >> 3) + 8 * j; const v4u o = *(const LAS v4u*)(scr + n * 128 + ((kc ^ ((n >> 2) & 7)) << 4));
        *(GAS v4u*)(d.dst + (size_t)n * 1024 + 8 * kc) = o; }
    LDS_WAIT(); asm volatile("" ::: "memory");
}
__device__ __forceinline__ void fold_qlat(const float* w_in, const float* w_uk, bf16* Win_t, int task, int lane) {
    const int h = task >> 8, kb = (task >> 4) & 15, r0 = (task & 15) * 8; const int k = kb * 64 + lane;
    const float* wrow = w_in + (size_t)k * INC + O_Q + h * 64; const float* up = w_uk + r0 * 512 + h * 64;
    float a[8] = {0, 0, 0, 0, 0, 0, 0, 0};
#pragma unroll 4
    for (int d4 = 0; d4 < 16; ++d4) { const f32x4 v = *(const f32x4*)(wrow + 4 * d4);
#pragma unroll
        for (int j = 0; j < 8; ++j) { const f32x4 u = *(const f32x4*)(up + j * 512 + 4 * d4); a[j] += (v.x * u.x + v.y * u.y) + (v.z * u.z + v.w * u.w); } }
#pragma unroll
    for (int j = 0; j < 8; ++j) Win_t[(size_t)(h * 128 + r0 + j) * 1024 + k] = (bf16)f2bf(a[j] * (0.125f * LOG2E));
}
__device__ __forceinline__ void fold_oa(const float* w_uv, const float* w_ba, bf16* Woa_t, int task, int lane) {
    const int h = task >> 8, nb = (task >> 4) & 15, r0 = (task & 15) * 8; const int n = nb * 64 + lane;
    const float* up = w_uv + r0 * 512 + h * 64; float a[8] = {0, 0, 0, 0, 0, 0, 0, 0};
#pragma unroll 4
    for (int d4 = 0; d4 < 16; ++d4) { float v[4];
#pragma unroll
        for (int i = 0; i < 4; ++i) v[i] = w_ba[(size_t)(h * 64 + 4 * d4 + i) * 1024 + n];
#pragma unroll
        for (int j = 0; j < 8; ++j) { const f32x4 u = *(const f32x4*)(up + j * 512 + 4 * d4); a[j] += (v[0] * u.x + v[1] * u.y) + (v[2] * u.z + v[3] * u.w); } }
    v4u o; o.x = pk2(a[0], a[1]); o.y = pk2(a[2], a[3]); o.z = pk2(a[4], a[5]); o.w = pk2(a[6], a[7]);
    *(GAS v4u*)(Woa_t + (size_t)n * 1024 + h * 128 + r0) = o;
}
__device__ __forceinline__ void fold_pb(const float* w_pg, const float* pscale, const float* w_bp, bf16* Wpb_t, int task, int lane) {
    const int g = task >> 8, nb = (task >> 4) & 15, c0 = (task & 15) * 8; const int n = nb * 64 + lane;
    const float* pg = w_pg + (size_t)g * 16384 + c0 * 128; float a[8] = {0, 0, 0, 0, 0, 0, 0, 0};
#pragma unroll 4
    for (int d4 = 0; d4 < 32; ++d4) { float v[4]; const f32x4 ps = *(const f32x4*)(pscale + g * 128 + 4 * d4);
#pragma unroll
        for (int i = 0; i < 4; ++i) v[i] = w_bp[(size_t)(g * 128 + 4 * d4 + i) * 1024 + n] * ps[i];
#pragma unroll
        for (int j = 0; j < 8; ++j) { const f32x4 u = *(const f32x4*)(pg + j * 128 + 4 * d4); a[j] += (v[0] * u.x + v[1] * u.y) + (v[2] * u.z + v[3] * u.w); } }
    v4u o; o.x = pk2(a[0], a[1]); o.y = pk2(a[2], a[3]); o.z = pk2(a[4], a[5]); o.w = pk2(a[6], a[7]);
    *(GAS v4u*)(Wpb_t + (size_t)n * 512 + g * 128 + c0) = o;
}
template <int VAR>
__device__ __forceinline__ void p0_prologue(Frame& F) {
    const float* c = frame_in(1); const float* w_ada = frame_in(2); const float* b_ada = frame_in(3); const float* w_in = frame_in(4);
    const float* w_uk = frame_in(6); const float* w_uv = frame_in(7); const float* w_pg = frame_in(8); const float* pscale = frame_in(9);
    const float* w_ba = frame_in(10); const float* w_bp = frame_in(11); const float* w_out = frame_in(12); const float* w_gu = frame_in(17); const float* w_d = frame_in(19);
    bf16* Win_t = (bf16*)(F.ws + WS_WIN); bf16* Woa_t = (bf16*)(F.ws + WS_WOA); bf16* Wpb_t = (bf16*)(F.ws + WS_WPB); bf16* Wout_t = (bf16*)(F.ws + WS_WOUT);
    bf16* Wgu_t = (bf16*)(F.ws + WS_WGU); bf16* Wd_t = (bf16*)(F.ws + WS_WD); float* MOD = (float*)(F.ws + WS_MOD);
    for (int cg = blockIdx.x; cg < 256; cg += F.G) {
        LAS float* cs = (LAS float*)(F.lds + 69632); LAS float* red = (LAS float*)(F.lds + 69632 + 32768);
        for (int i = F.tid; i < 8192; i += 512) { const float v = c[i]; cs[i] = v / (1.f + __expf(-v)); }
        __syncthreads();
        float acc[8] = {0, 0, 0, 0, 0, 0, 0, 0}; const int cc = F.lane & 31, rp = F.lane >> 5; const bool act = cc < 24; const float* wp = w_ada + cg * 24 + (act ? cc : 0);
#pragma unroll 16
        for (int i = 0; i < 64; ++i) { const int k = F.wave * 128 + 2 * i + rp; float w = __builtin_nontemporal_load(wp + (size_t)k * 6144); w = act ? w : 0.f;
#pragma unroll
            for (int b = 0; b < 8; ++b) acc[b] += cs[b * 1024 + k] * w; }
#pragma unroll
        for (int b = 0; b < 8; ++b) red[((F.wave * 2 + rp) * 8 + b) * 32 + cc] = acc[b];
        __syncthreads();
        if (F.tid < 256) { const int b = F.tid >> 5, l = F.tid & 31; if (l < 24) { float s = 0.f;
#pragma unroll
            for (int w = 0; w < 16; ++w) s += red[(w * 8 + b) * 32 + l];
            MOD[b * 6144 + cg * 24 + l] = s + b_ada[cg * 24 + l]; } }
        __syncthreads();
    }
    LAS unsigned char* scr8 = F.lds + F.wave * 8448; LAS float* scr = (LAS float*)scr8;
    const int gw = F.vcu * NWAVES + F.wave, NGW = F.G * NWAVES;
    constexpr int I_FQ = 2048, I_FO = 2048, I_FP = 1024, I_Z = 56, I_WI = 16, I_WR = 64, NSMALL = I_FQ + I_FO + I_FP + I_Z + I_WI + I_WR;
    for (int it = gw; it < NSMALL; it += NGW) {
        int r = it;
        if (r < I_FQ) { fold_qlat(w_in, w_uk, Win_t, r, F.lane); continue; } r -= I_FQ;
        if (r < I_FO) { fold_oa(w_uv, w_ba, Woa_t, r, F.lane); continue; } r -= I_FO;
        if (r < I_FP) { fold_pb(w_pg, pscale, w_bp, Wpb_t, r, F.lane); continue; } r -= I_FP;
        if (r < I_Z) { GAS v4u* z = (GAS v4u*)(Win_t + (size_t)(1736 + r) * 1024); z[F.lane] = (v4u){0u, 0u, 0u, 0u}; z[F.lane + 64] = (v4u){0u, 0u, 0u, 0u}; continue; } r -= I_Z;
        if (r < I_WI) { tr_item(w_in, INC, r * 64, O_WI, 8, 0.35355339059327373f, Win_t, 1024, 1728, scr, F.lane); continue; } r -= I_WI;
        {
            const float* w_r = frame_in(15); bf16* WrB = (bf16*)(F.ws + WS_WRB); const int ks = r, e = F.lane & 31, h8 = F.lane >> 5; float v[8]; unsigned hi[4], lo[4];
#pragma unroll
            for (int j = 0; j < 8; ++j) v[j] = w_r[(size_t)(16 * ks + 8 * h8 + j) * 32 + e];
#pragma unroll
            for (int j = 0; j < 4; ++j) { hi[j] = pkbf(v[2 * j], v[2 * j + 1]); lo[j] = pkbf(v[2 * j] - __uint_as_float(hi[j] << 16), v[2 * j + 1] - __uint_as_float(hi[j] & 0xffff0000u)); }
            *(GAS v4u*)(WrB + ((size_t)(ks * 2) * 64 + F.lane) * 8) = (v4u){hi[0], hi[1], hi[2], hi[3]}; *(GAS v4u*)(WrB + ((size_t)(ks * 2 + 1) * 64 + F.lane) * 8) = (v4u){lo[0], lo[1], lo[2], lo[3]}; }
    }
    constexpr int I_QI = 128, I_CKV = 32, I_KI = 16, I_U = 128, I_G = 512, I_OUT = 256, I_GU = 32 * 512, I_D = 32 * 256;
    constexpr int NTR = I_QI + I_CKV + I_KI + I_U + I_G + I_OUT + (VAR >= 1 ? 0 : I_GU + I_D);
    auto decode = [&](int r) -> TrDesc {
        if (r < I_QI) return TrDesc{w_in + (size_t)((r >> 3) * 64) * INC + O_QI + (r & 7) * 64, Win_t + (size_t)(1024 + (r & 7) * 64) * 1024 + (r >> 3) * 64, INC, 0.125f}; r -= I_QI;
        if (r < I_CKV) return TrDesc{w_in + (size_t)((r >> 1) * 64) * INC + O_CKV + (r & 1) * 64, Win_t + (size_t)(1536 + (r & 1) * 64) * 1024 + (r >> 1) * 64, INC, 1.f}; r -= I_CKV;
        if (r < I_KI) return TrDesc{w_in + (size_t)(r * 64) * INC + O_KI, Win_t + (size_t)1664 * 1024 + r * 64, INC, 1.f}; r -= I_KI;
        if (r < I_U) return TrDesc{w_in + (size_t)((r >> 3) * 64) * INC + O_U + (r & 7) * 64, Win_t + (size_t)(1792 + (r & 7) * 64) * 1024 + (r >> 3) * 64, INC, 1.f}; r -= I_U;
        if (r < I_G) return TrDesc{w_in + (size_t)((r >> 5) * 64) * INC + O_G + (r & 31) * 64, Win_t + (size_t)(2304 + (r & 31) * 64) * 1024 + (r >> 5) * 64, INC, 1.f}; r -= I_G;
        if (r < I_OUT) return TrDesc{w_out + (size_t)((r >> 4) * 64) * 1024 + (r & 15) * 64, Wout_t + (size_t)((r & 15) * 64) * 1024 + (r >> 4) * 64, 1024, 1.f}; r -= I_OUT;
        if (r < I_GU) { const int e = r >> 9, q = r & 511, kb = q >> 5, n0 = (q & 31) * 64;
            const int drow = (n0 < 1024) ? ((n0 >> 7) * 256 + (n0 & 127)) : (((n0 - 1024) >> 7) * 256 + 128 + ((n0 - 1024) & 127));
            return TrDesc{w_gu + ((size_t)e * 1024 + kb * 64) * 2048 + n0, Wgu_t + ((size_t)e * 2048 + drow) * 1024 + kb * 64, 2048, 1.f}; } r -= I_GU;
        { const int e = r >> 8, q = r & 255, kb = q >> 4, n0 = (q & 15) * 64;
          return TrDesc{w_d + ((size_t)e * 1024 + kb * 64) * 1024 + n0, Wd_t + ((size_t)e * 1024 + n0) * 1024 + kb * 64, 1024, 1.f}; }
    };
    {   f32x4 vA[16], vB[16]; TrDesc dA, dB; int it = gw;
        if (it < NTR) { dA = decode(it); tr_load(dA, F.lane, vA); }
        while (it < NTR) {
            int itn = it + NGW; if (itn < NTR) { dB = decode(itn); tr_load(dB, F.lane, vB); }
            tr_finish(dA, scr8, F.lane, vA);
            it = itn; if (it >= NTR) break;
            itn = it + NGW; if (itn < NTR) { dA = decode(itn); tr_load(dA, F.lane, vA); }
            tr_finish(dB, scr8, F.lane, vB);
            it = itn;
        }
    }
}
__device__ __forceinline__ void p1_modulate(Frame& F) {
    const float* x = frame_in(0); const float* MOD = (const float*)(F.ws + WS_MOD); bf16* H = (bf16*)(F.ws + WS_H);
    const int gw = F.vcu * NWAVES + F.wave, NGW = F.G * NWAVES;
    for (int m = gw; m < T; m += NGW) { const int b = m >> 11;
        const GAS f32x4* xr = (const GAS f32x4*)(x + (size_t)m * D) + F.lane; GAS unsigned long long* o8 = (GAS unsigned long long*)(H + (size_t)m * D) + F.lane;
#pragma unroll
        for (int j = 0; j < 4; ++j) { const f32x4 v = xr[64 * j]; const int col = 4 * F.lane + 256 * j;
            const f32x4 sh = *(const f32x4*)(MOD + b * 6144 + col), sc = *(const f32x4*)(MOD + b * 6144 + 1024 + col);
            const f32x4 h = v * (sc + 1.0f) + sh;
            o8[64 * j] = (unsigned long long)pk2(h.x, h.y) | ((unsigned long long)pk2(h.z, h.w) << 32); }
    }
}
constexpr int MOE_TAB_SLOTS = 10, LC_ROWTAB = LDSCTL_OFF + 8192;
constexpr int LC_LCNT = LDSCTL_OFF + 1024, LC_BASE = LDSCTL_OFF + 1280, LC_TSTART = LDSCTL_OFF + 1536, LC_LIST = LDSCTL_OFF + 4096;
namespace pg8 {
__device__ __forceinline__ float bfl(unsigned w) { return __uint_as_float(w << 16); }
__device__ __forceinline__ float bfh(unsigned w) { return __uint_as_float(w & 0xffff0000u); }
struct EpiGateMul {
    static constexpr bool PERM = true, AFTER_DRAIN = false;
    bf16_t* O; const bf16_t* SG; int goff, pad;
    __device__ __forceinline__ void operator()(const f32x4 (&acc)[2][2][4][2], const Unit& u, int wr, int wc, int fr, int fq) const {
        const int row0 = u.pm * BM + wr * 64 + fr, col0 = u.pn * BM + wc * 32 + 8 * fq;
#pragma unroll
        for (int ai = 0; ai < 2; ++ai)
#pragma unroll
            for (int m = 0; m < 4; ++m) { const size_t row = (size_t)(row0 + ai * HALF + m * 16);
#pragma unroll
                for (int bj = 0; bj < 2; ++bj) { const u32x4 g = *(const u32x4*)(SG + row * 2048 + goff + col0 + bj * HALF); const f32x4 v0 = acc[ai][bj][m][0], v1 = acc[ai][bj][m][1];
                    u32x4 w; w.x = cvt_pk_bf16(v0[0] * bfl(g.x), v0[1] * bfh(g.x)); w.y = cvt_pk_bf16(v0[2] * bfl(g.y), v0[3] * bfh(g.y));
                    w.z = cvt_pk_bf16(v1[0] * bfl(g.z), v1[1] * bfh(g.z)); w.w = cvt_pk_bf16(v1[2] * bfl(g.w), v1[3] * bfh(g.w));
                    *(u32x4*)(O + row * 1024 + col0 + bj * HALF) = w; } }
    }
};
struct EpiGateAdd {
    static constexpr bool PERM = true, AFTER_DRAIN = false;
    bf16_t* O; const bf16_t* TMPB; const bf16_t* SG; int goff, pad;
    __device__ __forceinline__ void operator()(const f32x4 (&acc)[2][2][4][2], const Unit& u, int wr, int wc, int fr, int fq) const {
        const int row0 = u.pm * BM + wr * 64 + fr, col0 = u.pn * BM + wc * 32 + 8 * fq;
#pragma unroll
        for (int ai = 0; ai < 2; ++ai)
#pragma unroll
            for (int m = 0; m < 4; ++m) { const size_t row = (size_t)(row0 + ai * HALF + m * 16);
#pragma unroll
                for (int bj = 0; bj < 2; ++bj) { const u32x4 g = *(const u32x4*)(SG + row * 2048 + goff + col0 + bj * HALF); const u32x4 t = *(const u32x4*)(TMPB + row * 1024 + col0 + bj * HALF);
                    const f32x4 v0 = acc[ai][bj][m][0], v1 = acc[ai][bj][m][1];
                    u32x4 w; w.x = cvt_pk_bf16(bfl(t.x) + v0[0] * bfl(g.x), bfh(t.x) + v0[1] * bfh(g.x)); w.y = cvt_pk_bf16(bfl(t.y) + v0[2] * bfl(g.y), bfh(t.y) + v0[3] * bfh(g.y));
                    w.z = cvt_pk_bf16(bfl(t.z) + v1[0] * bfl(g.z), bfh(t.z) + v1[1] * bfh(g.z)); w.w = cvt_pk_bf16(bfl(t.w) + v1[2] * bfl(g.w), bfh(t.w) + v1[3] * bfh(g.w));
                    *(u32x4*)(O + row * 1024 + col0 + bj * HALF) = w; } }
    }
};
struct EpiResid {
    static constexpr bool PERM = false, AFTER_DRAIN = false;
    float* Z; const float* x; const float* gate;
    __device__ __forceinline__ void operator()(const f32x4 (&acc)[2][2][4][2], const Unit& u, int wr, int wc, int fr, int fq) const {
        const int row0 = u.pm * BM + wr * 64 + fr, col0 = u.pn * BM + wc * 32 + 4 * fq; const int b = (u.pm * BM) >> 11;
        f32x4 gv[2][2];
#pragma unroll
        for (int bj = 0; bj < 2; ++bj)
#pragma unroll
            for (int n = 0; n < 2; ++n) gv[bj][n] = *(const f32x4*)(gate + b * 6144 + col0 + bj * HALF + n * 16);
#pragma unroll
        for (int ai = 0; ai < 2; ++ai)
#pragma unroll
            for (int m = 0; m < 4; ++m) { const size_t off = (size_t)(row0 + ai * HALF + m * 16) * 1024 + col0;
#pragma unroll
                for (int bj = 0; bj < 2; ++bj)
#pragma unroll
                    for (int n = 0; n < 2; ++n) { const f32x4 xv = *(const f32x4*)(x + off + bj * HALF + n * 16); *(f32x4*)(Z + off + bj * HALF + n * 16) = xv * ALPHA + gv[bj][n] * acc[ai][bj][m][n]; } }
    }
};
struct EpiSwiglu {
    static constexpr bool PERM = true, AFTER_DRAIN = false;
    bf16_t* ACT; const float* bgu;
    __device__ __forceinline__ void operator()(const f32x4 (&acc)[2][2][4][2], const Unit& u, int wr, int wc, int fr, int fq) const {
        const int e = u.pn >> 3, j = u.pn & 7; const int row0 = u.pm * BM + wr * 64 + fr, cc = wc * 32 + 8 * fq;
        const float* bg = bgu + e * 2048 + j * 128 + cc; f32x4 bgl[2], bli[2];
#pragma unroll
        for (int n = 0; n < 2; ++n) { bgl[n] = *(const f32x4*)(bg + 4 * n); bli[n] = *(const f32x4*)(bg + 1024 + 4 * n); }
#pragma unroll
        for (int ai = 0; ai < 2; ++ai)
#pragma unroll
            for (int m = 0; m < 4; ++m) { float o[8];
#pragma unroll
                for (int n = 0; n < 2; ++n) { const f32x4 gl4 = acc[ai][0][m][n] + bgl[n], li4 = acc[ai][1][m][n] + bli[n];
#pragma unroll
                    for (int i = 0; i < 4; ++i) { const float gl = fminf(gl4[i], 7.f), li = fminf(fmaxf(li4[i], -7.f), 7.f);
                        o[4 * n + i] = gl * __builtin_amdgcn_rcpf(1.f + __builtin_amdgcn_exp2f(gl * (-1.702f * LOG2E))) * (li + 1.f); } }
                u32x4 w; w.x = cvt_pk_bf16(o[0], o[1]); w.y = cvt_pk_bf16(o[2], o[3]); w.z = cvt_pk_bf16(o[4], o[5]); w.w = cvt_pk_bf16(o[6], o[7]);
                *(u32x4*)(ACT + (size_t)(row0 + ai * HALF + m * 16) * 1024 + j * 128 + cc) = w; }
    }
};
template <bool BIAS>
struct EpiDownT {
    static constexpr bool PERM = true, AFTER_DRAIN = false;
    bf16_t* Y; const float* bd;
    __device__ __forceinline__ void operator()(const f32x4 (&acc)[2][2][4][2], const Unit& u, int wr, int wc, int fr, int fq) const {
        const int e = u.pn >> 2, j = u.pn & 3; const int row0 = u.pm * BM + wr * 64 + fr, col0 = j * 256 + wc * 32 + 8 * fq;
        f32x4 bv[2][2];
#pragma unroll
        for (int bj = 0; bj < 2; ++bj)
#pragma unroll
            for (int n = 0; n < 2; ++n) bv[bj][n] = BIAS ? *(const f32x4*)(bd + e * 1024 + col0 + bj * HALF + 4 * n) : (f32x4){0.f, 0.f, 0.f, 0.f};
#pragma unroll
        for (int ai = 0; ai < 2; ++ai)
#pragma unroll
            for (int m = 0; m < 4; ++m) { bf16_t* rowp = Y + (size_t)(row0 + ai * HALF + m * 16) * 1024 + col0;
#pragma unroll
                for (int bj = 0; bj < 2; ++bj) { const f32x4 v0 = acc[ai][bj][m][0] + bv[bj][0], v1 = acc[ai][bj][m][1] + bv[bj][1];
                    u32x4 w; w.x = cvt_pk_bf16(v0[0], v0[1]); w.y = cvt_pk_bf16(v0[2], v0[3]); w.z = cvt_pk_bf16(v1[0], v1[1]); w.w = cvt_pk_bf16(v1[2], v1[3]);
                    *(u32x4*)(rowp + bj * HALF) = w; } }
    }
};
typedef EpiDownT<true> EpiDown;
template <bool GATHER_, bool REV = false>
struct MoeOrderT {
    static constexpr bool GATHER = GATHER_;
    const PG8_LAS int* tstart; int NT, G, c;
    const PG8_LAS int* rowtab; const int* slotmap; const int* cnt;
    __device__ __forceinline__ int arow(int slot, const Unit& u, int r) const {
        if (slot < MOE_TAB_SLOTS) return rowtab[slot * 256 + r];
        const int e = u.pn / NT, rank = (u.pm - tstart[e]) * 256 + r; return rank < cnt[e] ? slotmap[e * T + rank] : 0;
    }
    __device__ __forceinline__ bool next(int i, Unit& u) const {
        const int x = c & 7, li = c >> 3, per = G >> 3; int L = i * per + li;
#pragma unroll 1
        for (int j = 0; j < 4; ++j) { const int e = REV ? x + 8 * (3 - j) : x + 8 * j; const int nte = tstart[e + 1] - tstart[e], nu = nte * NT;
            if (L < nu) { u.pm = tstart[e] + L % nte; u.pn = e * NT + L / nte; return true; }
            L -= nu; }
        return false;
    }
    __device__ __forceinline__ void a_ready(const Unit&) const {}
    __device__ __forceinline__ void done(const Unit&) const {}
};
typedef MoeOrderT<true> MoeOrderG; typedef MoeOrderT<false, true> MoeOrder;
}

__device__ __forceinline__ float wave_sum(float v) {
#pragma unroll
    for (int o = 1; o < 64; o <<= 1) v += __shfl_xor(v, o);
    return v;
}
__device__ __forceinline__ void p3_post(Frame& F) {
    const float* MISC = (const float*)(F.ws + WS_MISC); const float* kvg = frame_in(5); bf16* CKV = (bf16*)(F.ws + WS_CKV); bf16* CKVT = (bf16*)(F.ws + WS_CKVT);
    const bf16* U = (const bf16*)(F.ws + WS_U); bf16* POOLED = (bf16*)(F.ws + WS_POOLED);
    LAS bf16* tile = (LAS bf16*)(F.lds);
    for (int task = blockIdx.x; task < 256; task += F.G) {
        const int t0 = task * 64; const int row = F.tid >> 3, seg = F.tid & 7;
        const float* src = MISC + (size_t)(t0 + row) * 256 + seg * 16; f32x4 v[4]; float ss = 0.f;
#pragma unroll
        for (int i = 0; i < 4; ++i) { v[i] = *(const f32x4*)(src + 4 * i); ss += (v[i].x * v[i].x + v[i].y * v[i].y) + (v[i].z * v[i].z + v[i].w * v[i].w); }
        ss += __shfl_xor(ss, 1); ss += __shfl_xor(ss, 2); ss += __shfl_xor(ss, 4);
        const float rs = 1.0f / sqrtf(ss * (1.f / 128.f) + LN_EPS);
        unsigned w[8];
#pragma unroll
        for (int i = 0; i < 4; ++i) { const f32x4 g = *(const f32x4*)(kvg + seg * 16 + 4 * i); w[2 * i] = pk2(v[i].x * rs * g.x, v[i].y * rs * g.y); w[2 * i + 1] = pk2(v[i].z * rs * g.z, v[i].w * rs * g.w); }
        GAS v4u* dst = (GAS v4u*)(CKV + (size_t)(t0 + row) * 128 + seg * 16); dst[0] = (v4u){w[0], w[1], w[2], w[3]}; dst[1] = (v4u){w[4], w[5], w[6], w[7]};
        LAS v4u* lt = (LAS v4u*)(tile + row * 128 + seg * 16); lt[0] = (v4u){w[0], w[1], w[2], w[3]}; lt[1] = (v4u){w[4], w[5], w[6], w[7]};
        __syncthreads();
        { const int d = F.tid >> 2, part = F.tid & 3; unsigned o[8];
#pragma unroll
          for (int q = 0; q < 16; q += 2) { unsigned pr[2];
#pragma unroll
              for (int z = 0; z < 2; ++z) { const int p = part * 16 + q + z; const int j = p & 7, h = (p >> 3) & 1, tt = (p >> 4) & 1, kb = p >> 5; const int key = kb * 32 + 16 * tt + 8 * (j >> 2) + 4 * h + (j & 3); pr[z] = tile[key * 128 + d]; }
              o[q >> 1] = pr[0] | (pr[1] << 16); }
          const int b = task >> 5, kt = task & 31;
          GAS v4u* dt = (GAS v4u*)(CKVT + ((size_t)(b * 128 + d) * 2048) + kt * 64 + part * 16); dt[0] = (v4u){o[0], o[1], o[2], o[3]}; dt[1] = (v4u){o[4], o[5], o[6], o[7]}; }
        __syncthreads();
    }
    LAS bf16* ut = (LAS bf16*)(F.lds + 16384);
    for (int task = blockIdx.x; task < 256; task += F.G) { const int t0 = task * 64, s0 = t0 & 2047;
        __syncthreads();
#pragma unroll
        for (int i = 0; i < 10; ++i) { const int c = F.tid + 512 * i, row = c >> 6, ch = c & 63; const int sp = s0 - 16 + row;
            v4u v = (v4u){0u, 0u, 0u, 0u}; if (sp >= 0) v = *(const GAS v4u*)(U + (size_t)(t0 - 16 + row) * 512 + ch * 8);
            *(LAS v4u*)(ut + row * 512 + ch * 8) = v; }
        __syncthreads();
        const int c = F.tid, g = c >> 7, w = 2 << g; float win = 0.f;
        for (int j = 16 - w; j < 16; ++j) win += bf2f(ut[j * 512 + c]);
        for (int j = 16; j < 80; ++j) { const float cur = bf2f(ut[j * 512 + c]); win += cur; win -= bf2f(ut[(j - w) * 512 + c]);
            const int sq = s0 + j - 16; const int cntw = (sq + 1 < w) ? (sq + 1) : w; POOLED[(size_t)(t0 + j - 16) * 512 + c] = (bf16)f2bf(win / (float)cntw - cur); }
    }
}
constexpr int P7_AL = 0, P7_LOGIT = 131072 - 4096;
__device__ __forceinline__ void p7_ln1_route(Frame& F, int cw_gcnt) {
    const float* Z = (const float*)(F.ws + WS_Z); const float* g1 = frame_in(13); const float* b1 = frame_in(14); const float* b_r = frame_in(16);
    const float* MOD = (const float*)(F.ws + WS_MOD); float* X1 = (float*)(F.ws + WS_X1); bf16* H2 = (bf16*)(F.ws + WS_H); const bf16* WrB = (const bf16*)(F.ws + WS_WRB);
    int* gcnt = (int*)(F.ctl + cw_gcnt); int* SLOTMAP = (int*)(F.ws + WS_SLOTMAP); int* TOKSLOT = (int*)(F.ws + WS_TOKSLOT); float* GATE = (float*)(F.ws + WS_GATE);
    LAS unsigned char* AL = F.lds + P7_AL; LAS float* red = (LAS float*)(F.lds);
    LAS float* logit = (LAS float*)(F.lds + 65536);
    LAS int* lcnt = (LAS int*)(F.lds + LC_LCNT); LAS int* lbase = (LAS int*)(F.lds + LC_BASE); LAS int* list = (LAS int*)(F.lds + LC_LIST);
    if (F.tid < 32) lcnt[F.tid] = 0;
    const int hh = F.lane >> 5, l31 = F.lane & 31;
    bf16x8 Bh[8], Bl[8];
#pragma unroll
    for (int s = 0; s < 8; ++s) { const bf16* p = WrB + ((size_t)((F.wave * 8 + s) * 2) * 64 + F.lane) * 8; Bh[s] = *(const GAS bf16x8*)p; Bl[s] = *(const GAS bf16x8*)(p + 64 * 8); }
    const int rows_per_wg = T / F.G;
    for (int step = 0; step < rows_per_wg / 32; ++step) { const int m0 = blockIdx.x * rows_per_wg + step * 32;
        __syncthreads();
#pragma unroll 1
        for (int rr = 0; rr < 4; ++rr) { const int row = F.wave * 4 + rr, m = m0 + row, b = m >> 11;
            const GAS f32x4* zr = (const GAS f32x4*)(Z + (size_t)m * D) + F.lane; f32x4 v[4]; float s = 0.f;
#pragma unroll
            for (int j = 0; j < 4; ++j) { v[j] = zr[64 * j]; s += (v[j].x + v[j].y) + (v[j].z + v[j].w); }
            const float mean = wave_sum(s) * (1.f / D); float s2 = 0.f;
#pragma unroll
            for (int j = 0; j < 4; ++j) { v[j] = v[j] - mean; s2 += (v[j].x * v[j].x + v[j].y * v[j].y) + (v[j].z * v[j].z + v[j].w * v[j].w); }
            const float rstd = 1.f / sqrtf(wave_sum(s2) * (1.f / D) + LN_EPS);
#pragma unroll
            for (int j = 0; j < 4; ++j) { const int col = 4 * F.lane + 256 * j;
                const f32x4 gg = *(const f32x4*)(g1 + col), bb = *(const f32x4*)(b1 + col); const f32x4 x1 = v[j] * rstd * gg + bb;
                *((GAS f32x4*)(X1 + (size_t)m * D) + F.lane + 64 * j) = x1;
                const f32x4 sh = *(const f32x4*)(MOD + b * 6144 + 3 * 1024 + col), sc = *(const f32x4*)(MOD + b * 6144 + 4 * 1024 + col); const f32x4 h2 = x1 * (sc + 1.0f) + sh;
                const unsigned h01 = pkbf(h2.x, h2.y), h23 = pkbf(h2.z, h2.w);
                *((GAS unsigned long long*)(H2 + (size_t)m * D) + F.lane + 64 * j) = (unsigned long long)h01 | ((unsigned long long)h23 << 32);
                const unsigned l01 = pkbf(h2.x - pg8::bfl(h01), h2.y - pg8::bfh(h01)), l23 = pkbf(h2.z - pg8::bfl(h23), h2.w - pg8::bfh(h23));
                const int chunk = 32 * j + (F.lane >> 1); const int off = row * 2048 + (((chunk & ~15) | ((chunk ^ row) & 15)) << 4) + (F.lane & 1) * 8;
                *(LAS unsigned long long*)(AL + off) = (unsigned long long)h01 | ((unsigned long long)h23 << 32);
                *(LAS unsigned long long*)(AL + 65536 + off) = (unsigned long long)l01 | ((unsigned long long)l23 << 32); } }
        __syncthreads();
        f32x16 acc;
#pragma unroll
        for (int r = 0; r < 16; ++r) acc[r] = 0.f;
#pragma unroll
        for (int s = 0; s < 8; ++s) { const int chunk = 2 * (F.wave * 8 + s) + hh; const int off = l31 * 2048 + (((chunk & ~15) | ((chunk ^ l31) & 15)) << 4);
            const bf16x8 Ah = *(const LAS bf16x8*)(AL + off), Alo = *(const LAS bf16x8*)(AL + 65536 + off);
            acc = MFMA32(Ah, Bh[s], acc); acc = MFMA32(Ah, Bl[s], acc); acc = MFMA32(Alo, Bh[s], acc); }
        __syncthreads();
#pragma unroll
        for (int r = 0; r < 16; ++r) red[(F.wave * 32 + krow16(r, hh)) * 32 + l31] = acc[r];
        __syncthreads();
        { const int row = F.tid >> 4, e0 = (F.tid & 15) * 2; float s0 = 0.f, s1 = 0.f;
#pragma unroll
          for (int w = 0; w < 8; ++w) { s0 += red[(w * 32 + row) * 32 + e0]; s1 += red[(w * 32 + row) * 32 + e0 + 1]; }
          logit[row * 33 + e0] = s0 + b_r[e0]; logit[row * 33 + e0 + 1] = s1 + b_r[e0 + 1]; }
        __syncthreads();
        if (F.tid < 32) { const int row = F.tid, m = m0 + row; float lg[32];
#pragma unroll
            for (int e = 0; e < 32; ++e) lg[e] = logit[row * 33 + e];
            int se[4]; float sv[4]; unsigned used = 0u;
#pragma unroll
            for (int k = 0; k < 4; ++k) { int best = 0; float bv = -INFINITY; bool have = false;
#pragma unroll
                for (int e = 0; e < 32; ++e) { const bool ok = !((used >> e) & 1u) && (!have || lg[e] > bv); if (ok) { best = e; bv = lg[e]; have = true; } }
                se[k] = best; sv[k] = bv; used |= 1u << best; }
            float ex[4], den = 0.f;
#pragma unroll
            for (int k = 0; k < 4; ++k) { ex[k] = __expf(sv[k] - sv[0]); den += ex[k]; }
            const float inv = 1.f / den;
#pragma unroll
            for (int k = 0; k < 4; ++k) { const int lr = __hip_atomic_fetch_add(&lcnt[se[k]], 1, __ATOMIC_RELAXED, __HIP_MEMORY_SCOPE_WORKGROUP);
                LAS int* ent = list + ((step * 32 + row) * 4 + k) * 4; ent[0] = m; ent[1] = se[k]; ent[2] = lr; ent[3] = __float_as_int(ex[k] * inv); } }
    }
    __syncthreads();
    if (F.tid < 32) lbase[F.tid] = atomicAdd(&gcnt[F.tid], lcnt[F.tid]);
    __syncthreads();
    if (F.tid < 256) { LAS int* ent = list + F.tid * 4; const int m = ent[0], e = ent[1], rank = lbase[e] + ent[2];
        SLOTMAP[e * T + rank] = m; TOKSLOT[m * 4 + (F.tid & 3)] = e | (rank << 8); GATE[m * 4 + (F.tid & 3)] = __int_as_float(ent[3]); }
}
__device__ __forceinline__ void load_tstart(Frame& F) {
    LAS int* ts = (LAS int*)(F.lds + LC_TSTART); const int* gcnt = (const int*)(F.ctl + CW_GCNT);
    if (F.tid == 0) { int a = 0; for (int e = 0; e < 32; ++e) { ts[e] = a; a += (__hip_atomic_load(gcnt + e, __ATOMIC_RELAXED, __HIP_MEMORY_SCOPE_AGENT) + 255) >> 8; } ts[32] = a; }
    __syncthreads();
}
__device__ __forceinline__ void warm_range(Frame& F, const unsigned char* base, size_t bytes) {
    const size_t per = bytes / (size_t)F.G; const GAS v4u* p = (const GAS v4u*)(base + per * (size_t)blockIdx.x) + F.tid; const int n = (int)(per / (512 * 16));
    v4u acc = (v4u){0u, 0u, 0u, 0u};
#pragma unroll 8
    for (int i = 0; i < n; ++i) { const v4u v = __builtin_nontemporal_load(p + (size_t)i * 512); acc.x ^= v.x; acc.y ^= v.y; acc.z ^= v.z; acc.w ^= v.w; }
    asm volatile("" :: "v"(acc.x), "v"(acc.y), "v"(acc.z), "v"(acc.w));
}
__device__ __forceinline__ void moe_fill_rowtab(Frame& F, const pg8::MoeOrderG& S) {
    LAS int* tab = (LAS int*)(F.lds + LC_ROWTAB); const LAS int* ts = (const LAS int*)(F.lds + LC_TSTART);
    for (int slot = 0; slot < MOE_TAB_SLOTS; ++slot) { pg8::Unit u; if (!S.next(slot, u)) break;
        if (F.tid < 256) { const int e = u.pn / S.NT, rank = (u.pm - ts[e]) * 256 + F.tid; tab[slot * 256 + F.tid] = rank < S.cnt[e] ? S.slotmap[e * T + rank] : 0; } }
    __syncthreads();
}
__device__ __forceinline__ void p11_final(Frame& F) {
    load_tstart(F);
    const LAS int* ts = (const LAS int*)(F.lds + LC_TSTART);
    const float* X1 = (const float*)(F.ws + WS_X1); const bf16* Y = (const bf16*)(F.ws + WS_Y); const int* TOKSLOT = (const int*)(F.ws + WS_TOKSLOT); const float* GATE = (const float*)(F.ws + WS_GATE);
    const float* MOD = (const float*)(F.ws + WS_MOD); const float* g2 = frame_in(21); const float* b2 = frame_in(22);
    const int gw = F.vcu * NWAVES + F.wave, NGW = F.G * NWAVES;
    for (int m = gw; m < T; m += NGW) { const int b = m >> 11;
        f32x4 mo[4];
#pragma unroll
        for (int j = 0; j < 4; ++j) mo[j] = (f32x4){0.f, 0.f, 0.f, 0.f};
#pragma unroll
        for (int k = 0; k < 4; ++k) { const int tsl = TOKSLOT[m * 4 + k]; const int e = tsl & 255, rank = tsl >> 8; const float gt = GATE[m * 4 + k];
            const GAS unsigned long long* yr = (const GAS unsigned long long*)(Y + ((size_t)ts[e] * 256 + rank) * D) + F.lane;
#pragma unroll
            for (int j = 0; j < 4; ++j) { const unsigned long long w = yr[64 * j]; const unsigned lo = (unsigned)w, hi = (unsigned)(w >> 32);
                mo[j].x += gt * pg8::bfl(lo); mo[j].y += gt * pg8::bfh(lo); mo[j].z += gt * pg8::bfl(hi); mo[j].w += gt * pg8::bfh(hi); } }
        f32x4 v[4]; float s = 0.f;
#pragma unroll
        for (int j = 0; j < 4; ++j) { const int col = 4 * F.lane + 256 * j; const f32x4 x1 = *((const GAS f32x4*)(X1 + (size_t)m * D) + F.lane + 64 * j);
            const f32x4 g2m = *(const f32x4*)(MOD + b * 6144 + 5 * 1024 + col); v[j] = x1 * ALPHA + g2m * mo[j]; s += (v[j].x + v[j].y) + (v[j].z + v[j].w); }
        const float mean = wave_sum(s) * (1.f / D); float s2 = 0.f;
#pragma unroll
        for (int j = 0; j < 4; ++j) { v[j] = v[j] - mean; s2 += (v[j].x * v[j].x + v[j].y * v[j].y) + (v[j].z * v[j].z + v[j].w * v[j].w); }
        const float rstd = 1.f / sqrtf(wave_sum(s2) * (1.f / D) + LN_EPS);
#pragma unroll
        for (int j = 0; j < 4; ++j) { const int col = 4 * F.lane + 256 * j; const f32x4 gg = *(const f32x4*)(g2 + col), bb = *(const f32x4*)(b2 + col);
            *((GAS f32x4*)(F.out + (size_t)m * D) + F.lane + 64 * j) = v[j] * rstd * gg + bb; }
    }
}
__device__ __forceinline__ unsigned ordkey(float f) { const unsigned u = __float_as_uint(f); return (u & 0x80000000u) ? ~u : (u | 0x80000000u); }

constexpr int SEL_QI = 0, SEL_HIST = 32768, SEL_CAND = 98304, SEL_MASK = 114688, SEL_META = 122880, SEL_CAP = 128;
__device__ __forceinline__ float relu_i(float x) { const int i = __float_as_int(x); return __int_as_float(i > 0 ? i : 0); }
__device__ __forceinline__ void idx_load_a(const bf16* KIb, int kt, int lane, bf16x8 (&A)[4]) {
    const bf16* kp = KIb + (size_t)(kt * 32 + (lane & 31)) * 64 + 8 * (lane >> 5);
#pragma unroll
    for (int s = 0; s < 4; ++s) A[s] = *(const GAS bf16x8*)(kp + 16 * s);
}
__device__ __forceinline__ void idx_scores1(const bf16x8 (&AA)[4], const LAS unsigned char* qiL, const float (&wi)[8], int lane, f32x16& scA) {
    const int hh = lane >> 5, q = lane & 31; const LAS unsigned char* qrow = qiL + q * 1024; const int qs = q & 15;
#pragma unroll
    for (int r = 0; r < 16; ++r) scA[r] = 0.f;
    f32x16 acc[2];
    { bf16x8 B0[4];
#pragma unroll
      for (int s = 0; s < 4; ++s) B0[s] = *(const LAS bf16x8*)(qrow + (((2 * s + hh) ^ qs) << 4));
#pragma unroll
      for (int r = 0; r < 16; ++r) acc[0][r] = 0.f;
#pragma unroll
      for (int s = 0; s < 4; ++s) acc[0] = MFMA32(AA[s], B0[s], acc[0]); }
#pragma unroll
    for (int h = 0; h < 8; ++h) { const int cur = h & 1, nxt = cur ^ 1;
        if (h < 7) { bf16x8 Bn[4];
#pragma unroll
            for (int s = 0; s < 4; ++s) Bn[s] = *(const LAS bf16x8*)(qrow + ((((h + 1) * 8 + 2 * s + hh) ^ qs) << 4));
#pragma unroll
            for (int r = 0; r < 16; ++r) acc[nxt][r] = 0.f;
#pragma unroll
            for (int s = 0; s < 4; ++s) acc[nxt] = MFMA32(AA[s], Bn[s], acc[nxt]); }
#pragma unroll
        for (int r = 0; r < 16; ++r) scA[r] = fmaf(wi[h], relu_i(acc[cur][r]), scA[r]);
        if (h < 7) {
            __builtin_amdgcn_sched_group_barrier(0x100, 4, 0);
#pragma unroll
            for (int i = 0; i < 4; ++i) { __builtin_amdgcn_sched_group_barrier(0x008, 1, 0); __builtin_amdgcn_sched_group_barrier(0x002, 8, 0); } }
    }
}
template <int MODE, int VAR>
__device__ __forceinline__ void sel_tile(Frame& F, const f32x16& sc, int kt, int hh, int q, int qpos, int bst, unsigned pfx, unsigned trial, unsigned& cntl) {
    LAS unsigned* hist = (LAS unsigned*)(F.lds + SEL_HIST); LAS unsigned* cand = (LAS unsigned*)(F.lds + SEL_CAND); LAS unsigned* maskL = (LAS unsigned*)(F.lds + SEL_MASK); LAS int* meta = (LAS int*)(F.lds + SEL_META);
    unsigned word = 0u; const int kbase = kt * 32 + 4 * hh; const int lim = qpos - kbase;
#pragma unroll
    for (int r = 0; r < 16; ++r) { const int kr0 = (r & 3) + 8 * (r >> 2); const bool valid = kr0 <= lim;
        const unsigned bits = __float_as_uint(sc[r]) & 0xFFFFF800u; const float st = __uint_as_float(bits);
        int bin = (int)(st * 64.f) + 256; bin = bin < 0 ? 0 : (bin > 511 ? 511 : bin);
        if (MODE == 0) { if (VAR == 1) { asm volatile("" :: "v"(bin), "v"(valid ? 1u : 0u)); } else __hip_atomic_fetch_add(hist + q * 512 + bin, valid ? 1u : 0u, __ATOMIC_RELAXED, __HIP_MEMORY_SCOPE_WORKGROUP); }
        else { const unsigned ck = (ordkey(st) & 0xFFFFF800u) | (unsigned)(2047 - kbase - kr0);
            if (MODE == 1) { word |= (valid && bin > bst) ? (1u << kr0) : 0u; const bool isc = valid && bin == bst;
                if (isc) { const int slot = __hip_atomic_fetch_add((LAS int*)meta + 64 + q, 1, __ATOMIC_RELAXED, __HIP_MEMORY_SCOPE_WORKGROUP); if (slot < SEL_CAP) cand[q * SEL_CAP + slot] = ck; } }
            if (MODE == 2) { cntl += (valid && ck >= (pfx | trial)) ? 1u : 0u; }
            if (MODE == 3) { word |= (valid && ck >= pfx) ? (1u << kr0) : 0u; } }
        }
    if (MODE == 1 || MODE == 3) __hip_atomic_fetch_or(maskL + q * 64 + kt, word << (4 * hh), __ATOMIC_RELAXED, __HIP_MEMORY_SCOPE_WORKGROUP);
}
template <int MODE, int VAR>
__device__ __forceinline__ void sel_pass(Frame& F, int lane, int wave, const bf16* KIb, int qb, const float (&wi)[8], unsigned trial) {
    const LAS unsigned char* qiL = F.lds + SEL_QI; LAS int* meta = (LAS int*)(F.lds + SEL_META);
    const int bst = meta[lane & 31]; const unsigned pfx = (unsigned)meta[128 + (lane & 31)];
    unsigned cntl = 0u;
    bf16x8 AA[4], NA[4];
    if (wave <= qb) idx_load_a(KIb, wave, lane, AA);
#pragma unroll 1
    for (int kt = wave; kt <= qb; kt += NWAVES) {
        int lane_t = lane; asm volatile("" : "+v"(lane_t));
        const int hh = lane_t >> 5, q = lane_t & 31, qpos = qb * 32 + q;
        if (kt + NWAVES <= qb) idx_load_a(KIb, kt + NWAVES, lane_t, NA);
        f32x16 scA;
        idx_scores1(AA, qiL, wi, lane_t, scA);
        if (VAR == 2) { asm volatile("" :: "v"(scA[0]), "v"(scA[7]), "v"(scA[15])); } else sel_tile<MODE, VAR>(F, scA, kt, hh, q, qpos, bst, pfx, trial, cntl);
#pragma unroll
        for (int s = 0; s < 4; ++s) AA[s] = NA[s];
    }
    if (MODE == 2) __hip_atomic_fetch_add((LAS unsigned*)meta + 160 + (lane & 31), cntl, __ATOMIC_RELAXED, __HIP_MEMORY_SCOPE_WORKGROUP);
}
template <int VAR>
__device__ __forceinline__ void p3_select(Frame& F) {
    const bf16* QI = (const bf16*)(F.ws + WS_QI); const float* MISC = (const float*)(F.ws + WS_MISC); unsigned* MASK = (unsigned*)(F.ws + WS_MASK);
    LAS unsigned* hist = (LAS unsigned*)(F.lds + SEL_HIST); LAS unsigned* cand = (LAS unsigned*)(F.lds + SEL_CAND); LAS unsigned* maskL = (LAS unsigned*)(F.lds + SEL_MASK); LAS int* meta = (LAS int*)(F.lds + SEL_META);
    const int b = blockIdx.x >> 5, ii = blockIdx.x & 31;
    for (int ui = 0; ui < 2; ++ui) { const int qb = ui ? 63 - ii : ii; const int t0 = b * S_ + qb * 32;
        int tid = F.tid; asm volatile("" : "+v"(tid)); const int lane = tid & 63; int wave = F.wave; asm volatile("" : "+s"(wave));
        if (qb < 8) {
            for (int wd = tid; wd < 2048; wd += 512) { const int q = wd >> 6, w = wd & 63, qpos = qb * 32 + q; const int rel = qpos - 32 * w;
                MASK[(size_t)(t0 + q) * 64 + w] = rel >= 31 ? 0xFFFFFFFFu : (rel < 0 ? 0u : ((2u << rel) - 1u)); }
            continue; }
        __syncthreads();
        for (int c = tid; c < 2048; c += 512) { const int q = c >> 6, c16 = c & 63; *(LAS v4u*)(F.lds + SEL_QI + q * 1024 + ((c16 ^ (q & 15)) << 4)) = *(const GAS v4u*)(QI + (size_t)(t0 + q) * 512 + c16 * 8); }
        { unsigned z = 0u; asm volatile("" : "+v"(z)); const v4u z4 = (v4u){z, z, z, z};
          for (int i = tid; i < 16384 / 4; i += 512) ((LAS v4u*)hist)[i] = z4;
          for (int i = tid; i < 2048 / 4; i += 512) ((LAS v4u*)maskL)[i] = z4; }
        if (tid < 192) meta[tid] = 0;
        float wi[8];
#pragma unroll
        for (int h = 0; h < 8; ++h) wi[h] = MISC[(size_t)(t0 + (lane & 31)) * 256 + 192 + h];
        const bf16* KIb = (const bf16*)(F.ws + WS_KI) + (size_t)b * S_ * 64;
        __syncthreads();
        sel_pass<0, VAR>(F, lane, wave, KIb, qb, wi, 0u);
        __syncthreads();
        for (int qq = 0; qq < 4; ++qq) { const int q = wave * 4 + qq; const LAS unsigned* hq = hist + q * 512; unsigned c8[8]; unsigned cs = 0u;
#pragma unroll
            for (int i = 0; i < 8; ++i) { c8[i] = hq[511 - 8 * lane - i]; cs += c8[i]; }
            unsigned incl = cs;
#pragma unroll
            for (int o = 1; o < 64; o <<= 1) { const unsigned v = __shfl_up(incl, o); if (lane >= o) incl += v; }
            const unsigned excl = incl - cs;
            if (excl < 256u && incl >= 256u) { unsigned run = excl;
#pragma unroll
                for (int i = 0; i < 8; ++i) { const unsigned before = run; run += c8[i]; if (before < 256u && run >= 256u) { meta[q] = 511 - 8 * lane - i; meta[32 + q] = (int)(256u - before); } } } }
        __syncthreads();
        sel_pass<1, VAR>(F, lane, wave, KIb, qb, wi, 0u);
        __syncthreads();
        if (tid < 32) { if (meta[64 + tid] > SEL_CAP) meta[96] = 1; }
        __syncthreads();
        if (meta[96] == 0) {
            for (int item = tid; item < 32 * SEL_CAP; item += 512) { const int q = item >> 7, i = item & (SEL_CAP - 1); const int n = meta[64 + q];
                if (i < n) { const unsigned my = cand[q * SEL_CAP + i]; int rank = 0; for (int j = 0; j < n; ++j) rank += (cand[q * SEL_CAP + j] > my) ? 1 : 0;
                    if (rank < meta[32 + q]) { const int idx = 2047 - (int)(my & 0x7FFu); __hip_atomic_fetch_or(maskL + q * 64 + (idx >> 5), 1u << (idx & 31), __ATOMIC_RELAXED, __HIP_MEMORY_SCOPE_WORKGROUP); } } }
        } else {
#pragma unroll 1
            for (int bit = 31; bit >= 0; --bit) {
                sel_pass<2, VAR>(F, lane, wave, KIb, qb, wi, 1u << bit);
                __syncthreads();
                if (tid < 32) { if ((unsigned)meta[160 + tid] >= 256u) meta[128 + tid] |= (int)(1u << bit); meta[160 + tid] = 0; }
                __syncthreads(); }
            sel_pass<3, VAR>(F, lane, wave, KIb, qb, wi, 0u);
        }
        __syncthreads();
        { const int q = tid >> 4, w4 = (tid & 15) * 4; *(GAS v4u*)(MASK + (size_t)(t0 + q) * 64 + w4) = *(const LAS v4u*)(maskL + q * 64 + w4); }
    }
}
typedef unsigned u32x2v __attribute__((ext_vector_type(2)));
constexpr int ATT_K = 0, ATT_VT = 65536;
__device__ __forceinline__ void att_load(const bf16* CKV, const bf16* CKVT, int b, int j, int tid, v4u (&st)[4]) {
#pragma unroll
    for (int i = 0; i < 2; ++i) { const int c = tid + 512 * i; st[i] = *(const GAS v4u*)(CKV + (size_t)(b * S_ + 64 * j) * 128 + c * 8); }
#pragma unroll
    for (int i = 0; i < 2; ++i) { const int c = tid + 512 * i, d = c >> 3, ch = c & 7; st[2 + i] = *(const GAS v4u*)(CKVT + (size_t)(b * 128 + d) * 2048 + 64 * j + ch * 8); }
}
__device__ __forceinline__ void att_store(LAS unsigned char* lds, int buf, int tid, const v4u (&st)[4]) {
#pragma unroll
    for (int i = 0; i < 2; ++i) { const int c = tid + 512 * i, row = c >> 4, ch = c & 15; *(LAS v4u*)(lds + ATT_K + buf * 16384 + row * 256 + ((ch ^ (row & 15)) << 4)) = st[i]; }
#pragma unroll
    for (int i = 0; i < 2; ++i) { const int c = tid + 512 * i, d = c >> 3, ch = c & 7; *(LAS v4u*)(lds + ATT_VT + buf * 16384 + d * 128 + ((ch ^ ((d >> 1) & 7)) << 4)) = st[2 + i]; }
}
__device__ __forceinline__ void att_tile(const LAS unsigned char* lds, int buf, int j, u32x2v mw, const bf16x8 (&Qf)[8], f32x16 (&O)[4], float& m_run, float& l_run, float slope2, int hh, int q, int qpos) {
    f32x16 S0, S1;
#pragma unroll
    for (int r = 0; r < 16; ++r) { S0[r] = 0.f; S1[r] = 0.f; }
    const LAS unsigned char* kb0 = lds + ATT_K + buf * 16384 + q * 256, * kb1 = kb0 + 32 * 256;
    { bf16x8 Kf[16];
#pragma unroll
      for (int s = 0; s < 8; ++s) { const int sw = ((2 * s + hh) ^ (q & 15)) << 4; Kf[2 * s] = *(const LAS bf16x8*)(kb0 + sw); Kf[2 * s + 1] = *(const LAS bf16x8*)(kb1 + sw); }
#pragma unroll
      for (int s = 0; s < 8; ++s) { S0 = MFMA32(Kf[2 * s], Qf[s], S0); S1 = MFMA32(Kf[2 * s + 1], Qf[s], S1); }
      __builtin_amdgcn_sched_group_barrier(0x100, 4, 0);
#pragma unroll
      for (int i = 0; i < 6; ++i) { __builtin_amdgcn_sched_group_barrier(0x008, 2, 0); __builtin_amdgcn_sched_group_barrier(0x100, 2, 0); }
      __builtin_amdgcn_sched_group_barrier(0x008, 4, 0); }
    const LAS unsigned char* vb = lds + ATT_VT + buf * 16384;
    const unsigned mlo = mw.x >> (4 * hh), mhi = mw.y >> (4 * hh);
    const float base0 = slope2 * (float)(64 * j + 4 * hh - qpos);
    float tmax = -INFINITY;
#pragma unroll
    for (int r = 0; r < 16; ++r) { const int kr = (r & 3) + 8 * (r >> 2);
        float s0 = S0[r] + (base0 + slope2 * (float)kr), s1 = S1[r] + (base0 + slope2 * (float)(kr + 32));
        s0 = ((mlo >> kr) & 1u) ? s0 : -INFINITY; s1 = ((mhi >> kr) & 1u) ? s1 : -INFINITY;
        S0[r] = s0; S1[r] = s1; tmax = fmaxf(tmax, fmaxf(s0, s1)); }
    { const auto rr = __builtin_amdgcn_permlane32_swap(__float_as_uint(tmax), __float_as_uint(tmax), false, false); tmax = fmaxf(__uint_as_float(rr[0]), __uint_as_float(rr[1])); }
    const float m_new = fmaxf(m_run, tmax), msafe = (m_new == -INFINITY) ? 0.f : m_new;
    const float alpha = __builtin_amdgcn_exp2f(m_run - msafe);
    float ps = 0.f;
#pragma unroll
    for (int r = 0; r < 16; ++r) { S0[r] = __builtin_amdgcn_exp2f(S0[r] - msafe); S1[r] = __builtin_amdgcn_exp2f(S1[r] - msafe); ps += S0[r] + S1[r]; }
    l_run = l_run * alpha + ps; m_run = m_new;
    if (__any(alpha != 1.f)) {
#pragma unroll
        for (int db = 0; db < 4; ++db)
#pragma unroll
            for (int r = 0; r < 16; ++r) O[db][r] *= alpha; }
    bf16x8 Pf[4];
    Pf[0] = pack8(S0[0], S0[1], S0[2], S0[3], S0[4], S0[5], S0[6], S0[7]); Pf[1] = pack8(S0[8], S0[9], S0[10], S0[11], S0[12], S0[13], S0[14], S0[15]);
    Pf[2] = pack8(S1[0], S1[1], S1[2], S1[3], S1[4], S1[5], S1[6], S1[7]); Pf[3] = pack8(S1[8], S1[9], S1[10], S1[11], S1[12], S1[13], S1[14], S1[15]);
    { bf16x8 Vf[16];
#pragma unroll
      for (int db = 0; db < 4; ++db) { const int d = db * 32 + q; const LAS unsigned char* vr = vb + d * 128; const int sx = (d >> 1) & 7;
#pragma unroll
          for (int c2 = 0; c2 < 4; ++c2) Vf[db * 4 + c2] = *(const LAS bf16x8*)(vr + (((c2 * 2 + hh) ^ sx) << 4)); }
#pragma unroll
      for (int db = 0; db < 4; ++db)
#pragma unroll
          for (int c2 = 0; c2 < 4; ++c2) O[db] = MFMA32(Vf[db * 4 + c2], Pf[c2], O[db]);
      __builtin_amdgcn_sched_group_barrier(0x100, 4, 0);
#pragma unroll
      for (int i = 0; i < 6; ++i) { __builtin_amdgcn_sched_group_barrier(0x008, 2, 0); __builtin_amdgcn_sched_group_barrier(0x100, 2, 0); }
      __builtin_amdgcn_sched_group_barrier(0x008, 4, 0); }
}
__device__ __forceinline__ void p4_attention(Frame& F) {
    const bf16* QL = (const bf16*)(F.ws + WS_QL); const bf16* CKV = (const bf16*)(F.ws + WS_CKV); const bf16* CKVT = (const bf16*)(F.ws + WS_CKVT);
    const unsigned* MASK = (const unsigned*)(F.ws + WS_MASK); bf16* OLAT = (bf16*)(F.ws + WS_OLAT);
    const int b = blockIdx.x >> 5, ii = blockIdx.x & 31;
    for (int ui = 0; ui < 2; ++ui) { const int qb = ui ? 63 - ii : ii;
        int lane; asm volatile("v_mbcnt_lo_u32_b32 %0, -1, 0\n\tv_mbcnt_hi_u32_b32 %0, -1, %0" : "=v"(lane)); int head = F.wave; asm volatile("" : "+s"(head)); const int tid = head * 64 + lane;
        const int hh = lane >> 5, q = lane & 31; const float slope2 = __builtin_amdgcn_exp2f(-(float)(head + 1)) * LOG2E;
        const int t0 = b * S_ + qb * 32, qpos = qb * 32 + q; const int nt = (qb >> 1) + 1;
        bf16x8 Qf[8];
#pragma unroll
        for (int s = 0; s < 8; ++s) Qf[s] = *(const GAS bf16x8*)(QL + (size_t)(t0 + q) * 1024 + head * 128 + 16 * s + 8 * hh);
#pragma unroll
        for (int s = 0; s < 8; ++s) asm volatile("" : "+v"(Qf[s]));
        f32x16 O[4];
#pragma unroll
        for (int db = 0; db < 4; ++db)
#pragma unroll
            for (int r = 0; r < 16; ++r) O[db][r] = 0.f;
        float m_run = -INFINITY, l_run = 0.f;
        v4u st[4];
        __syncthreads();
        att_load(CKV, CKVT, b, 0, tid, st); att_store(F.lds, 0, tid, st);
        att_load(CKV, CKVT, b, nt > 1 ? 1 : 0, tid, st); att_store(F.lds, 1, tid, st);
        __syncthreads();
        const unsigned* mrow = MASK + (size_t)(t0 + q) * 64;
        for (int j0 = 0; j0 < nt; j0 += 2) { const int j1 = j0 + 1; const bool has1 = j1 < nt; const int last = nt - 1;
            const u32x2v mw0 = *(const GAS u32x2v*)(mrow + 2 * j0);
            __builtin_amdgcn_sched_barrier(0);
            att_load(CKV, CKVT, b, (j0 + 2 < nt) ? j0 + 2 : last, tid, st);
            __builtin_amdgcn_sched_barrier(0);
            att_tile(F.lds, j0 & 3, j0, mw0, Qf, O, m_run, l_run, slope2, hh, q, qpos);
            att_store(F.lds, (j0 + 2) & 3, tid, st);
            const u32x2v mw1 = *(const GAS u32x2v*)(mrow + 2 * (has1 ? j1 : j0));
            __builtin_amdgcn_sched_barrier(0);
            att_load(CKV, CKVT, b, (j0 + 3 < nt) ? j0 + 3 : last, tid, st);
            __builtin_amdgcn_sched_barrier(0);
            if (has1) att_tile(F.lds, j1 & 3, j1, mw1, Qf, O, m_run, l_run, slope2, hh, q, qpos);
            att_store(F.lds, (j0 + 3) & 3, tid, st);
            __syncthreads();
        }
        float lt; { const auto rr = __builtin_amdgcn_permlane32_swap(__float_as_uint(l_run), __float_as_uint(l_run), false, false); lt = __uint_as_float(rr[0]) + __uint_as_float(rr[1]); }
        const float inv = 1.f / lt;
        int l2; asm volatile("v_mbcnt_lo_u32_b32 %0, -1, 0\n\tv_mbcnt_hi_u32_b32 %0, -1, %0" : "=v"(l2));
        bf16* orow = OLAT + (size_t)(t0 + (l2 & 31)) * 1024 + head * 128 + 4 * (l2 >> 5);
#pragma unroll
        for (int db = 0; db < 4; ++db)
#pragma unroll
            for (int g = 0; g < 4; ++g) { const unsigned lo = pkbf(O[db][4 * g] * inv, O[db][4 * g + 1] * inv), hi = pkbf(O[db][4 * g + 2] * inv, O[db][4 * g + 3] * inv);
                *(GAS unsigned long long*)(orow + db * 32 + 8 * g) = (unsigned long long)lo | ((unsigned long long)hi << 32); }
    }
}
struct Args { const float* in[23]; float* out; unsigned char* ws; int ph_lo, ph_hi; };
__global__ void __launch_bounds__(NWAVES * 64, 2) mk_fwd(Args args) {
    extern __shared__ __attribute__((aligned(16))) unsigned char lds[];
    Frame F;
    F.lds = (LAS unsigned char*)lds;
    F.MISCW = (volatile LAS unsigned*)(F.lds + MISC_OFF);
    F.tid = threadIdx.x; F.lane = F.tid & 63; F.wave = __builtin_amdgcn_readfirstlane(F.tid >> 6);
    F.G = gridDim.x; { const int bx = blockIdx.x; F.vcu = (F.G % 8 == 0) ? (bx % 8) * (F.G / 8) + bx / 8 : bx; }
    F.ws = args.ws; F.ctl = (gu32*)(args.ws + WS_CTL); F.out = args.out;
    for (int u = F.tid; u < (LDS_BYTES - LDSCTL_OFF) / 4; u += NWAVES * 64) ((LAS unsigned*)(F.lds + LDSCTL_OFF))[u] = 0u;
    __syncthreads();
    const int lo = args.ph_lo, hi = args.ph_hi;
#define IN(k) (lo <= (k) && (k) < hi)
#define REID() do { int l_; asm volatile("v_mbcnt_lo_u32_b32 %0, -1, 0\n\tv_mbcnt_hi_u32_b32 %0, -1, %0" : "=v"(l_)); F.lane = l_; F.tid = F.wave * 64 + l_; } while (0)
#define SEAM(k) do { if (IN(k) && IN((k) + 1)) { REID(); xcd_barrier(bar, F.wave == 0 && F.lane == 0); } } while (0)
#ifndef PROBE_MASK
#define PROBE_MASK 0
#endif
#define PHASE(k, BODY) do { if (IN(k)) { if ((PROBE_MASK >> (k)) & 1) { REID(); BODY; REID(); xcd_barrier(bar, F.wave == 0 && F.lane == 0); } REID(); BODY; } SEAM(k); } while (0)
#define BODY0 { p0_prologue<0>(F); }
#define BODY1 { p1_modulate(F); }
#define BODY2 { pg8::Gemm g{(const pg8::bf16_t*)(F.ws + WS_H), (const pg8::bf16_t*)(F.ws + WS_WIN), T, NIN, D}; pg8::StaticOrder S; S.init(T, NIN, F.G, (int)blockIdx.x); \
        pg8::EpiInProj E{(pg8::bf16_t*)(F.ws + WS_QL), (pg8::bf16_t*)(F.ws + WS_QI), (pg8::bf16_t*)(F.ws + WS_U), (pg8::bf16_t*)(F.ws + WS_SG), (float*)(F.ws + WS_MISC), (pg8::bf16_t*)(F.ws + WS_KI)}; \
        pg8::gemm_phase<pg8::EpiInProj, pg8::StaticOrder, PG8_ALIGN, PG8_SP2>(F.lds + RING_OFF, g, S, E, F.wave); }
#define BODY3 { p3_post(F); __syncthreads(); p3_select<0>(F); }
#ifndef SELVAR
#define SELVAR 0
#endif
#ifdef PROBE_POST
#define BODY3V { p3_post(F); }
#else
#define BODY3V { p3_select<SELVAR>(F); }
#endif
#define BODY4 { p4_attention(F); }
#define BODY5 { { pg8::Gemm g{(const pg8::bf16_t*)(F.ws + WS_OLAT), (const pg8::bf16_t*)(F.ws + WS_WOA), T, D, 1024}; pg8::StaticOrder S; S.init(T, D, F.G, (int)blockIdx.x); \
          pg8::EpiGateMul E{(pg8::bf16_t*)(F.ws + WS_TMP), (const pg8::bf16_t*)(F.ws + WS_SG), 0, 0}; \
          pg8::gemm_phase<pg8::EpiGateMul, pg8::StaticOrder, PG8_ALIGN, PG8_SP2>(F.lds + RING_OFF, g, S, E, F.wave); } \
        { pg8::Gemm g{(const pg8::bf16_t*)(F.ws + WS_POOLED), (const pg8::bf16_t*)(F.ws + WS_WPB), T, D, 512}; pg8::StaticOrder S; S.init(T, D, F.G, (int)blockIdx.x); \
          pg8::EpiGateAdd E{(pg8::bf16_t*)(F.ws + WS_MIX), (const pg8::bf16_t*)(F.ws + WS_TMP), (const pg8::bf16_t*)(F.ws + WS_SG), 1024, 0}; \
          pg8::gemm_phase<pg8::EpiGateAdd, pg8::StaticOrder, PG8_ALIGN, PG8_SP2>(F.lds + RING_OFF, g, S, E, F.wave); } }
#define BODY6 { pg8::Gemm g{(const pg8::bf16_t*)(F.ws + WS_MIX), (const pg8::bf16_t*)(F.ws + WS_WOUT), T, D, 1024}; pg8::StaticOrder S; S.init(T, D, F.G, (int)blockIdx.x); \
        pg8::EpiResid E{(float*)(F.ws + WS_Z), frame_in(0), (const float*)(F.ws + WS_MOD) + 2 * 1024}; \
        pg8::gemm_phase<pg8::EpiResid, pg8::StaticOrder, PG8_ALIGN, PG8_SP2>(F.lds + RING_OFF, g, S, E, F.wave); }
#define BODY7 { p7_ln1_route(F, CW_GCNT); }
#define BODY7DRY { p7_ln1_route(F, 128); }
#define BODY9 { load_tstart(F); \
        pg8::MoeOrderG S{(const LAS int*)(F.lds + LC_TSTART), 8, F.G, (int)blockIdx.x, (const LAS int*)(F.lds + LC_ROWTAB), (const int*)(F.ws + WS_SLOTMAP), (const int*)(F.ctl + CW_GCNT)}; \
        moe_fill_rowtab(F, S); \
        pg8::Gemm g{(const pg8::bf16_t*)(F.ws + WS_H), (const pg8::bf16_t*)(F.ws + WS_WGU), T, 32 * 2048, 1024}; \
        pg8::EpiSwiglu E{(pg8::bf16_t*)(F.ws + WS_ACT), frame_in(18)}; \
        pg8::gemm_phase<pg8::EpiSwiglu, pg8::MoeOrderG, PG8_ALIGN, PG8_SP2>(F.lds + RING_OFF, g, S, E, F.wave); }
#define BODY10 { load_tstart(F); \
        pg8::Gemm g{(const pg8::bf16_t*)(F.ws + WS_ACT), (const pg8::bf16_t*)(F.ws + WS_WD), MAXROWS, 32 * 1024, 1024}; \
        pg8::MoeOrder S{(const LAS int*)(F.lds + LC_TSTART), 4, F.G, (int)blockIdx.x, nullptr, nullptr, nullptr}; \
        pg8::EpiDown E{(pg8::bf16_t*)(F.ws + WS_Y), frame_in(20)}; \
        pg8::gemm_phase<pg8::EpiDown, pg8::MoeOrder, PG8_ALIGN, PG8_SP2>(F.lds + RING_OFF, g, S, E, F.wave); }
#define BODY10V { load_tstart(F); \
        pg8::Gemm g{(const pg8::bf16_t*)(F.ws + WS_ACT), (const pg8::bf16_t*)(F.ws + WS_WD), MAXROWS, 32 * 1024, 1024}; \
        pg8::MoeOrder S{(const LAS int*)(F.lds + LC_TSTART), 4, F.G, (int)blockIdx.x, nullptr, nullptr, nullptr}; \
        pg8::EpiDownT<false> E{(pg8::bf16_t*)(F.ws + WS_Y), frame_in(20)}; \
        pg8::gemm_phase<pg8::EpiDownT<false>, pg8::MoeOrder, PG8_ALIGN, PG8_SP2>(F.lds + RING_OFF, g, S, E, F.wave); }
#define BODY10X { pg8::Gemm g{(const pg8::bf16_t*)(F.ws + WS_ACT), (const pg8::bf16_t*)(F.ws + WS_WD), 272 * 256, 1024, 1024}; pg8::StaticOrder S; S.init(272 * 256, 1024, F.G, (int)blockIdx.x); \
        pg8::EpiDownT<false> E{(pg8::bf16_t*)(F.ws + WS_Y), frame_in(20)}; \
        pg8::gemm_phase<pg8::EpiDownT<false>, pg8::StaticOrder, PG8_ALIGN, PG8_SP2>(F.lds + RING_OFF, g, S, E, F.wave); }
#define BODY11 { p11_final(F); }
    XcdBarrier bar; bar.bar = (unsigned*)(F.ctl + CW_BAR); bar.x = 0; bar.st = nullptr;
    if (hi - lo > 1) bar = xcd_barrier_post((unsigned*)(F.ctl + CW_BAR), F.MISCW + 8, F.tid == 0);
#ifdef PROBE_P0SMALL
    if (IN(0)) { REID(); p0_prologue<PROBE_P0SMALL>(F); REID(); xcd_barrier(bar, F.wave == 0 && F.lane == 0); REID(); BODY0; } SEAM(0);
#else
    PHASE(0, BODY0);
#endif
    PHASE(1, BODY1); PHASE(2, BODY2);
    if (IN(3)) { if ((PROBE_MASK >> 3) & 1) { REID(); BODY3V; REID(); xcd_barrier(bar, F.wave == 0 && F.lane == 0); } REID(); BODY3; } SEAM(3);
    PHASE(4, BODY4); PHASE(5, BODY5);
    PHASE(6, BODY6);
    if (IN(7)) { if ((PROBE_MASK >> 7) & 1) { REID(); BODY7DRY; REID(); xcd_barrier(bar, F.wave == 0 && F.lane == 0); } REID(); BODY7; } SEAM(7);
    PHASE(9, BODY9);
#ifdef PROBE_STATIC10
    if (IN(10)) { REID(); BODY10X; REID(); xcd_barrier(bar, F.wave == 0 && F.lane == 0); REID(); BODY10; } SEAM(10);
#elif defined(PROBE_NOBIAS)
    if (IN(10)) { REID(); BODY10V; REID(); xcd_barrier(bar, F.wave == 0 && F.lane == 0); REID(); BODY10; } SEAM(10);
#else
    PHASE(10, BODY10);
#endif
    if (IN(11)) { if ((PROBE_MASK >> 11) & 1) { REID(); BODY11; REID(); xcd_barrier(bar, F.wave == 0 && F.lane == 0); } REID(); BODY11; }
#undef IN
#undef SEAM
}

static void launch_mk(const Args& a0, int lo, int hi, int grid, hipStream_t stream) {
    Args a = a0; a.ph_lo = lo; a.ph_hi = hi;
    hipLaunchKernelGGL(mk_fwd, dim3(grid), dim3(NWAVES * 64), LDS_BYTES, stream, a);
}
extern "C" void kernel_launch(void* const* d_in, const int* in_sizes, int n_in, void* d_out, int out_size, void* d_ws, size_t ws_size, hipStream_t stream) {
    static int grid = 0;
    if (grid == 0) {
        if (n_in != 23 || ws_size < WS_END) { fprintf(stderr, "kernel_launch: unexpected n_in %d / ws %zu\n", n_in, ws_size); grid = -1; return; }
        int dev = 0, cus = 0;
        if (hipGetDevice(&dev) != hipSuccess || hipDeviceGetAttribute(&cus, hipDeviceAttributeMultiprocessorCount, dev) != hipSuccess) { grid = -1; return; }
        if (hipFuncSetAttribute((const void*)mk_fwd, hipFuncAttributeMaxDynamicSharedMemorySize, LDS_BYTES) != hipSuccess) { fprintf(stderr, "hipFuncSetAttribute failed\n"); grid = -1; return; }
        grid = cus;
        if (grid != 256) { fprintf(stderr, "kernel_launch: built for 256 CUs, found %d\n", cus); grid = -1; return; }
    }
    if (grid < 0) return;
    unsigned char* ws = (unsigned char*)d_ws;
    (void)hipMemsetAsync(ws + WS_CTL, 0, CTL_ZERO_BYTES, stream);
    Args a{};
    for (int i = 0; i < 23; ++i) a.in[i] = (const float*)d_in[i];
    a.out = (float*)d_out; a.ws = ws;
    launch_mk(a, 0, 12, grid, stream);
}
```

```cpp
#include <hip/hip_runtime.h>
#include <cstdio>
#include <cstdint>
namespace pg8 {
#define PG8_LAS __attribute__((address_space(3)))
typedef unsigned short bf16_t;
typedef short bf16x8 __attribute__((ext_vector_type(8)));
typedef float f32x4 __attribute__((ext_vector_type(4)));
typedef unsigned u32x4 __attribute__((ext_vector_type(4)));
constexpr int BM = 256, BK = 64, HALF = 128, HTB = HALF * BK * 2  , STAGE_BYTES = 8 * HTB, NXCD = 8, WGM = 8;

__host__ __device__ __forceinline__ int lds_byte(int r, int c) { const int st = (r >> 4) * 2 + (c >> 5), rr = r & 15, cc = c & 31, ob = rr * 64 + cc * 2; return st * 1024 + (ob ^ (((ob >> 9) & 1) << 5)); }
__host__ __device__ __forceinline__ void stage_rc(int b, int& R, int& C) { const int st = b / 1024, sb = b % 1024, swz = sb ^ (((sb >> 9) & 1) << 5); R = (st >> 1) * 16 + swz / 64; C = (st & 1) * 32 + (swz % 64) / 2; }
__host__ __device__ __forceinline__ int perm32(int rho) { const int n = rho >> 4, i = rho & 15; return 8 * (i >> 2) + 4 * n + (i & 3); }

struct Unit { int pm, pn; };
struct Gemm { const bf16_t* A; const bf16_t* Bt; int M, N, K; };

struct StaticOrder {
    static constexpr bool GATHER = false;
    int nM, nN, nwg, G, c;
    __host__ __device__ void init(int M, int N, int G_, int c_) { nM = M / BM; nN = N / BM; nwg = nM * nN; G = G_; c = c_; }
    __host__ __device__ bool next(int i, Unit& u) const {
        const long L = (long)i * G + c; if (L >= nwg) return false;
        int wgid = (int)L; { const int q = nwg / NXCD, r = nwg % NXCD, xcd = wgid % NXCD, off = wgid / NXCD; wgid = (xcd < r ? xcd * (q + 1) : r * (q + 1) + (xcd - r) * q) + off; }
        const int nig = WGM * nN, gid = wgid / nig, fm = gid * WGM, gsz = (nM - fm) < WGM ? (nM - fm) : WGM;
        u.pm = fm + ((wgid % nig) % gsz); u.pn = (wgid % nig) / gsz; return true;
    }
    __device__ __forceinline__ void a_ready(const Unit&) const {}
    __device__ __forceinline__ void done(const Unit&) const {}
};

__device__ __forceinline__ unsigned cvt_pk_bf16(float lo, float hi) { unsigned r; asm volatile("v_cvt_pk_bf16_f32 %0, %1, %2" : "=v"(r) : "v"(lo), "v"(hi)); return r; }
typedef float f32x2 __attribute__((ext_vector_type(2)));
__device__ __forceinline__ f32x2 gelu_pk(f32x2 v) {
    const f32x2 av = __builtin_elementwise_abs(v), d = av * 0.2316418882f + 1.0f;
    f32x2 t; t.x = __builtin_amdgcn_rcpf(d.x); t.y = __builtin_amdgcn_rcpf(d.y);
    f32x2 q = t * 0.5307027145f + (-0.7265760135f); q = q * t + 0.7107068705f; q = q * t + (-0.142248368f); q = q * t + 0.127414796f; q = q * t;
    const f32x2 s = (v * v) * (-0.72134752044f);
    f32x2 e; e.x = __builtin_amdgcn_exp2f(s.x); e.y = __builtin_amdgcn_exp2f(s.y);
    const f32x2 m = v * (q * e), r = v - m;
    f32x2 o; o.x = v.x < 0.f ? m.x : r.x; o.y = v.y < 0.f ? m.y : r.y; return o;
}

template <int ACT  > struct EpiBf16 {
    static constexpr bool PERM = true, AFTER_DRAIN = false; static_assert(ACT == 0 || ACT == 1, "EpiBf16: ACT is 0 (none) or 1 (gelu_pk)");
    bf16_t* O; int ldc; const float* bias; int split_cols; size_t split_stride; float scale0;
    __device__ __forceinline__ void operator()(const f32x4 (&acc)[2][2][4][2], const Unit& u, int wr, int wc, int fr, int fq) const {
        const int row0 = u.pm * BM + wr * 64 + fr; int colt = u.pn * BM; bf16_t* base = O;
        float sc = 1.f; if (split_cols) { const int t = colt / split_cols; base += (size_t)t * split_stride; colt -= t * split_cols; if (t == 0) sc = scale0; }
        const int col0 = colt + wc * 32 + 8 * fq, bcol0 = u.pn * BM + wc * 32 + 8 * fq;
        f32x4 bv[2][2];
#pragma unroll
        for (int bj = 0; bj < 2; ++bj)
#pragma unroll
            for (int n = 0; n < 2; ++n) bv[bj][n] = bias ? *(const f32x4*)(bias + bcol0 + bj * HALF + 4 * n) : (f32x4){0.f, 0.f, 0.f, 0.f};
#pragma unroll
        for (int ai = 0; ai < 2; ++ai)
#pragma unroll
            for (int m = 0; m < 4; ++m) { bf16_t* rowp = base + (size_t)(row0 + ai * HALF + m * 16) * ldc + col0;
#pragma unroll
                for (int bj = 0; bj < 2; ++bj) { f32x4 v0 = acc[ai][bj][m][0] + bv[bj][0], v1 = acc[ai][bj][m][1] + bv[bj][1];
                    if (ACT == 1) { f32x2 a = gelu_pk((f32x2){v0[0], v0[1]}), b = gelu_pk((f32x2){v0[2], v0[3]}), c = gelu_pk((f32x2){v1[0], v1[1]}), d = gelu_pk((f32x2){v1[2], v1[3]});
                        v0 = (f32x4){a.x, a.y, b.x, b.y}; v1 = (f32x4){c.x, c.y, d.x, d.y}; }
                    v0 = v0 * sc; v1 = v1 * sc; u32x4 w; w.x = cvt_pk_bf16(v0[0], v0[1]); w.y = cvt_pk_bf16(v0[2], v0[3]); w.z = cvt_pk_bf16(v1[0], v1[1]); w.w = cvt_pk_bf16(v1[2], v1[3]);
                    *(u32x4*)(rowp + bj * HALF) = w; } }
    }
};

struct PanelStats {
    unsigned* xbuf;
    unsigned* cnt;
    unsigned* tmo;
    int ntn; float eps;
    unsigned code;
    __device__ __forceinline__ bool run(const f32x4 (&v)[2][2][4][2], const Unit& u, int wr, int wc, int fr, int fq, PG8_LAS unsigned char* lds, int wid, int lane) const {
        typedef float f32x2v __attribute__((ext_vector_type(2)));
        PG8_LAS f32x2v* P = (PG8_LAS f32x2v*)lds;
        PG8_LAS f32x2v* S = (PG8_LAS f32x2v*)(lds + 8192);
        PG8_LAS unsigned* flag = (PG8_LAS unsigned*)(lds + 8192 + 2048);
#pragma unroll
        for (int ai = 0; ai < 2; ++ai)
#pragma unroll
            for (int m = 0; m < 4; ++m) {
                float s = 0.f;
#pragma unroll
                for (int bj = 0; bj < 2; ++bj)
#pragma unroll
                    for (int n = 0; n < 2; ++n) { const f32x4 x = v[ai][bj][m][n]; s += (x[0] + x[1]) + (x[2] + x[3]); }
                s += __shfl_xor(s, 16); s += __shfl_xor(s, 32);
                const float mw = s * (1.0f / 64.0f); float q = 0.f;
#pragma unroll
                for (int bj = 0; bj < 2; ++bj)
#pragma unroll
                    for (int n = 0; n < 2; ++n) { const f32x4 d = v[ai][bj][m][n] - mw; q += (d[0] * d[0] + d[1] * d[1]) + (d[2] * d[2] + d[3] * d[3]); }
                q += __shfl_xor(q, 16); q += __shfl_xor(q, 32);
                if (fq == 0) P[(ai * HALF + wr * 64 + m * 16 + fr) * 4 + wc] = (f32x2v){mw, q};
            }
        asm volatile("s_waitcnt lgkmcnt(0)" ::: "memory"); __builtin_amdgcn_s_barrier(); asm volatile("" ::: "memory");
#if defined(BROKEN_EXCHANGE_NO_WAIT)
#warning BROKEN CONTROL BUILD: the row-statistics exchange does not wait; results are wrong by design
        if (blockIdx.x >= 64) { const long long t0_ = clock64(); while (clock64() - t0_ < 60000) __builtin_amdgcn_s_sleep(8); }
#endif
        const int row = wid * 32 + (lane & 31);
        if (lane < 32) {
            const f32x2v a = P[row * 4 + 0], b = P[row * 4 + 1], c = P[row * 4 + 2], d = P[row * 4 + 3];
            const float mt = (a.x + b.x + c.x + d.x) * 0.25f;
            const float da = a.x - mt, db = b.x - mt, dc = c.x - mt, dd = d.x - mt;
            const float m2 = (a.y + b.y) + (c.y + d.y) + 64.0f * ((da * da + db * db) + (dc * dc + dd * dd));
            unsigned long long* slot = (unsigned long long*)xbuf + ((size_t)(u.pm * BM + row) * 4 + u.pn);
            __hip_atomic_store(slot, ((unsigned long long)__float_as_uint(m2) << 32) | __float_as_uint(mt), __ATOMIC_RELAXED, __HIP_MEMORY_SCOPE_AGENT);
        }
        asm volatile("s_waitcnt vmcnt(0)" ::: "memory");
        if (lane == 0) __hip_atomic_fetch_add(cnt + 64 * u.pm, 1u, __ATOMIC_RELAXED, __HIP_MEMORY_SCOPE_AGENT);
        if (wid == 0) {
            bool dead = false; const unsigned long long t0 = __builtin_amdgcn_s_memrealtime(); const unsigned want = 8u * (unsigned)ntn;
            for (;;) {
#if defined(BROKEN_EXCHANGE_NO_WAIT)
                break;
#endif
                if ((unsigned)__builtin_amdgcn_readfirstlane(__hip_atomic_load(cnt + 64 * u.pm, __ATOMIC_RELAXED, __HIP_MEMORY_SCOPE_AGENT)) >= want) break;
                if (__builtin_amdgcn_s_memrealtime() - t0 > 2000000ull) {
                    if (lane == 0) { unsigned expect = 0u; __hip_atomic_compare_exchange_strong(tmo + 1, &expect, code | (unsigned)(u.pm & 0xff), __ATOMIC_RELAXED, __ATOMIC_RELAXED, __HIP_MEMORY_SCOPE_AGENT);
                                     __hip_atomic_store(tmo, 1u, __ATOMIC_RELAXED, __HIP_MEMORY_SCOPE_AGENT); }
                    dead = true; break; }
                __builtin_amdgcn_s_sleep(2);
            }
            __builtin_amdgcn_fence(__ATOMIC_ACQUIRE, "agent");
            if (lane == 0) flag[0] = dead ? 1u : 0u;
        }
        asm volatile("s_waitcnt vmcnt(0) lgkmcnt(0)" ::: "memory"); __builtin_amdgcn_s_barrier(); asm volatile("" ::: "memory");
        const bool bad = flag[0] != 0u;
        if (lane < 32) {
            const unsigned long long* slot = (const unsigned long long*)xbuf + (size_t)(u.pm * BM + row) * 4; float mt[4], m2[4]; float ms = 0.f;
#pragma unroll
            for (int t = 0; t < 4; ++t) { if (t < ntn) { const unsigned long long w = __hip_atomic_load(slot + t, __ATOMIC_RELAXED, __HIP_MEMORY_SCOPE_AGENT); mt[t] = __uint_as_float((unsigned)w); m2[t] = __uint_as_float((unsigned)(w >> 32)); } else { mt[t] = 0.f; m2[t] = 0.f; } ms += mt[t]; }
            const float mean = ms / (float)ntn; float q = 0.f;
#pragma unroll
            for (int t = 0; t < 4; ++t) if (t < ntn) { const float dm = mt[t] - mean; q += m2[t] + 256.0f * dm * dm; }
            S[row] = (f32x2v){mean, 1.0f / sqrtf(q / (256.0f * (float)ntn) + eps)};
        }
        asm volatile("s_waitcnt lgkmcnt(0)" ::: "memory"); __builtin_amdgcn_s_barrier(); asm volatile("" ::: "memory");
        return bad;
    }
};
struct EpiLnRes {
    static constexpr bool PERM = false, AFTER_DRAIN = true;
    const float* base; float* out; int ldc; const float* bias; PanelStats st; unsigned poison;
    __device__ __forceinline__ void fused(f32x4 (&acc)[2][2][4][2], const Unit& u, int wr, int wc, int fr, int fq, PG8_LAS unsigned char* lds, int wid, int lane) const {
        typedef float f32x2v __attribute__((ext_vector_type(2)));
        const PG8_LAS f32x2v* S = (const PG8_LAS f32x2v*)(lds + 8192);
        const int col0 = u.pn * BM + wc * 32 + 4 * fq;
#pragma unroll
        for (int bj = 0; bj < 2; ++bj)
#pragma unroll
            for (int n = 0; n < 2; ++n) { const f32x4 bv = bias ? *(const f32x4*)(bias + col0 + bj * HALF + n * 16) : (f32x4){0.f, 0.f, 0.f, 0.f};
#pragma unroll
                for (int ai = 0; ai < 2; ++ai)
#pragma unroll
                    for (int m = 0; m < 4; ++m) acc[ai][bj][m][n] += bv; }
        f32x4 pre[4][2][2];
#pragma unroll
        for (int m = 0; m < 4; ++m) { const size_t off = (size_t)(u.pm * BM + wr * 64 + m * 16 + fr) * ldc + col0;
#pragma unroll
            for (int bj = 0; bj < 2; ++bj)
#pragma unroll
                for (int n = 0; n < 2; ++n) pre[m][bj][n] = *(const f32x4*)(base + off + bj * HALF + n * 16); }
        const bool bad = st.run(acc, u, wr, wc, fr, fq, lds, wid, lane) || poison != 0u;
        const float qnan = __builtin_nanf("");
#pragma unroll
        for (int ai = 0; ai < 2; ++ai)
#pragma unroll
            for (int m = 0; m < 4; ++m) { const int r = ai * HALF + wr * 64 + m * 16 + fr; const f32x2v sr = S[r]; const size_t off = (size_t)(u.pm * BM + r) * ldc + col0;
#pragma unroll
                for (int bj = 0; bj < 2; ++bj)
#pragma unroll
                    for (int n = 0; n < 2; ++n) { const f32x4 bs = ai == 0 ? pre[m][bj][n] : *(const f32x4*)(base + off + bj * HALF + n * 16); f32x4 o = bs + (acc[ai][bj][m][n] - sr.x) * sr.y;
                        if (bad) o = (f32x4){qnan, qnan, qnan, qnan}; *(f32x4*)(out + off + bj * HALF + n * 16) = o; }
                if (m & 1) asm volatile("" ::: "memory"); }
    }
};
struct EpiLnResLn {
    static constexpr bool PERM = false, AFTER_DRAIN = true;
    const float* base; float* out; bf16_t* xn; int ldc; const float* bias; PanelStats st1, st2; unsigned poison;
    __device__ __forceinline__ void fused(f32x4 (&acc)[2][2][4][2], const Unit& u, int wr, int wc, int fr, int fq, PG8_LAS unsigned char* lds, int wid, int lane) const {
        typedef float f32x2v __attribute__((ext_vector_type(2))); typedef unsigned u32x2v __attribute__((ext_vector_type(2)));
        const PG8_LAS f32x2v* S = (const PG8_LAS f32x2v*)(lds + 8192);
        const int col0 = u.pn * BM + wc * 32 + 4 * fq;
#pragma unroll
        for (int bj = 0; bj < 2; ++bj)
#pragma unroll
            for (int n = 0; n < 2; ++n) { const f32x4 bv = bias ? *(const f32x4*)(bias + col0 + bj * HALF + n * 16) : (f32x4){0.f, 0.f, 0.f, 0.f};
#pragma unroll
                for (int ai = 0; ai < 2; ++ai)
#pragma unroll
                    for (int m = 0; m < 4; ++m) acc[ai][bj][m][n] += bv; }
        bool bad = st1.run(acc, u, wr, wc, fr, fq, lds, wid, lane) || poison != 0u;
        const float qnan = __builtin_nanf("");
#pragma unroll
        for (int ai = 0; ai < 2; ++ai)
#pragma unroll
            for (int m = 0; m < 4; ++m) { const int r = ai * HALF + wr * 64 + m * 16 + fr; const f32x2v sr = S[r]; const size_t off = (size_t)(u.pm * BM + r) * ldc + col0;
#pragma unroll
                for (int bj = 0; bj < 2; ++bj)
#pragma unroll
                    for (int n = 0; n < 2; ++n) { const f32x4 bs = *(const f32x4*)(base + off + bj * HALF + n * 16); acc[ai][bj][m][n] = bs + (acc[ai][bj][m][n] - sr.x) * sr.y; }
                asm volatile("" : "+v"(acc[ai][0][m][0]), "+v"(acc[ai][0][m][1]), "+v"(acc[ai][1][m][0]), "+v"(acc[ai][1][m][1]));
                if (m & 1) asm volatile("" ::: "memory"); }
        const bool bad1 = bad;
        bad = st2.run(acc, u, wr, wc, fr, fq, lds, wid, lane) || bad;
#pragma unroll
        for (int ai = 0; ai < 2; ++ai)
#pragma unroll
            for (int m = 0; m < 4; ++m) { const int r = ai * HALF + wr * 64 + m * 16 + fr; const f32x2v sr = S[r]; const size_t off = (size_t)(u.pm * BM + r) * ldc + col0;
#pragma unroll
                for (int bj = 0; bj < 2; ++bj)
#pragma unroll
                    for (int n = 0; n < 2; ++n) { const f32x4 x1 = acc[ai][bj][m][n]; *(f32x4*)(out + off + bj * HALF + n * 16) = bad1 ? (f32x4){qnan, qnan, qnan, qnan} : x1;
                        const f32x4 o = (x1 - sr.x) * sr.y; u32x2v w; w.x = cvt_pk_bf16(o[0], o[1]); w.y = cvt_pk_bf16(o[2], o[3]);
                        if (bad) { w.x = 0x7fc07fc0u; w.y = 0x7fc07fc0u; } *(u32x2v*)(xn + off + bj * HALF + n * 16) = w; }
                asm volatile("" ::: "memory"); }
    }
};

template <class Epi, class Sched, bool ALIGN_EPI = false, bool SP2 = false>
__device__ __forceinline__ void gemm_phase(PG8_LAS unsigned char* lds, const Gemm g, const Sched& S, const Epi& E, const int wave_id  ) {
    int tid; { int l_; asm volatile("v_mbcnt_lo_u32_b32 %0, -1, 0\n\tv_mbcnt_hi_u32_b32 %0, -1, %0" : "=v"(l_)); tid = wave_id * 64 + l_; }
    const int wid = wave_id, lane = tid & 63, wr = wid >> 2, wc = wid & 3, fr = lane & 15, fq = lane >> 4;
    const int K = g.K, nt = K / BK;
    constexpr bool GA = Sched::GATHER;
    static_assert(!GA || SP2, "row gather is wired into the SP2 loop only");
    unsigned voffA[2], voffB[2]; int RA[2], CA[2];
#pragma unroll
    for (int i = 0; i < 2; ++i) { int R, C; stage_rc(tid * 16 + i * 8192, R, C); const int Rb = Epi::PERM ? ((R & ~31) + perm32(R & 31)) : R; RA[i] = R; CA[i] = C;
        voffA[i] = (unsigned)(R * BK + C) * 2u; voffB[i] = (unsigned)(Rb * BK + C) * 2u; }
    unsigned goc[2][2], gon[2][2]; const char* const gA = (const char*)g.A;
#define PG8_GO(dst, slot, u) do { _Pragma("unroll") for (int _h = 0; _h < 2; ++_h) _Pragma("unroll") for (int _i = 0; _i < 2; ++_i) \
        { const unsigned _r = (unsigned)S.arow(slot, u, _h * HALF + RA[_i]); dst[_h][_i] = (_r >> 8) * (unsigned)(BM * K * 2) + (_r & 255u) * (unsigned)(BK * 2) + (unsigned)(CA[_i] * 2); } } while (0)
#define PG8_STAGE_A(bufoff, gbase_plain, kb, h, useN) do { if constexpr (GA) { _Pragma("unroll") for (int _i = 0; _i < 2; ++_i) { const unsigned _o = (useN) ? gon[h][_i] : goc[h][_i]; \
        __builtin_amdgcn_global_load_lds((const unsigned*)(gA + (kb) + _o), (PG8_LAS unsigned*)(lds + (bufoff) + ldsw + _i * 8192), 16, 0, 0); } } else { PG8_STAGE(bufoff, gbase_plain, voffA); } } while (0)
    const size_t kstep = (size_t)(BM * BK * 2);
    const size_t hstep = (size_t)HALF * BK * 2;
    const size_t tstep = (size_t)BM * K * 2;
    const unsigned ldsw = (unsigned)wid * 1024u;
    const int aoff = lds_byte(wr * 64 + fr, fq * 8), boff = lds_byte(wc * 32 + fr, fq * 8);
#define PG8_SA(b, h) (((b) * 2 + (h)) * HTB)
#define PG8_SB(b, h) ((4 + (b) * 2 + (h)) * HTB)
#define PG8_STAGE(bufoff, gbase, voff) do { _Pragma("unroll") for (int _i = 0; _i < 2; ++_i) \
        __builtin_amdgcn_global_load_lds((const unsigned*)((const char*)(gbase) + (voff)[_i]), (PG8_LAS unsigned*)(lds + (bufoff) + ldsw + _i * 8192), 16, 0, 0); } while (0)
#define PG8_LDA(dst, b, h) do { _Pragma("unroll") for (int m = 0; m < 4; ++m) _Pragma("unroll") for (int k = 0; k < 2; ++k) dst[m][k] = *(const PG8_LAS bf16x8*)(lds + PG8_SA(b, h) + aoff + m * 2048 + k * 1024); } while (0)
#define PG8_LDB(dst, b, h) do { _Pragma("unroll") for (int n = 0; n < 2; ++n) _Pragma("unroll") for (int k = 0; k < 2; ++k) dst[n][k] = *(const PG8_LAS bf16x8*)(lds + PG8_SB(b, h) + boff + n * 2048 + k * 1024); } while (0)
#define PG8_MMA(ai, bj, At, Bt) do { __builtin_amdgcn_s_setprio(1); _Pragma("unroll") for (int m = 0; m < 4; ++m) _Pragma("unroll") for (int n = 0; n < 2; ++n) _Pragma("unroll") for (int k = 0; k < 2; ++k) \
        acc[ai][bj][m][n] = __builtin_amdgcn_mfma_f32_16x16x32_bf16(Bt[n][k], At[m][k], acc[ai][bj][m][n], 0, 0, 0); __builtin_amdgcn_s_setprio(0); } while (0)
#define PG8_WAIT_V(n) asm volatile("s_waitcnt vmcnt(" #n ")" ::: "memory")
#define PG8_WAIT_L(n) asm volatile("s_waitcnt lgkmcnt(" #n ")" ::: "memory")
#define PG8_BAR __builtin_amdgcn_s_barrier()
#define PG8_SCHED __builtin_amdgcn_sched_barrier(0)
    Unit cur, nxt; int ui = 0;
    if (!S.next(0, cur)) return;
    f32x4 acc[2][2][4][2];
#pragma unroll
    for (int a = 0; a < 2; ++a)
#pragma unroll
        for (int b = 0; b < 2; ++b)
#pragma unroll
            for (int m = 0; m < 4; ++m)
#pragma unroll
                for (int n = 0; n < 2; ++n) acc[a][b][m][n] = (f32x4){0.f, 0.f, 0.f, 0.f};
    bf16x8 At[4][2], B0[2][2], B1[2][2];
#define PG8_ROT(u) (2 * (((u).pm + 3 * (u).pn) & 3))
#define PG8_KOFF(t, r) ((size_t)(((t) + (r)) & (nt - 1)) * kstep)
    int rc = SP2 ? PG8_ROT(cur) : 0, rn = rc;
    const char* cA = (const char*)g.A + (size_t)cur.pm * tstep; const char* cB = (const char*)g.Bt + (size_t)cur.pn * tstep;
    if constexpr (GA) { PG8_GO(goc, 0, cur); }
    S.a_ready(cur);
    if constexpr (SP2) {
        const size_t k0 = PG8_KOFF(0, rc);
        PG8_STAGE(PG8_SB(0, 0), cB + k0, voffB); PG8_STAGE(PG8_SB(0, 1), cB + k0 + hstep, voffB); PG8_STAGE_A(PG8_SA(0, 0), cA + k0, k0, 0, false); PG8_STAGE_A(PG8_SA(0, 1), cA + k0 + hstep, k0, 1, false);
        if (wr == 1) PG8_BAR;
        PG8_WAIT_V(2); PG8_BAR;
        PG8_STAGE(PG8_SB(1, 0), cB + k0 + kstep, voffB); PG8_STAGE_A(PG8_SA(1, 0), cA + k0 + kstep, k0 + kstep, 0, false); PG8_STAGE(PG8_SB(1, 1), cB + k0 + hstep + kstep, voffB);
        PG8_WAIT_V(6); PG8_BAR;
    } else {
        PG8_STAGE(PG8_SB(0, 0), cB, voffB); PG8_STAGE(PG8_SA(0, 0), cA, voffA); PG8_STAGE(PG8_SB(0, 1), cB + hstep, voffB); PG8_STAGE(PG8_SA(0, 1), cA + hstep, voffA);
        if (wr == 1) PG8_BAR;
        PG8_WAIT_V(4); PG8_BAR;
        PG8_STAGE(PG8_SB(1, 0), cB + kstep, voffB); PG8_STAGE(PG8_SA(1, 0), cA + kstep, voffA); PG8_STAGE(PG8_SB(1, 1), cB + hstep + kstep, voffB);
        PG8_WAIT_V(6); PG8_BAR;
    }
    for (;;) {
        const bool has_next = S.next(ui + 1, nxt);
        rn = (SP2 && has_next) ? PG8_ROT(nxt) : rc;
        unsigned tv = 0u;
        if (has_next) { const char* ta;
            if (tid < 128) ta = (const char*)g.Bt + (size_t)nxt.pn * tstep + (size_t)tid * 4096;
            else if constexpr (GA) { const unsigned _r = (unsigned)S.arow(ui + 1, nxt, (tid - 128) & 255); ta = gA + (size_t)(_r >> 8) * tstep + (size_t)(_r & 255u) * (BK * 2); }
            else ta = (const char*)g.A + (size_t)nxt.pm * tstep + (size_t)((tid - 128) & 127) * 4096;
            asm volatile("global_load_dword %0, %1, off" : "=v"(tv) : "v"(ta) : "memory"); }
        if constexpr (GA) { if (has_next) { PG8_GO(gon, ui + 1, nxt); } else { _Pragma("unroll") for (int _h = 0; _h < 2; ++_h) _Pragma("unroll") for (int _i = 0; _i < 2; ++_i) gon[_h][_i] = goc[_h][_i]; } }
        const char* nA = has_next ? (const char*)g.A + (size_t)nxt.pm * tstep : cA; const char* nB = has_next ? (const char*)g.Bt + (size_t)nxt.pn * tstep : cB;
        for (int t = 0; t < nt; t += 2) {
            const bool last = (t == nt - 2);
            const size_t kt0 = PG8_KOFF(t, rc), kt2 = last ? PG8_KOFF(0, rn) : PG8_KOFF(t + 2, rc);
            const char* a1 = cA + kt0 + kstep;
            const char* a2 = (last ? nA : cA) + kt2; const char* b2 = (last ? nB : cB) + kt2;
            const char* a3 = a2 + kstep; const char* b3 = b2 + kstep;
            const size_t k2 = kt2;
            if (last && has_next) S.a_ready(nxt);
            if constexpr (SP2) {
            PG8_LDB(B0, 0, 0); PG8_LDB(B1, 0, 1); PG8_SCHED; PG8_LDA(At, 0, 0); PG8_STAGE_A(PG8_SA(1, 1), a1 + hstep, kt0 + kstep, 1, false);
            PG8_WAIT_V(8); PG8_WAIT_L(0); PG8_BAR; PG8_MMA(0, 0, At, B0); PG8_MMA(0, 1, At, B1); PG8_BAR; PG8_SCHED;
            PG8_LDA(At, 0, 1); PG8_STAGE(PG8_SB(0, 0), b2, voffB); PG8_STAGE(PG8_SB(0, 1), b2 + hstep, voffB); PG8_STAGE_A(PG8_SA(0, 0), a2, k2, 0, last);
            PG8_WAIT_V(8); PG8_WAIT_L(0); PG8_BAR; PG8_MMA(1, 0, At, B0); PG8_MMA(1, 1, At, B1); PG8_BAR; PG8_SCHED;
            PG8_LDB(B0, 1, 0); PG8_LDB(B1, 1, 1); PG8_SCHED; PG8_LDA(At, 1, 0); PG8_STAGE_A(PG8_SA(0, 1), a2 + hstep, k2, 1, last);
            PG8_WAIT_V(8); PG8_WAIT_L(0); PG8_BAR; PG8_MMA(0, 0, At, B0); PG8_MMA(0, 1, At, B1); PG8_BAR; PG8_SCHED;
            PG8_LDA(At, 1, 1); PG8_STAGE(PG8_SB(1, 0), b3, voffB); PG8_STAGE(PG8_SB(1, 1), b3 + hstep, voffB); PG8_STAGE_A(PG8_SA(1, 0), a3, k2 + kstep, 0, last);
            PG8_WAIT_V(8); PG8_WAIT_L(0); PG8_BAR; PG8_MMA(1, 0, At, B0); PG8_MMA(1, 1, At, B1); PG8_BAR; PG8_SCHED;
            } else {
            PG8_LDB(B0, 0, 0); PG8_SCHED; PG8_LDA(At, 0, 0); PG8_STAGE(PG8_SA(1, 1), a1 + hstep, voffA);
            PG8_WAIT_L(8); PG8_BAR; PG8_WAIT_L(0); PG8_MMA(0, 0, At, B0); PG8_BAR; PG8_SCHED;
            PG8_LDB(B1, 0, 1); PG8_STAGE(PG8_SB(0, 0), b2, voffB);
            PG8_BAR; PG8_WAIT_L(0); PG8_MMA(0, 1, At, B1); PG8_BAR;
            PG8_LDA(At, 0, 1); PG8_STAGE(PG8_SA(0, 0), a2, voffA);
            PG8_BAR; PG8_WAIT_L(0); PG8_MMA(1, 0, At, B0); PG8_BAR; PG8_SCHED;
            PG8_STAGE(PG8_SB(0, 1), b2 + hstep, voffB);
            PG8_WAIT_V(6); PG8_BAR; PG8_MMA(1, 1, At, B1); PG8_BAR;
            PG8_LDB(B0, 1, 0); PG8_SCHED; PG8_LDA(At, 1, 0); PG8_STAGE(PG8_SA(0, 1), a2 + hstep, voffA);
            PG8_WAIT_L(8); PG8_BAR; PG8_WAIT_L(0); PG8_MMA(0, 0, At, B0); PG8_BAR; PG8_SCHED;
            PG8_LDB(B1, 1, 1); PG8_STAGE(PG8_SB(1, 0), b3, voffB);
            PG8_BAR; PG8_WAIT_L(0); PG8_MMA(0, 1, At, B1); PG8_BAR;
            PG8_LDA(At, 1, 1); PG8_STAGE(PG8_SA(1, 0), a3, voffA);
            PG8_BAR; PG8_WAIT_L(0); PG8_MMA(1, 0, At, B0); PG8_BAR; PG8_SCHED;
            PG8_STAGE(PG8_SB(1, 1), b3 + hstep, voffB);
            PG8_WAIT_V(6); PG8_BAR; PG8_MMA(1, 1, At, B1); PG8_BAR;
            }
        }
        if constexpr (ALIGN_EPI) { if (wr == 0) PG8_BAR; }
        if constexpr (!Epi::AFTER_DRAIN) { E(acc, cur, wr, wc, fr, fq); S.done(cur); }
        asm volatile("" : "+v"(tv));
        if (!has_next) break;
#pragma unroll
        for (int a = 0; a < 2; ++a)
#pragma unroll
            for (int b = 0; b < 2; ++b)
#pragma unroll
                for (int m = 0; m < 4; ++m)
#pragma unroll
                    for (int n = 0; n < 2; ++n) acc[a][b][m][n] = (f32x4){0.f, 0.f, 0.f, 0.f};
        cur = nxt; cA = nA; cB = nB; ++ui; rc = rn;
        if constexpr (GA) { _Pragma("unroll") for (int _h = 0; _h < 2; ++_h) _Pragma("unroll") for (int _i = 0; _i < 2; ++_i) goc[_h][_i] = gon[_h][_i]; }
        if constexpr (ALIGN_EPI) { if (wr == 1) PG8_BAR; }
    }
    PG8_WAIT_V(0);
    if constexpr (!ALIGN_EPI) { if (wr == 0) PG8_BAR; }
    PG8_BAR;
    if constexpr (Epi::AFTER_DRAIN) { E.fused(acc, cur, wr, wc, fr, fq, lds, wid, lane); S.done(cur); }
#undef PG8_SA
#undef PG8_SB
#undef PG8_STAGE
#undef PG8_ROT
#undef PG8_KOFF
#undef PG8_STAGE_A
#undef PG8_GO
#undef PG8_LDA
#undef PG8_LDB
#undef PG8_MMA
#undef PG8_WAIT_V
#undef PG8_WAIT_L
#undef PG8_BAR
#undef PG8_SCHED
}
}

#ifndef PG8_SP2
#define PG8_SP2 true
#endif
#ifndef PG8_ALIGN
#define PG8_ALIGN true
#endif
#define GAS __attribute__((address_space(1)))
#define LAS __attribute__((address_space(3)))
typedef unsigned short bf16;
typedef unsigned v4u __attribute__((ext_vector_type(4)));
typedef float f32x4 __attribute__((ext_vector_type(4)));
typedef short bf16x8 __attribute__((ext_vector_type(8)));
typedef GAS unsigned gu32;
typedef GAS unsigned long long gu64;
#define RLX_AGENT __ATOMIC_RELAXED, __HIP_MEMORY_SCOPE_AGENT
#define LDS_WAIT() asm volatile("s_waitcnt lgkmcnt(0)" ::: "memory")
#define VM_WAIT() asm volatile("s_waitcnt vmcnt(0)" ::: "memory")
__device__ __forceinline__ unsigned long long rt() { return __builtin_amdgcn_s_memrealtime(); }
__device__ __forceinline__ unsigned f2bf(float f) { unsigned u = __builtin_bit_cast(unsigned, f); return (u + 0x7fffu + ((u >> 16) & 1u)) >> 16; }
__device__ __forceinline__ unsigned pk2(float lo, float hi) { return f2bf(lo) | (f2bf(hi) << 16); }

#define XB_TMO      128
#define XB_XCNT(j)  (256  + 64 * (j))
#define XB_XSUB(j)  (1280 + 64 * (j))
#define XB_XGEN(j)  (2304 + 64 * (j))
#define XB_TOP      3328
#define XB_TOPGEN   3392
#define XCD_BAR_WORDS 3456
#define XB_SPIN_CAP (1u << 18)

__device__ __forceinline__ unsigned xb_ld(unsigned* p)              { return __hip_atomic_load(p, __ATOMIC_RELAXED, __HIP_MEMORY_SCOPE_AGENT); }
__device__ __forceinline__ unsigned xb_add(unsigned* p, unsigned v) { return __hip_atomic_fetch_add(p, v, __ATOMIC_RELAXED, __HIP_MEMORY_SCOPE_AGENT); }
__device__ __forceinline__ unsigned xb_xcc_id() { return (unsigned)__builtin_amdgcn_s_getreg((3 << 11) | 20) & 0xFu; }
#define XB_SPIN(cond, bar) do { unsigned _sp = 0; while (cond) { __builtin_amdgcn_s_sleep(1); \
    if ((++_sp & 255u) == 0u) { if (xb_ld(&(bar)[XB_TMO])) break; if (_sp > XB_SPIN_CAP) { atomicAdd(&(bar)[XB_TMO], 1u); break; } } } } while (0)

struct XcdBarrier {
    unsigned* bar; unsigned x;
    volatile LAS unsigned* st;
};

__device__ __forceinline__ XcdBarrier xcd_barrier_post(unsigned* bar, volatile LAS unsigned* st, bool leader) {
    XcdBarrier b; b.bar = bar; b.x = xb_xcc_id(); b.st = st;
    if (leader) (void)xb_add(&bar[XB_XCNT(b.x)], 1u);
    return b;
}
__device__ __forceinline__ void xcd_barrier_complete(unsigned* bar, unsigned x, unsigned& nloc, unsigned& nx) {
    const unsigned G = gridDim.x * gridDim.y * gridDim.z;
    unsigned sum, cnt, mine, sp = 0u;
    for (;;) {
        sum = 0u; cnt = 0u; mine = 0u;
#pragma unroll
        for (unsigned j = 0; j < 16; ++j) { const unsigned c = xb_ld(&bar[XB_XCNT(j)]); sum += c; cnt += (c > 0u) ? 1u : 0u; mine = (j == x) ? c : mine; }
        if (sum == G) break;
        __builtin_amdgcn_s_sleep(1);
        if ((++sp & 255u) == 0u) { if (xb_ld(&bar[XB_TMO])) break; if (sp > XB_SPIN_CAP) { atomicAdd(&bar[XB_TMO], 1u); break; } }
    }
    nloc = mine > 0u ? mine : 1u; nx = cnt > 0u ? cnt : 1u;
}

__device__ __forceinline__ void xcd_barrier(const XcdBarrier& b, bool leader) {
    asm volatile("s_waitcnt vmcnt(0)" ::: "memory");
    __syncthreads();
    if (leader) {
        unsigned* bar = b.bar;
        __builtin_amdgcn_s_waitcnt(0);
        unsigned nloc = b.st[0], nx = b.st[1];
        if (nloc == 0u) { xcd_barrier_complete(bar, b.x, nloc, nx); b.st[0] = nloc; b.st[1] = nx; }
        const unsigned old = xb_add(&bar[XB_XSUB(b.x)], 1u);
        const unsigned gen = old / nloc;
        if (old + 1u == (gen + 1u) * nloc) {
            __builtin_amdgcn_fence(__ATOMIC_RELEASE, "agent");
            asm volatile("s_waitcnt vmcnt(0)" ::: "memory");
            const unsigned og = xb_add(&bar[XB_TOP], 1u);
            const unsigned tg = og / nx;
            if (og + 1u == (tg + 1u) * nx) xb_add(&bar[XB_TOPGEN], 1u);
            else XB_SPIN(xb_ld(&bar[XB_TOPGEN]) == tg, bar);
            __builtin_amdgcn_fence(__ATOMIC_ACQUIRE, "agent");
            xb_add(&bar[XB_XGEN(b.x)], 1u);
            asm volatile("s_waitcnt vmcnt(0)" ::: "memory");
        } else {
            XB_SPIN(xb_ld(&bar[XB_XGEN(b.x)]) == gen, bar);
            __builtin_amdgcn_fence(__ATOMIC_ACQUIRE, "agent");
            asm volatile("s_waitcnt vmcnt(0)" ::: "memory");
        }
    }
    __syncthreads();
}
constexpr int NWAVES = 8;
constexpr int B_ = 8, S_ = 2048, T = B_ * S_, D = 1024;
constexpr int INC = 3784;
constexpr int O_Q = 0, O_CKV = 512, O_QI = 640, O_KI = 1152, O_WI = 1216, O_U = 1224, O_G = 1736;
constexpr int NIN = 3840;
constexpr float ALPHA = 1.189207115002721f, LN_EPS = 1e-5f, LOG2E = 1.4426950408889634f;
constexpr int MAXROWS = T * 4 + 32 * 256;
constexpr int TOPK = 256;

constexpr size_t MiB = 1u << 20;
constexpr size_t WS_CTL = 0, CTL_ZERO_BYTES = 1 * MiB;
constexpr size_t WS_MOD = 1 * MiB, WS_WIN = 2 * MiB, WS_WOA = 11 * MiB, WS_WPB = 13 * MiB, WS_WOUT = 14 * MiB, WS_WGU = 16 * MiB, WS_WD = 144 * MiB;
constexpr size_t WS_H = 208 * MiB, WS_QL = 240 * MiB, WS_QI = 272 * MiB, WS_MISC = 288 * MiB, WS_U = 304 * MiB, WS_SG = 320 * MiB;
constexpr size_t WS_CKV = 384 * MiB, WS_CKVT = 388 * MiB, WS_POOLED = 392 * MiB, WS_MASK = 408 * MiB, WS_OLAT = 412 * MiB, WS_TMP = 444 * MiB, WS_MIX = 476 * MiB;
constexpr size_t WS_Z = 508 * MiB, WS_X1 = 572 * MiB, WS_SLOTMAP = 636 * MiB, WS_TOKSLOT = 638 * MiB, WS_GATE = 638 * MiB + 512 * 1024;
constexpr size_t WS_XPAD = 640 * MiB, WS_ACT = 784 * MiB, WS_Y = WS_XPAD, WS_KI = 928 * MiB, WS_WRB = 930 * MiB, WS_END = 931 * MiB;
constexpr size_t WS_WBA = WS_WOA, WS_WUKB = WS_WOA + 1 * MiB, WS_WUVT = WS_WOA + 1 * MiB + 256 * 1024, WS_YA = WS_OLAT;
constexpr int CW_GCNT = 0, CW_TSTART = 64, CW_BAR = 4096;

constexpr int RING_OFF = 0, RING_BYTES = 131072;
constexpr int LDSCTL_OFF = RING_BYTES, MISC_OFF = LDSCTL_OFF + 320;
constexpr int LDS_BYTES = 163840;

struct Frame {
    LAS unsigned char* lds;
    volatile LAS unsigned* MISCW;
    gu32* ctl;
    int tid, lane, wave, vcu, G;
    unsigned char* ws;
    float* out;
};
__device__ __forceinline__ const float* frame_in(int i) { typedef __attribute__((address_space(4))) const char* kptr_t; kptr_t ka = (kptr_t)__builtin_amdgcn_kernarg_segment_ptr(); asm volatile("" : "+s"(ka));
    const float* p = *(const float* __attribute__((address_space(4))) const*)(ka + 8 * i); return (const float*)(const GAS float*)p; }
typedef __bf16 bf2v __attribute__((ext_vector_type(2)));
typedef float f2v __attribute__((ext_vector_type(2)));
__device__ __forceinline__ unsigned pkbf(float a, float b) { f2v v = {a, b}; bf2v r = __builtin_convertvector(v, bf2v); return __builtin_bit_cast(unsigned, r); }
__device__ __forceinline__ size_t bl_off(int r, int k, int K) { return ((size_t)(r >> 8) * (size_t)(K >> 6) + (size_t)(k >> 6)) * 16384 + (size_t)((r & 255) * 64 + (k & 63)); }
__device__ __forceinline__ float bf2f(unsigned short u) { return __uint_as_float((unsigned)u << 16); }
__device__ __forceinline__ float sigm_fast(float x) { return __builtin_amdgcn_rcpf(1.f + __builtin_amdgcn_exp2f(-x * LOG2E)); }

typedef float f32x16 __attribute__((ext_vector_type(16)));
__device__ __forceinline__ bf16x8 pack8(float a0, float a1, float a2, float a3, float a4, float a5, float a6, float a7) {
    v4u p; p.x = pkbf(a0, a1); p.y = pkbf(a2, a3); p.z = pkbf(a4, a5); p.w = pkbf(a6, a7); return __builtin_bit_cast(bf16x8, p); }
#define MFMA32(a, b, c) __builtin_amdgcn_mfma_f32_32x32x16_bf16((a), (b), (c), 0, 0, 0)
__device__ __forceinline__ int krow16(int r, int hh) { return (r & 3) + 8 * (r >> 2) + 4 * hh; }

namespace pg8 {
struct EpiInProj {
    static constexpr bool PERM = true, AFTER_DRAIN = false;
    bf16_t *QL, *QI, *U, *SG; float* MISC; bf16_t* KI;
    __device__ __forceinline__ void operator()(const f32x4 (&acc)[2][2][4][2], const Unit& u, int wr, int wc, int fr, int fq) const {
        const int row0 = u.pm * BM + wr * 64 + fr, c0 = wc * 32 + 8 * fq; const int pn = u.pn;
        if (pn == 4) {
#pragma unroll
            for (int ai = 0; ai < 2; ++ai)
#pragma unroll
                for (int m = 0; m < 4; ++m) { float* rowp = MISC + (size_t)(row0 + ai * HALF + m * 16) * 256 + c0;
#pragma unroll
                    for (int bj = 0; bj < 2; ++bj) { *(f32x4*)(rowp + bj * HALF) = acc[ai][bj][m][0]; *(f32x4*)(rowp + bj * HALF + 4) = acc[ai][bj][m][1]; }
                    if (wc < 2) { const f32x4 v0 = acc[ai][1][m][0], v1 = acc[ai][1][m][1]; u32x4 w; w.x = cvt_pk_bf16(v0[0], v0[1]); w.y = cvt_pk_bf16(v0[2], v0[3]); w.z = cvt_pk_bf16(v1[0], v1[1]); w.w = cvt_pk_bf16(v1[2], v1[3]);
                        *(u32x4*)(KI + (size_t)(row0 + ai * HALF + m * 16) * 64 + c0) = w; } }
        } else {
            bf16_t* base; int ld, colt; bool sg = false;
            if (pn < 2) { base = QL; ld = 512; colt = pn * 256; }
            else if (pn < 4) { base = QI; ld = 512; colt = (pn - 2) * 256; }
            else if (pn < 7) { base = U; ld = 512; colt = (pn - 5) * 256; }
            else { base = SG; ld = 2048; colt = (pn - 7) * 256; sg = true; }
#pragma unroll
            for (int ai = 0; ai < 2; ++ai)
#pragma unroll
                for (int m = 0; m < 4; ++m) { bf16_t* rowp = base + (size_t)(row0 + ai * HALF + m * 16) * ld + colt + c0;
#pragma unroll
                    for (int bj = 0; bj < 2; ++bj) { f32x4 v0 = acc[ai][bj][m][0], v1 = acc[ai][bj][m][1];
                        if (sg) {
#pragma unroll
                            for (int i = 0; i < 4; ++i) { v0[i] = sigm_fast(v0[i]); v1[i] = sigm_fast(v1[i]); } }
                        u32x4 w; w.x = cvt_pk_bf16(v0[0], v0[1]); w.y = cvt_pk_bf16(v0[2], v0[3]); w.z = cvt_pk_bf16(v1[0], v1[1]); w.w = cvt_pk_bf16(v1[2], v1[3]);
                        *(u32x4*)(rowp + bj * HALF) = w; } }
        }
    }
};
}

__device__ __forceinline__ void tr_item(const float* W, int ldw, int k0, int n0, int ncols, float scale, bf16* WT, int ldt, int drow0, LAS float* scr, int lane) {
    const int nn = lane & 31;
#pragma unroll 8
    for (int i = 0; i < 32; ++i) { const int kk = 2 * i + (lane >> 5); scr[kk * 33 + nn] = (nn < ncols) ? W[(size_t)(k0 + kk) * ldw + n0 + nn] * scale : 0.f; }
    LDS_WAIT(); asm volatile("" ::: "memory");
    const int c = lane & 7;
#pragma unroll
    for (int j = 0; j < 4; ++j) { const int n = (lane >> 3) + 8 * j; const LAS float* s = scr + (8 * c) * 33 + n;
        v4u o; o.x = pk2(s[0 * 33], s[1 * 33]); o.y = pk2(s[2 * 33], s[3 * 33]); o.z = pk2(s[4 * 33], s[5 * 33]); o.w = pk2(s[6 * 33], s[7 * 33]);
        if (n < ncols) *(GAS v4u*)(WT + bl_off(drow0 + n, k0 + 8 * c, ldt)) = o; }
    LDS_WAIT(); asm volatile("" ::: "memory");
}
struct TrDesc { const float* src; bf16* dst; int ldw; float scale; };
__device__ __forceinline__ void tr_load(const TrDesc& d, int lane, f32x4 (&v)[16]) {
    const int kr = lane >> 4, nc = lane & 15; const float* src = d.src + (size_t)(16 * kr) * d.ldw + 4 * nc;
#pragma unroll
    for (int i = 0; i < 16; ++i) v[i] = __builtin_nontemporal_load((const f32x4*)(src + (size_t)i * d.ldw));
}
__device__ __forceinline__ void tr_finish(const TrDesc& d, LAS unsigned char* scr, int lane, const f32x4 (&v)[16]) {
    const int kr = lane >> 4, nc = lane & 15; const float scale = d.scale;
#pragma unroll
    for (int j = 0; j < 4; ++j) { const int n = 4 * nc + j; const int f = (n >> 2) & 7;
#pragma unroll
        for (int hlf = 0; hlf < 2; ++hlf) { v4u o;
            o.x = pkbf(v[8 * hlf + 0][j] * scale, v[8 * hlf + 1][j] * scale); o.y = pkbf(v[8 * hlf + 2][j] * scale, v[8 * hlf + 3][j] * scale);
            o.z = pkbf(v[8 * hlf + 4][j] * scale, v[8 * hlf + 5][j] * scale); o.w = pkbf(v[8 * hlf + 6][j] * scale, v[8 * hlf + 7][j] * scale);
            *(LAS v4u*)(scr + n * 128 + (((2 * kr + hlf) ^ f) << 4)) = o; } }
    LDS_WAIT(); asm volatile("" ::: "memory");
    const int kc = lane & 7;
#pragma unroll
    for (int j = 0; j < 8; ++j) { const int n = (lane >> 3) + 8 * j; const v4u o = *(const LAS v4u*)(scr + n * 128 + ((kc ^ ((n >> 2) & 7)) << 4));
        *(GAS v4u*)(d.dst + (size_t)n * 64 + 8 * kc) = o; }
    LDS_WAIT(); asm volatile("" ::: "memory");
}
__device__ __forceinline__ void fold_qlat(const float* w_in, const float* w_uk, bf16* Win_t, int task, int lane) {
    const int h = task >> 8, kb = (task >> 4) & 15, r0 = (task & 15) * 8; const int k = kb * 64 + lane;
    const float* wrow = w_in + (size_t)k * INC + O_Q + h * 64; const float* up = w_uk + r0 * 512 + h * 64;
    float a[8] = {0, 0, 0, 0, 0, 0, 0, 0};
#pragma unroll 4
    for (int d4 = 0; d4 < 16; ++d4) { const f32x4 v = *(const f32x4*)(wrow + 4 * d4);
#pragma unroll
        for (int j = 0; j < 8; ++j) { const f32x4 u = *(const f32x4*)(up + j * 512 + 4 * d4); a[j] += (v.x * u.x + v.y * u.y) + (v.z * u.z + v.w * u.w); } }
#pragma unroll
    for (int j = 0; j < 8; ++j) Win_t[bl_off(h * 128 + r0 + j, k, 1024)] = (bf16)f2bf(a[j] * (0.125f * LOG2E));
}
__device__ __forceinline__ void fold_oa(const float* w_uv, const float* w_ba, bf16* Woa_t, int task, int lane) {
    const int h = task >> 8, nb = (task >> 4) & 15, r0 = (task & 15) * 8; const int n = nb * 64 + lane;
    const float* up = w_uv + r0 * 512 + h * 64; float a[8] = {0, 0, 0, 0, 0, 0, 0, 0};
#pragma unroll 4
    for (int d4 = 0; d4 < 16; ++d4) { float v[4];
#pragma unroll
        for (int i = 0; i < 4; ++i) v[i] = w_ba[(size_t)(h * 64 + 4 * d4 + i) * 1024 + n];
#pragma unroll
        for (int j = 0; j < 8; ++j) { const f32x4 u = *(const f32x4*)(up + j * 512 + 4 * d4); a[j] += (v[0] * u.x + v[1] * u.y) + (v[2] * u.z + v[3] * u.w); } }
    v4u o; o.x = pk2(a[0], a[1]); o.y = pk2(a[2], a[3]); o.z = pk2(a[4], a[5]); o.w = pk2(a[6], a[7]);
    *(GAS v4u*)(Woa_t + bl_off(n, h * 128 + r0, 1024)) = o;
}
__device__ __forceinline__ void fold_pb(const float* w_pg, const float* pscale, const float* w_bp, bf16* Wpb_t, int task, int lane) {
    const int g = task >> 8, nb = (task >> 4) & 15, c0 = (task & 15) * 8; const int n = nb * 64 + lane;
    const float* pg = w_pg + (size_t)g * 16384 + c0 * 128; float a[8] = {0, 0, 0, 0, 0, 0, 0, 0};
#pragma unroll 4
    for (int d4 = 0; d4 < 32; ++d4) { float v[4]; const f32x4 ps = *(const f32x4*)(pscale + g * 128 + 4 * d4);
#pragma unroll
        for (int i = 0; i < 4; ++i) v[i] = w_bp[(size_t)(g * 128 + 4 * d4 + i) * 1024 + n] * ps[i];
#pragma unroll
        for (int j = 0; j < 8; ++j) { const f32x4 u = *(const f32x4*)(pg + j * 128 + 4 * d4); a[j] += (v[0] * u.x + v[1] * u.y) + (v[2] * u.z + v[3] * u.w); } }
    v4u o; o.x = pk2(a[0], a[1]); o.y = pk2(a[2], a[3]); o.z = pk2(a[4], a[5]); o.w = pk2(a[6], a[7]);
    *(GAS v4u*)(Wpb_t + bl_off(n, g * 128 + c0, 512)) = o;
}
template <int VAR>
__device__ __forceinline__ void p0_prologue(Frame& F) {
    const float* c = frame_in(1); const float* w_ada = frame_in(2); const float* b_ada = frame_in(3); const float* w_in = frame_in(4);
    const float* w_uk = frame_in(6); const float* w_uv = frame_in(7); const float* w_pg = frame_in(8); const float* pscale = frame_in(9);
    const float* w_ba = frame_in(10); const float* w_bp = frame_in(11); const float* w_out = frame_in(12); const float* w_gu = frame_in(17); const float* w_d = frame_in(19);
    bf16* Win_t = (bf16*)(F.ws + WS_WIN); bf16* Woa_t = (bf16*)(F.ws + WS_WOA); bf16* Wpb_t = (bf16*)(F.ws + WS_WPB); bf16* Wout_t = (bf16*)(F.ws + WS_WOUT);
    bf16* Wgu_t = (bf16*)(F.ws + WS_WGU); bf16* Wd_t = (bf16*)(F.ws + WS_WD); float* MOD = (float*)(F.ws + WS_MOD);
    for (int cg = blockIdx.x; cg < 256; cg += F.G) {
        LAS float* cs = (LAS float*)(F.lds + 69632); LAS float* red = (LAS float*)(F.lds + 69632 + 32768);
        for (int i = F.tid; i < 8192; i += 512) { const float v = c[i]; cs[i] = v / (1.f + __expf(-v)); }
        __syncthreads();
        float acc[8] = {0, 0, 0, 0, 0, 0, 0, 0}; const int cc = F.lane & 31, rp = F.lane >> 5; const bool act = cc < 24; const float* wp = w_ada + cg * 24 + (act ? cc : 0);
#pragma unroll 16
        for (int i = 0; i < 64; ++i) { const int k = F.wave * 128 + 2 * i + rp; float w = __builtin_nontemporal_load(wp + (size_t)k * 6144); w = act ? w : 0.f;
#pragma unroll
            for (int b = 0; b < 8; ++b) acc[b] += cs[b * 1024 + k] * w; }
#pragma unroll
        for (int b = 0; b < 8; ++b) red[((F.wave * 2 + rp) * 8 + b) * 32 + cc] = acc[b];
        __syncthreads();
        if (F.tid < 256) { const int b = F.tid >> 5, l = F.tid & 31; if (l < 24) { float s = 0.f;
#pragma unroll
            for (int w = 0; w < 16; ++w) s += red[(w * 8 + b) * 32 + l];
            MOD[b * 6144 + cg * 24 + l] = s + b_ada[cg * 24 + l]; } }
        __syncthreads();
    }
    LAS unsigned char* scr8 = F.lds + F.wave * 8448; LAS float* scr = (LAS float*)scr8;
    const int gw = F.vcu * NWAVES + F.wave, NGW = F.G * NWAVES;
    constexpr int I_FQ = 64  , I_FO = 64  , I_FP = 1024, I_Z = 56, I_WI = 16, I_WR = 64, NSMALL = I_FQ + I_FO + I_FP + I_Z + I_WI + I_WR;
    for (int it = gw; it < NSMALL; it += NGW) {
        int r = it;
        if (r < I_FQ) {
            bf16* WukB = (bf16*)(F.ws + WS_WUKB); const int h = r >> 3, rr = (r & 7) * 16 + (F.lane >> 2), dc = F.lane & 3; const float* sp = w_uk + (size_t)rr * 512 + h * 64 + dc * 16;
            const f32x4 a = *(const f32x4*)sp, b = *(const f32x4*)(sp + 4), c4 = *(const f32x4*)(sp + 8), d4 = *(const f32x4*)(sp + 12);
            GAS v4u* dp = (GAS v4u*)(WukB + (size_t)(h * 128 + rr) * 64 + dc * 16);
            dp[0] = (v4u){pkbf(a.x, a.y), pkbf(a.z, a.w), pkbf(b.x, b.y), pkbf(b.z, b.w)}; dp[1] = (v4u){pkbf(c4.x, c4.y), pkbf(c4.z, c4.w), pkbf(d4.x, d4.y), pkbf(d4.z, d4.w)};
            continue; } r -= I_FQ;
        if (r < I_FO) {
            bf16* WuvT = (bf16*)(F.ws + WS_WUVT); const int h = r >> 3, dp = (r & 7) * 8 + (F.lane >> 3), c0 = (F.lane & 7) * 2;
#pragma unroll
            for (int cc = 0; cc < 2; ++cc) { const int cidx = c0 + cc, ks = cidx >> 1, hh = cidx & 1; float v[8];
#pragma unroll
                for (int j = 0; j < 8; ++j) v[j] = w_uv[(size_t)(16 * ks + 8 * (j >> 2) + 4 * hh + (j & 3)) * 512 + h * 64 + dp];
                *(GAS v4u*)(WuvT + (size_t)(h * 64 + dp) * 128 + cidx * 8) = (v4u){pkbf(v[0], v[1]), pkbf(v[2], v[3]), pkbf(v[4], v[5]), pkbf(v[6], v[7])}; }
            continue; } r -= I_FO;
        if (r < I_FP) { fold_pb(w_pg, pscale, w_bp, Wpb_t, r, F.lane); continue; } r -= I_FP;
        if (r < I_Z) { *(GAS v4u*)(Win_t + bl_off(1224 + r, F.lane * 8, 1024)) = (v4u){0u, 0u, 0u, 0u}; *(GAS v4u*)(Win_t + bl_off(1224 + r, (F.lane + 64) * 8, 1024)) = (v4u){0u, 0u, 0u, 0u}; continue; } r -= I_Z;
        if (r < I_WI) { tr_item(w_in, INC, r * 64, O_WI, 8, 0.35355339059327373f, Win_t, 1024, 1216, scr, F.lane); continue; } r -= I_WI;
        {
            const float* w_r = frame_in(15); bf16* WrB = (bf16*)(F.ws + WS_WRB); const int ks = r, e = F.lane & 31, h8 = F.lane >> 5; float v[8]; unsigned hi[4], lo[4];
#pragma unroll
            for (int j = 0; j < 8; ++j) v[j] = w_r[(size_t)(16 * ks + 8 * h8 + j) * 32 + e];
#pragma unroll
            for (int j = 0; j < 4; ++j) { hi[j] = pkbf(v[2 * j], v[2 * j + 1]); lo[j] = pkbf(v[2 * j] - __uint_as_float(hi[j] << 16), v[2 * j + 1] - __uint_as_float(hi[j] & 0xffff0000u)); }
            *(GAS v4u*)(WrB + ((size_t)(ks * 2) * 64 + F.lane) * 8) = (v4u){hi[0], hi[1], hi[2], hi[3]}; *(GAS v4u*)(WrB + ((size_t)(ks * 2 + 1) * 64 + F.lane) * 8) = (v4u){lo[0], lo[1], lo[2], lo[3]}; }
    }
    constexpr int I_Q = 128, I_QI = 128, I_CKV = 32, I_KI = 16, I_U = 128, I_G = 512, I_OUT = 256, I_BA = 128, I_GU = 32 * 512, I_D = 32 * 256;
    constexpr int NTR = I_Q + I_QI + I_CKV + I_KI + I_U + I_G + I_OUT + I_BA + (VAR >= 1 ? 0 : I_GU + I_D);
    auto decode = [&](int r) -> TrDesc {
        if (r < I_Q) return TrDesc{w_in + (size_t)((r >> 3) * 64) * INC + O_Q + (r & 7) * 64, Win_t + bl_off((r & 7) * 64, (r >> 3) * 64, 1024), INC, 0.125f * LOG2E}; r -= I_Q;
        if (r < I_QI) return TrDesc{w_in + (size_t)((r >> 3) * 64) * INC + O_QI + (r & 7) * 64, Win_t + bl_off(512 + (r & 7) * 64, (r >> 3) * 64, 1024), INC, 0.125f}; r -= I_QI;
        if (r < I_CKV) return TrDesc{w_in + (size_t)((r >> 1) * 64) * INC + O_CKV + (r & 1) * 64, Win_t + bl_off(1024 + (r & 1) * 64, (r >> 1) * 64, 1024), INC, 1.f}; r -= I_CKV;
        if (r < I_KI) return TrDesc{w_in + (size_t)(r * 64) * INC + O_KI, Win_t + bl_off(1152, r * 64, 1024), INC, 1.f}; r -= I_KI;
        if (r < I_U) return TrDesc{w_in + (size_t)((r >> 3) * 64) * INC + O_U + (r & 7) * 64, Win_t + bl_off(1280 + (r & 7) * 64, (r >> 3) * 64, 1024), INC, 1.f}; r -= I_U;
        if (r < I_G) return TrDesc{w_in + (size_t)((r >> 5) * 64) * INC + O_G + (r & 31) * 64, Win_t + bl_off(1792 + (r & 31) * 64, (r >> 5) * 64, 1024), INC, 1.f}; r -= I_G;
        if (r < I_OUT) return TrDesc{w_out + (size_t)((r >> 4) * 64) * 1024 + (r & 15) * 64, Wout_t + bl_off((r & 15) * 64, (r >> 4) * 64, 1024), 1024, 1.f}; r -= I_OUT;
        if (r < I_BA) return TrDesc{w_ba + (size_t)((r >> 4) * 64) * 1024 + (r & 15) * 64, (bf16*)(F.ws + WS_WBA) + bl_off((r & 15) * 64, (r >> 4) * 64, 512), 1024, 1.f}; r -= I_BA;
        if (r < I_GU) { const int e = r >> 9, q = r & 511, kb = q >> 5, n0 = (q & 31) * 64;
            const int drow = (n0 < 1024) ? ((n0 >> 7) * 256 + (n0 & 127)) : (((n0 - 1024) >> 7) * 256 + 128 + ((n0 - 1024) & 127));
            return TrDesc{w_gu + ((size_t)e * 1024 + kb * 64) * 2048 + n0, Wgu_t + bl_off(e * 2048 + drow, kb * 64, 1024), 2048, 1.f}; } r -= I_GU;
        { const int e = r >> 8, q = r & 255, kb = q >> 4, n0 = (q & 15) * 64;
          return TrDesc{w_d + ((size_t)e * 1024 + kb * 64) * 1024 + n0, Wd_t + bl_off(e * 1024 + n0, kb * 64, 1024), 1024, 1.f}; }
    };
    {   f32x4 vA[16], vB[16]; TrDesc dA, dB; int it = gw;
        if (it < NTR) { dA = decode(it); tr_load(dA, F.lane, vA); }
        while (it < NTR) {
            int itn = it + NGW; if (itn < NTR) { dB = decode(itn); tr_load(dB, F.lane, vB); }
            tr_finish(dA, scr8, F.lane, vA);
            it = itn; if (it >= NTR) break;
            itn = it + NGW; if (itn < NTR) { dA = decode(itn); tr_load(dA, F.lane, vA); }
            tr_finish(dB, scr8, F.lane, vB);
            it = itn;
        }
    }
}
__device__ __forceinline__ void p1_modulate(Frame& F) {
    const float* x = frame_in(0); const float* MOD = (const float*)(F.ws + WS_MOD); bf16* H = (bf16*)(F.ws + WS_H);
    const int gw = F.vcu * NWAVES + F.wave, NGW = F.G * NWAVES;
    for (int m = gw; m < T; m += NGW) { const int b = m >> 11;
        const GAS f32x4* xr = (const GAS f32x4*)(x + (size_t)m * D) + F.lane;
#pragma unroll
        for (int j = 0; j < 4; ++j) { const f32x4 v = xr[64 * j]; const int col = 4 * F.lane + 256 * j;
            const f32x4 sh = *(const f32x4*)(MOD + b * 6144 + col), sc = *(const f32x4*)(MOD + b * 6144 + 1024 + col);
            const f32x4 h = v * (sc + 1.0f) + sh;
            *(GAS unsigned long long*)(H + bl_off(m, col, D)) = (unsigned long long)pk2(h.x, h.y) | ((unsigned long long)pk2(h.z, h.w) << 32); }
    }
}
constexpr int MOE_TAB_SLOTS = 10, LC_ROWTAB = LDSCTL_OFF + 8192;
constexpr int LC_LCNT = LDSCTL_OFF + 1024, LC_BASE = LDSCTL_OFF + 1280, LC_TSTART = LDSCTL_OFF + 1536, LC_LIST = LDSCTL_OFF + 4096;
namespace pg8 {
__device__ __forceinline__ float bfl(unsigned w) { return __uint_as_float(w << 16); }
__device__ __forceinline__ float bfh(unsigned w) { return __uint_as_float(w & 0xffff0000u); }
struct EpiGateMul {
    static constexpr bool PERM = true, AFTER_DRAIN = false;
    bf16_t* O; const bf16_t* SG; int goff, pad;
    __device__ __forceinline__ void operator()(const f32x4 (&acc)[2][2][4][2], const Unit& u, int wr, int wc, int fr, int fq) const {
        const int row0 = u.pm * BM + wr * 64 + fr, col0 = u.pn * BM + wc * 32 + 8 * fq;
#pragma unroll
        for (int ai = 0; ai < 2; ++ai)
#pragma unroll
            for (int m = 0; m < 4; ++m) { const size_t row = (size_t)(row0 + ai * HALF + m * 16);
#pragma unroll
                for (int bj = 0; bj < 2; ++bj) { const u32x4 g = *(const u32x4*)(SG + row * 2048 + goff + col0 + bj * HALF); const f32x4 v0 = acc[ai][bj][m][0], v1 = acc[ai][bj][m][1];
                    u32x4 w; w.x = cvt_pk_bf16(v0[0] * bfl(g.x), v0[1] * bfh(g.x)); w.y = cvt_pk_bf16(v0[2] * bfl(g.y), v0[3] * bfh(g.y));
                    w.z = cvt_pk_bf16(v1[0] * bfl(g.z), v1[1] * bfh(g.z)); w.w = cvt_pk_bf16(v1[2] * bfl(g.w), v1[3] * bfh(g.w));
                    *(u32x4*)(O + row * 1024 + col0 + bj * HALF) = w; } }
    }
};
struct EpiGateAdd {
    static constexpr bool PERM = true, AFTER_DRAIN = false;
    bf16_t* O; const bf16_t* TMPB; const bf16_t* SG; int goff, pad;
    __device__ __forceinline__ void operator()(const f32x4 (&acc)[2][2][4][2], const Unit& u, int wr, int wc, int fr, int fq) const {
        const int row0 = u.pm * BM + wr * 64 + fr, col0 = u.pn * BM + wc * 32 + 8 * fq;
#pragma unroll
        for (int ai = 0; ai < 2; ++ai)
#pragma unroll
            for (int m = 0; m < 4; ++m) { const size_t row = (size_t)(row0 + ai * HALF + m * 16);
#pragma unroll
                for (int bj = 0; bj < 2; ++bj) { const u32x4 g = *(const u32x4*)(SG + row * 2048 + goff + col0 + bj * HALF); const u32x4 t = *(const u32x4*)(TMPB + row * 1024 + col0 + bj * HALF);
                    const f32x4 v0 = acc[ai][bj][m][0], v1 = acc[ai][bj][m][1];
                    u32x4 w; w.x = cvt_pk_bf16(bfl(t.x) + v0[0] * bfl(g.x), bfh(t.x) + v0[1] * bfh(g.x)); w.y = cvt_pk_bf16(bfl(t.y) + v0[2] * bfl(g.y), bfh(t.y) + v0[3] * bfh(g.y));
                    w.z = cvt_pk_bf16(bfl(t.z) + v1[0] * bfl(g.z), bfh(t.z) + v1[1] * bfh(g.z)); w.w = cvt_pk_bf16(bfl(t.w) + v1[2] * bfl(g.w), bfh(t.w) + v1[3] * bfh(g.w));
                    *(u32x4*)(O + bl_off((int)row, col0 + bj * HALF, 1024)) = w; } }
    }
};
struct EpiResid {
    static constexpr bool PERM = false, AFTER_DRAIN = false;
    float* Z; const float* x; const float* gate;
    __device__ __forceinline__ void operator()(const f32x4 (&acc)[2][2][4][2], const Unit& u, int wr, int wc, int fr, int fq) const {
        const int row0 = u.pm * BM + wr * 64 + fr, col0 = u.pn * BM + wc * 32 + 4 * fq; const int b = (u.pm * BM) >> 11;
        f32x4 gv[2][2];
#pragma unroll
        for (int bj = 0; bj < 2; ++bj)
#pragma unroll
            for (int n = 0; n < 2; ++n) gv[bj][n] = *(const f32x4*)(gate + b * 6144 + col0 + bj * HALF + n * 16);
#pragma unroll
        for (int ai = 0; ai < 2; ++ai)
#pragma unroll
            for (int m = 0; m < 4; ++m) { const size_t off = (size_t)(row0 + ai * HALF + m * 16) * 1024 + col0;
#pragma unroll
                for (int bj = 0; bj < 2; ++bj)
#pragma unroll
                    for (int n = 0; n < 2; ++n) { const f32x4 xv = *(const f32x4*)(x + off + bj * HALF + n * 16); *(f32x4*)(Z + off + bj * HALF + n * 16) = xv * ALPHA + gv[bj][n] * acc[ai][bj][m][n]; } }
    }
};
struct EpiSwiglu {
    static constexpr bool PERM = true, AFTER_DRAIN = false;
    bf16_t* ACT; const float* bgu;
    __device__ __forceinline__ void operator()(const f32x4 (&acc)[2][2][4][2], const Unit& u, int wr, int wc, int fr, int fq) const {
        const int e = u.pn >> 3, j = u.pn & 7; const int row0 = u.pm * BM + wr * 64 + fr, cc = wc * 32 + 8 * fq;
        const float* bg = bgu + e * 2048 + j * 128 + cc; f32x4 bgl[2], bli[2];
#pragma unroll
        for (int n = 0; n < 2; ++n) { bgl[n] = *(const f32x4*)(bg + 4 * n); bli[n] = *(const f32x4*)(bg + 1024 + 4 * n); }
#pragma unroll
        for (int ai = 0; ai < 2; ++ai)
#pragma unroll
            for (int m = 0; m < 4; ++m) { float o[8];
#pragma unroll
                for (int n = 0; n < 2; ++n) { const f32x4 gl4 = acc[ai][0][m][n] + bgl[n], li4 = acc[ai][1][m][n] + bli[n];
#pragma unroll
                    for (int i = 0; i < 4; ++i) { const float gl = fminf(gl4[i], 7.f), li = fminf(fmaxf(li4[i], -7.f), 7.f);
                        o[4 * n + i] = gl * __builtin_amdgcn_rcpf(1.f + __builtin_amdgcn_exp2f(gl * (-1.702f * LOG2E))) * (li + 1.f); } }
                u32x4 w; w.x = cvt_pk_bf16(o[0], o[1]); w.y = cvt_pk_bf16(o[2], o[3]); w.z = cvt_pk_bf16(o[4], o[5]); w.w = cvt_pk_bf16(o[6], o[7]);
                *(u32x4*)(ACT + bl_off(row0 + ai * HALF + m * 16, j * 128 + cc, 1024)) = w; }
    }
};
template <bool BIAS>
struct EpiDownT {
    static constexpr bool PERM = true, AFTER_DRAIN = false;
    bf16_t* Y; const float* bd;
    __device__ __forceinline__ void operator()(const f32x4 (&acc)[2][2][4][2], const Unit& u, int wr, int wc, int fr, int fq) const {
        const int e = u.pn >> 2, j = u.pn & 3; const int row0 = u.pm * BM + wr * 64 + fr, col0 = j * 256 + wc * 32 + 8 * fq;
        f32x4 bv[2][2];
#pragma unroll
        for (int bj = 0; bj < 2; ++bj)
#pragma unroll
            for (int n = 0; n < 2; ++n) bv[bj][n] = BIAS ? *(const f32x4*)(bd + e * 1024 + col0 + bj * HALF + 4 * n) : (f32x4){0.f, 0.f, 0.f, 0.f};
#pragma unroll
        for (int ai = 0; ai < 2; ++ai)
#pragma unroll
            for (int m = 0; m < 4; ++m) { bf16_t* rowp = Y + (size_t)(row0 + ai * HALF + m * 16) * 1024 + col0;
#pragma unroll
                for (int bj = 0; bj < 2; ++bj) { const f32x4 v0 = acc[ai][bj][m][0] + bv[bj][0], v1 = acc[ai][bj][m][1] + bv[bj][1];
                    u32x4 w; w.x = cvt_pk_bf16(v0[0], v0[1]); w.y = cvt_pk_bf16(v0[2], v0[3]); w.z = cvt_pk_bf16(v1[0], v1[1]); w.w = cvt_pk_bf16(v1[2], v1[3]);
                    *(u32x4*)(rowp + bj * HALF) = w; } }
    }
};
typedef EpiDownT<true> EpiDown;
template <bool GATHER_, bool REV = false>
struct MoeOrderT {
    static constexpr bool GATHER = GATHER_;
    const PG8_LAS int* tstart; int NT, G, c;
    const PG8_LAS int* rowtab; const int* slotmap; const int* cnt;
    __device__ __forceinline__ int arow(int slot, const Unit& u, int r) const {
        if (slot < MOE_TAB_SLOTS) return rowtab[slot * 256 + r];
        const int e = u.pn / NT, rank = (u.pm - tstart[e]) * 256 + r; return rank < cnt[e] ? slotmap[e * T + rank] : 0;
    }
    __device__ __forceinline__ bool next(int i, Unit& u) const {
        const int x = c & 7, li = c >> 3, per = G >> 3; int L = i * per + li;
#pragma unroll 1
        for (int j = 0; j < 4; ++j) { const int e = REV ? x + 8 * (3 - j) : x + 8 * j; const int nte = tstart[e + 1] - tstart[e], nu = nte * NT;
            if (L < nu) { u.pm = tstart[e] + L % nte; u.pn = e * NT + L / nte; return true; }
            L -= nu; }
        return false;
    }
    __device__ __forceinline__ void a_ready(const Unit&) const {}
    __device__ __forceinline__ void done(const Unit&) const {}
};
typedef MoeOrderT<true> MoeOrderG; typedef MoeOrderT<false, true> MoeOrder;
}

__device__ __forceinline__ float wave_sum(float v) {
#pragma unroll
    for (int o = 1; o < 64; o <<= 1) v += __shfl_xor(v, o);
    return v;
}
__device__ __forceinline__ void p3_post(Frame& F) {
    const float* MISC = (const float*)(F.ws + WS_MISC); const float* kvg = frame_in(5); bf16* CKV = (bf16*)(F.ws + WS_CKV); bf16* CKVT = (bf16*)(F.ws + WS_CKVT);
    const bf16* U = (const bf16*)(F.ws + WS_U); bf16* POOLED = (bf16*)(F.ws + WS_POOLED);
    LAS bf16* tile = (LAS bf16*)(F.lds);
    for (int task = blockIdx.x; task < 256; task += F.G) {
        const int t0 = task * 64; const int row = F.tid >> 3, seg = F.tid & 7;
        const float* src = MISC + (size_t)(t0 + row) * 256 + seg * 16; f32x4 v[4]; float ss = 0.f;
#pragma unroll
        for (int i = 0; i < 4; ++i) { v[i] = *(const f32x4*)(src + 4 * i); ss += (v[i].x * v[i].x + v[i].y * v[i].y) + (v[i].z * v[i].z + v[i].w * v[i].w); }
        ss += __shfl_xor(ss, 1); ss += __shfl_xor(ss, 2); ss += __shfl_xor(ss, 4);
        const float rs = 1.0f / sqrtf(ss * (1.f / 128.f) + LN_EPS);
        unsigned w[8];
#pragma unroll
        for (int i = 0; i < 4; ++i) { const f32x4 g = *(const f32x4*)(kvg + seg * 16 + 4 * i); w[2 * i] = pk2(v[i].x * rs * g.x, v[i].y * rs * g.y); w[2 * i + 1] = pk2(v[i].z * rs * g.z, v[i].w * rs * g.w); }
        GAS v4u* dst = (GAS v4u*)(CKV + (size_t)(t0 + row) * 128 + seg * 16); dst[0] = (v4u){w[0], w[1], w[4], w[5]}; dst[1] = (v4u){w[2], w[3], w[6], w[7]};
        LAS v4u* lt = (LAS v4u*)(tile + row * 128 + seg * 16); lt[0] = (v4u){w[0], w[1], w[2], w[3]}; lt[1] = (v4u){w[4], w[5], w[6], w[7]};
        __syncthreads();
        { const int d = F.tid >> 2, part = F.tid & 3; unsigned o[8];
#pragma unroll
          for (int q = 0; q < 16; q += 2) { unsigned pr[2];
#pragma unroll
              for (int z = 0; z < 2; ++z) { const int p = part * 16 + q + z; const int j = p & 7, h = (p >> 3) & 1, tt = (p >> 4) & 1, kb = p >> 5; const int key = kb * 32 + 16 * tt + 8 * (j >> 2) + 4 * h + (j & 3); pr[z] = tile[key * 128 + d]; }
              o[q >> 1] = pr[0] | (pr[1] << 16); }
          const int b = task >> 5, kt = task & 31;
          GAS v4u* dt = (GAS v4u*)(CKVT + ((size_t)(b * 128 + d) * 2048) + kt * 64 + part * 16); dt[0] = (v4u){o[0], o[1], o[2], o[3]}; dt[1] = (v4u){o[4], o[5], o[6], o[7]}; }
        __syncthreads();
    }
    LAS bf16* ut = (LAS bf16*)(F.lds + 16384);
    for (int task = blockIdx.x; task < 256; task += F.G) { const int t0 = task * 64, s0 = t0 & 2047;
        __syncthreads();
#pragma unroll
        for (int i = 0; i < 10; ++i) { const int c = F.tid + 512 * i, row = c >> 6, ch = c & 63; const int sp = s0 - 16 + row;
            v4u v = (v4u){0u, 0u, 0u, 0u}; if (sp >= 0) v = *(const GAS v4u*)(U + (size_t)(t0 - 16 + row) * 512 + ch * 8);
            *(LAS v4u*)(ut + row * 512 + ch * 8) = v; }
        __syncthreads();
        const int c = F.tid, g = c >> 7, w = 2 << g; float win = 0.f;
        for (int j = 16 - w; j < 16; ++j) win += bf2f(ut[j * 512 + c]);
        for (int j = 16; j < 80; ++j) { const float cur = bf2f(ut[j * 512 + c]); win += cur; win -= bf2f(ut[(j - w) * 512 + c]);
            const int sq = s0 + j - 16; const int cntw = (sq + 1 < w) ? (sq + 1) : w; POOLED[bl_off(t0 + j - 16, c, 512)] = (bf16)f2bf(win / (float)cntw - cur); }
    }
}
constexpr int P7_AL = 0, P7_LOGIT = 131072 - 4096;
__device__ __forceinline__ void p7_ln1_route(Frame& F, int cw_gcnt) {
    const float* Z = (const float*)(F.ws + WS_Z); const float* g1 = frame_in(13); const float* b1 = frame_in(14); const float* b_r = frame_in(16);
    const float* MOD = (const float*)(F.ws + WS_MOD); float* X1 = (float*)(F.ws + WS_X1); bf16* H2 = (bf16*)(F.ws + WS_H); const bf16* WrB = (const bf16*)(F.ws + WS_WRB);
    int* gcnt = (int*)(F.ctl + cw_gcnt); int* SLOTMAP = (int*)(F.ws + WS_SLOTMAP); int* TOKSLOT = (int*)(F.ws + WS_TOKSLOT); float* GATE = (float*)(F.ws + WS_GATE);
    LAS unsigned char* AL = F.lds + P7_AL; LAS float* red = (LAS float*)(F.lds);
    LAS float* logit = (LAS float*)(F.lds + 65536);
    LAS int* lcnt = (LAS int*)(F.lds + LC_LCNT); LAS int* lbase = (LAS int*)(F.lds + LC_BASE); LAS int* list = (LAS int*)(F.lds + LC_LIST);
    if (F.tid < 32) lcnt[F.tid] = 0;
    const int hh = F.lane >> 5, l31 = F.lane & 31;
    bf16x8 Bh[8], Bl[8];
#pragma unroll
    for (int s = 0; s < 8; ++s) { const bf16* p = WrB + ((size_t)((F.wave * 8 + s) * 2) * 64 + F.lane) * 8; Bh[s] = *(const GAS bf16x8*)p; Bl[s] = *(const GAS bf16x8*)(p + 64 * 8); }
    const int rows_per_wg = T / F.G;
    for (int step = 0; step < rows_per_wg / 32; ++step) { const int m0 = blockIdx.x * rows_per_wg + step * 32;
        __syncthreads();
#pragma unroll 1
        for (int rr = 0; rr < 4; ++rr) { const int row = F.wave * 4 + rr, m = m0 + row, b = m >> 11;
            const GAS f32x4* zr = (const GAS f32x4*)(Z + (size_t)m * D) + F.lane; f32x4 v[4]; float s = 0.f;
#pragma unroll
            for (int j = 0; j < 4; ++j) { v[j] = zr[64 * j]; s += (v[j].x + v[j].y) + (v[j].z + v[j].w); }
            const float mean = wave_sum(s) * (1.f / D); float s2 = 0.f;
#pragma unroll
            for (int j = 0; j < 4; ++j) { v[j] = v[j] - mean; s2 += (v[j].x * v[j].x + v[j].y * v[j].y) + (v[j].z * v[j].z + v[j].w * v[j].w); }
            const float rstd = 1.f / sqrtf(wave_sum(s2) * (1.f / D) + LN_EPS);
#pragma unroll
            for (int j = 0; j < 4; ++j) { const int col = 4 * F.lane + 256 * j;
                const f32x4 gg = *(const f32x4*)(g1 + col), bb = *(const f32x4*)(b1 + col); const f32x4 x1 = v[j] * rstd * gg + bb;
                *((GAS f32x4*)(X1 + (size_t)m * D) + F.lane + 64 * j) = x1;
                const f32x4 sh = *(const f32x4*)(MOD + b * 6144 + 3 * 1024 + col), sc = *(const f32x4*)(MOD + b * 6144 + 4 * 1024 + col); const f32x4 h2 = x1 * (sc + 1.0f) + sh;
                const unsigned h01 = pkbf(h2.x, h2.y), h23 = pkbf(h2.z, h2.w);
                *(GAS unsigned long long*)(H2 + bl_off(m, col, D)) = (unsigned long long)h01 | ((unsigned long long)h23 << 32);
                const unsigned l01 = pkbf(h2.x - pg8::bfl(h01), h2.y - pg8::bfh(h01)), l23 = pkbf(h2.z - pg8::bfl(h23), h2.w - pg8::bfh(h23));
                const int chunk = 32 * j + (F.lane >> 1); const int off = row * 2048 + (((chunk & ~15) | ((chunk ^ row) & 15)) << 4) + (F.lane & 1) * 8;
                *(LAS unsigned long long*)(AL + off) = (unsigned long long)h01 | ((unsigned long long)h23 << 32);
                *(LAS unsigned long long*)(AL + 65536 + off) = (unsigned long long)l01 | ((unsigned long long)l23 << 32); } }
        __syncthreads();
        f32x16 acc;
#pragma unroll
        for (int r = 0; r < 16; ++r) acc[r] = 0.f;
#pragma unroll
        for (int s = 0; s < 8; ++s) { const int chunk = 2 * (F.wave * 8 + s) + hh; const int off = l31 * 2048 + (((chunk & ~15) | ((chunk ^ l31) & 15)) << 4);
            const bf16x8 Ah = *(const LAS bf16x8*)(AL + off), Alo = *(const LAS bf16x8*)(AL + 65536 + off);
            acc = MFMA32(Ah, Bh[s], acc); acc = MFMA32(Ah, Bl[s], acc); acc = MFMA32(Alo, Bh[s], acc); }
        __syncthreads();
#pragma unroll
        for (int r = 0; r < 16; ++r) red[(F.wave * 32 + krow16(r, hh)) * 32 + l31] = acc[r];
        __syncthreads();
        { const int row = F.tid >> 4, e0 = (F.tid & 15) * 2; float s0 = 0.f, s1 = 0.f;
#pragma unroll
          for (int w = 0; w < 8; ++w) { s0 += red[(w * 32 + row) * 32 + e0]; s1 += red[(w * 32 + row) * 32 + e0 + 1]; }
          logit[row * 33 + e0] = s0 + b_r[e0]; logit[row * 33 + e0 + 1] = s1 + b_r[e0 + 1]; }
        __syncthreads();
        if (F.tid < 32) { const int row = F.tid, m = m0 + row; float lg[32];
#pragma unroll
            for (int e = 0; e < 32; ++e) lg[e] = logit[row * 33 + e];
            int se[4]; float sv[4]; unsigned used = 0u;
#pragma unroll
            for (int k = 0; k < 4; ++k) { int best = 0; float bv = -INFINITY; bool have = false;
#pragma unroll
                for (int e = 0; e < 32; ++e) { const bool ok = !((used >> e) & 1u) && (!have || lg[e] > bv); if (ok) { best = e; bv = lg[e]; have = true; } }
                se[k] = best; sv[k] = bv; used |= 1u << best; }
            float ex[4], den = 0.f;
#pragma unroll
            for (int k = 0; k < 4; ++k) { ex[k] = __expf(sv[k] - sv[0]); den += ex[k]; }
            const float inv = 1.f / den;
#pragma unroll
            for (int k = 0; k < 4; ++k) { const int lr = __hip_atomic_fetch_add(&lcnt[se[k]], 1, __ATOMIC_RELAXED, __HIP_MEMORY_SCOPE_WORKGROUP);
                LAS int* ent = list + ((step * 32 + row) * 4 + k) * 4; ent[0] = m; ent[1] = se[k]; ent[2] = lr; ent[3] = __float_as_int(ex[k] * inv); } }
    }
    __syncthreads();
    if (F.tid < 32) lbase[F.tid] = atomicAdd(&gcnt[F.tid], lcnt[F.tid]);
    __syncthreads();
    if (F.tid < 256) { LAS int* ent = list + F.tid * 4; const int m = ent[0], e = ent[1], rank = lbase[e] + ent[2];
        SLOTMAP[e * T + rank] = m; TOKSLOT[m * 4 + (F.tid & 3)] = e | (rank << 8); GATE[m * 4 + (F.tid & 3)] = __int_as_float(ent[3]); }
}
__device__ __forceinline__ void load_tstart(Frame& F) {
    LAS int* ts = (LAS int*)(F.lds + LC_TSTART); const int* gcnt = (const int*)(F.ctl + CW_GCNT);
    if (F.tid == 0) { int a = 0; for (int e = 0; e < 32; ++e) { ts[e] = a; a += (__hip_atomic_load(gcnt + e, __ATOMIC_RELAXED, __HIP_MEMORY_SCOPE_AGENT) + 255) >> 8; } ts[32] = a; }
    __syncthreads();
}
__device__ __forceinline__ void warm_range(Frame& F, const unsigned char* base, size_t bytes) {
    const size_t per = bytes / (size_t)F.G; const GAS v4u* p = (const GAS v4u*)(base + per * (size_t)blockIdx.x) + F.tid; const int n = (int)(per / (512 * 16));
    v4u acc = (v4u){0u, 0u, 0u, 0u};
#pragma unroll 8
    for (int i = 0; i < n; ++i) { const v4u v = __builtin_nontemporal_load(p + (size_t)i * 512); acc.x ^= v.x; acc.y ^= v.y; acc.z ^= v.z; acc.w ^= v.w; }
    asm volatile("" :: "v"(acc.x), "v"(acc.y), "v"(acc.z), "v"(acc.w));
}
__device__ __forceinline__ void moe_fill_rowtab(Frame& F, const pg8::MoeOrderG& S) {
    LAS int* tab = (LAS int*)(F.lds + LC_ROWTAB); const LAS int* ts = (const LAS int*)(F.lds + LC_TSTART);
    for (int slot = 0; slot < MOE_TAB_SLOTS; ++slot) { pg8::Unit u; if (!S.next(slot, u)) break;
        if (F.tid < 256) { const int e = u.pn / S.NT, rank = (u.pm - ts[e]) * 256 + F.tid; tab[slot * 256 + F.tid] = rank < S.cnt[e] ? S.slotmap[e * T + rank] : 0; } }
    __syncthreads();
}
__device__ __forceinline__ void p11_final(Frame& F) {
    load_tstart(F);
    const LAS int* ts = (const LAS int*)(F.lds + LC_TSTART);
    const float* X1 = (const float*)(F.ws + WS_X1); const bf16* Y = (const bf16*)(F.ws + WS_Y); const int* TOKSLOT = (const int*)(F.ws + WS_TOKSLOT); const float* GATE = (const float*)(F.ws + WS_GATE);
    const float* MOD = (const float*)(F.ws + WS_MOD); const float* g2 = frame_in(21); const float* b2 = frame_in(22);
    const int gw = F.vcu * NWAVES + F.wave, NGW = F.G * NWAVES;
    for (int m = gw; m < T; m += NGW) { const int b = m >> 11;
        f32x4 mo[4];
#pragma unroll
        for (int j = 0; j < 4; ++j) mo[j] = (f32x4){0.f, 0.f, 0.f, 0.f};
#pragma unroll
        for (int k = 0; k < 4; ++k) { const int tsl = TOKSLOT[m * 4 + k]; const int e = tsl & 255, rank = tsl >> 8; const float gt = GATE[m * 4 + k];
            const GAS unsigned long long* yr = (const GAS unsigned long long*)(Y + ((size_t)ts[e] * 256 + rank) * D) + F.lane;
#pragma unroll
            for (int j = 0; j < 4; ++j) { const unsigned long long w = yr[64 * j]; const unsigned lo = (unsigned)w, hi = (unsigned)(w >> 32);
                mo[j].x += gt * pg8::bfl(lo); mo[j].y += gt * pg8::bfh(lo); mo[j].z += gt * pg8::bfl(hi); mo[j].w += gt * pg8::bfh(hi); } }
        f32x4 v[4]; float s = 0.f;
#pragma unroll
        for (int j = 0; j < 4; ++j) { const int col = 4 * F.lane + 256 * j; const f32x4 x1 = *((const GAS f32x4*)(X1 + (size_t)m * D) + F.lane + 64 * j);
            const f32x4 g2m = *(const f32x4*)(MOD + b * 6144 + 5 * 1024 + col); v[j] = x1 * ALPHA + g2m * mo[j]; s += (v[j].x + v[j].y) + (v[j].z + v[j].w); }
        const float mean = wave_sum(s) * (1.f / D); float s2 = 0.f;
#pragma unroll
        for (int j = 0; j < 4; ++j) { v[j] = v[j] - mean; s2 += (v[j].x * v[j].x + v[j].y * v[j].y) + (v[j].z * v[j].z + v[j].w * v[j].w); }
        const float rstd = 1.f / sqrtf(wave_sum(s2) * (1.f / D) + LN_EPS);
#pragma unroll
        for (int j = 0; j < 4; ++j) { const int col = 4 * F.lane + 256 * j; const f32x4 gg = *(const f32x4*)(g2 + col), bb = *(const f32x4*)(b2 + col);
            *((GAS f32x4*)(F.out + (size_t)m * D) + F.lane + 64 * j) = v[j] * rstd * gg + bb; }
    }
}
__device__ __forceinline__ unsigned ordkey(float f) { const unsigned u = __float_as_uint(f); return (u & 0x80000000u) ? ~u : (u | 0x80000000u); }

constexpr int SEL_QI = 0, SEL_HIST = 32768, SEL_CAND = 98304, SEL_MASK = 114688, SEL_META = 122880, SEL_CAP = 128;
__device__ __forceinline__ float relu_i(float x) { const int i = __float_as_int(x); return __int_as_float(i > 0 ? i : 0); }
__device__ __forceinline__ void idx_load_a(const bf16* KIb, int kt, int lane, bf16x8 (&A)[4]) {
    const bf16* kp = KIb + (size_t)(kt * 32 + (lane & 31)) * 64 + 8 * (lane >> 5);
#pragma unroll
    for (int s = 0; s < 4; ++s) A[s] = *(const GAS bf16x8*)(kp + 16 * s);
}
__device__ __forceinline__ void idx_scores1(const bf16x8 (&AA)[4], const LAS unsigned char* qiL, const float (&wi)[8], int lane, f32x16& scA) {
    const int hh = lane >> 5, q = lane & 31; const LAS unsigned char* qrow = qiL + q * 1024; const int qs = q & 15;
#pragma unroll
    for (int r = 0; r < 16; ++r) scA[r] = 0.f;
    f32x16 acc[2];
    { bf16x8 B0[4];
#pragma unroll
      for (int s = 0; s < 4; ++s) B0[s] = *(const LAS bf16x8*)(qrow + (((2 * s + hh) ^ qs) << 4));
#pragma unroll
      for (int r = 0; r < 16; ++r) acc[0][r] = 0.f;
#pragma unroll
      for (int s = 0; s < 4; ++s) acc[0] = MFMA32(AA[s], B0[s], acc[0]); }
#pragma unroll
    for (int h = 0; h < 8; ++h) { const int cur = h & 1, nxt = cur ^ 1;
        if (h < 7) { bf16x8 Bn[4];
#pragma unroll
            for (int s = 0; s < 4; ++s) Bn[s] = *(const LAS bf16x8*)(qrow + ((((h + 1) * 8 + 2 * s + hh) ^ qs) << 4));
#pragma unroll
            for (int r = 0; r < 16; ++r) acc[nxt][r] = 0.f;
#pragma unroll
            for (int s = 0; s < 4; ++s) acc[nxt] = MFMA32(AA[s], Bn[s], acc[nxt]); }
#pragma unroll
        for (int r = 0; r < 16; ++r) scA[r] = fmaf(wi[h], relu_i(acc[cur][r]), scA[r]);
        if (h < 7) {
            __builtin_amdgcn_sched_group_barrier(0x100, 4, 0);
#pragma unroll
            for (int i = 0; i < 4; ++i) { __builtin_amdgcn_sched_group_barrier(0x008, 1, 0); __builtin_amdgcn_sched_group_barrier(0x002, 8, 0); } }
    }
}
template <int MODE, int VAR>
__device__ __forceinline__ void sel_tile(Frame& F, const f32x16& sc, int kt, int hh, int q, int qpos, int bst, unsigned pfx, unsigned trial, unsigned& cntl) {
    LAS unsigned* hist = (LAS unsigned*)(F.lds + SEL_HIST); LAS unsigned* cand = (LAS unsigned*)(F.lds + SEL_CAND); LAS unsigned* maskL = (LAS unsigned*)(F.lds + SEL_MASK); LAS int* meta = (LAS int*)(F.lds + SEL_META);
    unsigned word = 0u; const int kbase = kt * 32 + 4 * hh; const int lim = qpos - kbase;
#pragma unroll
    for (int r = 0; r < 16; ++r) { const int kr0 = (r & 3) + 8 * (r >> 2); const bool valid = kr0 <= lim;
        const unsigned bits = __float_as_uint(sc[r]) & 0xFFFFF800u; const float st = __uint_as_float(bits);
        int bin = (int)(st * 64.f) + 256; bin = bin < 0 ? 0 : (bin > 511 ? 511 : bin);
        if (MODE == 0) { if (VAR == 1) { asm volatile("" :: "v"(bin), "v"(valid ? 1u : 0u)); } else __hip_atomic_fetch_add(hist + q * 512 + bin, valid ? 1u : 0u, __ATOMIC_RELAXED, __HIP_MEMORY_SCOPE_WORKGROUP); }
        else { const unsigned ck = (ordkey(st) & 0xFFFFF800u) | (unsigned)(2047 - kbase - kr0);
            if (MODE == 1) { word |= (valid && bin > bst) ? (1u << kr0) : 0u; const bool isc = valid && bin == bst;
                if (isc) { const int slot = __hip_atomic_fetch_add((LAS int*)meta + 64 + q, 1, __ATOMIC_RELAXED, __HIP_MEMORY_SCOPE_WORKGROUP); if (slot < SEL_CAP) cand[q * SEL_CAP + slot] = ck; } }
            if (MODE == 2) { cntl += (valid && ck >= (pfx | trial)) ? 1u : 0u; }
            if (MODE == 3) { word |= (valid && ck >= pfx) ? (1u << kr0) : 0u; } }
        }
    if (MODE == 1 || MODE == 3) __hip_atomic_fetch_or(maskL + q * 64 + kt, word << (4 * hh), __ATOMIC_RELAXED, __HIP_MEMORY_SCOPE_WORKGROUP);
}
template <int MODE, int VAR>
__device__ __forceinline__ void sel_pass(Frame& F, int lane, int wave, const bf16* KIb, int qb, const float (&wi)[8], unsigned trial) {
    const LAS unsigned char* qiL = F.lds + SEL_QI; LAS int* meta = (LAS int*)(F.lds + SEL_META);
    const int bst = meta[lane & 31]; const unsigned pfx = (unsigned)meta[128 + (lane & 31)];
    unsigned cntl = 0u;
    bf16x8 AA[4], NA[4];
    if (wave <= qb) idx_load_a(KIb, wave, lane, AA);
#pragma unroll 1
    for (int kt = wave; kt <= qb; kt += NWAVES) {
        int lane_t = lane; asm volatile("" : "+v"(lane_t));
        const int hh = lane_t >> 5, q = lane_t & 31, qpos = qb * 32 + q;
        if (kt + NWAVES <= qb) idx_load_a(KIb, kt + NWAVES, lane_t, NA);
        f32x16 scA;
        idx_scores1(AA, qiL, wi, lane_t, scA);
        if (VAR == 2) { asm volatile("" :: "v"(scA[0]), "v"(scA[7]), "v"(scA[15])); } else sel_tile<MODE, VAR>(F, scA, kt, hh, q, qpos, bst, pfx, trial, cntl);
#pragma unroll
        for (int s = 0; s < 4; ++s) AA[s] = NA[s];
    }
    if (MODE == 2) __hip_atomic_fetch_add((LAS unsigned*)meta + 160 + (lane & 31), cntl, __ATOMIC_RELAXED, __HIP_MEMORY_SCOPE_WORKGROUP);
}
template <int VAR>
__device__ __forceinline__ void p3_select(Frame& F) {
    const bf16* QI = (const bf16*)(F.ws + WS_QI); const float* MISC = (const float*)(F.ws + WS_MISC); unsigned* MASK = (unsigned*)(F.ws + WS_MASK);
    LAS unsigned* hist = (LAS unsigned*)(F.lds + SEL_HIST); LAS unsigned* cand = (LAS unsigned*)(F.lds + SEL_CAND); LAS unsigned* maskL = (LAS unsigned*)(F.lds + SEL_MASK); LAS int* meta = (LAS int*)(F.lds + SEL_META);
    const int b = blockIdx.x >> 5, ii = blockIdx.x & 31;
    for (int ui = 0; ui < 2; ++ui) { const int qb = ui ? 63 - ii : ii; const int t0 = b * S_ + qb * 32;
        int tid = F.tid; asm volatile("" : "+v"(tid)); const int lane = tid & 63; int wave = F.wave; asm volatile("" : "+s"(wave));
        if (qb < 8) {
            for (int wd = tid; wd < 2048; wd += 512) { const int q = wd >> 6, w = wd & 63, qpos = qb * 32 + q; const int rel = qpos - 32 * w;
                MASK[(size_t)(t0 + q) * 64 + w] = rel >= 31 ? 0xFFFFFFFFu : (rel < 0 ? 0u : ((2u << rel) - 1u)); }
            continue; }
        __syncthreads();
        for (int c = tid; c < 2048; c += 512) { const int q = c >> 6, c16 = c & 63; *(LAS v4u*)(F.lds + SEL_QI + q * 1024 + ((c16 ^ (q & 15)) << 4)) = *(const GAS v4u*)(QI + (size_t)(t0 + q) * 512 + c16 * 8); }
        { unsigned z = 0u; asm volatile("" : "+v"(z)); const v4u z4 = (v4u){z, z, z, z};
          for (int i = tid; i < 16384 / 4; i += 512) ((LAS v4u*)hist)[i] = z4;
          for (int i = tid; i < 2048 / 4; i += 512) ((LAS v4u*)maskL)[i] = z4; }
        if (tid < 192) meta[tid] = 0;
        float wi[8];
#pragma unroll
        for (int h = 0; h < 8; ++h) wi[h] = MISC[(size_t)(t0 + (lane & 31)) * 256 + 192 + h];
        const bf16* KIb = (const bf16*)(F.ws + WS_KI) + (size_t)b * S_ * 64;
        __syncthreads();
        sel_pass<0, VAR>(F, lane, wave, KIb, qb, wi, 0u);
        __syncthreads();
        for (int qq = 0; qq < 4; ++qq) { const int q = wave * 4 + qq; const LAS unsigned* hq = hist + q * 512; unsigned c8[8]; unsigned cs = 0u;
#pragma unroll
            for (int i = 0; i < 8; ++i) { c8[i] = hq[511 - 8 * lane - i]; cs += c8[i]; }
            unsigned incl = cs;
#pragma unroll
            for (int o = 1; o < 64; o <<= 1) { const unsigned v = __shfl_up(incl, o); if (lane >= o) incl += v; }
            const unsigned excl = incl - cs;
            if (excl < 256u && incl >= 256u) { unsigned run = excl;
#pragma unroll
                for (int i = 0; i < 8; ++i) { const unsigned before = run; run += c8[i]; if (before < 256u && run >= 256u) { meta[q] = 511 - 8 * lane - i; meta[32 + q] = (int)(256u - before); } } } }
        __syncthreads();
        sel_pass<1, VAR>(F, lane, wave, KIb, qb, wi, 0u);
        __syncthreads();
        if (tid < 32) { if (meta[64 + tid] > SEL_CAP) meta[96] = 1; }
        __syncthreads();
        if (meta[96] == 0) {
            for (int item = tid; item < 32 * SEL_CAP; item += 512) { const int q = item >> 7, i = item & (SEL_CAP - 1); const int n = meta[64 + q];
                if (i < n) { const unsigned my = cand[q * SEL_CAP + i]; int rank = 0; for (int j = 0; j < n; ++j) rank += (cand[q * SEL_CAP + j] > my) ? 1 : 0;
                    if (rank < meta[32 + q]) { const int idx = 2047 - (int)(my & 0x7FFu); __hip_atomic_fetch_or(maskL + q * 64 + (idx >> 5), 1u << (idx & 31), __ATOMIC_RELAXED, __HIP_MEMORY_SCOPE_WORKGROUP); } } }
        } else {
#pragma unroll 1
            for (int bit = 31; bit >= 0; --bit) {
                sel_pass<2, VAR>(F, lane, wave, KIb, qb, wi, 1u << bit);
                __syncthreads();
                if (tid < 32) { if ((unsigned)meta[160 + tid] >= 256u) meta[128 + tid] |= (int)(1u << bit); meta[160 + tid] = 0; }
                __syncthreads(); }
            sel_pass<3, VAR>(F, lane, wave, KIb, qb, wi, 0u);
        }
        __syncthreads();
        { const int q = tid >> 4, w4 = (tid & 15) * 4; *(GAS v4u*)(MASK + (size_t)(t0 + q) * 64 + w4) = *(const LAS v4u*)(maskL + q * 64 + w4); }
    }
}
typedef unsigned u32x2v __attribute__((ext_vector_type(2)));
constexpr int ATT_K = 0, ATT_VT = 65536;
__device__ __forceinline__ void att_load(const bf16* CKV, const bf16* CKVT, int b, int j, int tid, v4u (&st)[4]) {
#pragma unroll
    for (int i = 0; i < 2; ++i) { const int c = tid + 512 * i; st[i] = *(const GAS v4u*)(CKV + (size_t)(b * S_ + 64 * j) * 128 + c * 8); }
#pragma unroll
    for (int i = 0; i < 2; ++i) { const int c = tid + 512 * i, d = c >> 3, ch = c & 7; st[2 + i] = *(const GAS v4u*)(CKVT + (size_t)(b * 128 + d) * 2048 + 64 * j + ch * 8); }
}
__device__ __forceinline__ void att_store(LAS unsigned char* lds, int buf, int tid, const v4u (&st)[4]) {
#pragma unroll
    for (int i = 0; i < 2; ++i) { const int c = tid + 512 * i, row = c >> 4, ch = c & 15; *(LAS v4u*)(lds + ATT_K + buf * 16384 + row * 256 + ((ch ^ (row & 15)) << 4)) = st[i]; }
#pragma unroll
    for (int i = 0; i < 2; ++i) { const int c = tid + 512 * i, d = c >> 3, ch = c & 7; *(LAS v4u*)(lds + ATT_VT + buf * 16384 + d * 128 + ((ch ^ ((d >> 1) & 7)) << 4)) = st[2 + i]; }
}
__device__ __forceinline__ void att_tile(const LAS unsigned char* lds, int buf, int j, u32x2v mw, const bf16x8 (&Qf)[8], f32x16 (&O)[4], float& m_run, float& l_run, float slope2, int hh, int q, int qpos) {
    f32x16 S0, S1;
#pragma unroll
    for (int r = 0; r < 16; ++r) { S0[r] = 0.f; S1[r] = 0.f; }
    const LAS unsigned char* kb0 = lds + ATT_K + buf * 16384 + q * 256, * kb1 = kb0 + 32 * 256;
    { bf16x8 Kf[16];
#pragma unroll
      for (int s = 0; s < 8; ++s) { const int sw = ((2 * s + hh) ^ (q & 15)) << 4; Kf[2 * s] = *(const LAS bf16x8*)(kb0 + sw); Kf[2 * s + 1] = *(const LAS bf16x8*)(kb1 + sw); }
#pragma unroll
      for (int s = 0; s < 8; ++s) { S0 = MFMA32(Kf[2 * s], Qf[s], S0); S1 = MFMA32(Kf[2 * s + 1], Qf[s], S1); }
      __builtin_amdgcn_sched_group_barrier(0x100, 4, 0);
#pragma unroll
      for (int i = 0; i < 6; ++i) { __builtin_amdgcn_sched_group_barrier(0x008, 2, 0); __builtin_amdgcn_sched_group_barrier(0x100, 2, 0); }
      __builtin_amdgcn_sched_group_barrier(0x008, 4, 0); }
    const LAS unsigned char* vb = lds + ATT_VT + buf * 16384;
    const unsigned mlo = mw.x >> (4 * hh), mhi = mw.y >> (4 * hh);
    const float base0 = slope2 * (float)(64 * j + 4 * hh - qpos);
    float tmax = -INFINITY;
#pragma unroll
    for (int r = 0; r < 16; ++r) { const int kr = (r & 3) + 8 * (r >> 2);
        float s0 = S0[r] + (base0 + slope2 * (float)kr), s1 = S1[r] + (base0 + slope2 * (float)(kr + 32));
        s0 = ((mlo >> kr) & 1u) ? s0 : -INFINITY; s1 = ((mhi >> kr) & 1u) ? s1 : -INFINITY;
        S0[r] = s0; S1[r] = s1; tmax = fmaxf(tmax, fmaxf(s0, s1)); }
    { const auto rr = __builtin_amdgcn_permlane32_swap(__float_as_uint(tmax), __float_as_uint(tmax), false, false); tmax = fmaxf(__uint_as_float(rr[0]), __uint_as_float(rr[1])); }
    const float m_new = fmaxf(m_run, tmax), msafe = (m_new == -INFINITY) ? 0.f : m_new;
    const float alpha = __builtin_amdgcn_exp2f(m_run - msafe);
    float ps = 0.f;
#pragma unroll
    for (int r = 0; r < 16; ++r) { S0[r] = __builtin_amdgcn_exp2f(S0[r] - msafe); S1[r] = __builtin_amdgcn_exp2f(S1[r] - msafe); ps += S0[r] + S1[r]; }
    l_run = l_run * alpha + ps; m_run = m_new;
    if (__any(alpha != 1.f)) {
#pragma unroll
        for (int db = 0; db < 4; ++db)
#pragma unroll
            for (int r = 0; r < 16; ++r) O[db][r] *= alpha; }
    bf16x8 Pf[4];
    Pf[0] = pack8(S0[0], S0[1], S0[2], S0[3], S0[4], S0[5], S0[6], S0[7]); Pf[1] = pack8(S0[8], S0[9], S0[10], S0[11], S0[12], S0[13], S0[14], S0[15]);
    Pf[2] = pack8(S1[0], S1[1], S1[2], S1[3], S1[4], S1[5], S1[6], S1[7]); Pf[3] = pack8(S1[8], S1[9], S1[10], S1[11], S1[12], S1[13], S1[14], S1[15]);
    { bf16x8 Vf[16];
#pragma unroll
      for (int db = 0; db < 4; ++db) { const int d = db * 32 + q; const LAS unsigned char* vr = vb + d * 128; const int sx = (d >> 1) & 7;
#pragma unroll
          for (int c2 = 0; c2 < 4; ++c2) Vf[db * 4 + c2] = *(const LAS bf16x8*)(vr + (((c2 * 2 + hh) ^ sx) << 4)); }
#pragma unroll
      for (int db = 0; db < 4; ++db)
#pragma unroll
          for (int c2 = 0; c2 < 4; ++c2) O[db] = MFMA32(Vf[db * 4 + c2], Pf[c2], O[db]);
      __builtin_amdgcn_sched_group_barrier(0x100, 4, 0);
#pragma unroll
      for (int i = 0; i < 6; ++i) { __builtin_amdgcn_sched_group_barrier(0x008, 2, 0); __builtin_amdgcn_sched_group_barrier(0x100, 2, 0); }
      __builtin_amdgcn_sched_group_barrier(0x008, 4, 0); }
}
__device__ __forceinline__ void p4_attention(Frame& F) {
    const bf16* QL = (const bf16*)(F.ws + WS_QL); const bf16* CKV = (const bf16*)(F.ws + WS_CKV); const bf16* CKVT = (const bf16*)(F.ws + WS_CKVT);
    const unsigned* MASK = (const unsigned*)(F.ws + WS_MASK);
    const int b = blockIdx.x >> 5, ii = blockIdx.x & 31;
    for (int ui = 0; ui < 2; ++ui) { const int qb = ui ? 63 - ii : ii;
        int lane; asm volatile("v_mbcnt_lo_u32_b32 %0, -1, 0\n\tv_mbcnt_hi_u32_b32 %0, -1, %0" : "=v"(lane)); int head = F.wave; asm volatile("" : "+s"(head)); const int tid = head * 64 + lane;
        const int hh = lane >> 5, q = lane & 31; const float slope2 = __builtin_amdgcn_exp2f(-(float)(head + 1)) * LOG2E;
        const int t0 = b * S_ + qb * 32, qpos = qb * 32 + q; const int nt = (qb >> 1) + 1;
        bf16x8 Qf[8];
        {
            const bf16* WukB = (const bf16*)(F.ws + WS_WUKB); bf16x8 qB[4];
#pragma unroll
            for (int ks = 0; ks < 4; ++ks) qB[ks] = *(const GAS bf16x8*)(QL + (size_t)(t0 + q) * 512 + head * 64 + 16 * ks + 8 * hh);
#pragma unroll
            for (int rb = 0; rb < 4; ++rb) { f32x16 X;
#pragma unroll
                for (int r = 0; r < 16; ++r) X[r] = 0.f;
                const bf16* wr = WukB + (size_t)(head * 128 + rb * 32 + q) * 64 + 8 * hh;
#pragma unroll
                for (int ks = 0; ks < 4; ++ks) { const bf16x8 Aw = *(const GAS bf16x8*)(wr + 16 * ks); X = MFMA32(Aw, qB[ks], X); }
                Qf[2 * rb] = pack8(X[0], X[1], X[2], X[3], X[4], X[5], X[6], X[7]); Qf[2 * rb + 1] = pack8(X[8], X[9], X[10], X[11], X[12], X[13], X[14], X[15]); } }
#pragma unroll
        for (int s = 0; s < 8; ++s) asm volatile("" : "+v"(Qf[s]));
        f32x16 O[4];
#pragma unroll
        for (int db = 0; db < 4; ++db)
#pragma unroll
            for (int r = 0; r < 16; ++r) O[db][r] = 0.f;
        float m_run = -INFINITY, l_run = 0.f;
        v4u st[4];
        __syncthreads();
        att_load(CKV, CKVT, b, 0, tid, st); att_store(F.lds, 0, tid, st);
        att_load(CKV, CKVT, b, nt > 1 ? 1 : 0, tid, st); att_store(F.lds, 1, tid, st);
        __syncthreads();
        const unsigned* mrow = MASK + (size_t)(t0 + q) * 64;
        for (int j0 = 0; j0 < nt; j0 += 2) { const int j1 = j0 + 1; const bool has1 = j1 < nt; const int last = nt - 1;
            const u32x2v mw0 = *(const GAS u32x2v*)(mrow + 2 * j0);
            __builtin_amdgcn_sched_barrier(0);
            att_load(CKV, CKVT, b, (j0 + 2 < nt) ? j0 + 2 : last, tid, st);
            __builtin_amdgcn_sched_barrier(0);
            att_tile(F.lds, j0 & 3, j0, mw0, Qf, O, m_run, l_run, slope2, hh, q, qpos);
            att_store(F.lds, (j0 + 2) & 3, tid, st);
            const u32x2v mw1 = *(const GAS u32x2v*)(mrow + 2 * (has1 ? j1 : j0));
            __builtin_amdgcn_sched_barrier(0);
            att_load(CKV, CKVT, b, (j0 + 3 < nt) ? j0 + 3 : last, tid, st);
            __builtin_amdgcn_sched_barrier(0);
            if (has1) att_tile(F.lds, j1 & 3, j1, mw1, Qf, O, m_run, l_run, slope2, hh, q, qpos);
            att_store(F.lds, (j0 + 3) & 3, tid, st);
            __syncthreads();
        }
        float lt; { const auto rr = __builtin_amdgcn_permlane32_swap(__float_as_uint(l_run), __float_as_uint(l_run), false, false); lt = __uint_as_float(rr[0]) + __uint_as_float(rr[1]); }
        const float inv = 1.f / lt;
        bf16x8 Ob[8];
#pragma unroll
        for (int db = 0; db < 4; ++db)
#pragma unroll
            for (int t = 0; t < 2; ++t) Ob[db * 2 + t] = pack8(O[db][8 * t] * inv, O[db][8 * t + 1] * inv, O[db][8 * t + 2] * inv, O[db][8 * t + 3] * inv, O[db][8 * t + 4] * inv, O[db][8 * t + 5] * inv, O[db][8 * t + 6] * inv, O[db][8 * t + 7] * inv);
        int l2; asm volatile("v_mbcnt_lo_u32_b32 %0, -1, 0\n\tv_mbcnt_hi_u32_b32 %0, -1, %0" : "=v"(l2));
        const bf16* WuvT = (const bf16*)(F.ws + WS_WUVT); bf16* YA = (bf16*)(F.ws + WS_YA);
        const int orow_t = t0 + (l2 & 31);
#pragma unroll
        for (int dbp = 0; dbp < 2; ++dbp) { f32x16 Yt;
#pragma unroll
            for (int r = 0; r < 16; ++r) Yt[r] = 0.f;
            const bf16* wrow = WuvT + (size_t)(head * 64 + dbp * 32 + (l2 & 31)) * 128 + (l2 >> 5) * 8;
#pragma unroll
            for (int ks = 0; ks < 8; ++ks) { const bf16x8 Aw = *(const GAS bf16x8*)(wrow + ks * 16); Yt = MFMA32(Aw, Ob[ks], Yt); }
#pragma unroll
            for (int g = 0; g < 4; ++g) { const unsigned lo = pkbf(Yt[4 * g], Yt[4 * g + 1]), hi = pkbf(Yt[4 * g + 2], Yt[4 * g + 3]);
                *(GAS unsigned long long*)(YA + bl_off(orow_t, head * 64 + dbp * 32 + 8 * g + 4 * (l2 >> 5), 512)) = (unsigned long long)lo | ((unsigned long long)hi << 32); } }
    }
}
struct HotOrder : pg8::StaticOrder { __device__ __forceinline__ bool next(int i, pg8::Unit& u) const { const bool ok = pg8::StaticOrder::next(i, u); u.pm &= 7; return ok; } };
struct Args { const float* in[23]; float* out; unsigned char* ws; int ph_lo, ph_hi; };
__global__ void __launch_bounds__(NWAVES * 64, 2) mk_fwd(Args args) {
    extern __shared__ __attribute__((aligned(16))) unsigned char lds[];
    Frame F;
    F.lds = (LAS unsigned char*)lds;
    F.MISCW = (volatile LAS unsigned*)(F.lds + MISC_OFF);
    F.tid = threadIdx.x; F.lane = F.tid & 63; F.wave = __builtin_amdgcn_readfirstlane(F.tid >> 6);
    F.G = gridDim.x; { const int bx = blockIdx.x; F.vcu = (F.G % 8 == 0) ? (bx % 8) * (F.G / 8) + bx / 8 : bx; }
    F.ws = args.ws; F.ctl = (gu32*)(args.ws + WS_CTL); F.out = args.out;
    for (int u = F.tid; u < (LDS_BYTES - LDSCTL_OFF) / 4; u += NWAVES * 64) ((LAS unsigned*)(F.lds + LDSCTL_OFF))[u] = 0u;
    __syncthreads();
    const int lo = args.ph_lo, hi = args.ph_hi;
#define IN(k) (lo <= (k) && (k) < hi)
#define REID() do { int l_; asm volatile("v_mbcnt_lo_u32_b32 %0, -1, 0\n\tv_mbcnt_hi_u32_b32 %0, -1, %0" : "=v"(l_)); F.lane = l_; F.tid = F.wave * 64 + l_; } while (0)
#define SEAM(k) do { if (IN(k) && IN((k) + 1)) { REID(); xcd_barrier(bar, F.wave == 0 && F.lane == 0); } } while (0)
#ifndef PROBE_MASK
#define PROBE_MASK 0
#endif
#define PHASE(k, BODY) do { if (IN(k)) { if ((PROBE_MASK >> (k)) & 1) { REID(); BODY; REID(); xcd_barrier(bar, F.wave == 0 && F.lane == 0); } REID(); BODY; } SEAM(k); } while (0)
#define BODY0 { p0_prologue<0>(F); }
#define BODY1 { p1_modulate(F); }
#define BODY2 { pg8::Gemm g{(const pg8::bf16_t*)(F.ws + WS_H), (const pg8::bf16_t*)(F.ws + WS_WIN), T, NIN, D}; pg8::StaticOrder S; S.init(T, NIN, F.G, (int)blockIdx.x); \
        pg8::EpiInProj E{(pg8::bf16_t*)(F.ws + WS_QL), (pg8::bf16_t*)(F.ws + WS_QI), (pg8::bf16_t*)(F.ws + WS_U), (pg8::bf16_t*)(F.ws + WS_SG), (float*)(F.ws + WS_MISC), (pg8::bf16_t*)(F.ws + WS_KI)}; \
        pg8::gemm_phase<pg8::EpiInProj, pg8::StaticOrder, PG8_ALIGN, PG8_SP2>(F.lds + RING_OFF, g, S, E, F.wave); }
#define BODY3 { p3_post(F); __syncthreads(); p3_select<0>(F); }
#ifndef SELVAR
#define SELVAR 0
#endif
#ifdef PROBE_POST
#define BODY3V { p3_post(F); }
#else
#define BODY3V { p3_select<SELVAR>(F); }
#endif
#define BODY4 { p4_attention(F); }
#define BODY5 { { pg8::Gemm g{(const pg8::bf16_t*)(F.ws + WS_YA), (const pg8::bf16_t*)(F.ws + WS_WBA), T, D, 512}; pg8::StaticOrder S; S.init(T, D, F.G, (int)blockIdx.x); \
          pg8::EpiGateMul E{(pg8::bf16_t*)(F.ws + WS_TMP), (const pg8::bf16_t*)(F.ws + WS_SG), 0, 0}; \
          pg8::gemm_phase<pg8::EpiGateMul, pg8::StaticOrder, PG8_ALIGN, PG8_SP2>(F.lds + RING_OFF, g, S, E, F.wave); } \
        { pg8::Gemm g{(const pg8::bf16_t*)(F.ws + WS_POOLED), (const pg8::bf16_t*)(F.ws + WS_WPB), T, D, 512}; pg8::StaticOrder S; S.init(T, D, F.G, (int)blockIdx.x); \
          pg8::EpiGateAdd E{(pg8::bf16_t*)(F.ws + WS_MIX), (const pg8::bf16_t*)(F.ws + WS_TMP), (const pg8::bf16_t*)(F.ws + WS_SG), 1024, 0}; \
          pg8::gemm_phase<pg8::EpiGateAdd, pg8::StaticOrder, PG8_ALIGN, PG8_SP2>(F.lds + RING_OFF, g, S, E, F.wave); } }
#define BODY6 { pg8::Gemm g{(const pg8::bf16_t*)(F.ws + WS_MIX), (const pg8::bf16_t*)(F.ws + WS_WOUT), T, D, 1024}; pg8::StaticOrder S; S.init(T, D, F.G, (int)blockIdx.x); \
        pg8::EpiResid E{(float*)(F.ws + WS_Z), frame_in(0), (const float*)(F.ws + WS_MOD) + 2 * 1024}; \
        pg8::gemm_phase<pg8::EpiResid, pg8::StaticOrder, PG8_ALIGN, PG8_SP2>(F.lds + RING_OFF, g, S, E, F.wave); }
#define BODY7 { p7_ln1_route(F, CW_GCNT); }
#define BODY7DRY { p7_ln1_route(F, 128); }
#define BODY9 { load_tstart(F); \
        pg8::MoeOrderG S{(const LAS int*)(F.lds + LC_TSTART), 8, F.G, (int)blockIdx.x, (const LAS int*)(F.lds + LC_ROWTAB), (const int*)(F.ws + WS_SLOTMAP), (const int*)(F.ctl + CW_GCNT)}; \
        moe_fill_rowtab(F, S); \
        pg8::Gemm g{(const pg8::bf16_t*)(F.ws + WS_H), (const pg8::bf16_t*)(F.ws + WS_WGU), T, 32 * 2048, 1024}; \
        pg8::EpiSwiglu E{(pg8::bf16_t*)(F.ws + WS_ACT), frame_in(18)}; \
        pg8::gemm_phase<pg8::EpiSwiglu, pg8::MoeOrderG, PG8_ALIGN, PG8_SP2>(F.lds + RING_OFF, g, S, E, F.wave); }
#define BODY10 { load_tstart(F); \
        pg8::Gemm g{(const pg8::bf16_t*)(F.ws + WS_ACT), (const pg8::bf16_t*)(F.ws + WS_WD), MAXROWS, 32 * 1024, 1024}; \
        pg8::MoeOrder S{(const LAS int*)(F.lds + LC_TSTART), 4, F.G, (int)blockIdx.x, nullptr, nullptr, nullptr}; \
        pg8::EpiDown E{(pg8::bf16_t*)(F.ws + WS_Y), frame_in(20)}; \
        pg8::gemm_phase<pg8::EpiDown, pg8::MoeOrder, PG8_ALIGN, PG8_SP2>(F.lds + RING_OFF, g, S, E, F.wave); }
#define BODY10V { load_tstart(F); \
        pg8::Gemm g{(const pg8::bf16_t*)(F.ws + WS_ACT), (const pg8::bf16_t*)(F.ws + WS_WD), MAXROWS, 32 * 1024, 1024}; \
        pg8::MoeOrder S{(const LAS int*)(F.lds + LC_TSTART), 4, F.G, (int)blockIdx.x, nullptr, nullptr, nullptr}; \
        pg8::EpiDownT<false> E{(pg8::bf16_t*)(F.ws + WS_Y), frame_in(20)}; \
        pg8::gemm_phase<pg8::EpiDownT<false>, pg8::MoeOrder, PG8_ALIGN, PG8_SP2>(F.lds + RING_OFF, g, S, E, F.wave); }
#define BODY10X { pg8::Gemm g{(const pg8::bf16_t*)(F.ws + WS_ACT), (const pg8::bf16_t*)(F.ws + WS_WD), 272 * 256, 1024, 1024}; pg8::StaticOrder S; S.init(272 * 256, 1024, F.G, (int)blockIdx.x); \
        pg8::EpiDownT<false> E{(pg8::bf16_t*)(F.ws + WS_Y), frame_in(20)}; \
        pg8::gemm_phase<pg8::EpiDownT<false>, pg8::StaticOrder, PG8_ALIGN, PG8_SP2>(F.lds + RING_OFF, g, S, E, F.wave); }
#define BODY10H { pg8::Gemm g{(const pg8::bf16_t*)(F.ws + WS_ACT), (const pg8::bf16_t*)(F.ws + WS_WD), 272 * 256, 1024, 1024}; HotOrder S; S.init(272 * 256, 1024, F.G, (int)blockIdx.x); \
        pg8::EpiDownT<false> E{(pg8::bf16_t*)(F.ws + WS_Y), frame_in(20)}; \
        pg8::gemm_phase<pg8::EpiDownT<false>, HotOrder, PG8_ALIGN, PG8_SP2>(F.lds + RING_OFF, g, S, E, F.wave); }
#define BODY11 { p11_final(F); }
    XcdBarrier bar; bar.bar = (unsigned*)(F.ctl + CW_BAR); bar.x = 0; bar.st = nullptr;
    if (hi - lo > 1) bar = xcd_barrier_post((unsigned*)(F.ctl + CW_BAR), F.MISCW + 8, F.tid == 0);
#ifdef PROBE_P0SMALL
    if (IN(0)) { REID(); p0_prologue<PROBE_P0SMALL>(F); REID(); xcd_barrier(bar, F.wave == 0 && F.lane == 0); REID(); BODY0; } SEAM(0);
#else
    PHASE(0, BODY0);
#endif
    PHASE(1, BODY1);
#ifdef PROBE_BARRIERS
    for (int i_ = 0; i_ < PROBE_BARRIERS; ++i_) { REID(); xcd_barrier(bar, F.wave == 0 && F.lane == 0); }
#endif
 PHASE(2, BODY2);
    if (IN(3)) { if ((PROBE_MASK >> 3) & 1) { REID(); BODY3V; REID(); xcd_barrier(bar, F.wave == 0 && F.lane == 0); } REID(); BODY3; } SEAM(3);
    PHASE(4, BODY4); PHASE(5, BODY5);
    PHASE(6, BODY6);
    if (IN(7)) { if ((PROBE_MASK >> 7) & 1) { REID(); BODY7DRY; REID(); xcd_barrier(bar, F.wave == 0 && F.lane == 0); } REID(); BODY7; } SEAM(7);
    PHASE(9, BODY9);
#ifdef PROBE_HOT10
    if (IN(10)) { REID(); BODY10H; REID(); xcd_barrier(bar, F.wave == 0 && F.lane == 0); REID(); BODY10; } SEAM(10);
#elif defined(PROBE_STATIC10)
    if (IN(10)) { REID(); BODY10X; REID(); xcd_barrier(bar, F.wave == 0 && F.lane == 0); REID(); BODY10; } SEAM(10);
#elif defined(PROBE_NOBIAS)
    if (IN(10)) { REID(); BODY10V; REID(); xcd_barrier(bar, F.wave == 0 && F.lane == 0); REID(); BODY10; } SEAM(10);
#else
    PHASE(10, BODY10);
#endif
    if (IN(11)) { if ((PROBE_MASK >> 11) & 1) { REID(); BODY11; REID(); xcd_barrier(bar, F.wave == 0 && F.lane == 0); } REID(); BODY11; }
#undef IN
#undef SEAM
}

static void launch_mk(const Args& a0, int lo, int hi, int grid, hipStream_t stream) {
    Args a = a0; a.ph_lo = lo; a.ph_hi = hi;
    hipLaunchKernelGGL(mk_fwd, dim3(grid), dim3(NWAVES * 64), LDS_BYTES, stream, a);
}
extern "C" void kernel_launch(void* const* d_in, const int* in_sizes, int n_in, void* d_out, int out_size, void* d_ws, size_t ws_size, hipStream_t stream) {
    static int grid = 0;
    if (grid == 0) {
        if (n_in != 23 || ws_size < WS_END) { fprintf(stderr, "kernel_launch: unexpected n_in %d / ws %zu\n", n_in, ws_size); grid = -1; return; }
        int dev = 0, cus = 0;
        if (hipGetDevice(&dev) != hipSuccess || hipDeviceGetAttribute(&cus, hipDeviceAttributeMultiprocessorCount, dev) != hipSuccess) { grid = -1; return; }
        if (hipFuncSetAttribute((const void*)mk_fwd, hipFuncAttributeMaxDynamicSharedMemorySize, LDS_BYTES) != hipSuccess) { fprintf(stderr, "hipFuncSetAttribute failed\n"); grid = -1; return; }
        grid = cus;
        if (grid != 256) { fprintf(stderr, "kernel_launch: built for 256 CUs, found %d\n", cus); grid = -1; return; }
    }
    if (grid < 0) return;
    unsigned char* ws = (unsigned char*)d_ws;
    (void)hipMemsetAsync(ws + WS_CTL, 0, CTL_ZERO_BYTES, stream);
    Args a{};
    for (int i = 0; i < 23; ++i) a.in[i] = (const float*)d_in[i];
    a.out = (float*)d_out; a.ws = ws;
    launch_mk(a, 0, 12, grid, stream);
}
```

```cpp
#include <hip/hip_runtime.h>
#include <cstdio>
#include <cstdint>
namespace pg8 {
#define PG8_LAS __attribute__((address_space(3)))
typedef unsigned short bf16_t;
typedef short bf16x8 __attribute__((ext_vector_type(8)));
typedef float f32x4 __attribute__((ext_vector_type(4)));
typedef unsigned u32x4 __attribute__((ext_vector_type(4)));
constexpr int BM = 256, BK = 64, HALF = 128, HTB = HALF * BK * 2  , STAGE_BYTES = 8 * HTB, NXCD = 8, WGM = 8;

__host__ __device__ __forceinline__ int lds_byte(int r, int c) { const int st = (r >> 4) * 2 + (c >> 5), rr = r & 15, cc = c & 31, ob = rr * 64 + cc * 2; return st * 1024 + (ob ^ (((ob >> 9) & 1) << 5)); }
__host__ __device__ __forceinline__ void stage_rc(int b, int& R, int& C) { const int st = b / 1024, sb = b % 1024, swz = sb ^ (((sb >> 9) & 1) << 5); R = (st >> 1) * 16 + swz / 64; C = (st & 1) * 32 + (swz % 64) / 2; }
__host__ __device__ __forceinline__ int perm32(int rho) { const int n = rho >> 4, i = rho & 15; return 8 * (i >> 2) + 4 * n + (i & 3); }

struct Unit { int pm, pn; };
struct Gemm { const bf16_t* A; const bf16_t* Bt; int M, N, K; };

struct StaticOrder {
    static constexpr bool GATHER = false;
    int nM, nN, nwg, G, c;
    __host__ __device__ void init(int M, int N, int G_, int c_) { nM = M / BM; nN = N / BM; nwg = nM * nN; G = G_; c = c_; }
    __host__ __device__ bool next(int i, Unit& u) const {
        const long L = (long)i * G + c; if (L >= nwg) return false;
        int wgid = (int)L; { const int q = nwg / NXCD, r = nwg % NXCD, xcd = wgid % NXCD, off = wgid / NXCD; wgid = (xcd < r ? xcd * (q + 1) : r * (q + 1) + (xcd - r) * q) + off; }
        const int nig = WGM * nN, gid = wgid / nig, fm = gid * WGM, gsz = (nM - fm) < WGM ? (nM - fm) : WGM;
        u.pm = fm + ((wgid % nig) % gsz); u.pn = (wgid % nig) / gsz; return true;
    }
    __device__ __forceinline__ void a_ready(const Unit&) const {}
    __device__ __forceinline__ void done(const Unit&) const {}
};

__device__ __forceinline__ unsigned cvt_pk_bf16(float lo, float hi) { unsigned r; asm volatile("v_cvt_pk_bf16_f32 %0, %1, %2" : "=v"(r) : "v"(lo), "v"(hi)); return r; }
typedef float f32x2 __attribute__((ext_vector_type(2)));
__device__ __forceinline__ f32x2 gelu_pk(f32x2 v) {
    const f32x2 av = __builtin_elementwise_abs(v), d = av * 0.2316418882f + 1.0f;
    f32x2 t; t.x = __builtin_amdgcn_rcpf(d.x); t.y = __builtin_amdgcn_rcpf(d.y);
    f32x2 q = t * 0.5307027145f + (-0.7265760135f); q = q * t + 0.7107068705f; q = q * t + (-0.142248368f); q = q * t + 0.127414796f; q = q * t;
    const f32x2 s = (v * v) * (-0.72134752044f);
    f32x2 e; e.x = __builtin_amdgcn_exp2f(s.x); e.y = __builtin_amdgcn_exp2f(s.y);
    const f32x2 m = v * (q * e), r = v - m;
    f32x2 o; o.x = v.x < 0.f ? m.x : r.x; o.y = v.y < 0.f ? m.y : r.y; return o;
}

template <int ACT  > struct EpiBf16 {
    static constexpr bool PERM = true, AFTER_DRAIN = false; static_assert(ACT == 0 || ACT == 1, "EpiBf16: ACT is 0 (none) or 1 (gelu_pk)");
    bf16_t* O; int ldc; const float* bias; int split_cols; size_t split_stride; float scale0;
    __device__ __forceinline__ void operator()(const f32x4 (&acc)[2][2][4][2], const Unit& u, int wr, int wc, int fr, int fq) const {
        const int row0 = u.pm * BM + wr * 64 + fr; int colt = u.pn * BM; bf16_t* base = O;
        float sc = 1.f; if (split_cols) { const int t = colt / split_cols; base += (size_t)t * split_stride; colt -= t * split_cols; if (t == 0) sc = scale0; }
        const int col0 = colt + wc * 32 + 8 * fq, bcol0 = u.pn * BM + wc * 32 + 8 * fq;
        f32x4 bv[2][2];
#pragma unroll
        for (int bj = 0; bj < 2; ++bj)
#pragma unroll
            for (int n = 0; n < 2; ++n) bv[bj][n] = bias ? *(const f32x4*)(bias + bcol0 + bj * HALF + 4 * n) : (f32x4){0.f, 0.f, 0.f, 0.f};
#pragma unroll
        for (int ai = 0; ai < 2; ++ai)
#pragma unroll
            for (int m = 0; m < 4; ++m) { bf16_t* rowp = base + (size_t)(row0 + ai * HALF + m * 16) * ldc + col0;
#pragma unroll
                for (int bj = 0; bj < 2; ++bj) { f32x4 v0 = acc[ai][bj][m][0] + bv[bj][0], v1 = acc[ai][bj][m][1] + bv[bj][1];
                    if (ACT == 1) { f32x2 a = gelu_pk((f32x2){v0[0], v0[1]}), b = gelu_pk((f32x2){v0[2], v0[3]}), c = gelu_pk((f32x2){v1[0], v1[1]}), d = gelu_pk((f32x2){v1[2], v1[3]});
                        v0 = (f32x4){a.x, a.y, b.x, b.y}; v1 = (f32x4){c.x, c.y, d.x, d.y}; }
                    v0 = v0 * sc; v1 = v1 * sc; u32x4 w; w.x = cvt_pk_bf16(v0[0], v0[1]); w.y = cvt_pk_bf16(v0[2], v0[3]); w.z = cvt_pk_bf16(v1[0], v1[1]); w.w = cvt_pk_bf16(v1[2], v1[3]);
                    *(u32x4*)(rowp + bj * HALF) = w; } }
    }
};

struct PanelStats {
    unsigned* xbuf;
    unsigned* cnt;
    unsigned* tmo;
    int ntn; float eps;
    unsigned code;
    __device__ __forceinline__ bool run(const f32x4 (&v)[2][2][4][2], const Unit& u, int wr, int wc, int fr, int fq, PG8_LAS unsigned char* lds, int wid, int lane) const {
        typedef float f32x2v __attribute__((ext_vector_type(2)));
        PG8_LAS f32x2v* P = (PG8_LAS f32x2v*)lds;
        PG8_LAS f32x2v* S = (PG8_LAS f32x2v*)(lds + 8192);
        PG8_LAS unsigned* flag = (PG8_LAS unsigned*)(lds + 8192 + 2048);
#pragma unroll
        for (int ai = 0; ai < 2; ++ai)
#pragma unroll
            for (int m = 0; m < 4; ++m) {
                float s = 0.f;
#pragma unroll
                for (int bj = 0; bj < 2; ++bj)
#pragma unroll
                    for (int n = 0; n < 2; ++n) { const f32x4 x = v[ai][bj][m][n]; s += (x[0] + x[1]) + (x[2] + x[3]); }
                s += __shfl_xor(s, 16); s += __shfl_xor(s, 32);
                const float mw = s * (1.0f / 64.0f); float q = 0.f;
#pragma unroll
                for (int bj = 0; bj < 2; ++bj)
#pragma unroll
                    for (int n = 0; n < 2; ++n) { const f32x4 d = v[ai][bj][m][n] - mw; q += (d[0] * d[0] + d[1] * d[1]) + (d[2] * d[2] + d[3] * d[3]); }
                q += __shfl_xor(q, 16); q += __shfl_xor(q, 32);
                if (fq == 0) P[(ai * HALF + wr * 64 + m * 16 + fr) * 4 + wc] = (f32x2v){mw, q};
            }
        asm volatile("s_waitcnt lgkmcnt(0)" ::: "memory"); __builtin_amdgcn_s_barrier(); asm volatile("" ::: "memory");
#if defined(BROKEN_EXCHANGE_NO_WAIT)
#warning BROKEN CONTROL BUILD: the row-statistics exchange does not wait; results are wrong by design
        if (blockIdx.x >= 64) { const long long t0_ = clock64(); while (clock64() - t0_ < 60000) __builtin_amdgcn_s_sleep(8); }
#endif
        const int row = wid * 32 + (lane & 31);
        if (lane < 32) {
            const f32x2v a = P[row * 4 + 0], b = P[row * 4 + 1], c = P[row * 4 + 2], d = P[row * 4 + 3];
            const float mt = (a.x + b.x + c.x + d.x) * 0.25f;
            const float da = a.x - mt, db = b.x - mt, dc = c.x - mt, dd = d.x - mt;
            const float m2 = (a.y + b.y) + (c.y + d.y) + 64.0f * ((da * da + db * db) + (dc * dc + dd * dd));
            unsigned long long* slot = (unsigned long long*)xbuf + ((size_t)(u.pm * BM + row) * 4 + u.pn);
            __hip_atomic_store(slot, ((unsigned long long)__float_as_uint(m2) << 32) | __float_as_uint(mt), __ATOMIC_RELAXED, __HIP_MEMORY_SCOPE_AGENT);
        }
        asm volatile("s_waitcnt vmcnt(0)" ::: "memory");
        if (lane == 0) __hip_atomic_fetch_add(cnt + 64 * u.pm, 1u, __ATOMIC_RELAXED, __HIP_MEMORY_SCOPE_AGENT);
        if (wid == 0) {
            bool dead = false; const unsigned long long t0 = __builtin_amdgcn_s_memrealtime(); const unsigned want = 8u * (unsigned)ntn;
            for (;;) {
#if defined(BROKEN_EXCHANGE_NO_WAIT)
                break;
#endif
                if ((unsigned)__builtin_amdgcn_readfirstlane(__hip_atomic_load(cnt + 64 * u.pm, __ATOMIC_RELAXED, __HIP_MEMORY_SCOPE_AGENT)) >= want) break;
                if (__builtin_amdgcn_s_memrealtime() - t0 > 2000000ull) {
                    if (lane == 0) { unsigned expect = 0u; __hip_atomic_compare_exchange_strong(tmo + 1, &expect, code | (unsigned)(u.pm & 0xff), __ATOMIC_RELAXED, __ATOMIC_RELAXED, __HIP_MEMORY_SCOPE_AGENT);
                                     __hip_atomic_store(tmo, 1u, __ATOMIC_RELAXED, __HIP_MEMORY_SCOPE_AGENT); }
                    dead = true; break; }
                __builtin_amdgcn_s_sleep(2);
            }
            __builtin_amdgcn_fence(__ATOMIC_ACQUIRE, "agent");
            if (lane == 0) flag[0] = dead ? 1u : 0u;
        }
        asm volatile("s_waitcnt vmcnt(0) lgkmcnt(0)" ::: "memory"); __builtin_amdgcn_s_barrier(); asm volatile("" ::: "memory");
        const bool bad = flag[0] != 0u;
        if (lane < 32) {
            const unsigned long long* slot = (const unsigned long long*)xbuf + (size_t)(u.pm * BM + row) * 4; float mt[4], m2[4]; float ms = 0.f;
#pragma unroll
            for (int t = 0; t < 4; ++t) { if (t < ntn) { const unsigned long long w = __hip_atomic_load(slot + t, __ATOMIC_RELAXED, __HIP_MEMORY_SCOPE_AGENT); mt[t] = __uint_as_float((unsigned)w); m2[t] = __uint_as_float((unsigned)(w >> 32)); } else { mt[t] = 0.f; m2[t] = 0.f; } ms += mt[t]; }
            const float mean = ms / (float)ntn; float q = 0.f;
#pragma unroll
            for (int t = 0; t < 4; ++t) if (t < ntn) { const float dm = mt[t] - mean; q += m2[t] + 256.0f * dm * dm; }
            S[row] = (f32x2v){mean, 1.0f / sqrtf(q / (256.0f * (float)ntn) + eps)};
        }
        asm volatile("s_waitcnt lgkmcnt(0)" ::: "memory"); __builtin_amdgcn_s_barrier(); asm volatile("" ::: "memory");
        return bad;
    }
};
struct EpiLnRes {
    static constexpr bool PERM = false, AFTER_DRAIN = true;
    const float* base; float* out; int ldc; const float* bias; PanelStats st; unsigned poison;
    __device__ __forceinline__ void fused(f32x4 (&acc)[2][2][4][2], const Unit& u, int wr, int wc, int fr, int fq, PG8_LAS unsigned char* lds, int wid, int lane) const {
        typedef float f32x2v __attribute__((ext_vector_type(2)));
        const PG8_LAS f32x2v* S = (const PG8_LAS f32x2v*)(lds + 8192);
        const int col0 = u.pn * BM + wc * 32 + 4 * fq;
#pragma unroll
        for (int bj = 0; bj < 2; ++bj)
#pragma unroll
            for (int n = 0; n < 2; ++n) { const f32x4 bv = bias ? *(const f32x4*)(bias + col0 + bj * HALF + n * 16) : (f32x4){0.f, 0.f, 0.f, 0.f};
#pragma unroll
                for (int ai = 0; ai < 2; ++ai)
#pragma unroll
                    for (int m = 0; m < 4; ++m) acc[ai][bj][m][n] += bv; }
        f32x4 pre[4][2][2];
#pragma unroll
        for (int m = 0; m < 4; ++m) { const size_t off = (size_t)(u.pm * BM + wr * 64 + m * 16 + fr) * ldc + col0;
#pragma unroll
            for (int bj = 0; bj < 2; ++bj)
#pragma unroll
                for (int n = 0; n < 2; ++n) pre[m][bj][n] = *(const f32x4*)(base + off + bj * HALF + n * 16); }
        const bool bad = st.run(acc, u, wr, wc, fr, fq, lds, wid, lane) || poison != 0u;
        const float qnan = __builtin_nanf("");
#pragma unroll
        for (int ai = 0; ai < 2; ++ai)
#pragma unroll
            for (int m = 0; m < 4; ++m) { const int r = ai * HALF + wr * 64 + m * 16 + fr; const f32x2v sr = S[r]; const size_t off = (size_t)(u.pm * BM + r) * ldc + col0;
#pragma unroll
                for (int bj = 0; bj < 2; ++bj)
#pragma unroll
                    for (int n = 0; n < 2; ++n) { const f32x4 bs = ai == 0 ? pre[m][bj][n] : *(const f32x4*)(base + off + bj * HALF + n * 16); f32x4 o = bs + (acc[ai][bj][m][n] - sr.x) * sr.y;
                        if (bad) o = (f32x4){qnan, qnan, qnan, qnan}; *(f32x4*)(out + off + bj * HALF + n * 16) = o; }
                if (m & 1) asm volatile("" ::: "memory"); }
    }
};
struct EpiLnResLn {
    static constexpr bool PERM = false, AFTER_DRAIN = true;
    const float* base; float* out; bf16_t* xn; int ldc; const float* bias; PanelStats st1, st2; unsigned poison;
    __device__ __forceinline__ void fused(f32x4 (&acc)[2][2][4][2], const Unit& u, int wr, int wc, int fr, int fq, PG8_LAS unsigned char* lds, int wid, int lane) const {
        typedef float f32x2v __attribute__((ext_vector_type(2))); typedef unsigned u32x2v __attribute__((ext_vector_type(2)));
        const PG8_LAS f32x2v* S = (const PG8_LAS f32x2v*)(lds + 8192);
        const int col0 = u.pn * BM + wc * 32 + 4 * fq;
#pragma unroll
        for (int bj = 0; bj < 2; ++bj)
#pragma unroll
            for (int n = 0; n < 2; ++n) { const f32x4 bv = bias ? *(const f32x4*)(bias + col0 + bj * HALF + n * 16) : (f32x4){0.f, 0.f, 0.f, 0.f};
#pragma unroll
                for (int ai = 0; ai < 2; ++ai)
#pragma unroll
                    for (int m = 0; m < 4; ++m) acc[ai][bj][m][n] += bv; }
        bool bad = st1.run(acc, u, wr, wc, fr, fq, lds, wid, lane) || poison != 0u;
        const float qnan = __builtin_nanf("");
#pragma unroll
        for (int ai = 0; ai < 2; ++ai)
#pragma unroll
            for (int m = 0; m < 4; ++m) { const int r = ai * HALF + wr * 64 + m * 16 + fr; const f32x2v sr = S[r]; const size_t off = (size_t)(u.pm * BM + r) * ldc + col0;
#pragma unroll
                for (int bj = 0; bj < 2; ++bj)
#pragma unroll
                    for (int n = 0; n < 2; ++n) { const f32x4 bs = *(const f32x4*)(base + off + bj * HALF + n * 16); acc[ai][bj][m][n] = bs + (acc[ai][bj][m][n] - sr.x) * sr.y; }
                asm volatile("" : "+v"(acc[ai][0][m][0]), "+v"(acc[ai][0][m][1]), "+v"(acc[ai][1][m][0]), "+v"(acc[ai][1][m][1]));
                if (m & 1) asm volatile("" ::: "memory"); }
        const bool bad1 = bad;
        bad = st2.run(acc, u, wr, wc, fr, fq, lds, wid, lane) || bad;
#pragma unroll
        for (int ai = 0; ai < 2; ++ai)
#pragma unroll
            for (int m = 0; m < 4; ++m) { const int r = ai * HALF + wr * 64 + m * 16 + fr; const f32x2v sr = S[r]; const size_t off = (size_t)(u.pm * BM + r) * ldc + col0;
#pragma unroll
                for (int bj = 0; bj < 2; ++bj)
#pragma unroll
                    for (int n = 0; n < 2; ++n) { const f32x4 x1 = acc[ai][bj][m][n]; *(f32x4*)(out + off + bj * HALF + n * 16) = bad1 ? (f32x4){qnan, qnan, qnan, qnan} : x1;
                        const f32x4 o = (x1 - sr.x) * sr.y; u32x2v w; w.x = cvt_pk_bf16(o[0], o[1]); w.y = cvt_pk_bf16(o[2], o[3]);
                        if (bad) { w.x = 0x7fc07fc0u; w.y = 0x7fc07fc0u; } *(u32x2v*)(xn + off + bj * HALF + n * 16) = w; }
                asm volatile("" ::: "memory"); }
    }
};

typedef int i32x4v __attribute__((ext_vector_type(4))); typedef int i32x8v __attribute__((ext_vector_type(8)));
template <class Epi, class Sched, bool ALIGN_EPI = false, bool SP2 = false, bool FP8 = false>
__device__ __forceinline__ void gemm_phase(PG8_LAS unsigned char* lds, const Gemm g, const Sched& S, const Epi& E, const int wave_id  ) {
    int tid; { int l_; asm volatile("v_mbcnt_lo_u32_b32 %0, -1, 0\n\tv_mbcnt_hi_u32_b32 %0, -1, %0" : "=v"(l_)); tid = wave_id * 64 + l_; }
    const int wid = wave_id, lane = tid & 63, wr = wid >> 2, wc = wid & 3, fr = lane & 15, fq = lane >> 4;
    const int K = g.K, nt = K / BK;
    constexpr bool GA = Sched::GATHER;
    static_assert(!GA || SP2, "row gather is wired into the SP2 loop only");
    unsigned voffA[2], voffB[2];
#pragma unroll
    for (int i = 0; i < 2; ++i) { int R, C; stage_rc(tid * 16 + i * 8192, R, C); const int Rb = Epi::PERM ? ((R & ~31) + perm32(R & 31)) : R;
        voffA[i] = (unsigned)(R * BK + C) * 2u; voffB[i] = (unsigned)(Rb * BK + C) * 2u; }
    unsigned goc[2][2]; const char* const gA = (const char*)g.A;
#define PG8_GO(dst, slot, u) do { _Pragma("unroll") for (int _i = 0; _i < 2; ++_i) { int _R, _C; stage_rc(tid * 16 + _i * 8192, _R, _C); _Pragma("unroll") for (int _h = 0; _h < 2; ++_h) \
        { const unsigned _r = (unsigned)S.arow(slot, u, _h * HALF + _R); dst[_h][_i] = (_r >> 8) * (unsigned)(BM * K * 2) + (_r & 255u) * (unsigned)(BK * 2) + (unsigned)(_C * 2); } } } while (0)
#define PG8_STAGE_A(bufoff, gbase_plain, kb, h, useN) do { if constexpr (GA) { _Pragma("unroll") for (int _i = 0; _i < 2; ++_i) \
        __builtin_amdgcn_global_load_lds((const unsigned*)(gA + (kb) + goc[h][_i]), (PG8_LAS unsigned*)(lds + (bufoff) + ldsw + _i * 8192), 16, 0, 0); } else { PG8_STAGE(bufoff, gbase_plain, voffA); } } while (0)
    const size_t kstep = (size_t)(BM * BK * 2);
    const size_t hstep = (size_t)HALF * BK * 2;
    const size_t tstep = (size_t)BM * K * 2;
    const unsigned ldsw = (unsigned)wid * 1024u;
    const int aoff = lds_byte(wr * 64 + fr, fq * 8), boff = lds_byte(wc * 32 + fr, fq * 8);
#define PG8_SA(b, h) (((b) * 2 + (h)) * HTB)
#define PG8_SB(b, h) ((4 + (b) * 2 + (h)) * HTB)
#define PG8_STAGE(bufoff, gbase, voff) do { _Pragma("unroll") for (int _i = 0; _i < 2; ++_i) \
        __builtin_amdgcn_global_load_lds((const unsigned*)((const char*)(gbase) + (voff)[_i]), (PG8_LAS unsigned*)(lds + (bufoff) + ldsw + _i * 8192), 16, 0, 0); } while (0)
#define PG8_LDA(dst, b, h) do { if constexpr (FP8) { _Pragma("unroll") for (int m = 0; m < 4; ++m) { const i32x4v _lo = *(const PG8_LAS i32x4v*)(lds + PG8_SA(b, h) + aoff + m * 2048), _hi = *(const PG8_LAS i32x4v*)(lds + PG8_SA(b, h) + aoff + m * 2048 + 1024); \
        dst##8[m] = __builtin_shufflevector(_lo, _hi, 0, 1, 2, 3, 4, 5, 6, 7); } } else { _Pragma("unroll") for (int m = 0; m < 4; ++m) _Pragma("unroll") for (int k = 0; k < 2; ++k) dst[m][k] = *(const PG8_LAS bf16x8*)(lds + PG8_SA(b, h) + aoff + m * 2048 + k * 1024); } } while (0)
#define PG8_LDB(dst, b, h) do { if constexpr (FP8) { _Pragma("unroll") for (int n = 0; n < 2; ++n) { const i32x4v _lo = *(const PG8_LAS i32x4v*)(lds + PG8_SB(b, h) + boff + n * 2048), _hi = *(const PG8_LAS i32x4v*)(lds + PG8_SB(b, h) + boff + n * 2048 + 1024); \
        dst##8[n] = __builtin_shufflevector(_lo, _hi, 0, 1, 2, 3, 4, 5, 6, 7); } } else { _Pragma("unroll") for (int n = 0; n < 2; ++n) _Pragma("unroll") for (int k = 0; k < 2; ++k) dst[n][k] = *(const PG8_LAS bf16x8*)(lds + PG8_SB(b, h) + boff + n * 2048 + k * 1024); } } while (0)
#define PG8_MMA16(ai, bj, At, Bt) do { __builtin_amdgcn_s_setprio(1); _Pragma("unroll") for (int m = 0; m < 4; ++m) _Pragma("unroll") for (int n = 0; n < 2; ++n) _Pragma("unroll") for (int k = 0; k < 2; ++k) \
        acc[ai][bj][m][n] = __builtin_amdgcn_mfma_f32_16x16x32_bf16(Bt[n][k], At[m][k], acc[ai][bj][m][n], 0, 0, 0); __builtin_amdgcn_s_setprio(0); } while (0)
#define PG8_MMA8(ai, bj, At, Bt) do { __builtin_amdgcn_sched_barrier(0); __builtin_amdgcn_s_setprio(1); _Pragma("unroll") for (int m = 0; m < 4; ++m) _Pragma("unroll") for (int n = 0; n < 2; ++n) \
        acc[ai][bj][m][n] = __builtin_amdgcn_mfma_scale_f32_16x16x128_f8f6f4(Bt##8[n], At##8[m], acc[ai][bj][m][n], 0, 0, 0, 0x7f7f7f7f, 0, 0x7f7f7f7f); __builtin_amdgcn_s_setprio(0); __builtin_amdgcn_sched_barrier(0); } while (0)
#define PG8_MMA(ai, bj, At, Bt) do { if constexpr (FP8) { PG8_MMA8(ai, bj, At, Bt); } else { PG8_MMA16(ai, bj, At, Bt); } } while (0)
#define PG8_WAIT_V(n) asm volatile("s_waitcnt vmcnt(" #n ")" ::: "memory")
#define PG8_WAIT_L(n) asm volatile("s_waitcnt lgkmcnt(" #n ")" ::: "memory")
#define PG8_BAR __builtin_amdgcn_s_barrier()
#define PG8_SCHED __builtin_amdgcn_sched_barrier(0)
    Unit cur, nxt; int ui = 0;
    if (!S.next(0, cur)) return;
    f32x4 acc[2][2][4][2];
#pragma unroll
    for (int a = 0; a < 2; ++a)
#pragma unroll
        for (int b = 0; b < 2; ++b)
#pragma unroll
            for (int m = 0; m < 4; ++m)
#pragma unroll
                for (int n = 0; n < 2; ++n) acc[a][b][m][n] = (f32x4){0.f, 0.f, 0.f, 0.f};
    bf16x8 At[4][2], B0[2][2], B1[2][2];
    i32x8v At8[4], B08[2], B18[2];
#define PG8_ROT(u) (2 * (((u).pm + 3 * (u).pn) & 3))
#define PG8_KOFF(t, r) ((size_t)(((t) + (r)) & (nt - 1)) * kstep)
    int rc = SP2 ? PG8_ROT(cur) : 0, rn = rc;
    const char* cA = (const char*)g.A + (size_t)cur.pm * tstep; const char* cB = (const char*)g.Bt + (size_t)cur.pn * tstep;
    if constexpr (GA) { PG8_GO(goc, 0, cur); }
    S.a_ready(cur);
    if constexpr (SP2) {
        const size_t k0 = PG8_KOFF(0, rc);
        PG8_STAGE(PG8_SB(0, 0), cB + k0, voffB); PG8_STAGE(PG8_SB(0, 1), cB + k0 + hstep, voffB); PG8_STAGE_A(PG8_SA(0, 0), cA + k0, k0, 0, false); PG8_STAGE_A(PG8_SA(0, 1), cA + k0 + hstep, k0, 1, false);
        if (wr == 1) PG8_BAR;
        PG8_WAIT_V(2); PG8_BAR;
        PG8_STAGE(PG8_SB(1, 0), cB + k0 + kstep, voffB); PG8_STAGE_A(PG8_SA(1, 0), cA + k0 + kstep, k0 + kstep, 0, false); PG8_STAGE(PG8_SB(1, 1), cB + k0 + hstep + kstep, voffB);
        PG8_WAIT_V(6); PG8_BAR;
    } else {
        PG8_STAGE(PG8_SB(0, 0), cB, voffB); PG8_STAGE(PG8_SA(0, 0), cA, voffA); PG8_STAGE(PG8_SB(0, 1), cB + hstep, voffB); PG8_STAGE(PG8_SA(0, 1), cA + hstep, voffA);
        if (wr == 1) PG8_BAR;
        PG8_WAIT_V(4); PG8_BAR;
        PG8_STAGE(PG8_SB(1, 0), cB + kstep, voffB); PG8_STAGE(PG8_SA(1, 0), cA + kstep, voffA); PG8_STAGE(PG8_SB(1, 1), cB + hstep + kstep, voffB);
        PG8_WAIT_V(6); PG8_BAR;
    }
    for (;;) {
        const bool has_next = S.next(ui + 1, nxt);
        rn = (SP2 && has_next) ? PG8_ROT(nxt) : rc;
        const char* nA = has_next ? (const char*)g.A + (size_t)nxt.pm * tstep : cA; const char* nB = has_next ? (const char*)g.Bt + (size_t)nxt.pn * tstep : cB;
#pragma unroll 1
        for (int t = 0; t < nt; t += 2) {
            const bool last = (t == nt - 2);
            const size_t kt0 = PG8_KOFF(t, rc), kt2 = last ? PG8_KOFF(0, rn) : PG8_KOFF(t + 2, rc);
            const char* a1 = cA + kt0 + kstep;
            const char* a2 = (last ? nA : cA) + kt2; const char* b2 = (last ? nB : cB) + kt2;
            const char* a3 = a2 + kstep; const char* b3 = b2 + kstep;
            const size_t k2 = kt2;
            if (last && has_next) S.a_ready(nxt);
            if constexpr (SP2) {
            PG8_LDB(B0, 0, 0); PG8_LDB(B1, 0, 1); PG8_SCHED; PG8_LDA(At, 0, 0); PG8_STAGE_A(PG8_SA(1, 1), a1 + hstep, kt0 + kstep, 1, false);
            if constexpr (GA) { if (last && has_next) { PG8_GO(goc, ui + 1, nxt); } }
            PG8_WAIT_V(8); PG8_WAIT_L(0); PG8_BAR; PG8_MMA(0, 0, At, B0); PG8_MMA(0, 1, At, B1); PG8_BAR; PG8_SCHED;
            PG8_LDA(At, 0, 1); PG8_STAGE(PG8_SB(0, 0), b2, voffB); PG8_STAGE(PG8_SB(0, 1), b2 + hstep, voffB); PG8_STAGE_A(PG8_SA(0, 0), a2, k2, 0, last);
            PG8_WAIT_V(8); PG8_WAIT_L(0); PG8_BAR; PG8_MMA(1, 0, At, B0); PG8_MMA(1, 1, At, B1); PG8_BAR; PG8_SCHED;
            PG8_LDB(B0, 1, 0); PG8_LDB(B1, 1, 1); PG8_SCHED; PG8_LDA(At, 1, 0); PG8_STAGE_A(PG8_SA(0, 1), a2 + hstep, k2, 1, last);
            PG8_WAIT_V(8); PG8_WAIT_L(0); PG8_BAR; PG8_MMA(0, 0, At, B0); PG8_MMA(0, 1, At, B1); PG8_BAR; PG8_SCHED;
            PG8_LDA(At, 1, 1); PG8_STAGE(PG8_SB(1, 0), b3, voffB); PG8_STAGE(PG8_SB(1, 1), b3 + hstep, voffB); PG8_STAGE_A(PG8_SA(1, 0), a3, k2 + kstep, 0, last);
            PG8_WAIT_V(8); PG8_WAIT_L(0); PG8_BAR; PG8_MMA(1, 0, At, B0); PG8_MMA(1, 1, At, B1); PG8_BAR; PG8_SCHED;
            } else {
            PG8_LDB(B0, 0, 0); PG8_SCHED; PG8_LDA(At, 0, 0); PG8_STAGE(PG8_SA(1, 1), a1 + hstep, voffA);
            PG8_WAIT_L(8); PG8_BAR; PG8_WAIT_L(0); PG8_MMA(0, 0, At, B0); PG8_BAR; PG8_SCHED;
            PG8_LDB(B1, 0, 1); PG8_STAGE(PG8_SB(0, 0), b2, voffB);
            PG8_BAR; PG8_WAIT_L(0); PG8_MMA(0, 1, At, B1); PG8_BAR;
            PG8_LDA(At, 0, 1); PG8_STAGE(PG8_SA(0, 0), a2, voffA);
            PG8_BAR; PG8_WAIT_L(0); PG8_MMA(1, 0, At, B0); PG8_BAR; PG8_SCHED;
            PG8_STAGE(PG8_SB(0, 1), b2 + hstep, voffB);
            PG8_WAIT_V(6); PG8_BAR; PG8_MMA(1, 1, At, B1); PG8_BAR;
            PG8_LDB(B0, 1, 0); PG8_SCHED; PG8_LDA(At, 1, 0); PG8_STAGE(PG8_SA(0, 1), a2 + hstep, voffA);
            PG8_WAIT_L(8); PG8_BAR; PG8_WAIT_L(0); PG8_MMA(0, 0, At, B0); PG8_BAR; PG8_SCHED;
            PG8_LDB(B1, 1, 1); PG8_STAGE(PG8_SB(1, 0), b3, voffB);
            PG8_BAR; PG8_WAIT_L(0); PG8_MMA(0, 1, At, B1); PG8_BAR;
            PG8_LDA(At, 1, 1); PG8_STAGE(PG8_SA(1, 0), a3, voffA);
            PG8_BAR; PG8_WAIT_L(0); PG8_MMA(1, 0, At, B0); PG8_BAR; PG8_SCHED;
            PG8_STAGE(PG8_SB(1, 1), b3 + hstep, voffB);
            PG8_WAIT_V(6); PG8_BAR; PG8_MMA(1, 1, At, B1); PG8_BAR;
            }
        }
        if constexpr (ALIGN_EPI) { if (wr == 0) PG8_BAR; }
        if constexpr (!Epi::AFTER_DRAIN) { E(acc, cur, wr, wc, fr, fq); S.done(cur); }
        if (!has_next) break;
#pragma unroll
        for (int a = 0; a < 2; ++a)
#pragma unroll
            for (int b = 0; b < 2; ++b)
#pragma unroll
                for (int m = 0; m < 4; ++m)
#pragma unroll
                    for (int n = 0; n < 2; ++n) acc[a][b][m][n] = (f32x4){0.f, 0.f, 0.f, 0.f};
        cur = nxt; cA = nA; cB = nB; ++ui; rc = rn;

        if constexpr (ALIGN_EPI) { if (wr == 1) PG8_BAR; }
    }
    PG8_WAIT_V(0);
    if constexpr (!ALIGN_EPI) { if (wr == 0) PG8_BAR; }
    PG8_BAR;
    if constexpr (Epi::AFTER_DRAIN) { E.fused(acc, cur, wr, wc, fr, fq, lds, wid, lane); S.done(cur); }
#undef PG8_SA
#undef PG8_SB
#undef PG8_STAGE
#undef PG8_ROT
#undef PG8_KOFF
#undef PG8_STAGE_A
#undef PG8_GO
#undef PG8_LDA
#undef PG8_LDB
#undef PG8_MMA
#undef PG8_MMA8
#undef PG8_MMA16
#undef PG8_WAIT_V
#undef PG8_WAIT_L
#undef PG8_BAR
#undef PG8_SCHED
}
}

#ifndef PG8_SP2
#define PG8_SP2 true
#endif
#ifndef PG8_ALIGN
#define PG8_ALIGN true
#endif
#define GAS __attribute__((address_space(1)))
#define LAS __attribute__((address_space(3)))
typedef unsigned short bf16;
typedef unsigned v4u __attribute__((ext_vector_type(4)));
typedef float f32x4 __attribute__((ext_vector_type(4)));
typedef short bf16x8 __attribute__((ext_vector_type(8)));
typedef GAS unsigned gu32;
typedef GAS unsigned long long gu64;
#define RLX_AGENT __ATOMIC_RELAXED, __HIP_MEMORY_SCOPE_AGENT
#define LDS_WAIT() asm volatile("s_waitcnt lgkmcnt(0)" ::: "memory")
#define VM_WAIT() asm volatile("s_waitcnt vmcnt(0)" ::: "memory")
__device__ __forceinline__ unsigned long long rt() { return __builtin_amdgcn_s_memrealtime(); }
__device__ __forceinline__ unsigned f2bf(float f) { unsigned u = __builtin_bit_cast(unsigned, f); return (u + 0x7fffu + ((u >> 16) & 1u)) >> 16; }
__device__ __forceinline__ unsigned pk2(float lo, float hi) { return f2bf(lo) | (f2bf(hi) << 16); }

#define XB_TMO      128
#define XB_XCNT(j)  (256  + 64 * (j))
#define XB_XSUB(j)  (1280 + 64 * (j))
#define XB_XGEN(j)  (2304 + 64 * (j))
#define XB_TOP      3328
#define XB_TOPGEN   3392
#define XCD_BAR_WORDS 3456
#define XB_SPIN_CAP (1u << 18)

__device__ __forceinline__ unsigned xb_ld(unsigned* p)              { return __hip_atomic_load(p, __ATOMIC_RELAXED, __HIP_MEMORY_SCOPE_AGENT); }
__device__ __forceinline__ unsigned xb_add(unsigned* p, unsigned v) { return __hip_atomic_fetch_add(p, v, __ATOMIC_RELAXED, __HIP_MEMORY_SCOPE_AGENT); }
__device__ __forceinline__ unsigned xb_xcc_id() { return (unsigned)__builtin_amdgcn_s_getreg((3 << 11) | 20) & 0xFu; }
#define XB_SPIN(cond, bar) do { unsigned _sp = 0; while (cond) { __builtin_amdgcn_s_sleep(1); \
    if ((++_sp & 255u) == 0u) { if (xb_ld(&(bar)[XB_TMO])) break; if (_sp > XB_SPIN_CAP) { atomicAdd(&(bar)[XB_TMO], 1u); break; } } } } while (0)

struct XcdBarrier {
    unsigned* bar; unsigned x;
    volatile LAS unsigned* st;
};

__device__ __forceinline__ XcdBarrier xcd_barrier_post(unsigned* bar, volatile LAS unsigned* st, bool leader) {
    XcdBarrier b; b.bar = bar; b.x = xb_xcc_id(); b.st = st;
    if (leader) (void)xb_add(&bar[XB_XCNT(b.x)], 1u);
    return b;
}
__device__ __forceinline__ void xcd_barrier_complete(unsigned* bar, unsigned x, unsigned& nloc, unsigned& nx) {
    const unsigned G = gridDim.x * gridDim.y * gridDim.z;
    unsigned sum, cnt, mine, sp = 0u;
    for (;;) {
        sum = 0u; cnt = 0u; mine = 0u;
#pragma unroll
        for (unsigned j = 0; j < 16; ++j) { const unsigned c = xb_ld(&bar[XB_XCNT(j)]); sum += c; cnt += (c > 0u) ? 1u : 0u; mine = (j == x) ? c : mine; }
        if (sum == G) break;
        __builtin_amdgcn_s_sleep(1);
        if ((++sp & 255u) == 0u) { if (xb_ld(&bar[XB_TMO])) break; if (sp > XB_SPIN_CAP) { atomicAdd(&bar[XB_TMO], 1u); break; } }
    }
    nloc = mine > 0u ? mine : 1u; nx = cnt > 0u ? cnt : 1u;
}

__device__ __forceinline__ void xcd_barrier(const XcdBarrier& b, bool leader) {
    asm volatile("s_waitcnt vmcnt(0)" ::: "memory");
    __syncthreads();
    if (leader) {
        unsigned* bar = b.bar;
        __builtin_amdgcn_s_waitcnt(0);
        unsigned nloc = b.st[0], nx = b.st[1];
        if (nloc == 0u) { xcd_barrier_complete(bar, b.x, nloc, nx); b.st[0] = nloc; b.st[1] = nx; }
        const unsigned old = xb_add(&bar[XB_XSUB(b.x)], 1u);
        const unsigned gen = old / nloc;
        if (old + 1u == (gen + 1u) * nloc) {
            __builtin_amdgcn_fence(__ATOMIC_RELEASE, "agent");
            asm volatile("s_waitcnt vmcnt(0)" ::: "memory");
            const unsigned og = xb_add(&bar[XB_TOP], 1u);
            const unsigned tg = og / nx;
            if (og + 1u == (tg + 1u) * nx) xb_add(&bar[XB_TOPGEN], 1u);
            else XB_SPIN(xb_ld(&bar[XB_TOPGEN]) == tg, bar);
            __builtin_amdgcn_fence(__ATOMIC_ACQUIRE, "agent");
            xb_add(&bar[XB_XGEN(b.x)], 1u);
            asm volatile("s_waitcnt vmcnt(0)" ::: "memory");
        } else {
            XB_SPIN(xb_ld(&bar[XB_XGEN(b.x)]) == gen, bar);
            __builtin_amdgcn_fence(__ATOMIC_ACQUIRE, "agent");
            asm volatile("s_waitcnt vmcnt(0)" ::: "memory");
        }
    }
    __syncthreads();
}
constexpr int NWAVES = 8;
constexpr int B_ = 8, S_ = 2048, T = B_ * S_, D = 1024;
constexpr int INC = 3784;
constexpr int O_Q = 0, O_CKV = 512, O_QI = 640, O_KI = 1152, O_WI = 1216, O_U = 1224, O_G = 1736;
constexpr int NIN = 3840;
constexpr float ALPHA = 1.189207115002721f, LN_EPS = 1e-5f, LOG2E = 1.4426950408889634f;
constexpr int MAXROWS = T * 4 + 32 * 256;
constexpr int TOPK = 256;
constexpr float A8_H = 32.f, W8_GU = 1024.f, A8_ACT = 8.f, W8_D = 2048.f;

constexpr size_t MiB = 1u << 20;
constexpr size_t WS_CTL = 0, CTL_ZERO_BYTES = 1 * MiB;
constexpr size_t WS_MOD = 1 * MiB, WS_WIN = 2 * MiB, WS_WOA = 11 * MiB, WS_WPB = 13 * MiB, WS_WOUT = 14 * MiB, WS_WGU = 16 * MiB, WS_WD = 144 * MiB;
constexpr size_t WS_H = 208 * MiB, WS_QL = 240 * MiB, WS_QI = 272 * MiB, WS_MISC = 288 * MiB, WS_U = 304 * MiB, WS_SG = 320 * MiB;
constexpr size_t WS_CKV = 384 * MiB, WS_CKVT = 388 * MiB, WS_POOLED = 392 * MiB, WS_MASK = 408 * MiB, WS_OLAT = 412 * MiB, WS_TMP = 444 * MiB, WS_MIX = 476 * MiB;
constexpr size_t WS_Z = 508 * MiB, WS_X1 = 572 * MiB, WS_SLOTMAP = 636 * MiB, WS_TOKSLOT = 638 * MiB, WS_GATE = 638 * MiB + 512 * 1024;
constexpr size_t WS_XPAD = 640 * MiB, WS_ACT = 784 * MiB, WS_Y = WS_XPAD, WS_KI = 928 * MiB, WS_WRB = 930 * MiB, WS_END = 931 * MiB;
constexpr size_t WS_WBA = WS_WOA, WS_WUKB = WS_WOA + 1 * MiB, WS_WUVT = WS_WOA + 1 * MiB + 256 * 1024, WS_YA = WS_OLAT;
constexpr int CW_GCNT = 0, CW_TSTART = 64, CW_BAR = 4096;

constexpr int RING_OFF = 0, RING_BYTES = 131072;
constexpr int LDSCTL_OFF = RING_BYTES, MISC_OFF = LDSCTL_OFF + 320;
constexpr int LDS_BYTES = 163840;

struct Frame {
    LAS unsigned char* lds;
    volatile LAS unsigned* MISCW;
    gu32* ctl;
    int tid, lane, wave, vcu, G;
    unsigned char* ws;
    float* out;
};
__device__ __forceinline__ const float* frame_in(int i) { typedef __attribute__((address_space(4))) const char* kptr_t; kptr_t ka = (kptr_t)__builtin_amdgcn_kernarg_segment_ptr(); asm volatile("" : "+s"(ka));
    const float* p = *(const float* __attribute__((address_space(4))) const*)(ka + 8 * i); return (const float*)(const GAS float*)p; }
typedef __bf16 bf2v __attribute__((ext_vector_type(2)));
typedef float f2v __attribute__((ext_vector_type(2)));
__device__ __forceinline__ unsigned pkbf(float a, float b) { f2v v = {a, b}; bf2v r = __builtin_convertvector(v, bf2v); return __builtin_bit_cast(unsigned, r); }
__device__ __forceinline__ size_t bl_off(int r, int k, int K) { return ((size_t)(r >> 8) * (size_t)(K >> 6) + (size_t)(k >> 6)) * 16384 + (size_t)((r & 255) * 64 + (k & 63)); }
__device__ __forceinline__ float bf2f(unsigned short u) { return __uint_as_float((unsigned)u << 16); }
__device__ __forceinline__ float sigm_fast(float x) { return __builtin_amdgcn_rcpf(1.f + __builtin_amdgcn_exp2f(-x * LOG2E)); }

typedef float f32x16 __attribute__((ext_vector_type(16)));
__device__ __forceinline__ bf16x8 pack8(float a0, float a1, float a2, float a3, float a4, float a5, float a6, float a7) {
    v4u p; p.x = pkbf(a0, a1); p.y = pkbf(a2, a3); p.z = pkbf(a4, a5); p.w = pkbf(a6, a7); return __builtin_bit_cast(bf16x8, p); }
#define MFMA32(a, b, c) __builtin_amdgcn_mfma_f32_32x32x16_bf16((a), (b), (c), 0, 0, 0)
__device__ __forceinline__ int krow16(int r, int hh) { return (r & 3) + 8 * (r >> 2) + 4 * hh; }

namespace pg8 {
struct EpiInProj {
    static constexpr bool PERM = true, AFTER_DRAIN = false;
    bf16_t *QL, *QI, *U, *SG; float* MISC; bf16_t* KI;
    __device__ __forceinline__ void operator()(const f32x4 (&acc)[2][2][4][2], const Unit& u, int wr, int wc, int fr_, int fq_) const {
        int fr = fr_, fq = fq_; asm volatile("" : "+v"(fr), "+v"(fq));
        const int row0 = u.pm * BM + wr * 64 + fr, c0 = wc * 32 + 8 * fq; const int pn = u.pn;
        if (pn == 4) {
#pragma unroll
            for (int ai = 0; ai < 2; ++ai)
#pragma unroll
                for (int m = 0; m < 4; ++m) { float* rowp = MISC + (size_t)(row0 + ai * HALF + m * 16) * 256 + c0;
#pragma unroll
                    for (int bj = 0; bj < 2; ++bj) { *(f32x4*)(rowp + bj * HALF) = acc[ai][bj][m][0]; *(f32x4*)(rowp + bj * HALF + 4) = acc[ai][bj][m][1]; }
                    if (wc < 2) { const f32x4 v0 = acc[ai][1][m][0], v1 = acc[ai][1][m][1]; u32x4 w; w.x = cvt_pk_bf16(v0[0], v0[1]); w.y = cvt_pk_bf16(v0[2], v0[3]); w.z = cvt_pk_bf16(v1[0], v1[1]); w.w = cvt_pk_bf16(v1[2], v1[3]);
                        *(u32x4*)(KI + (size_t)(row0 + ai * HALF + m * 16) * 64 + c0) = w; } }
        } else {
            bf16_t* base; int ld, colt; bool sg = false;
            if (pn < 2) { base = QL; ld = 512; colt = pn * 256; }
            else if (pn < 4) { base = QI; ld = 512; colt = (pn - 2) * 256; }
            else if (pn < 7) { base = U; ld = 512; colt = (pn - 5) * 256; }
            else { base = SG; ld = 2048; colt = (pn - 7) * 256; sg = true; }
#pragma unroll
            for (int ai = 0; ai < 2; ++ai)
#pragma unroll
                for (int m = 0; m < 4; ++m) { bf16_t* rowp = base + (size_t)(row0 + ai * HALF + m * 16) * ld + colt + c0;
#pragma unroll
                    for (int bj = 0; bj < 2; ++bj) { f32x4 v0 = acc[ai][bj][m][0], v1 = acc[ai][bj][m][1];
                        if (sg) {
#pragma unroll
                            for (int i = 0; i < 4; ++i) { v0[i] = sigm_fast(v0[i]); v1[i] = sigm_fast(v1[i]); } }
                        u32x4 w; w.x = cvt_pk_bf16(v0[0], v0[1]); w.y = cvt_pk_bf16(v0[2], v0[3]); w.z = cvt_pk_bf16(v1[0], v1[1]); w.w = cvt_pk_bf16(v1[2], v1[3]);
                        *(u32x4*)(rowp + bj * HALF) = w; } }
        }
    }
};
}

__device__ __forceinline__ void tr_item(const float* W, int ldw, int k0, int n0, int ncols, float scale, bf16* WT, int ldt, int drow0, LAS float* scr, int lane) {
    const int nn = lane & 31;
#pragma unroll 8
    for (int i = 0; i < 32; ++i) { const int kk = 2 * i + (lane >> 5); scr[kk * 33 + nn] = (nn < ncols) ? W[(size_t)(k0 + kk) * ldw + n0 + nn] * scale : 0.f; }
    LDS_WAIT(); asm volatile("" ::: "memory");
    const int c = lane & 7;
#pragma unroll
    for (int j = 0; j < 4; ++j) { const int n = (lane >> 3) + 8 * j; const LAS float* s = scr + (8 * c) * 33 + n;
        v4u o; o.x = pk2(s[0 * 33], s[1 * 33]); o.y = pk2(s[2 * 33], s[3 * 33]); o.z = pk2(s[4 * 33], s[5 * 33]); o.w = pk2(s[6 * 33], s[7 * 33]);
        if (n < ncols) *(GAS v4u*)(WT + bl_off(drow0 + n, k0 + 8 * c, ldt)) = o; }
    LDS_WAIT(); asm volatile("" ::: "memory");
}
__device__ __forceinline__ float clamp8(float x) { return fminf(fmaxf(x, -448.f), 448.f); }
struct TrDesc { const float* src; bf16* dst; int ldw; float scale; int f8; int pad_; };
__device__ __forceinline__ void tr_load(const TrDesc& d, int lane, f32x4 (&v)[16]) {
    const int kr = lane >> 4, nc = lane & 15; const float* src = d.src + (size_t)(16 * kr) * d.ldw + 4 * nc;
#pragma unroll
    for (int i = 0; i < 16; ++i) v[i] = __builtin_nontemporal_load((const f32x4*)(src + (size_t)i * d.ldw));
}
__device__ __forceinline__ void tr_finish(const TrDesc& d, LAS unsigned char* scr, int lane, const f32x4 (&v)[16]) {
    const int kr = lane >> 4, nc = lane & 15; const float scale = d.scale;
    if (d.f8) {
#pragma unroll
        for (int j = 0; j < 4; ++j) { const int n = 4 * nc + j; v4u o;
#pragma unroll
            for (int w4 = 0; w4 < 4; ++w4) { unsigned r = __builtin_amdgcn_cvt_pk_fp8_f32(clamp8(v[4 * w4][j] * scale), clamp8(v[4 * w4 + 1][j] * scale), 0u, false);
                r = __builtin_amdgcn_cvt_pk_fp8_f32(clamp8(v[4 * w4 + 2][j] * scale), clamp8(v[4 * w4 + 3][j] * scale), r, true); o[w4] = r; }
            *(LAS v4u*)(scr + n * 64 + ((kr ^ ((n >> 2) & 3)) << 4)) = o; }
        LDS_WAIT(); asm volatile("" ::: "memory");
        const int kc4 = lane & 3;
#pragma unroll
        for (int j = 0; j < 4; ++j) { const int n = (lane >> 2) + 16 * j; const v4u o = *(const LAS v4u*)(scr + n * 64 + ((kc4 ^ ((n >> 2) & 3)) << 4));
            *(GAS v4u*)((GAS unsigned char*)(d.dst + (size_t)n * 64) + 16 * kc4) = o; }
        LDS_WAIT(); asm volatile("" ::: "memory");
        return; }
#pragma unroll
    for (int j = 0; j < 4; ++j) { const int n = 4 * nc + j; const int f = (n >> 2) & 7;
#pragma unroll
        for (int hlf = 0; hlf < 2; ++hlf) { v4u o;
            o.x = pkbf(v[8 * hlf + 0][j] * scale, v[8 * hlf + 1][j] * scale); o.y = pkbf(v[8 * hlf + 2][j] * scale, v[8 * hlf + 3][j] * scale);
            o.z = pkbf(v[8 * hlf + 4][j] * scale, v[8 * hlf + 5][j] * scale); o.w = pkbf(v[8 * hlf + 6][j] * scale, v[8 * hlf + 7][j] * scale);
            *(LAS v4u*)(scr + n * 128 + (((2 * kr + hlf) ^ f) << 4)) = o; } }
    LDS_WAIT(); asm volatile("" ::: "memory");
    const int kc = lane & 7;
#pragma unroll
    for (int j = 0; j < 8; ++j) { const int n = (lane >> 3) + 8 * j; const v4u o = *(const LAS v4u*)(scr + n * 128 + ((kc ^ ((n >> 2) & 7)) << 4));
        *(GAS v4u*)(d.dst + (size_t)n * 64 + 8 * kc) = o; }
    LDS_WAIT(); asm volatile("" ::: "memory");
}
__device__ __forceinline__ void fold_pb(const float* w_pg, const float* pscale, const float* w_bp, bf16* Wpb_t, int task, int lane) {
    const int g = task >> 8, nb = (task >> 4) & 15, c0 = (task & 15) * 8; const int n = nb * 64 + lane;
    const float* pg = w_pg + (size_t)g * 16384 + c0 * 128; float a[8] = {0, 0, 0, 0, 0, 0, 0, 0};
#pragma unroll 4
    for (int d4 = 0; d4 < 32; ++d4) { float v[4]; const f32x4 ps = *(const f32x4*)(pscale + g * 128 + 4 * d4);
#pragma unroll
        for (int i = 0; i < 4; ++i) v[i] = w_bp[(size_t)(g * 128 + 4 * d4 + i) * 1024 + n] * ps[i];
#pragma unroll
        for (int j = 0; j < 8; ++j) { const f32x4 u = *(const f32x4*)(pg + j * 128 + 4 * d4); a[j] += (v[0] * u.x + v[1] * u.y) + (v[2] * u.z + v[3] * u.w); } }
    v4u o; o.x = pk2(a[0], a[1]); o.y = pk2(a[2], a[3]); o.z = pk2(a[4], a[5]); o.w = pk2(a[6], a[7]);
    *(GAS v4u*)(Wpb_t + bl_off(n, g * 128 + c0, 512)) = o;
}
template <int VAR>
__device__ __forceinline__ void p0_prologue(Frame& F) {
    const float* c = frame_in(1); const float* w_ada = frame_in(2); const float* b_ada = frame_in(3); const float* w_in = frame_in(4);
    const float* w_uk = frame_in(6); const float* w_uv = frame_in(7); const float* w_pg = frame_in(8); const float* pscale = frame_in(9);
    const float* w_ba = frame_in(10); const float* w_bp = frame_in(11); const float* w_out = frame_in(12); const float* w_gu = frame_in(17); const float* w_d = frame_in(19);
    bf16* Win_t = (bf16*)(F.ws + WS_WIN); bf16* Wpb_t = (bf16*)(F.ws + WS_WPB); bf16* Wout_t = (bf16*)(F.ws + WS_WOUT);
    bf16* Wgu_t = (bf16*)(F.ws + WS_WGU); bf16* Wd_t = (bf16*)(F.ws + WS_WD); float* MOD = (float*)(F.ws + WS_MOD);
    for (int cg = blockIdx.x; cg < 256; cg += F.G) {
        LAS float* cs = (LAS float*)(F.lds + 69632); LAS float* red = (LAS float*)(F.lds + 69632 + 32768);
        for (int i = F.tid; i < 8192; i += 512) { const float v = c[i]; cs[i] = v / (1.f + __expf(-v)); }
        __syncthreads();
        float acc[8] = {0, 0, 0, 0, 0, 0, 0, 0}; const int cc = F.lane & 31, rp = F.lane >> 5; const bool act = cc < 24; const float* wp = w_ada + cg * 24 + (act ? cc : 0);
#pragma unroll 16
        for (int i = 0; i < 64; ++i) { const int k = F.wave * 128 + 2 * i + rp; float w = __builtin_nontemporal_load(wp + (size_t)k * 6144); w = act ? w : 0.f;
#pragma unroll
            for (int b = 0; b < 8; ++b) acc[b] += cs[b * 1024 + k] * w; }
#pragma unroll
        for (int b = 0; b < 8; ++b) red[((F.wave * 2 + rp) * 8 + b) * 32 + cc] = acc[b];
        __syncthreads();
        if (F.tid < 256) { const int b = F.tid >> 5, l = F.tid & 31; if (l < 24) { float s = 0.f;
#pragma unroll
            for (int w = 0; w < 16; ++w) s += red[(w * 8 + b) * 32 + l];
            MOD[b * 6144 + cg * 24 + l] = s + b_ada[cg * 24 + l]; } }
        __syncthreads();
    }
    LAS unsigned char* scr8 = F.lds + F.wave * 8448; LAS float* scr = (LAS float*)scr8;
    const int gw = F.vcu * NWAVES + F.wave, NGW = F.G * NWAVES;
    constexpr int I_FQ = 64  , I_FO = 64  , I_FP = 1024, I_Z = 56, I_WI = 16, I_WR = 64, NSMALL = I_FQ + I_FO + I_FP + I_Z + I_WI + I_WR;
    for (int it = gw; it < NSMALL; it += NGW) {
        int r = it;
        if (r < I_FQ) {
            bf16* WukB = (bf16*)(F.ws + WS_WUKB); const int h = r >> 3, rr = (r & 7) * 16 + (F.lane >> 2), dc = F.lane & 3; const float* sp = w_uk + (size_t)rr * 512 + h * 64 + dc * 16;
            const f32x4 a = *(const f32x4*)sp, b = *(const f32x4*)(sp + 4), c4 = *(const f32x4*)(sp + 8), d4 = *(const f32x4*)(sp + 12);
            GAS v4u* dp = (GAS v4u*)(WukB + (size_t)(h * 128 + rr) * 64 + dc * 16);
            dp[0] = (v4u){pkbf(a.x, a.y), pkbf(a.z, a.w), pkbf(b.x, b.y), pkbf(b.z, b.w)}; dp[1] = (v4u){pkbf(c4.x, c4.y), pkbf(c4.z, c4.w), pkbf(d4.x, d4.y), pkbf(d4.z, d4.w)};
            continue; } r -= I_FQ;
        if (r < I_FO) {
            bf16* WuvT = (bf16*)(F.ws + WS_WUVT); const int h = r >> 3, dp = (r & 7) * 8 + (F.lane >> 3), c0 = (F.lane & 7) * 2;
#pragma unroll
            for (int cc = 0; cc < 2; ++cc) { const int cidx = c0 + cc, ks = cidx >> 1, hh = cidx & 1; float v[8];
#pragma unroll
                for (int j = 0; j < 8; ++j) v[j] = w_uv[(size_t)(16 * ks + 8 * (j >> 2) + 4 * hh + (j & 3)) * 512 + h * 64 + dp];
                *(GAS v4u*)(WuvT + (size_t)(h * 64 + dp) * 128 + cidx * 8) = (v4u){pkbf(v[0], v[1]), pkbf(v[2], v[3]), pkbf(v[4], v[5]), pkbf(v[6], v[7])}; }
            continue; } r -= I_FO;
        if (r < I_FP) { fold_pb(w_pg, pscale, w_bp, Wpb_t, r, F.lane); continue; } r -= I_FP;
        if (r < I_Z) { *(GAS v4u*)(Win_t + bl_off(1224 + r, F.lane * 8, 1024)) = (v4u){0u, 0u, 0u, 0u}; *(GAS v4u*)(Win_t + bl_off(1224 + r, (F.lane + 64) * 8, 1024)) = (v4u){0u, 0u, 0u, 0u}; continue; } r -= I_Z;
        if (r < I_WI) { tr_item(w_in, INC, r * 64, O_WI, 8, 0.35355339059327373f, Win_t, 1024, 1216, scr, F.lane); continue; } r -= I_WI;
        {
            const float* w_r = frame_in(15); bf16* WrB = (bf16*)(F.ws + WS_WRB); const int ks = r, e = F.lane & 31, h8 = F.lane >> 5; float v[8]; unsigned hi[4], lo[4];
#pragma unroll
            for (int j = 0; j < 8; ++j) v[j] = w_r[(size_t)(16 * ks + 8 * h8 + j) * 32 + e];
#pragma unroll
            for (int j = 0; j < 4; ++j) { hi[j] = pkbf(v[2 * j], v[2 * j + 1]); lo[j] = pkbf(v[2 * j] - __uint_as_float(hi[j] << 16), v[2 * j + 1] - __uint_as_float(hi[j] & 0xffff0000u)); }
            *(GAS v4u*)(WrB + ((size_t)(ks * 2) * 64 + F.lane) * 8) = (v4u){hi[0], hi[1], hi[2], hi[3]}; *(GAS v4u*)(WrB + ((size_t)(ks * 2 + 1) * 64 + F.lane) * 8) = (v4u){lo[0], lo[1], lo[2], lo[3]}; }
    }
    constexpr int I_Q = 128, I_QI = 128, I_CKV = 32, I_KI = 16, I_U = 128, I_G = 512, I_OUT = 256, I_BA = 128, I_GU = 32 * 512, I_D = 32 * 256;
    constexpr int NTR = I_Q + I_QI + I_CKV + I_KI + I_U + I_G + I_OUT + I_BA + (VAR >= 1 ? 0 : I_GU + I_D);
    auto decode = [&](int r) -> TrDesc {
        if (r < I_Q) return TrDesc{w_in + (size_t)((r >> 3) * 64) * INC + O_Q + (r & 7) * 64, Win_t + bl_off((r & 7) * 64, (r >> 3) * 64, 1024), INC, 0.125f * LOG2E, 0, 0}; r -= I_Q;
        if (r < I_QI) return TrDesc{w_in + (size_t)((r >> 3) * 64) * INC + O_QI + (r & 7) * 64, Win_t + bl_off(512 + (r & 7) * 64, (r >> 3) * 64, 1024), INC, 0.125f, 0, 0}; r -= I_QI;
        if (r < I_CKV) return TrDesc{w_in + (size_t)((r >> 1) * 64) * INC + O_CKV + (r & 1) * 64, Win_t + bl_off(1024 + (r & 1) * 64, (r >> 1) * 64, 1024), INC, 1.f, 0, 0}; r -= I_CKV;
        if (r < I_KI) return TrDesc{w_in + (size_t)(r * 64) * INC + O_KI, Win_t + bl_off(1152, r * 64, 1024), INC, 1.f, 0, 0}; r -= I_KI;
        if (r < I_U) return TrDesc{w_in + (size_t)((r >> 3) * 64) * INC + O_U + (r & 7) * 64, Win_t + bl_off(1280 + (r & 7) * 64, (r >> 3) * 64, 1024), INC, 1.f, 0, 0}; r -= I_U;
        if (r < I_G) return TrDesc{w_in + (size_t)((r >> 5) * 64) * INC + O_G + (r & 31) * 64, Win_t + bl_off(1792 + (r & 31) * 64, (r >> 5) * 64, 1024), INC, 1.f, 0, 0}; r -= I_G;
        if (r < I_OUT) return TrDesc{w_out + (size_t)((r >> 4) * 64) * 1024 + (r & 15) * 64, Wout_t + bl_off((r & 15) * 64, (r >> 4) * 64, 1024), 1024, 1.f, 0, 0}; r -= I_OUT;
        if (r < I_BA) return TrDesc{w_ba + (size_t)((r >> 4) * 64) * 1024 + (r & 15) * 64, (bf16*)(F.ws + WS_WBA) + bl_off((r & 15) * 64, (r >> 4) * 64, 512), 1024, 1.f, 0, 0}; r -= I_BA;
        if (r < I_GU) { const int e = r >> 9, q = r & 511, kb = q >> 5, n0 = (q & 31) * 64;
            const int drow = (n0 < 1024) ? ((n0 >> 7) * 256 + (n0 & 127)) : (((n0 - 1024) >> 7) * 256 + 128 + ((n0 - 1024) & 127));
            return TrDesc{w_gu + ((size_t)e * 1024 + kb * 64) * 2048 + n0, Wgu_t + bl_off(e * 2048 + drow, kb * 32, 512), 2048, W8_GU, 1, 0}; } r -= I_GU;
        { const int e = r >> 8, q = r & 255, kb = q >> 4, n0 = (q & 15) * 64;
          return TrDesc{w_d + ((size_t)e * 1024 + kb * 64) * 1024 + n0, Wd_t + bl_off(e * 1024 + n0, kb * 32, 512), 1024, W8_D, 1, 0}; }
    };
    {   f32x4 vA[16], vB[16]; TrDesc dA, dB; int it = gw;
        if (it < NTR) { dA = decode(it); tr_load(dA, F.lane, vA); }
        while (it < NTR) {
            int itn = it + NGW; if (itn < NTR) { dB = decode(itn); tr_load(dB, F.lane, vB); }
            tr_finish(dA, scr8, F.lane, vA);
            it = itn; if (it >= NTR) break;
            itn = it + NGW; if (itn < NTR) { dA = decode(itn); tr_load(dA, F.lane, vA); }
            tr_finish(dB, scr8, F.lane, vB);
            it = itn;
        }
    }
}
__device__ __forceinline__ void p1_modulate(Frame& F) {
    const float* x = frame_in(0); const float* MOD = (const float*)(F.ws + WS_MOD); bf16* H = (bf16*)(F.ws + WS_H);
    const int gw = F.vcu * NWAVES + F.wave, NGW = F.G * NWAVES;
    for (int m = gw; m < T; m += NGW) { const int b = m >> 11;
        const GAS f32x4* xr = (const GAS f32x4*)(x + (size_t)m * D) + F.lane;
#pragma unroll
        for (int j = 0; j < 4; ++j) { const f32x4 v = xr[64 * j]; const int col = 4 * F.lane + 256 * j;
            const f32x4 sh = *(const f32x4*)(MOD + b * 6144 + col), sc = *(const f32x4*)(MOD + b * 6144 + 1024 + col);
            const f32x4 h = v * (sc + 1.0f) + sh;
            *(GAS unsigned long long*)(H + bl_off(m, col, D)) = (unsigned long long)pk2(h.x, h.y) | ((unsigned long long)pk2(h.z, h.w) << 32); }
    }
}
constexpr int MOE_TAB_SLOTS = 10, LC_ROWTAB = LDSCTL_OFF + 8192;
constexpr int LC_LCNT = LDSCTL_OFF + 1024, LC_BASE = LDSCTL_OFF + 1280, LC_TSTART = LDSCTL_OFF + 1536, LC_LIST = LDSCTL_OFF + 4096;
namespace pg8 {
__device__ __forceinline__ float bfl(unsigned w) { return __uint_as_float(w << 16); }
__device__ __forceinline__ float bfh(unsigned w) { return __uint_as_float(w & 0xffff0000u); }
struct EpiGateMul {
    static constexpr bool PERM = true, AFTER_DRAIN = false;
    bf16_t* O; const bf16_t* SG; int goff, pad;
    __device__ __forceinline__ void operator()(const f32x4 (&acc)[2][2][4][2], const Unit& u, int wr, int wc, int fr_, int fq_) const {
        int fr = fr_, fq = fq_; asm volatile("" : "+v"(fr), "+v"(fq));
        const int row0 = u.pm * BM + wr * 64 + fr, col0 = u.pn * BM + wc * 32 + 8 * fq;
#pragma unroll
        for (int ai = 0; ai < 2; ++ai)
#pragma unroll
            for (int m = 0; m < 4; ++m) { const size_t row = (size_t)(row0 + ai * HALF + m * 16);
#pragma unroll
                for (int bj = 0; bj < 2; ++bj) { const u32x4 g = *(const u32x4*)(SG + row * 2048 + goff + col0 + bj * HALF); const f32x4 v0 = acc[ai][bj][m][0], v1 = acc[ai][bj][m][1];
                    u32x4 w; w.x = cvt_pk_bf16(v0[0] * bfl(g.x), v0[1] * bfh(g.x)); w.y = cvt_pk_bf16(v0[2] * bfl(g.y), v0[3] * bfh(g.y));
                    w.z = cvt_pk_bf16(v1[0] * bfl(g.z), v1[1] * bfh(g.z)); w.w = cvt_pk_bf16(v1[2] * bfl(g.w), v1[3] * bfh(g.w));
                    *(u32x4*)(O + row * 1024 + col0 + bj * HALF) = w; } }
    }
};
struct EpiGateAdd {
    static constexpr bool PERM = true, AFTER_DRAIN = false;
    bf16_t* O; const bf16_t* TMPB; const bf16_t* SG; int goff, pad;
    __device__ __forceinline__ void operator()(const f32x4 (&acc)[2][2][4][2], const Unit& u, int wr, int wc, int fr_, int fq_) const {
        int fr = fr_, fq = fq_; asm volatile("" : "+v"(fr), "+v"(fq));
        const int row0 = u.pm * BM + wr * 64 + fr, col0 = u.pn * BM + wc * 32 + 8 * fq;
#pragma unroll
        for (int ai = 0; ai < 2; ++ai)
#pragma unroll
            for (int m = 0; m < 4; ++m) { const size_t row = (size_t)(row0 + ai * HALF + m * 16);
#pragma unroll
                for (int bj = 0; bj < 2; ++bj) { const u32x4 g = *(const u32x4*)(SG + row * 2048 + goff + col0 + bj * HALF); const u32x4 t = *(const u32x4*)(TMPB + row * 1024 + col0 + bj * HALF);
                    const f32x4 v0 = acc[ai][bj][m][0], v1 = acc[ai][bj][m][1];
                    u32x4 w; w.x = cvt_pk_bf16(bfl(t.x) + v0[0] * bfl(g.x), bfh(t.x) + v0[1] * bfh(g.x)); w.y = cvt_pk_bf16(bfl(t.y) + v0[2] * bfl(g.y), bfh(t.y) + v0[3] * bfh(g.y));
                    w.z = cvt_pk_bf16(bfl(t.z) + v1[0] * bfl(g.z), bfh(t.z) + v1[1] * bfh(g.z)); w.w = cvt_pk_bf16(bfl(t.w) + v1[2] * bfl(g.w), bfh(t.w) + v1[3] * bfh(g.w));
                    *(u32x4*)(O + bl_off((int)row, col0 + bj * HALF, 1024)) = w; } }
    }
};
struct EpiResid {
    static constexpr bool PERM = false, AFTER_DRAIN = false;
    float* Z; const float* x; const float* gate;
    __device__ __forceinline__ void operator()(const f32x4 (&acc)[2][2][4][2], const Unit& u, int wr, int wc, int fr_, int fq_) const {
        int fr = fr_, fq = fq_; asm volatile("" : "+v"(fr), "+v"(fq));
        const int row0 = u.pm * BM + wr * 64 + fr, col0 = u.pn * BM + wc * 32 + 4 * fq; const int b = (u.pm * BM) >> 11;
        f32x4 gv[2][2];
#pragma unroll
        for (int bj = 0; bj < 2; ++bj)
#pragma unroll
            for (int n = 0; n < 2; ++n) gv[bj][n] = *(const f32x4*)(gate + b * 6144 + col0 + bj * HALF + n * 16);
#pragma unroll
        for (int ai = 0; ai < 2; ++ai)
#pragma unroll
            for (int m = 0; m < 4; ++m) { const size_t off = (size_t)(row0 + ai * HALF + m * 16) * 1024 + col0;
#pragma unroll
                for (int bj = 0; bj < 2; ++bj)
#pragma unroll
                    for (int n = 0; n < 2; ++n) { const f32x4 xv = *(const f32x4*)(x + off + bj * HALF + n * 16); *(f32x4*)(Z + off + bj * HALF + n * 16) = xv * ALPHA + gv[bj][n] * acc[ai][bj][m][n]; } }
    }
};
struct EpiSwiglu {
    static constexpr bool PERM = true, AFTER_DRAIN = false;
    bf16_t* ACT; const float* bgu;
    __device__ __forceinline__ void operator()(const f32x4 (&acc)[2][2][4][2], const Unit& u, int wr, int wc, int fr_, int fq_) const {
        int fr = fr_, fq = fq_; asm volatile("" : "+v"(fr), "+v"(fq));
        const int e = u.pn >> 3, j = u.pn & 7; const int row0 = u.pm * BM + wr * 64 + fr, cc = wc * 32 + 8 * fq;
        const float* bg = bgu + e * 2048 + j * 128 + cc; f32x4 bgl[2], bli[2];
#pragma unroll
        for (int n = 0; n < 2; ++n) { bgl[n] = *(const f32x4*)(bg + 4 * n); bli[n] = *(const f32x4*)(bg + 1024 + 4 * n); }
#pragma unroll
        for (int ai = 0; ai < 2; ++ai)
#pragma unroll
            for (int m = 0; m < 4; ++m) { float o[8];
#pragma unroll
                for (int n = 0; n < 2; ++n) { const f32x4 gl4 = acc[ai][0][m][n] * (1.f / (A8_H * W8_GU)) + bgl[n], li4 = acc[ai][1][m][n] * (1.f / (A8_H * W8_GU)) + bli[n];
#pragma unroll
                    for (int i = 0; i < 4; ++i) { const float gl = fminf(gl4[i], 7.f), li = fminf(fmaxf(li4[i], -7.f), 7.f);
                        o[4 * n + i] = gl * __builtin_amdgcn_rcpf(1.f + __builtin_amdgcn_exp2f(gl * (-1.702f * LOG2E))) * (li + 1.f); } }
                unsigned w0 = __builtin_amdgcn_cvt_pk_fp8_f32(clamp8(o[0] * A8_ACT), clamp8(o[1] * A8_ACT), 0u, false); w0 = __builtin_amdgcn_cvt_pk_fp8_f32(clamp8(o[2] * A8_ACT), clamp8(o[3] * A8_ACT), w0, true);
                unsigned w1 = __builtin_amdgcn_cvt_pk_fp8_f32(clamp8(o[4] * A8_ACT), clamp8(o[5] * A8_ACT), 0u, false); w1 = __builtin_amdgcn_cvt_pk_fp8_f32(clamp8(o[6] * A8_ACT), clamp8(o[7] * A8_ACT), w1, true);
                *(unsigned long long*)(ACT + bl_off(row0 + ai * HALF + m * 16, (j * 128 + cc) >> 1, 512)) = (unsigned long long)w0 | ((unsigned long long)w1 << 32); }
    }
};
template <bool BIAS>
struct EpiDownT {
    static constexpr bool PERM = true, AFTER_DRAIN = false;
    bf16_t* Y; const float* bd;
    __device__ __forceinline__ void operator()(const f32x4 (&acc)[2][2][4][2], const Unit& u, int wr, int wc, int fr_, int fq_) const {
        int fr = fr_, fq = fq_; asm volatile("" : "+v"(fr), "+v"(fq));
        const int e = u.pn >> 2, j = u.pn & 3; const int row0 = u.pm * BM + wr * 64 + fr, col0 = j * 256 + wc * 32 + 8 * fq;
        f32x4 bv[2][2];
#pragma unroll
        for (int bj = 0; bj < 2; ++bj)
#pragma unroll
            for (int n = 0; n < 2; ++n) bv[bj][n] = BIAS ? *(const f32x4*)(bd + e * 1024 + col0 + bj * HALF + 4 * n) : (f32x4){0.f, 0.f, 0.f, 0.f};
#pragma unroll
        for (int ai = 0; ai < 2; ++ai)
#pragma unroll
            for (int m = 0; m < 4; ++m) { bf16_t* rowp = Y + (size_t)(row0 + ai * HALF + m * 16) * 1024 + col0;
#pragma unroll
                for (int bj = 0; bj < 2; ++bj) { const f32x4 v0 = acc[ai][bj][m][0] * (1.f / (A8_ACT * W8_D)) + bv[bj][0], v1 = acc[ai][bj][m][1] * (1.f / (A8_ACT * W8_D)) + bv[bj][1];
                    u32x4 w; w.x = cvt_pk_bf16(v0[0], v0[1]); w.y = cvt_pk_bf16(v0[2], v0[3]); w.z = cvt_pk_bf16(v1[0], v1[1]); w.w = cvt_pk_bf16(v1[2], v1[3]);
                    *(u32x4*)(rowp + bj * HALF) = w; } }
    }
};
typedef EpiDownT<true> EpiDown;
template <bool GATHER_, bool REV = false>
struct MoeOrderT {
    static constexpr bool GATHER = GATHER_;
    const PG8_LAS int* tstart; int NT, G, c;
    const PG8_LAS int* rowtab; const int* slotmap; const int* cnt;
    __device__ __forceinline__ int arow(int slot, const Unit& u, int r) const {
        if (slot < MOE_TAB_SLOTS) return rowtab[slot * 256 + r];
        const int e = u.pn / NT, rank = (u.pm - tstart[e]) * 256 + r; return rank < cnt[e] ? slotmap[e * T + rank] : 0;
    }
    __device__ __forceinline__ bool next(int i, Unit& u) const {
        const int x = c & 7, li = c >> 3, per = G >> 3; int L = i * per + li;
#pragma unroll 1
        for (int j = 0; j < 4; ++j) { const int e = REV ? x + 8 * (3 - j) : x + 8 * j; const int nte = tstart[e + 1] - tstart[e], nu = nte * NT;
            if (L < nu) { u.pm = tstart[e] + L % nte; u.pn = e * NT + L / nte; return true; }
            L -= nu; }
        return false;
    }
    __device__ __forceinline__ void a_ready(const Unit&) const {}
    __device__ __forceinline__ void done(const Unit&) const {}
};
typedef MoeOrderT<true> MoeOrderG; typedef MoeOrderT<false, true> MoeOrder;
}

__device__ __forceinline__ float wave_sum(float v) {
#pragma unroll
    for (int o = 1; o < 64; o <<= 1) v += __shfl_xor(v, o);
    return v;
}
__device__ __forceinline__ void p3_post(Frame& F) {
    const float* MISC = (const float*)(F.ws + WS_MISC); const float* kvg = frame_in(5); bf16* CKV = (bf16*)(F.ws + WS_CKV); bf16* CKVT = (bf16*)(F.ws + WS_CKVT);
    const bf16* U = (const bf16*)(F.ws + WS_U); bf16* POOLED = (bf16*)(F.ws + WS_POOLED);
    LAS bf16* tile = (LAS bf16*)(F.lds);
    for (int task = blockIdx.x; task < 256; task += F.G) {
        const int t0 = task * 64; const int row = F.tid >> 3, seg = F.tid & 7;
        const float* src = MISC + (size_t)(t0 + row) * 256 + seg * 16; f32x4 v[4]; float ss = 0.f;
#pragma unroll
        for (int i = 0; i < 4; ++i) { v[i] = *(const f32x4*)(src + 4 * i); ss += (v[i].x * v[i].x + v[i].y * v[i].y) + (v[i].z * v[i].z + v[i].w * v[i].w); }
        ss += __shfl_xor(ss, 1); ss += __shfl_xor(ss, 2); ss += __shfl_xor(ss, 4);
        const float rs = 1.0f / sqrtf(ss * (1.f / 128.f) + LN_EPS);
        unsigned w[8];
#pragma unroll
        for (int i = 0; i < 4; ++i) { const f32x4 g = *(const f32x4*)(kvg + seg * 16 + 4 * i); w[2 * i] = pk2(v[i].x * rs * g.x, v[i].y * rs * g.y); w[2 * i + 1] = pk2(v[i].z * rs * g.z, v[i].w * rs * g.w); }
        GAS v4u* dst = (GAS v4u*)(CKV + (size_t)(t0 + row) * 128 + seg * 16); dst[0] = (v4u){w[0], w[1], w[4], w[5]}; dst[1] = (v4u){w[2], w[3], w[6], w[7]};
        LAS v4u* lt = (LAS v4u*)(tile + row * 128 + seg * 16); lt[0] = (v4u){w[0], w[1], w[2], w[3]}; lt[1] = (v4u){w[4], w[5], w[6], w[7]};
        __syncthreads();
        { const int d = F.tid >> 2, part = F.tid & 3; unsigned o[8];
#pragma unroll
          for (int q = 0; q < 16; q += 2) { unsigned pr[2];
#pragma unroll
              for (int z = 0; z < 2; ++z) { const int p = part * 16 + q + z; const int j = p & 7, h = (p >> 3) & 1, tt = (p >> 4) & 1, kb = p >> 5; const int key = kb * 32 + 16 * tt + 8 * (j >> 2) + 4 * h + (j & 3); pr[z] = tile[key * 128 + d]; }
              o[q >> 1] = pr[0] | (pr[1] << 16); }
          const int b = task >> 5, kt = task & 31;
          GAS v4u* dt = (GAS v4u*)(CKVT + ((size_t)(b * 128 + d) * 2048) + kt * 64 + part * 16); dt[0] = (v4u){o[0], o[1], o[2], o[3]}; dt[1] = (v4u){o[4], o[5], o[6], o[7]}; }
        __syncthreads();
    }
    LAS bf16* ut = (LAS bf16*)(F.lds + 16384);
    for (int task = blockIdx.x; task < 256; task += F.G) { const int t0 = task * 64, s0 = t0 & 2047;
        __syncthreads();
#pragma unroll
        for (int i = 0; i < 10; ++i) { const int c = F.tid + 512 * i, row = c >> 6, ch = c & 63; const int sp = s0 - 16 + row;
            v4u v = (v4u){0u, 0u, 0u, 0u}; if (sp >= 0) v = *(const GAS v4u*)(U + (size_t)(t0 - 16 + row) * 512 + ch * 8);
            *(LAS v4u*)(ut + row * 512 + ch * 8) = v; }
        __syncthreads();
        const int c = F.tid, g = c >> 7, w = 2 << g; float win = 0.f;
        for (int j = 16 - w; j < 16; ++j) win += bf2f(ut[j * 512 + c]);
        for (int j = 16; j < 80; ++j) { const float cur = bf2f(ut[j * 512 + c]); win += cur; win -= bf2f(ut[(j - w) * 512 + c]);
            const int sq = s0 + j - 16; const int cntw = (sq + 1 < w) ? (sq + 1) : w; POOLED[bl_off(t0 + j - 16, c, 512)] = (bf16)f2bf(win / (float)cntw - cur); }
    }
}
constexpr int P7_AL = 0, P7_LOGIT = 131072 - 4096;
__device__ __forceinline__ void p7_ln1_route(Frame& F, int cw_gcnt) {
    const float* Z = (const float*)(F.ws + WS_Z); const float* g1 = frame_in(13); const float* b1 = frame_in(14); const float* b_r = frame_in(16);
    const float* MOD = (const float*)(F.ws + WS_MOD); float* X1 = (float*)(F.ws + WS_X1); bf16* H2 = (bf16*)(F.ws + WS_H); const bf16* WrB = (const bf16*)(F.ws + WS_WRB);
    int* gcnt = (int*)(F.ctl + cw_gcnt); int* SLOTMAP = (int*)(F.ws + WS_SLOTMAP); int* TOKSLOT = (int*)(F.ws + WS_TOKSLOT); float* GATE = (float*)(F.ws + WS_GATE);
    LAS unsigned char* AL = F.lds + P7_AL; LAS float* red = (LAS float*)(F.lds);
    LAS float* logit = (LAS float*)(F.lds + 65536);
    LAS int* lcnt = (LAS int*)(F.lds + LC_LCNT); LAS int* lbase = (LAS int*)(F.lds + LC_BASE); LAS int* list = (LAS int*)(F.lds + LC_LIST);
    if (F.tid < 32) lcnt[F.tid] = 0;
    const int hh = F.lane >> 5, l31 = F.lane & 31;
    bf16x8 Bh[8], Bl[8];
#pragma unroll
    for (int s = 0; s < 8; ++s) { const bf16* p = WrB + ((size_t)((F.wave * 8 + s) * 2) * 64 + F.lane) * 8; Bh[s] = *(const GAS bf16x8*)p; Bl[s] = *(const GAS bf16x8*)(p + 64 * 8); }
    const int rows_per_wg = T / F.G;
    for (int step = 0; step < rows_per_wg / 32; ++step) { const int m0 = blockIdx.x * rows_per_wg + step * 32;
        __syncthreads();
#pragma unroll 1
        for (int rr = 0; rr < 4; ++rr) { const int row = F.wave * 4 + rr, m = m0 + row, b = m >> 11;
            const GAS f32x4* zr = (const GAS f32x4*)(Z + (size_t)m * D) + F.lane; f32x4 v[4]; float s = 0.f;
#pragma unroll
            for (int j = 0; j < 4; ++j) { v[j] = zr[64 * j]; s += (v[j].x + v[j].y) + (v[j].z + v[j].w); }
            const float mean = wave_sum(s) * (1.f / D); float s2 = 0.f;
#pragma unroll
            for (int j = 0; j < 4; ++j) { v[j] = v[j] - mean; s2 += (v[j].x * v[j].x + v[j].y * v[j].y) + (v[j].z * v[j].z + v[j].w * v[j].w); }
            const float rstd = 1.f / sqrtf(wave_sum(s2) * (1.f / D) + LN_EPS);
#pragma unroll
            for (int j = 0; j < 4; ++j) { const int col = 4 * F.lane + 256 * j;
                const f32x4 gg = *(const f32x4*)(g1 + col), bb = *(const f32x4*)(b1 + col); const f32x4 x1 = v[j] * rstd * gg + bb;
                *((GAS f32x4*)(X1 + (size_t)m * D) + F.lane + 64 * j) = x1;
                const f32x4 sh = *(const f32x4*)(MOD + b * 6144 + 3 * 1024 + col), sc = *(const f32x4*)(MOD + b * 6144 + 4 * 1024 + col); const f32x4 h2 = x1 * (sc + 1.0f) + sh;
                const unsigned h01 = pkbf(h2.x, h2.y), h23 = pkbf(h2.z, h2.w);
                { unsigned r8 = __builtin_amdgcn_cvt_pk_fp8_f32(clamp8(h2.x * A8_H), clamp8(h2.y * A8_H), 0u, false); r8 = __builtin_amdgcn_cvt_pk_fp8_f32(clamp8(h2.z * A8_H), clamp8(h2.w * A8_H), r8, true);
                  *(GAS unsigned*)(H2 + bl_off(m, col >> 1, D / 2)) = r8; }
                const unsigned l01 = pkbf(h2.x - pg8::bfl(h01), h2.y - pg8::bfh(h01)), l23 = pkbf(h2.z - pg8::bfl(h23), h2.w - pg8::bfh(h23));
                const int chunk = 32 * j + (F.lane >> 1); const int off = row * 2048 + (((chunk & ~15) | ((chunk ^ row) & 15)) << 4) + (F.lane & 1) * 8;
                *(LAS unsigned long long*)(AL + off) = (unsigned long long)h01 | ((unsigned long long)h23 << 32);
                *(LAS unsigned long long*)(AL + 65536 + off) = (unsigned long long)l01 | ((unsigned long long)l23 << 32); } }
        __syncthreads();
        f32x16 acc;
#pragma unroll
        for (int r = 0; r < 16; ++r) acc[r] = 0.f;
#pragma unroll
        for (int s = 0; s < 8; ++s) { const int chunk = 2 * (F.wave * 8 + s) + hh; const int off = l31 * 2048 + (((chunk & ~15) | ((chunk ^ l31) & 15)) << 4);
            const bf16x8 Ah = *(const LAS bf16x8*)(AL + off), Alo = *(const LAS bf16x8*)(AL + 65536 + off);
            acc = MFMA32(Ah, Bh[s], acc); acc = MFMA32(Ah, Bl[s], acc); acc = MFMA32(Alo, Bh[s], acc); }
        __syncthreads();
#pragma unroll
        for (int r = 0; r < 16; ++r) red[(F.wave * 32 + krow16(r, hh)) * 32 + l31] = acc[r];
        __syncthreads();
        { const int row = F.tid >> 4, e0 = (F.tid & 15) * 2; float s0 = 0.f, s1 = 0.f;
#pragma unroll
          for (int w = 0; w < 8; ++w) { s0 += red[(w * 32 + row) * 32 + e0]; s1 += red[(w * 32 + row) * 32 + e0 + 1]; }
          logit[row * 33 + e0] = s0 + b_r[e0]; logit[row * 33 + e0 + 1] = s1 + b_r[e0 + 1]; }
        __syncthreads();
        if (F.tid < 32) { const int row = F.tid, m = m0 + row; float lg[32];
#pragma unroll
            for (int e = 0; e < 32; ++e) lg[e] = logit[row * 33 + e];
            int se[4]; float sv[4]; unsigned used = 0u;
#pragma unroll
            for (int k = 0; k < 4; ++k) { int best = 0; float bv = -INFINITY; bool have = false;
#pragma unroll
                for (int e = 0; e < 32; ++e) { const bool ok = !((used >> e) & 1u) && (!have || lg[e] > bv); if (ok) { best = e; bv = lg[e]; have = true; } }
                se[k] = best; sv[k] = bv; used |= 1u << best; }
            float ex[4], den = 0.f;
#pragma unroll
            for (int k = 0; k < 4; ++k) { ex[k] = __expf(sv[k] - sv[0]); den += ex[k]; }
            const float inv = 1.f / den;
#pragma unroll
            for (int k = 0; k < 4; ++k) { const int lr = __hip_atomic_fetch_add(&lcnt[se[k]], 1, __ATOMIC_RELAXED, __HIP_MEMORY_SCOPE_WORKGROUP);
                LAS int* ent = list + ((step * 32 + row) * 4 + k) * 4; ent[0] = m; ent[1] = se[k]; ent[2] = lr; ent[3] = __float_as_int(ex[k] * inv); } }
    }
    __syncthreads();
    if (F.tid < 32) lbase[F.tid] = atomicAdd(&gcnt[F.tid], lcnt[F.tid]);
    __syncthreads();
    if (F.tid < 256) { LAS int* ent = list + F.tid * 4; const int m = ent[0], e = ent[1], rank = lbase[e] + ent[2];
        SLOTMAP[e * T + rank] = m; TOKSLOT[m * 4 + (F.tid & 3)] = e | (rank << 8); GATE[m * 4 + (F.tid & 3)] = __int_as_float(ent[3]); }
}
__device__ __forceinline__ void load_tstart(Frame& F) {
    LAS int* ts = (LAS int*)(F.lds + LC_TSTART); const int* gcnt = (const int*)(F.ctl + CW_GCNT);
    if (F.tid == 0) { int a = 0; for (int e = 0; e < 32; ++e) { ts[e] = a; a += (__hip_atomic_load(gcnt + e, __ATOMIC_RELAXED, __HIP_MEMORY_SCOPE_AGENT) + 255) >> 8; } ts[32] = a; }
    __syncthreads();
}
__device__ __forceinline__ void warm_range(Frame& F, const unsigned char* base, size_t bytes) {
    const size_t per = bytes / (size_t)F.G; const GAS v4u* p = (const GAS v4u*)(base + per * (size_t)blockIdx.x) + F.tid; const int n = (int)(per / (512 * 16));
    v4u acc = (v4u){0u, 0u, 0u, 0u};
#pragma unroll 8
    for (int i = 0; i < n; ++i) { const v4u v = __builtin_nontemporal_load(p + (size_t)i * 512); acc.x ^= v.x; acc.y ^= v.y; acc.z ^= v.z; acc.w ^= v.w; }
    asm volatile("" :: "v"(acc.x), "v"(acc.y), "v"(acc.z), "v"(acc.w));
}
__device__ __forceinline__ void moe_fill_rowtab(Frame& F, const pg8::MoeOrderG& S) {
    LAS int* tab = (LAS int*)(F.lds + LC_ROWTAB); const LAS int* ts = (const LAS int*)(F.lds + LC_TSTART);
    for (int slot = 0; slot < MOE_TAB_SLOTS; ++slot) { pg8::Unit u; if (!S.next(slot, u)) break;
        if (F.tid < 256) { const int e = u.pn / S.NT, rank = (u.pm - ts[e]) * 256 + F.tid; tab[slot * 256 + F.tid] = rank < S.cnt[e] ? S.slotmap[e * T + rank] : 0; } }
    __syncthreads();
}
__device__ __forceinline__ void p11_final(Frame& F) {
    load_tstart(F);
    const LAS int* ts = (const LAS int*)(F.lds + LC_TSTART);
    const float* X1 = (const float*)(F.ws + WS_X1); const bf16* Y = (const bf16*)(F.ws + WS_Y); const int* TOKSLOT = (const int*)(F.ws + WS_TOKSLOT); const float* GATE = (const float*)(F.ws + WS_GATE);
    const float* MOD = (const float*)(F.ws + WS_MOD); const float* g2 = frame_in(21); const float* b2 = frame_in(22);
    const int gw = F.vcu * NWAVES + F.wave, NGW = F.G * NWAVES;
    for (int m = gw; m < T; m += NGW) { const int b = m >> 11;
        f32x4 mo[4];
#pragma unroll
        for (int j = 0; j < 4; ++j) mo[j] = (f32x4){0.f, 0.f, 0.f, 0.f};
#pragma unroll
        for (int k = 0; k < 4; ++k) { const int tsl = TOKSLOT[m * 4 + k]; const int e = tsl & 255, rank = tsl >> 8; const float gt = GATE[m * 4 + k];
            const GAS unsigned long long* yr = (const GAS unsigned long long*)(Y + ((size_t)ts[e] * 256 + rank) * D) + F.lane;
#pragma unroll
            for (int j = 0; j < 4; ++j) { const unsigned long long w = yr[64 * j]; const unsigned lo = (unsigned)w, hi = (unsigned)(w >> 32);
                mo[j].x += gt * pg8::bfl(lo); mo[j].y += gt * pg8::bfh(lo); mo[j].z += gt * pg8::bfl(hi); mo[j].w += gt * pg8::bfh(hi); } }
        f32x4 v[4]; float s = 0.f;
#pragma unroll
        for (int j = 0; j < 4; ++j) { const int col = 4 * F.lane + 256 * j; const f32x4 x1 = *((const GAS f32x4*)(X1 + (size_t)m * D) + F.lane + 64 * j);
            const f32x4 g2m = *(const f32x4*)(MOD + b * 6144 + 5 * 1024 + col); v[j] = x1 * ALPHA + g2m * mo[j]; s += (v[j].x + v[j].y) + (v[j].z + v[j].w); }
        const float mean = wave_sum(s) * (1.f / D); float s2 = 0.f;
#pragma unroll
        for (int j = 0; j < 4; ++j) { v[j] = v[j] - mean; s2 += (v[j].x * v[j].x + v[j].y * v[j].y) + (v[j].z * v[j].z + v[j].w * v[j].w); }
        const float rstd = 1.f / sqrtf(wave_sum(s2) * (1.f / D) + LN_EPS);
#pragma unroll
        for (int j = 0; j < 4; ++j) { const int col = 4 * F.lane + 256 * j; const f32x4 gg = *(const f32x4*)(g2 + col), bb = *(const f32x4*)(b2 + col);
            *((GAS f32x4*)(F.out + (size_t)m * D) + F.lane + 64 * j) = v[j] * rstd * gg + bb; }
    }
}
__device__ __forceinline__ unsigned ordkey(float f) { const unsigned u = __float_as_uint(f); return (u & 0x80000000u) ? ~u : (u | 0x80000000u); }

constexpr int SEL_QI = 0, SEL_HIST = 32768, SEL_CAND = 98304, SEL_MASK = 114688, SEL_META = 122880, SEL_CAP = 128;
__device__ __forceinline__ float relu_i(float x) { const int i = __float_as_int(x); return __int_as_float(i > 0 ? i : 0); }
__device__ __forceinline__ void idx_load_a(const bf16* KIb, int kt, int lane, bf16x8 (&A)[4]) {
    const bf16* kp = KIb + (size_t)(kt * 32 + (lane & 31)) * 64 + 8 * (lane >> 5);
#pragma unroll
    for (int s = 0; s < 4; ++s) A[s] = *(const GAS bf16x8*)(kp + 16 * s);
}
__device__ __forceinline__ void idx_scores1(const bf16x8 (&AA)[4], const LAS unsigned char* qiL, const float (&wi)[8], int lane, f32x16& scA) {
    const int hh = lane >> 5, q = lane & 31; const LAS unsigned char* qrow = qiL + q * 1024; const int qs = q & 15;
#pragma unroll
    for (int r = 0; r < 16; ++r) scA[r] = 0.f;
    f32x16 acc[2];
    { bf16x8 B0[4];
#pragma unroll
      for (int s = 0; s < 4; ++s) B0[s] = *(const LAS bf16x8*)(qrow + (((2 * s + hh) ^ qs) << 4));
#pragma unroll
      for (int r = 0; r < 16; ++r) acc[0][r] = 0.f;
#pragma unroll
      for (int s = 0; s < 4; ++s) acc[0] = MFMA32(AA[s], B0[s], acc[0]); }
#pragma unroll
    for (int h = 0; h < 8; ++h) { const int cur = h & 1, nxt = cur ^ 1;
        if (h < 7) { bf16x8 Bn[4];
#pragma unroll
            for (int s = 0; s < 4; ++s) Bn[s] = *(const LAS bf16x8*)(qrow + ((((h + 1) * 8 + 2 * s + hh) ^ qs) << 4));
#pragma unroll
            for (int r = 0; r < 16; ++r) acc[nxt][r] = 0.f;
#pragma unroll
            for (int s = 0; s < 4; ++s) acc[nxt] = MFMA32(AA[s], Bn[s], acc[nxt]); }
#pragma unroll
        for (int r = 0; r < 16; ++r) scA[r] = fmaf(wi[h], relu_i(acc[cur][r]), scA[r]);
        if (h < 7) {
            __builtin_amdgcn_sched_group_barrier(0x100, 4, 0);
#pragma unroll
            for (int i = 0; i < 4; ++i) { __builtin_amdgcn_sched_group_barrier(0x008, 1, 0); __builtin_amdgcn_sched_group_barrier(0x002, 8, 0); } }
    }
}
template <int MODE, int VAR>
__device__ __forceinline__ void sel_tile(Frame& F, const f32x16& sc, int kt, int hh, int q, int qpos, int bst, unsigned pfx, unsigned trial, unsigned& cntl) {
    LAS unsigned* hist = (LAS unsigned*)(F.lds + SEL_HIST); LAS unsigned* cand = (LAS unsigned*)(F.lds + SEL_CAND); LAS unsigned* maskL = (LAS unsigned*)(F.lds + SEL_MASK); LAS int* meta = (LAS int*)(F.lds + SEL_META);
    unsigned word = 0u; const int kbase = kt * 32 + 4 * hh; const int lim = qpos - kbase;
#pragma unroll
    for (int r = 0; r < 16; ++r) { const int kr0 = (r & 3) + 8 * (r >> 2); const bool valid = kr0 <= lim;
        const unsigned bits = __float_as_uint(sc[r]) & 0xFFFFF800u; const float st = __uint_as_float(bits);
        int bin = (int)(st * 64.f) + 256; bin = bin < 0 ? 0 : (bin > 511 ? 511 : bin);
        if (MODE == 0) { if (VAR == 1) { asm volatile("" :: "v"(bin), "v"(valid ? 1u : 0u)); } else __hip_atomic_fetch_add(hist + q * 512 + bin, valid ? 1u : 0u, __ATOMIC_RELAXED, __HIP_MEMORY_SCOPE_WORKGROUP); }
        else { const unsigned ck = (ordkey(st) & 0xFFFFF800u) | (unsigned)(2047 - kbase - kr0);
            if (MODE == 1) { word |= (valid && bin > bst) ? (1u << kr0) : 0u; const bool isc = valid && bin == bst;
                if (isc) { const int slot = __hip_atomic_fetch_add((LAS int*)meta + 64 + q, 1, __ATOMIC_RELAXED, __HIP_MEMORY_SCOPE_WORKGROUP); if (slot < SEL_CAP) cand[q * SEL_CAP + slot] = ck; } }
            if (MODE == 2) { cntl += (valid && ck >= (pfx | trial)) ? 1u : 0u; }
            if (MODE == 3) { word |= (valid && ck >= pfx) ? (1u << kr0) : 0u; } }
        }
    if (MODE == 1 || MODE == 3) __hip_atomic_fetch_or(maskL + q * 64 + kt, word << (4 * hh), __ATOMIC_RELAXED, __HIP_MEMORY_SCOPE_WORKGROUP);
}
template <int MODE, int VAR>
__device__ __forceinline__ void sel_pass(Frame& F, int lane, int wave, const bf16* KIb, int qb, const float (&wi)[8], unsigned trial) {
    const LAS unsigned char* qiL = F.lds + SEL_QI; LAS int* meta = (LAS int*)(F.lds + SEL_META);
    const int bst = meta[lane & 31]; const unsigned pfx = (unsigned)meta[128 + (lane & 31)];
    unsigned cntl = 0u;
    bf16x8 AA[4], NA[4];
    if (wave <= qb) idx_load_a(KIb, wave, lane, AA);
#pragma unroll 1
    for (int kt = wave; kt <= qb; kt += NWAVES) {
        int lane_t = lane; asm volatile("" : "+v"(lane_t));
        const int hh = lane_t >> 5, q = lane_t & 31, qpos = qb * 32 + q;
        if (kt + NWAVES <= qb) idx_load_a(KIb, kt + NWAVES, lane_t, NA);
        f32x16 scA;
        idx_scores1(AA, qiL, wi, lane_t, scA);
        if (VAR == 2) { asm volatile("" :: "v"(scA[0]), "v"(scA[7]), "v"(scA[15])); } else sel_tile<MODE, VAR>(F, scA, kt, hh, q, qpos, bst, pfx, trial, cntl);
#pragma unroll
        for (int s = 0; s < 4; ++s) AA[s] = NA[s];
    }
    if (MODE == 2) __hip_atomic_fetch_add((LAS unsigned*)meta + 160 + (lane & 31), cntl, __ATOMIC_RELAXED, __HIP_MEMORY_SCOPE_WORKGROUP);
}
template <int VAR>
__device__ __forceinline__ void p3_select(Frame& F) {
    const bf16* QI = (const bf16*)(F.ws + WS_QI); const float* MISC = (const float*)(F.ws + WS_MISC); unsigned* MASK = (unsigned*)(F.ws + WS_MASK);
    LAS unsigned* hist = (LAS unsigned*)(F.lds + SEL_HIST); LAS unsigned* cand = (LAS unsigned*)(F.lds + SEL_CAND); LAS unsigned* maskL = (LAS unsigned*)(F.lds + SEL_MASK); LAS int* meta = (LAS int*)(F.lds + SEL_META);
    const int b = blockIdx.x >> 5, ii = blockIdx.x & 31;
    for (int ui = 0; ui < 2; ++ui) { const int qb = ui ? 63 - ii : ii; const int t0 = b * S_ + qb * 32;
        int tid = F.tid; asm volatile("" : "+v"(tid)); const int lane = tid & 63; int wave = F.wave; asm volatile("" : "+s"(wave));
        if (qb < 8) {
            for (int wd = tid; wd < 2048; wd += 512) { const int q = wd >> 6, w = wd & 63, qpos = qb * 32 + q; const int rel = qpos - 32 * w;
                MASK[(size_t)(t0 + q) * 64 + w] = rel >= 31 ? 0xFFFFFFFFu : (rel < 0 ? 0u : ((2u << rel) - 1u)); }
            continue; }
        __syncthreads();
        for (int c = tid; c < 2048; c += 512) { const int q = c >> 6, c16 = c & 63; *(LAS v4u*)(F.lds + SEL_QI + q * 1024 + ((c16 ^ (q & 15)) << 4)) = *(const GAS v4u*)(QI + (size_t)(t0 + q) * 512 + c16 * 8); }
        { unsigned z = 0u; asm volatile("" : "+v"(z)); const v4u z4 = (v4u){z, z, z, z};
          for (int i = tid; i < 16384 / 4; i += 512) ((LAS v4u*)hist)[i] = z4;
          for (int i = tid; i < 2048 / 4; i += 512) ((LAS v4u*)maskL)[i] = z4; }
        if (tid < 192) meta[tid] = 0;
        float wi[8];
#pragma unroll
        for (int h = 0; h < 8; ++h) wi[h] = MISC[(size_t)(t0 + (lane & 31)) * 256 + 192 + h];
        const bf16* KIb = (const bf16*)(F.ws + WS_KI) + (size_t)b * S_ * 64;
        __syncthreads();
        sel_pass<0, VAR>(F, lane, wave, KIb, qb, wi, 0u);
        __syncthreads();
        for (int qq = 0; qq < 4; ++qq) { const int q = wave * 4 + qq; const LAS unsigned* hq = hist + q * 512; unsigned c8[8]; unsigned cs = 0u;
#pragma unroll
            for (int i = 0; i < 8; ++i) { c8[i] = hq[511 - 8 * lane - i]; cs += c8[i]; }
            unsigned incl = cs;
#pragma unroll
            for (int o = 1; o < 64; o <<= 1) { const unsigned v = __shfl_up(incl, o); if (lane >= o) incl += v; }
            const unsigned excl = incl - cs;
            if (excl < 256u && incl >= 256u) { unsigned run = excl;
#pragma unroll
                for (int i = 0; i < 8; ++i) { const unsigned before = run; run += c8[i]; if (before < 256u && run >= 256u) { meta[q] = 511 - 8 * lane - i; meta[32 + q] = (int)(256u - before); } } } }
        __syncthreads();
        sel_pass<1, VAR>(F, lane, wave, KIb, qb, wi, 0u);
        __syncthreads();
        if (tid < 32) { if (meta[64 + tid] > SEL_CAP) meta[96] = 1; }
        __syncthreads();
        if (meta[96] == 0) {
            for (int item = tid; item < 32 * SEL_CAP; item += 512) { const int q = item >> 7, i = item & (SEL_CAP - 1); const int n = meta[64 + q];
                if (i < n) { const unsigned my = cand[q * SEL_CAP + i]; int rank = 0; for (int j = 0; j < n; ++j) rank += (cand[q * SEL_CAP + j] > my) ? 1 : 0;
                    if (rank < meta[32 + q]) { const int idx = 2047 - (int)(my & 0x7FFu); __hip_atomic_fetch_or(maskL + q * 64 + (idx >> 5), 1u << (idx & 31), __ATOMIC_RELAXED, __HIP_MEMORY_SCOPE_WORKGROUP); } } }
        } else {
#pragma unroll 1
            for (int bit = 31; bit >= 0; --bit) {
                sel_pass<2, VAR>(F, lane, wave, KIb, qb, wi, 1u << bit);
                __syncthreads();
                if (tid < 32) { if ((unsigned)meta[160 + tid] >= 256u) meta[128 + tid] |= (int)(1u << bit); meta[160 + tid] = 0; }
                __syncthreads(); }
            sel_pass<3, VAR>(F, lane, wave, KIb, qb, wi, 0u);
        }
        __syncthreads();
        { const int q = tid >> 4, w4 = (tid & 15) * 4; *(GAS v4u*)(MASK + (size_t)(t0 + q) * 64 + w4) = *(const LAS v4u*)(maskL + q * 64 + w4); }
    }
}
typedef unsigned u32x2v __attribute__((ext_vector_type(2)));
constexpr int ATT_K = 0, ATT_VT = 65536;
__device__ __forceinline__ void att_load(const bf16* CKV, const bf16* CKVT, int b, int j, int tid, v4u (&st)[4]) {
#pragma unroll
    for (int i = 0; i < 2; ++i) { const int c = tid + 512 * i; st[i] = *(const GAS v4u*)(CKV + (size_t)(b * S_ + 64 * j) * 128 + c * 8); }
#pragma unroll
    for (int i = 0; i < 2; ++i) { const int c = tid + 512 * i, d = c >> 3, ch = c & 7; st[2 + i] = *(const GAS v4u*)(CKVT + (size_t)(b * 128 + d) * 2048 + 64 * j + ch * 8); }
}
__device__ __forceinline__ void att_store(LAS unsigned char* lds, int buf, int tid, const v4u (&st)[4]) {
#pragma unroll
    for (int i = 0; i < 2; ++i) { const int c = tid + 512 * i, row = c >> 4, ch = c & 15; *(LAS v4u*)(lds + ATT_K + buf * 16384 + row * 256 + ((ch ^ (row & 15)) << 4)) = st[i]; }
#pragma unroll
    for (int i = 0; i < 2; ++i) { const int c = tid + 512 * i, d = c >> 3, ch = c & 7; *(LAS v4u*)(lds + ATT_VT + buf * 16384 + d * 128 + ((ch ^ ((d >> 1) & 7)) << 4)) = st[2 + i]; }
}
__device__ __forceinline__ void att_tile(const LAS unsigned char* lds, int buf, int j, u32x2v mw, const bf16x8 (&Qf)[8], f32x16 (&O)[4], float& m_run, float& l_run, float slope2, int hh, int q, int qpos) {
    f32x16 S0, S1;
#pragma unroll
    for (int r = 0; r < 16; ++r) { S0[r] = 0.f; S1[r] = 0.f; }
    const LAS unsigned char* kb0 = lds + ATT_K + buf * 16384 + q * 256, * kb1 = kb0 + 32 * 256;
    { bf16x8 Kf[16];
#pragma unroll
      for (int s = 0; s < 8; ++s) { const int sw = ((2 * s + hh) ^ (q & 15)) << 4; Kf[2 * s] = *(const LAS bf16x8*)(kb0 + sw); Kf[2 * s + 1] = *(const LAS bf16x8*)(kb1 + sw); }
#pragma unroll
      for (int s = 0; s < 8; ++s) { S0 = MFMA32(Kf[2 * s], Qf[s], S0); S1 = MFMA32(Kf[2 * s + 1], Qf[s], S1); }
      __builtin_amdgcn_sched_group_barrier(0x100, 4, 0);
#pragma unroll
      for (int i = 0; i < 6; ++i) { __builtin_amdgcn_sched_group_barrier(0x008, 2, 0); __builtin_amdgcn_sched_group_barrier(0x100, 2, 0); }
      __builtin_amdgcn_sched_group_barrier(0x008, 4, 0); }
    const LAS unsigned char* vb = lds + ATT_VT + buf * 16384;
    const unsigned mlo = mw.x >> (4 * hh), mhi = mw.y >> (4 * hh);
    const float base0 = slope2 * (float)(64 * j + 4 * hh - qpos);
    float tmax = -INFINITY;
#pragma unroll
    for (int r = 0; r < 16; ++r) { const int kr = (r & 3) + 8 * (r >> 2);
        float s0 = S0[r] + (base0 + slope2 * (float)kr), s1 = S1[r] + (base0 + slope2 * (float)(kr + 32));
        { const int t0_ = __builtin_amdgcn_sbfe((int)mlo, kr, 1), t1_ = __builtin_amdgcn_sbfe((int)mhi, kr, 1);
          s0 = __int_as_float((__float_as_int(s0) & t0_) | ((int)0xff800000 & ~t0_)); s1 = __int_as_float((__float_as_int(s1) & t1_) | ((int)0xff800000 & ~t1_)); }
        S0[r] = s0; S1[r] = s1; tmax = fmaxf(tmax, fmaxf(s0, s1)); }
    { const auto rr = __builtin_amdgcn_permlane32_swap(__float_as_uint(tmax), __float_as_uint(tmax), false, false); tmax = fmaxf(__uint_as_float(rr[0]), __uint_as_float(rr[1])); }
    const float m_new = fmaxf(m_run, tmax), msafe = (m_new == -INFINITY) ? 0.f : m_new;
    const float alpha = __builtin_amdgcn_exp2f(m_run - msafe);
    float ps = 0.f;
#pragma unroll
    for (int r = 0; r < 16; ++r) { S0[r] = __builtin_amdgcn_exp2f(S0[r] - msafe); S1[r] = __builtin_amdgcn_exp2f(S1[r] - msafe); ps += S0[r] + S1[r]; }
    l_run = l_run * alpha + ps; m_run = m_new;
    if (__any(alpha != 1.f)) {
#pragma unroll
        for (int db = 0; db < 4; ++db)
#pragma unroll
            for (int r = 0; r < 16; ++r) O[db][r] *= alpha; }
    bf16x8 Pf[4];
    Pf[0] = pack8(S0[0], S0[1], S0[2], S0[3], S0[4], S0[5], S0[6], S0[7]); Pf[1] = pack8(S0[8], S0[9], S0[10], S0[11], S0[12], S0[13], S0[14], S0[15]);
    Pf[2] = pack8(S1[0], S1[1], S1[2], S1[3], S1[4], S1[5], S1[6], S1[7]); Pf[3] = pack8(S1[8], S1[9], S1[10], S1[11], S1[12], S1[13], S1[14], S1[15]);
    { bf16x8 Vf[16];
#pragma unroll
      for (int db = 0; db < 4; ++db) { const int d = db * 32 + q; const LAS unsigned char* vr = vb + d * 128; const int sx = (d >> 1) & 7;
#pragma unroll
          for (int c2 = 0; c2 < 4; ++c2) Vf[db * 4 + c2] = *(const LAS bf16x8*)(vr + (((c2 * 2 + hh) ^ sx) << 4)); }
#pragma unroll
      for (int db = 0; db < 4; ++db)
#pragma unroll
          for (int c2 = 0; c2 < 4; ++c2) O[db] = MFMA32(Vf[db * 4 + c2], Pf[c2], O[db]);
      __builtin_amdgcn_sched_group_barrier(0x100, 4, 0);
#pragma unroll
      for (int i = 0; i < 6; ++i) { __builtin_amdgcn_sched_group_barrier(0x008, 2, 0); __builtin_amdgcn_sched_group_barrier(0x100, 2, 0); }
      __builtin_amdgcn_sched_group_barrier(0x008, 4, 0); }
}
__device__ __forceinline__ void p4_attention(Frame& F) {
    const bf16* QL = (const bf16*)(F.ws + WS_QL); const bf16* CKV = (const bf16*)(F.ws + WS_CKV); const bf16* CKVT = (const bf16*)(F.ws + WS_CKVT);
    const unsigned* MASK = (const unsigned*)(F.ws + WS_MASK);
    const int b = blockIdx.x >> 5, ii = blockIdx.x & 31;
    for (int ui = 0; ui < 2; ++ui) { const int qb = ui ? 63 - ii : ii;
        int lane; asm volatile("v_mbcnt_lo_u32_b32 %0, -1, 0\n\tv_mbcnt_hi_u32_b32 %0, -1, %0" : "=v"(lane)); int head = F.wave; asm volatile("" : "+s"(head)); const int tid = head * 64 + lane;
        const int hh = lane >> 5, q = lane & 31; const float slope2 = __builtin_amdgcn_exp2f(-(float)(head + 1)) * LOG2E;
        const int t0 = b * S_ + qb * 32, qpos = qb * 32 + q; const int nt = (qb >> 1) + 1;
        bf16x8 Qf[8];
        {
            const bf16* WukB = (const bf16*)(F.ws + WS_WUKB); bf16x8 qB[4];
#pragma unroll
            for (int ks = 0; ks < 4; ++ks) qB[ks] = *(const GAS bf16x8*)(QL + (size_t)(t0 + q) * 512 + head * 64 + 16 * ks + 8 * hh);
#pragma unroll
            for (int rb = 0; rb < 4; ++rb) { f32x16 X;
#pragma unroll
                for (int r = 0; r < 16; ++r) X[r] = 0.f;
                const bf16* wr = WukB + (size_t)(head * 128 + rb * 32 + q) * 64 + 8 * hh;
#pragma unroll
                for (int ks = 0; ks < 4; ++ks) { const bf16x8 Aw = *(const GAS bf16x8*)(wr + 16 * ks); X = MFMA32(Aw, qB[ks], X); }
                Qf[2 * rb] = pack8(X[0], X[1], X[2], X[3], X[4], X[5], X[6], X[7]); Qf[2 * rb + 1] = pack8(X[8], X[9], X[10], X[11], X[12], X[13], X[14], X[15]); } }
#pragma unroll
        for (int s = 0; s < 8; ++s) asm volatile("" : "+v"(Qf[s]));
        f32x16 O[4];
#pragma unroll
        for (int db = 0; db < 4; ++db)
#pragma unroll
            for (int r = 0; r < 16; ++r) O[db][r] = 0.f;
        float m_run = -INFINITY, l_run = 0.f;
        v4u st[4];
        __syncthreads();
        att_load(CKV, CKVT, b, 0, tid, st); att_store(F.lds, 0, tid, st);
        att_load(CKV, CKVT, b, nt > 1 ? 1 : 0, tid, st); att_store(F.lds, 1, tid, st);
        __syncthreads();
        const unsigned* mrow = MASK + (size_t)(t0 + q) * 64;
        for (int j0 = 0; j0 < nt; j0 += 2) { const int j1 = j0 + 1; const bool has1 = j1 < nt; const int last = nt - 1;
            const u32x2v mw0 = *(const GAS u32x2v*)(mrow + 2 * j0);
            __builtin_amdgcn_sched_barrier(0);
            att_load(CKV, CKVT, b, (j0 + 2 < nt) ? j0 + 2 : last, tid, st);
            __builtin_amdgcn_sched_barrier(0);
            att_tile(F.lds, j0 & 3, j0, mw0, Qf, O, m_run, l_run, slope2, hh, q, qpos);
            att_store(F.lds, (j0 + 2) & 3, tid, st);
            const u32x2v mw1 = *(const GAS u32x2v*)(mrow + 2 * (has1 ? j1 : j0));
            __builtin_amdgcn_sched_barrier(0);
            att_load(CKV, CKVT, b, (j0 + 3 < nt) ? j0 + 3 : last, tid, st);
            __builtin_amdgcn_sched_barrier(0);
            if (has1) att_tile(F.lds, j1 & 3, j1, mw1, Qf, O, m_run, l_run, slope2, hh, q, qpos);
            att_store(F.lds, (j0 + 3) & 3, tid, st);
            __syncthreads();
        }
        float lt; { const auto rr = __builtin_amdgcn_permlane32_swap(__float_as_uint(l_run), __float_as_uint(l_run), false, false); lt = __uint_as_float(rr[0]) + __uint_as_float(rr[1]); }
        const float inv = 1.f / lt;
        bf16x8 Ob[8];
#pragma unroll
        for (int db = 0; db < 4; ++db)
#pragma unroll
            for (int t = 0; t < 2; ++t) Ob[db * 2 + t] = pack8(O[db][8 * t] * inv, O[db][8 * t + 1] * inv, O[db][8 * t + 2] * inv, O[db][8 * t + 3] * inv, O[db][8 * t + 4] * inv, O[db][8 * t + 5] * inv, O[db][8 * t + 6] * inv, O[db][8 * t + 7] * inv);
        int l2; asm volatile("v_mbcnt_lo_u32_b32 %0, -1, 0\n\tv_mbcnt_hi_u32_b32 %0, -1, %0" : "=v"(l2));
        const bf16* WuvT = (const bf16*)(F.ws + WS_WUVT); bf16* YA = (bf16*)(F.ws + WS_YA);
        const int orow_t = t0 + (l2 & 31);
#pragma unroll
        for (int dbp = 0; dbp < 2; ++dbp) { f32x16 Yt;
#pragma unroll
            for (int r = 0; r < 16; ++r) Yt[r] = 0.f;
            const bf16* wrow = WuvT + (size_t)(head * 64 + dbp * 32 + (l2 & 31)) * 128 + (l2 >> 5) * 8;
#pragma unroll
            for (int ks = 0; ks < 8; ++ks) { const bf16x8 Aw = *(const GAS bf16x8*)(wrow + ks * 16); Yt = MFMA32(Aw, Ob[ks], Yt); }
#pragma unroll
            for (int g = 0; g < 4; ++g) { const unsigned lo = pkbf(Yt[4 * g], Yt[4 * g + 1]), hi = pkbf(Yt[4 * g + 2], Yt[4 * g + 3]);
                *(GAS unsigned long long*)(YA + bl_off(orow_t, head * 64 + dbp * 32 + 8 * g + 4 * (l2 >> 5), 512)) = (unsigned long long)lo | ((unsigned long long)hi << 32); } }
    }
}
struct HotOrder : pg8::StaticOrder { __device__ __forceinline__ bool next(int i, pg8::Unit& u) const { const bool ok = pg8::StaticOrder::next(i, u); u.pm &= 7; return ok; } };
struct Args { const float* in[23]; float* out; unsigned char* ws; int ph_lo, ph_hi; };
__global__ void __launch_bounds__(NWAVES * 64, 2) mk_fwd(Args args) {
    extern __shared__ __attribute__((aligned(16))) unsigned char lds[];
    Frame F;
    F.lds = (LAS unsigned char*)lds;
    F.MISCW = (volatile LAS unsigned*)(F.lds + MISC_OFF);
    F.tid = threadIdx.x; F.lane = F.tid & 63; F.wave = __builtin_amdgcn_readfirstlane(F.tid >> 6);
    F.G = gridDim.x; { const int bx = blockIdx.x; F.vcu = (F.G % 8 == 0) ? (bx % 8) * (F.G / 8) + bx / 8 : bx; }
    F.ws = args.ws; F.ctl = (gu32*)(args.ws + WS_CTL); F.out = args.out;
    for (int u = F.tid; u < (LDS_BYTES - LDSCTL_OFF) / 4; u += NWAVES * 64) ((LAS unsigned*)(F.lds + LDSCTL_OFF))[u] = 0u;
    __syncthreads();
    const int lo = args.ph_lo, hi = args.ph_hi;
#define IN(k) (lo <= (k) && (k) < hi)
#define REID() do { int l_; asm volatile("v_mbcnt_lo_u32_b32 %0, -1, 0\n\tv_mbcnt_hi_u32_b32 %0, -1, %0" : "=v"(l_)); F.lane = l_; F.tid = F.wave * 64 + l_; } while (0)
#define SEAM(k) do { if (IN(k) && IN((k) + 1)) { REID(); xcd_barrier(bar, F.wave == 0 && F.lane == 0); } } while (0)
#ifndef PROBE_MASK
#define PROBE_MASK 0
#endif
#define PHASE(k, BODY) do { if (IN(k)) { if ((PROBE_MASK >> (k)) & 1) { REID(); BODY; REID(); xcd_barrier(bar, F.wave == 0 && F.lane == 0); } REID(); BODY; } SEAM(k); } while (0)
#define BODY0 { p0_prologue<0>(F); }
#define BODY1 { p1_modulate(F); }
#define BODY2 { pg8::Gemm g{(const pg8::bf16_t*)(F.ws + WS_H), (const pg8::bf16_t*)(F.ws + WS_WIN), T, NIN, D}; pg8::StaticOrder S; S.init(T, NIN, F.G, (int)blockIdx.x); \
        pg8::EpiInProj E{(pg8::bf16_t*)(F.ws + WS_QL), (pg8::bf16_t*)(F.ws + WS_QI), (pg8::bf16_t*)(F.ws + WS_U), (pg8::bf16_t*)(F.ws + WS_SG), (float*)(F.ws + WS_MISC), (pg8::bf16_t*)(F.ws + WS_KI)}; \
        pg8::gemm_phase<pg8::EpiInProj, pg8::StaticOrder, PG8_ALIGN, PG8_SP2>(F.lds + RING_OFF, g, S, E, F.wave); }
#define BODY3 { p3_post(F); __syncthreads(); p3_select<0>(F); }
#ifndef SELVAR
#define SELVAR 0
#endif
#ifdef PROBE_POST
#define BODY3V { p3_post(F); }
#else
#define BODY3V { p3_select<SELVAR>(F); }
#endif
#define BODY4 { p4_attention(F); }
#define BODY5 { { pg8::Gemm g{(const pg8::bf16_t*)(F.ws + WS_YA), (const pg8::bf16_t*)(F.ws + WS_WBA), T, D, 512}; pg8::StaticOrder S; S.init(T, D, F.G, (int)blockIdx.x); \
          pg8::EpiGateMul E{(pg8::bf16_t*)(F.ws + WS_TMP), (const pg8::bf16_t*)(F.ws + WS_SG), 0, 0}; \
          pg8::gemm_phase<pg8::EpiGateMul, pg8::StaticOrder, PG8_ALIGN, PG8_SP2>(F.lds + RING_OFF, g, S, E, F.wave); } \
        { pg8::Gemm g{(const pg8::bf16_t*)(F.ws + WS_POOLED), (const pg8::bf16_t*)(F.ws + WS_WPB), T, D, 512}; pg8::StaticOrder S; S.init(T, D, F.G, (int)blockIdx.x); \
          pg8::EpiGateAdd E{(pg8::bf16_t*)(F.ws + WS_MIX), (const pg8::bf16_t*)(F.ws + WS_TMP), (const pg8::bf16_t*)(F.ws + WS_SG), 1024, 0}; \
          pg8::gemm_phase<pg8::EpiGateAdd, pg8::StaticOrder, PG8_ALIGN, PG8_SP2>(F.lds + RING_OFF, g, S, E, F.wave); } }
#define BODY6 { pg8::Gemm g{(const pg8::bf16_t*)(F.ws + WS_MIX), (const pg8::bf16_t*)(F.ws + WS_WOUT), T, D, 1024}; pg8::StaticOrder S; S.init(T, D, F.G, (int)blockIdx.x); \
        pg8::EpiResid E{(float*)(F.ws + WS_Z), frame_in(0), (const float*)(F.ws + WS_MOD) + 2 * 1024}; \
        pg8::gemm_phase<pg8::EpiResid, pg8::StaticOrder, PG8_ALIGN, PG8_SP2>(F.lds + RING_OFF, g, S, E, F.wave); }
#define BODY7 { p7_ln1_route(F, CW_GCNT); }
#define BODY7DRY { p7_ln1_route(F, 128); }
#define BODY9 { load_tstart(F); \
        pg8::MoeOrderG S{(const LAS int*)(F.lds + LC_TSTART), 8, F.G, (int)blockIdx.x, (const LAS int*)(F.lds + LC_ROWTAB), (const int*)(F.ws + WS_SLOTMAP), (const int*)(F.ctl + CW_GCNT)}; \
        moe_fill_rowtab(F, S); \
        pg8::Gemm g{(const pg8::bf16_t*)(F.ws + WS_H), (const pg8::bf16_t*)(F.ws + WS_WGU), T, 32 * 2048, 512}; \
        pg8::EpiSwiglu E{(pg8::bf16_t*)(F.ws + WS_ACT), frame_in(18)}; \
        pg8::gemm_phase<pg8::EpiSwiglu, pg8::MoeOrderG, PG8_ALIGN, PG8_SP2, true>(F.lds + RING_OFF, g, S, E, F.wave); }
#define BODY10 { load_tstart(F); \
        pg8::Gemm g{(const pg8::bf16_t*)(F.ws + WS_ACT), (const pg8::bf16_t*)(F.ws + WS_WD), MAXROWS, 32 * 1024, 512}; \
        pg8::MoeOrder S{(const LAS int*)(F.lds + LC_TSTART), 4, F.G, (int)blockIdx.x, nullptr, nullptr, nullptr}; \
        pg8::EpiDown E{(pg8::bf16_t*)(F.ws + WS_Y), frame_in(20)}; \
        pg8::gemm_phase<pg8::EpiDown, pg8::MoeOrder, PG8_ALIGN, PG8_SP2, true>(F.lds + RING_OFF, g, S, E, F.wave); }
#define BODY10V { load_tstart(F); \
        pg8::Gemm g{(const pg8::bf16_t*)(F.ws + WS_ACT), (const pg8::bf16_t*)(F.ws + WS_WD), MAXROWS, 32 * 1024, 1024}; \
        pg8::MoeOrder S{(const LAS int*)(F.lds + LC_TSTART), 4, F.G, (int)blockIdx.x, nullptr, nullptr, nullptr}; \
        pg8::EpiDownT<false> E{(pg8::bf16_t*)(F.ws + WS_Y), frame_in(20)}; \
        pg8::gemm_phase<pg8::EpiDownT<false>, pg8::MoeOrder, PG8_ALIGN, PG8_SP2>(F.lds + RING_OFF, g, S, E, F.wave); }
#define BODY10X { pg8::Gemm g{(const pg8::bf16_t*)(F.ws + WS_ACT), (const pg8::bf16_t*)(F.ws + WS_WD), 272 * 256, 1024, 1024}; pg8::StaticOrder S; S.init(272 * 256, 1024, F.G, (int)blockIdx.x); \
        pg8::EpiDownT<false> E{(pg8::bf16_t*)(F.ws + WS_Y), frame_in(20)}; \
        pg8::gemm_phase<pg8::EpiDownT<false>, pg8::StaticOrder, PG8_ALIGN, PG8_SP2>(F.lds + RING_OFF, g, S, E, F.wave); }
#define BODY10H { pg8::Gemm g{(const pg8::bf16_t*)(F.ws + WS_ACT), (const pg8::bf16_t*)(F.ws + WS_WD), 272 * 256, 1024, 1024}; HotOrder S; S.init(272 * 256, 1024, F.G, (int)blockIdx.x); \
        pg8::EpiDownT<false> E{(pg8::bf16_t*)(F.ws + WS_Y), frame_in(20)}; \
        pg8::gemm_phase<pg8::EpiDownT<false>, HotOrder, PG8_ALIGN, PG8_SP2>(F.lds + RING_OFF, g, S, E, F.wave); }
#define BODY11 { p11_final(F); }
    XcdBarrier bar; bar.bar = (unsigned*)(F.ctl + CW_BAR); bar.x = 0; bar.st = nullptr;
    if (hi - lo > 1) bar = xcd_barrier_post((unsigned*)(F.ctl + CW_BAR), F.MISCW + 8, F.tid == 0);
#ifdef PROBE_P0SMALL
    if (IN(0)) { REID(); p0_prologue<PROBE_P0SMALL>(F); REID(); xcd_barrier(bar, F.wave == 0 && F.lane == 0); REID(); BODY0; } SEAM(0);
#else
    PHASE(0, BODY0);
#endif
    PHASE(1, BODY1);
#ifdef PROBE_BARRIERS
    for (int i_ = 0; i_ < PROBE_BARRIERS; ++i_) { REID(); xcd_barrier(bar, F.wave == 0 && F.lane == 0); }
#endif
 PHASE(2, BODY2);
    if (IN(3)) { if ((PROBE_MASK >> 3) & 1) { REID(); BODY3V; REID(); xcd_barrier(bar, F.wave == 0 && F.lane == 0); } REID(); BODY3; } SEAM(3);
    PHASE(4, BODY4); PHASE(5, BODY5);
    PHASE(6, BODY6);
    if (IN(7)) { if ((PROBE_MASK >> 7) & 1) { REID(); BODY7DRY; REID(); xcd_barrier(bar, F.wave == 0 && F.lane == 0); } REID(); BODY7; } SEAM(7);
    PHASE(9, BODY9);
#ifdef PROBE_HOT10
    if (IN(10)) { REID(); BODY10H; REID(); xcd_barrier(bar, F.wave == 0 && F.lane == 0); REID(); BODY10; } SEAM(10);
#elif defined(PROBE_STATIC10)
    if (IN(10)) { REID(); BODY10X; REID(); xcd_barrier(bar, F.wave == 0 && F.lane == 0); REID(); BODY10; } SEAM(10);
#elif defined(PROBE_NOBIAS)
    if (IN(10)) { REID(); BODY10V; REID(); xcd_barrier(bar, F.wave == 0 && F.lane == 0); REID(); BODY10; } SEAM(10);
#else
    PHASE(10, BODY10);
#endif
    if (IN(11)) { if ((PROBE_MASK >> 11) & 1) { REID(); BODY11; REID(); xcd_barrier(bar, F.wave == 0 && F.lane == 0); } REID(); BODY11; }
#undef IN
#undef SEAM
}

static void launch_mk(const Args& a0, int lo, int hi, int grid, hipStream_t stream) {
    Args a = a0; a.ph_lo = lo; a.ph_hi = hi;
    hipLaunchKernelGGL(mk_fwd, dim3(grid), dim3(NWAVES * 64), LDS_BYTES, stream, a);
}
extern "C" void kernel_launch(void* const* d_in, const int* in_sizes, int n_in, void* d_out, int out_size, void* d_ws, size_t ws_size, hipStream_t stream) {
    static int grid = 0;
    if (grid == 0) {
        if (n_in != 23 || ws_size < WS_END) { fprintf(stderr, "kernel_launch: unexpected n_in %d / ws %zu\n", n_in, ws_size); grid = -1; return; }
        int dev = 0, cus = 0;
        if (hipGetDevice(&dev) != hipSuccess || hipDeviceGetAttribute(&cus, hipDeviceAttributeMultiprocessorCount, dev) != hipSuccess) { grid = -1; return; }
        if (hipFuncSetAttribute((const void*)mk_fwd, hipFuncAttributeMaxDynamicSharedMemorySize, LDS_BYTES) != hipSuccess) { fprintf(stderr, "hipFuncSetAttribute failed\n"); grid = -1; return; }
        grid = cus;
        if (grid != 256) { fprintf(stderr, "kernel_launch: built for 256 CUs, found %d\n", cus); grid = -1; return; }
    }
    if (grid < 0) return;
    unsigned char* ws = (unsigned char*)d_ws;
    (void)hipMemsetAsync(ws + WS_CTL, 0, CTL_ZERO_BYTES, stream);
    Args a{};
    for (int i = 0; i < 23; ++i) a.in[i] = (const float*)d_in[i];
    a.out = (float*)d_out; a.ws = ws;
    launch_mk(a, 0, 12, grid, stream);
}
```

```cpp
#include <hip/hip_runtime.h>
#include <cstdio>
#include <cstdint>
namespace pg8 {
#define PG8_LAS __attribute__((address_space(3)))
typedef unsigned short bf16_t;
typedef short bf16x8 __attribute__((ext_vector_type(8)));
typedef float f32x4 __attribute__((ext_vector_type(4)));
typedef unsigned u32x4 __attribute__((ext_vector_type(4)));
constexpr int BM = 256, BK = 64, HALF = 128, HTB = HALF * BK * 2  , STAGE_BYTES = 8 * HTB, NXCD = 8, WGM = 8;

__host__ __device__ __forceinline__ int lds_byte(int r, int c) { const int st = (r >> 4) * 2 + (c >> 5), rr = r & 15, cc = c & 31, ob = rr * 64 + cc * 2; return st * 1024 + (ob ^ (((ob >> 9) & 1) << 5)); }
__host__ __device__ __forceinline__ void stage_rc(int b, int& R, int& C) { const int st = b / 1024, sb = b % 1024, swz = sb ^ (((sb >> 9) & 1) << 5); R = (st >> 1) * 16 + swz / 64; C = (st & 1) * 32 + (swz % 64) / 2; }
__host__ __device__ __forceinline__ int perm32(int rho) { const int n = rho >> 4, i = rho & 15; return 8 * (i >> 2) + 4 * n + (i & 3); }

struct Unit { int pm, pn; };
struct Gemm { const bf16_t* A; const bf16_t* Bt; int M, N, K; };

struct StaticOrder {
    static constexpr bool GATHER = false;
    int nM, nN, nwg, G, c;
    __host__ __device__ void init(int M, int N, int G_, int c_) { nM = M / BM; nN = N / BM; nwg = nM * nN; G = G_; c = c_; }
    __host__ __device__ bool next(int i, Unit& u) const {
        const long L = (long)i * G + c; if (L >= nwg) return false;
        int wgid = (int)L; { const int q = nwg / NXCD, r = nwg % NXCD, xcd = wgid % NXCD, off = wgid / NXCD; wgid = (xcd < r ? xcd * (q + 1) : r * (q + 1) + (xcd - r) * q) + off; }
        const int nig = WGM * nN, gid = wgid / nig, fm = gid * WGM, gsz = (nM - fm) < WGM ? (nM - fm) : WGM;
        u.pm = fm + ((wgid % nig) % gsz); u.pn = (wgid % nig) / gsz; return true;
    }
    __device__ __forceinline__ void a_ready(const Unit&) const {}
    __device__ __forceinline__ void done(const Unit&) const {}
};

__device__ __forceinline__ unsigned cvt_pk_bf16(float lo, float hi) { unsigned r; asm volatile("v_cvt_pk_bf16_f32 %0, %1, %2" : "=v"(r) : "v"(lo), "v"(hi)); return r; }
typedef float f32x2 __attribute__((ext_vector_type(2)));
__device__ __forceinline__ f32x2 gelu_pk(f32x2 v) {
    const f32x2 av = __builtin_elementwise_abs(v), d = av * 0.2316418882f + 1.0f;
    f32x2 t; t.x = __builtin_amdgcn_rcpf(d.x); t.y = __builtin_amdgcn_rcpf(d.y);
    f32x2 q = t * 0.5307027145f + (-0.7265760135f); q = q * t + 0.7107068705f; q = q * t + (-0.142248368f); q = q * t + 0.127414796f; q = q * t;
    const f32x2 s = (v * v) * (-0.72134752044f);
    f32x2 e; e.x = __builtin_amdgcn_exp2f(s.x); e.y = __builtin_amdgcn_exp2f(s.y);
    const f32x2 m = v * (q * e), r = v - m;
    f32x2 o; o.x = v.x < 0.f ? m.x : r.x; o.y = v.y < 0.f ? m.y : r.y; return o;
}

template <int ACT  > struct EpiBf16 {
    static constexpr bool PERM = true, AFTER_DRAIN = false; static_assert(ACT == 0 || ACT == 1, "EpiBf16: ACT is 0 (none) or 1 (gelu_pk)");
    bf16_t* O; int ldc; const float* bias; int split_cols; size_t split_stride; float scale0;
    __device__ __forceinline__ void operator()(const f32x4 (&acc)[2][2][4][2], const Unit& u, int wr, int wc, int fr, int fq) const {
        const int row0 = u.pm * BM + wr * 64 + fr; int colt = u.pn * BM; bf16_t* base = O;
        float sc = 1.f; if (split_cols) { const int t = colt / split_cols; base += (size_t)t * split_stride; colt -= t * split_cols; if (t == 0) sc = scale0; }
        const int col0 = colt + wc * 32 + 8 * fq, bcol0 = u.pn * BM + wc * 32 + 8 * fq;
        f32x4 bv[2][2];
#pragma unroll
        for (int bj = 0; bj < 2; ++bj)
#pragma unroll
            for (int n = 0; n < 2; ++n) bv[bj][n] = bias ? *(const f32x4*)(bias + bcol0 + bj * HALF + 4 * n) : (f32x4){0.f, 0.f, 0.f, 0.f};
#pragma unroll
        for (int ai = 0; ai < 2; ++ai)
#pragma unroll
            for (int m = 0; m < 4; ++m) { bf16_t* rowp = base + (size_t)(row0 + ai * HALF + m * 16) * ldc + col0;
#pragma unroll
                for (int bj = 0; bj < 2; ++bj) { f32x4 v0 = acc[ai][bj][m][0] + bv[bj][0], v1 = acc[ai][bj][m][1] + bv[bj][1];
                    if (ACT == 1) { f32x2 a = gelu_pk((f32x2){v0[0], v0[1]}), b = gelu_pk((f32x2){v0[2], v0[3]}), c = gelu_pk((f32x2){v1[0], v1[1]}), d = gelu_pk((f32x2){v1[2], v1[3]});
                        v0 = (f32x4){a.x, a.y, b.x, b.y}; v1 = (f32x4){c.x, c.y, d.x, d.y}; }
                    v0 = v0 * sc; v1 = v1 * sc; u32x4 w; w.x = cvt_pk_bf16(v0[0], v0[1]); w.y = cvt_pk_bf16(v0[2], v0[3]); w.z = cvt_pk_bf16(v1[0], v1[1]); w.w = cvt_pk_bf16(v1[2], v1[3]);
                    *(u32x4*)(rowp + bj * HALF) = w; } }
    }
};

struct PanelStats {
    unsigned* xbuf;
    unsigned* cnt;
    unsigned* tmo;
    int ntn; float eps;
    unsigned code;
    __device__ __forceinline__ bool run(const f32x4 (&v)[2][2][4][2], const Unit& u, int wr, int wc, int fr, int fq, PG8_LAS unsigned char* lds, int wid, int lane) const {
        typedef float f32x2v __attribute__((ext_vector_type(2)));
        PG8_LAS f32x2v* P = (PG8_LAS f32x2v*)lds;
        PG8_LAS f32x2v* S = (PG8_LAS f32x2v*)(lds + 8192);
        PG8_LAS unsigned* flag = (PG8_LAS unsigned*)(lds + 8192 + 2048);
#pragma unroll
        for (int ai = 0; ai < 2; ++ai)
#pragma unroll
            for (int m = 0; m < 4; ++m) {
                float s = 0.f;
#pragma unroll
                for (int bj = 0; bj < 2; ++bj)
#pragma unroll
                    for (int n = 0; n < 2; ++n) { const f32x4 x = v[ai][bj][m][n]; s += (x[0] + x[1]) + (x[2] + x[3]); }
                s += __shfl_xor(s, 16); s += __shfl_xor(s, 32);
                const float mw = s * (1.0f / 64.0f); float q = 0.f;
#pragma unroll
                for (int bj = 0; bj < 2; ++bj)
#pragma unroll
                    for (int n = 0; n < 2; ++n) { const f32x4 d = v[ai][bj][m][n] - mw; q += (d[0] * d[0] + d[1] * d[1]) + (d[2] * d[2] + d[3] * d[3]); }
                q += __shfl_xor(q, 16); q += __shfl_xor(q, 32);
                if (fq == 0) P[(ai * HALF + wr * 64 + m * 16 + fr) * 4 + wc] = (f32x2v){mw, q};
            }
        asm volatile("s_waitcnt lgkmcnt(0)" ::: "memory"); __builtin_amdgcn_s_barrier(); asm volatile("" ::: "memory");
#if defined(BROKEN_EXCHANGE_NO_WAIT)
#warning BROKEN CONTROL BUILD: the row-statistics exchange does not wait; results are wrong by design
        if (blockIdx.x >= 64) { const long long t0_ = clock64(); while (clock64() - t0_ < 60000) __builtin_amdgcn_s_sleep(8); }
#endif
        const int row = wid * 32 + (lane & 31);
        if (lane < 32) {
            const f32x2v a = P[row * 4 + 0], b = P[row * 4 + 1], c = P[row * 4 + 2], d = P[row * 4 + 3];
            const float mt = (a.x + b.x + c.x + d.x) * 0.25f;
            const float da = a.x - mt, db = b.x - mt, dc = c.x - mt, dd = d.x - mt;
            const float m2 = (a.y + b.y) + (c.y + d.y) + 64.0f * ((da * da + db * db) + (dc * dc + dd * dd));
            unsigned long long* slot = (unsigned long long*)xbuf + ((size_t)(u.pm * BM + row) * 4 + u.pn);
            __hip_atomic_store(slot, ((unsigned long long)__float_as_uint(m2) << 32) | __float_as_uint(mt), __ATOMIC_RELAXED, __HIP_MEMORY_SCOPE_AGENT);
        }
        asm volatile("s_waitcnt vmcnt(0)" ::: "memory");
        if (lane == 0) __hip_atomic_fetch_add(cnt + 64 * u.pm, 1u, __ATOMIC_RELAXED, __HIP_MEMORY_SCOPE_AGENT);
        if (wid == 0) {
            bool dead = false; const unsigned long long t0 = __builtin_amdgcn_s_memrealtime(); const unsigned want = 8u * (unsigned)ntn;
            for (;;) {
#if defined(BROKEN_EXCHANGE_NO_WAIT)
                break;
#endif
                if ((unsigned)__builtin_amdgcn_readfirstlane(__hip_atomic_load(cnt + 64 * u.pm, __ATOMIC_RELAXED, __HIP_MEMORY_SCOPE_AGENT)) >= want) break;
                if (__builtin_amdgcn_s_memrealtime() - t0 > 2000000ull) {
                    if (lane == 0) { unsigned expect = 0u; __hip_atomic_compare_exchange_strong(tmo + 1, &expect, code | (unsigned)(u.pm & 0xff), __ATOMIC_RELAXED, __ATOMIC_RELAXED, __HIP_MEMORY_SCOPE_AGENT);
                                     __hip_atomic_store(tmo, 1u, __ATOMIC_RELAXED, __HIP_MEMORY_SCOPE_AGENT); }
                    dead = true; break; }
                __builtin_amdgcn_s_sleep(2);
            }
            __builtin_amdgcn_fence(__ATOMIC_ACQUIRE, "agent");
            if (lane == 0) flag[0] = dead ? 1u : 0u;
        }
        asm volatile("s_waitcnt vmcnt(0) lgkmcnt(0)" ::: "memory"); __builtin_amdgcn_s_barrier(); asm volatile("" ::: "memory");
        const bool bad = flag[0] != 0u;
        if (lane < 32) {
            const unsigned long long* slot = (const unsigned long long*)xbuf + (size_t)(u.pm * BM + row) * 4; float mt[4], m2[4]; float ms = 0.f;
#pragma unroll
            for (int t = 0; t < 4; ++t) { if (t < ntn) { const unsigned long long w = __hip_atomic_load(slot + t, __ATOMIC_RELAXED, __HIP_MEMORY_SCOPE_AGENT); mt[t] = __uint_as_float((unsigned)w); m2[t] = __uint_as_float((unsigned)(w >> 32)); } else { mt[t] = 0.f; m2[t] = 0.f; } ms += mt[t]; }
            const float mean = ms / (float)ntn; float q = 0.f;
#pragma unroll
            for (int t = 0; t < 4; ++t) if (t < ntn) { const float dm = mt[t] - mean; q += m2[t] + 256.0f * dm * dm; }
            S[row] = (f32x2v){mean, 1.0f / sqrtf(q / (256.0f * (float)ntn) + eps)};
        }
        asm volatile("s_waitcnt lgkmcnt(0)" ::: "memory"); __builtin_amdgcn_s_barrier(); asm volatile("" ::: "memory");
        return bad;
    }
};
struct EpiLnRes {
    static constexpr bool PERM = false, AFTER_DRAIN = true;
    const float* base; float* out; int ldc; const float* bias; PanelStats st; unsigned poison;
    __device__ __forceinline__ void fused(f32x4 (&acc)[2][2][4][2], const Unit& u, int wr, int wc, int fr, int fq, PG8_LAS unsigned char* lds, int wid, int lane) const {
        typedef float f32x2v __attribute__((ext_vector_type(2)));
        const PG8_LAS f32x2v* S = (const PG8_LAS f32x2v*)(lds + 8192);
        const int col0 = u.pn * BM + wc * 32 + 4 * fq;
#pragma unroll
        for (int bj = 0; bj < 2; ++bj)
#pragma unroll
            for (int n = 0; n < 2; ++n) { const f32x4 bv = bias ? *(const f32x4*)(bias + col0 + bj * HALF + n * 16) : (f32x4){0.f, 0.f, 0.f, 0.f};
#pragma unroll
                for (int ai = 0; ai < 2; ++ai)
#pragma unroll
                    for (int m = 0; m < 4; ++m) acc[ai][bj][m][n] += bv; }
        f32x4 pre[4][2][2];
#pragma unroll
        for (int m = 0; m < 4; ++m) { const size_t off = (size_t)(u.pm * BM + wr * 64 + m * 16 + fr) * ldc + col0;
#pragma unroll
            for (int bj = 0; bj < 2; ++bj)
#pragma unroll
                for (int n = 0; n < 2; ++n) pre[m][bj][n] = *(const f32x4*)(base + off + bj * HALF + n * 16); }
        const bool bad = st.run(acc, u, wr, wc, fr, fq, lds, wid, lane) || poison != 0u;
        const float qnan = __builtin_nanf("");
#pragma unroll
        for (int ai = 0; ai < 2; ++ai)
#pragma unroll
            for (int m = 0; m < 4; ++m) { const int r = ai * HALF + wr * 64 + m * 16 + fr; const f32x2v sr = S[r]; const size_t off = (size_t)(u.pm * BM + r) * ldc + col0;
#pragma unroll
                for (int bj = 0; bj < 2; ++bj)
#pragma unroll
                    for (int n = 0; n < 2; ++n) { const f32x4 bs = ai == 0 ? pre[m][bj][n] : *(const f32x4*)(base + off + bj * HALF + n * 16); f32x4 o = bs + (acc[ai][bj][m][n] - sr.x) * sr.y;
                        if (bad) o = (f32x4){qnan, qnan, qnan, qnan}; *(f32x4*)(out + off + bj * HALF + n * 16) = o; }
                if (m & 1) asm volatile("" ::: "memory"); }
    }
};
struct EpiLnResLn {
    static constexpr bool PERM = false, AFTER_DRAIN = true;
    const float* base; float* out; bf16_t* xn; int ldc; const float* bias; PanelStats st1, st2; unsigned poison;
    __device__ __forceinline__ void fused(f32x4 (&acc)[2][2][4][2], const Unit& u, int wr, int wc, int fr, int fq, PG8_LAS unsigned char* lds, int wid, int lane) const {
        typedef float f32x2v __attribute__((ext_vector_type(2))); typedef unsigned u32x2v __attribute__((ext_vector_type(2)));
        const PG8_LAS f32x2v* S = (const PG8_LAS f32x2v*)(lds + 8192);
        const int col0 = u.pn * BM + wc * 32 + 4 * fq;
#pragma unroll
        for (int bj = 0; bj < 2; ++bj)
#pragma unroll
            for (int n = 0; n < 2; ++n) { const f32x4 bv = bias ? *(const f32x4*)(bias + col0 + bj * HALF + n * 16) : (f32x4){0.f, 0.f, 0.f, 0.f};
#pragma unroll
                for (int ai = 0; ai < 2; ++ai)
#pragma unroll
                    for (int m = 0; m < 4; ++m) acc[ai][bj][m][n] += bv; }
        bool bad = st1.run(acc, u, wr, wc, fr, fq, lds, wid, lane) || poison != 0u;
        const float qnan = __builtin_nanf("");
#pragma unroll
        for (int ai = 0; ai < 2; ++ai)
#pragma unroll
            for (int m = 0; m < 4; ++m) { const int r = ai * HALF + wr * 64 + m * 16 + fr; const f32x2v sr = S[r]; const size_t off = (size_t)(u.pm * BM + r) * ldc + col0;
#pragma unroll
                for (int bj = 0; bj < 2; ++bj)
#pragma unroll
                    for (int n = 0; n < 2; ++n) { const f32x4 bs = *(const f32x4*)(base + off + bj * HALF + n * 16); acc[ai][bj][m][n] = bs + (acc[ai][bj][m][n] - sr.x) * sr.y; }
                asm volatile("" : "+v"(acc[ai][0][m][0]), "+v"(acc[ai][0][m][1]), "+v"(acc[ai][1][m][0]), "+v"(acc[ai][1][m][1]));
                if (m & 1) asm volatile("" ::: "memory"); }
        const bool bad1 = bad;
        bad = st2.run(acc, u, wr, wc, fr, fq, lds, wid, lane) || bad;
#pragma unroll
        for (int ai = 0; ai < 2; ++ai)
#pragma unroll
            for (int m = 0; m < 4; ++m) { const int r = ai * HALF + wr * 64 + m * 16 + fr; const f32x2v sr = S[r]; const size_t off = (size_t)(u.pm * BM + r) * ldc + col0;
#pragma unroll
                for (int bj = 0; bj < 2; ++bj)
#pragma unroll
                    for (int n = 0; n < 2; ++n) { const f32x4 x1 = acc[ai][bj][m][n]; *(f32x4*)(out + off + bj * HALF + n * 16) = bad1 ? (f32x4){qnan, qnan, qnan, qnan} : x1;
                        const f32x4 o = (x1 - sr.x) * sr.y; u32x2v w; w.x = cvt_pk_bf16(o[0], o[1]); w.y = cvt_pk_bf16(o[2], o[3]);
                        if (bad) { w.x = 0x7fc07fc0u; w.y = 0x7fc07fc0u; } *(u32x2v*)(xn + off + bj * HALF + n * 16) = w; }
                asm volatile("" ::: "memory"); }
    }
};

typedef int i32x4v __attribute__((ext_vector_type(4))); typedef int i32x8v __attribute__((ext_vector_type(8)));
template <class Epi, class Sched, bool ALIGN_EPI = false, bool SP2 = false, bool FP8 = false>
__device__ __forceinline__ void gemm_phase(PG8_LAS unsigned char* lds, const Gemm g, const Sched& S, const Epi& E, const int wave_id  ) {
    int tid; { int l_; asm volatile("v_mbcnt_lo_u32_b32 %0, -1, 0\n\tv_mbcnt_hi_u32_b32 %0, -1, %0" : "=v"(l_)); tid = wave_id * 64 + l_; }
    const int wid = wave_id, lane = tid & 63, wr = wid >> 2, wc = wid & 3, fr = lane & 15, fq = lane >> 4;
    const int K = g.K, nt = K / BK;
    constexpr bool GA = Sched::GATHER;
    static_assert(!GA || SP2, "row gather is wired into the SP2 loop only");
    unsigned voffA[2], voffB[2];
#pragma unroll
    for (int i = 0; i < 2; ++i) { int R, C; stage_rc(tid * 16 + i * 8192, R, C); const int Rb = Epi::PERM ? ((R & ~31) + perm32(R & 31)) : R;
        voffA[i] = (unsigned)(R * BK + C) * 2u; voffB[i] = (unsigned)(Rb * BK + C) * 2u; }
    unsigned goc[2][2]; const char* const gA = (const char*)g.A;
#define PG8_GO(dst, slot, u) do { _Pragma("unroll") for (int _i = 0; _i < 2; ++_i) { int _R, _C; stage_rc(tid * 16 + _i * 8192, _R, _C); _Pragma("unroll") for (int _h = 0; _h < 2; ++_h) \
        { const unsigned _r = (unsigned)S.arow(slot, u, _h * HALF + _R); dst[_h][_i] = (_r >> 8) * (unsigned)(BM * K * 2) + (_r & 255u) * (unsigned)(BK * 2) + (unsigned)(_C * 2); } } } while (0)
#define PG8_STAGE_A(bufoff, gbase_plain, kb, h, useN) do { if constexpr (GA) { _Pragma("unroll") for (int _i = 0; _i < 2; ++_i) \
        __builtin_amdgcn_global_load_lds((const unsigned*)(gA + (kb) + goc[h][_i]), (PG8_LAS unsigned*)(lds + (bufoff) + ldsw + _i * 8192), 16, 0, 0); } else { PG8_STAGE(bufoff, gbase_plain, voffA); } } while (0)
    const size_t kstep = (size_t)(BM * BK * 2);
    const size_t hstep = (size_t)HALF * BK * 2;
    const size_t tstep = (size_t)BM * K * 2;
    const unsigned ldsw = (unsigned)wid * 1024u;
    const int aoff = lds_byte(wr * 64 + fr, fq * 8), boff = lds_byte(wc * 32 + fr, fq * 8);
#define PG8_SA(b, h) (((b) * 2 + (h)) * HTB)
#define PG8_SB(b, h) ((4 + (b) * 2 + (h)) * HTB)
#define PG8_STAGE(bufoff, gbase, voff) do { _Pragma("unroll") for (int _i = 0; _i < 2; ++_i) \
        __builtin_amdgcn_global_load_lds((const unsigned*)((const char*)(gbase) + (voff)[_i]), (PG8_LAS unsigned*)(lds + (bufoff) + ldsw + _i * 8192), 16, 0, 0); } while (0)
#define PG8_LDA(dst, b, h) do { if constexpr (FP8) { _Pragma("unroll") for (int m = 0; m < 4; ++m) { const i32x4v _lo = *(const PG8_LAS i32x4v*)(lds + PG8_SA(b, h) + aoff + m * 2048), _hi = *(const PG8_LAS i32x4v*)(lds + PG8_SA(b, h) + aoff + m * 2048 + 1024); \
        dst##8[m] = __builtin_shufflevector(_lo, _hi, 0, 1, 2, 3, 4, 5, 6, 7); } } else { _Pragma("unroll") for (int m = 0; m < 4; ++m) _Pragma("unroll") for (int k = 0; k < 2; ++k) dst[m][k] = *(const PG8_LAS bf16x8*)(lds + PG8_SA(b, h) + aoff + m * 2048 + k * 1024); } } while (0)
#define PG8_LDB(dst, b, h) do { if constexpr (FP8) { _Pragma("unroll") for (int n = 0; n < 2; ++n) { const i32x4v _lo = *(const PG8_LAS i32x4v*)(lds + PG8_SB(b, h) + boff + n * 2048), _hi = *(const PG8_LAS i32x4v*)(lds + PG8_SB(b, h) + boff + n * 2048 + 1024); \
        dst##8[n] = __builtin_shufflevector(_lo, _hi, 0, 1, 2, 3, 4, 5, 6, 7); } } else { _Pragma("unroll") for (int n = 0; n < 2; ++n) _Pragma("unroll") for (int k = 0; k < 2; ++k) dst[n][k] = *(const PG8_LAS bf16x8*)(lds + PG8_SB(b, h) + boff + n * 2048 + k * 1024); } } while (0)
#define PG8_MMA16(ai, bj, At, Bt) do { __builtin_amdgcn_s_setprio(1); _Pragma("unroll") for (int m = 0; m < 4; ++m) _Pragma("unroll") for (int n = 0; n < 2; ++n) _Pragma("unroll") for (int k = 0; k < 2; ++k) \
        acc[ai][bj][m][n] = __builtin_amdgcn_mfma_f32_16x16x32_bf16(Bt[n][k], At[m][k], acc[ai][bj][m][n], 0, 0, 0); __builtin_amdgcn_s_setprio(0); } while (0)
#define PG8_MMA8(ai, bj, At, Bt) do { __builtin_amdgcn_sched_barrier(0); __builtin_amdgcn_s_setprio(1); _Pragma("unroll") for (int m = 0; m < 4; ++m) _Pragma("unroll") for (int n = 0; n < 2; ++n) \
        acc[ai][bj][m][n] = __builtin_amdgcn_mfma_scale_f32_16x16x128_f8f6f4(Bt##8[n], At##8[m], acc[ai][bj][m][n], 0, 0, 0, 0x7f7f7f7f, 0, 0x7f7f7f7f); __builtin_amdgcn_s_setprio(0); __builtin_amdgcn_sched_barrier(0); } while (0)
#define PG8_MMA(ai, bj, At, Bt) do { if constexpr (FP8) { PG8_MMA8(ai, bj, At, Bt); } else { PG8_MMA16(ai, bj, At, Bt); } } while (0)
#define PG8_WAIT_V(n) asm volatile("s_waitcnt vmcnt(" #n ")" ::: "memory")
#define PG8_WAIT_L(n) asm volatile("s_waitcnt lgkmcnt(" #n ")" ::: "memory")
#define PG8_BAR __builtin_amdgcn_s_barrier()
#define PG8_SCHED __builtin_amdgcn_sched_barrier(0)
    Unit cur, nxt; int ui = 0;
    if (!S.next(0, cur)) return;
    f32x4 acc[2][2][4][2];
#pragma unroll
    for (int a = 0; a < 2; ++a)
#pragma unroll
        for (int b = 0; b < 2; ++b)
#pragma unroll
            for (int m = 0; m < 4; ++m)
#pragma unroll
                for (int n = 0; n < 2; ++n) acc[a][b][m][n] = (f32x4){0.f, 0.f, 0.f, 0.f};
    bf16x8 At[4][2], B0[2][2], B1[2][2];
    i32x8v At8[4], B08[2], B18[2];
#define PG8_ROT(u) (2 * (((u).pm + 3 * (u).pn) & 3))
#define PG8_KOFF(t, r) ((size_t)(((t) + (r)) & (nt - 1)) * kstep)
    int rc = SP2 ? PG8_ROT(cur) : 0, rn = rc;
    const char* cA = (const char*)g.A + (size_t)cur.pm * tstep; const char* cB = (const char*)g.Bt + (size_t)cur.pn * tstep;
    if constexpr (GA) { PG8_GO(goc, 0, cur); }
    S.a_ready(cur);
    if constexpr (SP2) {
        const size_t k0 = PG8_KOFF(0, rc);
        PG8_STAGE(PG8_SB(0, 0), cB + k0, voffB); PG8_STAGE(PG8_SB(0, 1), cB + k0 + hstep, voffB); PG8_STAGE_A(PG8_SA(0, 0), cA + k0, k0, 0, false); PG8_STAGE_A(PG8_SA(0, 1), cA + k0 + hstep, k0, 1, false);
        if (wr == 1) PG8_BAR;
        PG8_WAIT_V(2); PG8_BAR;
        PG8_STAGE(PG8_SB(1, 0), cB + k0 + kstep, voffB); PG8_STAGE_A(PG8_SA(1, 0), cA + k0 + kstep, k0 + kstep, 0, false); PG8_STAGE(PG8_SB(1, 1), cB + k0 + hstep + kstep, voffB);
        PG8_WAIT_V(6); PG8_BAR;
    } else {
        PG8_STAGE(PG8_SB(0, 0), cB, voffB); PG8_STAGE(PG8_SA(0, 0), cA, voffA); PG8_STAGE(PG8_SB(0, 1), cB + hstep, voffB); PG8_STAGE(PG8_SA(0, 1), cA + hstep, voffA);
        if (wr == 1) PG8_BAR;
        PG8_WAIT_V(4); PG8_BAR;
        PG8_STAGE(PG8_SB(1, 0), cB + kstep, voffB); PG8_STAGE(PG8_SA(1, 0), cA + kstep, voffA); PG8_STAGE(PG8_SB(1, 1), cB + hstep + kstep, voffB);
        PG8_WAIT_V(6); PG8_BAR;
    }
    for (;;) {
        const bool has_next = S.next(ui + 1, nxt);
        rn = (SP2 && has_next) ? PG8_ROT(nxt) : rc;
        const char* nA = has_next ? (const char*)g.A + (size_t)nxt.pm * tstep : cA; const char* nB = has_next ? (const char*)g.Bt + (size_t)nxt.pn * tstep : cB;
#pragma unroll 1
        for (int t = 0; t < nt; t += 2) {
            const bool last = (t == nt - 2);
            const size_t kt0 = PG8_KOFF(t, rc), kt2 = last ? PG8_KOFF(0, rn) : PG8_KOFF(t + 2, rc);
            const char* a1 = cA + kt0 + kstep;
            const char* a2 = (last ? nA : cA) + kt2; const char* b2 = (last ? nB : cB) + kt2;
            const char* a3 = a2 + kstep; const char* b3 = b2 + kstep;
            const size_t k2 = kt2;
            if (last && has_next) S.a_ready(nxt);
            if constexpr (SP2) {
            PG8_LDB(B0, 0, 0); PG8_LDB(B1, 0, 1); PG8_SCHED; PG8_LDA(At, 0, 0); PG8_STAGE_A(PG8_SA(1, 1), a1 + hstep, kt0 + kstep, 1, false);
            if constexpr (GA) { if (last && has_next) { PG8_GO(goc, ui + 1, nxt); } }
            PG8_WAIT_V(8); PG8_WAIT_L(0); PG8_BAR; PG8_MMA(0, 0, At, B0); PG8_MMA(0, 1, At, B1); PG8_BAR; PG8_SCHED;
            PG8_LDA(At, 0, 1); PG8_STAGE(PG8_SB(0, 0), b2, voffB); PG8_STAGE(PG8_SB(0, 1), b2 + hstep, voffB); PG8_STAGE_A(PG8_SA(0, 0), a2, k2, 0, last);
            PG8_WAIT_V(8); PG8_WAIT_L(0); PG8_BAR; PG8_MMA(1, 0, At, B0); PG8_MMA(1, 1, At, B1); PG8_BAR; PG8_SCHED;
            PG8_LDB(B0, 1, 0); PG8_LDB(B1, 1, 1); PG8_SCHED; PG8_LDA(At, 1, 0); PG8_STAGE_A(PG8_SA(0, 1), a2 + hstep, k2, 1, last);
            PG8_WAIT_V(8); PG8_WAIT_L(0); PG8_BAR; PG8_MMA(0, 0, At, B0); PG8_MMA(0, 1, At, B1); PG8_BAR; PG8_SCHED;
            PG8_LDA(At, 1, 1); PG8_STAGE(PG8_SB(1, 0), b3, voffB); PG8_STAGE(PG8_SB(1, 1), b3 + hstep, voffB); PG8_STAGE_A(PG8_SA(1, 0), a3, k2 + kstep, 0, last);
            PG8_WAIT_V(8); PG8_WAIT_L(0); PG8_BAR; PG8_MMA(1, 0, At, B0); PG8_MMA(1, 1, At, B1); PG8_BAR; PG8_SCHED;
            } else {
            PG8_LDB(B0, 0, 0); PG8_SCHED; PG8_LDA(At, 0, 0); PG8_STAGE(PG8_SA(1, 1), a1 + hstep, voffA);
            PG8_WAIT_L(8); PG8_BAR; PG8_WAIT_L(0); PG8_MMA(0, 0, At, B0); PG8_BAR; PG8_SCHED;
            PG8_LDB(B1, 0, 1); PG8_STAGE(PG8_SB(0, 0), b2, voffB);
            PG8_BAR; PG8_WAIT_L(0); PG8_MMA(0, 1, At, B1); PG8_BAR;
            PG8_LDA(At, 0, 1); PG8_STAGE(PG8_SA(0, 0), a2, voffA);
            PG8_BAR; PG8_WAIT_L(0); PG8_MMA(1, 0, At, B0); PG8_BAR; PG8_SCHED;
            PG8_STAGE(PG8_SB(0, 1), b2 + hstep, voffB);
            PG8_WAIT_V(6); PG8_BAR; PG8_MMA(1, 1, At, B1); PG8_BAR;
            PG8_LDB(B0, 1, 0); PG8_SCHED; PG8_LDA(At, 1, 0); PG8_STAGE(PG8_SA(0, 1), a2 + hstep, voffA);
            PG8_WAIT_L(8); PG8_BAR; PG8_WAIT_L(0); PG8_MMA(0, 0, At, B0); PG8_BAR; PG8_SCHED;
            PG8_LDB(B1, 1, 1); PG8_STAGE(PG8_SB(1, 0), b3, voffB);
            PG8_BAR; PG8_WAIT_L(0); PG8_MMA(0, 1, At, B1); PG8_BAR;
            PG8_LDA(At, 1, 1); PG8_STAGE(PG8_SA(1, 0), a3, voffA);
            PG8_BAR; PG8_WAIT_L(0); PG8_MMA(1, 0, At, B0); PG8_BAR; PG8_SCHED;
            PG8_STAGE(PG8_SB(1, 1), b3 + hstep, voffB);
            PG8_WAIT_V(6); PG8_BAR; PG8_MMA(1, 1, At, B1); PG8_BAR;
            }
        }
        if constexpr (ALIGN_EPI) { if (wr == 0) PG8_BAR; }
        if constexpr (!Epi::AFTER_DRAIN) { E(acc, cur, wr, wc, fr, fq); S.done(cur); }
        if (!has_next) break;
#pragma unroll
        for (int a = 0; a < 2; ++a)
#pragma unroll
            for (int b = 0; b < 2; ++b)
#pragma unroll
                for (int m = 0; m < 4; ++m)
#pragma unroll
                    for (int n = 0; n < 2; ++n) acc[a][b][m][n] = (f32x4){0.f, 0.f, 0.f, 0.f};
        cur = nxt; cA = nA; cB = nB; ++ui; rc = rn;

        if constexpr (ALIGN_EPI) { if (wr == 1) PG8_BAR; }
    }
    PG8_WAIT_V(0);
    if constexpr (!ALIGN_EPI) { if (wr == 0) PG8_BAR; }
    PG8_BAR;
    if constexpr (Epi::AFTER_DRAIN) { E.fused(acc, cur, wr, wc, fr, fq, lds, wid, lane); S.done(cur); }
#undef PG8_SA
#undef PG8_SB
#undef PG8_STAGE
#undef PG8_ROT
#undef PG8_KOFF
#undef PG8_STAGE_A
#undef PG8_GO
#undef PG8_LDA
#undef PG8_LDB
#undef PG8_MMA
#undef PG8_MMA8
#undef PG8_MMA16
#undef PG8_WAIT_V
#undef PG8_WAIT_L
#undef PG8_BAR
#undef PG8_SCHED
}
}

#ifndef PG8_SP2
#define PG8_SP2 true
#endif
#ifndef PG8_ALIGN
#define PG8_ALIGN true
#endif
#define GAS __attribute__((address_space(1)))
#define LAS __attribute__((address_space(3)))
typedef unsigned short bf16;
typedef unsigned v4u __attribute__((ext_vector_type(4)));
typedef float f32x4 __attribute__((ext_vector_type(4)));
typedef short bf16x8 __attribute__((ext_vector_type(8)));
typedef GAS unsigned gu32;
typedef GAS unsigned long long gu64;
#define RLX_AGENT __ATOMIC_RELAXED, __HIP_MEMORY_SCOPE_AGENT
#define LDS_WAIT() asm volatile("s_waitcnt lgkmcnt(0)" ::: "memory")
#define VM_WAIT() asm volatile("s_waitcnt vmcnt(0)" ::: "memory")
__device__ __forceinline__ unsigned long long rt() { return __builtin_amdgcn_s_memrealtime(); }
__device__ __forceinline__ unsigned f2bf(float f) { unsigned u = __builtin_bit_cast(unsigned, f); return (u + 0x7fffu + ((u >> 16) & 1u)) >> 16; }
__device__ __forceinline__ unsigned pk2(float lo, float hi) { return f2bf(lo) | (f2bf(hi) << 16); }

#define XB_TMO      128
#define XB_XCNT(j)  (256  + 64 * (j))
#define XB_XSUB(j)  (1280 + 64 * (j))
#define XB_XGEN(j)  (2304 + 64 * (j))
#define XB_TOP      3328
#define XB_TOPGEN   3392
#define XCD_BAR_WORDS 3456
#define XB_SPIN_CAP (1u << 18)

__device__ __forceinline__ unsigned xb_ld(unsigned* p)              { return __hip_atomic_load(p, __ATOMIC_RELAXED, __HIP_MEMORY_SCOPE_AGENT); }
__device__ __forceinline__ unsigned xb_add(unsigned* p, unsigned v) { return __hip_atomic_fetch_add(p, v, __ATOMIC_RELAXED, __HIP_MEMORY_SCOPE_AGENT); }
__device__ __forceinline__ unsigned xb_xcc_id() { return (unsigned)__builtin_amdgcn_s_getreg((3 << 11) | 20) & 0xFu; }
#define XB_SPIN(cond, bar) do { unsigned _sp = 0; while (cond) { __builtin_amdgcn_s_sleep(1); \
    if ((++_sp & 255u) == 0u) { if (xb_ld(&(bar)[XB_TMO])) break; if (_sp > XB_SPIN_CAP) { atomicAdd(&(bar)[XB_TMO], 1u); break; } } } } while (0)

struct XcdBarrier {
    unsigned* bar; unsigned x;
    volatile LAS unsigned* st;
};

__device__ __forceinline__ XcdBarrier xcd_barrier_post(unsigned* bar, volatile LAS unsigned* st, bool leader) {
    XcdBarrier b; b.bar = bar; b.x = xb_xcc_id(); b.st = st;
    if (leader) (void)xb_add(&bar[XB_XCNT(b.x)], 1u);
    return b;
}
__device__ __forceinline__ void xcd_barrier_complete(unsigned* bar, unsigned x, unsigned& nloc, unsigned& nx) {
    const unsigned G = gridDim.x * gridDim.y * gridDim.z;
    unsigned sum, cnt, mine, sp = 0u;
    for (;;) {
        sum = 0u; cnt = 0u; mine = 0u;
#pragma unroll
        for (unsigned j = 0; j < 16; ++j) { const unsigned c = xb_ld(&bar[XB_XCNT(j)]); sum += c; cnt += (c > 0u) ? 1u : 0u; mine = (j == x) ? c : mine; }
        if (sum == G) break;
        __builtin_amdgcn_s_sleep(1);
        if ((++sp & 255u) == 0u) { if (xb_ld(&bar[XB_TMO])) break; if (sp > XB_SPIN_CAP) { atomicAdd(&bar[XB_TMO], 1u); break; } }
    }
    nloc = mine > 0u ? mine : 1u; nx = cnt > 0u ? cnt : 1u;
}

__device__ __forceinline__ void xcd_barrier(const XcdBarrier& b, bool leader) {
    asm volatile("s_waitcnt vmcnt(0)" ::: "memory");
    __syncthreads();
    if (leader) {
        unsigned* bar = b.bar;
        __builtin_amdgcn_s_waitcnt(0);
        unsigned nloc = b.st[0], nx = b.st[1];
        if (nloc == 0u) { xcd_barrier_complete(bar, b.x, nloc, nx); b.st[0] = nloc; b.st[1] = nx; }
        const unsigned old = xb_add(&bar[XB_XSUB(b.x)], 1u);
        const unsigned gen = old / nloc;
        if (old + 1u == (gen + 1u) * nloc) {
            __builtin_amdgcn_fence(__ATOMIC_RELEASE, "agent");
            asm volatile("s_waitcnt vmcnt(0)" ::: "memory");
            const unsigned og = xb_add(&bar[XB_TOP], 1u);
            const unsigned tg = og / nx;
            if (og + 1u == (tg + 1u) * nx) xb_add(&bar[XB_TOPGEN], 1u);
            else XB_SPIN(xb_ld(&bar[XB_TOPGEN]) == tg, bar);
            __builtin_amdgcn_fence(__ATOMIC_ACQUIRE, "agent");
            xb_add(&bar[XB_XGEN(b.x)], 1u);
            asm volatile("s_waitcnt vmcnt(0)" ::: "memory");
        } else {
            XB_SPIN(xb_ld(&bar[XB_XGEN(b.x)]) == gen, bar);
            __builtin_amdgcn_fence(__ATOMIC_ACQUIRE, "agent");
            asm volatile("s_waitcnt vmcnt(0)" ::: "memory");
        }
    }
    __syncthreads();
}
constexpr int NWAVES = 8;
constexpr int B_ = 8, S_ = 2048, T = B_ * S_, D = 1024;
constexpr int INC = 3784;
constexpr int O_Q = 0, O_CKV = 512, O_QI = 640, O_KI = 1152, O_WI = 1216, O_U = 1224, O_G = 1736;
constexpr int NIN = 3840;
constexpr float ALPHA = 1.189207115002721f, LN_EPS = 1e-5f, LOG2E = 1.4426950408889634f;
constexpr int MAXROWS = T * 4 + 32 * 256;
constexpr int TOPK = 256;
constexpr float A8_H = 32.f, W8_GU = 1024.f, A8_ACT = 8.f, W8_D = 2048.f;

constexpr size_t MiB = 1u << 20;
constexpr size_t WS_CTL = 0, CTL_ZERO_BYTES = 1 * MiB;
constexpr size_t WS_MOD = 1 * MiB, WS_WIN = 2 * MiB, WS_WOA = 11 * MiB, WS_WPB = 13 * MiB, WS_WOUT = 14 * MiB, WS_WGU = 16 * MiB, WS_WD = 144 * MiB;
constexpr size_t WS_H = 208 * MiB, WS_QL = 240 * MiB, WS_QI = 272 * MiB, WS_MISC = 288 * MiB, WS_U = 304 * MiB, WS_SG = 320 * MiB;
constexpr size_t WS_CKV = 384 * MiB, WS_CKVT = 388 * MiB, WS_POOLED = 392 * MiB, WS_MASK = 408 * MiB, WS_OLAT = 412 * MiB, WS_TMP = 444 * MiB, WS_MIX = 476 * MiB;
constexpr size_t WS_Z = 508 * MiB, WS_X1 = 572 * MiB, WS_SLOTMAP = 636 * MiB, WS_TOKSLOT = 638 * MiB, WS_GATE = 638 * MiB + 512 * 1024;
constexpr size_t WS_XPAD = 640 * MiB, WS_ACT = 784 * MiB, WS_Y = WS_XPAD, WS_KI = 928 * MiB, WS_WRB = 930 * MiB, WS_END = 931 * MiB;
constexpr size_t WS_WBA = WS_WOA, WS_WUKB = WS_WOA + 1 * MiB, WS_WUVT = WS_WOA + 1 * MiB + 256 * 1024, WS_YA = WS_OLAT;
constexpr int CW_GCNT = 0, CW_TSTART = 64, CW_BAR = 4096;

constexpr int RING_OFF = 0, RING_BYTES = 131072;
constexpr int LDSCTL_OFF = RING_BYTES, MISC_OFF = LDSCTL_OFF + 320;
constexpr int LDS_BYTES = 163840;

struct Frame {
    LAS unsigned char* lds;
    volatile LAS unsigned* MISCW;
    gu32* ctl;
    int tid, lane, wave, vcu, G;
    unsigned char* ws;
    float* out;
};
__device__ __forceinline__ const float* frame_in(int i) { typedef __attribute__((address_space(4))) const char* kptr_t; kptr_t ka = (kptr_t)__builtin_amdgcn_kernarg_segment_ptr(); asm volatile("" : "+s"(ka));
    const float* p = *(const float* __attribute__((address_space(4))) const*)(ka + 8 * i); return (const float*)(const GAS float*)p; }
typedef __bf16 bf2v __attribute__((ext_vector_type(2)));
typedef float f2v __attribute__((ext_vector_type(2)));
__device__ __forceinline__ unsigned pkbf(float a, float b) { f2v v = {a, b}; bf2v r = __builtin_convertvector(v, bf2v); return __builtin_bit_cast(unsigned, r); }
__device__ __forceinline__ size_t bl_off(int r, int k, int K) { return ((size_t)(r >> 8) * (size_t)(K >> 6) + (size_t)(k >> 6)) * 16384 + (size_t)((r & 255) * 64 + (k & 63)); }
__device__ __forceinline__ float bf2f(unsigned short u) { return __uint_as_float((unsigned)u << 16); }
__device__ __forceinline__ float sigm_fast(float x) { return __builtin_amdgcn_rcpf(1.f + __builtin_amdgcn_exp2f(-x * LOG2E)); }

typedef float f32x16 __attribute__((ext_vector_type(16)));
__device__ __forceinline__ bf16x8 pack8(float a0, float a1, float a2, float a3, float a4, float a5, float a6, float a7) {
    v4u p; p.x = pkbf(a0, a1); p.y = pkbf(a2, a3); p.z = pkbf(a4, a5); p.w = pkbf(a6, a7); return __builtin_bit_cast(bf16x8, p); }
#define MFMA32(a, b, c) __builtin_amdgcn_mfma_f32_32x32x16_bf16((a), (b), (c), 0, 0, 0)
__device__ __forceinline__ int krow16(int r, int hh) { return (r & 3) + 8 * (r >> 2) + 4 * hh; }

namespace pg8 {
struct EpiInProj {
    static constexpr bool PERM = true, AFTER_DRAIN = false;
    bf16_t *QL, *QI, *U, *SG; float* MISC; bf16_t* KI;
    __device__ __forceinline__ void operator()(const f32x4 (&acc)[2][2][4][2], const Unit& u, int wr, int wc, int fr_, int fq_) const {
        int fr = fr_, fq = fq_; asm volatile("" : "+v"(fr), "+v"(fq));
        const int row0 = u.pm * BM + wr * 64 + fr, c0 = wc * 32 + 8 * fq; const int pn = u.pn;
        if (pn == 4) {
#pragma unroll
            for (int ai = 0; ai < 2; ++ai)
#pragma unroll
                for (int m = 0; m < 4; ++m) { float* rowp = MISC + (size_t)(row0 + ai * HALF + m * 16) * 256 + c0;
#pragma unroll
                    for (int bj = 0; bj < 2; ++bj) { *(f32x4*)(rowp + bj * HALF) = acc[ai][bj][m][0]; *(f32x4*)(rowp + bj * HALF + 4) = acc[ai][bj][m][1]; }
                    if (wc < 2) { const f32x4 v0 = acc[ai][1][m][0], v1 = acc[ai][1][m][1]; u32x4 w; w.x = cvt_pk_bf16(v0[0], v0[1]); w.y = cvt_pk_bf16(v0[2], v0[3]); w.z = cvt_pk_bf16(v1[0], v1[1]); w.w = cvt_pk_bf16(v1[2], v1[3]);
                        *(u32x4*)(KI + (size_t)(row0 + ai * HALF + m * 16) * 64 + c0) = w; } }
        } else {
            bf16_t* base; int ld, colt; bool sg = false;
            if (pn < 2) { base = QL; ld = 512; colt = pn * 256; }
            else if (pn < 4) { base = QI; ld = 512; colt = (pn - 2) * 256; }
            else if (pn < 7) { base = U; ld = 512; colt = (pn - 5) * 256; }
            else { base = SG; ld = 2048; colt = (pn - 7) * 256; sg = true; }
#pragma unroll
            for (int ai = 0; ai < 2; ++ai)
#pragma unroll
                for (int m = 0; m < 4; ++m) { bf16_t* rowp = base + (size_t)(row0 + ai * HALF + m * 16) * ld + colt + c0;
#pragma unroll
                    for (int bj = 0; bj < 2; ++bj) { f32x4 v0 = acc[ai][bj][m][0], v1 = acc[ai][bj][m][1];
                        if (sg) {
#pragma unroll
                            for (int i = 0; i < 4; ++i) { v0[i] = sigm_fast(v0[i]); v1[i] = sigm_fast(v1[i]); } }
                        u32x4 w; w.x = cvt_pk_bf16(v0[0], v0[1]); w.y = cvt_pk_bf16(v0[2], v0[3]); w.z = cvt_pk_bf16(v1[0], v1[1]); w.w = cvt_pk_bf16(v1[2], v1[3]);
                        *(u32x4*)(rowp + bj * HALF) = w; } }
        }
    }
};
}

__device__ __forceinline__ void tr_item(const float* W, int ldw, int k0, int n0, int ncols, float scale, bf16* WT, int ldt, int drow0, LAS float* scr, int lane) {
    const int nn = lane & 31;
#pragma unroll 8
    for (int i = 0; i < 32; ++i) { const int kk = 2 * i + (lane >> 5); scr[kk * 33 + nn] = (nn < ncols) ? W[(size_t)(k0 + kk) * ldw + n0 + nn] * scale : 0.f; }
    LDS_WAIT(); asm volatile("" ::: "memory");
    const int c = lane & 7;
#pragma unroll
    for (int j = 0; j < 4; ++j) { const int n = (lane >> 3) + 8 * j; const LAS float* s = scr + (8 * c) * 33 + n;
        v4u o; o.x = pk2(s[0 * 33], s[1 * 33]); o.y = pk2(s[2 * 33], s[3 * 33]); o.z = pk2(s[4 * 33], s[5 * 33]); o.w = pk2(s[6 * 33], s[7 * 33]);
        if (n < ncols) *(GAS v4u*)(WT + bl_off(drow0 + n, k0 + 8 * c, ldt)) = o; }
    LDS_WAIT(); asm volatile("" ::: "memory");
}
__device__ __forceinline__ float clamp8(float x) { return fminf(fmaxf(x, -448.f), 448.f); }
struct TrDesc { const float* src; bf16* dst; int ldw; float scale; int f8; int pad_; };
__device__ __forceinline__ void tr_load(const TrDesc& d, int lane, f32x4 (&v)[16]) {
    const int kr = lane >> 4, nc = lane & 15; const float* src = d.src + (size_t)(16 * kr) * d.ldw + 4 * nc;
#pragma unroll
    for (int i = 0; i < 16; ++i) v[i] = __builtin_nontemporal_load((const f32x4*)(src + (size_t)i * d.ldw));
}
__device__ __forceinline__ void tr_finish(const TrDesc& d, LAS unsigned char* scr, int lane, const f32x4 (&v)[16]) {
    const int kr = lane >> 4, nc = lane & 15; const float scale = d.scale;
    if (d.f8) {
#pragma unroll
        for (int j = 0; j < 4; ++j) { const int n = 4 * nc + j; v4u o;
#pragma unroll
            for (int w4 = 0; w4 < 4; ++w4) { unsigned r = __builtin_amdgcn_cvt_pk_fp8_f32(clamp8(v[4 * w4][j] * scale), clamp8(v[4 * w4 + 1][j] * scale), 0u, false);
                r = __builtin_amdgcn_cvt_pk_fp8_f32(clamp8(v[4 * w4 + 2][j] * scale), clamp8(v[4 * w4 + 3][j] * scale), r, true); o[w4] = r; }
            *(LAS v4u*)(scr + n * 64 + ((kr ^ ((n >> 2) & 3)) << 4)) = o; }
        LDS_WAIT(); asm volatile("" ::: "memory");
        const int kc4 = lane & 3;
#pragma unroll
        for (int j = 0; j < 4; ++j) { const int n = (lane >> 2) + 16 * j; const v4u o = *(const LAS v4u*)(scr + n * 64 + ((kc4 ^ ((n >> 2) & 3)) << 4));
            *(GAS v4u*)((GAS unsigned char*)(d.dst + (size_t)n * 64) + 16 * kc4) = o; }
        LDS_WAIT(); asm volatile("" ::: "memory");
        return; }
#pragma unroll
    for (int j = 0; j < 4; ++j) { const int n = 4 * nc + j; const int f = (n >> 2) & 7;
#pragma unroll
        for (int hlf = 0; hlf < 2; ++hlf) { v4u o;
            o.x = pkbf(v[8 * hlf + 0][j] * scale, v[8 * hlf + 1][j] * scale); o.y = pkbf(v[8 * hlf + 2][j] * scale, v[8 * hlf + 3][j] * scale);
            o.z = pkbf(v[8 * hlf + 4][j] * scale, v[8 * hlf + 5][j] * scale); o.w = pkbf(v[8 * hlf + 6][j] * scale, v[8 * hlf + 7][j] * scale);
            *(LAS v4u*)(scr + n * 128 + (((2 * kr + hlf) ^ f) << 4)) = o; } }
    LDS_WAIT(); asm volatile("" ::: "memory");
    const int kc = lane & 7;
#pragma unroll
    for (int j = 0; j < 8; ++j) { const int n = (lane >> 3) + 8 * j; const v4u o = *(const LAS v4u*)(scr + n * 128 + ((kc ^ ((n >> 2) & 7)) << 4));
        *(GAS v4u*)(d.dst + (size_t)n * 64 + 8 * kc) = o; }
    LDS_WAIT(); asm volatile("" ::: "memory");
}
__device__ __forceinline__ void fold_pb(const float* w_pg, const float* pscale, const float* w_bp, bf16* Wpb_t, int task, int lane) {
    const int g = task >> 8, nb = (task >> 4) & 15, c0 = (task & 15) * 8; const int n = nb * 64 + lane;
    const float* pg = w_pg + (size_t)g * 16384 + c0 * 128; float a[8] = {0, 0, 0, 0, 0, 0, 0, 0};
#pragma unroll 4
    for (int d4 = 0; d4 < 32; ++d4) { float v[4]; const f32x4 ps = *(const f32x4*)(pscale + g * 128 + 4 * d4);
#pragma unroll
        for (int i = 0; i < 4; ++i) v[i] = w_bp[(size_t)(g * 128 + 4 * d4 + i) * 1024 + n] * ps[i];
#pragma unroll
        for (int j = 0; j < 8; ++j) { const f32x4 u = *(const f32x4*)(pg + j * 128 + 4 * d4); a[j] += (v[0] * u.x + v[1] * u.y) + (v[2] * u.z + v[3] * u.w); } }
    v4u o; o.x = pk2(a[0], a[1]); o.y = pk2(a[2], a[3]); o.z = pk2(a[4], a[5]); o.w = pk2(a[6], a[7]);
    *(GAS v4u*)(Wpb_t + bl_off(n, g * 128 + c0, 512)) = o;
}
template <int VAR>
__device__ __forceinline__ void p0_prologue(Frame& F) {
    const float* c = frame_in(1); const float* w_ada = frame_in(2); const float* b_ada = frame_in(3); const float* w_in = frame_in(4);
    const float* w_uk = frame_in(6); const float* w_uv = frame_in(7); const float* w_pg = frame_in(8); const float* pscale = frame_in(9);
    const float* w_ba = frame_in(10); const float* w_bp = frame_in(11); const float* w_out = frame_in(12); const float* w_gu = frame_in(17); const float* w_d = frame_in(19);
    bf16* Win_t = (bf16*)(F.ws + WS_WIN); bf16* Wpb_t = (bf16*)(F.ws + WS_WPB); bf16* Wout_t = (bf16*)(F.ws + WS_WOUT);
    bf16* Wgu_t = (bf16*)(F.ws + WS_WGU); bf16* Wd_t = (bf16*)(F.ws + WS_WD); float* MOD = (float*)(F.ws + WS_MOD);
    for (int cg = blockIdx.x; cg < 256; cg += F.G) {
        LAS float* cs = (LAS float*)(F.lds + 69632); LAS float* red = (LAS float*)(F.lds + 69632 + 32768);
        for (int i = F.tid; i < 8192; i += 512) { const float v = c[i]; cs[i] = v / (1.f + __expf(-v)); }
        __syncthreads();
        float acc[8] = {0, 0, 0, 0, 0, 0, 0, 0}; const int cc = F.lane & 31, rp = F.lane >> 5; const bool act = cc < 24; const float* wp = w_ada + cg * 24 + (act ? cc : 0);
#pragma unroll 16
        for (int i = 0; i < 64; ++i) { const int k = F.wave * 128 + 2 * i + rp; float w = __builtin_nontemporal_load(wp + (size_t)k * 6144); w = act ? w : 0.f;
#pragma unroll
            for (int b = 0; b < 8; ++b) acc[b] += cs[b * 1024 + k] * w; }
#pragma unroll
        for (int b = 0; b < 8; ++b) red[((F.wave * 2 + rp) * 8 + b) * 32 + cc] = acc[b];
        __syncthreads();
        if (F.tid < 256) { const int b = F.tid >> 5, l = F.tid & 31; if (l < 24) { float s = 0.f;
#pragma unroll
            for (int w = 0; w < 16; ++w) s += red[(w * 8 + b) * 32 + l];
            MOD[b * 6144 + cg * 24 + l] = s + b_ada[cg * 24 + l]; } }
        __syncthreads();
    }
    LAS unsigned char* scr8 = F.lds + F.wave * 8448; LAS float* scr = (LAS float*)scr8;
    const int gw = F.vcu * NWAVES + F.wave, NGW = F.G * NWAVES;
    constexpr int I_FQ = 64  , I_FO = 64  , I_FP = 1024, I_Z = 56, I_WI = 16, I_WR = 64, NSMALL = I_FQ + I_FO + I_FP + I_Z + I_WI + I_WR;
    for (int it = gw; it < NSMALL; it += NGW) {
        int r = it;
        if (r < I_FQ) {
            bf16* WukB = (bf16*)(F.ws + WS_WUKB); const int h = r >> 3, rr = (r & 7) * 16 + (F.lane >> 2), dc = F.lane & 3; const float* sp = w_uk + (size_t)rr * 512 + h * 64 + dc * 16;
            const f32x4 a = *(const f32x4*)sp, b = *(const f32x4*)(sp + 4), c4 = *(const f32x4*)(sp + 8), d4 = *(const f32x4*)(sp + 12);
            GAS v4u* dp = (GAS v4u*)(WukB + (size_t)(h * 128 + rr) * 64 + dc * 16);
            dp[0] = (v4u){pkbf(a.x, a.y), pkbf(a.z, a.w), pkbf(b.x, b.y), pkbf(b.z, b.w)}; dp[1] = (v4u){pkbf(c4.x, c4.y), pkbf(c4.z, c4.w), pkbf(d4.x, d4.y), pkbf(d4.z, d4.w)};
            continue; } r -= I_FQ;
        if (r < I_FO) {
            bf16* WuvT = (bf16*)(F.ws + WS_WUVT); const int h = r >> 3, dp = (r & 7) * 8 + (F.lane >> 3), c0 = (F.lane & 7) * 2;
#pragma unroll
            for (int cc = 0; cc < 2; ++cc) { const int cidx = c0 + cc, ks = cidx >> 1, hh = cidx & 1; float v[8];
#pragma unroll
                for (int j = 0; j < 8; ++j) v[j] = w_uv[(size_t)(16 * ks + 8 * (j >> 2) + 4 * hh + (j & 3)) * 512 + h * 64 + dp];
                *(GAS v4u*)(WuvT + (size_t)(h * 64 + dp) * 128 + cidx * 8) = (v4u){pkbf(v[0], v[1]), pkbf(v[2], v[3]), pkbf(v[4], v[5]), pkbf(v[6], v[7])}; }
            continue; } r -= I_FO;
        if (r < I_FP) { fold_pb(w_pg, pscale, w_bp, Wpb_t, r, F.lane); continue; } r -= I_FP;
        if (r < I_Z) { *(GAS v4u*)(Win_t + bl_off(1224 + r, F.lane * 8, 1024)) = (v4u){0u, 0u, 0u, 0u}; *(GAS v4u*)(Win_t + bl_off(1224 + r, (F.lane + 64) * 8, 1024)) = (v4u){0u, 0u, 0u, 0u}; continue; } r -= I_Z;
        if (r < I_WI) { tr_item(w_in, INC, r * 64, O_WI, 8, 0.35355339059327373f, Win_t, 1024, 1216, scr, F.lane); continue; } r -= I_WI;
        {
            const float* w_r = frame_in(15); bf16* WrB = (bf16*)(F.ws + WS_WRB); const int ks = r, e = F.lane & 31, h8 = F.lane >> 5; float v[8]; unsigned hi[4], lo[4];
#pragma unroll
            for (int j = 0; j < 8; ++j) v[j] = w_r[(size_t)(16 * ks + 8 * h8 + j) * 32 + e];
#pragma unroll
            for (int j = 0; j < 4; ++j) { hi[j] = pkbf(v[2 * j], v[2 * j + 1]); lo[j] = pkbf(v[2 * j] - __uint_as_float(hi[j] << 16), v[2 * j + 1] - __uint_as_float(hi[j] & 0xffff0000u)); }
            *(GAS v4u*)(WrB + ((size_t)(ks * 2) * 64 + F.lane) * 8) = (v4u){hi[0], hi[1], hi[2], hi[3]}; *(GAS v4u*)(WrB + ((size_t)(ks * 2 + 1) * 64 + F.lane) * 8) = (v4u){lo[0], lo[1], lo[2], lo[3]}; }
    }
    constexpr int I_Q = 128, I_QI = 128, I_CKV = 32, I_KI = 16, I_U = 128, I_G = 512, I_OUT = 256, I_BA = 128, I_GU = 32 * 512, I_D = 32 * 256;
    constexpr int NTR = I_Q + I_QI + I_CKV + I_KI + I_U + I_G + I_OUT + I_BA + (VAR >= 1 ? 0 : I_GU + I_D);
    auto decode = [&](int r) -> TrDesc {
        if (r < I_Q) return TrDesc{w_in + (size_t)((r >> 3) * 64) * INC + O_Q + (r & 7) * 64, Win_t + bl_off((r & 7) * 64, (r >> 3) * 64, 1024), INC, 0.125f * LOG2E, 0, 0}; r -= I_Q;
        if (r < I_QI) return TrDesc{w_in + (size_t)((r >> 3) * 64) * INC + O_QI + (r & 7) * 64, Win_t + bl_off(512 + (r & 7) * 64, (r >> 3) * 64, 1024), INC, 0.125f, 0, 0}; r -= I_QI;
        if (r < I_CKV) return TrDesc{w_in + (size_t)((r >> 1) * 64) * INC + O_CKV + (r & 1) * 64, Win_t + bl_off(1024 + (r & 1) * 64, (r >> 1) * 64, 1024), INC, 1.f, 0, 0}; r -= I_CKV;
        if (r < I_KI) return TrDesc{w_in + (size_t)(r * 64) * INC + O_KI, Win_t + bl_off(1152, r * 64, 1024), INC, 1.f, 0, 0}; r -= I_KI;
        if (r < I_U) return TrDesc{w_in + (size_t)((r >> 3) * 64) * INC + O_U + (r & 7) * 64, Win_t + bl_off(1280 + (r & 7) * 64, (r >> 3) * 64, 1024), INC, 1.f, 0, 0}; r -= I_U;
        if (r < I_G) return TrDesc{w_in + (size_t)((r >> 5) * 64) * INC + O_G + (r & 31) * 64, Win_t + bl_off(1792 + (r & 31) * 64, (r >> 5) * 64, 1024), INC, 1.f, 0, 0}; r -= I_G;
        if (r < I_OUT) return TrDesc{w_out + (size_t)((r >> 4) * 64) * 1024 + (r & 15) * 64, Wout_t + bl_off((r & 15) * 64, (r >> 4) * 64, 1024), 1024, 1.f, 0, 0}; r -= I_OUT;
        if (r < I_BA) return TrDesc{w_ba + (size_t)((r >> 4) * 64) * 1024 + (r & 15) * 64, (bf16*)(F.ws + WS_WBA) + bl_off((r & 15) * 64, (r >> 4) * 64, 512), 1024, 1.f, 0, 0}; r -= I_BA;
        if (r < I_GU) { const int e = r >> 9, q = r & 511, kb = q >> 5, n0 = (q & 31) * 64;
            const int drow = (n0 < 1024) ? ((n0 >> 7) * 256 + (n0 & 127)) : (((n0 - 1024) >> 7) * 256 + 128 + ((n0 - 1024) & 127));
            return TrDesc{w_gu + ((size_t)e * 1024 + kb * 64) * 2048 + n0, Wgu_t + bl_off(e * 2048 + drow, kb * 32, 512), 2048, W8_GU, 1, 0}; } r -= I_GU;
        { const int e = r >> 8, q = r & 255, kb = q >> 4, n0 = (q & 15) * 64;
          return TrDesc{w_d + ((size_t)e * 1024 + kb * 64) * 1024 + n0, Wd_t + bl_off(e * 1024 + n0, kb * 32, 512), 1024, W8_D, 1, 0}; }
    };
    {   f32x4 vA[16], vB[16]; TrDesc dA, dB; int it = gw;
        if (it < NTR) { dA = decode(it); tr_load(dA, F.lane, vA); }
        while (it < NTR) {
            int itn = it + NGW; if (itn < NTR) { dB = decode(itn); tr_load(dB, F.lane, vB); }
            tr_finish(dA, scr8, F.lane, vA);
            it = itn; if (it >= NTR) break;
            itn = it + NGW; if (itn < NTR) { dA = decode(itn); tr_load(dA, F.lane, vA); }
            tr_finish(dB, scr8, F.lane, vB);
            it = itn;
        }
    }
}
__device__ __forceinline__ void p1_modulate(Frame& F) {
    const float* x = frame_in(0); const float* MOD = (const float*)(F.ws + WS_MOD); bf16* H = (bf16*)(F.ws + WS_H);
    const int gw = F.vcu * NWAVES + F.wave, NGW = F.G * NWAVES;
    for (int m = gw; m < T; m += NGW) { const int b = m >> 11;
        const GAS f32x4* xr = (const GAS f32x4*)(x + (size_t)m * D) + F.lane;
#pragma unroll
        for (int j = 0; j < 4; ++j) { const f32x4 v = xr[64 * j]; const int col = 4 * F.lane + 256 * j;
            const f32x4 sh = *(const f32x4*)(MOD + b * 6144 + col), sc = *(const f32x4*)(MOD + b * 6144 + 1024 + col);
            const f32x4 h = v * (sc + 1.0f) + sh;
            *(GAS unsigned long long*)(H + bl_off(m, col, D)) = (unsigned long long)pk2(h.x, h.y) | ((unsigned long long)pk2(h.z, h.w) << 32); }
    }
}
constexpr int MOE_TAB_SLOTS = 10, LC_ROWTAB = LDSCTL_OFF + 8192;
constexpr int LC_LCNT = LDSCTL_OFF + 1024, LC_BASE = LDSCTL_OFF + 1280, LC_TSTART = LDSCTL_OFF + 1536, LC_LIST = LDSCTL_OFF + 4096;
namespace pg8 {
__device__ __forceinline__ float bfl(unsigned w) { return __uint_as_float(w << 16); }
__device__ __forceinline__ float bfh(unsigned w) { return __uint_as_float(w & 0xffff0000u); }
struct EpiGateMul {
    static constexpr bool PERM = true, AFTER_DRAIN = false;
    bf16_t* O; const bf16_t* SG; int goff, pad;
    __device__ __forceinline__ void operator()(const f32x4 (&acc)[2][2][4][2], const Unit& u, int wr, int wc, int fr_, int fq_) const {
        int fr = fr_, fq = fq_; asm volatile("" : "+v"(fr), "+v"(fq));
        const int row0 = u.pm * BM + wr * 64 + fr, col0 = u.pn * BM + wc * 32 + 8 * fq;
#pragma unroll
        for (int ai = 0; ai < 2; ++ai)
#pragma unroll
            for (int m = 0; m < 4; ++m) { const size_t row = (size_t)(row0 + ai * HALF + m * 16);
#pragma unroll
                for (int bj = 0; bj < 2; ++bj) { const u32x4 g = *(const u32x4*)(SG + row * 2048 + goff + col0 + bj * HALF); const f32x4 v0 = acc[ai][bj][m][0], v1 = acc[ai][bj][m][1];
                    u32x4 w; w.x = cvt_pk_bf16(v0[0] * bfl(g.x), v0[1] * bfh(g.x)); w.y = cvt_pk_bf16(v0[2] * bfl(g.y), v0[3] * bfh(g.y));
                    w.z = cvt_pk_bf16(v1[0] * bfl(g.z), v1[1] * bfh(g.z)); w.w = cvt_pk_bf16(v1[2] * bfl(g.w), v1[3] * bfh(g.w));
                    *(u32x4*)(O + row * 1024 + col0 + bj * HALF) = w; } }
    }
};
struct EpiGateAdd {
    static constexpr bool PERM = true, AFTER_DRAIN = false;
    bf16_t* O; const bf16_t* TMPB; const bf16_t* SG; int goff, pad;
    __device__ __forceinline__ void operator()(const f32x4 (&acc)[2][2][4][2], const Unit& u, int wr, int wc, int fr_, int fq_) const {
        int fr = fr_, fq = fq_; asm volatile("" : "+v"(fr), "+v"(fq));
        const int row0 = u.pm * BM + wr * 64 + fr, col0 = u.pn * BM + wc * 32 + 8 * fq;
#pragma unroll
        for (int ai = 0; ai < 2; ++ai)
#pragma unroll
            for (int m = 0; m < 4; ++m) { const size_t row = (size_t)(row0 + ai * HALF + m * 16);
#pragma unroll
                for (int bj = 0; bj < 2; ++bj) { const u32x4 g = *(const u32x4*)(SG + row * 2048 + goff + col0 + bj * HALF); const u32x4 t = *(const u32x4*)(TMPB + row * 1024 + col0 + bj * HALF);
                    const f32x4 v0 = acc[ai][bj][m][0], v1 = acc[ai][bj][m][1];
                    u32x4 w; w.x = cvt_pk_bf16(bfl(t.x) + v0[0] * bfl(g.x), bfh(t.x) + v0[1] * bfh(g.x)); w.y = cvt_pk_bf16(bfl(t.y) + v0[2] * bfl(g.y), bfh(t.y) + v0[3] * bfh(g.y));
                    w.z = cvt_pk_bf16(bfl(t.z) + v1[0] * bfl(g.z), bfh(t.z) + v1[1] * bfh(g.z)); w.w = cvt_pk_bf16(bfl(t.w) + v1[2] * bfl(g.w), bfh(t.w) + v1[3] * bfh(g.w));
                    *(u32x4*)(O + bl_off((int)row, col0 + bj * HALF, 1024)) = w; } }
    }
};
struct EpiResid {
    static constexpr bool PERM = false, AFTER_DRAIN = false;
    float* Z; const float* x; const float* gate;
    __device__ __forceinline__ void operator()(const f32x4 (&acc)[2][2][4][2], const Unit& u, int wr, int wc, int fr_, int fq_) const {
        int fr = fr_, fq = fq_; asm volatile("" : "+v"(fr), "+v"(fq));
        const int row0 = u.pm * BM + wr * 64 + fr, col0 = u.pn * BM + wc * 32 + 4 * fq; const int b = (u.pm * BM) >> 11;
        f32x4 gv[2][2];
#pragma unroll
        for (int bj = 0; bj < 2; ++bj)
#pragma unroll
            for (int n = 0; n < 2; ++n) gv[bj][n] = *(const f32x4*)(gate + b * 6144 + col0 + bj * HALF + n * 16);
#pragma unroll
        for (int ai = 0; ai < 2; ++ai)
#pragma unroll
            for (int m = 0; m < 4; ++m) { const size_t off = (size_t)(row0 + ai * HALF + m * 16) * 1024 + col0;
#pragma unroll
                for (int bj = 0; bj < 2; ++bj)
#pragma unroll
                    for (int n = 0; n < 2; ++n) { const f32x4 xv = *(const f32x4*)(x + off + bj * HALF + n * 16); *(f32x4*)(Z + off + bj * HALF + n * 16) = xv * ALPHA + gv[bj][n] * acc[ai][bj][m][n]; } }
    }
};
struct EpiSwiglu {
    static constexpr bool PERM = true, AFTER_DRAIN = false;
    bf16_t* ACT; const float* bgu;
    __device__ __forceinline__ void operator()(const f32x4 (&acc)[2][2][4][2], const Unit& u, int wr, int wc, int fr_, int fq_) const {
        int fr = fr_, fq = fq_; asm volatile("" : "+v"(fr), "+v"(fq));
        const int e = u.pn >> 3, j = u.pn & 7; const int row0 = u.pm * BM + wr * 64 + fr, cc = wc * 32 + 8 * fq;
        const float* bg = bgu + e * 2048 + j * 128 + cc; f32x4 bgl[2], bli[2];
#pragma unroll
        for (int n = 0; n < 2; ++n) { bgl[n] = *(const f32x4*)(bg + 4 * n); bli[n] = *(const f32x4*)(bg + 1024 + 4 * n); }
#pragma unroll
        for (int ai = 0; ai < 2; ++ai)
#pragma unroll
            for (int m = 0; m < 4; ++m) { float o[8];
#pragma unroll
                for (int n = 0; n < 2; ++n) { const f32x4 gl4 = acc[ai][0][m][n] * (1.f / (A8_H * W8_GU)) + bgl[n], li4 = acc[ai][1][m][n] * (1.f / (A8_H * W8_GU)) + bli[n];
#pragma unroll
                    for (int i = 0; i < 4; ++i) { const float gl = fminf(gl4[i], 7.f), li = fminf(fmaxf(li4[i], -7.f), 7.f);
                        o[4 * n + i] = gl * __builtin_amdgcn_rcpf(1.f + __builtin_amdgcn_exp2f(gl * (-1.702f * LOG2E))) * fmaf(li, A8_ACT, A8_ACT); } }
                unsigned w0 = __builtin_amdgcn_cvt_pk_fp8_f32(o[0], o[1], 0u, false); w0 = __builtin_amdgcn_cvt_pk_fp8_f32(o[2], o[3], w0, true);
                unsigned w1 = __builtin_amdgcn_cvt_pk_fp8_f32(o[4], o[5], 0u, false); w1 = __builtin_amdgcn_cvt_pk_fp8_f32(o[6], o[7], w1, true);
                *(unsigned long long*)(ACT + bl_off(row0 + ai * HALF + m * 16, (j * 128 + cc) >> 1, 512)) = (unsigned long long)w0 | ((unsigned long long)w1 << 32); }
    }
};
template <bool BIAS>
struct EpiDownT {
    static constexpr bool PERM = true, AFTER_DRAIN = false;
    bf16_t* Y; const float* bd;
    __device__ __forceinline__ void operator()(const f32x4 (&acc)[2][2][4][2], const Unit& u, int wr, int wc, int fr_, int fq_) const {
        int fr = fr_, fq = fq_; asm volatile("" : "+v"(fr), "+v"(fq));
        const int e = u.pn >> 2, j = u.pn & 3; const int row0 = u.pm * BM + wr * 64 + fr, col0 = j * 256 + wc * 32 + 8 * fq;
        f32x4 bv[2][2];
#pragma unroll
        for (int bj = 0; bj < 2; ++bj)
#pragma unroll
            for (int n = 0; n < 2; ++n) bv[bj][n] = BIAS ? *(const f32x4*)(bd + e * 1024 + col0 + bj * HALF + 4 * n) : (f32x4){0.f, 0.f, 0.f, 0.f};
#pragma unroll
        for (int ai = 0; ai < 2; ++ai)
#pragma unroll
            for (int m = 0; m < 4; ++m) { bf16_t* rowp = Y + (size_t)(row0 + ai * HALF + m * 16) * 1024 + col0;
#pragma unroll
                for (int bj = 0; bj < 2; ++bj) { const f32x4 v0 = acc[ai][bj][m][0] * (1.f / (A8_ACT * W8_D)) + bv[bj][0], v1 = acc[ai][bj][m][1] * (1.f / (A8_ACT * W8_D)) + bv[bj][1];
                    u32x4 w; w.x = cvt_pk_bf16(v0[0], v0[1]); w.y = cvt_pk_bf16(v0[2], v0[3]); w.z = cvt_pk_bf16(v1[0], v1[1]); w.w = cvt_pk_bf16(v1[2], v1[3]);
                    *(u32x4*)(rowp + bj * HALF) = w; } }
    }
};
typedef EpiDownT<true> EpiDown;
template <bool GATHER_, bool REV = false>
struct MoeOrderT {
    static constexpr bool GATHER = GATHER_;
    const PG8_LAS int* tstart; int NT, G, c;
    const PG8_LAS int* rowtab; const int* slotmap; const int* cnt;
    __device__ __forceinline__ int arow(int slot, const Unit& u, int r) const {
        if (slot < MOE_TAB_SLOTS) return rowtab[slot * 256 + r];
        const int e = u.pn / NT, rank = (u.pm - tstart[e]) * 256 + r; return rank < cnt[e] ? slotmap[e * T + rank] : 0;
    }
    __device__ __forceinline__ bool next(int i, Unit& u) const {
        const int x = c & 7, li = c >> 3, per = G >> 3; int L = i * per + li;
#pragma unroll 1
        for (int j = 0; j < 4; ++j) { const int e = REV ? x + 8 * (3 - j) : x + 8 * j; const int nte = tstart[e + 1] - tstart[e], nu = nte * NT;
            if (L < nu) { u.pm = tstart[e] + L % nte; u.pn = e * NT + L / nte; return true; }
            L -= nu; }
        return false;
    }
    __device__ __forceinline__ void a_ready(const Unit&) const {}
    __device__ __forceinline__ void done(const Unit&) const {}
};
typedef MoeOrderT<true> MoeOrderG; typedef MoeOrderT<false, true> MoeOrder;
}

__device__ __forceinline__ float wave_sum(float v) {
#pragma unroll
    for (int o = 1; o < 64; o <<= 1) v += __shfl_xor(v, o);
    return v;
}
__device__ __forceinline__ void p3_post(Frame& F) {
    const float* MISC = (const float*)(F.ws + WS_MISC); const float* kvg = frame_in(5); bf16* CKV = (bf16*)(F.ws + WS_CKV); bf16* CKVT = (bf16*)(F.ws + WS_CKVT);
    const bf16* U = (const bf16*)(F.ws + WS_U); bf16* POOLED = (bf16*)(F.ws + WS_POOLED);
    LAS bf16* tile = (LAS bf16*)(F.lds);
    for (int task = blockIdx.x; task < 256; task += F.G) {
        const int t0 = task * 64; const int row = F.tid >> 3, seg = F.tid & 7;
        const float* src = MISC + (size_t)(t0 + row) * 256 + seg * 16; f32x4 v[4]; float ss = 0.f;
#pragma unroll
        for (int i = 0; i < 4; ++i) { v[i] = *(const f32x4*)(src + 4 * i); ss += (v[i].x * v[i].x + v[i].y * v[i].y) + (v[i].z * v[i].z + v[i].w * v[i].w); }
        ss += __shfl_xor(ss, 1); ss += __shfl_xor(ss, 2); ss += __shfl_xor(ss, 4);
        const float rs = 1.0f / sqrtf(ss * (1.f / 128.f) + LN_EPS);
        unsigned w[8];
#pragma unroll
        for (int i = 0; i < 4; ++i) { const f32x4 g = *(const f32x4*)(kvg + seg * 16 + 4 * i); w[2 * i] = pk2(v[i].x * rs * g.x, v[i].y * rs * g.y); w[2 * i + 1] = pk2(v[i].z * rs * g.z, v[i].w * rs * g.w); }
        GAS v4u* dst = (GAS v4u*)(CKV + (size_t)(t0 + row) * 128 + seg * 16); dst[0] = (v4u){w[0], w[1], w[4], w[5]}; dst[1] = (v4u){w[2], w[3], w[6], w[7]};
        LAS v4u* lt = (LAS v4u*)(tile + row * 128 + seg * 16); lt[0] = (v4u){w[0], w[1], w[2], w[3]}; lt[1] = (v4u){w[4], w[5], w[6], w[7]};
        __syncthreads();
        { const int d = F.tid >> 2, part = F.tid & 3; unsigned o[8];
#pragma unroll
          for (int q = 0; q < 16; q += 2) { unsigned pr[2];
#pragma unroll
              for (int z = 0; z < 2; ++z) { const int p = part * 16 + q + z; const int j = p & 7, h = (p >> 3) & 1, tt = (p >> 4) & 1, kb = p >> 5; const int key = kb * 32 + 16 * tt + 8 * (j >> 2) + 4 * h + (j & 3); pr[z] = tile[key * 128 + d]; }
              o[q >> 1] = pr[0] | (pr[1] << 16); }
          const int b = task >> 5, kt = task & 31;
          GAS v4u* dt = (GAS v4u*)(CKVT + ((size_t)(b * 128 + d) * 2048) + kt * 64 + part * 16); dt[0] = (v4u){o[0], o[1], o[2], o[3]}; dt[1] = (v4u){o[4], o[5], o[6], o[7]}; }
        __syncthreads();
    }
    LAS bf16* ut = (LAS bf16*)(F.lds + 16384);
    for (int task = blockIdx.x; task < 256; task += F.G) { const int t0 = task * 64, s0 = t0 & 2047;
        __syncthreads();
#pragma unroll
        for (int i = 0; i < 10; ++i) { const int c = F.tid + 512 * i, row = c >> 6, ch = c & 63; const int sp = s0 - 16 + row;
            v4u v = (v4u){0u, 0u, 0u, 0u}; if (sp >= 0) v = *(const GAS v4u*)(U + (size_t)(t0 - 16 + row) * 512 + ch * 8);
            *(LAS v4u*)(ut + row * 512 + ch * 8) = v; }
        __syncthreads();
        const int c = F.tid, g = c >> 7, w = 2 << g; float win = 0.f;
        for (int j = 16 - w; j < 16; ++j) win += bf2f(ut[j * 512 + c]);
        for (int j = 16; j < 80; ++j) { const float cur = bf2f(ut[j * 512 + c]); win += cur; win -= bf2f(ut[(j - w) * 512 + c]);
            const int sq = s0 + j - 16; const int cntw = (sq + 1 < w) ? (sq + 1) : w; POOLED[bl_off(t0 + j - 16, c, 512)] = (bf16)f2bf(win / (float)cntw - cur); }
    }
}
constexpr int P7_AL = 0, P7_LOGIT = 131072 - 4096;
__device__ __forceinline__ void p7_ln1_route(Frame& F, int cw_gcnt) {
    const float* Z = (const float*)(F.ws + WS_Z); const float* g1 = frame_in(13); const float* b1 = frame_in(14); const float* b_r = frame_in(16);
    const float* MOD = (const float*)(F.ws + WS_MOD); float* X1 = (float*)(F.ws + WS_X1); bf16* H2 = (bf16*)(F.ws + WS_H); const bf16* WrB = (const bf16*)(F.ws + WS_WRB);
    int* gcnt = (int*)(F.ctl + cw_gcnt); int* SLOTMAP = (int*)(F.ws + WS_SLOTMAP); int* TOKSLOT = (int*)(F.ws + WS_TOKSLOT); float* GATE = (float*)(F.ws + WS_GATE);
    LAS unsigned char* AL = F.lds + P7_AL; LAS float* red = (LAS float*)(F.lds);
    LAS float* logit = (LAS float*)(F.lds + 65536);
    LAS int* lcnt = (LAS int*)(F.lds + LC_LCNT); LAS int* lbase = (LAS int*)(F.lds + LC_BASE); LAS int* list = (LAS int*)(F.lds + LC_LIST);
    if (F.tid < 32) lcnt[F.tid] = 0;
    const int hh = F.lane >> 5, l31 = F.lane & 31;
    bf16x8 Bh[8], Bl[8];
#pragma unroll
    for (int s = 0; s < 8; ++s) { const bf16* p = WrB + ((size_t)((F.wave * 8 + s) * 2) * 64 + F.lane) * 8; Bh[s] = *(const GAS bf16x8*)p; Bl[s] = *(const GAS bf16x8*)(p + 64 * 8); }
    const int rows_per_wg = T / F.G;
    for (int step = 0; step < rows_per_wg / 32; ++step) { const int m0 = blockIdx.x * rows_per_wg + step * 32;
        __syncthreads();
#pragma unroll 1
        for (int rr = 0; rr < 4; ++rr) { const int row = F.wave * 4 + rr, m = m0 + row, b = m >> 11;
            const GAS f32x4* zr = (const GAS f32x4*)(Z + (size_t)m * D) + F.lane; f32x4 v[4]; float s = 0.f;
#pragma unroll
            for (int j = 0; j < 4; ++j) { v[j] = zr[64 * j]; s += (v[j].x + v[j].y) + (v[j].z + v[j].w); }
            const float mean = wave_sum(s) * (1.f / D); float s2 = 0.f;
#pragma unroll
            for (int j = 0; j < 4; ++j) { v[j] = v[j] - mean; s2 += (v[j].x * v[j].x + v[j].y * v[j].y) + (v[j].z * v[j].z + v[j].w * v[j].w); }
            const float rstd = 1.f / sqrtf(wave_sum(s2) * (1.f / D) + LN_EPS);
#pragma unroll
            for (int j = 0; j < 4; ++j) { const int col = 4 * F.lane + 256 * j;
                const f32x4 gg = *(const f32x4*)(g1 + col), bb = *(const f32x4*)(b1 + col); const f32x4 x1 = v[j] * rstd * gg + bb;
                *((GAS f32x4*)(X1 + (size_t)m * D) + F.lane + 64 * j) = x1;
                const f32x4 sh = *(const f32x4*)(MOD + b * 6144 + 3 * 1024 + col), sc = *(const f32x4*)(MOD + b * 6144 + 4 * 1024 + col); const f32x4 h2 = x1 * (sc + 1.0f) + sh;
                const unsigned h01 = pkbf(h2.x, h2.y), h23 = pkbf(h2.z, h2.w);
                { unsigned r8 = __builtin_amdgcn_cvt_pk_fp8_f32(clamp8(h2.x * A8_H), clamp8(h2.y * A8_H), 0u, false); r8 = __builtin_amdgcn_cvt_pk_fp8_f32(clamp8(h2.z * A8_H), clamp8(h2.w * A8_H), r8, true);
                  *(GAS unsigned*)(H2 + bl_off(m, col >> 1, D / 2)) = r8; }
                const unsigned l01 = pkbf(h2.x - pg8::bfl(h01), h2.y - pg8::bfh(h01)), l23 = pkbf(h2.z - pg8::bfl(h23), h2.w - pg8::bfh(h23));
                const int chunk = 32 * j + (F.lane >> 1); const int off = row * 2048 + (((chunk & ~15) | ((chunk ^ row) & 15)) << 4) + (F.lane & 1) * 8;
                *(LAS unsigned long long*)(AL + off) = (unsigned long long)h01 | ((unsigned long long)h23 << 32);
                *(LAS unsigned long long*)(AL + 65536 + off) = (unsigned long long)l01 | ((unsigned long long)l23 << 32); } }
        __syncthreads();
        f32x16 acc;
#pragma unroll
        for (int r = 0; r < 16; ++r) acc[r] = 0.f;
#pragma unroll
        for (int s = 0; s < 8; ++s) { const int chunk = 2 * (F.wave * 8 + s) + hh; const int off = l31 * 2048 + (((chunk & ~15) | ((chunk ^ l31) & 15)) << 4);
            const bf16x8 Ah = *(const LAS bf16x8*)(AL + off), Alo = *(const LAS bf16x8*)(AL + 65536 + off);
            acc = MFMA32(Ah, Bh[s], acc); acc = MFMA32(Ah, Bl[s], acc); acc = MFMA32(Alo, Bh[s], acc); }
        __syncthreads();
#pragma unroll
        for (int r = 0; r < 16; ++r) red[(F.wave * 32 + krow16(r, hh)) * 32 + l31] = acc[r];
        __syncthreads();
        { const int row = F.tid >> 4, e0 = (F.tid & 15) * 2; float s0 = 0.f, s1 = 0.f;
#pragma unroll
          for (int w = 0; w < 8; ++w) { s0 += red[(w * 32 + row) * 32 + e0]; s1 += red[(w * 32 + row) * 32 + e0 + 1]; }
          logit[row * 33 + e0] = s0 + b_r[e0]; logit[row * 33 + e0 + 1] = s1 + b_r[e0 + 1]; }
        __syncthreads();
        if (F.tid < 32) { const int row = F.tid, m = m0 + row; float lg[32];
#pragma unroll
            for (int e = 0; e < 32; ++e) lg[e] = logit[row * 33 + e];
            int se[4]; float sv[4]; unsigned used = 0u;
#pragma unroll
            for (int k = 0; k < 4; ++k) { int best = 0; float bv = -INFINITY; bool have = false;
#pragma unroll
                for (int e = 0; e < 32; ++e) { const bool ok = !((used >> e) & 1u) && (!have || lg[e] > bv); if (ok) { best = e; bv = lg[e]; have = true; } }
                se[k] = best; sv[k] = bv; used |= 1u << best; }
            float ex[4], den = 0.f;
#pragma unroll
            for (int k = 0; k < 4; ++k) { ex[k] = __expf(sv[k] - sv[0]); den += ex[k]; }
            const float inv = 1.f / den;
#pragma unroll
            for (int k = 0; k < 4; ++k) { const int lr = __hip_atomic_fetch_add(&lcnt[se[k]], 1, __ATOMIC_RELAXED, __HIP_MEMORY_SCOPE_WORKGROUP);
                LAS int* ent = list + ((step * 32 + row) * 4 + k) * 4; ent[0] = m; ent[1] = se[k]; ent[2] = lr; ent[3] = __float_as_int(ex[k] * inv); } }
    }
    __syncthreads();
    if (F.tid < 32) lbase[F.tid] = atomicAdd(&gcnt[F.tid], lcnt[F.tid]);
    __syncthreads();
    if (F.tid < 256) { LAS int* ent = list + F.tid * 4; const int m = ent[0], e = ent[1], rank = lbase[e] + ent[2];
        SLOTMAP[e * T + rank] = m; TOKSLOT[m * 4 + (F.tid & 3)] = e | (rank << 8); GATE[m * 4 + (F.tid & 3)] = __int_as_float(ent[3]); }
}
__device__ __forceinline__ void load_tstart(Frame& F) {
    LAS int* ts = (LAS int*)(F.lds + LC_TSTART); const int* gcnt = (const int*)(F.ctl + CW_GCNT);
    if (F.tid == 0) { int a = 0; for (int e = 0; e < 32; ++e) { ts[e] = a; a += (__hip_atomic_load(gcnt + e, __ATOMIC_RELAXED, __HIP_MEMORY_SCOPE_AGENT) + 255) >> 8; } ts[32] = a; }
    __syncthreads();
}
__device__ __forceinline__ void warm_range(Frame& F, const unsigned char* base, size_t bytes) {
    const size_t per = bytes / (size_t)F.G; const GAS v4u* p = (const GAS v4u*)(base + per * (size_t)blockIdx.x) + F.tid; const int n = (int)(per / (512 * 16));
    v4u acc = (v4u){0u, 0u, 0u, 0u};
#pragma unroll 8
    for (int i = 0; i < n; ++i) { const v4u v = __builtin_nontemporal_load(p + (size_t)i * 512); acc.x ^= v.x; acc.y ^= v.y; acc.z ^= v.z; acc.w ^= v.w; }
    asm volatile("" :: "v"(acc.x), "v"(acc.y), "v"(acc.z), "v"(acc.w));
}
__device__ __forceinline__ void moe_fill_rowtab(Frame& F, const pg8::MoeOrderG& S) {
    LAS int* tab = (LAS int*)(F.lds + LC_ROWTAB); const LAS int* ts = (const LAS int*)(F.lds + LC_TSTART);
    for (int slot = 0; slot < MOE_TAB_SLOTS; ++slot) { pg8::Unit u; if (!S.next(slot, u)) break;
        if (F.tid < 256) { const int e = u.pn / S.NT, rank = (u.pm - ts[e]) * 256 + F.tid; tab[slot * 256 + F.tid] = rank < S.cnt[e] ? S.slotmap[e * T + rank] : 0; } }
    __syncthreads();
}
__device__ __forceinline__ void p11_final(Frame& F) {
    load_tstart(F);
    const LAS int* ts = (const LAS int*)(F.lds + LC_TSTART);
    const float* X1 = (const float*)(F.ws + WS_X1); const bf16* Y = (const bf16*)(F.ws + WS_Y); const int* TOKSLOT = (const int*)(F.ws + WS_TOKSLOT); const float* GATE = (const float*)(F.ws + WS_GATE);
    const float* MOD = (const float*)(F.ws + WS_MOD); const float* g2 = frame_in(21); const float* b2 = frame_in(22);
    const int gw = F.vcu * NWAVES + F.wave, NGW = F.G * NWAVES;
    for (int m = gw; m < T; m += NGW) { const int b = m >> 11;
        f32x4 mo[4];
#pragma unroll
        for (int j = 0; j < 4; ++j) mo[j] = (f32x4){0.f, 0.f, 0.f, 0.f};
#pragma unroll
        for (int k = 0; k < 4; ++k) { const int tsl = TOKSLOT[m * 4 + k]; const int e = tsl & 255, rank = tsl >> 8; const float gt = GATE[m * 4 + k];
            const GAS unsigned long long* yr = (const GAS unsigned long long*)(Y + ((size_t)ts[e] * 256 + rank) * D) + F.lane;
#pragma unroll
            for (int j = 0; j < 4; ++j) { const unsigned long long w = yr[64 * j]; const unsigned lo = (unsigned)w, hi = (unsigned)(w >> 32);
                mo[j].x += gt * pg8::bfl(lo); mo[j].y += gt * pg8::bfh(lo); mo[j].z += gt * pg8::bfl(hi); mo[j].w += gt * pg8::bfh(hi); } }
        f32x4 v[4]; float s = 0.f;
#pragma unroll
        for (int j = 0; j < 4; ++j) { const int col = 4 * F.lane + 256 * j; const f32x4 x1 = *((const GAS f32x4*)(X1 + (size_t)m * D) + F.lane + 64 * j);
            const f32x4 g2m = *(const f32x4*)(MOD + b * 6144 + 5 * 1024 + col); v[j] = x1 * ALPHA + g2m * mo[j]; s += (v[j].x + v[j].y) + (v[j].z + v[j].w); }
        const float mean = wave_sum(s) * (1.f / D); float s2 = 0.f;
#pragma unroll
        for (int j = 0; j < 4; ++j) { v[j] = v[j] - mean; s2 += (v[j].x * v[j].x + v[j].y * v[j].y) + (v[j].z * v[j].z + v[j].w * v[j].w); }
        const float rstd = 1.f / sqrtf(wave_sum(s2) * (1.f / D) + LN_EPS);
#pragma unroll
        for (int j = 0; j < 4; ++j) { const int col = 4 * F.lane + 256 * j; const f32x4 gg = *(const f32x4*)(g2 + col), bb = *(const f32x4*)(b2 + col);
            *((GAS f32x4*)(F.out + (size_t)m * D) + F.lane + 64 * j) = v[j] * rstd * gg + bb; }
    }
}
__device__ __forceinline__ unsigned ordkey(float f) { const unsigned u = __float_as_uint(f); return (u & 0x80000000u) ? ~u : (u | 0x80000000u); }

constexpr int SEL_QI = 0, SEL_HIST = 32768, SEL_CAND = 98304, SEL_MASK = 114688, SEL_META = 122880, SEL_CAP = 128;
__device__ __forceinline__ float relu_i(float x) { const int i = __float_as_int(x); return __int_as_float(i > 0 ? i : 0); }
__device__ __forceinline__ void idx_load_a(const bf16* KIb, int kt, int lane, bf16x8 (&A)[4]) {
    const bf16* kp = KIb + (size_t)(kt * 32 + (lane & 31)) * 64 + 8 * (lane >> 5);
#pragma unroll
    for (int s = 0; s < 4; ++s) A[s] = *(const GAS bf16x8*)(kp + 16 * s);
}
__device__ __forceinline__ void idx_scores1(const bf16x8 (&AA)[4], const LAS unsigned char* qiL, const float (&wi)[8], int lane, f32x16& scA) {
    const int hh = lane >> 5, q = lane & 31; const LAS unsigned char* qrow = qiL + q * 1024; const int qs = q & 15;
#pragma unroll
    for (int r = 0; r < 16; ++r) scA[r] = 0.f;
    f32x16 acc[2];
    { bf16x8 B0[4];
#pragma unroll
      for (int s = 0; s < 4; ++s) B0[s] = *(const LAS bf16x8*)(qrow + (((2 * s + hh) ^ qs) << 4));
#pragma unroll
      for (int r = 0; r < 16; ++r) acc[0][r] = 0.f;
#pragma unroll
      for (int s = 0; s < 4; ++s) acc[0] = MFMA32(AA[s], B0[s], acc[0]); }
#pragma unroll
    for (int h = 0; h < 8; ++h) { const int cur = h & 1, nxt = cur ^ 1;
        if (h < 7) { bf16x8 Bn[4];
#pragma unroll
            for (int s = 0; s < 4; ++s) Bn[s] = *(const LAS bf16x8*)(qrow + ((((h + 1) * 8 + 2 * s + hh) ^ qs) << 4));
#pragma unroll
            for (int r = 0; r < 16; ++r) acc[nxt][r] = 0.f;
#pragma unroll
            for (int s = 0; s < 4; ++s) acc[nxt] = MFMA32(AA[s], Bn[s], acc[nxt]); }
#pragma unroll
        for (int r = 0; r < 16; ++r) scA[r] = fmaf(wi[h], relu_i(acc[cur][r]), scA[r]);
        if (h < 7) {
            __builtin_amdgcn_sched_group_barrier(0x100, 4, 0);
#pragma unroll
            for (int i = 0; i < 4; ++i) { __builtin_amdgcn_sched_group_barrier(0x008, 1, 0); __builtin_amdgcn_sched_group_barrier(0x002, 8, 0); } }
    }
}
template <int MODE, int VAR>
__device__ __forceinline__ void sel_tile(Frame& F, const f32x16& sc, int kt, int hh, int q, int qpos, int bst, unsigned pfx, unsigned trial, unsigned& cntl) {
    LAS unsigned* hist = (LAS unsigned*)(F.lds + SEL_HIST); LAS unsigned* cand = (LAS unsigned*)(F.lds + SEL_CAND); LAS unsigned* maskL = (LAS unsigned*)(F.lds + SEL_MASK); LAS int* meta = (LAS int*)(F.lds + SEL_META);
    unsigned word = 0u; const int kbase = kt * 32 + 4 * hh; const int lim = qpos - kbase;
#pragma unroll
    for (int r = 0; r < 16; ++r) { const int kr0 = (r & 3) + 8 * (r >> 2); const bool valid = kr0 <= lim;
        const unsigned bits = __float_as_uint(sc[r]) & 0xFFFFF800u; const float st = __uint_as_float(bits);
        int bin = (int)(st * 64.f) + 256; bin = bin < 0 ? 0 : (bin > 511 ? 511 : bin);
        if (MODE == 0) { if (VAR == 1) { asm volatile("" :: "v"(bin), "v"(valid ? 1u : 0u)); } else __hip_atomic_fetch_add(hist + q * 512 + bin, valid ? 1u : 0u, __ATOMIC_RELAXED, __HIP_MEMORY_SCOPE_WORKGROUP); }
        else { const unsigned ck = (ordkey(st) & 0xFFFFF800u) | (unsigned)(2047 - kbase - kr0);
            if (MODE == 1) { word |= (valid && bin > bst) ? (1u << kr0) : 0u; const bool isc = valid && bin == bst;
                if (isc) { const int slot = __hip_atomic_fetch_add((LAS int*)meta + 64 + q, 1, __ATOMIC_RELAXED, __HIP_MEMORY_SCOPE_WORKGROUP); if (slot < SEL_CAP) cand[q * SEL_CAP + slot] = ck; } }
            if (MODE == 2) { cntl += (valid && ck >= (pfx | trial)) ? 1u : 0u; }
            if (MODE == 3) { word |= (valid && ck >= pfx) ? (1u << kr0) : 0u; } }
        }
    if (MODE == 1 || MODE == 3) __hip_atomic_fetch_or(maskL + q * 64 + kt, word << (4 * hh), __ATOMIC_RELAXED, __HIP_MEMORY_SCOPE_WORKGROUP);
}
template <int MODE, int VAR>
__device__ __forceinline__ void sel_pass(Frame& F, int lane, int wave, const bf16* KIb, int qb, const float (&wi)[8], unsigned trial) {
    const LAS unsigned char* qiL = F.lds + SEL_QI; LAS int* meta = (LAS int*)(F.lds + SEL_META);
    const int bst = meta[lane & 31]; const unsigned pfx = (unsigned)meta[128 + (lane & 31)];
    unsigned cntl = 0u;
    bf16x8 AA[4], NA[4];
    if (wave <= qb) idx_load_a(KIb, wave, lane, AA);
#pragma unroll 1
    for (int kt = wave; kt <= qb; kt += NWAVES) {
        int lane_t = lane; asm volatile("" : "+v"(lane_t));
        const int hh = lane_t >> 5, q = lane_t & 31, qpos = qb * 32 + q;
        if (kt + NWAVES <= qb) idx_load_a(KIb, kt + NWAVES, lane_t, NA);
        f32x16 scA;
        idx_scores1(AA, qiL, wi, lane_t, scA);
        if (VAR == 2) { asm volatile("" :: "v"(scA[0]), "v"(scA[7]), "v"(scA[15])); } else sel_tile<MODE, VAR>(F, scA, kt, hh, q, qpos, bst, pfx, trial, cntl);
#pragma unroll
        for (int s = 0; s < 4; ++s) AA[s] = NA[s];
    }
    if (MODE == 2) __hip_atomic_fetch_add((LAS unsigned*)meta + 160 + (lane & 31), cntl, __ATOMIC_RELAXED, __HIP_MEMORY_SCOPE_WORKGROUP);
}
template <int VAR>
__device__ __forceinline__ void p3_select(Frame& F) {
    const bf16* QI = (const bf16*)(F.ws + WS_QI); const float* MISC = (const float*)(F.ws + WS_MISC); unsigned* MASK = (unsigned*)(F.ws + WS_MASK);
    LAS unsigned* hist = (LAS unsigned*)(F.lds + SEL_HIST); LAS unsigned* cand = (LAS unsigned*)(F.lds + SEL_CAND); LAS unsigned* maskL = (LAS unsigned*)(F.lds + SEL_MASK); LAS int* meta = (LAS int*)(F.lds + SEL_META);
    const int b = blockIdx.x >> 5, ii = blockIdx.x & 31;
    for (int ui = 0; ui < 2; ++ui) { const int qb = ui ? 63 - ii : ii; const int t0 = b * S_ + qb * 32;
        int tid = F.tid; asm volatile("" : "+v"(tid)); const int lane = tid & 63; int wave = F.wave; asm volatile("" : "+s"(wave));
        if (qb < 8) {
            for (int wd = tid; wd < 2048; wd += 512) { const int q = wd >> 6, w = wd & 63, qpos = qb * 32 + q; const int rel = qpos - 32 * w;
                MASK[(size_t)(t0 + q) * 64 + w] = rel >= 31 ? 0xFFFFFFFFu : (rel < 0 ? 0u : ((2u << rel) - 1u)); }
            continue; }
        __syncthreads();
        for (int c = tid; c < 2048; c += 512) { const int q = c >> 6, c16 = c & 63; *(LAS v4u*)(F.lds + SEL_QI + q * 1024 + ((c16 ^ (q & 15)) << 4)) = *(const GAS v4u*)(QI + (size_t)(t0 + q) * 512 + c16 * 8); }
        { unsigned z = 0u; asm volatile("" : "+v"(z)); const v4u z4 = (v4u){z, z, z, z};
          for (int i = tid; i < 16384 / 4; i += 512) ((LAS v4u*)hist)[i] = z4;
          for (int i = tid; i < 2048 / 4; i += 512) ((LAS v4u*)maskL)[i] = z4; }
        if (tid < 192) meta[tid] = 0;
        float wi[8];
#pragma unroll
        for (int h = 0; h < 8; ++h) wi[h] = MISC[(size_t)(t0 + (lane & 31)) * 256 + 192 + h];
        const bf16* KIb = (const bf16*)(F.ws + WS_KI) + (size_t)b * S_ * 64;
        __syncthreads();
        sel_pass<0, VAR>(F, lane, wave, KIb, qb, wi, 0u);
        __syncthreads();
        for (int qq = 0; qq < 4; ++qq) { const int q = wave * 4 + qq; const LAS unsigned* hq = hist + q * 512; unsigned c8[8]; unsigned cs = 0u;
#pragma unroll
            for (int i = 0; i < 8; ++i) { c8[i] = hq[511 - 8 * lane - i]; cs += c8[i]; }
            unsigned incl = cs;
#pragma unroll
            for (int o = 1; o < 64; o <<= 1) { const unsigned v = __shfl_up(incl, o); if (lane >= o) incl += v; }
            const unsigned excl = incl - cs;
            if (excl < 256u && incl >= 256u) { unsigned run = excl;
#pragma unroll
                for (int i = 0; i < 8; ++i) { const unsigned before = run; run += c8[i]; if (before < 256u && run >= 256u) { meta[q] = 511 - 8 * lane - i; meta[32 + q] = (int)(256u - before); } } } }
        __syncthreads();
        sel_pass<1, VAR>(F, lane, wave, KIb, qb, wi, 0u);
        __syncthreads();
        if (tid < 32) { if (meta[64 + tid] > SEL_CAP) meta[96] = 1; }
        __syncthreads();
        if (meta[96] == 0) {
            for (int item = tid; item < 32 * SEL_CAP; item += 512) { const int q = item >> 7, i = item & (SEL_CAP - 1); const int n = meta[64 + q];
                if (i < n) { const unsigned my = cand[q * SEL_CAP + i]; int rank = 0; for (int j = 0; j < n; ++j) rank += (cand[q * SEL_CAP + j] > my) ? 1 : 0;
                    if (rank < meta[32 + q]) { const int idx = 2047 - (int)(my & 0x7FFu); __hip_atomic_fetch_or(maskL + q * 64 + (idx >> 5), 1u << (idx & 31), __ATOMIC_RELAXED, __HIP_MEMORY_SCOPE_WORKGROUP); } } }
        } else {
#pragma unroll 1
            for (int bit = 31; bit >= 0; --bit) {
                sel_pass<2, VAR>(F, lane, wave, KIb, qb, wi, 1u << bit);
                __syncthreads();
                if (tid < 32) { if ((unsigned)meta[160 + tid] >= 256u) meta[128 + tid] |= (int)(1u << bit); meta[160 + tid] = 0; }
                __syncthreads(); }
            sel_pass<3, VAR>(F, lane, wave, KIb, qb, wi, 0u);
        }
        __syncthreads();
        { const int q = tid >> 4, w4 = (tid & 15) * 4; *(GAS v4u*)(MASK + (size_t)(t0 + q) * 64 + w4) = *(const LAS v4u*)(maskL + q * 64 + w4); }
    }
}
typedef unsigned u32x2v __attribute__((ext_vector_type(2)));
constexpr int ATT_K = 0, ATT_VT = 65536;
__device__ __forceinline__ void att_load(const bf16* CKV, const bf16* CKVT, int b, int j, int tid, v4u (&st)[4]) {
#pragma unroll
    for (int i = 0; i < 2; ++i) { const int c = tid + 512 * i; st[i] = *(const GAS v4u*)(CKV + (size_t)(b * S_ + 64 * j) * 128 + c * 8); }
#pragma unroll
    for (int i = 0; i < 2; ++i) { const int c = tid + 512 * i, d = c >> 3, ch = c & 7; st[2 + i] = *(const GAS v4u*)(CKVT + (size_t)(b * 128 + d) * 2048 + 64 * j + ch * 8); }
}
__device__ __forceinline__ void att_store(LAS unsigned char* lds, int buf, int tid, const v4u (&st)[4]) {
#pragma unroll
    for (int i = 0; i < 2; ++i) { const int c = tid + 512 * i, row = c >> 4, ch = c & 15; *(LAS v4u*)(lds + ATT_K + buf * 16384 + row * 256 + ((ch ^ (row & 15)) << 4)) = st[i]; }
#pragma unroll
    for (int i = 0; i < 2; ++i) { const int c = tid + 512 * i, d = c >> 3, ch = c & 7; *(LAS v4u*)(lds + ATT_VT + buf * 16384 + d * 128 + ((ch ^ ((d >> 1) & 7)) << 4)) = st[2 + i]; }
}
__device__ __forceinline__ void att_tile(const LAS unsigned char* lds, int buf, int j, u32x2v mw, const bf16x8 (&Qf)[8], f32x16 (&O)[4], float& m_run, float& l_run, float slope2, int hh, int q, int qpos) {
    f32x16 S0, S1;
#pragma unroll
    for (int r = 0; r < 16; ++r) { S0[r] = 0.f; S1[r] = 0.f; }
    const LAS unsigned char* kb0 = lds + ATT_K + buf * 16384 + q * 256, * kb1 = kb0 + 32 * 256;
    { bf16x8 Kf[16];
#pragma unroll
      for (int s = 0; s < 8; ++s) { const int sw = ((2 * s + hh) ^ (q & 15)) << 4; Kf[2 * s] = *(const LAS bf16x8*)(kb0 + sw); Kf[2 * s + 1] = *(const LAS bf16x8*)(kb1 + sw); }
#pragma unroll
      for (int s = 0; s < 8; ++s) { S0 = MFMA32(Kf[2 * s], Qf[s], S0); S1 = MFMA32(Kf[2 * s + 1], Qf[s], S1); }
      __builtin_amdgcn_sched_group_barrier(0x100, 4, 0);
#pragma unroll
      for (int i = 0; i < 6; ++i) { __builtin_amdgcn_sched_group_barrier(0x008, 2, 0); __builtin_amdgcn_sched_group_barrier(0x100, 2, 0); }
      __builtin_amdgcn_sched_group_barrier(0x008, 4, 0); }
    const LAS unsigned char* vb = lds + ATT_VT + buf * 16384;
    const unsigned mlo = mw.x >> (4 * hh), mhi = mw.y >> (4 * hh);
    const float base0 = slope2 * (float)(64 * j + 4 * hh - qpos);
    float tmax = -INFINITY;
#pragma unroll
    for (int r = 0; r < 16; ++r) { const int kr = (r & 3) + 8 * (r >> 2);
        float s0 = S0[r] + (base0 + slope2 * (float)kr), s1 = S1[r] + (base0 + slope2 * (float)(kr + 32));
        { const int t0_ = __builtin_amdgcn_sbfe((int)mlo, kr, 1), t1_ = __builtin_amdgcn_sbfe((int)mhi, kr, 1);
          s0 = __int_as_float((__float_as_int(s0) & t0_) | ((int)0xff800000 & ~t0_)); s1 = __int_as_float((__float_as_int(s1) & t1_) | ((int)0xff800000 & ~t1_)); }
        S0[r] = s0; S1[r] = s1; tmax = fmaxf(tmax, fmaxf(s0, s1)); }
    { const auto rr = __builtin_amdgcn_permlane32_swap(__float_as_uint(tmax), __float_as_uint(tmax), false, false); tmax = fmaxf(__uint_as_float(rr[0]), __uint_as_float(rr[1])); }
    const float m_new = fmaxf(m_run, tmax), msafe = (m_new == -INFINITY) ? 0.f : m_new;
    const float alpha = __builtin_amdgcn_exp2f(m_run - msafe);
    float ps = 0.f;
#pragma unroll
    for (int r = 0; r < 16; ++r) { S0[r] = __builtin_amdgcn_exp2f(S0[r] - msafe); S1[r] = __builtin_amdgcn_exp2f(S1[r] - msafe); ps += S0[r] + S1[r]; }
    l_run = l_run * alpha + ps; m_run = m_new;
    if (__any(alpha != 1.f)) {
#pragma unroll
        for (int db = 0; db < 4; ++db)
#pragma unroll
            for (int r = 0; r < 16; ++r) O[db][r] *= alpha; }
    bf16x8 Pf[4];
    Pf[0] = pack8(S0[0], S0[1], S0[2], S0[3], S0[4], S0[5], S0[6], S0[7]); Pf[1] = pack8(S0[8], S0[9], S0[10], S0[11], S0[12], S0[13], S0[14], S0[15]);
    Pf[2] = pack8(S1[0], S1[1], S1[2], S1[3], S1[4], S1[5], S1[6], S1[7]); Pf[3] = pack8(S1[8], S1[9], S1[10], S1[11], S1[12], S1[13], S1[14], S1[15]);
    { bf16x8 Vf[16];
#pragma unroll
      for (int db = 0; db < 4; ++db) { const int d = db * 32 + q; const LAS unsigned char* vr = vb + d * 128; const int sx = (d >> 1) & 7;
#pragma unroll
          for (int c2 = 0; c2 < 4; ++c2) Vf[db * 4 + c2] = *(const LAS bf16x8*)(vr + (((c2 * 2 + hh) ^ sx) << 4)); }
#pragma unroll
      for (int db = 0; db < 4; ++db)
#pragma unroll
          for (int c2 = 0; c2 < 4; ++c2) O[db] = MFMA32(Vf[db * 4 + c2], Pf[c2], O[db]);
      __builtin_amdgcn_sched_group_barrier(0x100, 4, 0);
#pragma unroll
      for (int i = 0; i < 6; ++i) { __builtin_amdgcn_sched_group_barrier(0x008, 2, 0); __builtin_amdgcn_sched_group_barrier(0x100, 2, 0); }
      __builtin_amdgcn_sched_group_barrier(0x008, 4, 0); }
}
__device__ __forceinline__ void p4_attention(Frame& F) {
    const bf16* QL = (const bf16*)(F.ws + WS_QL); const bf16* CKV = (const bf16*)(F.ws + WS_CKV); const bf16* CKVT = (const bf16*)(F.ws + WS_CKVT);
    const unsigned* MASK = (const unsigned*)(F.ws + WS_MASK);
    const int b = blockIdx.x >> 5, ii = blockIdx.x & 31;
    for (int ui = 0; ui < 2; ++ui) { const int qb = ui ? 63 - ii : ii;
        int lane; asm volatile("v_mbcnt_lo_u32_b32 %0, -1, 0\n\tv_mbcnt_hi_u32_b32 %0, -1, %0" : "=v"(lane)); int head = F.wave; asm volatile("" : "+s"(head)); const int tid = head * 64 + lane;
        const int hh = lane >> 5, q = lane & 31; const float slope2 = __builtin_amdgcn_exp2f(-(float)(head + 1)) * LOG2E;
        const int t0 = b * S_ + qb * 32, qpos = qb * 32 + q; const int nt = (qb >> 1) + 1;
        bf16x8 Qf[8];
        {
            const bf16* WukB = (const bf16*)(F.ws + WS_WUKB); bf16x8 qB[4];
#pragma unroll
            for (int ks = 0; ks < 4; ++ks) qB[ks] = *(const GAS bf16x8*)(QL + (size_t)(t0 + q) * 512 + head * 64 + 16 * ks + 8 * hh);
#pragma unroll
            for (int rb = 0; rb < 4; ++rb) { f32x16 X;
#pragma unroll
                for (int r = 0; r < 16; ++r) X[r] = 0.f;
                const bf16* wr = WukB + (size_t)(head * 128 + rb * 32 + q) * 64 + 8 * hh;
#pragma unroll
                for (int ks = 0; ks < 4; ++ks) { const bf16x8 Aw = *(const GAS bf16x8*)(wr + 16 * ks); X = MFMA32(Aw, qB[ks], X); }
                Qf[2 * rb] = pack8(X[0], X[1], X[2], X[3], X[4], X[5], X[6], X[7]); Qf[2 * rb + 1] = pack8(X[8], X[9], X[10], X[11], X[12], X[13], X[14], X[15]); } }
#pragma unroll
        for (int s = 0; s < 8; ++s) asm volatile("" : "+v"(Qf[s]));
        f32x16 O[4];
#pragma unroll
        for (int db = 0; db < 4; ++db)
#pragma unroll
            for (int r = 0; r < 16; ++r) O[db][r] = 0.f;
        float m_run = -INFINITY, l_run = 0.f;
        v4u st[4];
        __syncthreads();
        att_load(CKV, CKVT, b, 0, tid, st); att_store(F.lds, 0, tid, st);
        att_load(CKV, CKVT, b, nt > 1 ? 1 : 0, tid, st); att_store(F.lds, 1, tid, st);
        __syncthreads();
        const unsigned* mrow = MASK + (size_t)(t0 + q) * 64;
        for (int j0 = 0; j0 < nt; j0 += 2) { const int j1 = j0 + 1; const bool has1 = j1 < nt; const int last = nt - 1;
            const u32x2v mw0 = *(const GAS u32x2v*)(mrow + 2 * j0);
            __builtin_amdgcn_sched_barrier(0);
            att_load(CKV, CKVT, b, (j0 + 2 < nt) ? j0 + 2 : last, tid, st);
            __builtin_amdgcn_sched_barrier(0);
            att_tile(F.lds, j0 & 3, j0, mw0, Qf, O, m_run, l_run, slope2, hh, q, qpos);
            att_store(F.lds, (j0 + 2) & 3, tid, st);
            const u32x2v mw1 = *(const GAS u32x2v*)(mrow + 2 * (has1 ? j1 : j0));
            __builtin_amdgcn_sched_barrier(0);
            att_load(CKV, CKVT, b, (j0 + 3 < nt) ? j0 + 3 : last, tid, st);
            __builtin_amdgcn_sched_barrier(0);
            if (has1) att_tile(F.lds, j1 & 3, j1, mw1, Qf, O, m_run, l_run, slope2, hh, q, qpos);
            att_store(F.lds, (j0 + 3) & 3, tid, st);
            __syncthreads();
        }
        float lt; { const auto rr = __builtin_amdgcn_permlane32_swap(__float_as_uint(l_run), __float_as_uint(l_run), false, false); lt = __uint_as_float(rr[0]) + __uint_as_float(rr[1]); }
        const float inv = 1.f / lt;
        bf16x8 Ob[8];
#pragma unroll
        for (int db = 0; db < 4; ++db)
#pragma unroll
            for (int t = 0; t < 2; ++t) Ob[db * 2 + t] = pack8(O[db][8 * t] * inv, O[db][8 * t + 1] * inv, O[db][8 * t + 2] * inv, O[db][8 * t + 3] * inv, O[db][8 * t + 4] * inv, O[db][8 * t + 5] * inv, O[db][8 * t + 6] * inv, O[db][8 * t + 7] * inv);
        int l2; asm volatile("v_mbcnt_lo_u32_b32 %0, -1, 0\n\tv_mbcnt_hi_u32_b32 %0, -1, %0" : "=v"(l2));
        const bf16* WuvT = (const bf16*)(F.ws + WS_WUVT); bf16* YA = (bf16*)(F.ws + WS_YA);
        const int orow_t = t0 + (l2 & 31);
#pragma unroll
        for (int dbp = 0; dbp < 2; ++dbp) { f32x16 Yt;
#pragma unroll
            for (int r = 0; r < 16; ++r) Yt[r] = 0.f;
            const bf16* wrow = WuvT + (size_t)(head * 64 + dbp * 32 + (l2 & 31)) * 128 + (l2 >> 5) * 8;
#pragma unroll
            for (int ks = 0; ks < 8; ++ks) { const bf16x8 Aw = *(const GAS bf16x8*)(wrow + ks * 16); Yt = MFMA32(Aw, Ob[ks], Yt); }
#pragma unroll
            for (int g = 0; g < 4; ++g) { const unsigned lo = pkbf(Yt[4 * g], Yt[4 * g + 1]), hi = pkbf(Yt[4 * g + 2], Yt[4 * g + 3]);
                *(GAS unsigned long long*)(YA + bl_off(orow_t, head * 64 + dbp * 32 + 8 * g + 4 * (l2 >> 5), 512)) = (unsigned long long)lo | ((unsigned long long)hi << 32); } }
    }
}
struct HotOrder : pg8::StaticOrder { __device__ __forceinline__ bool next(int i, pg8::Unit& u) const { const bool ok = pg8::StaticOrder::next(i, u); u.pm &= 7; return ok; } };
struct Args { const float* in[23]; float* out; unsigned char* ws; int ph_lo, ph_hi; };
__global__ void __launch_bounds__(NWAVES * 64, 2) mk_fwd(Args args) {
    extern __shared__ __attribute__((aligned(16))) unsigned char lds[];
    Frame F;
    F.lds = (LAS unsigned char*)lds;
    F.MISCW = (volatile LAS unsigned*)(F.lds + MISC_OFF);
    F.tid = threadIdx.x; F.lane = F.tid & 63; F.wave = __builtin_amdgcn_readfirstlane(F.tid >> 6);
    F.G = gridDim.x; { const int bx = blockIdx.x; F.vcu = (F.G % 8 == 0) ? (bx % 8) * (F.G / 8) + bx / 8 : bx; }
    F.ws = args.ws; F.ctl = (gu32*)(args.ws + WS_CTL); F.out = args.out;
    for (int u = F.tid; u < (LDS_BYTES - LDSCTL_OFF) / 4; u += NWAVES * 64) ((LAS unsigned*)(F.lds + LDSCTL_OFF))[u] = 0u;
    __syncthreads();
    const int lo = args.ph_lo, hi = args.ph_hi;
#define IN(k) (lo <= (k) && (k) < hi)
#define REID() do { int l_; asm volatile("v_mbcnt_lo_u32_b32 %0, -1, 0\n\tv_mbcnt_hi_u32_b32 %0, -1, %0" : "=v"(l_)); F.lane = l_; F.tid = F.wave * 64 + l_; } while (0)
#define SEAM(k) do { if (IN(k) && IN((k) + 1)) { REID(); xcd_barrier(bar, F.wave == 0 && F.lane == 0); } } while (0)
#ifndef PROBE_MASK
#define PROBE_MASK 0
#endif
#define PHASE(k, BODY) do { if (IN(k)) { if ((PROBE_MASK >> (k)) & 1) { REID(); BODY; REID(); xcd_barrier(bar, F.wave == 0 && F.lane == 0); } REID(); BODY; } SEAM(k); } while (0)
#define BODY0 { p0_prologue<0>(F); }
#define BODY1 { p1_modulate(F); }
#define BODY2 { pg8::Gemm g{(const pg8::bf16_t*)(F.ws + WS_H), (const pg8::bf16_t*)(F.ws + WS_WIN), T, NIN, D}; pg8::StaticOrder S; S.init(T, NIN, F.G, (int)blockIdx.x); \
        pg8::EpiInProj E{(pg8::bf16_t*)(F.ws + WS_QL), (pg8::bf16_t*)(F.ws + WS_QI), (pg8::bf16_t*)(F.ws + WS_U), (pg8::bf16_t*)(F.ws + WS_SG), (float*)(F.ws + WS_MISC), (pg8::bf16_t*)(F.ws + WS_KI)}; \
        pg8::gemm_phase<pg8::EpiInProj, pg8::StaticOrder, PG8_ALIGN, PG8_SP2>(F.lds + RING_OFF, g, S, E, F.wave); }
#define BODY3 { p3_post(F); __syncthreads(); p3_select<0>(F); }
#ifndef SELVAR
#define SELVAR 0
#endif
#ifdef PROBE_POST
#define BODY3V { p3_post(F); }
#else
#define BODY3V { p3_select<SELVAR>(F); }
#endif
#define BODY4 { p4_attention(F); }
#define BODY5 { { pg8::Gemm g{(const pg8::bf16_t*)(F.ws + WS_YA), (const pg8::bf16_t*)(F.ws + WS_WBA), T, D, 512}; pg8::StaticOrder S; S.init(T, D, F.G, (int)blockIdx.x); \
          pg8::EpiGateMul E{(pg8::bf16_t*)(F.ws + WS_TMP), (const pg8::bf16_t*)(F.ws + WS_SG), 0, 0}; \
          pg8::gemm_phase<pg8::EpiGateMul, pg8::StaticOrder, PG8_ALIGN, PG8_SP2>(F.lds + RING_OFF, g, S, E, F.wave); } \
        { pg8::Gemm g{(const pg8::bf16_t*)(F.ws + WS_POOLED), (const pg8::bf16_t*)(F.ws + WS_WPB), T, D, 512}; pg8::StaticOrder S; S.init(T, D, F.G, (int)blockIdx.x); \
          pg8::EpiGateAdd E{(pg8::bf16_t*)(F.ws + WS_MIX), (const pg8::bf16_t*)(F.ws + WS_TMP), (const pg8::bf16_t*)(F.ws + WS_SG), 1024, 0}; \
          pg8::gemm_phase<pg8::EpiGateAdd, pg8::StaticOrder, PG8_ALIGN, PG8_SP2>(F.lds + RING_OFF, g, S, E, F.wave); } }
#define BODY6 { pg8::Gemm g{(const pg8::bf16_t*)(F.ws + WS_MIX), (const pg8::bf16_t*)(F.ws + WS_WOUT), T, D, 1024}; pg8::StaticOrder S; S.init(T, D, F.G, (int)blockIdx.x); \
        pg8::EpiResid E{(float*)(F.ws + WS_Z), frame_in(0), (const float*)(F.ws + WS_MOD) + 2 * 1024}; \
        pg8::gemm_phase<pg8::EpiResid, pg8::StaticOrder, PG8_ALIGN, PG8_SP2>(F.lds + RING_OFF, g, S, E, F.wave); }
#define BODY7 { p7_ln1_route(F, CW_GCNT); }
#define BODY7DRY { p7_ln1_route(F, 128); }
#define BODY9 { load_tstart(F); \
        pg8::MoeOrderG S{(const LAS int*)(F.lds + LC_TSTART), 8, F.G, (int)blockIdx.x, (const LAS int*)(F.lds + LC_ROWTAB), (const int*)(F.ws + WS_SLOTMAP), (const int*)(F.ctl + CW_GCNT)}; \
        moe_fill_rowtab(F, S); \
        pg8::Gemm g{(const pg8::bf16_t*)(F.ws + WS_H), (const pg8::bf16_t*)(F.ws + WS_WGU), T, 32 * 2048, 512}; \
        pg8::EpiSwiglu E{(pg8::bf16_t*)(F.ws + WS_ACT), frame_in(18)}; \
        pg8::gemm_phase<pg8::EpiSwiglu, pg8::MoeOrderG, PG8_ALIGN, PG8_SP2, true>(F.lds + RING_OFF, g, S, E, F.wave); }
#define BODY10 { load_tstart(F); \
        pg8::Gemm g{(const pg8::bf16_t*)(F.ws + WS_ACT), (const pg8::bf16_t*)(F.ws + WS_WD), MAXROWS, 32 * 1024, 512}; \
        pg8::MoeOrder S{(const LAS int*)(F.lds + LC_TSTART), 4, F.G, (int)blockIdx.x, nullptr, nullptr, nullptr}; \
        pg8::EpiDown E{(pg8::bf16_t*)(F.ws + WS_Y), frame_in(20)}; \
        pg8::gemm_phase<pg8::EpiDown, pg8::MoeOrder, PG8_ALIGN, PG8_SP2, true>(F.lds + RING_OFF, g, S, E, F.wave); }
#define BODY10V { load_tstart(F); \
        pg8::Gemm g{(const pg8::bf16_t*)(F.ws + WS_ACT), (const pg8::bf16_t*)(F.ws + WS_WD), MAXROWS, 32 * 1024, 1024}; \
        pg8::MoeOrder S{(const LAS int*)(F.lds + LC_TSTART), 4, F.G, (int)blockIdx.x, nullptr, nullptr, nullptr}; \
        pg8::EpiDownT<false> E{(pg8::bf16_t*)(F.ws + WS_Y), frame_in(20)}; \
        pg8::gemm_phase<pg8::EpiDownT<false>, pg8::MoeOrder, PG8_ALIGN, PG8_SP2>(F.lds + RING_OFF, g, S, E, F.wave); }
#define BODY10X { pg8::Gemm g{(const pg8::bf16_t*)(F.ws + WS_ACT), (const pg8::bf16_t*)(F.ws + WS_WD), 272 * 256, 1024, 1024}; pg8::StaticOrder S; S.init(272 * 256, 1024, F.G, (int)blockIdx.x); \
        pg8::EpiDownT<false> E{(pg8::bf16_t*)(F.ws + WS_Y), frame_in(20)}; \
        pg8::gemm_phase<pg8::EpiDownT<false>, pg8::StaticOrder, PG8_ALIGN, PG8_SP2>(F.lds + RING_OFF, g, S, E, F.wave); }
#define BODY10H { pg8::Gemm g{(const pg8::bf16_t*)(F.ws + WS_ACT), (const pg8::bf16_t*)(F.ws + WS_WD), 272 * 256, 1024, 1024}; HotOrder S; S.init(272 * 256, 1024, F.G, (int)blockIdx.x); \
        pg8::EpiDownT<false> E{(pg8::bf16_t*)(F.ws + WS_Y), frame_in(20)}; \
        pg8::gemm_phase<pg8::EpiDownT<false>, HotOrder, PG8_ALIGN, PG8_SP2>(F.lds + RING_OFF, g, S, E, F.wave); }
#define BODY11 { p11_final(F); }
    XcdBarrier bar; bar.bar = (unsigned*)(F.ctl + CW_BAR); bar.x = 0; bar.st = nullptr;
    if (hi - lo > 1) bar = xcd_barrier_post((unsigned*)(F.ctl + CW_BAR), F.MISCW + 8, F.tid == 0);
#ifdef PROBE_P0SMALL
    if (IN(0)) { REID(); p0_prologue<PROBE_P0SMALL>(F); REID(); xcd_barrier(bar, F.wave == 0 && F.lane == 0); REID(); BODY0; } SEAM(0);
#else
    PHASE(0, BODY0);
#endif
    PHASE(1, BODY1);
#ifdef PROBE_BARRIERS
    for (int i_ = 0; i_ < PROBE_BARRIERS; ++i_) { REID(); xcd_barrier(bar, F.wave == 0 && F.lane == 0); }
#endif
 PHASE(2, BODY2);
    if (IN(3)) { if ((PROBE_MASK >> 3) & 1) { REID(); BODY3V; REID(); xcd_barrier(bar, F.wave == 0 && F.lane == 0); } REID(); BODY3; } SEAM(3);
    PHASE(4, BODY4); PHASE(5, BODY5);
    PHASE(6, BODY6);
    if (IN(7)) { if ((PROBE_MASK >> 7) & 1) { REID(); BODY7DRY; REID(); xcd_barrier(bar, F.wave == 0 && F.lane == 0); } REID(); BODY7; } SEAM(7);
    PHASE(9, BODY9);
#ifdef PROBE_HOT10
    if (IN(10)) { REID(); BODY10H; REID(); xcd_barrier(bar, F.wave == 0 && F.lane == 0); REID(); BODY10; } SEAM(10);
#elif defined(PROBE_STATIC10)
    if (IN(10)) { REID(); BODY10X; REID(); xcd_barrier(bar, F.wave == 0 && F.lane == 0); REID(); BODY10; } SEAM(10);
#elif defined(PROBE_NOBIAS)
    if (IN(10)) { REID(); BODY10V; REID(); xcd_barrier(bar, F.wave == 0 && F.lane == 0); REID(); BODY10; } SEAM(10);
#else
    PHASE(10, BODY10);
#endif
    if (IN(11)) { if ((PROBE_MASK >> 11) & 1) { REID(); BODY11; REID(); xcd_barrier(bar, F.wave == 0 && F.lane == 0); } REID(); BODY11; }
#undef IN
#undef SEAM
}

static void launch_mk(const Args& a0, int lo, int hi, int grid, hipStream_t stream) {
    Args a = a0; a.ph_lo = lo; a.ph_hi = hi;
    hipLaunchKernelGGL(mk_fwd, dim3(grid), dim3(NWAVES * 64), LDS_BYTES, stream, a);
}
extern "C" void kernel_launch(void* const* d_in, const int* in_sizes, int n_in, void* d_out, int out_size, void* d_ws, size_t ws_size, hipStream_t stream) {
    static int grid = 0;
    if (grid == 0) {
        if (n_in != 23 || ws_size < WS_END) { fprintf(stderr, "kernel_launch: unexpected n_in %d / ws %zu\n", n_in, ws_size); grid = -1; return; }
        int dev = 0, cus = 0;
        if (hipGetDevice(&dev) != hipSuccess || hipDeviceGetAttribute(&cus, hipDeviceAttributeMultiprocessorCount, dev) != hipSuccess) { grid = -1; return; }
        if (hipFuncSetAttribute((const void*)mk_fwd, hipFuncAttributeMaxDynamicSharedMemorySize, LDS_BYTES) != hipSuccess) { fprintf(stderr, "hipFuncSetAttribute failed\n"); grid = -1; return; }
        grid = cus;
        if (grid != 256) { fprintf(stderr, "kernel_launch: built for 256 CUs, found %d\n", cus); grid = -1; return; }
    }
    if (grid < 0) return;
    unsigned char* ws = (unsigned char*)d_ws;
    (void)hipMemsetAsync(ws + WS_CTL, 0, CTL_ZERO_BYTES, stream);
    Args a{};
    for (int i = 0; i < 23; ++i) a.in[i] = (const float*)d_in[i];
    a.out = (float*)d_out; a.ws = ws;
    launch_mk(a, 0, 12, grid, stream);
}
```

```cpp
#include <hip/hip_runtime.h>
#include <cstdio>
#include <cstdint>
namespace pg8 {
#define PG8_LAS __attribute__((address_space(3)))
typedef unsigned short bf16_t;
typedef short bf16x8 __attribute__((ext_vector_type(8)));
typedef float f32x4 __attribute__((ext_vector_type(4)));
typedef unsigned u32x4 __attribute__((ext_vector_type(4)));
constexpr int PF_SCRATCH = 131072 + 20480;
constexpr int BM = 256, BK = 64, HALF = 128, HTB = HALF * BK * 2  , STAGE_BYTES = 8 * HTB, NXCD = 8, WGM = 8;

__host__ __device__ __forceinline__ int lds_byte(int r, int c) { const int st = (r >> 4) * 2 + (c >> 5), rr = r & 15, cc = c & 31, ob = rr * 64 + cc * 2; return st * 1024 + (ob ^ (((ob >> 9) & 1) << 5)); }
__host__ __device__ __forceinline__ void stage_rc(int b, int& R, int& C) { const int st = b / 1024, sb = b % 1024, swz = sb ^ (((sb >> 9) & 1) << 5); R = (st >> 1) * 16 + swz / 64; C = (st & 1) * 32 + (swz % 64) / 2; }
__host__ __device__ __forceinline__ int perm32(int rho) { const int n = rho >> 4, i = rho & 15; return 8 * (i >> 2) + 4 * n + (i & 3); }

struct Unit { int pm, pn; };
struct Gemm { const bf16_t* A; const bf16_t* Bt; int M, N, K; };

struct StaticOrder {
    static constexpr bool GATHER = false; static constexpr int PREFETCH = 0;
    int nM, nN, nwg, G, c;
    __host__ __device__ void init(int M, int N, int G_, int c_) { nM = M / BM; nN = N / BM; nwg = nM * nN; G = G_; c = c_; }
    __host__ __device__ bool next(int i, Unit& u) const {
        const long L = (long)i * G + c; if (L >= nwg) return false;
        int wgid = (int)L; { const int q = nwg / NXCD, r = nwg % NXCD, xcd = wgid % NXCD, off = wgid / NXCD; wgid = (xcd < r ? xcd * (q + 1) : r * (q + 1) + (xcd - r) * q) + off; }
        const int nig = WGM * nN, gid = wgid / nig, fm = gid * WGM, gsz = (nM - fm) < WGM ? (nM - fm) : WGM;
        u.pm = fm + ((wgid % nig) % gsz); u.pn = (wgid % nig) / gsz; return true;
    }
    __device__ __forceinline__ void a_ready(const Unit&) const {}
    __device__ __forceinline__ void done(const Unit&) const {}
};

__device__ __forceinline__ unsigned cvt_pk_bf16(float lo, float hi) { unsigned r; asm volatile("v_cvt_pk_bf16_f32 %0, %1, %2" : "=v"(r) : "v"(lo), "v"(hi)); return r; }
typedef float f32x2 __attribute__((ext_vector_type(2)));
__device__ __forceinline__ f32x2 gelu_pk(f32x2 v) {
    const f32x2 av = __builtin_elementwise_abs(v), d = av * 0.2316418882f + 1.0f;
    f32x2 t; t.x = __builtin_amdgcn_rcpf(d.x); t.y = __builtin_amdgcn_rcpf(d.y);
    f32x2 q = t * 0.5307027145f + (-0.7265760135f); q = q * t + 0.7107068705f; q = q * t + (-0.142248368f); q = q * t + 0.127414796f; q = q * t;
    const f32x2 s = (v * v) * (-0.72134752044f);
    f32x2 e; e.x = __builtin_amdgcn_exp2f(s.x); e.y = __builtin_amdgcn_exp2f(s.y);
    const f32x2 m = v * (q * e), r = v - m;
    f32x2 o; o.x = v.x < 0.f ? m.x : r.x; o.y = v.y < 0.f ? m.y : r.y; return o;
}

template <int ACT  > struct EpiBf16 {
    static constexpr bool PERM = true, AFTER_DRAIN = false; static_assert(ACT == 0 || ACT == 1, "EpiBf16: ACT is 0 (none) or 1 (gelu_pk)");
    bf16_t* O; int ldc; const float* bias; int split_cols; size_t split_stride; float scale0;
    __device__ __forceinline__ void operator()(const f32x4 (&acc)[2][2][4][2], const Unit& u, int wr, int wc, int fr, int fq) const {
        const int row0 = u.pm * BM + wr * 64 + fr; int colt = u.pn * BM; bf16_t* base = O;
        float sc = 1.f; if (split_cols) { const int t = colt / split_cols; base += (size_t)t * split_stride; colt -= t * split_cols; if (t == 0) sc = scale0; }
        const int col0 = colt + wc * 32 + 8 * fq, bcol0 = u.pn * BM + wc * 32 + 8 * fq;
        f32x4 bv[2][2];
#pragma unroll
        for (int bj = 0; bj < 2; ++bj)
#pragma unroll
            for (int n = 0; n < 2; ++n) bv[bj][n] = bias ? *(const f32x4*)(bias + bcol0 + bj * HALF + 4 * n) : (f32x4){0.f, 0.f, 0.f, 0.f};
#pragma unroll
        for (int ai = 0; ai < 2; ++ai)
#pragma unroll
            for (int m = 0; m < 4; ++m) { bf16_t* rowp = base + (size_t)(row0 + ai * HALF + m * 16) * ldc + col0;
#pragma unroll
                for (int bj = 0; bj < 2; ++bj) { f32x4 v0 = acc[ai][bj][m][0] + bv[bj][0], v1 = acc[ai][bj][m][1] + bv[bj][1];
                    if (ACT == 1) { f32x2 a = gelu_pk((f32x2){v0[0], v0[1]}), b = gelu_pk((f32x2){v0[2], v0[3]}), c = gelu_pk((f32x2){v1[0], v1[1]}), d = gelu_pk((f32x2){v1[2], v1[3]});
                        v0 = (f32x4){a.x, a.y, b.x, b.y}; v1 = (f32x4){c.x, c.y, d.x, d.y}; }
                    v0 = v0 * sc; v1 = v1 * sc; u32x4 w; w.x = cvt_pk_bf16(v0[0], v0[1]); w.y = cvt_pk_bf16(v0[2], v0[3]); w.z = cvt_pk_bf16(v1[0], v1[1]); w.w = cvt_pk_bf16(v1[2], v1[3]);
                    *(u32x4*)(rowp + bj * HALF) = w; } }
    }
};

struct PanelStats {
    unsigned* xbuf;
    unsigned* cnt;
    unsigned* tmo;
    int ntn; float eps;
    unsigned code;
    __device__ __forceinline__ bool run(const f32x4 (&v)[2][2][4][2], const Unit& u, int wr, int wc, int fr, int fq, PG8_LAS unsigned char* lds, int wid, int lane) const {
        typedef float f32x2v __attribute__((ext_vector_type(2)));
        PG8_LAS f32x2v* P = (PG8_LAS f32x2v*)lds;
        PG8_LAS f32x2v* S = (PG8_LAS f32x2v*)(lds + 8192);
        PG8_LAS unsigned* flag = (PG8_LAS unsigned*)(lds + 8192 + 2048);
#pragma unroll
        for (int ai = 0; ai < 2; ++ai)
#pragma unroll
            for (int m = 0; m < 4; ++m) {
                float s = 0.f;
#pragma unroll
                for (int bj = 0; bj < 2; ++bj)
#pragma unroll
                    for (int n = 0; n < 2; ++n) { const f32x4 x = v[ai][bj][m][n]; s += (x[0] + x[1]) + (x[2] + x[3]); }
                s += __shfl_xor(s, 16); s += __shfl_xor(s, 32);
                const float mw = s * (1.0f / 64.0f); float q = 0.f;
#pragma unroll
                for (int bj = 0; bj < 2; ++bj)
#pragma unroll
                    for (int n = 0; n < 2; ++n) { const f32x4 d = v[ai][bj][m][n] - mw; q += (d[0] * d[0] + d[1] * d[1]) + (d[2] * d[2] + d[3] * d[3]); }
                q += __shfl_xor(q, 16); q += __shfl_xor(q, 32);
                if (fq == 0) P[(ai * HALF + wr * 64 + m * 16 + fr) * 4 + wc] = (f32x2v){mw, q};
            }
        asm volatile("s_waitcnt lgkmcnt(0)" ::: "memory"); __builtin_amdgcn_s_barrier(); asm volatile("" ::: "memory");
#if defined(BROKEN_EXCHANGE_NO_WAIT)
#warning BROKEN CONTROL BUILD: the row-statistics exchange does not wait; results are wrong by design
        if (blockIdx.x >= 64) { const long long t0_ = clock64(); while (clock64() - t0_ < 60000) __builtin_amdgcn_s_sleep(8); }
#endif
        const int row = wid * 32 + (lane & 31);
        if (lane < 32) {
            const f32x2v a = P[row * 4 + 0], b = P[row * 4 + 1], c = P[row * 4 + 2], d = P[row * 4 + 3];
            const float mt = (a.x + b.x + c.x + d.x) * 0.25f;
            const float da = a.x - mt, db = b.x - mt, dc = c.x - mt, dd = d.x - mt;
            const float m2 = (a.y + b.y) + (c.y + d.y) + 64.0f * ((da * da + db * db) + (dc * dc + dd * dd));
            unsigned long long* slot = (unsigned long long*)xbuf + ((size_t)(u.pm * BM + row) * 4 + u.pn);
            __hip_atomic_store(slot, ((unsigned long long)__float_as_uint(m2) << 32) | __float_as_uint(mt), __ATOMIC_RELAXED, __HIP_MEMORY_SCOPE_AGENT);
        }
        asm volatile("s_waitcnt vmcnt(0)" ::: "memory");
        if (lane == 0) __hip_atomic_fetch_add(cnt + 64 * u.pm, 1u, __ATOMIC_RELAXED, __HIP_MEMORY_SCOPE_AGENT);
        if (wid == 0) {
            bool dead = false; const unsigned long long t0 = __builtin_amdgcn_s_memrealtime(); const unsigned want = 8u * (unsigned)ntn;
            for (;;) {
#if defined(BROKEN_EXCHANGE_NO_WAIT)
                break;
#endif
                if ((unsigned)__builtin_amdgcn_readfirstlane(__hip_atomic_load(cnt + 64 * u.pm, __ATOMIC_RELAXED, __HIP_MEMORY_SCOPE_AGENT)) >= want) break;
                if (__builtin_amdgcn_s_memrealtime() - t0 > 2000000ull) {
                    if (lane == 0) { unsigned expect = 0u; __hip_atomic_compare_exchange_strong(tmo + 1, &expect, code | (unsigned)(u.pm & 0xff), __ATOMIC_RELAXED, __ATOMIC_RELAXED, __HIP_MEMORY_SCOPE_AGENT);
                                     __hip_atomic_store(tmo, 1u, __ATOMIC_RELAXED, __HIP_MEMORY_SCOPE_AGENT); }
                    dead = true; break; }
                __builtin_amdgcn_s_sleep(2);
            }
            __builtin_amdgcn_fence(__ATOMIC_ACQUIRE, "agent");
            if (lane == 0) flag[0] = dead ? 1u : 0u;
        }
        asm volatile("s_waitcnt vmcnt(0) lgkmcnt(0)" ::: "memory"); __builtin_amdgcn_s_barrier(); asm volatile("" ::: "memory");
        const bool bad = flag[0] != 0u;
        if (lane < 32) {
            const unsigned long long* slot = (const unsigned long long*)xbuf + (size_t)(u.pm * BM + row) * 4; float mt[4], m2[4]; float ms = 0.f;
#pragma unroll
            for (int t = 0; t < 4; ++t) { if (t < ntn) { const unsigned long long w = __hip_atomic_load(slot + t, __ATOMIC_RELAXED, __HIP_MEMORY_SCOPE_AGENT); mt[t] = __uint_as_float((unsigned)w); m2[t] = __uint_as_float((unsigned)(w >> 32)); } else { mt[t] = 0.f; m2[t] = 0.f; } ms += mt[t]; }
            const float mean = ms / (float)ntn; float q = 0.f;
#pragma unroll
            for (int t = 0; t < 4; ++t) if (t < ntn) { const float dm = mt[t] - mean; q += m2[t] + 256.0f * dm * dm; }
            S[row] = (f32x2v){mean, 1.0f / sqrtf(q / (256.0f * (float)ntn) + eps)};
        }
        asm volatile("s_waitcnt lgkmcnt(0)" ::: "memory"); __builtin_amdgcn_s_barrier(); asm volatile("" ::: "memory");
        return bad;
    }
};
struct EpiLnRes {
    static constexpr bool PERM = false, AFTER_DRAIN = true;
    const float* base; float* out; int ldc; const float* bias; PanelStats st; unsigned poison;
    __device__ __forceinline__ void fused(f32x4 (&acc)[2][2][4][2], const Unit& u, int wr, int wc, int fr, int fq, PG8_LAS unsigned char* lds, int wid, int lane) const {
        typedef float f32x2v __attribute__((ext_vector_type(2)));
        const PG8_LAS f32x2v* S = (const PG8_LAS f32x2v*)(lds + 8192);
        const int col0 = u.pn * BM + wc * 32 + 4 * fq;
#pragma unroll
        for (int bj = 0; bj < 2; ++bj)
#pragma unroll
            for (int n = 0; n < 2; ++n) { const f32x4 bv = bias ? *(const f32x4*)(bias + col0 + bj * HALF + n * 16) : (f32x4){0.f, 0.f, 0.f, 0.f};
#pragma unroll
                for (int ai = 0; ai < 2; ++ai)
#pragma unroll
                    for (int m = 0; m < 4; ++m) acc[ai][bj][m][n] += bv; }
        f32x4 pre[4][2][2];
#pragma unroll
        for (int m = 0; m < 4; ++m) { const size_t off = (size_t)(u.pm * BM + wr * 64 + m * 16 + fr) * ldc + col0;
#pragma unroll
            for (int bj = 0; bj < 2; ++bj)
#pragma unroll
                for (int n = 0; n < 2; ++n) pre[m][bj][n] = *(const f32x4*)(base + off + bj * HALF + n * 16); }
        const bool bad = st.run(acc, u, wr, wc, fr, fq, lds, wid, lane) || poison != 0u;
        const float qnan = __builtin_nanf("");
#pragma unroll
        for (int ai = 0; ai < 2; ++ai)
#pragma unroll
            for (int m = 0; m < 4; ++m) { const int r = ai * HALF + wr * 64 + m * 16 + fr; const f32x2v sr = S[r]; const size_t off = (size_t)(u.pm * BM + r) * ldc + col0;
#pragma unroll
                for (int bj = 0; bj < 2; ++bj)
#pragma unroll
                    for (int n = 0; n < 2; ++n) { const f32x4 bs = ai == 0 ? pre[m][bj][n] : *(const f32x4*)(base + off + bj * HALF + n * 16); f32x4 o = bs + (acc[ai][bj][m][n] - sr.x) * sr.y;
                        if (bad) o = (f32x4){qnan, qnan, qnan, qnan}; *(f32x4*)(out + off + bj * HALF + n * 16) = o; }
                if (m & 1) asm volatile("" ::: "memory"); }
    }
};
struct EpiLnResLn {
    static constexpr bool PERM = false, AFTER_DRAIN = true;
    const float* base; float* out; bf16_t* xn; int ldc; const float* bias; PanelStats st1, st2; unsigned poison;
    __device__ __forceinline__ void fused(f32x4 (&acc)[2][2][4][2], const Unit& u, int wr, int wc, int fr, int fq, PG8_LAS unsigned char* lds, int wid, int lane) const {
        typedef float f32x2v __attribute__((ext_vector_type(2))); typedef unsigned u32x2v __attribute__((ext_vector_type(2)));
        const PG8_LAS f32x2v* S = (const PG8_LAS f32x2v*)(lds + 8192);
        const int col0 = u.pn * BM + wc * 32 + 4 * fq;
#pragma unroll
        for (int bj = 0; bj < 2; ++bj)
#pragma unroll
            for (int n = 0; n < 2; ++n) { const f32x4 bv = bias ? *(const f32x4*)(bias + col0 + bj * HALF + n * 16) : (f32x4){0.f, 0.f, 0.f, 0.f};
#pragma unroll
                for (int ai = 0; ai < 2; ++ai)
#pragma unroll
                    for (int m = 0; m < 4; ++m) acc[ai][bj][m][n] += bv; }
        bool bad = st1.run(acc, u, wr, wc, fr, fq, lds, wid, lane) || poison != 0u;
        const float qnan = __builtin_nanf("");
#pragma unroll
        for (int ai = 0; ai < 2; ++ai)
#pragma unroll
            for (int m = 0; m < 4; ++m) { const int r = ai * HALF + wr * 64 + m * 16 + fr; const f32x2v sr = S[r]; const size_t off = (size_t)(u.pm * BM + r) * ldc + col0;
#pragma unroll
                for (int bj = 0; bj < 2; ++bj)
#pragma unroll
                    for (int n = 0; n < 2; ++n) { const f32x4 bs = *(const f32x4*)(base + off + bj * HALF + n * 16); acc[ai][bj][m][n] = bs + (acc[ai][bj][m][n] - sr.x) * sr.y; }
                asm volatile("" : "+v"(acc[ai][0][m][0]), "+v"(acc[ai][0][m][1]), "+v"(acc[ai][1][m][0]), "+v"(acc[ai][1][m][1]));
                if (m & 1) asm volatile("" ::: "memory"); }
        const bool bad1 = bad;
        bad = st2.run(acc, u, wr, wc, fr, fq, lds, wid, lane) || bad;
#pragma unroll
        for (int ai = 0; ai < 2; ++ai)
#pragma unroll
            for (int m = 0; m < 4; ++m) { const int r = ai * HALF + wr * 64 + m * 16 + fr; const f32x2v sr = S[r]; const size_t off = (size_t)(u.pm * BM + r) * ldc + col0;
#pragma unroll
                for (int bj = 0; bj < 2; ++bj)
#pragma unroll
                    for (int n = 0; n < 2; ++n) { const f32x4 x1 = acc[ai][bj][m][n]; *(f32x4*)(out + off + bj * HALF + n * 16) = bad1 ? (f32x4){qnan, qnan, qnan, qnan} : x1;
                        const f32x4 o = (x1 - sr.x) * sr.y; u32x2v w; w.x = cvt_pk_bf16(o[0], o[1]); w.y = cvt_pk_bf16(o[2], o[3]);
                        if (bad) { w.x = 0x7fc07fc0u; w.y = 0x7fc07fc0u; } *(u32x2v*)(xn + off + bj * HALF + n * 16) = w; }
                asm volatile("" ::: "memory"); }
    }
};

typedef int i32x4v __attribute__((ext_vector_type(4))); typedef int i32x8v __attribute__((ext_vector_type(8)));
template <class Epi, class Sched, bool ALIGN_EPI = false, bool SP2 = false, bool FP8 = false>
__device__ __forceinline__ void gemm_phase(PG8_LAS unsigned char* lds, const Gemm g, const Sched& S, const Epi& E, const int wave_id  ) {
    int tid; { int l_; asm volatile("v_mbcnt_lo_u32_b32 %0, -1, 0\n\tv_mbcnt_hi_u32_b32 %0, -1, %0" : "=v"(l_)); tid = wave_id * 64 + l_; }
    const int wid = wave_id, lane = tid & 63, wr = wid >> 2, wc = wid & 3, fr = lane & 15, fq = lane >> 4;
    const int K = g.K, nt = K / BK;
    constexpr bool GA = Sched::GATHER;
    static_assert(!GA || SP2, "row gather is wired into the SP2 loop only");
    unsigned voffA[2], voffB[2];
#pragma unroll
    for (int i = 0; i < 2; ++i) { int R, C; stage_rc(tid * 16 + i * 8192, R, C); const int Rb = Epi::PERM ? ((R & ~31) + perm32(R & 31)) : R;
        voffA[i] = (unsigned)(R * BK + C) * 2u; voffB[i] = (unsigned)(Rb * BK + C) * 2u; }
    unsigned goc[2][2]; const char* const gA = (const char*)g.A;
#define PG8_GO(dst, slot, u) do { _Pragma("unroll") for (int _i = 0; _i < 2; ++_i) { int _R, _C; stage_rc(tid * 16 + _i * 8192, _R, _C); _Pragma("unroll") for (int _h = 0; _h < 2; ++_h) \
        { const unsigned _r = (unsigned)S.arow(slot, u, _h * HALF + _R); dst[_h][_i] = (_r >> 8) * (unsigned)(BM * K * 2) + (_r & 255u) * (unsigned)(BK * 2) + (unsigned)(_C * 2); } } } while (0)
#define PG8_STAGE_A(bufoff, gbase_plain, kb, h, useN) do { if constexpr (GA) { _Pragma("unroll") for (int _i = 0; _i < 2; ++_i) \
        __builtin_amdgcn_global_load_lds((const unsigned*)(gA + (kb) + goc[h][_i]), (PG8_LAS unsigned*)(lds + (bufoff) + ldsw + _i * 8192), 16, 0, 0); } else { PG8_STAGE(bufoff, gbase_plain, voffA); } } while (0)
    const size_t kstep = (size_t)(BM * BK * 2);
    const size_t hstep = (size_t)HALF * BK * 2;
    const size_t tstep = (size_t)BM * K * 2;
    const unsigned ldsw = (unsigned)wid * 1024u;
    const int aoff = lds_byte(wr * 64 + fr, fq * 8), boff = lds_byte(wc * 32 + fr, fq * 8);
#define PG8_SA(b, h) (((b) * 2 + (h)) * HTB)
#define PG8_SB(b, h) ((4 + (b) * 2 + (h)) * HTB)
#define PG8_STAGE(bufoff, gbase, voff) do { _Pragma("unroll") for (int _i = 0; _i < 2; ++_i) \
        __builtin_amdgcn_global_load_lds((const unsigned*)((const char*)(gbase) + (voff)[_i]), (PG8_LAS unsigned*)(lds + (bufoff) + ldsw + _i * 8192), 16, 0, 0); } while (0)
#define PG8_LDA(dst, b, h) do { if constexpr (FP8) { _Pragma("unroll") for (int m = 0; m < 4; ++m) { const i32x4v _lo = *(const PG8_LAS i32x4v*)(lds + PG8_SA(b, h) + aoff + m * 2048), _hi = *(const PG8_LAS i32x4v*)(lds + PG8_SA(b, h) + aoff + m * 2048 + 1024); \
        dst##8[m] = __builtin_shufflevector(_lo, _hi, 0, 1, 2, 3, 4, 5, 6, 7); } } else { _Pragma("unroll") for (int m = 0; m < 4; ++m) _Pragma("unroll") for (int k = 0; k < 2; ++k) dst[m][k] = *(const PG8_LAS bf16x8*)(lds + PG8_SA(b, h) + aoff + m * 2048 + k * 1024); } } while (0)
#define PG8_LDB(dst, b, h) do { if constexpr (FP8) { _Pragma("unroll") for (int n = 0; n < 2; ++n) { const i32x4v _lo = *(const PG8_LAS i32x4v*)(lds + PG8_SB(b, h) + boff + n * 2048), _hi = *(const PG8_LAS i32x4v*)(lds + PG8_SB(b, h) + boff + n * 2048 + 1024); \
        dst##8[n] = __builtin_shufflevector(_lo, _hi, 0, 1, 2, 3, 4, 5, 6, 7); } } else { _Pragma("unroll") for (int n = 0; n < 2; ++n) _Pragma("unroll") for (int k = 0; k < 2; ++k) dst[n][k] = *(const PG8_LAS bf16x8*)(lds + PG8_SB(b, h) + boff + n * 2048 + k * 1024); } } while (0)
#define PG8_MMA16(ai, bj, At, Bt) do { __builtin_amdgcn_s_setprio(1); _Pragma("unroll") for (int m = 0; m < 4; ++m) _Pragma("unroll") for (int n = 0; n < 2; ++n) _Pragma("unroll") for (int k = 0; k < 2; ++k) \
        acc[ai][bj][m][n] = __builtin_amdgcn_mfma_f32_16x16x32_bf16(Bt[n][k], At[m][k], acc[ai][bj][m][n], 0, 0, 0); __builtin_amdgcn_s_setprio(0); } while (0)
#define PG8_MMA8(ai, bj, At, Bt) do { __builtin_amdgcn_sched_barrier(0); __builtin_amdgcn_s_setprio(1); _Pragma("unroll") for (int m = 0; m < 4; ++m) _Pragma("unroll") for (int n = 0; n < 2; ++n) \
        acc[ai][bj][m][n] = __builtin_amdgcn_mfma_scale_f32_16x16x128_f8f6f4(Bt##8[n], At##8[m], acc[ai][bj][m][n], 0, 0, 0, 0x7f7f7f7f, 0, 0x7f7f7f7f); __builtin_amdgcn_s_setprio(0); __builtin_amdgcn_sched_barrier(0); } while (0)
#define PG8_MMA(ai, bj, At, Bt) do { if constexpr (FP8) { PG8_MMA8(ai, bj, At, Bt); } else { PG8_MMA16(ai, bj, At, Bt); } } while (0)
#define PG8_WAIT_V(n) asm volatile("s_waitcnt vmcnt(" #n ")" ::: "memory")
#define PG8_WAIT_L(n) asm volatile("s_waitcnt lgkmcnt(" #n ")" ::: "memory")
#define PG8_BAR __builtin_amdgcn_s_barrier()
#define PG8_SCHED __builtin_amdgcn_sched_barrier(0)
    Unit cur, nxt; int ui = 0;
    if (!S.next(0, cur)) return;
    f32x4 acc[2][2][4][2];
#pragma unroll
    for (int a = 0; a < 2; ++a)
#pragma unroll
        for (int b = 0; b < 2; ++b)
#pragma unroll
            for (int m = 0; m < 4; ++m)
#pragma unroll
                for (int n = 0; n < 2; ++n) acc[a][b][m][n] = (f32x4){0.f, 0.f, 0.f, 0.f};
    bf16x8 At[4][2], B0[2][2], B1[2][2];
    i32x8v At8[4], B08[2], B18[2];
#define PG8_ROT(u) (2 * (((u).pm + 3 * (u).pn) & 3))
#define PG8_KOFF(t, r) ((size_t)(((t) + (r)) & (nt - 1)) * kstep)
    int rc = SP2 ? PG8_ROT(cur) : 0, rn = rc;
    const char* cA = (const char*)g.A + (size_t)cur.pm * tstep; const char* cB = (const char*)g.Bt + (size_t)cur.pn * tstep;
    if constexpr (GA) { PG8_GO(goc, 0, cur); }
    S.a_ready(cur);
    if constexpr (SP2) {
        const size_t k0 = PG8_KOFF(0, rc);
        PG8_STAGE(PG8_SB(0, 0), cB + k0, voffB); PG8_STAGE(PG8_SB(0, 1), cB + k0 + hstep, voffB); PG8_STAGE_A(PG8_SA(0, 0), cA + k0, k0, 0, false); PG8_STAGE_A(PG8_SA(0, 1), cA + k0 + hstep, k0, 1, false);
        if (wr == 1) PG8_BAR;
        PG8_WAIT_V(2); PG8_BAR;
        PG8_STAGE(PG8_SB(1, 0), cB + k0 + kstep, voffB); PG8_STAGE_A(PG8_SA(1, 0), cA + k0 + kstep, k0 + kstep, 0, false); PG8_STAGE(PG8_SB(1, 1), cB + k0 + hstep + kstep, voffB);
        PG8_WAIT_V(6); PG8_BAR;
    } else {
        PG8_STAGE(PG8_SB(0, 0), cB, voffB); PG8_STAGE(PG8_SA(0, 0), cA, voffA); PG8_STAGE(PG8_SB(0, 1), cB + hstep, voffB); PG8_STAGE(PG8_SA(0, 1), cA + hstep, voffA);
        if (wr == 1) PG8_BAR;
        PG8_WAIT_V(4); PG8_BAR;
        PG8_STAGE(PG8_SB(1, 0), cB + kstep, voffB); PG8_STAGE(PG8_SA(1, 0), cA + kstep, voffA); PG8_STAGE(PG8_SB(1, 1), cB + hstep + kstep, voffB);
        PG8_WAIT_V(6); PG8_BAR;
    }
    for (;;) {
        const bool has_next = S.next(ui + 1, nxt);
        rn = (SP2 && has_next) ? PG8_ROT(nxt) : rc;
        const char* nA = has_next ? (const char*)g.A + (size_t)nxt.pm * tstep : cA; const char* nB = has_next ? (const char*)g.Bt + (size_t)nxt.pn * tstep : cB;
#pragma unroll 1
        for (int t = 0; t < nt; t += 2) {
            const bool last = (t == nt - 2);
            const size_t kt0 = PG8_KOFF(t, rc), kt2 = last ? PG8_KOFF(0, rn) : PG8_KOFF(t + 2, rc);
            const char* a1 = cA + kt0 + kstep;
            const char* a2 = (last ? nA : cA) + kt2; const char* b2 = (last ? nB : cB) + kt2;
            const char* a3 = a2 + kstep; const char* b3 = b2 + kstep;
            const size_t k2 = kt2;
            if (last && has_next) S.a_ready(nxt);
            if constexpr (SP2) {
            PG8_LDB(B0, 0, 0); PG8_LDB(B1, 0, 1); PG8_SCHED; PG8_LDA(At, 0, 0); PG8_STAGE_A(PG8_SA(1, 1), a1 + hstep, kt0 + kstep, 1, false);
            if constexpr (GA) { if (last && has_next) { PG8_GO(goc, ui + 1, nxt); } }
            PG8_WAIT_V(8); PG8_WAIT_L(0); PG8_BAR; PG8_MMA(0, 0, At, B0); PG8_MMA(0, 1, At, B1); PG8_BAR; PG8_SCHED;
            PG8_LDA(At, 0, 1); PG8_STAGE(PG8_SB(0, 0), b2, voffB); PG8_STAGE(PG8_SB(0, 1), b2 + hstep, voffB); PG8_STAGE_A(PG8_SA(0, 0), a2, k2, 0, last);
            PG8_WAIT_V(8); PG8_WAIT_L(0); PG8_BAR; PG8_MMA(1, 0, At, B0); PG8_MMA(1, 1, At, B1); PG8_BAR; PG8_SCHED;
            PG8_LDB(B0, 1, 0); PG8_LDB(B1, 1, 1); PG8_SCHED; PG8_LDA(At, 1, 0); PG8_STAGE_A(PG8_SA(0, 1), a2 + hstep, k2, 1, last);
            PG8_WAIT_V(8); PG8_WAIT_L(0); PG8_BAR; PG8_MMA(0, 0, At, B0); PG8_MMA(0, 1, At, B1); PG8_BAR; PG8_SCHED;
            PG8_LDA(At, 1, 1); PG8_STAGE(PG8_SB(1, 0), b3, voffB); PG8_STAGE(PG8_SB(1, 1), b3 + hstep, voffB); PG8_STAGE_A(PG8_SA(1, 0), a3, k2 + kstep, 0, last);
            PG8_WAIT_V(8); PG8_WAIT_L(0); PG8_BAR; PG8_MMA(1, 0, At, B0); PG8_MMA(1, 1, At, B1); PG8_BAR; PG8_SCHED;
            } else {
            PG8_LDB(B0, 0, 0); PG8_SCHED; PG8_LDA(At, 0, 0); PG8_STAGE(PG8_SA(1, 1), a1 + hstep, voffA);
            PG8_WAIT_L(8); PG8_BAR; PG8_WAIT_L(0); PG8_MMA(0, 0, At, B0); PG8_BAR; PG8_SCHED;
            PG8_LDB(B1, 0, 1); PG8_STAGE(PG8_SB(0, 0), b2, voffB);
            PG8_BAR; PG8_WAIT_L(0); PG8_MMA(0, 1, At, B1); PG8_BAR;
            PG8_LDA(At, 0, 1); PG8_STAGE(PG8_SA(0, 0), a2, voffA);
            PG8_BAR; PG8_WAIT_L(0); PG8_MMA(1, 0, At, B0); PG8_BAR; PG8_SCHED;
            PG8_STAGE(PG8_SB(0, 1), b2 + hstep, voffB);
            PG8_WAIT_V(6); PG8_BAR; PG8_MMA(1, 1, At, B1); PG8_BAR;
            PG8_LDB(B0, 1, 0); PG8_SCHED; PG8_LDA(At, 1, 0); PG8_STAGE(PG8_SA(0, 1), a2 + hstep, voffA);
            PG8_WAIT_L(8); PG8_BAR; PG8_WAIT_L(0); PG8_MMA(0, 0, At, B0); PG8_BAR; PG8_SCHED;
            PG8_LDB(B1, 1, 1); PG8_STAGE(PG8_SB(1, 0), b3, voffB);
            PG8_BAR; PG8_WAIT_L(0); PG8_MMA(0, 1, At, B1); PG8_BAR;
            PG8_LDA(At, 1, 1); PG8_STAGE(PG8_SA(1, 0), a3, voffA);
            PG8_BAR; PG8_WAIT_L(0); PG8_MMA(1, 0, At, B0); PG8_BAR; PG8_SCHED;
            PG8_STAGE(PG8_SB(1, 1), b3 + hstep, voffB);
            PG8_WAIT_V(6); PG8_BAR; PG8_MMA(1, 1, At, B1); PG8_BAR;
            }
        }
        if constexpr (Sched::PREFETCH != 0) { if (has_next) {
            int fr2 = fr, fq2 = fq; asm volatile("" : "+v"(fr2), "+v"(fq2));
            const int pr = (wid & 3) * 64 + fq2 * 16 + fr2, kh = wid >> 2;
            const size_t kb = (size_t)((2 * (nxt.pm & 3) + kh) & (nt - 1)) * kstep, ka = (size_t)((2 * (nxt.pn & 3) + kh) & (nt - 1)) * kstep;
            const char* pa;
            if constexpr (GA) { const unsigned r_ = (unsigned)S.arow(ui + 1, nxt, pr); pa = gA + (size_t)(r_ >> 8) * tstep + ka + (size_t)(r_ & 255u) * (BK * 2); }
            else pa = nA + ka + (size_t)pr * (BK * 2);
            if constexpr ((Sched::PREFETCH & 1) != 0) __builtin_amdgcn_global_load_lds((const unsigned*)pa, (PG8_LAS unsigned*)(lds + PF_SCRATCH), 4, 0, 0);
            if constexpr ((Sched::PREFETCH & 2) != 0) __builtin_amdgcn_global_load_lds((const unsigned*)(nB + kb + (size_t)pr * (BK * 2)), (PG8_LAS unsigned*)(lds + PF_SCRATCH), 4, 0, 0);
        } }
        if constexpr (ALIGN_EPI) { if (wr == 0) PG8_BAR; }
#ifdef PROBE_EPI2
        if constexpr (!Epi::AFTER_DRAIN && Epi::ID == PROBE_EPI2) { E(acc, cur, wr, wc, fr, fq); asm volatile("" ::: "memory"); }
#endif
        if constexpr (!Epi::AFTER_DRAIN) { E(acc, cur, wr, wc, fr, fq); S.done(cur); }
        if (!has_next) break;
#pragma unroll
        for (int a = 0; a < 2; ++a)
#pragma unroll
            for (int b = 0; b < 2; ++b)
#pragma unroll
                for (int m = 0; m < 4; ++m)
#pragma unroll
                    for (int n = 0; n < 2; ++n) acc[a][b][m][n] = (f32x4){0.f, 0.f, 0.f, 0.f};
        cur = nxt; cA = nA; cB = nB; ++ui; rc = rn;

        if constexpr (ALIGN_EPI) { if (wr == 1) PG8_BAR; }
    }
    PG8_WAIT_V(0);
    if constexpr (!ALIGN_EPI) { if (wr == 0) PG8_BAR; }
    PG8_BAR;
    if constexpr (Epi::AFTER_DRAIN) { E.fused(acc, cur, wr, wc, fr, fq, lds, wid, lane); S.done(cur); }
#undef PG8_SA
#undef PG8_SB
#undef PG8_STAGE
#undef PG8_ROT
#undef PG8_KOFF
#undef PG8_STAGE_A
#undef PG8_GO
#undef PG8_LDA
#undef PG8_LDB
#undef PG8_MMA
#undef PG8_MMA8
#undef PG8_MMA16
#undef PG8_WAIT_V
#undef PG8_WAIT_L
#undef PG8_BAR
#undef PG8_SCHED
}
}

#ifndef PG8_SP2
#define PG8_SP2 true
#endif
#ifndef PG8_ALIGN
#define PG8_ALIGN true
#endif
#define GAS __attribute__((address_space(1)))
#define LAS __attribute__((address_space(3)))
typedef unsigned short bf16;
typedef unsigned v4u __attribute__((ext_vector_type(4)));
typedef float f32x4 __attribute__((ext_vector_type(4)));
typedef short bf16x8 __attribute__((ext_vector_type(8)));
typedef GAS unsigned gu32;
typedef GAS unsigned long long gu64;
#define RLX_AGENT __ATOMIC_RELAXED, __HIP_MEMORY_SCOPE_AGENT
#define LDS_WAIT() asm volatile("s_waitcnt lgkmcnt(0)" ::: "memory")
#define VM_WAIT() asm volatile("s_waitcnt vmcnt(0)" ::: "memory")
__device__ __forceinline__ unsigned long long rt() { return __builtin_amdgcn_s_memrealtime(); }
__device__ __forceinline__ unsigned f2bf(float f) { unsigned u = __builtin_bit_cast(unsigned, f); return (u + 0x7fffu + ((u >> 16) & 1u)) >> 16; }
__device__ __forceinline__ unsigned pk2(float lo, float hi) { return f2bf(lo) | (f2bf(hi) << 16); }

#define XB_TMO      128
#define XB_XCNT(j)  (256  + 64 * (j))
#define XB_XSUB(j)  (1280 + 64 * (j))
#define XB_XGEN(j)  (2304 + 64 * (j))
#define XB_TOP      3328
#define XB_TOPGEN   3392
#define XCD_BAR_WORDS 3456
#define XB_SPIN_CAP (1u << 18)

__device__ __forceinline__ unsigned xb_ld(unsigned* p)              { return __hip_atomic_load(p, __ATOMIC_RELAXED, __HIP_MEMORY_SCOPE_AGENT); }
__device__ __forceinline__ unsigned xb_add(unsigned* p, unsigned v) { return __hip_atomic_fetch_add(p, v, __ATOMIC_RELAXED, __HIP_MEMORY_SCOPE_AGENT); }
__device__ __forceinline__ unsigned xb_xcc_id() { return (unsigned)__builtin_amdgcn_s_getreg((3 << 11) | 20) & 0xFu; }
#define XB_SPIN(cond, bar) do { unsigned _sp = 0; while (cond) { __builtin_amdgcn_s_sleep(1); \
    if ((++_sp & 255u) == 0u) { if (xb_ld(&(bar)[XB_TMO])) break; if (_sp > XB_SPIN_CAP) { atomicAdd(&(bar)[XB_TMO], 1u); break; } } } } while (0)

struct XcdBarrier {
    unsigned* bar; unsigned x;
    volatile LAS unsigned* st;
};

__device__ __forceinline__ XcdBarrier xcd_barrier_post(unsigned* bar, volatile LAS unsigned* st, bool leader) {
    XcdBarrier b; b.bar = bar; b.x = xb_xcc_id(); b.st = st;
    if (leader) (void)xb_add(&bar[XB_XCNT(b.x)], 1u);
    return b;
}
__device__ __forceinline__ void xcd_barrier_complete(unsigned* bar, unsigned x, unsigned& nloc, unsigned& nx) {
    const unsigned G = gridDim.x * gridDim.y * gridDim.z;
    unsigned sum, cnt, mine, sp = 0u;
    for (;;) {
        sum = 0u; cnt = 0u; mine = 0u;
#pragma unroll
        for (unsigned j = 0; j < 16; ++j) { const unsigned c = xb_ld(&bar[XB_XCNT(j)]); sum += c; cnt += (c > 0u) ? 1u : 0u; mine = (j == x) ? c : mine; }
        if (sum == G) break;
        __builtin_amdgcn_s_sleep(1);
        if ((++sp & 255u) == 0u) { if (xb_ld(&bar[XB_TMO])) break; if (sp > XB_SPIN_CAP) { atomicAdd(&bar[XB_TMO], 1u); break; } }
    }
    nloc = mine > 0u ? mine : 1u; nx = cnt > 0u ? cnt : 1u;
}

__device__ __forceinline__ void xcd_barrier(const XcdBarrier& b, bool leader) {
    asm volatile("s_waitcnt vmcnt(0)" ::: "memory");
    __syncthreads();
    if (leader) {
        unsigned* bar = b.bar;
        __builtin_amdgcn_s_waitcnt(0);
        unsigned nloc = b.st[0], nx = b.st[1];
        if (nloc == 0u) { xcd_barrier_complete(bar, b.x, nloc, nx); b.st[0] = nloc; b.st[1] = nx; }
        const unsigned old = xb_add(&bar[XB_XSUB(b.x)], 1u);
        const unsigned gen = old / nloc;
        if (old + 1u == (gen + 1u) * nloc) {
            __builtin_amdgcn_fence(__ATOMIC_RELEASE, "agent");
            asm volatile("s_waitcnt vmcnt(0)" ::: "memory");
            const unsigned og = xb_add(&bar[XB_TOP], 1u);
            const unsigned tg = og / nx;
            if (og + 1u == (tg + 1u) * nx) xb_add(&bar[XB_TOPGEN], 1u);
            else XB_SPIN(xb_ld(&bar[XB_TOPGEN]) == tg, bar);
            __builtin_amdgcn_fence(__ATOMIC_ACQUIRE, "agent");
            xb_add(&bar[XB_XGEN(b.x)], 1u);
            asm volatile("s_waitcnt vmcnt(0)" ::: "memory");
        } else {
            XB_SPIN(xb_ld(&bar[XB_XGEN(b.x)]) == gen, bar);
            __builtin_amdgcn_fence(__ATOMIC_ACQUIRE, "agent");
            asm volatile("s_waitcnt vmcnt(0)" ::: "memory");
        }
    }
    __syncthreads();
}
constexpr int NWAVES = 8;
constexpr int B_ = 8, S_ = 2048, T = B_ * S_, D = 1024;
constexpr int INC = 3784;
constexpr int O_Q = 0, O_CKV = 512, O_QI = 640, O_KI = 1152, O_WI = 1216, O_U = 1224, O_G = 1736;
constexpr int NIN = 3840;
constexpr float ALPHA = 1.189207115002721f, LN_EPS = 1e-5f, LOG2E = 1.4426950408889634f;
constexpr int MAXROWS = T * 4 + 32 * 256;
constexpr int TOPK = 256;
constexpr float A8_H = 32.f, W8_GU = 1024.f, A8_ACT = 8.f, W8_D = 2048.f;

constexpr size_t MiB = 1u << 20;
constexpr size_t WS_CTL = 0, CTL_ZERO_BYTES = 1 * MiB;
constexpr size_t WS_MOD = 1 * MiB, WS_WIN = 2 * MiB, WS_WOA = 11 * MiB, WS_WPB = 13 * MiB, WS_WOUT = 14 * MiB, WS_WGU = 16 * MiB, WS_WD = 144 * MiB;
constexpr size_t WS_H = 208 * MiB, WS_QL = 240 * MiB, WS_QI = 272 * MiB, WS_MISC = 288 * MiB, WS_U = 304 * MiB, WS_SG = 320 * MiB;
constexpr size_t WS_CKV = 384 * MiB, WS_CKVT = 388 * MiB, WS_POOLED = 392 * MiB, WS_MASK = 408 * MiB, WS_OLAT = 412 * MiB, WS_TMP = 444 * MiB, WS_MIX = 476 * MiB;
constexpr size_t WS_Z = 508 * MiB, WS_X1 = 572 * MiB, WS_SLOTMAP = 636 * MiB, WS_TOKSLOT = 638 * MiB, WS_GATE = 638 * MiB + 512 * 1024;
constexpr size_t WS_XPAD = 640 * MiB, WS_ACT = 784 * MiB, WS_Y = WS_XPAD, WS_KI = 928 * MiB, WS_WRB = 930 * MiB, WS_END = 931 * MiB;
constexpr size_t WS_WBA = WS_WOA, WS_WUKB = WS_WOA + 1 * MiB, WS_WUVT = WS_WOA + 1 * MiB + 256 * 1024, WS_YA = WS_OLAT;
constexpr int CW_GCNT = 0, CW_TSTART = 64, CW_BAR = 4096;

constexpr int RING_OFF = 0, RING_BYTES = 131072;
constexpr int LDSCTL_OFF = RING_BYTES, MISC_OFF = LDSCTL_OFF + 320;
constexpr int LDS_BYTES = 163840;

struct Frame {
    LAS unsigned char* lds;
    volatile LAS unsigned* MISCW;
    gu32* ctl;
    int tid, lane, wave, vcu, G;
    unsigned char* ws;
    float* out;
};
__device__ __forceinline__ const float* frame_in(int i) { typedef __attribute__((address_space(4))) const char* kptr_t; kptr_t ka = (kptr_t)__builtin_amdgcn_kernarg_segment_ptr(); asm volatile("" : "+s"(ka));
    const float* p = *(const float* __attribute__((address_space(4))) const*)(ka + 8 * i); return (const float*)(const GAS float*)p; }
typedef __bf16 bf2v __attribute__((ext_vector_type(2)));
typedef float f2v __attribute__((ext_vector_type(2)));
__device__ __forceinline__ unsigned pkbf(float a, float b) { f2v v = {a, b}; bf2v r = __builtin_convertvector(v, bf2v); return __builtin_bit_cast(unsigned, r); }
__device__ __forceinline__ size_t bl_off(int r, int k, int K) { return ((size_t)(r >> 8) * (size_t)(K >> 6) + (size_t)(k >> 6)) * 16384 + (size_t)((r & 255) * 64 + (k & 63)); }
__device__ __forceinline__ float bf2f(unsigned short u) { return __uint_as_float((unsigned)u << 16); }
__device__ __forceinline__ float sigm_fast(float x) { return __builtin_amdgcn_rcpf(1.f + __builtin_amdgcn_exp2f(-x * LOG2E)); }

typedef float f32x16 __attribute__((ext_vector_type(16)));
__device__ __forceinline__ bf16x8 pack8(float a0, float a1, float a2, float a3, float a4, float a5, float a6, float a7) {
    v4u p; p.x = pkbf(a0, a1); p.y = pkbf(a2, a3); p.z = pkbf(a4, a5); p.w = pkbf(a6, a7); return __builtin_bit_cast(bf16x8, p); }
#define MFMA32(a, b, c) __builtin_amdgcn_mfma_f32_32x32x16_bf16((a), (b), (c), 0, 0, 0)
__device__ __forceinline__ int krow16(int r, int hh) { return (r & 3) + 8 * (r >> 2) + 4 * hh; }

namespace pg8 {
struct EpiInProj {
    static constexpr bool PERM = true, AFTER_DRAIN = false; static constexpr int ID = 1;
    bf16_t *QL, *QI, *U, *SG; float* MISC; bf16_t* KI;
    __device__ __forceinline__ void operator()(const f32x4 (&acc)[2][2][4][2], const Unit& u, int wr, int wc, int fr_, int fq_) const {
        int fr = fr_, fq = fq_; asm volatile("" : "+v"(fr), "+v"(fq));
        const int row0 = u.pm * BM + wr * 64 + fr, c0 = wc * 32 + 8 * fq; const int pn = u.pn;
        if (pn == 4) {
#pragma unroll
            for (int ai = 0; ai < 2; ++ai)
#pragma unroll
                for (int m = 0; m < 4; ++m) { float* rowp = MISC + (size_t)(row0 + ai * HALF + m * 16) * 256 + c0;
#pragma unroll
                    for (int bj = 0; bj < 2; ++bj) { *(f32x4*)(rowp + bj * HALF) = acc[ai][bj][m][0]; *(f32x4*)(rowp + bj * HALF + 4) = acc[ai][bj][m][1]; }
                    if (wc < 2) { const f32x4 v0 = acc[ai][1][m][0], v1 = acc[ai][1][m][1]; u32x4 w; w.x = cvt_pk_bf16(v0[0], v0[1]); w.y = cvt_pk_bf16(v0[2], v0[3]); w.z = cvt_pk_bf16(v1[0], v1[1]); w.w = cvt_pk_bf16(v1[2], v1[3]);
                        *(u32x4*)(KI + (size_t)(row0 + ai * HALF + m * 16) * 64 + c0) = w; } }
        } else {
            bf16_t* base; int ld, colt; bool sg = false;
            if (pn < 2) { base = QL; ld = 512; colt = pn * 256; }
            else if (pn < 4) { base = QI; ld = 512; colt = (pn - 2) * 256; }
            else if (pn < 7) { base = U; ld = 512; colt = (pn - 5) * 256; }
            else { base = SG; ld = 2048; colt = (pn - 7) * 256; sg = true; }
#pragma unroll
            for (int ai = 0; ai < 2; ++ai)
#pragma unroll
                for (int m = 0; m < 4; ++m) { bf16_t* rowp = base + (size_t)(row0 + ai * HALF + m * 16) * ld + colt + c0;
#pragma unroll
                    for (int bj = 0; bj < 2; ++bj) { f32x4 v0 = acc[ai][bj][m][0], v1 = acc[ai][bj][m][1];
                        if (sg) {
#pragma unroll
                            for (int i = 0; i < 4; ++i) { v0[i] = sigm_fast(v0[i]); v1[i] = sigm_fast(v1[i]); } }
                        u32x4 w; w.x = cvt_pk_bf16(v0[0], v0[1]); w.y = cvt_pk_bf16(v0[2], v0[3]); w.z = cvt_pk_bf16(v1[0], v1[1]); w.w = cvt_pk_bf16(v1[2], v1[3]);
                        *(u32x4*)(rowp + bj * HALF) = w; } }
        }
    }
};
}

__device__ __forceinline__ void tr_item(const float* W, int ldw, int k0, int n0, int ncols, float scale, bf16* WT, int ldt, int drow0, LAS float* scr, int lane) {
    const int nn = lane & 31;
#pragma unroll 8
    for (int i = 0; i < 32; ++i) { const int kk = 2 * i + (lane >> 5); scr[kk * 33 + nn] = (nn < ncols) ? W[(size_t)(k0 + kk) * ldw + n0 + nn] * scale : 0.f; }
    LDS_WAIT(); asm volatile("" ::: "memory");
    const int c = lane & 7;
#pragma unroll
    for (int j = 0; j < 4; ++j) { const int n = (lane >> 3) + 8 * j; const LAS float* s = scr + (8 * c) * 33 + n;
        v4u o; o.x = pk2(s[0 * 33], s[1 * 33]); o.y = pk2(s[2 * 33], s[3 * 33]); o.z = pk2(s[4 * 33], s[5 * 33]); o.w = pk2(s[6 * 33], s[7 * 33]);
        if (n < ncols) *(GAS v4u*)(WT + bl_off(drow0 + n, k0 + 8 * c, ldt)) = o; }
    LDS_WAIT(); asm volatile("" ::: "memory");
}
__device__ __forceinline__ float clamp8(float x) { return fminf(fmaxf(x, -448.f), 448.f); }
struct TrDesc { const float* src; bf16* dst; int ldw; float scale; int f8; int pad_; };
__device__ __forceinline__ void tr_load(const TrDesc& d, int lane, f32x4 (&v)[16]) {
    const int kr = lane >> 4, nc = lane & 15; const float* src = d.src + (size_t)(16 * kr) * d.ldw + 4 * nc;
#pragma unroll
    for (int i = 0; i < 16; ++i) v[i] = __builtin_nontemporal_load((const f32x4*)(src + (size_t)i * d.ldw));
}
__device__ __forceinline__ void tr_finish(const TrDesc& d, LAS unsigned char* scr, int lane, const f32x4 (&v)[16]) {
    const int kr = lane >> 4, nc = lane & 15; const float scale = d.scale;
    if (d.f8) {
#pragma unroll
        for (int j = 0; j < 4; ++j) { const int n = 4 * nc + j; v4u o;
#pragma unroll
            for (int w4 = 0; w4 < 4; ++w4) { unsigned r = __builtin_amdgcn_cvt_pk_fp8_f32(clamp8(v[4 * w4][j] * scale), clamp8(v[4 * w4 + 1][j] * scale), 0u, false);
                r = __builtin_amdgcn_cvt_pk_fp8_f32(clamp8(v[4 * w4 + 2][j] * scale), clamp8(v[4 * w4 + 3][j] * scale), r, true); o[w4] = r; }
            *(LAS v4u*)(scr + n * 64 + ((kr ^ ((n >> 2) & 3)) << 4)) = o; }
        LDS_WAIT(); asm volatile("" ::: "memory");
        const int kc4 = lane & 3;
#pragma unroll
        for (int j = 0; j < 4; ++j) { const int n = (lane >> 2) + 16 * j; const v4u o = *(const LAS v4u*)(scr + n * 64 + ((kc4 ^ ((n >> 2) & 3)) << 4));
            *(GAS v4u*)((GAS unsigned char*)(d.dst + (size_t)n * 64) + 16 * kc4) = o; }
        LDS_WAIT(); asm volatile("" ::: "memory");
        return; }
#pragma unroll
    for (int j = 0; j < 4; ++j) { const int n = 4 * nc + j; const int f = (n >> 2) & 7;
#pragma unroll
        for (int hlf = 0; hlf < 2; ++hlf) { v4u o;
            o.x = pkbf(v[8 * hlf + 0][j] * scale, v[8 * hlf + 1][j] * scale); o.y = pkbf(v[8 * hlf + 2][j] * scale, v[8 * hlf + 3][j] * scale);
            o.z = pkbf(v[8 * hlf + 4][j] * scale, v[8 * hlf + 5][j] * scale); o.w = pkbf(v[8 * hlf + 6][j] * scale, v[8 * hlf + 7][j] * scale);
            *(LAS v4u*)(scr + n * 128 + (((2 * kr + hlf) ^ f) << 4)) = o; } }
    LDS_WAIT(); asm volatile("" ::: "memory");
    const int kc = lane & 7;
#pragma unroll
    for (int j = 0; j < 8; ++j) { const int n = (lane >> 3) + 8 * j; const v4u o = *(const LAS v4u*)(scr + n * 128 + ((kc ^ ((n >> 2) & 7)) << 4));
        *(GAS v4u*)(d.dst + (size_t)n * 64 + 8 * kc) = o; }
    LDS_WAIT(); asm volatile("" ::: "memory");
}
__device__ __forceinline__ void fold_pb(const float* w_pg, const float* pscale, const float* w_bp, bf16* Wpb_t, int task, int lane) {
    const int g = task >> 8, nb = (task >> 4) & 15, c0 = (task & 15) * 8; const int n = nb * 64 + lane;
    const float* pg = w_pg + (size_t)g * 16384 + c0 * 128; float a[8] = {0, 0, 0, 0, 0, 0, 0, 0};
#pragma unroll 4
    for (int d4 = 0; d4 < 32; ++d4) { float v[4]; const f32x4 ps = *(const f32x4*)(pscale + g * 128 + 4 * d4);
#pragma unroll
        for (int i = 0; i < 4; ++i) v[i] = w_bp[(size_t)(g * 128 + 4 * d4 + i) * 1024 + n] * ps[i];
#pragma unroll
        for (int j = 0; j < 8; ++j) { const f32x4 u = *(const f32x4*)(pg + j * 128 + 4 * d4); a[j] += (v[0] * u.x + v[1] * u.y) + (v[2] * u.z + v[3] * u.w); } }
    v4u o; o.x = pk2(a[0], a[1]); o.y = pk2(a[2], a[3]); o.z = pk2(a[4], a[5]); o.w = pk2(a[6], a[7]);
    *(GAS v4u*)(Wpb_t + bl_off(n, g * 128 + c0, 512)) = o;
}
template <int VAR>
__device__ __forceinline__ void p0_prologue(Frame& F) {
    const float* c = frame_in(1); const float* w_ada = frame_in(2); const float* b_ada = frame_in(3); const float* w_in = frame_in(4);
    const float* w_uk = frame_in(6); const float* w_uv = frame_in(7); const float* w_pg = frame_in(8); const float* pscale = frame_in(9);
    const float* w_ba = frame_in(10); const float* w_bp = frame_in(11); const float* w_out = frame_in(12); const float* w_gu = frame_in(17); const float* w_d = frame_in(19);
    bf16* Win_t = (bf16*)(F.ws + WS_WIN); bf16* Wpb_t = (bf16*)(F.ws + WS_WPB); bf16* Wout_t = (bf16*)(F.ws + WS_WOUT);
    bf16* Wgu_t = (bf16*)(F.ws + WS_WGU); bf16* Wd_t = (bf16*)(F.ws + WS_WD); float* MOD = (float*)(F.ws + WS_MOD);
    for (int cg = blockIdx.x; cg < 256; cg += F.G) {
        LAS float* cs = (LAS float*)(F.lds + 69632); LAS float* red = (LAS float*)(F.lds + 69632 + 32768);
        for (int i = F.tid; i < 8192; i += 512) { const float v = c[i]; cs[i] = v / (1.f + __expf(-v)); }
        __syncthreads();
        float acc[8] = {0, 0, 0, 0, 0, 0, 0, 0}; const int cc = F.lane & 31, rp = F.lane >> 5; const bool act = cc < 24; const float* wp = w_ada + cg * 24 + (act ? cc : 0);
#pragma unroll 16
        for (int i = 0; i < 64; ++i) { const int k = F.wave * 128 + 2 * i + rp; float w = __builtin_nontemporal_load(wp + (size_t)k * 6144); w = act ? w : 0.f;
#pragma unroll
            for (int b = 0; b < 8; ++b) acc[b] += cs[b * 1024 + k] * w; }
#pragma unroll
        for (int b = 0; b < 8; ++b) red[((F.wave * 2 + rp) * 8 + b) * 32 + cc] = acc[b];
        __syncthreads();
        if (F.tid < 256) { const int b = F.tid >> 5, l = F.tid & 31; if (l < 24) { float s = 0.f;
#pragma unroll
            for (int w = 0; w < 16; ++w) s += red[(w * 8 + b) * 32 + l];
            MOD[b * 6144 + cg * 24 + l] = s + b_ada[cg * 24 + l]; } }
        __syncthreads();
    }
    LAS unsigned char* scr8 = F.lds + F.wave * 8448; LAS float* scr = (LAS float*)scr8;
    const int gw = F.vcu * NWAVES + F.wave, NGW = F.G * NWAVES;
    constexpr int I_FQ = 64  , I_FO = 64  , I_FP = 1024, I_Z = 56, I_WI = 16, I_WR = 64, NSMALL = I_FQ + I_FO + I_FP + I_Z + I_WI + I_WR;
    for (int it = gw; it < NSMALL; it += NGW) {
        int r = it;
        if (r < I_FQ) {
            bf16* WukB = (bf16*)(F.ws + WS_WUKB); const int h = r >> 3, rr = (r & 7) * 16 + (F.lane >> 2), dc = F.lane & 3; const float* sp = w_uk + (size_t)rr * 512 + h * 64 + dc * 16;
            const f32x4 a = *(const f32x4*)sp, b = *(const f32x4*)(sp + 4), c4 = *(const f32x4*)(sp + 8), d4 = *(const f32x4*)(sp + 12);
            GAS v4u* dp = (GAS v4u*)(WukB + (size_t)(h * 128 + rr) * 64 + dc * 16);
            dp[0] = (v4u){pkbf(a.x, a.y), pkbf(a.z, a.w), pkbf(b.x, b.y), pkbf(b.z, b.w)}; dp[1] = (v4u){pkbf(c4.x, c4.y), pkbf(c4.z, c4.w), pkbf(d4.x, d4.y), pkbf(d4.z, d4.w)};
            continue; } r -= I_FQ;
        if (r < I_FO) {
            bf16* WuvT = (bf16*)(F.ws + WS_WUVT); const int h = r >> 3, dp = (r & 7) * 8 + (F.lane >> 3), c0 = (F.lane & 7) * 2;
#pragma unroll
            for (int cc = 0; cc < 2; ++cc) { const int cidx = c0 + cc, ks = cidx >> 1, hh = cidx & 1; float v[8];
#pragma unroll
                for (int j = 0; j < 8; ++j) v[j] = w_uv[(size_t)(16 * ks + 8 * (j >> 2) + 4 * hh + (j & 3)) * 512 + h * 64 + dp];
                *(GAS v4u*)(WuvT + (size_t)(h * 64 + dp) * 128 + cidx * 8) = (v4u){pkbf(v[0], v[1]), pkbf(v[2], v[3]), pkbf(v[4], v[5]), pkbf(v[6], v[7])}; }
            continue; } r -= I_FO;
        if (r < I_FP) { fold_pb(w_pg, pscale, w_bp, Wpb_t, r, F.lane); continue; } r -= I_FP;
        if (r < I_Z) { *(GAS v4u*)(Win_t + bl_off(1224 + r, F.lane * 8, 1024)) = (v4u){0u, 0u, 0u, 0u}; *(GAS v4u*)(Win_t + bl_off(1224 + r, (F.lane + 64) * 8, 1024)) = (v4u){0u, 0u, 0u, 0u}; continue; } r -= I_Z;
        if (r < I_WI) { tr_item(w_in, INC, r * 64, O_WI, 8, 0.35355339059327373f, Win_t, 1024, 1216, scr, F.lane); continue; } r -= I_WI;
        {
            const float* w_r = frame_in(15); bf16* WrB = (bf16*)(F.ws + WS_WRB); const int ks = r, e = F.lane & 31, h8 = F.lane >> 5; float v[8]; unsigned hi[4], lo[4];
#pragma unroll
            for (int j = 0; j < 8; ++j) v[j] = w_r[(size_t)(16 * ks + 8 * h8 + j) * 32 + e];
#pragma unroll
            for (int j = 0; j < 4; ++j) { hi[j] = pkbf(v[2 * j], v[2 * j + 1]); lo[j] = pkbf(v[2 * j] - __uint_as_float(hi[j] << 16), v[2 * j + 1] - __uint_as_float(hi[j] & 0xffff0000u)); }
            *(GAS v4u*)(WrB + ((size_t)(ks * 2) * 64 + F.lane) * 8) = (v4u){hi[0], hi[1], hi[2], hi[3]}; *(GAS v4u*)(WrB + ((size_t)(ks * 2 + 1) * 64 + F.lane) * 8) = (v4u){lo[0], lo[1], lo[2], lo[3]}; }
    }
    constexpr int I_Q = 128, I_QI = 128, I_CKV = 32, I_KI = 16, I_U = 128, I_G = 512, I_OUT = 256, I_BA = 128, I_GU = 32 * 512, I_D = 32 * 256;
    constexpr int NTR = I_Q + I_QI + I_CKV + I_KI + I_U + I_G + I_OUT + I_BA + (VAR >= 1 ? 0 : I_GU + I_D);
    auto decode = [&](int r) -> TrDesc {
        if (r < I_Q) return TrDesc{w_in + (size_t)((r >> 3) * 64) * INC + O_Q + (r & 7) * 64, Win_t + bl_off((r & 7) * 64, (r >> 3) * 64, 1024), INC, 0.125f * LOG2E, 0, 0}; r -= I_Q;
        if (r < I_QI) return TrDesc{w_in + (size_t)((r >> 3) * 64) * INC + O_QI + (r & 7) * 64, Win_t + bl_off(512 + (r & 7) * 64, (r >> 3) * 64, 1024), INC, 0.125f, 0, 0}; r -= I_QI;
        if (r < I_CKV) return TrDesc{w_in + (size_t)((r >> 1) * 64) * INC + O_CKV + (r & 1) * 64, Win_t + bl_off(1024 + (r & 1) * 64, (r >> 1) * 64, 1024), INC, 1.f, 0, 0}; r -= I_CKV;
        if (r < I_KI) return TrDesc{w_in + (size_t)(r * 64) * INC + O_KI, Win_t + bl_off(1152, r * 64, 1024), INC, 1.f, 0, 0}; r -= I_KI;
        if (r < I_U) return TrDesc{w_in + (size_t)((r >> 3) * 64) * INC + O_U + (r & 7) * 64, Win_t + bl_off(1280 + (r & 7) * 64, (r >> 3) * 64, 1024), INC, 1.f, 0, 0}; r -= I_U;
        if (r < I_G) return TrDesc{w_in + (size_t)((r >> 5) * 64) * INC + O_G + (r & 31) * 64, Win_t + bl_off(1792 + (r & 31) * 64, (r >> 5) * 64, 1024), INC, 1.f, 0, 0}; r -= I_G;
        if (r < I_OUT) return TrDesc{w_out + (size_t)((r >> 4) * 64) * 1024 + (r & 15) * 64, Wout_t + bl_off((r & 15) * 64, (r >> 4) * 64, 1024), 1024, 1.f, 0, 0}; r -= I_OUT;
        if (r < I_BA) return TrDesc{w_ba + (size_t)((r >> 4) * 64) * 1024 + (r & 15) * 64, (bf16*)(F.ws + WS_WBA) + bl_off((r & 15) * 64, (r >> 4) * 64, 512), 1024, 1.f, 0, 0}; r -= I_BA;
        if (r < I_GU) { const int e = r >> 9, q = r & 511, kb = q >> 5, n0 = (q & 31) * 64;
            const int drow = (n0 < 1024) ? ((n0 >> 7) * 256 + (n0 & 127)) : (((n0 - 1024) >> 7) * 256 + 128 + ((n0 - 1024) & 127));
            return TrDesc{w_gu + ((size_t)e * 1024 + kb * 64) * 2048 + n0, Wgu_t + bl_off(e * 2048 + drow, kb * 32, 512), 2048, W8_GU, 1, 0}; } r -= I_GU;
        { const int e = r >> 8, q = r & 255, kb = q >> 4, n0 = (q & 15) * 64;
          return TrDesc{w_d + ((size_t)e * 1024 + kb * 64) * 1024 + n0, Wd_t + bl_off(e * 1024 + n0, kb * 32, 512), 1024, W8_D, 1, 0}; }
    };
    {   f32x4 vA[16], vB[16]; TrDesc dA, dB; int it = gw;
        if (it < NTR) { dA = decode(it); tr_load(dA, F.lane, vA); }
        while (it < NTR) {
            int itn = it + NGW; if (itn < NTR) { dB = decode(itn); tr_load(dB, F.lane, vB); }
            tr_finish(dA, scr8, F.lane, vA);
            it = itn; if (it >= NTR) break;
            itn = it + NGW; if (itn < NTR) { dA = decode(itn); tr_load(dA, F.lane, vA); }
            tr_finish(dB, scr8, F.lane, vB);
            it = itn;
        }
    }
}
__device__ __forceinline__ void p1_modulate(Frame& F) {
    const float* x = frame_in(0); const float* MOD = (const float*)(F.ws + WS_MOD); bf16* H = (bf16*)(F.ws + WS_H);
    const int gw = F.vcu * NWAVES + F.wave, NGW = F.G * NWAVES;
    for (int m = gw; m < T; m += NGW) { const int b = m >> 11;
        const GAS f32x4* xr = (const GAS f32x4*)(x + (size_t)m * D) + F.lane;
#pragma unroll
        for (int j = 0; j < 4; ++j) { const f32x4 v = xr[64 * j]; const int col = 4 * F.lane + 256 * j;
            const f32x4 sh = *(const f32x4*)(MOD + b * 6144 + col), sc = *(const f32x4*)(MOD + b * 6144 + 1024 + col);
            const f32x4 h = v * (sc + 1.0f) + sh;
            *(GAS unsigned long long*)(H + bl_off(m, col, D)) = (unsigned long long)pk2(h.x, h.y) | ((unsigned long long)pk2(h.z, h.w) << 32); }
    }
}
constexpr int MOE_TAB_SLOTS = 10, LC_ROWTAB = LDSCTL_OFF + 8192;
constexpr int LC_LCNT = LDSCTL_OFF + 1024, LC_BASE = LDSCTL_OFF + 1280, LC_TSTART = LDSCTL_OFF + 1536, LC_LIST = LDSCTL_OFF + 4096;
namespace pg8 {
__device__ __forceinline__ float bfl(unsigned w) { return __uint_as_float(w << 16); }
__device__ __forceinline__ float bfh(unsigned w) { return __uint_as_float(w & 0xffff0000u); }
struct EpiGateMul {
    static constexpr bool PERM = true, AFTER_DRAIN = false; static constexpr int ID = 2;
    bf16_t* O; const bf16_t* SG; int goff, pad;
    __device__ __forceinline__ void operator()(const f32x4 (&acc)[2][2][4][2], const Unit& u, int wr, int wc, int fr_, int fq_) const {
        int fr = fr_, fq = fq_; asm volatile("" : "+v"(fr), "+v"(fq));
        const int row0 = u.pm * BM + wr * 64 + fr, col0 = u.pn * BM + wc * 32 + 8 * fq;
#pragma unroll
        for (int ai = 0; ai < 2; ++ai)
#pragma unroll
            for (int m = 0; m < 4; ++m) { const size_t row = (size_t)(row0 + ai * HALF + m * 16);
#pragma unroll
                for (int bj = 0; bj < 2; ++bj) { const u32x4 g = *(const u32x4*)(SG + row * 2048 + goff + col0 + bj * HALF); const f32x4 v0 = acc[ai][bj][m][0], v1 = acc[ai][bj][m][1];
                    u32x4 w; w.x = cvt_pk_bf16(v0[0] * bfl(g.x), v0[1] * bfh(g.x)); w.y = cvt_pk_bf16(v0[2] * bfl(g.y), v0[3] * bfh(g.y));
                    w.z = cvt_pk_bf16(v1[0] * bfl(g.z), v1[1] * bfh(g.z)); w.w = cvt_pk_bf16(v1[2] * bfl(g.w), v1[3] * bfh(g.w));
                    *(u32x4*)(O + row * 1024 + col0 + bj * HALF) = w; } }
    }
};
struct EpiGateAdd {
    static constexpr bool PERM = true, AFTER_DRAIN = false; static constexpr int ID = 3;
    bf16_t* O; const bf16_t* TMPB; const bf16_t* SG; int goff, pad;
    __device__ __forceinline__ void operator()(const f32x4 (&acc)[2][2][4][2], const Unit& u, int wr, int wc, int fr_, int fq_) const {
        int fr = fr_, fq = fq_; asm volatile("" : "+v"(fr), "+v"(fq));
        const int row0 = u.pm * BM + wr * 64 + fr, col0 = u.pn * BM + wc * 32 + 8 * fq;
#pragma unroll
        for (int ai = 0; ai < 2; ++ai)
#pragma unroll
            for (int m = 0; m < 4; ++m) { const size_t row = (size_t)(row0 + ai * HALF + m * 16);
#pragma unroll
                for (int bj = 0; bj < 2; ++bj) { const u32x4 g = *(const u32x4*)(SG + row * 2048 + goff + col0 + bj * HALF); const u32x4 t = *(const u32x4*)(TMPB + row * 1024 + col0 + bj * HALF);
                    const f32x4 v0 = acc[ai][bj][m][0], v1 = acc[ai][bj][m][1];
                    u32x4 w; w.x = cvt_pk_bf16(bfl(t.x) + v0[0] * bfl(g.x), bfh(t.x) + v0[1] * bfh(g.x)); w.y = cvt_pk_bf16(bfl(t.y) + v0[2] * bfl(g.y), bfh(t.y) + v0[3] * bfh(g.y));
                    w.z = cvt_pk_bf16(bfl(t.z) + v1[0] * bfl(g.z), bfh(t.z) + v1[1] * bfh(g.z)); w.w = cvt_pk_bf16(bfl(t.w) + v1[2] * bfl(g.w), bfh(t.w) + v1[3] * bfh(g.w));
                    *(u32x4*)(O + bl_off((int)row, col0 + bj * HALF, 1024)) = w; } }
    }
};
struct EpiResid {
    static constexpr bool PERM = false, AFTER_DRAIN = false; static constexpr int ID = 4;
    float* Z; const float* x; const float* gate;
    __device__ __forceinline__ void operator()(const f32x4 (&acc)[2][2][4][2], const Unit& u, int wr, int wc, int fr_, int fq_) const {
        int fr = fr_, fq = fq_; asm volatile("" : "+v"(fr), "+v"(fq));
        const int row0 = u.pm * BM + wr * 64 + fr, col0 = u.pn * BM + wc * 32 + 4 * fq; const int b = (u.pm * BM) >> 11;
        f32x4 gv[2][2];
#pragma unroll
        for (int bj = 0; bj < 2; ++bj)
#pragma unroll
            for (int n = 0; n < 2; ++n) gv[bj][n] = *(const f32x4*)(gate + b * 6144 + col0 + bj * HALF + n * 16);
#pragma unroll
        for (int ai = 0; ai < 2; ++ai)
#pragma unroll
            for (int m = 0; m < 4; ++m) { const size_t off = (size_t)(row0 + ai * HALF + m * 16) * 1024 + col0;
#pragma unroll
                for (int bj = 0; bj < 2; ++bj)
#pragma unroll
                    for (int n = 0; n < 2; ++n) { const f32x4 xv = *(const f32x4*)(x + off + bj * HALF + n * 16); *(f32x4*)(Z + off + bj * HALF + n * 16) = xv * ALPHA + gv[bj][n] * acc[ai][bj][m][n]; } }
    }
};
struct EpiSwiglu {
    static constexpr bool PERM = true, AFTER_DRAIN = false; static constexpr int ID = 5;
    bf16_t* ACT; const float* bgu;
    __device__ __forceinline__ void operator()(const f32x4 (&acc)[2][2][4][2], const Unit& u, int wr, int wc, int fr_, int fq_) const {
        int fr = fr_, fq = fq_; asm volatile("" : "+v"(fr), "+v"(fq));
        const int e = u.pn >> 3, j = u.pn & 7; const int row0 = u.pm * BM + wr * 64 + fr, cc = wc * 32 + 8 * fq;
        const float* bg = bgu + e * 2048 + j * 128 + cc; f32x4 bgl[2], bli[2];
#pragma unroll
        for (int n = 0; n < 2; ++n) { bgl[n] = *(const f32x4*)(bg + 4 * n); bli[n] = *(const f32x4*)(bg + 1024 + 4 * n); }
#pragma unroll
        for (int ai = 0; ai < 2; ++ai)
#pragma unroll
            for (int m = 0; m < 4; ++m) { float o[8];
#pragma unroll
                for (int n = 0; n < 2; ++n) { const f32x4 gl4 = acc[ai][0][m][n] * (1.f / (A8_H * W8_GU)) + bgl[n], li4 = acc[ai][1][m][n] * (1.f / (A8_H * W8_GU)) + bli[n];
#pragma unroll
                    for (int i = 0; i < 4; ++i) { const float gl = fminf(gl4[i], 7.f), li = fminf(fmaxf(li4[i], -7.f), 7.f);
                        o[4 * n + i] = gl * __builtin_amdgcn_rcpf(1.f + __builtin_amdgcn_exp2f(gl * (-1.702f * LOG2E))) * fmaf(li, A8_ACT, A8_ACT); } }
                unsigned w0 = __builtin_amdgcn_cvt_pk_fp8_f32(o[0], o[1], 0u, false); w0 = __builtin_amdgcn_cvt_pk_fp8_f32(o[2], o[3], w0, true);
                unsigned w1 = __builtin_amdgcn_cvt_pk_fp8_f32(o[4], o[5], 0u, false); w1 = __builtin_amdgcn_cvt_pk_fp8_f32(o[6], o[7], w1, true);
                *(unsigned long long*)(ACT + bl_off(row0 + ai * HALF + m * 16, (j * 128 + cc) >> 1, 512)) = (unsigned long long)w0 | ((unsigned long long)w1 << 32); }
    }
};
template <bool BIAS>
struct EpiDownT {
    static constexpr bool PERM = true, AFTER_DRAIN = false; static constexpr int ID = 6;
    bf16_t* Y; const float* bd;
    __device__ __forceinline__ void operator()(const f32x4 (&acc)[2][2][4][2], const Unit& u, int wr, int wc, int fr_, int fq_) const {
        int fr = fr_, fq = fq_; asm volatile("" : "+v"(fr), "+v"(fq));
        const int e = u.pn >> 2, j = u.pn & 3; const int row0 = u.pm * BM + wr * 64 + fr, col0 = j * 256 + wc * 32 + 8 * fq;
        f32x4 bv[2][2];
#pragma unroll
        for (int bj = 0; bj < 2; ++bj)
#pragma unroll
            for (int n = 0; n < 2; ++n) bv[bj][n] = BIAS ? *(const f32x4*)(bd + e * 1024 + col0 + bj * HALF + 4 * n) : (f32x4){0.f, 0.f, 0.f, 0.f};
#pragma unroll
        for (int ai = 0; ai < 2; ++ai)
#pragma unroll
            for (int m = 0; m < 4; ++m) { bf16_t* rowp = Y + (size_t)(row0 + ai * HALF + m * 16) * 1024 + col0;
#pragma unroll
                for (int bj = 0; bj < 2; ++bj) { const f32x4 v0 = acc[ai][bj][m][0] * (1.f / (A8_ACT * W8_D)) + bv[bj][0], v1 = acc[ai][bj][m][1] * (1.f / (A8_ACT * W8_D)) + bv[bj][1];
                    u32x4 w; w.x = cvt_pk_bf16(v0[0], v0[1]); w.y = cvt_pk_bf16(v0[2], v0[3]); w.z = cvt_pk_bf16(v1[0], v1[1]); w.w = cvt_pk_bf16(v1[2], v1[3]);
                    *(u32x4*)(rowp + bj * HALF) = w; } }
    }
};
typedef EpiDownT<true> EpiDown;
struct EpiNull {
    static constexpr bool PERM = true, AFTER_DRAIN = false; static constexpr int ID = 7;
    long long dummy;
    __device__ __forceinline__ void operator()(const f32x4 (&acc)[2][2][4][2], const Unit&, int, int, int, int) const {
#pragma unroll
        for (int a = 0; a < 2; ++a)
#pragma unroll
            for (int b = 0; b < 2; ++b)
#pragma unroll
                for (int m = 0; m < 4; ++m) asm volatile("" :: "v"(acc[a][b][m][0]), "v"(acc[a][b][m][1]));
    }
};
template <bool GATHER_, bool REV = false>
struct MoeOrderT {
    static constexpr bool GATHER = GATHER_;
#ifndef MOE_PREFETCH
#define MOE_PREFETCH 0
#endif
    static constexpr int PREFETCH = MOE_PREFETCH;
    const PG8_LAS int* tstart; int NT, G, c;
    const PG8_LAS int* rowtab; const int* slotmap; const int* cnt;
    __device__ __forceinline__ int arow(int slot, const Unit& u, int r) const {
        if (slot < MOE_TAB_SLOTS) return rowtab[slot * 256 + r];
        const int e = u.pn / NT, rank = (u.pm - tstart[e]) * 256 + r; return rank < cnt[e] ? slotmap[e * T + rank] : 0;
    }
    __device__ __forceinline__ bool next(int i, Unit& u) const {
        const int x = c & 7, li = c >> 3, per = G >> 3; int L = i * per + li;
#pragma unroll 1
        for (int j = 0; j < 4; ++j) { const int e = REV ? x + 8 * (3 - j) : x + 8 * j; const int nte = tstart[e + 1] - tstart[e], nu = nte * NT;
            if (L < nu) { u.pm = tstart[e] + L % nte; u.pn = e * NT + L / nte; return true; }
            L -= nu; }
        return false;
    }
    __device__ __forceinline__ void a_ready(const Unit&) const {}
    __device__ __forceinline__ void done(const Unit&) const {}
};
typedef MoeOrderT<true> MoeOrderG; typedef MoeOrderT<false, true> MoeOrder;
}

__device__ __forceinline__ float wave_sum(float v) {
#pragma unroll
    for (int o = 1; o < 64; o <<= 1) v += __shfl_xor(v, o);
    return v;
}
__device__ __forceinline__ void p3_post(Frame& F) {
    const float* MISC = (const float*)(F.ws + WS_MISC); const float* kvg = frame_in(5); bf16* CKV = (bf16*)(F.ws + WS_CKV); bf16* CKVT = (bf16*)(F.ws + WS_CKVT);
    const bf16* U = (const bf16*)(F.ws + WS_U); bf16* POOLED = (bf16*)(F.ws + WS_POOLED);
    LAS bf16* tile = (LAS bf16*)(F.lds);
    for (int task = blockIdx.x; task < 256; task += F.G) {
        const int t0 = task * 64; const int row = F.tid >> 3, seg = F.tid & 7;
        const float* src = MISC + (size_t)(t0 + row) * 256 + seg * 16; f32x4 v[4]; float ss = 0.f;
#pragma unroll
        for (int i = 0; i < 4; ++i) { v[i] = *(const f32x4*)(src + 4 * i); ss += (v[i].x * v[i].x + v[i].y * v[i].y) + (v[i].z * v[i].z + v[i].w * v[i].w); }
        ss += __shfl_xor(ss, 1); ss += __shfl_xor(ss, 2); ss += __shfl_xor(ss, 4);
        const float rs = 1.0f / sqrtf(ss * (1.f / 128.f) + LN_EPS);
        unsigned w[8];
#pragma unroll
        for (int i = 0; i < 4; ++i) { const f32x4 g = *(const f32x4*)(kvg + seg * 16 + 4 * i); w[2 * i] = pk2(v[i].x * rs * g.x, v[i].y * rs * g.y); w[2 * i + 1] = pk2(v[i].z * rs * g.z, v[i].w * rs * g.w); }
        GAS v4u* dst = (GAS v4u*)(CKV + (size_t)(t0 + row) * 128 + seg * 16); dst[0] = (v4u){w[0], w[1], w[4], w[5]}; dst[1] = (v4u){w[2], w[3], w[6], w[7]};
        LAS v4u* lt = (LAS v4u*)(tile + row * 128 + seg * 16); lt[0] = (v4u){w[0], w[1], w[2], w[3]}; lt[1] = (v4u){w[4], w[5], w[6], w[7]};
        __syncthreads();
        { const int d = F.tid >> 2, part = F.tid & 3; unsigned o[8];
#pragma unroll
          for (int q = 0; q < 16; q += 2) { unsigned pr[2];
#pragma unroll
              for (int z = 0; z < 2; ++z) { const int p = part * 16 + q + z; const int j = p & 7, h = (p >> 3) & 1, tt = (p >> 4) & 1, kb = p >> 5; const int key = kb * 32 + 16 * tt + 8 * (j >> 2) + 4 * h + (j & 3); pr[z] = tile[key * 128 + d]; }
              o[q >> 1] = pr[0] | (pr[1] << 16); }
          const int b = task >> 5, kt = task & 31;
          GAS v4u* dt = (GAS v4u*)(CKVT + ((size_t)(b * 128 + d) * 2048) + kt * 64 + part * 16); dt[0] = (v4u){o[0], o[1], o[2], o[3]}; dt[1] = (v4u){o[4], o[5], o[6], o[7]}; }
        __syncthreads();
    }
    LAS bf16* ut = (LAS bf16*)(F.lds + 16384);
    for (int task = blockIdx.x; task < 256; task += F.G) { const int t0 = task * 64, s0 = t0 & 2047;
        __syncthreads();
#pragma unroll
        for (int i = 0; i < 10; ++i) { const int c = F.tid + 512 * i, row = c >> 6, ch = c & 63; const int sp = s0 - 16 + row;
            v4u v = (v4u){0u, 0u, 0u, 0u}; if (sp >= 0) v = *(const GAS v4u*)(U + (size_t)(t0 - 16 + row) * 512 + ch * 8);
            *(LAS v4u*)(ut + row * 512 + ch * 8) = v; }
        __syncthreads();
        const int c = F.tid, g = c >> 7, w = 2 << g; float win = 0.f;
        for (int j = 16 - w; j < 16; ++j) win += bf2f(ut[j * 512 + c]);
        for (int j = 16; j < 80; ++j) { const float cur = bf2f(ut[j * 512 + c]); win += cur; win -= bf2f(ut[(j - w) * 512 + c]);
            const int sq = s0 + j - 16; const int cntw = (sq + 1 < w) ? (sq + 1) : w; POOLED[bl_off(t0 + j - 16, c, 512)] = (bf16)f2bf(win / (float)cntw - cur); }
    }
}
constexpr int P7_AL = 0, P7_LOGIT = 131072 - 4096;
__device__ __forceinline__ void p7_ln1_route(Frame& F, int cw_gcnt) {
    const float* Z = (const float*)(F.ws + WS_Z); const float* g1 = frame_in(13); const float* b1 = frame_in(14); const float* b_r = frame_in(16);
    const float* MOD = (const float*)(F.ws + WS_MOD); bf16* X1 = (bf16*)(F.ws + WS_X1); bf16* H2 = (bf16*)(F.ws + WS_H); const bf16* WrB = (const bf16*)(F.ws + WS_WRB);
    int* gcnt = (int*)(F.ctl + cw_gcnt); int* SLOTMAP = (int*)(F.ws + WS_SLOTMAP); int* TOKSLOT = (int*)(F.ws + WS_TOKSLOT); float* GATE = (float*)(F.ws + WS_GATE);
    LAS unsigned char* AL = F.lds + P7_AL; LAS float* red = (LAS float*)(F.lds);
    LAS float* logit = (LAS float*)(F.lds + 65536);
    LAS int* lcnt = (LAS int*)(F.lds + LC_LCNT); LAS int* lbase = (LAS int*)(F.lds + LC_BASE); LAS int* list = (LAS int*)(F.lds + LC_LIST);
    if (F.tid < 32) lcnt[F.tid] = 0;
    const int hh = F.lane >> 5, l31 = F.lane & 31;
    bf16x8 Bh[8], Bl[8];
#pragma unroll
    for (int s = 0; s < 8; ++s) { const bf16* p = WrB + ((size_t)((F.wave * 8 + s) * 2) * 64 + F.lane) * 8; Bh[s] = *(const GAS bf16x8*)p; Bl[s] = *(const GAS bf16x8*)(p + 64 * 8); }
    const int rows_per_wg = T / F.G;
    for (int step = 0; step < rows_per_wg / 32; ++step) { const int m0 = blockIdx.x * rows_per_wg + step * 32;
        __syncthreads();
        f32x4 vz[4][4];
#pragma unroll
        for (int rr = 0; rr < 4; ++rr) { const GAS f32x4* zr = (const GAS f32x4*)(Z + (size_t)(m0 + F.wave * 4 + rr) * D) + F.lane;
#pragma unroll
            for (int j = 0; j < 4; ++j) vz[rr][j] = zr[64 * j]; }
#pragma unroll
        for (int rr = 0; rr < 4; ++rr) { const int row = F.wave * 4 + rr, m = m0 + row, b = m >> 11;
            f32x4 v[4]; float s = 0.f;
#pragma unroll
            for (int j = 0; j < 4; ++j) { v[j] = vz[rr][j]; s += (v[j].x + v[j].y) + (v[j].z + v[j].w); }
            const float mean = wave_sum(s) * (1.f / D); float s2 = 0.f;
#pragma unroll
            for (int j = 0; j < 4; ++j) { v[j] = v[j] - mean; s2 += (v[j].x * v[j].x + v[j].y * v[j].y) + (v[j].z * v[j].z + v[j].w * v[j].w); }
            const float rstd = 1.f / sqrtf(wave_sum(s2) * (1.f / D) + LN_EPS);
#pragma unroll
            for (int j = 0; j < 4; ++j) { const int col = 4 * F.lane + 256 * j;
                const f32x4 gg = *(const f32x4*)(g1 + col), bb = *(const f32x4*)(b1 + col); const f32x4 x1 = v[j] * rstd * gg + bb;
                *((GAS unsigned long long*)(X1 + (size_t)m * D) + F.lane + 64 * j) = (unsigned long long)pkbf(x1.x, x1.y) | ((unsigned long long)pkbf(x1.z, x1.w) << 32);
                const f32x4 sh = *(const f32x4*)(MOD + b * 6144 + 3 * 1024 + col), sc = *(const f32x4*)(MOD + b * 6144 + 4 * 1024 + col); const f32x4 h2 = x1 * (sc + 1.0f) + sh;
                const unsigned h01 = pkbf(h2.x, h2.y), h23 = pkbf(h2.z, h2.w);
                { unsigned r8 = __builtin_amdgcn_cvt_pk_fp8_f32(clamp8(h2.x * A8_H), clamp8(h2.y * A8_H), 0u, false); r8 = __builtin_amdgcn_cvt_pk_fp8_f32(clamp8(h2.z * A8_H), clamp8(h2.w * A8_H), r8, true);
                  *(GAS unsigned*)(H2 + bl_off(m, col >> 1, D / 2)) = r8; }
                const unsigned l01 = pkbf(h2.x - pg8::bfl(h01), h2.y - pg8::bfh(h01)), l23 = pkbf(h2.z - pg8::bfl(h23), h2.w - pg8::bfh(h23));
                const int chunk = 32 * j + (F.lane >> 1); const int off = row * 2048 + (((chunk & ~15) | ((chunk ^ row) & 15)) << 4) + (F.lane & 1) * 8;
                *(LAS unsigned long long*)(AL + off) = (unsigned long long)h01 | ((unsigned long long)h23 << 32);
                *(LAS unsigned long long*)(AL + 65536 + off) = (unsigned long long)l01 | ((unsigned long long)l23 << 32); } }
        __syncthreads();
        f32x16 acc;
#pragma unroll
        for (int r = 0; r < 16; ++r) acc[r] = 0.f;
#pragma unroll
        for (int s = 0; s < 8; ++s) { const int chunk = 2 * (F.wave * 8 + s) + hh; const int off = l31 * 2048 + (((chunk & ~15) | ((chunk ^ l31) & 15)) << 4);
            const bf16x8 Ah = *(const LAS bf16x8*)(AL + off), Alo = *(const LAS bf16x8*)(AL + 65536 + off);
            acc = MFMA32(Ah, Bh[s], acc); acc = MFMA32(Ah, Bl[s], acc); acc = MFMA32(Alo, Bh[s], acc); }
        __syncthreads();
#pragma unroll
        for (int r = 0; r < 16; ++r) red[(F.wave * 32 + krow16(r, hh)) * 32 + l31] = acc[r];
        __syncthreads();
        { const int row = F.tid >> 4, e0 = (F.tid & 15) * 2; float s0 = 0.f, s1 = 0.f;
#pragma unroll
          for (int w = 0; w < 8; ++w) { s0 += red[(w * 32 + row) * 32 + e0]; s1 += red[(w * 32 + row) * 32 + e0 + 1]; }
          logit[row * 33 + e0] = s0 + b_r[e0]; logit[row * 33 + e0 + 1] = s1 + b_r[e0 + 1]; }
        __syncthreads();
        if (F.tid < 32) { const int row = F.tid, m = m0 + row; float lg[32];
#pragma unroll
            for (int e = 0; e < 32; ++e) lg[e] = logit[row * 33 + e];
            int se[4]; float sv[4]; unsigned used = 0u;
#pragma unroll
            for (int k = 0; k < 4; ++k) { int best = 0; float bv = -INFINITY; bool have = false;
#pragma unroll
                for (int e = 0; e < 32; ++e) { const bool ok = !((used >> e) & 1u) && (!have || lg[e] > bv); if (ok) { best = e; bv = lg[e]; have = true; } }
                se[k] = best; sv[k] = bv; used |= 1u << best; }
            float ex[4], den = 0.f;
#pragma unroll
            for (int k = 0; k < 4; ++k) { ex[k] = __expf(sv[k] - sv[0]); den += ex[k]; }
            const float inv = 1.f / den;
#pragma unroll
            for (int k = 0; k < 4; ++k) { const int lr = __hip_atomic_fetch_add(&lcnt[se[k]], 1, __ATOMIC_RELAXED, __HIP_MEMORY_SCOPE_WORKGROUP);
                LAS int* ent = list + ((step * 32 + row) * 4 + k) * 4; ent[0] = m; ent[1] = se[k]; ent[2] = lr; ent[3] = __float_as_int(ex[k] * inv); } }
    }
    __syncthreads();
    if (F.tid < 32) lbase[F.tid] = atomicAdd(&gcnt[F.tid], lcnt[F.tid]);
    __syncthreads();
    if (F.tid < 256) { LAS int* ent = list + F.tid * 4; const int m = ent[0], e = ent[1], rank = lbase[e] + ent[2];
        SLOTMAP[e * T + rank] = m; TOKSLOT[m * 4 + (F.tid & 3)] = e | (rank << 8); GATE[m * 4 + (F.tid & 3)] = __int_as_float(ent[3]); }
}
__device__ __forceinline__ void load_tstart(Frame& F) {
    LAS int* ts = (LAS int*)(F.lds + LC_TSTART); const int* gcnt = (const int*)(F.ctl + CW_GCNT);
    if (F.tid == 0) { int a = 0; for (int e = 0; e < 32; ++e) { ts[e] = a; a += (__hip_atomic_load(gcnt + e, __ATOMIC_RELAXED, __HIP_MEMORY_SCOPE_AGENT) + 255) >> 8; } ts[32] = a; }
    __syncthreads();
}
__device__ __forceinline__ void warm_range(Frame& F, const unsigned char* base, size_t bytes) {
    const size_t per = bytes / (size_t)F.G; const GAS v4u* p = (const GAS v4u*)(base + per * (size_t)blockIdx.x) + F.tid; const int n = (int)(per / (512 * 16));
    v4u acc = (v4u){0u, 0u, 0u, 0u};
#pragma unroll 8
    for (int i = 0; i < n; ++i) { const v4u v = __builtin_nontemporal_load(p + (size_t)i * 512); acc.x ^= v.x; acc.y ^= v.y; acc.z ^= v.z; acc.w ^= v.w; }
    asm volatile("" :: "v"(acc.x), "v"(acc.y), "v"(acc.z), "v"(acc.w));
}
__device__ __forceinline__ void moe_fill_rowtab(Frame& F, const pg8::MoeOrderG& S) {
    LAS int* tab = (LAS int*)(F.lds + LC_ROWTAB); const LAS int* ts = (const LAS int*)(F.lds + LC_TSTART);
    for (int slot = 0; slot < MOE_TAB_SLOTS; ++slot) { pg8::Unit u; if (!S.next(slot, u)) break;
        if (F.tid < 256) { const int e = u.pn / S.NT, rank = (u.pm - ts[e]) * 256 + F.tid; tab[slot * 256 + F.tid] = rank < S.cnt[e] ? S.slotmap[e * T + rank] : 0; } }
    __syncthreads();
}
__device__ __forceinline__ void p11_final(Frame& F) {
    load_tstart(F);
    const LAS int* ts = (const LAS int*)(F.lds + LC_TSTART);
    const bf16* X1 = (const bf16*)(F.ws + WS_X1); const bf16* Y = (const bf16*)(F.ws + WS_Y); const int* TOKSLOT = (const int*)(F.ws + WS_TOKSLOT); const float* GATE = (const float*)(F.ws + WS_GATE);
    const float* MOD = (const float*)(F.ws + WS_MOD); const float* g2 = frame_in(21); const float* b2 = frame_in(22);
    const int gw = F.vcu * NWAVES + F.wave, NGW = F.G * NWAVES;
    for (int m = gw; m < T; m += NGW) { const int b = m >> 11;
        f32x4 mo[4];
#pragma unroll
        for (int j = 0; j < 4; ++j) mo[j] = (f32x4){0.f, 0.f, 0.f, 0.f};
#pragma unroll
        for (int k = 0; k < 4; ++k) { const int tsl = TOKSLOT[m * 4 + k]; const int e = tsl & 255, rank = tsl >> 8; const float gt = GATE[m * 4 + k];
            const GAS unsigned long long* yr = (const GAS unsigned long long*)(Y + ((size_t)ts[e] * 256 + rank) * D) + F.lane;
#pragma unroll
            for (int j = 0; j < 4; ++j) { const unsigned long long w = yr[64 * j]; const unsigned lo = (unsigned)w, hi = (unsigned)(w >> 32);
                mo[j].x += gt * pg8::bfl(lo); mo[j].y += gt * pg8::bfh(lo); mo[j].z += gt * pg8::bfl(hi); mo[j].w += gt * pg8::bfh(hi); } }
        f32x4 v[4]; float s = 0.f;
#pragma unroll
        for (int j = 0; j < 4; ++j) { const int col = 4 * F.lane + 256 * j; const unsigned long long xw = *((const GAS unsigned long long*)(X1 + (size_t)m * D) + F.lane + 64 * j);
            const f32x4 x1 = (f32x4){pg8::bfl((unsigned)xw), pg8::bfh((unsigned)xw), pg8::bfl((unsigned)(xw >> 32)), pg8::bfh((unsigned)(xw >> 32))};
            const f32x4 g2m = *(const f32x4*)(MOD + b * 6144 + 5 * 1024 + col); v[j] = x1 * ALPHA + g2m * mo[j]; s += (v[j].x + v[j].y) + (v[j].z + v[j].w); }
        const float mean = wave_sum(s) * (1.f / D); float s2 = 0.f;
#pragma unroll
        for (int j = 0; j < 4; ++j) { v[j] = v[j] - mean; s2 += (v[j].x * v[j].x + v[j].y * v[j].y) + (v[j].z * v[j].z + v[j].w * v[j].w); }
        const float rstd = 1.f / sqrtf(wave_sum(s2) * (1.f / D) + LN_EPS);
#pragma unroll
        for (int j = 0; j < 4; ++j) { const int col = 4 * F.lane + 256 * j; const f32x4 gg = *(const f32x4*)(g2 + col), bb = *(const f32x4*)(b2 + col);
            *((GAS f32x4*)(F.out + (size_t)m * D) + F.lane + 64 * j) = v[j] * rstd * gg + bb; }
    }
}
__device__ __forceinline__ unsigned ordkey(float f) { const unsigned u = __float_as_uint(f); return (u & 0x80000000u) ? ~u : (u | 0x80000000u); }

constexpr int SEL_QI = 0, SEL_HIST = 32768, SEL_CAND = 98304, SEL_MASK = 114688, SEL_META = 122880, SEL_CAP = 128;
__device__ __forceinline__ float relu_i(float x) { const int i = __float_as_int(x); return __int_as_float(i > 0 ? i : 0); }
__device__ __forceinline__ void idx_load_a(const bf16* KIb, int kt, int lane, bf16x8 (&A)[4]) {
    const bf16* kp = KIb + (size_t)(kt * 32 + (lane & 31)) * 64 + 8 * (lane >> 5);
#pragma unroll
    for (int s = 0; s < 4; ++s) A[s] = *(const GAS bf16x8*)(kp + 16 * s);
}
__device__ __forceinline__ void idx_scores1(const bf16x8 (&AA)[4], const LAS unsigned char* qiL, const float (&wi)[8], int lane, f32x16& scA) {
    const int hh = lane >> 5, q = lane & 31; const LAS unsigned char* qrow = qiL + q * 1024; const int qs = q & 15;
#pragma unroll
    for (int r = 0; r < 16; ++r) scA[r] = 0.f;
    f32x16 acc[2];
    { bf16x8 B0[4];
#pragma unroll
      for (int s = 0; s < 4; ++s) B0[s] = *(const LAS bf16x8*)(qrow + (((2 * s + hh) ^ qs) << 4));
#pragma unroll
      for (int r = 0; r < 16; ++r) acc[0][r] = 0.f;
#pragma unroll
      for (int s = 0; s < 4; ++s) acc[0] = MFMA32(AA[s], B0[s], acc[0]); }
#pragma unroll
    for (int h = 0; h < 8; ++h) { const int cur = h & 1, nxt = cur ^ 1;
        if (h < 7) { bf16x8 Bn[4];
#pragma unroll
            for (int s = 0; s < 4; ++s) Bn[s] = *(const LAS bf16x8*)(qrow + ((((h + 1) * 8 + 2 * s + hh) ^ qs) << 4));
#pragma unroll
            for (int r = 0; r < 16; ++r) acc[nxt][r] = 0.f;
#pragma unroll
            for (int s = 0; s < 4; ++s) acc[nxt] = MFMA32(AA[s], Bn[s], acc[nxt]); }
#pragma unroll
        for (int r = 0; r < 16; ++r) scA[r] = fmaf(wi[h], relu_i(acc[cur][r]), scA[r]);
        if (h < 7) {
            __builtin_amdgcn_sched_group_barrier(0x100, 4, 0);
#pragma unroll
            for (int i = 0; i < 4; ++i) { __builtin_amdgcn_sched_group_barrier(0x008, 1, 0); __builtin_amdgcn_sched_group_barrier(0x002, 8, 0); } }
    }
}
template <int MODE, int VAR>
__device__ __forceinline__ void sel_tile(Frame& F, const f32x16& sc, int kt, int hh, int q, int qpos, int bst, unsigned pfx, unsigned trial, unsigned& cntl) {
    LAS unsigned* hist = (LAS unsigned*)(F.lds + SEL_HIST); LAS unsigned* cand = (LAS unsigned*)(F.lds + SEL_CAND); LAS unsigned* maskL = (LAS unsigned*)(F.lds + SEL_MASK); LAS int* meta = (LAS int*)(F.lds + SEL_META);
    unsigned word = 0u; const int kbase = kt * 32 + 4 * hh; const int lim = qpos - kbase;
#pragma unroll
    for (int r = 0; r < 16; ++r) { const int kr0 = (r & 3) + 8 * (r >> 2); const bool valid = kr0 <= lim;
        const unsigned bits = __float_as_uint(sc[r]) & 0xFFFFF800u; const float st = __uint_as_float(bits);
        int bin = (int)(st * 64.f) + 256; bin = bin < 0 ? 0 : (bin > 511 ? 511 : bin);
        if (MODE == 0) { if (VAR == 1) { asm volatile("" :: "v"(bin), "v"(valid ? 1u : 0u)); } else __hip_atomic_fetch_add(hist + q * 512 + bin, valid ? 1u : 0u, __ATOMIC_RELAXED, __HIP_MEMORY_SCOPE_WORKGROUP); }
        else { const unsigned ck = (ordkey(st) & 0xFFFFF800u) | (unsigned)(2047 - kbase - kr0);
            if (MODE == 1) { word |= (valid && bin > bst) ? (1u << kr0) : 0u; const bool isc = valid && bin == bst;
                if (isc) { const int slot = __hip_atomic_fetch_add((LAS int*)meta + 64 + q, 1, __ATOMIC_RELAXED, __HIP_MEMORY_SCOPE_WORKGROUP); if (slot < SEL_CAP) cand[q * SEL_CAP + slot] = ck; } }
            if (MODE == 2) { cntl += (valid && ck >= (pfx | trial)) ? 1u : 0u; }
            if (MODE == 3) { word |= (valid && ck >= pfx) ? (1u << kr0) : 0u; } }
        }
    if (MODE == 1 || MODE == 3) __hip_atomic_fetch_or(maskL + q * 64 + kt, word << (4 * hh), __ATOMIC_RELAXED, __HIP_MEMORY_SCOPE_WORKGROUP);
}
template <int MODE, int VAR>
__device__ __forceinline__ void sel_pass(Frame& F, int lane, int wave, const bf16* KIb, int qb, const float (&wi)[8], unsigned trial) {
    const LAS unsigned char* qiL = F.lds + SEL_QI; LAS int* meta = (LAS int*)(F.lds + SEL_META);
    const int bst = meta[lane & 31]; const unsigned pfx = (unsigned)meta[128 + (lane & 31)];
    unsigned cntl = 0u;
    bf16x8 AA[4], NA[4];
    if (wave <= qb) idx_load_a(KIb, wave, lane, AA);
#pragma unroll 1
    for (int kt = wave; kt <= qb; kt += NWAVES) {
        int lane_t = lane; asm volatile("" : "+v"(lane_t));
        const int hh = lane_t >> 5, q = lane_t & 31, qpos = qb * 32 + q;
        if (kt + NWAVES <= qb) idx_load_a(KIb, kt + NWAVES, lane_t, NA);
        f32x16 scA;
        idx_scores1(AA, qiL, wi, lane_t, scA);
        if (VAR == 2) { asm volatile("" :: "v"(scA[0]), "v"(scA[7]), "v"(scA[15])); } else sel_tile<MODE, VAR>(F, scA, kt, hh, q, qpos, bst, pfx, trial, cntl);
#pragma unroll
        for (int s = 0; s < 4; ++s) AA[s] = NA[s];
    }
    if (MODE == 2) __hip_atomic_fetch_add((LAS unsigned*)meta + 160 + (lane & 31), cntl, __ATOMIC_RELAXED, __HIP_MEMORY_SCOPE_WORKGROUP);
}
template <int VAR>
__device__ __forceinline__ void p3_select(Frame& F) {
    const bf16* QI = (const bf16*)(F.ws + WS_QI); const float* MISC = (const float*)(F.ws + WS_MISC); unsigned* MASK = (unsigned*)(F.ws + WS_MASK);
    LAS unsigned* hist = (LAS unsigned*)(F.lds + SEL_HIST); LAS unsigned* cand = (LAS unsigned*)(F.lds + SEL_CAND); LAS unsigned* maskL = (LAS unsigned*)(F.lds + SEL_MASK); LAS int* meta = (LAS int*)(F.lds + SEL_META);
    const int b = blockIdx.x >> 5, ii = blockIdx.x & 31;
    for (int ui = 0; ui < 2; ++ui) { const int qb = ui ? 63 - ii : ii; const int t0 = b * S_ + qb * 32;
        int tid = F.tid; asm volatile("" : "+v"(tid)); const int lane = tid & 63; int wave = F.wave; asm volatile("" : "+s"(wave));
        if (qb < 8) {
            for (int wd = tid; wd < 2048; wd += 512) { const int q = wd >> 6, w = wd & 63, qpos = qb * 32 + q; const int rel = qpos - 32 * w;
                MASK[(size_t)(t0 + q) * 64 + w] = rel >= 31 ? 0xFFFFFFFFu : (rel < 0 ? 0u : ((2u << rel) - 1u)); }
            continue; }
        __syncthreads();
        for (int c = tid; c < 2048; c += 512) { const int q = c >> 6, c16 = c & 63; *(LAS v4u*)(F.lds + SEL_QI + q * 1024 + ((c16 ^ (q & 15)) << 4)) = *(const GAS v4u*)(QI + (size_t)(t0 + q) * 512 + c16 * 8); }
        { unsigned z = 0u; asm volatile("" : "+v"(z)); const v4u z4 = (v4u){z, z, z, z};
          for (int i = tid; i < 16384 / 4; i += 512) ((LAS v4u*)hist)[i] = z4;
          for (int i = tid; i < 2048 / 4; i += 512) ((LAS v4u*)maskL)[i] = z4; }
        if (tid < 192) meta[tid] = 0;
        float wi[8];
#pragma unroll
        for (int h = 0; h < 8; ++h) wi[h] = MISC[(size_t)(t0 + (lane & 31)) * 256 + 192 + h];
        const bf16* KIb = (const bf16*)(F.ws + WS_KI) + (size_t)b * S_ * 64;
        __syncthreads();
        sel_pass<0, VAR>(F, lane, wave, KIb, qb, wi, 0u);
        __syncthreads();
        for (int qq = 0; qq < 4; ++qq) { const int q = wave * 4 + qq; const LAS unsigned* hq = hist + q * 512; unsigned c8[8]; unsigned cs = 0u;
#pragma unroll
            for (int i = 0; i < 8; ++i) { c8[i] = hq[511 - 8 * lane - i]; cs += c8[i]; }
            unsigned incl = cs;
#pragma unroll
            for (int o = 1; o < 64; o <<= 1) { const unsigned v = __shfl_up(incl, o); if (lane >= o) incl += v; }
            const unsigned excl = incl - cs;
            if (excl < 256u && incl >= 256u) { unsigned run = excl;
#pragma unroll
                for (int i = 0; i < 8; ++i) { const unsigned before = run; run += c8[i]; if (before < 256u && run >= 256u) { meta[q] = 511 - 8 * lane - i; meta[32 + q] = (int)(256u - before); } } } }
        __syncthreads();
        sel_pass<1, VAR>(F, lane, wave, KIb, qb, wi, 0u);
        __syncthreads();
        if (tid < 32) { if (meta[64 + tid] > SEL_CAP) meta[96] = 1; }
        __syncthreads();
        if (meta[96] == 0) {
            for (int item = tid; item < 32 * SEL_CAP; item += 512) { const int q = item >> 7, i = item & (SEL_CAP - 1); const int n = meta[64 + q];
                if (i < n) { const unsigned my = cand[q * SEL_CAP + i]; int rank = 0; for (int j = 0; j < n; ++j) rank += (cand[q * SEL_CAP + j] > my) ? 1 : 0;
                    if (rank < meta[32 + q]) { const int idx = 2047 - (int)(my & 0x7FFu); __hip_atomic_fetch_or(maskL + q * 64 + (idx >> 5), 1u << (idx & 31), __ATOMIC_RELAXED, __HIP_MEMORY_SCOPE_WORKGROUP); } } }
        } else {
#pragma unroll 1
            for (int bit = 31; bit >= 0; --bit) {
                sel_pass<2, VAR>(F, lane, wave, KIb, qb, wi, 1u << bit);
                __syncthreads();
                if (tid < 32) { if ((unsigned)meta[160 + tid] >= 256u) meta[128 + tid] |= (int)(1u << bit); meta[160 + tid] = 0; }
                __syncthreads(); }
            sel_pass<3, VAR>(F, lane, wave, KIb, qb, wi, 0u);
        }
        __syncthreads();
        { const int q = tid >> 4, w4 = (tid & 15) * 4; *(GAS v4u*)(MASK + (size_t)(t0 + q) * 64 + w4) = *(const LAS v4u*)(maskL + q * 64 + w4); }
    }
}
typedef unsigned u32x2v __attribute__((ext_vector_type(2)));
constexpr int ATT_K = 0, ATT_VT = 65536;
__device__ __forceinline__ void att_load(const bf16* CKV, const bf16* CKVT, int b, int j, int tid, v4u (&st)[4]) {
#pragma unroll
    for (int i = 0; i < 2; ++i) { const int c = tid + 512 * i; st[i] = *(const GAS v4u*)(CKV + (size_t)(b * S_ + 64 * j) * 128 + c * 8); }
#pragma unroll
    for (int i = 0; i < 2; ++i) { const int c = tid + 512 * i, d = c >> 3, ch = c & 7; st[2 + i] = *(const GAS v4u*)(CKVT + (size_t)(b * 128 + d) * 2048 + 64 * j + ch * 8); }
}
__device__ __forceinline__ void att_store(LAS unsigned char* lds, int buf, int tid, const v4u (&st)[4]) {
#pragma unroll
    for (int i = 0; i < 2; ++i) { const int c = tid + 512 * i, row = c >> 4, ch = c & 15; *(LAS v4u*)(lds + ATT_K + buf * 16384 + row * 256 + ((ch ^ (row & 15)) << 4)) = st[i]; }
#pragma unroll
    for (int i = 0; i < 2; ++i) { const int c = tid + 512 * i, d = c >> 3, ch = c & 7; *(LAS v4u*)(lds + ATT_VT + buf * 16384 + d * 128 + ((ch ^ ((d >> 1) & 7)) << 4)) = st[2 + i]; }
}
__device__ __forceinline__ void att_tile(const LAS unsigned char* lds, int buf, int j, u32x2v mw, const bf16x8 (&Qf)[8], f32x16 (&O)[4], float& m_run, float& l_run, float slope2, int hh, int q, int qpos) {
    f32x16 S0, S1;
#pragma unroll
    for (int r = 0; r < 16; ++r) { S0[r] = 0.f; S1[r] = 0.f; }
    const LAS unsigned char* kb0 = lds + ATT_K + buf * 16384 + q * 256, * kb1 = kb0 + 32 * 256;
    { bf16x8 Kf[16];
#pragma unroll
      for (int s = 0; s < 8; ++s) { const int sw = ((2 * s + hh) ^ (q & 15)) << 4; Kf[2 * s] = *(const LAS bf16x8*)(kb0 + sw); Kf[2 * s + 1] = *(const LAS bf16x8*)(kb1 + sw); }
#pragma unroll
      for (int s = 0; s < 8; ++s) { S0 = MFMA32(Kf[2 * s], Qf[s], S0); S1 = MFMA32(Kf[2 * s + 1], Qf[s], S1); }
      __builtin_amdgcn_sched_group_barrier(0x100, 4, 0);
#pragma unroll
      for (int i = 0; i < 6; ++i) { __builtin_amdgcn_sched_group_barrier(0x008, 2, 0); __builtin_amdgcn_sched_group_barrier(0x100, 2, 0); }
      __builtin_amdgcn_sched_group_barrier(0x008, 4, 0); }
    const LAS unsigned char* vb = lds + ATT_VT + buf * 16384;
    const unsigned mlo = mw.x >> (4 * hh), mhi = mw.y >> (4 * hh);
    const float base0 = slope2 * (float)(64 * j + 4 * hh - qpos);
    float tmax = -INFINITY;
#pragma unroll
    for (int r = 0; r < 16; ++r) { const int kr = (r & 3) + 8 * (r >> 2);
        float s0 = S0[r] + (base0 + slope2 * (float)kr), s1 = S1[r] + (base0 + slope2 * (float)(kr + 32));
        { const int t0_ = __builtin_amdgcn_sbfe((int)mlo, kr, 1), t1_ = __builtin_amdgcn_sbfe((int)mhi, kr, 1);
          s0 = __int_as_float((__float_as_int(s0) & t0_) | ((int)0xff800000 & ~t0_)); s1 = __int_as_float((__float_as_int(s1) & t1_) | ((int)0xff800000 & ~t1_)); }
        S0[r] = s0; S1[r] = s1; tmax = fmaxf(tmax, fmaxf(s0, s1)); }
    { const auto rr = __builtin_amdgcn_permlane32_swap(__float_as_uint(tmax), __float_as_uint(tmax), false, false); tmax = fmaxf(__uint_as_float(rr[0]), __uint_as_float(rr[1])); }
    const float m_new = fmaxf(m_run, tmax), msafe = (m_new == -INFINITY) ? 0.f : m_new;
    const float alpha = __builtin_amdgcn_exp2f(m_run - msafe);
    float ps = 0.f;
#pragma unroll
    for (int r = 0; r < 16; ++r) { S0[r] = __builtin_amdgcn_exp2f(S0[r] - msafe); S1[r] = __builtin_amdgcn_exp2f(S1[r] - msafe); ps += S0[r] + S1[r]; }
    l_run = l_run * alpha + ps; m_run = m_new;
    if (__any(alpha != 1.f)) {
#pragma unroll
        for (int db = 0; db < 4; ++db)
#pragma unroll
            for (int r = 0; r < 16; ++r) O[db][r] *= alpha; }
    bf16x8 Pf[4];
    Pf[0] = pack8(S0[0], S0[1], S0[2], S0[3], S0[4], S0[5], S0[6], S0[7]); Pf[1] = pack8(S0[8], S0[9], S0[10], S0[11], S0[12], S0[13], S0[14], S0[15]);
    Pf[2] = pack8(S1[0], S1[1], S1[2], S1[3], S1[4], S1[5], S1[6], S1[7]); Pf[3] = pack8(S1[8], S1[9], S1[10], S1[11], S1[12], S1[13], S1[14], S1[15]);
    { bf16x8 Vf[16];
#pragma unroll
      for (int db = 0; db < 4; ++db) { const int d = db * 32 + q; const LAS unsigned char* vr = vb + d * 128; const int sx = (d >> 1) & 7;
#pragma unroll
          for (int c2 = 0; c2 < 4; ++c2) Vf[db * 4 + c2] = *(const LAS bf16x8*)(vr + (((c2 * 2 + hh) ^ sx) << 4)); }
#pragma unroll
      for (int db = 0; db < 4; ++db)
#pragma unroll
          for (int c2 = 0; c2 < 4; ++c2) O[db] = MFMA32(Vf[db * 4 + c2], Pf[c2], O[db]);
      __builtin_amdgcn_sched_group_barrier(0x100, 4, 0);
#pragma unroll
      for (int i = 0; i < 6; ++i) { __builtin_amdgcn_sched_group_barrier(0x008, 2, 0); __builtin_amdgcn_sched_group_barrier(0x100, 2, 0); }
      __builtin_amdgcn_sched_group_barrier(0x008, 4, 0); }
}
__device__ __forceinline__ void p4_attention(Frame& F) {
    const bf16* QL = (const bf16*)(F.ws + WS_QL); const bf16* CKV = (const bf16*)(F.ws + WS_CKV); const bf16* CKVT = (const bf16*)(F.ws + WS_CKVT);
    const unsigned* MASK = (const unsigned*)(F.ws + WS_MASK);
    const int b = blockIdx.x >> 5, ii = blockIdx.x & 31;
    for (int ui = 0; ui < 2; ++ui) { const int qb = ui ? 63 - ii : ii;
        int lane; asm volatile("v_mbcnt_lo_u32_b32 %0, -1, 0\n\tv_mbcnt_hi_u32_b32 %0, -1, %0" : "=v"(lane)); int head = F.wave; asm volatile("" : "+s"(head)); const int tid = head * 64 + lane;
        const int hh = lane >> 5, q = lane & 31; const float slope2 = __builtin_amdgcn_exp2f(-(float)(head + 1)) * LOG2E;
        const int t0 = b * S_ + qb * 32, qpos = qb * 32 + q; const int nt = (qb >> 1) + 1;
        bf16x8 Qf[8];
        {
            const bf16* WukB = (const bf16*)(F.ws + WS_WUKB); bf16x8 qB[4];
#pragma unroll
            for (int ks = 0; ks < 4; ++ks) qB[ks] = *(const GAS bf16x8*)(QL + (size_t)(t0 + q) * 512 + head * 64 + 16 * ks + 8 * hh);
#pragma unroll
            for (int rb = 0; rb < 4; ++rb) { f32x16 X;
#pragma unroll
                for (int r = 0; r < 16; ++r) X[r] = 0.f;
                const bf16* wr = WukB + (size_t)(head * 128 + rb * 32 + q) * 64 + 8 * hh;
#pragma unroll
                for (int ks = 0; ks < 4; ++ks) { const bf16x8 Aw = *(const GAS bf16x8*)(wr + 16 * ks); X = MFMA32(Aw, qB[ks], X); }
                Qf[2 * rb] = pack8(X[0], X[1], X[2], X[3], X[4], X[5], X[6], X[7]); Qf[2 * rb + 1] = pack8(X[8], X[9], X[10], X[11], X[12], X[13], X[14], X[15]); } }
#pragma unroll
        for (int s = 0; s < 8; ++s) asm volatile("" : "+v"(Qf[s]));
        f32x16 O[4];
#pragma unroll
        for (int db = 0; db < 4; ++db)
#pragma unroll
            for (int r = 0; r < 16; ++r) O[db][r] = 0.f;
        float m_run = -INFINITY, l_run = 0.f;
        v4u st[4];
        __syncthreads();
        att_load(CKV, CKVT, b, 0, tid, st); att_store(F.lds, 0, tid, st);
        att_load(CKV, CKVT, b, nt > 1 ? 1 : 0, tid, st); att_store(F.lds, 1, tid, st);
        __syncthreads();
        const unsigned* mrow = MASK + (size_t)(t0 + q) * 64;
        for (int j0 = 0; j0 < nt; j0 += 2) { const int j1 = j0 + 1; const bool has1 = j1 < nt; const int last = nt - 1;
            const u32x2v mw0 = *(const GAS u32x2v*)(mrow + 2 * j0);
            __builtin_amdgcn_sched_barrier(0);
            att_load(CKV, CKVT, b, (j0 + 2 < nt) ? j0 + 2 : last, tid, st);
            __builtin_amdgcn_sched_barrier(0);
            att_tile(F.lds, j0 & 3, j0, mw0, Qf, O, m_run, l_run, slope2, hh, q, qpos);
            att_store(F.lds, (j0 + 2) & 3, tid, st);
            const u32x2v mw1 = *(const GAS u32x2v*)(mrow + 2 * (has1 ? j1 : j0));
            __builtin_amdgcn_sched_barrier(0);
            att_load(CKV, CKVT, b, (j0 + 3 < nt) ? j0 + 3 : last, tid, st);
            __builtin_amdgcn_sched_barrier(0);
            if (has1) att_tile(F.lds, j1 & 3, j1, mw1, Qf, O, m_run, l_run, slope2, hh, q, qpos);
            att_store(F.lds, (j0 + 3) & 3, tid, st);
            __syncthreads();
        }
        float lt; { const auto rr = __builtin_amdgcn_permlane32_swap(__float_as_uint(l_run), __float_as_uint(l_run), false, false); lt = __uint_as_float(rr[0]) + __uint_as_float(rr[1]); }
        const float inv = 1.f / lt;
        bf16x8 Ob[8];
#pragma unroll
        for (int db = 0; db < 4; ++db)
#pragma unroll
            for (int t = 0; t < 2; ++t) Ob[db * 2 + t] = pack8(O[db][8 * t] * inv, O[db][8 * t + 1] * inv, O[db][8 * t + 2] * inv, O[db][8 * t + 3] * inv, O[db][8 * t + 4] * inv, O[db][8 * t + 5] * inv, O[db][8 * t + 6] * inv, O[db][8 * t + 7] * inv);
        int l2; asm volatile("v_mbcnt_lo_u32_b32 %0, -1, 0\n\tv_mbcnt_hi_u32_b32 %0, -1, %0" : "=v"(l2));
        const bf16* WuvT = (const bf16*)(F.ws + WS_WUVT); bf16* YA = (bf16*)(F.ws + WS_YA);
        const int orow_t = t0 + (l2 & 31);
#pragma unroll
        for (int dbp = 0; dbp < 2; ++dbp) { f32x16 Yt;
#pragma unroll
            for (int r = 0; r < 16; ++r) Yt[r] = 0.f;
            const bf16* wrow = WuvT + (size_t)(head * 64 + dbp * 32 + (l2 & 31)) * 128 + (l2 >> 5) * 8;
#pragma unroll
            for (int ks = 0; ks < 8; ++ks) { const bf16x8 Aw = *(const GAS bf16x8*)(wrow + ks * 16); Yt = MFMA32(Aw, Ob[ks], Yt); }
#pragma unroll
            for (int g = 0; g < 4; ++g) { const unsigned lo = pkbf(Yt[4 * g], Yt[4 * g + 1]), hi = pkbf(Yt[4 * g + 2], Yt[4 * g + 3]);
                *(GAS unsigned long long*)(YA + bl_off(orow_t, head * 64 + dbp * 32 + 8 * g + 4 * (l2 >> 5), 512)) = (unsigned long long)lo | ((unsigned long long)hi << 32); } }
    }
}
struct HotOrder : pg8::StaticOrder { __device__ __forceinline__ bool next(int i, pg8::Unit& u) const { const bool ok = pg8::StaticOrder::next(i, u); u.pm &= 7; return ok; } };
struct Args { const float* in[23]; float* out; unsigned char* ws; int ph_lo, ph_hi; };
__global__ void __launch_bounds__(NWAVES * 64, 2) mk_fwd(Args args) {
    extern __shared__ __attribute__((aligned(16))) unsigned char lds[];
    Frame F;
    F.lds = (LAS unsigned char*)lds;
    F.MISCW = (volatile LAS unsigned*)(F.lds + MISC_OFF);
    F.tid = threadIdx.x; F.lane = F.tid & 63; F.wave = __builtin_amdgcn_readfirstlane(F.tid >> 6);
    F.G = gridDim.x; { const int bx = blockIdx.x; F.vcu = (F.G % 8 == 0) ? (bx % 8) * (F.G / 8) + bx / 8 : bx; }
    F.ws = args.ws; F.ctl = (gu32*)(args.ws + WS_CTL); F.out = args.out;
    for (int u = F.tid; u < (LDS_BYTES - LDSCTL_OFF) / 4; u += NWAVES * 64) ((LAS unsigned*)(F.lds + LDSCTL_OFF))[u] = 0u;
    __syncthreads();
    const int lo = args.ph_lo, hi = args.ph_hi;
#define IN(k) (lo <= (k) && (k) < hi)
#define REID() do { int l_; asm volatile("v_mbcnt_lo_u32_b32 %0, -1, 0\n\tv_mbcnt_hi_u32_b32 %0, -1, %0" : "=v"(l_)); F.lane = l_; F.tid = F.wave * 64 + l_; } while (0)
#define SEAM(k) do { if (IN(k) && IN((k) + 1)) { REID(); xcd_barrier(bar, F.wave == 0 && F.lane == 0); } } while (0)
#ifndef PROBE_MASK
#define PROBE_MASK 0
#endif
#define PHASE(k, BODY) do { if (IN(k)) { if ((PROBE_MASK >> (k)) & 1) { REID(); BODY; REID(); xcd_barrier(bar, F.wave == 0 && F.lane == 0); } REID(); BODY; } SEAM(k); } while (0)
#define BODY0 { p0_prologue<0>(F); }
#define BODY1 { p1_modulate(F); }
#define BODY2 { pg8::Gemm g{(const pg8::bf16_t*)(F.ws + WS_H), (const pg8::bf16_t*)(F.ws + WS_WIN), T, NIN, D}; pg8::StaticOrder S; S.init(T, NIN, F.G, (int)blockIdx.x); \
        pg8::EpiInProj E{(pg8::bf16_t*)(F.ws + WS_QL), (pg8::bf16_t*)(F.ws + WS_QI), (pg8::bf16_t*)(F.ws + WS_U), (pg8::bf16_t*)(F.ws + WS_SG), (float*)(F.ws + WS_MISC), (pg8::bf16_t*)(F.ws + WS_KI)}; \
        pg8::gemm_phase<pg8::EpiInProj, pg8::StaticOrder, PG8_ALIGN, PG8_SP2>(F.lds + RING_OFF, g, S, E, F.wave); }
#define BODY3 { p3_post(F); __syncthreads(); p3_select<0>(F); }
#ifndef SELVAR
#define SELVAR 0
#endif
#ifdef PROBE_POST
#define BODY3V { p3_post(F); }
#else
#define BODY3V { p3_select<SELVAR>(F); }
#endif
#define BODY4 { p4_attention(F); }
#define BODY5 { { pg8::Gemm g{(const pg8::bf16_t*)(F.ws + WS_YA), (const pg8::bf16_t*)(F.ws + WS_WBA), T, D, 512}; pg8::StaticOrder S; S.init(T, D, F.G, (int)blockIdx.x); \
          pg8::EpiGateMul E{(pg8::bf16_t*)(F.ws + WS_TMP), (const pg8::bf16_t*)(F.ws + WS_SG), 0, 0}; \
          pg8::gemm_phase<pg8::EpiGateMul, pg8::StaticOrder, PG8_ALIGN, PG8_SP2>(F.lds + RING_OFF, g, S, E, F.wave); } \
        { pg8::Gemm g{(const pg8::bf16_t*)(F.ws + WS_POOLED), (const pg8::bf16_t*)(F.ws + WS_WPB), T, D, 512}; pg8::StaticOrder S; S.init(T, D, F.G, (int)blockIdx.x); \
          pg8::EpiGateAdd E{(pg8::bf16_t*)(F.ws + WS_MIX), (const pg8::bf16_t*)(F.ws + WS_TMP), (const pg8::bf16_t*)(F.ws + WS_SG), 1024, 0}; \
          pg8::gemm_phase<pg8::EpiGateAdd, pg8::StaticOrder, PG8_ALIGN, PG8_SP2>(F.lds + RING_OFF, g, S, E, F.wave); } }
#define BODY6 { pg8::Gemm g{(const pg8::bf16_t*)(F.ws + WS_MIX), (const pg8::bf16_t*)(F.ws + WS_WOUT), T, D, 1024}; pg8::StaticOrder S; S.init(T, D, F.G, (int)blockIdx.x); \
        pg8::EpiResid E{(float*)(F.ws + WS_Z), frame_in(0), (const float*)(F.ws + WS_MOD) + 2 * 1024}; \
        pg8::gemm_phase<pg8::EpiResid, pg8::StaticOrder, PG8_ALIGN, PG8_SP2>(F.lds + RING_OFF, g, S, E, F.wave); }
#define BODY7 { p7_ln1_route(F, CW_GCNT); }
#define BODY7DRY { p7_ln1_route(F, 128); }
#define BODY9 { load_tstart(F); \
        pg8::MoeOrderG S{(const LAS int*)(F.lds + LC_TSTART), 8, F.G, (int)blockIdx.x, (const LAS int*)(F.lds + LC_ROWTAB), (const int*)(F.ws + WS_SLOTMAP), (const int*)(F.ctl + CW_GCNT)}; \
        moe_fill_rowtab(F, S); \
        pg8::Gemm g{(const pg8::bf16_t*)(F.ws + WS_H), (const pg8::bf16_t*)(F.ws + WS_WGU), T, 32 * 2048, 512}; \
        pg8::EpiSwiglu E{(pg8::bf16_t*)(F.ws + WS_ACT), frame_in(18)}; \
        pg8::gemm_phase<pg8::EpiSwiglu, pg8::MoeOrderG, PG8_ALIGN, PG8_SP2, true>(F.lds + RING_OFF, g, S, E, F.wave); }
#define BODY9N { load_tstart(F); \
        pg8::MoeOrderG S{(const LAS int*)(F.lds + LC_TSTART), 8, F.G, (int)blockIdx.x, (const LAS int*)(F.lds + LC_ROWTAB), (const int*)(F.ws + WS_SLOTMAP), (const int*)(F.ctl + CW_GCNT)}; \
        moe_fill_rowtab(F, S); \
        pg8::Gemm g{(const pg8::bf16_t*)(F.ws + WS_H), (const pg8::bf16_t*)(F.ws + WS_WGU), T, 32 * 2048, 512}; \
        pg8::EpiNull E{0}; \
        pg8::gemm_phase<pg8::EpiNull, pg8::MoeOrderG, PG8_ALIGN, PG8_SP2, true>(F.lds + RING_OFF, g, S, E, F.wave); }
#define BODY2N { pg8::Gemm g{(const pg8::bf16_t*)(F.ws + WS_H), (const pg8::bf16_t*)(F.ws + WS_WIN), T, NIN, D}; pg8::StaticOrder S; S.init(T, NIN, F.G, (int)blockIdx.x); \
        pg8::EpiNull E{0}; \
        pg8::gemm_phase<pg8::EpiNull, pg8::StaticOrder, PG8_ALIGN, PG8_SP2>(F.lds + RING_OFF, g, S, E, F.wave); }
#define BODY10 { load_tstart(F); \
        pg8::Gemm g{(const pg8::bf16_t*)(F.ws + WS_ACT), (const pg8::bf16_t*)(F.ws + WS_WD), MAXROWS, 32 * 1024, 512}; \
        pg8::MoeOrder S{(const LAS int*)(F.lds + LC_TSTART), 4, F.G, (int)blockIdx.x, nullptr, nullptr, nullptr}; \
        pg8::EpiDown E{(pg8::bf16_t*)(F.ws + WS_Y), frame_in(20)}; \
        pg8::gemm_phase<pg8::EpiDown, pg8::MoeOrder, PG8_ALIGN, PG8_SP2, true>(F.lds + RING_OFF, g, S, E, F.wave); }
#define BODY10V { load_tstart(F); \
        pg8::Gemm g{(const pg8::bf16_t*)(F.ws + WS_ACT), (const pg8::bf16_t*)(F.ws + WS_WD), MAXROWS, 32 * 1024, 1024}; \
        pg8::MoeOrder S{(const LAS int*)(F.lds + LC_TSTART), 4, F.G, (int)blockIdx.x, nullptr, nullptr, nullptr}; \
        pg8::EpiDownT<false> E{(pg8::bf16_t*)(F.ws + WS_Y), frame_in(20)}; \
        pg8::gemm_phase<pg8::EpiDownT<false>, pg8::MoeOrder, PG8_ALIGN, PG8_SP2>(F.lds + RING_OFF, g, S, E, F.wave); }
#define BODY10X { pg8::Gemm g{(const pg8::bf16_t*)(F.ws + WS_ACT), (const pg8::bf16_t*)(F.ws + WS_WD), 272 * 256, 1024, 1024}; pg8::StaticOrder S; S.init(272 * 256, 1024, F.G, (int)blockIdx.x); \
        pg8::EpiDownT<false> E{(pg8::bf16_t*)(F.ws + WS_Y), frame_in(20)}; \
        pg8::gemm_phase<pg8::EpiDownT<false>, pg8::StaticOrder, PG8_ALIGN, PG8_SP2>(F.lds + RING_OFF, g, S, E, F.wave); }
#define BODY10H { pg8::Gemm g{(const pg8::bf16_t*)(F.ws + WS_ACT), (const pg8::bf16_t*)(F.ws + WS_WD), 272 * 256, 1024, 1024}; HotOrder S; S.init(272 * 256, 1024, F.G, (int)blockIdx.x); \
        pg8::EpiDownT<false> E{(pg8::bf16_t*)(F.ws + WS_Y), frame_in(20)}; \
        pg8::gemm_phase<pg8::EpiDownT<false>, HotOrder, PG8_ALIGN, PG8_SP2>(F.lds + RING_OFF, g, S, E, F.wave); }
#define BODY11 { p11_final(F); }
    XcdBarrier bar; bar.bar = (unsigned*)(F.ctl + CW_BAR); bar.x = 0; bar.st = nullptr;
    if (hi - lo > 1) bar = xcd_barrier_post((unsigned*)(F.ctl + CW_BAR), F.MISCW + 8, F.tid == 0);
#ifdef PROBE_P0SMALL
    if (IN(0)) { REID(); p0_prologue<PROBE_P0SMALL>(F); REID(); xcd_barrier(bar, F.wave == 0 && F.lane == 0); REID(); BODY0; } SEAM(0);
#else
    PHASE(0, BODY0);
#endif
    PHASE(1, BODY1);
#ifdef PROBE_BARRIERS
    for (int i_ = 0; i_ < PROBE_BARRIERS; ++i_) { REID(); xcd_barrier(bar, F.wave == 0 && F.lane == 0); }
#endif
#ifdef PROBE_NULL2
    if (IN(2)) { REID(); BODY2N; REID(); xcd_barrier(bar, F.wave == 0 && F.lane == 0); REID(); BODY2; } SEAM(2);
#else
    PHASE(2, BODY2);
#endif
    if (IN(3)) { if ((PROBE_MASK >> 3) & 1) { REID(); BODY3V; REID(); xcd_barrier(bar, F.wave == 0 && F.lane == 0); } REID(); BODY3; } SEAM(3);
    PHASE(4, BODY4); PHASE(5, BODY5);
    PHASE(6, BODY6);
    if (IN(7)) { if ((PROBE_MASK >> 7) & 1) { REID(); BODY7DRY; REID(); xcd_barrier(bar, F.wave == 0 && F.lane == 0); } REID(); BODY7; } SEAM(7);
#ifdef PROBE_NULL9
    if (IN(9)) { REID(); BODY9N; REID(); xcd_barrier(bar, F.wave == 0 && F.lane == 0); REID(); BODY9; } SEAM(9);
#else
    PHASE(9, BODY9);
#endif
#ifdef PROBE_HOT10
    if (IN(10)) { REID(); BODY10H; REID(); xcd_barrier(bar, F.wave == 0 && F.lane == 0); REID(); BODY10; } SEAM(10);
#elif defined(PROBE_STATIC10)
    if (IN(10)) { REID(); BODY10X; REID(); xcd_barrier(bar, F.wave == 0 && F.lane == 0); REID(); BODY10; } SEAM(10);
#elif defined(PROBE_NOBIAS)
    if (IN(10)) { REID(); BODY10V; REID(); xcd_barrier(bar, F.wave == 0 && F.lane == 0); REID(); BODY10; } SEAM(10);
#else
    PHASE(10, BODY10);
#endif
    if (IN(11)) { if ((PROBE_MASK >> 11) & 1) { REID(); BODY11; REID(); xcd_barrier(bar, F.wave == 0 && F.lane == 0); } REID(); BODY11; }
#undef IN
#undef SEAM
}

static void launch_mk(const Args& a0, int lo, int hi, int grid, hipStream_t stream) {
    Args a = a0; a.ph_lo = lo; a.ph_hi = hi;
    hipLaunchKernelGGL(mk_fwd, dim3(grid), dim3(NWAVES * 64), LDS_BYTES, stream, a);
}
extern "C" void kernel_launch(void* const* d_in, const int* in_sizes, int n_in, void* d_out, int out_size, void* d_ws, size_t ws_size, hipStream_t stream) {
    static int grid = 0;
    if (grid == 0) {
        if (n_in != 23 || ws_size < WS_END) { fprintf(stderr, "kernel_launch: unexpected n_in %d / ws %zu\n", n_in, ws_size); grid = -1; return; }
        int dev = 0, cus = 0;
        if (hipGetDevice(&dev) != hipSuccess || hipDeviceGetAttribute(&cus, hipDeviceAttributeMultiprocessorCount, dev) != hipSuccess) { grid = -1; return; }
        if (hipFuncSetAttribute((const void*)mk_fwd, hipFuncAttributeMaxDynamicSharedMemorySize, LDS_BYTES) != hipSuccess) { fprintf(stderr, "hipFuncSetAttribute failed\n"); grid = -1; return; }
        grid = cus;
        if (grid != 256) { fprintf(stderr, "kernel_launch: built for 256 CUs, found %d\n", cus); grid = -1; return; }
    }
    if (grid < 0) return;
    unsigned char* ws = (unsigned char*)d_ws;
    (void)hipMemsetAsync(ws + WS_CTL, 0, CTL_ZERO_BYTES, stream);
    Args a{};
    for (int i = 0; i < 23; ++i) a.in[i] = (const float*)d_in[i];
    a.out = (float*)d_out; a.ws = ws;
    launch_mk(a, 0, 12, grid, stream);
}
```
